# Optimizing an MI355X kernel written in HIP

```python
import math
import jax, jax.numpy as jnp
from jax import lax
import numpy as np

D_MODEL = 2048
BATCH = 8
SEQ = 2048
DEPTH = 1
DEC_BATCH = 16
DEC_SEQ = 2048
PAST_LEN = 128

D_MIX = 2048
ATTN_HEADS = 8
ATTN_KV_HEADS = 2
ATTN_HEAD_DIM = 128
ATTN_WIDTH = ATTN_HEADS * ATTN_HEAD_DIM
KV_WIDTH = ATTN_KV_HEADS * ATTN_HEAD_DIM
MLSTM_HEADS = 4
MLSTM_QK_DIM = 128
MLSTM_V_DIM = 256
MLSTM_QK_WIDTH = MLSTM_HEADS * MLSTM_QK_DIM
MLSTM_WIDTH = MLSTM_HEADS * MLSTM_V_DIM
N_GATE_COLS = 4 * MLSTM_HEADS
GRID_W = 64
ROPE_THETA = 10000.0
Q_BLOCK = 128
CHUNK = 128
EPS = 1e-6
IN_SPLITS = (ATTN_WIDTH, KV_WIDTH, KV_WIDTH, ATTN_WIDTH,
             MLSTM_QK_WIDTH, MLSTM_QK_WIDTH, MLSTM_WIDTH, MLSTM_WIDTH, MLSTM_WIDTH,
             N_GATE_COLS)
D_IN_PROJ = ATTN_WIDTH + 2 * KV_WIDTH + ATTN_WIDTH + 2 * MLSTM_QK_WIDTH + 3 * MLSTM_WIDTH + N_GATE_COLS

kernel_name = "hymba_attn_mlstm_bidir_encoder"


def rmsnorm(x, g):
    xf = x.astype(jnp.float32)
    y = xf * lax.rsqrt(jnp.mean(xf * xf, axis=-1, keepdims=True) + EPS) * g.astype(jnp.float32)
    return y.astype(x.dtype)


def axial_rope_tables(S):
    rows = S // GRID_W
    row = jnp.repeat(jnp.arange(rows), GRID_W).astype(jnp.float32)
    col = jnp.tile(jnp.arange(GRID_W), rows).astype(jnp.float32)
    nf = ATTN_HEAD_DIM // 4
    inv = 1.0 / (ROPE_THETA ** (jnp.arange(nf, dtype=jnp.float32) / nf))
    ang_r = row[:, None] * inv
    ang_c = col[:, None] * inv
    ang = jnp.concatenate([ang_r, ang_r, ang_c, ang_c], axis=-1)
    return jnp.cos(ang), jnp.sin(ang)


def apply_axial_rope(x, cos, sin):
    q = ATTN_HEAD_DIM // 4
    x1, x2, x3, x4 = x[..., :q], x[..., q:2 * q], x[..., 2 * q:3 * q], x[..., 3 * q:]
    rot = jnp.concatenate([-x2, x1, -x4, x3], axis=-1)
    return x * cos[None, :, None, :] + rot * sin[None, :, None, :]


def blocked_gqa_attention(q, k, v):
    B, S, H, D = q.shape
    G = H // ATTN_KV_HEADS
    nblk = S // Q_BLOCK
    scale = 1.0 / math.sqrt(D)
    qb = q.reshape(B, nblk, Q_BLOCK, ATTN_KV_HEADS, G, D).transpose(1, 0, 2, 3, 4, 5)

    def one_block(qi):
        s = jnp.einsum('bqkgd,bskd->bkgqs', qi, k) * scale
        p = jax.nn.softmax(s, axis=-1)
        return jnp.einsum('bkgqs,bskd->bqkgd', p, v)

    o = lax.map(one_block, qb)
    return o.transpose(1, 0, 2, 3, 4, 5).reshape(B, S, H * D)


def mlstm_chunkwise(q, k, v, i_pre, logf):
    B, H, S, dk = q.shape
    dv = v.shape[-1]
    nc = S // CHUNK

    def to_chunks(a):
        return jnp.moveaxis(a.reshape(a.shape[:2] + (nc, CHUNK) + a.shape[3:]), 2, 0)

    qc, kc, vc, ic, fc = (to_chunks(a) for a in (q, k, v, i_pre, logf))
    mask = jnp.tril(jnp.ones((CHUNK, CHUNK), dtype=bool))

    def step(carry, inp):
        C, n, m = carry
        qq, kk, vv, ii, ff = inp
        b = jnp.cumsum(ff, axis=-1)
        g = b[..., -1]
        a = b[..., :, None] - b[..., None, :] + ii[..., None, :]
        a = jnp.where(mask, a, -jnp.inf)
        inter = b + m[..., None]
        m_t = jnp.maximum(inter, jnp.max(a, axis=-1))
        w = jnp.exp(a - m_t[..., None])
        si = jnp.exp(inter - m_t)
        qk = jnp.einsum('bhtd,bhsd->bhts', qq, kk) * w
        num = jnp.einsum('bhts,bhsv->bhtv', qk, vv) + si[..., None] * jnp.einsum('bhtd,bhdv->bhtv', qq, C)
        den = jnp.sum(qk, axis=-1) + si * jnp.einsum('bhtd,bhd->bht', qq, n)
        h = num / jnp.maximum(jnp.abs(den), jnp.exp(-m_t))[..., None]
        e = g[..., None] - b + ii
        m_new = jnp.maximum(g + m, jnp.max(e, axis=-1))
        sc = jnp.exp(g + m - m_new)
        we = jnp.exp(e - m_new[..., None])
        C_new = sc[..., None, None] * C + jnp.einsum('bhs,bhsd,bhsv->bhdv', we, kk, vv)
        n_new = sc[..., None] * n + jnp.einsum('bhs,bhsd->bhd', we, kk)
        return (C_new, n_new, m_new), h

    init = (jnp.zeros((B, H, dk, dv), jnp.float32), jnp.zeros((B, H, dk), jnp.float32),
            jnp.zeros((B, H), jnp.float32))
    _, hs = lax.scan(step, init, (qc, kc, vc, ic, fc))
    return jnp.moveaxis(hs, 0, 2).reshape(B, H, S, dv)


def hybrid_layer(x, norm_g, w_in, b_gates, q_norm_g, k_norm_g, mlstm_norm_g, w_out):
    B, S, _ = x.shape
    f32 = jnp.float32
    h = rmsnorm(x, norm_g)
    proj = h @ w_in
    parts = []
    off = 0
    for size in IN_SPLITS:
        parts.append(proj[..., off:off + size])
        off += size
    aq, ak, av, az, mq, mk, mv, mo, mz, gates = parts

    cos, sin = axial_rope_tables(S)
    aq = rmsnorm(aq.reshape(B, S, ATTN_HEADS, ATTN_HEAD_DIM), q_norm_g).astype(f32)
    ak = rmsnorm(ak.reshape(B, S, ATTN_KV_HEADS, ATTN_HEAD_DIM), k_norm_g).astype(f32)
    av = av.reshape(B, S, ATTN_KV_HEADS, ATTN_HEAD_DIM).astype(f32)
    aq = apply_axial_rope(aq, cos, sin)
    ak = apply_axial_rope(ak, cos, sin)
    attn_out = blocked_gqa_attention(aq, ak, av).astype(x.dtype) * jax.nn.silu(az)

    g4 = (gates.astype(f32) + b_gates.astype(f32)).reshape(B, S, 4, MLSTM_HEADS)
    g4 = jnp.transpose(g4, (2, 0, 3, 1))
    i_f, f_f, i_b, f_b = g4[0], g4[1], g4[2], g4[3]
    mq = mq.astype(f32).reshape(B, S, MLSTM_HEADS, MLSTM_QK_DIM).transpose(0, 2, 1, 3) * (MLSTM_QK_DIM ** -0.5)
    mk = mk.astype(f32).reshape(B, S, MLSTM_HEADS, MLSTM_QK_DIM).transpose(0, 2, 1, 3)
    mv = mv.astype(f32).reshape(B, S, MLSTM_HEADS, MLSTM_V_DIM).transpose(0, 2, 1, 3)
    h_fwd = mlstm_chunkwise(mq, mk, mv, i_f, jax.nn.log_sigmoid(f_f))
    fl = lambda a: jnp.flip(a, axis=2)
    h_bwd = fl(mlstm_chunkwise(fl(mq), fl(mk), fl(mv), fl(i_b), fl(jax.nn.log_sigmoid(f_b))))
    hm = (h_fwd + h_bwd).transpose(0, 2, 1, 3)
    hm = jax.nn.sigmoid(mo.astype(f32)).reshape(B, S, MLSTM_HEADS, MLSTM_V_DIM) * hm
    hm = rmsnorm(hm, mlstm_norm_g.reshape(MLSTM_HEADS, MLSTM_V_DIM))
    mlstm_out = hm.reshape(B, S, MLSTM_WIDTH).astype(x.dtype) * jax.nn.silu(mz)

    y = jnp.concatenate([attn_out, mlstm_out], axis=-1) @ w_out
    return x + y.astype(x.dtype)


def trunk(x, norm_g, w_in, b_gates, q_norm_g, k_norm_g, mlstm_norm_g, w_out):
    for l in range(DEPTH):
        x = hybrid_layer(x, norm_g[l], w_in[l], b_gates[l], q_norm_g[l], k_norm_g[l],
                         mlstm_norm_g[l], w_out[l])
    return x


def setup_inputs(seed: int = 0) -> dict:
    key = jax.random.key(seed)
    ks = jax.random.split(key, 9)
    x_prompt = jax.random.normal(ks[0], (BATCH, SEQ, D_MODEL), jnp.float32)
    x_sample = jax.random.normal(ks[1], (DEC_BATCH, DEC_SEQ, D_MODEL), jnp.float32)
    norm_g = 1.0 + 0.02 * jax.random.normal(ks[2], (DEPTH, D_MODEL), jnp.float32)
    w_in = jax.random.normal(ks[3], (DEPTH, D_MODEL, D_IN_PROJ), jnp.float32) * (D_MODEL ** -0.5)
    fb = jnp.linspace(3.0, 6.0, MLSTM_HEADS, dtype=jnp.float32)
    zb = jnp.zeros((MLSTM_HEADS,), jnp.float32)
    gate_base = jnp.concatenate([zb, fb, zb, fb])
    b_gates = gate_base[None, :] + 0.1 * jax.random.normal(ks[4], (DEPTH, N_GATE_COLS), jnp.float32)
    q_norm_g = 1.0 + 0.02 * jax.random.normal(ks[5], (DEPTH, ATTN_HEAD_DIM), jnp.float32)
    k_norm_g = 1.0 + 0.02 * jax.random.normal(ks[6], (DEPTH, ATTN_HEAD_DIM), jnp.float32)
    mlstm_norm_g = 1.0 + 0.02 * jax.random.normal(ks[7], (DEPTH, MLSTM_WIDTH), jnp.float32)
    w_out = jax.random.normal(ks[8], (DEPTH, D_MIX, D_MODEL), jnp.float32) * (D_MIX ** -0.5)
    return {"x_prompt": x_prompt, "x_sample": x_sample, "norm_g": norm_g, "w_in": w_in,
            "b_gates": b_gates, "q_norm_g": q_norm_g, "k_norm_g": k_norm_g,
            "mlstm_norm_g": mlstm_norm_g, "w_out": w_out}


def reference(x_prompt, x_sample, norm_g, w_in, b_gates, q_norm_g, k_norm_g, mlstm_norm_g, w_out):
    y_prompt = trunk(x_prompt, norm_g, w_in, b_gates, q_norm_g, k_norm_g, mlstm_norm_g, w_out)
    y_sample = trunk(x_sample, norm_g, w_in, b_gates, q_norm_g, k_norm_g, mlstm_norm_g, w_out)
    return (y_prompt, y_sample)
```

```cpp
#include <hip/hip_runtime.h>
#include <hip/hip_bf16.h>
#include <hip/hip_cooperative_groups.h>
#include <cstdio>
#include <cstdint>
#include <cmath>
namespace cg = cooperative_groups;

#ifndef HY_N_LAUNCHES
#define HY_N_LAUNCHES 7
#endif

constexpr int SEQ = 2048, NSEQ = 24, NTOK = NSEQ * SEQ, TOK_PROMPT = 8 * SEQ, DM = 2048;
constexpr int NPROJ = 6672, NP256 = 6656, N1PAD = 6912;
constexpr float EPS = 1e-6f;

constexpr size_t MiB = 1u << 20;
constexpr size_t WS_CTL = 0, CTL_ZERO_BYTES = 1 * MiB;
constexpr size_t WS_ROPE = 1 * MiB;
constexpr size_t WS_W1T = 2 * MiB;
constexpr size_t WS_W2T = 30 * MiB;
constexpr size_t WS_GATES = 38 * MiB;
constexpr size_t WS_H = 42 * MiB;
constexpr size_t WS_HF = WS_H, WS_HB = WS_H + 96 * MiB;
constexpr size_t WS_MIX = 234 * MiB;
constexpr size_t WS_AK = 426 * MiB, WS_AV = 450 * MiB;
constexpr size_t WS_AZ = 474 * MiB;
constexpr size_t WS_MQ = 570 * MiB, WS_MK = 618 * MiB;
constexpr size_t WS_MV = 666 * MiB, WS_MO = 762 * MiB, WS_MZ = 858 * MiB;
constexpr size_t WS_END = 954 * MiB;

typedef unsigned short bf16;
__device__ __forceinline__ unsigned f2bf(float f) { unsigned u = __builtin_bit_cast(unsigned, f); return (u + 0x7fffu + ((u >> 16) & 1u)) >> 16; }
__device__ __forceinline__ unsigned pk2(float lo, float hi) { return f2bf(lo) | (f2bf(hi) << 16); }
__device__ __forceinline__ float bf2f(unsigned short b) { return __builtin_bit_cast(float, (unsigned)b << 16); }
__device__ __forceinline__ float bflo(unsigned w) { return __builtin_bit_cast(float, w << 16); }
__device__ __forceinline__ float bfhi(unsigned w) { return __builtin_bit_cast(float, w & 0xffff0000u); }
__device__ __forceinline__ float log_sigmoid_f(float x) { return x >= 0.f ? -log1pf(expf(-x)) : x - log1pf(expf(x)); }
namespace pg8 {
#define PG8_LAS __attribute__((address_space(3)))
typedef unsigned short bf16_t;
typedef short bf16x8 __attribute__((ext_vector_type(8)));
typedef float f32x4 __attribute__((ext_vector_type(4)));
typedef unsigned u32x4 __attribute__((ext_vector_type(4)));
constexpr int BM = 256, BK = 64, HALF = 128, HTB = HALF * BK * 2  , STAGE_BYTES = 8 * HTB, NXCD = 8, WGM = 8;

__host__ __device__ __forceinline__ int lds_byte(int r, int c) { const int st = (r >> 4) * 2 + (c >> 5), rr = r & 15, cc = c & 31, ob = rr * 64 + cc * 2; return st * 1024 + (ob ^ (((ob >> 9) & 1) << 5)); }
__host__ __device__ __forceinline__ void stage_rc(int b, int& R, int& C) { const int st = b / 1024, sb = b % 1024, swz = sb ^ (((sb >> 9) & 1) << 5); R = (st >> 1) * 16 + swz / 64; C = (st & 1) * 32 + (swz % 64) / 2; }
__host__ __device__ __forceinline__ int perm32(int rho) { const int n = rho >> 4, i = rho & 15; return 8 * (i >> 2) + 4 * n + (i & 3); }

struct Unit { int pm, pn; };
struct Gemm { const bf16_t* A; const bf16_t* Bt; int M, N, K; };

struct StaticOrder {
    int nM, nN, nwg, G, c;
    __host__ __device__ void init(int M, int N, int G_, int c_) { nM = M / BM; nN = N / BM; nwg = nM * nN; G = G_; c = c_; }
    __host__ __device__ bool next(int i, Unit& u) const {
        const long L = (long)i * G + c; if (L >= nwg) return false;
        int wgid = (int)L; { const int q = nwg / NXCD, r = nwg % NXCD, xcd = wgid % NXCD, off = wgid / NXCD; wgid = (xcd < r ? xcd * (q + 1) : r * (q + 1) + (xcd - r) * q) + off; }
        const int nig = WGM * nN, gid = wgid / nig, fm = gid * WGM, gsz = (nM - fm) < WGM ? (nM - fm) : WGM;
        u.pm = fm + ((wgid % nig) % gsz); u.pn = (wgid % nig) / gsz; return true;
    }
    __device__ __forceinline__ void a_ready(const Unit&) const {}
    __device__ __forceinline__ void done(const Unit&) const {}
};


__device__ __forceinline__ unsigned cvt_pk_bf16(float lo, float hi) { unsigned r; asm volatile("v_cvt_pk_bf16_f32 %0, %1, %2" : "=v"(r) : "v"(lo), "v"(hi)); return r; }

struct EpiProj {
    static constexpr bool PERM = true, AFTER_DRAIN = false;
    unsigned char* ws; const float* b_gates;
    __device__ __forceinline__ void operator()(const f32x4 (&acc)[2][2][4][2], const Unit& u, int wr, int wc, int fr, int fq) const {
        const int pn = u.pn; const int row0 = u.pm * BM + wr * 64 + fr;
        if (pn == 26) {
            if (wc == 0 && fq < 2) {
                float* G = (float*)(ws + WS_GATES);
                const f32x4 b0 = *(const f32x4*)(b_gates + 8 * fq), b1 = *(const f32x4*)(b_gates + 8 * fq + 4);
#pragma unroll
                for (int ai = 0; ai < 2; ++ai)
#pragma unroll
                    for (int m = 0; m < 4; ++m) { const size_t row = (size_t)(row0 + ai * HALF + m * 16);
                        const f32x4 vi = acc[ai][0][m][0] + b0; f32x4 vf = acc[ai][0][m][1] + b1;
                        vf[0] = log_sigmoid_f(vf[0]); vf[1] = log_sigmoid_f(vf[1]); vf[2] = log_sigmoid_f(vf[2]); vf[3] = log_sigmoid_f(vf[3]);
                        *(f32x4*)(G + row * 16 + 8 * fq) = vi; *(f32x4*)(G + row * 16 + 8 * fq + 4) = vf; }
            }
            return;
        }
        size_t off; int ldc, colt; float sc = 1.f;
        if (pn < 4)       { off = WS_MIX; ldc = 2048; colt = pn * 256; }
        else if (pn == 4) { off = WS_AK;  ldc = 256;  colt = 0; }
        else if (pn == 5) { off = WS_AV;  ldc = 256;  colt = 0; }
        else if (pn < 10) { off = WS_AZ;  ldc = 1024; colt = (pn - 6) * 256; }
        else if (pn < 12) { off = WS_MQ;  ldc = 512;  colt = (pn - 10) * 256; sc = 0.08838834764831845f; }
        else if (pn < 14) { off = WS_MK;  ldc = 512;  colt = (pn - 12) * 256; }
        else if (pn < 18) { off = WS_MV;  ldc = 1024; colt = (pn - 14) * 256; }
        else if (pn < 22) { off = WS_MO;  ldc = 1024; colt = (pn - 18) * 256; }
        else              { off = WS_MZ;  ldc = 1024; colt = (pn - 22) * 256; }
        bf16_t* base = (bf16_t*)(ws + off);
        const int col0 = colt + wc * 32 + 8 * fq;
#pragma unroll
        for (int ai = 0; ai < 2; ++ai)
#pragma unroll
            for (int m = 0; m < 4; ++m) { bf16_t* rowp = base + (size_t)(row0 + ai * HALF + m * 16) * ldc + col0;
#pragma unroll
                for (int bj = 0; bj < 2; ++bj) { const f32x4 v0 = acc[ai][bj][m][0] * sc, v1 = acc[ai][bj][m][1] * sc;
                    u32x4 w; w.x = cvt_pk_bf16(v0[0], v0[1]); w.y = cvt_pk_bf16(v0[2], v0[3]); w.z = cvt_pk_bf16(v1[0], v1[1]); w.w = cvt_pk_bf16(v1[2], v1[3]);
                    *(u32x4*)(rowp + bj * HALF) = w; } }
    }
};
struct EpiOut {
    static constexpr bool PERM = true, AFTER_DRAIN = false;
    const float* xp; const float* xs; float* out;
    __device__ __forceinline__ void operator()(const f32x4 (&acc)[2][2][4][2], const Unit& u, int wr, int wc, int fr, int fq) const {
        const int row0 = u.pm * BM + wr * 64 + fr; const int col0 = u.pn * BM + wc * 32 + 8 * fq;
        const bool pr = row0 < TOK_PROMPT; const float* xb = pr ? xp : xs;
        const size_t xsub = pr ? 0 : (size_t)TOK_PROMPT * DM;
#pragma unroll
        for (int ai = 0; ai < 2; ++ai)
#pragma unroll
            for (int m = 0; m < 4; ++m) { const size_t ro = (size_t)(row0 + ai * HALF + m * 16) * DM + col0;
#pragma unroll
                for (int bj = 0; bj < 2; ++bj) { const f32x4 x0 = *(const f32x4*)(xb + (ro - xsub) + bj * HALF), x1 = *(const f32x4*)(xb + (ro - xsub) + bj * HALF + 4);
                    *(f32x4*)(out + ro + bj * HALF) = x0 + acc[ai][bj][m][0]; *(f32x4*)(out + ro + bj * HALF + 4) = x1 + acc[ai][bj][m][1]; } }
    }
};

template <class Epi, class Sched, bool ALIGN_EPI = false, bool SP2 = false>
__device__ __forceinline__ void gemm_phase(PG8_LAS unsigned char* lds, const Gemm g, const Sched& S, const Epi& E) {
    const int tid = threadIdx.x, wid = __builtin_amdgcn_readfirstlane(tid >> 6), lane = tid & 63, wr = wid >> 2, wc = wid & 3, fr = lane & 15, fq = lane >> 4;
    const int K = g.K, nt = K / BK;
    unsigned voffA[2], voffB[2];
#pragma unroll
    for (int i = 0; i < 2; ++i) { int R, C; stage_rc(tid * 16 + i * 8192, R, C); const int Rb = Epi::PERM ? ((R & ~31) + perm32(R & 31)) : R;
        voffA[i] = (unsigned)(R * K + C) * 2u; voffB[i] = (unsigned)(Rb * K + C) * 2u; }
    const size_t kstep = (size_t)(BK * 2);
    const size_t hstep = (size_t)HALF * K * 2;
    const size_t tstep = 2 * hstep;
    const unsigned ldsw = (unsigned)wid * 1024u;
    const int aoff = lds_byte(wr * 64 + fr, fq * 8), boff = lds_byte(wc * 32 + fr, fq * 8);
#define PG8_SA(b, h) (((b) * 2 + (h)) * HTB)
#define PG8_SB(b, h) ((4 + (b) * 2 + (h)) * HTB)
#define PG8_STAGE(bufoff, gbase, voff) do { _Pragma("unroll") for (int _i = 0; _i < 2; ++_i) \
        __builtin_amdgcn_global_load_lds((const unsigned*)((const char*)(gbase) + (voff)[_i]), (PG8_LAS unsigned*)(lds + (bufoff) + ldsw + _i * 8192), 16, 0, 0); } while (0)
#define PG8_LDA(dst, b, h) do { _Pragma("unroll") for (int m = 0; m < 4; ++m) _Pragma("unroll") for (int k = 0; k < 2; ++k) dst[m][k] = *(const PG8_LAS bf16x8*)(lds + PG8_SA(b, h) + aoff + m * 2048 + k * 1024); } while (0)
#define PG8_LDB(dst, b, h) do { _Pragma("unroll") for (int n = 0; n < 2; ++n) _Pragma("unroll") for (int k = 0; k < 2; ++k) dst[n][k] = *(const PG8_LAS bf16x8*)(lds + PG8_SB(b, h) + boff + n * 2048 + k * 1024); } while (0)
#define PG8_MMA(ai, bj, At, Bt) do { __builtin_amdgcn_s_setprio(1); _Pragma("unroll") for (int m = 0; m < 4; ++m) _Pragma("unroll") for (int n = 0; n < 2; ++n) _Pragma("unroll") for (int k = 0; k < 2; ++k) \
        acc[ai][bj][m][n] = __builtin_amdgcn_mfma_f32_16x16x32_bf16(Bt[n][k], At[m][k], acc[ai][bj][m][n], 0, 0, 0); __builtin_amdgcn_s_setprio(0); } while (0)
#define PG8_WAIT_V(n) asm volatile("s_waitcnt vmcnt(" #n ")" ::: "memory")
#define PG8_WAIT_L(n) asm volatile("s_waitcnt lgkmcnt(" #n ")" ::: "memory")
#define PG8_BAR __builtin_amdgcn_s_barrier()
#define PG8_SCHED __builtin_amdgcn_sched_barrier(0)
    Unit cur, nxt; int ui = 0;
    if (!S.next(0, cur)) return;
    f32x4 acc[2][2][4][2];
#pragma unroll
    for (int a = 0; a < 2; ++a)
#pragma unroll
        for (int b = 0; b < 2; ++b)
#pragma unroll
            for (int m = 0; m < 4; ++m)
#pragma unroll
                for (int n = 0; n < 2; ++n) acc[a][b][m][n] = (f32x4){0.f, 0.f, 0.f, 0.f};
    bf16x8 At[4][2], B0[2][2], B1[2][2];
    const char* cA = (const char*)g.A + (size_t)cur.pm * tstep; const char* cB = (const char*)g.Bt + (size_t)cur.pn * tstep;
    S.a_ready(cur);
    if constexpr (SP2) {
        PG8_STAGE(PG8_SB(0, 0), cB, voffB); PG8_STAGE(PG8_SB(0, 1), cB + hstep, voffB); PG8_STAGE(PG8_SA(0, 0), cA, voffA); PG8_STAGE(PG8_SA(0, 1), cA + hstep, voffA);
        if (wr == 1) PG8_BAR;
        PG8_WAIT_V(2); PG8_BAR;
        PG8_STAGE(PG8_SB(1, 0), cB + kstep, voffB); PG8_STAGE(PG8_SA(1, 0), cA + kstep, voffA); PG8_STAGE(PG8_SB(1, 1), cB + hstep + kstep, voffB);
        PG8_WAIT_V(6); PG8_BAR;
    } else {
        PG8_STAGE(PG8_SB(0, 0), cB, voffB); PG8_STAGE(PG8_SA(0, 0), cA, voffA); PG8_STAGE(PG8_SB(0, 1), cB + hstep, voffB); PG8_STAGE(PG8_SA(0, 1), cA + hstep, voffA);
        if (wr == 1) PG8_BAR;
        PG8_WAIT_V(4); PG8_BAR;
        PG8_STAGE(PG8_SB(1, 0), cB + kstep, voffB); PG8_STAGE(PG8_SA(1, 0), cA + kstep, voffA); PG8_STAGE(PG8_SB(1, 1), cB + hstep + kstep, voffB);
        PG8_WAIT_V(6); PG8_BAR;
    }
    for (;;) {
        const bool has_next = S.next(ui + 1, nxt);
        const char* nA = has_next ? (const char*)g.A + (size_t)nxt.pm * tstep : cA; const char* nB = has_next ? (const char*)g.Bt + (size_t)nxt.pn * tstep : cB;
        for (int t = 0; t < nt; t += 2) {
            const bool last = (t == nt - 2);
            const char* a1 = cA + (size_t)(t + 1) * kstep;
            const char* a2 = last ? nA : cA + (size_t)(t + 2) * kstep; const char* b2 = last ? nB : cB + (size_t)(t + 2) * kstep;
            const char* a3 = a2 + kstep; const char* b3 = b2 + kstep;
            if (last && has_next) S.a_ready(nxt);
            if constexpr (SP2) {
            PG8_LDB(B0, 0, 0); PG8_LDB(B1, 0, 1); PG8_SCHED; PG8_LDA(At, 0, 0); PG8_STAGE(PG8_SA(1, 1), a1 + hstep, voffA);
            PG8_WAIT_V(8); PG8_WAIT_L(0); PG8_BAR; PG8_MMA(0, 0, At, B0); PG8_MMA(0, 1, At, B1); PG8_BAR; PG8_SCHED;
            PG8_LDA(At, 0, 1); PG8_STAGE(PG8_SB(0, 0), b2, voffB); PG8_STAGE(PG8_SB(0, 1), b2 + hstep, voffB); PG8_STAGE(PG8_SA(0, 0), a2, voffA);
            PG8_WAIT_V(8); PG8_WAIT_L(0); PG8_BAR; PG8_MMA(1, 0, At, B0); PG8_MMA(1, 1, At, B1); PG8_BAR; PG8_SCHED;
            PG8_LDB(B0, 1, 0); PG8_LDB(B1, 1, 1); PG8_SCHED; PG8_LDA(At, 1, 0); PG8_STAGE(PG8_SA(0, 1), a2 + hstep, voffA);
            PG8_WAIT_V(8); PG8_WAIT_L(0); PG8_BAR; PG8_MMA(0, 0, At, B0); PG8_MMA(0, 1, At, B1); PG8_BAR; PG8_SCHED;
            PG8_LDA(At, 1, 1); PG8_STAGE(PG8_SB(1, 0), b3, voffB); PG8_STAGE(PG8_SB(1, 1), b3 + hstep, voffB); PG8_STAGE(PG8_SA(1, 0), a3, voffA);
            PG8_WAIT_V(8); PG8_WAIT_L(0); PG8_BAR; PG8_MMA(1, 0, At, B0); PG8_MMA(1, 1, At, B1); PG8_BAR; PG8_SCHED;
            } else {
            PG8_LDB(B0, 0, 0); PG8_SCHED; PG8_LDA(At, 0, 0); PG8_STAGE(PG8_SA(1, 1), a1 + hstep, voffA);
            PG8_WAIT_L(8); PG8_BAR; PG8_WAIT_L(0); PG8_MMA(0, 0, At, B0); PG8_BAR; PG8_SCHED;
            PG8_LDB(B1, 0, 1); PG8_STAGE(PG8_SB(0, 0), b2, voffB);
            PG8_BAR; PG8_WAIT_L(0); PG8_MMA(0, 1, At, B1); PG8_BAR;
            PG8_LDA(At, 0, 1); PG8_STAGE(PG8_SA(0, 0), a2, voffA);
            PG8_BAR; PG8_WAIT_L(0); PG8_MMA(1, 0, At, B0); PG8_BAR; PG8_SCHED;
            PG8_STAGE(PG8_SB(0, 1), b2 + hstep, voffB);
            PG8_WAIT_V(6); PG8_BAR; PG8_MMA(1, 1, At, B1); PG8_BAR;
            PG8_LDB(B0, 1, 0); PG8_SCHED; PG8_LDA(At, 1, 0); PG8_STAGE(PG8_SA(0, 1), a2 + hstep, voffA);
            PG8_WAIT_L(8); PG8_BAR; PG8_WAIT_L(0); PG8_MMA(0, 0, At, B0); PG8_BAR; PG8_SCHED;
            PG8_LDB(B1, 1, 1); PG8_STAGE(PG8_SB(1, 0), b3, voffB);
            PG8_BAR; PG8_WAIT_L(0); PG8_MMA(0, 1, At, B1); PG8_BAR;
            PG8_LDA(At, 1, 1); PG8_STAGE(PG8_SA(1, 0), a3, voffA);
            PG8_BAR; PG8_WAIT_L(0); PG8_MMA(1, 0, At, B0); PG8_BAR; PG8_SCHED;
            PG8_STAGE(PG8_SB(1, 1), b3 + hstep, voffB);
            PG8_WAIT_V(6); PG8_BAR; PG8_MMA(1, 1, At, B1); PG8_BAR;
            }
        }
        if constexpr (ALIGN_EPI) { if (wr == 0) PG8_BAR; }
        if constexpr (!Epi::AFTER_DRAIN) { E(acc, cur, wr, wc, fr, fq); S.done(cur); }
        if (!has_next) break;
#pragma unroll
        for (int a = 0; a < 2; ++a)
#pragma unroll
            for (int b = 0; b < 2; ++b)
#pragma unroll
                for (int m = 0; m < 4; ++m)
#pragma unroll
                    for (int n = 0; n < 2; ++n) acc[a][b][m][n] = (f32x4){0.f, 0.f, 0.f, 0.f};
        cur = nxt; cA = nA; cB = nB; ++ui;
        if constexpr (ALIGN_EPI) { if (wr == 1) PG8_BAR; }
    }
    PG8_WAIT_V(0);
    if constexpr (!ALIGN_EPI) { if (wr == 0) PG8_BAR; }
    PG8_BAR;
    if constexpr (Epi::AFTER_DRAIN) { E.fused(acc, cur, wr, wc, fr, fq, lds, wid, lane); S.done(cur); }
#undef PG8_SA
#undef PG8_SB
#undef PG8_STAGE
#undef PG8_LDA
#undef PG8_LDB
#undef PG8_MMA
#undef PG8_WAIT_V
#undef PG8_WAIT_L
#undef PG8_BAR
#undef PG8_SCHED
}
}
namespace attn {
using bf16 = __hip_bfloat16;
constexpr int   D = 128, NW = 8, QBLK = 32, KVBLK = 64;
constexpr float SCALE = 0.088388347648318440f;
constexpr float THR = 8.f;
constexpr int SDEPTH = 2;
constexpr int LDQ = 2048, LDK = 256, LDO = 2048, LDZ = 1024;
constexpr size_t SHM_V = KVBLK * D * 2, SHM_K = KVBLK * D * 2, SHM_ATTN = 2 * SHM_V + 2 * SHM_K + NW * 64 * 4;
using bf16x8 = __attribute__((ext_vector_type(8))) short;
using s16x4  = __attribute__((ext_vector_type(4))) short;
using f32x16 = __attribute__((ext_vector_type(16))) float;
using f32x8  = __attribute__((ext_vector_type(8))) float;
using u32x4  = __attribute__((ext_vector_type(4))) unsigned;
#define KSWZ(row, colB) ((row) * 256 + ((colB) ^ (((row) & 7) << 4)))
#define SBAR() __builtin_amdgcn_sched_barrier(0)
__device__ __forceinline__ int crow(int r, int hi) { return (r & 3) + 8 * (r >> 2) + 4 * hi; }
__device__ __forceinline__ unsigned cvtpk(float lo, float hi) {
  unsigned r; asm volatile("v_cvt_pk_bf16_f32 %0, %1, %2" : "=v"(r) : "v"(lo), "v"(hi)); return r;
}
template <typename TIn> struct Stage;
template <> struct Stage<bf16>  { using T = bf16x8;
  __device__ static __forceinline__ T ld8(const bf16* p) { return *reinterpret_cast<const bf16x8*>(p); }
  __device__ static __forceinline__ bf16x8 tobf(T x) { return x; } };
template <> struct Stage<float> { using T = f32x8;
  __device__ static __forceinline__ T ld8(const float* p) { return *reinterpret_cast<const f32x8*>(p); }
  __device__ static __forceinline__ bf16x8 tobf(T x) {
    u32x4 w = {cvtpk(x[0], x[1]), cvtpk(x[2], x[3]), cvtpk(x[4], x[5]), cvtpk(x[6], x[7])}; return *reinterpret_cast<bf16x8*>(&w); } };

__device__ __forceinline__ void partialSM(f32x16& p0, f32x16& p1, float& m_reg, float& mn, float& alpha) {
  constexpr float C = SCALE * 1.4426950408889634f;
  float pmax = p0[0]; for (int r = 1; r < 16; ++r) pmax = fmaxf(pmax, p0[r]); for (int r = 0; r < 16; ++r) pmax = fmaxf(pmax, p1[r]);
  { auto rr = __builtin_amdgcn_permlane32_swap(__float_as_uint(pmax), __float_as_uint(pmax), false, false);
    pmax = fmaxf(__uint_as_float(rr[0]), __uint_as_float(rr[1])); }
  if (__builtin_expect(__all(pmax - m_reg <= THR / SCALE), 1)) { mn = m_reg; alpha = 1.f; }
  else { mn = fmaxf(m_reg, pmax); alpha = __builtin_amdgcn_exp2f((m_reg - mn) * C); m_reg = mn; }
  float mnC = -mn * C;
  for (int r = 0; r < 16; ++r) p0[r] = fmaf(p0[r], C, mnC); for (int r = 0; r < 16; ++r) p1[r] = fmaf(p1[r], C, mnC);
  for (int r = 0; r < 16; ++r) p0[r] = __builtin_amdgcn_exp2f(p0[r]);
}
__device__ __forceinline__ void finishSM(f32x16& p0, f32x16& p1, float alpha, float& l_reg, bf16x8& pa0, bf16x8& pa1, bf16x8& pa2, bf16x8& pa3) {
  for (int r = 0; r < 16; ++r) p1[r] = __builtin_amdgcn_exp2f(p1[r]);
  float ps = 0; for (int r = 0; r < 16; ++r) ps += p0[r]; for (int r = 0; r < 16; ++r) ps += p1[r];
  { auto rr = __builtin_amdgcn_permlane32_swap(__float_as_uint(ps), __float_as_uint(ps), false, false);
    ps = __uint_as_float(rr[0]) + __uint_as_float(rr[1]); }
  l_reg = l_reg * alpha + ps;
#define PK4(P, BASE, OUT) do { unsigned a0 = cvtpk(P[BASE + 0], P[BASE + 1]), a1 = cvtpk(P[BASE + 2], P[BASE + 3]);   \
    unsigned b0 = cvtpk(P[BASE + 4], P[BASE + 5]), b1 = cvtpk(P[BASE + 6], P[BASE + 7]);                              \
    auto r0 = __builtin_amdgcn_permlane32_swap(a0, b0, false, false); auto r1 = __builtin_amdgcn_permlane32_swap(a1, b1, false, false); \
    u32x4 w = {r0[0], r1[0], r0[1], r1[1]}; OUT = *reinterpret_cast<bf16x8*>(&w); } while (0)
  PK4(p0, 0, pa0); PK4(p0, 8, pa1); PK4(p1, 0, pa2); PK4(p1, 8, pa3);
#undef PK4
}
__device__ __forceinline__ void qkt(f32x16& p0, f32x16& p1, const bf16* Ks, const bf16x8* qr, int r32, int hi) {
  p0 = f32x16{}; p1 = f32x16{};
  for (int d0 = 0; d0 < 8; ++d0) { int cb = (d0 * 16 + hi * 8) * 2;
    bf16x8 b0 = *reinterpret_cast<const bf16x8*>((const char*)Ks + KSWZ(r32, cb));
    bf16x8 b1 = *reinterpret_cast<const bf16x8*>((const char*)Ks + KSWZ(32 + r32, cb));
    p0 = __builtin_amdgcn_mfma_f32_32x32x16_bf16(b0, qr[d0], p0, 0, 0, 0);
    p1 = __builtin_amdgcn_mfma_f32_32x32x16_bf16(b1, qr[d0], p1, 0, 0, 0); }
}
__device__ __forceinline__ int v_st(int k, int c) { const int kk = (k & ~0xC) | ((k & 4) << 1) | ((k & 8) >> 1); return ((kk >> 3) * 4 + (c >> 5)) * 512 + ((kk & 7) * 32 + (c & 31)) * 2; }
__device__ __forceinline__ int v_rd_base(int lane) { return ((lane & 3) << 3) | (((lane >> 2) & 3) << 6) | (((lane >> 4) & 1) << 5) | (((lane >> 5) & 1) << 8); }
constexpr int v_rd_off(int d0, int ks, int half) { return d0 * 512 + ks * 4096 + half * 2048; }
template <int OFF> __device__ __forceinline__ s16x4 tr_read(int vb) {
  s16x4 r; asm volatile("ds_read_b64_tr_b16 %0, %1 offset:%2" : "=&v"(r) : "v"(vb), "i"(OFF) : "memory"); return r;
}
template <int D0> __device__ __forceinline__ void pv_one(f32x16& od, int vb, bf16x8 pa0, bf16x8 pa1, bf16x8 pa2, bf16x8 pa3) {
  const s16x4 l0 = tr_read<v_rd_off(D0, 0, 0)>(vb), h0 = tr_read<v_rd_off(D0, 0, 1)>(vb), l1 = tr_read<v_rd_off(D0, 1, 0)>(vb), h1 = tr_read<v_rd_off(D0, 1, 1)>(vb);
  const s16x4 l2 = tr_read<v_rd_off(D0, 2, 0)>(vb), h2 = tr_read<v_rd_off(D0, 2, 1)>(vb), l3 = tr_read<v_rd_off(D0, 3, 0)>(vb), h3 = tr_read<v_rd_off(D0, 3, 1)>(vb);
  asm volatile("s_waitcnt lgkmcnt(0)" ::: "memory"); SBAR();
#define PK(L, H) (bf16x8){L[0], L[1], L[2], L[3], H[0], H[1], H[2], H[3]}
  od = __builtin_amdgcn_mfma_f32_32x32x16_bf16(pa0, PK(l0, h0), od, 0, 0, 0);
  od = __builtin_amdgcn_mfma_f32_32x32x16_bf16(pa1, PK(l1, h1), od, 0, 0, 0);
  od = __builtin_amdgcn_mfma_f32_32x32x16_bf16(pa2, PK(l2, h2), od, 0, 0, 0);
  od = __builtin_amdgcn_mfma_f32_32x32x16_bf16(pa3, PK(l3, h3), od, 0, 0, 0);
#undef PK
}
__device__ __forceinline__ void pv_d0(f32x16* o, int vb, bf16x8 pa0, bf16x8 pa1, bf16x8 pa2, bf16x8 pa3) {
  pv_one<0>(o[0], vb, pa0, pa1, pa2, pa3); pv_one<1>(o[1], vb, pa0, pa1, pa2, pa3); pv_one<2>(o[2], vb, pa0, pa1, pa2, pa3); pv_one<3>(o[3], vb, pa0, pa1, pa2, pa3);
}

template <typename TQ>
__device__ __forceinline__ void attn_dense_body(const TQ* Qb, const bf16* __restrict__ Kh, const bf16* __restrict__ Vh,
                                                unsigned short* Ob, const unsigned short* __restrict__ Zb, int seq, char* lds) {
  using St = Stage<bf16>; using SQ = Stage<TQ>;
  const int tid = threadIdx.x, wid = tid >> 6, lane = tid & 63, r32 = lane & 31, hi = lane >> 5;
  bf16* V_lds = (bf16*)lds; bf16* K_lds = (bf16*)(lds + 2 * SHM_V);
  float* ws = (float*)(lds + 2 * SHM_V + 2 * SHM_K) + wid * 64; float* li_l = ws; float* al_l = ws + 32;
  float m_reg = -1e30f, l_reg = 0; f32x16 o[4] = {}; bf16x8 qr[8];
  const TQ* Qw = Qb + (long)(wid * QBLK + r32) * LDQ + hi * 8;
#pragma unroll
  for (int d0 = 0; d0 < 8; ++d0) qr[d0] = SQ::tobf(SQ::ld8(Qw + d0 * 16));
  const int sr = tid >> 4, sc = (tid & 15) * 8, vst0 = v_st(sr, sc), vst1 = v_st(32 + sr, sc);
  const int vb0 = (int)(uintptr_t)V_lds + v_rd_base(lane);
  struct { typename St::T vs0, vs1, ks0, ks1; } sr_[SDEPTH];
#define SLOAD(i, k0) do { sr_[i].vs0 = St::ld8(&Vh[(long)((k0) + sr) * LDK + sc]); sr_[i].vs1 = St::ld8(&Vh[(long)((k0) + 32 + sr) * LDK + sc]); \
    sr_[i].ks0 = St::ld8(&Kh[(long)((k0) + sr) * LDK + sc]); sr_[i].ks1 = St::ld8(&Kh[(long)((k0) + 32 + sr) * LDK + sc]); } while (0)
#define SWRITE(b, i) do { *(bf16x8*)((char*)V_lds + (b) * SHM_V + vst0) = St::tobf(sr_[i].vs0);          \
    *(bf16x8*)((char*)V_lds + (b) * SHM_V + vst1) = St::tobf(sr_[i].vs1); int kc = sc * 2;               \
    *(bf16x8*)((char*)K_lds + (b) * SHM_K + KSWZ(sr, kc)) = St::tobf(sr_[i].ks0);                       \
    *(bf16x8*)((char*)K_lds + (b) * SHM_K + KSWZ(32 + sr, kc)) = St::tobf(sr_[i].ks1); } while (0)
#define SWAIT() do { if constexpr (SDEPTH == 2) asm volatile("s_waitcnt vmcnt(4)" ::: "memory"); else asm volatile("s_waitcnt vmcnt(0)" ::: "memory"); } while (0)
#define RESC(a) do { if (__any((a) < 1.f)) { if (hi == 0) al_l[r32] = (a); asm volatile("s_waitcnt lgkmcnt(0)" ::: "memory"); \
    for (int d = 0; d < 4; ++d) for (int r = 0; r < 16; ++r) o[d][r] *= al_l[crow(r, hi)]; } } while (0)
  f32x16 pA0, pA1, pB0, pB1; float mnA, mnB, alA, alB; bf16x8 pa0, pa1, pa2, pa3; const int NT = seq / KVBLK;
  constexpr int SE = 0, SO = SDEPTH - 1;
  SLOAD(SE, 0); asm volatile("s_waitcnt vmcnt(0)" ::: "memory"); SWRITE(0, SE); __syncthreads();
  qkt(pA0, pA1, K_lds, qr, r32, hi); partialSM(pA0, pA1, m_reg, mnA, alA);
  SLOAD(SO, KVBLK); if constexpr (SDEPTH == 2) { if (2 < NT) SLOAD(SE, 2 * KVBLK); }
  SWAIT(); SWRITE(1, SO); __syncthreads();
  for (int j = 1; j + 1 < NT; j += 2) {
    SBAR(); qkt(pB0, pB1, (bf16*)((char*)K_lds + SHM_K), qr, r32, hi);
    finishSM(pA0, pA1, alA, l_reg, pa0, pa1, pa2, pa3); SBAR();
    SLOAD(SO, (j + SDEPTH) * KVBLK); SBAR();
    pv_d0(o, vb0, pa0, pa1, pa2, pa3); partialSM(pB0, pB1, m_reg, mnB, alB);
    __syncthreads(); SWAIT(); SWRITE(0, SE);
    RESC(alB); __syncthreads();
    SBAR(); qkt(pA0, pA1, K_lds, qr, r32, hi);
    finishSM(pB0, pB1, alB, l_reg, pa0, pa1, pa2, pa3); SBAR();
    if (SDEPTH == 1 || j + 3 < NT) SLOAD(SE, (j + 1 + SDEPTH) * KVBLK); SBAR();
    pv_d0(o, vb0 + (int)SHM_V, pa0, pa1, pa2, pa3); partialSM(pA0, pA1, m_reg, mnA, alA);
    __syncthreads(); SWAIT(); SWRITE(1, SO);
    RESC(alA); __syncthreads();
  }
  SBAR(); qkt(pB0, pB1, (bf16*)((char*)K_lds + SHM_K), qr, r32, hi);
  finishSM(pA0, pA1, alA, l_reg, pa0, pa1, pa2, pa3); SBAR();
  pv_d0(o, vb0, pa0, pa1, pa2, pa3); partialSM(pB0, pB1, m_reg, mnB, alB);
  __syncthreads(); RESC(alB);
  finishSM(pB0, pB1, alB, l_reg, pa0, pa1, pa2, pa3); SBAR();
  pv_d0(o, vb0 + (int)SHM_V, pa0, pa1, pa2, pa3);
  if (hi == 0) li_l[r32] = l_reg; asm volatile("s_waitcnt lgkmcnt(0)" ::: "memory");
  float rli[16];
#pragma unroll
  for (int r = 0; r < 16; ++r) rli[r] = __builtin_amdgcn_rcpf(li_l[crow(r, hi)]);
  __syncthreads();
  { unsigned short* stg = (unsigned short*)(lds + wid * 8192);
#pragma unroll
    for (int r = 0; r < 16; ++r) { const int orow = crow(r, hi);
#pragma unroll
      for (int d0 = 0; d0 < 4; ++d0) { unsigned u = __builtin_bit_cast(unsigned, o[d0][r] * rli[r]); u = (u + 0x7fffu + ((u >> 16) & 1u)) >> 16; stg[orow * 128 + d0 * 32 + r32] = (unsigned short)u; } }
    asm volatile("s_waitcnt lgkmcnt(0)" ::: "memory");
    unsigned short* Ow = Ob + (long)(wid * QBLK) * LDO; const unsigned short* Zw = Zb + (long)(wid * QBLK) * LDZ;
#pragma unroll 2
    for (int i = 0; i < 8; ++i) { const int row = i * 4 + (lane >> 4), ch = lane & 15;
      const u32x4 ov = *(const u32x4*)(stg + row * 128 + ch * 8); const u32x4 zv = *(const u32x4*)(Zw + (long)row * LDZ + ch * 8); u32x4 w;
#pragma unroll
      for (int e = 0; e < 4; ++e) { const float z0 = __builtin_bit_cast(float, zv[e] << 16), z1 = __builtin_bit_cast(float, zv[e] & 0xffff0000u);
        const float a0 = __builtin_bit_cast(float, ov[e] << 16) * (z0 / (1.f + __expf(-z0))), a1 = __builtin_bit_cast(float, ov[e] & 0xffff0000u) * (z1 / (1.f + __expf(-z1)));
        w[e] = cvtpk(a0, a1); }
      *(u32x4*)(Ow + (long)row * LDO + ch * 8) = w; } }
#undef SLOAD
#undef SWRITE
#undef SWAIT
#undef RESC
}

}
constexpr int NWAVES = 8;
constexpr int RING_BYTES = 131072;
constexpr int LDS_BYTES = 147456;
#define LAS __attribute__((address_space(3)))
#define GAS __attribute__((address_space(1)))
typedef unsigned v4u __attribute__((ext_vector_type(4)));
typedef unsigned v2u __attribute__((ext_vector_type(2)));
typedef float f32x4 __attribute__((ext_vector_type(4)));
#define LDS_WAIT() asm volatile("s_waitcnt lgkmcnt(0)" ::: "memory")

struct Args { const float* in[9]; float* out; unsigned char* ws; int ph_lo, ph_hi; };

__device__ __forceinline__ float wave_sum(float v) {
#pragma unroll
    for (int o = 1; o < 64; o <<= 1) v += __shfl_xor(v, o);
    return v;
}

__device__ __forceinline__ void p0_transpose_item(const float* W, int K, int ldw, int nblk, bf16* WT, LAS float* scr, int item, int lane) {
    const int kb = item / nblk, nb = item % nblk, k0 = 64 * kb, n0 = 32 * nb;
#pragma unroll 8
    for (int i = 0; i < 32; ++i) { const int kk = 2 * i + (lane >> 5); scr[kk * 33 + (lane & 31)] = W[(size_t)(k0 + kk) * ldw + n0 + (lane & 31)]; }
    LDS_WAIT(); asm volatile("" ::: "memory");
    const int c = lane & 7;
#pragma unroll
    for (int j = 0; j < 4; ++j) { const int n = (lane >> 3) + 8 * j; const LAS float* s = scr + (8 * c) * 33 + n;
        v4u o; o.x = pk2(s[0 * 33], s[1 * 33]); o.y = pk2(s[2 * 33], s[3 * 33]); o.z = pk2(s[4 * 33], s[5 * 33]); o.w = pk2(s[6 * 33], s[7 * 33]);
        *(v4u*)(WT + (size_t)(n0 + n) * K + k0 + 8 * c) = o; }
    LDS_WAIT(); asm volatile("" ::: "memory");
}
__device__ __forceinline__ void rms_row_to_bf16(const float* xrow, const float* g, bf16* orow, int lane) {
    const f32x4* xr = (const f32x4*)xrow + lane; const f32x4* gr = (const f32x4*)g + lane;
    f32x4 v[8]; float s = 0.f;
#pragma unroll
    for (int j = 0; j < 8; ++j) { v[j] = xr[64 * j]; s += (v[j].x * v[j].x + v[j].y * v[j].y) + (v[j].z * v[j].z + v[j].w * v[j].w); }
    const float rstd = 1.f / sqrtf(wave_sum(s) * (1.f / DM) + EPS);
    v2u* o8 = (v2u*)orow + lane;
#pragma unroll
    for (int j = 0; j < 8; ++j) { const f32x4 gg = gr[64 * j]; v2u w; w.x = pk2(v[j].x * rstd * gg.x, v[j].y * rstd * gg.y); w.y = pk2(v[j].z * rstd * gg.z, v[j].w * rstd * gg.w); o8[64 * j] = w; }
}
__device__ __forceinline__ void p0_prologue(const Args& a, LAS unsigned char* lds, int vcu, int G, int tid, int wave, int lane) {
    unsigned char* ws = a.ws;
    const float* w_in = a.in[3]; const float* w_out = a.in[8]; const float* norm_g = a.in[2];
    bf16* W1t = (bf16*)(ws + WS_W1T); bf16* W2t = (bf16*)(ws + WS_W2T);
    const int gw = vcu * NWAVES + wave, NGW = G * NWAVES; const int gt = vcu * (NWAVES * 64) + tid, NGT = G * NWAVES * 64;
    for (int e = gt; e < 64 * 32; e += NGT) { const int pos = e >> 5, j = e & 31; const float inv = 1.0f / powf(10000.0f, (float)j * (1.0f / 32.0f)); const float ang = (float)pos * inv;
        float* R = (float*)(ws + WS_ROPE); R[2 * e] = cosf(ang); R[2 * e + 1] = sinf(ang); }
    for (int e = gt; e < 16 * DM; e += NGT) { const int g = e >> 11, k = e & (DM - 1); W1t[(size_t)(NP256 + g) * DM + k] = (bf16)f2bf(w_in[(size_t)k * NPROJ + NP256 + g]); }
    for (int e = gt; e < (N1PAD - NPROJ) * DM / 8; e += NGT) { *(v4u*)(W1t + (size_t)NPROJ * DM + (size_t)e * 8) = (v4u){0u, 0u, 0u, 0u}; }
    LAS float* scr = (LAS float*)(lds + wave * 16384);
    constexpr int I_1 = (DM / 64) * (NP256 / 32), I_2 = (DM / 64) * (DM / 32);
    for (int it = gw; it < I_1 + I_2; it += NGW) {
        if (it < I_1) p0_transpose_item(w_in, DM, NPROJ, NP256 / 32, W1t, scr, it, lane);
        else p0_transpose_item(w_out, DM, DM, DM / 32, W2t, scr, it - I_1, lane);
    }
    bf16* H = (bf16*)(ws + WS_H);
    for (int m = gw; m < NTOK; m += NGW) { const float* xrow = (m < TOK_PROMPT) ? a.in[0] + (size_t)m * DM : a.in[1] + (size_t)(m - TOK_PROMPT) * DM; rms_row_to_bf16(xrow, norm_g, H + (size_t)m * DM, lane); }
}

__device__ __forceinline__ void p2_qknorm_rope(const Args& a, int vcu, int G, int wave, int lane) {
    unsigned char* ws = a.ws; const float* R = (const float*)(ws + WS_ROPE);
    const int gw = vcu * NWAVES + wave, NGW = G * NWAVES;
    const int fj = lane & 31, c0 = (lane < 32) ? lane : 64 + (lane - 32), c1 = c0 + 32;
    const float gq0 = a.in[5][c0], gq1 = a.in[5][c1], gk0 = a.in[6][c0], gk1 = a.in[6][c1];
    for (int it = gw; it < NTOK * 10; it += NGW) {
        const int t = it / 10, slot = it - t * 10; const int tl = t & (SEQ - 1); const int pos = (lane < 32) ? (tl >> 6) : (tl & 63);
        bf16* p = (slot < 8) ? (bf16*)(ws + WS_MIX) + (size_t)t * 2048 + slot * 128 : (bf16*)(ws + WS_AK) + (size_t)t * 256 + (slot - 8) * 128;
        const float x0 = bf2f(p[c0]), x1 = bf2f(p[c1]);
        const float r = 1.f / sqrtf(wave_sum(x0 * x0 + x1 * x1) * (1.f / 128.f) + EPS);
        const float y0 = x0 * r * ((slot < 8) ? gq0 : gk0), y1 = x1 * r * ((slot < 8) ? gq1 : gk1);
        const float cs = R[2 * (pos * 32 + fj)], sn = R[2 * (pos * 32 + fj) + 1];
        p[c0] = (bf16)f2bf(y0 * cs - y1 * sn); p[c1] = (bf16)f2bf(y1 * cs + y0 * sn);
    }
}

__device__ __forceinline__ void p4_mlstm_recurrent(const Args& a, LAS unsigned char* lds, int vcu, int G, int tid) {
    unsigned char* ws = a.ws;
    const bf16* MQ = (const bf16*)(ws + WS_MQ); const bf16* MK = (const bf16*)(ws + WS_MK); const bf16* MV = (const bf16*)(ws + WS_MV); const float* GT = (const float*)(ws + WS_GATES);
    LAS float* qs = (LAS float*)lds;
    LAS float* ks = qs + 32 * 128;
    LAS float* vs = ks + 32 * 128;
    LAS float* gi = vs + 32 * 256;
    LAS float* gf = gi + 32;
    const int dv = tid >> 1, half = tid & 1;
    for (int item = vcu; item < NSEQ * 8; item += G) {
        const int b = item >> 3, hd = (item >> 1) & 3, dir = item & 1;
        bf16* HO = (bf16*)(ws + (dir ? WS_HB : WS_HF));
        float C[64], nn[64]; float m = 0.f;
#pragma unroll
        for (int j = 0; j < 64; ++j) { C[j] = 0.f; nn[j] = 0.f; }
        for (int p0 = 0; p0 < SEQ; p0 += 32) {
            __syncthreads();
            { const int rr = tid >> 4, c8 = (tid & 15) * 8; const int tok = dir ? (SEQ - 1 - (p0 + rr)) : (p0 + rr); const size_t row = (size_t)b * SEQ + tok;
              const v4u q4 = *(const v4u*)(MQ + row * 512 + hd * 128 + c8), k4 = *(const v4u*)(MK + row * 512 + hd * 128 + c8);
              LAS float* qd = qs + rr * 128 + c8; LAS float* kd = ks + rr * 128 + c8;
              qd[0] = bflo(q4.x); qd[1] = bfhi(q4.x); qd[2] = bflo(q4.y); qd[3] = bfhi(q4.y); qd[4] = bflo(q4.z); qd[5] = bfhi(q4.z); qd[6] = bflo(q4.w); qd[7] = bfhi(q4.w);
              kd[0] = bflo(k4.x); kd[1] = bfhi(k4.x); kd[2] = bflo(k4.y); kd[3] = bfhi(k4.y); kd[4] = bflo(k4.z); kd[5] = bfhi(k4.z); kd[6] = bflo(k4.w); kd[7] = bfhi(k4.w);
              const int c16 = (tid & 15) * 16; LAS float* vd = vs + rr * 256 + c16;
#pragma unroll
              for (int h2 = 0; h2 < 2; ++h2) { const v4u v4 = *(const v4u*)(MV + row * 1024 + hd * 256 + c16 + 8 * h2);
                  vd[8 * h2 + 0] = bflo(v4.x); vd[8 * h2 + 1] = bfhi(v4.x); vd[8 * h2 + 2] = bflo(v4.y); vd[8 * h2 + 3] = bfhi(v4.y); vd[8 * h2 + 4] = bflo(v4.z); vd[8 * h2 + 5] = bfhi(v4.z); vd[8 * h2 + 6] = bflo(v4.w); vd[8 * h2 + 7] = bfhi(v4.w); }
              if (tid < 32) { const int tk = dir ? (SEQ - 1 - (p0 + tid)) : (p0 + tid); const size_t rw = (size_t)b * SEQ + tk; gi[tid] = GT[rw * 16 + dir * 8 + hd]; gf[tid] = GT[rw * 16 + dir * 8 + 4 + hd]; }
            }
            __syncthreads();
            for (int pp = 0; pp < 32; ++pp) {
                const float lf = gf[pp], ii = gi[pp];
                const float mn = fmaxf(lf + m, ii);
                const float ca = expf(lf + m - mn), cb = expf(ii - mn);
                const float bv = cb * vs[pp * 256 + dv];
                float hp = 0.f, qn = 0.f;
                const LAS float* kr = ks + pp * 128 + 64 * half; const LAS float* qr = qs + pp * 128 + 64 * half;
#pragma unroll
                for (int j = 0; j < 64; ++j) { const float kk = kr[j], qq = qr[j];
                    C[j] = fmaf(ca, C[j], kk * bv); nn[j] = fmaf(ca, nn[j], cb * kk); hp = fmaf(qq, C[j], hp); qn = fmaf(qq, nn[j], qn); }
                hp += __shfl_xor(hp, 1); qn += __shfl_xor(qn, 1);
                const float den = fmaxf(fabsf(qn), expf(-mn));
                if (half == 0) { const int tok = dir ? (SEQ - 1 - (p0 + pp)) : (p0 + pp); HO[((size_t)b * SEQ + tok) * 1024 + hd * 256 + dv] = (bf16)f2bf(hp / den); }
                m = mn;
            }
        }
    }
}

__device__ __forceinline__ void p5_mlstm_finalize(const Args& a, int vcu, int G, int wave, int lane) {
    unsigned char* ws = a.ws; const float* mg = a.in[7];
    const bf16* HF = (const bf16*)(ws + WS_HF); const bf16* HB = (const bf16*)(ws + WS_HB); const bf16* MO = (const bf16*)(ws + WS_MO); const bf16* MZ = (const bf16*)(ws + WS_MZ);
    bf16* MIX = (bf16*)(ws + WS_MIX);
    const int gw = vcu * NWAVES + wave, NGW = G * NWAVES;
    for (int it = gw; it < NTOK * 4; it += NGW) {
        const int t = it >> 2, hd = it & 3; const size_t o = (size_t)t * 1024 + hd * 256 + 4 * lane;
        const v2u f2 = *(const v2u*)(HF + o), b2 = *(const v2u*)(HB + o), o2 = *(const v2u*)(MO + o), z2 = *(const v2u*)(MZ + o);
        const f32x4 gg = *(const f32x4*)(mg + hd * 256 + 4 * lane);
        float hm[4], zz[4];
        { const float hs0 = bflo(f2.x) + bflo(b2.x), hs1 = bfhi(f2.x) + bfhi(b2.x), hs2 = bflo(f2.y) + bflo(b2.y), hs3 = bfhi(f2.y) + bfhi(b2.y);
          const float m0 = bflo(o2.x), m1 = bfhi(o2.x), m2 = bflo(o2.y), m3 = bfhi(o2.y);
          hm[0] = hs0 / (1.f + expf(-m0)); hm[1] = hs1 / (1.f + expf(-m1)); hm[2] = hs2 / (1.f + expf(-m2)); hm[3] = hs3 / (1.f + expf(-m3));
          zz[0] = bflo(z2.x); zz[1] = bfhi(z2.x); zz[2] = bflo(z2.y); zz[3] = bfhi(z2.y); }
        const float ss = wave_sum((hm[0] * hm[0] + hm[1] * hm[1]) + (hm[2] * hm[2] + hm[3] * hm[3]));
        const float r = 1.f / sqrtf(ss * (1.f / 256.f) + EPS);
        float ov[4];
#pragma unroll
        for (int i = 0; i < 4; ++i) ov[i] = hm[i] * r * gg[i] * (zz[i] / (1.f + expf(-zz[i])));
        v2u w; w.x = pk2(ov[0], ov[1]); w.y = pk2(ov[2], ov[3]);
        *(v2u*)(MIX + (size_t)t * 2048 + 1024 + hd * 256 + 4 * lane) = w;
    }
}

constexpr int N_PHASES = 7;
__global__ void __launch_bounds__(NWAVES * 64, 2) hy_fwd(Args args) {
    extern __shared__ __attribute__((aligned(16))) unsigned char lds_raw[];
    LAS unsigned char* lds = (LAS unsigned char*)lds_raw;
    const int tid = threadIdx.x, lane = tid & 63, wave = __builtin_amdgcn_readfirstlane(tid >> 6);
    const int G = gridDim.x; const int bx = blockIdx.x; const int vcu = (G % 8 == 0) ? (bx % 8) * (G / 8) + bx / 8 : bx;
    unsigned char* ws = args.ws;
    const int lo = args.ph_lo, hi = args.ph_hi;
#ifndef HY_PHASE_MASK
#define HY_PHASE_MASK 0x7f
#endif
#define IN(k) (((HY_PHASE_MASK >> (k)) & 1) && lo <= (k) && (k) < hi)
#define BOTH(k) (IN(k) && IN((k) + 1))
#define GRID_BAR() do { cg::this_grid().sync(); } while (0)

    if (IN(0)) { p0_prologue(args, lds, vcu, G, tid, wave, lane); if (BOTH(0)) GRID_BAR(); }

    if (IN(1)) {
        pg8::Gemm g{(const pg8::bf16_t*)(ws + WS_H), (const pg8::bf16_t*)(ws + WS_W1T), NTOK, N1PAD, DM}; pg8::StaticOrder S; S.init(NTOK, N1PAD, G, bx);
        pg8::EpiProj E{ws, args.in[4]};
        pg8::gemm_phase<pg8::EpiProj, pg8::StaticOrder, true, true>(lds, g, S, E);
        if (BOTH(1)) GRID_BAR();
    }

    if (IN(2)) { p2_qknorm_rope(args, vcu, G, wave, lane); if (BOTH(2)) GRID_BAR(); }

    if (IN(3)) {
        for (int u = vcu; u < NSEQ * 2 * 32; u += G) {
            const int grp = u >> 5, w = u & 31; const int b = grp >> 1, kvh = grp & 1, h = kvh * 4 + (w >> 3), qb = w & 7;
            const size_t row0 = (size_t)b * SEQ + qb * 256;
            bf16* Q = (bf16*)(ws + WS_MIX) + row0 * 2048 + h * 128;
            const attn::bf16* K = (const attn::bf16*)(ws + WS_AK) + (size_t)b * SEQ * 256 + kvh * 128;
            const attn::bf16* V = (const attn::bf16*)(ws + WS_AV) + (size_t)b * SEQ * 256 + kvh * 128;
            const bf16* Z = (const bf16*)(ws + WS_AZ) + row0 * 1024 + h * 128;
            int seqv = SEQ; asm volatile("" : "+s"(seqv));
            attn::attn_dense_body<attn::bf16>((const attn::bf16*)Q, K, V, Q, Z, seqv, (char*)lds_raw);
            __syncthreads();
        }
        if (BOTH(3)) GRID_BAR();
    }

    if (IN(4)) { p4_mlstm_recurrent(args, lds, vcu, G, tid); if (BOTH(4)) GRID_BAR(); }

    if (IN(5)) { p5_mlstm_finalize(args, vcu, G, wave, lane); if (BOTH(5)) GRID_BAR(); }

    if (IN(6)) {
        pg8::Gemm g{(const pg8::bf16_t*)(ws + WS_MIX), (const pg8::bf16_t*)(ws + WS_W2T), NTOK, DM, DM}; pg8::StaticOrder S; S.init(NTOK, DM, G, bx);
        pg8::EpiOut E{args.in[0], args.in[1], args.out};
        pg8::gemm_phase<pg8::EpiOut, pg8::StaticOrder, true, true>(lds, g, S, E);
    }
#undef IN
#undef BOTH
}

extern "C" void kernel_launch(void* const* d_in, const int* in_sizes, int n_in, void* d_out, int out_size, void* d_ws, size_t ws_size, hipStream_t stream) {
    static int grid = 0;
    if (grid == 0) {
        if (n_in != 9 || in_sizes[0] != TOK_PROMPT * DM || in_sizes[1] != (NTOK - TOK_PROMPT) * DM || out_size != NTOK * DM || ws_size < WS_END) {
            fprintf(stderr, "kernel_launch: shape mismatch n_in %d in0 %d in1 %d out %d ws %zu (need %zu)\n", n_in, n_in > 0 ? in_sizes[0] : -1, n_in > 1 ? in_sizes[1] : -1, out_size, ws_size, (size_t)WS_END); grid = -1; return; }
        int dev = 0, cus = 0, per_cu = 0;
        if (hipGetDevice(&dev) != hipSuccess || hipDeviceGetAttribute(&cus, hipDeviceAttributeMultiprocessorCount, dev) != hipSuccess) { fprintf(stderr, "kernel_launch: device query failed\n"); grid = -1; return; }
        if (hipFuncSetAttribute((const void*)hy_fwd, hipFuncAttributeMaxDynamicSharedMemorySize, LDS_BYTES) != hipSuccess) { fprintf(stderr, "kernel_launch: hipFuncSetAttribute failed\n"); grid = -1; return; }
        if (hipOccupancyMaxActiveBlocksPerMultiprocessor(&per_cu, (const void*)hy_fwd, NWAVES * 64, LDS_BYTES) != hipSuccess || per_cu < 1) { fprintf(stderr, "kernel_launch: occupancy query says %d\n", per_cu); per_cu = 1; }
        (void)hipGetLastError();
        grid = cus;
    }
    if (grid < 0) return;
    Args a{};
    for (int i = 0; i < 9; ++i) a.in[i] = (const float*)d_in[i];
    a.out = (float*)d_out; a.ws = (unsigned char*)d_ws;
#if HY_N_LAUNCHES == 1
    a.ph_lo = 0; a.ph_hi = N_PHASES;
    void* kargs[] = {&a};
    hipError_t e = hipLaunchCooperativeKernel((const void*)hy_fwd, dim3(grid), dim3(NWAVES * 64), kargs, LDS_BYTES, stream);
    if (e != hipSuccess) fprintf(stderr, "kernel_launch: cooperative launch failed: %s (grid %d)\n", hipGetErrorString(e), grid);
#else
    for (int p = 0; p < N_PHASES; ++p) {
        a.ph_lo = p; a.ph_hi = p + 1;
        hipLaunchKernelGGL(hy_fwd, dim3(grid), dim3(NWAVES * 64), LDS_BYTES, stream, a);
        const hipError_t le = hipPeekAtLastError();
        if (le != hipSuccess) { fprintf(stderr, "kernel_launch: launch %d failed: %s\n", p, hipGetErrorName(le)); break; }
    }
#endif
}
```

```cpp
#include <hip/hip_runtime.h>
#include <hip/hip_bf16.h>
#include <hip/hip_cooperative_groups.h>
#include <cstdio>
#include <cstdint>
#include <cmath>
namespace cg = cooperative_groups;

#ifndef HY_SEPARATE_ROPE
#define HY_SEPARATE_ROPE 0
#endif
#ifndef HY_ATTN_NOMAX
#define HY_ATTN_NOMAX 1
#endif
#ifndef HY_SCHED_J
#define HY_SCHED_J 1
#endif
#ifndef HY_MLSTM_REF
#define HY_MLSTM_REF 0
#endif
#ifndef HY_N_LAUNCHES
#define HY_N_LAUNCHES 1
#endif

constexpr int SEQ = 2048, NSEQ = 24, NTOK = NSEQ * SEQ, TOK_PROMPT = 8 * SEQ, DM = 2048;
constexpr int NPROJ = 6672, NP256 = 6656;
constexpr float EPS = 1e-6f;

constexpr size_t MiB = 1u << 20;
constexpr size_t WS_CTL = 0, CTL_ZERO_BYTES = 1 * MiB;
constexpr int CW_BAR = 4096, CW_QUEUE = 8192;
constexpr size_t WS_ROPE = 1 * MiB;
constexpr size_t WS_W1T = 2 * MiB;
constexpr size_t WS_W2T = 30 * MiB;
constexpr size_t WS_GATES = 38 * MiB;
constexpr size_t WS_H = 42 * MiB;
constexpr size_t WS_HF = WS_H, WS_HB = WS_H + 96 * MiB;
constexpr size_t WS_MIX = 234 * MiB;
constexpr size_t WS_AK = 426 * MiB, WS_AV = 450 * MiB;
constexpr size_t WS_AZ = 474 * MiB;
constexpr size_t WS_MQ = 570 * MiB, WS_MK = 618 * MiB;
constexpr size_t WS_MV = 666 * MiB, WS_MO = 762 * MiB, WS_MZ = 858 * MiB;
constexpr size_t WS_END = 954 * MiB;

typedef unsigned short bf16;
__device__ __forceinline__ unsigned f2bf(float f) { unsigned u = __builtin_bit_cast(unsigned, f); return (u + 0x7fffu + ((u >> 16) & 1u)) >> 16; }
__device__ __forceinline__ unsigned pk2(float lo, float hi) { return f2bf(lo) | (f2bf(hi) << 16); }
__device__ __forceinline__ float bf2f(unsigned short b) { return __builtin_bit_cast(float, (unsigned)b << 16); }
__device__ __forceinline__ float bflo(unsigned w) { return __builtin_bit_cast(float, w << 16); }
__device__ __forceinline__ float bfhi(unsigned w) { return __builtin_bit_cast(float, w & 0xffff0000u); }
__device__ __forceinline__ float log_sigmoid_f(float x) { return x >= 0.f ? -log1pf(expf(-x)) : x - log1pf(expf(x)); }
namespace pg8 {
#define PG8_LAS __attribute__((address_space(3)))
typedef unsigned short bf16_t;
typedef short bf16x8 __attribute__((ext_vector_type(8)));
typedef float f32x4 __attribute__((ext_vector_type(4)));
typedef unsigned u32x4 __attribute__((ext_vector_type(4)));
constexpr int BM = 256, BK = 64, HALF = 128, HTB = HALF * BK * 2  , STAGE_BYTES = 8 * HTB, NXCD = 8, WGM = 8;

__host__ __device__ __forceinline__ int lds_byte(int r, int c) { const int st = (r >> 4) * 2 + (c >> 5), rr = r & 15, cc = c & 31, ob = rr * 64 + cc * 2; return st * 1024 + (ob ^ (((ob >> 9) & 1) << 5)); }
__host__ __device__ __forceinline__ void stage_rc(int b, int& R, int& C) { const int st = b / 1024, sb = b % 1024, swz = sb ^ (((sb >> 9) & 1) << 5); R = (st >> 1) * 16 + swz / 64; C = (st & 1) * 32 + (swz % 64) / 2; }
__host__ __device__ __forceinline__ int perm32(int rho) { const int n = rho >> 4, i = rho & 15; return 8 * (i >> 2) + 4 * n + (i & 3); }

struct Unit { int pm, pn; };
struct Gemm { const bf16_t* A; const bf16_t* Bt; int M, N, K; };

struct StaticOrder {
    int nM, nN, nwg, G, c;
    __host__ __device__ void init(int M, int N, int G_, int c_) { nM = M / BM; nN = N / BM; nwg = nM * nN; G = G_; c = c_; }
    __host__ __device__ bool next(int i, Unit& u) const {
        const long L = (long)i * G + c; if (L >= nwg) return false;
        int wgid = (int)L; { const int q = nwg / NXCD, r = nwg % NXCD, xcd = wgid % NXCD, off = wgid / NXCD; wgid = (xcd < r ? xcd * (q + 1) : r * (q + 1) + (xcd - r) * q) + off; }
        const int nig = WGM * nN, gid = wgid / nig, fm = gid * WGM, gsz = (nM - fm) < WGM ? (nM - fm) : WGM;
        u.pm = fm + ((wgid % nig) % gsz); u.pn = (wgid % nig) / gsz; return true;
    }
    __device__ __forceinline__ void a_ready(const Unit&) const {}
    __device__ __forceinline__ void done(const Unit&) const {}
};


__device__ __forceinline__ unsigned cvt_pk_bf16(float lo, float hi) { unsigned r; asm volatile("v_cvt_pk_bf16_f32 %0, %1, %2" : "=v"(r) : "v"(lo), "v"(hi)); return r; }

struct EpiProj {
    static constexpr bool PERM = true, AFTER_DRAIN = false; static constexpr int NSTORE = 16;
    unsigned char* ws; PG8_LAS float* xch; PG8_LAS float* ropeL; PG8_LAS float* qkgL;
    __device__ __forceinline__ void operator()(const f32x4 (&acc)[2][2][4][2], const Unit& u, int wr, int wc, int fr, int fq) const {
        const int pn = u.pn; const int row0 = u.pm * BM + wr * 64 + fr;
        if (!HY_SEPARATE_ROPE && pn <= 4) {
            PG8_LAS float* gsrc = qkgL + ((pn < 4) ? 0 : 128); const int cb = 64 * (wc >> 1) + 16 * (wc & 1) + 4 * fq;
            const f32x4 g1 = *(const PG8_LAS f32x4*)(gsrc + cb), g2 = *(const PG8_LAS f32x4*)(gsrc + cb + 32);
#pragma unroll
            for (int ai = 0; ai < 2; ++ai)
#pragma unroll
                for (int m = 0; m < 4; ++m)
#pragma unroll
                    for (int bj = 0; bj < 2; ++bj) { const f32x4 a = acc[ai][bj][m][0], b = acc[ai][bj][m][1];
                        float s = ((a[0] * a[0] + a[1] * a[1]) + (a[2] * a[2] + a[3] * a[3])) + ((b[0] * b[0] + b[1] * b[1]) + (b[2] * b[2] + b[3] * b[3]));
                        s += __shfl_xor(s, 16); s += __shfl_xor(s, 32);
                        if (fq == 0) xch[((ai * HALF + wr * 64 + m * 16 + fr) * 2 + bj) * 4 + wc] = s; }
            asm volatile("s_waitcnt lgkmcnt(0)" ::: "memory"); __builtin_amdgcn_s_barrier(); asm volatile("" ::: "memory");
            bf16_t* base = (bf16_t*)(ws + (pn < 4 ? WS_MIX : WS_AK)); const int ldc = (pn < 4) ? 2048 : 256; const int colt = (pn < 4) ? pn * 256 : 0;
            PG8_LAS float* R = ropeL; const int j0 = 16 * (wc & 1) + 4 * fq;
#pragma unroll
            for (int ai = 0; ai < 2; ++ai)
#pragma unroll
                for (int m = 0; m < 4; ++m) { const int row = row0 + ai * HALF + m * 16; const int tl = row & (SEQ - 1); const int pos = (wc < 2) ? (tl >> 6) : (tl & 63);
                    const f32x4 cs0 = *(const PG8_LAS f32x4*)(R + (pos * 32 + j0) * 2), cs1 = *(const PG8_LAS f32x4*)(R + (pos * 32 + j0) * 2 + 4);
#pragma unroll
                    for (int bj = 0; bj < 2; ++bj) { const f32x4 pt = *(const PG8_LAS f32x4*)(xch + ((ai * HALF + wr * 64 + m * 16 + fr) * 2 + bj) * 4);
                        const float rstd = 1.f / sqrtf(((pt[0] + pt[1]) + (pt[2] + pt[3])) * (1.f / 128.f) + EPS);
                        const f32x4 y1 = acc[ai][bj][m][0] * rstd * g1, y2 = acc[ai][bj][m][1] * rstd * g2;
                        const float o10 = y1[0] * cs0[0] - y2[0] * cs0[1], o11 = y1[1] * cs0[2] - y2[1] * cs0[3], o12 = y1[2] * cs1[0] - y2[2] * cs1[1], o13 = y1[3] * cs1[2] - y2[3] * cs1[3];
                        const float o20 = y2[0] * cs0[0] + y1[0] * cs0[1], o21 = y2[1] * cs0[2] + y1[1] * cs0[3], o22 = y2[2] * cs1[0] + y1[2] * cs1[1], o23 = y2[3] * cs1[2] + y1[3] * cs1[3];
                        bf16_t* dst = base + (size_t)row * ldc + colt + bj * HALF + cb;
                        typedef unsigned u32x2v __attribute__((ext_vector_type(2)));
                        u32x2v w1, w2; w1.x = cvt_pk_bf16(o10, o11); w1.y = cvt_pk_bf16(o12, o13); w2.x = cvt_pk_bf16(o20, o21); w2.y = cvt_pk_bf16(o22, o23);
                        *(u32x2v*)dst = w1; *(u32x2v*)(dst + 32) = w2; } }
            return;
        }
        size_t off; int ldc, colt;
        if (pn < 4)       { off = WS_MIX; ldc = 2048; colt = pn * 256; }
        else if (pn == 4) { off = WS_AK;  ldc = 256;  colt = 0; }
        else if (pn == 5) { off = WS_AV;  ldc = 256;  colt = 0; }
        else if (pn < 10) { off = WS_AZ;  ldc = 1024; colt = (pn - 6) * 256; }
        else if (pn < 12) { off = WS_MQ;  ldc = 512;  colt = (pn - 10) * 256; }
        else if (pn < 14) { off = WS_MK;  ldc = 512;  colt = (pn - 12) * 256; }
        else if (pn < 18) { off = WS_MV;  ldc = 1024; colt = (pn - 14) * 256; }
        else if (pn < 22) { off = WS_MO;  ldc = 1024; colt = (pn - 18) * 256; }
        else              { off = WS_MZ;  ldc = 1024; colt = (pn - 22) * 256; }
        bf16_t* base = (bf16_t*)(ws + off);
        const int col0 = colt + wc * 32 + 8 * fq;
#pragma unroll
        for (int ai = 0; ai < 2; ++ai)
#pragma unroll
            for (int m = 0; m < 4; ++m) { bf16_t* rowp = base + (size_t)(row0 + ai * HALF + m * 16) * ldc + col0;
#pragma unroll
                for (int bj = 0; bj < 2; ++bj) { const f32x4 v0 = acc[ai][bj][m][0], v1 = acc[ai][bj][m][1];
                    u32x4 w; w.x = cvt_pk_bf16(v0[0], v0[1]); w.y = cvt_pk_bf16(v0[2], v0[3]); w.z = cvt_pk_bf16(v1[0], v1[1]); w.w = cvt_pk_bf16(v1[2], v1[3]);
                    *(u32x4*)(rowp + bj * HALF) = w; } }
    }
};
struct EpiNull { static constexpr bool PERM = true, AFTER_DRAIN = false; static constexpr int NSTORE = 0;
    __device__ __forceinline__ void operator()(const f32x4 (&acc)[2][2][4][2], const Unit& u, int wr, int wc, int fr, int fq) const {
#pragma unroll
        for (int ai = 0; ai < 2; ++ai)
#pragma unroll
            for (int bj = 0; bj < 2; ++bj)
#pragma unroll
                for (int m = 0; m < 4; ++m) asm volatile("" :: "v"(acc[ai][bj][m][0]), "v"(acc[ai][bj][m][1])); } };
struct EpiOut {
    static constexpr bool PERM = false, AFTER_DRAIN = false; static constexpr int NSTORE = 32;
    const float* xp; const float* xs; float* out;
    __device__ __forceinline__ void operator()(const f32x4 (&acc)[2][2][4][2], const Unit& u, int wr, int wc, int fr, int fq) const {
        const int row0 = u.pm * BM + wr * 64 + fr; const int col0 = u.pn * BM + wc * 32 + 4 * fq;
        const bool pr = row0 < TOK_PROMPT; const float* xb = (pr ? xp : xs) + col0;
        const size_t xsub = pr ? 0 : (size_t)TOK_PROMPT * DM; float* ob = out + col0;
        f32x4 xr[4][4];
#define EPO_LOAD(g_) do { const size_t ro_ = (size_t)(row0 + ((g_) >> 2) * HALF + ((g_) & 3) * 16) * DM - xsub; \
            xr[(g_) & 3][0] = *(const f32x4*)(xb + ro_); xr[(g_) & 3][1] = *(const f32x4*)(xb + ro_ + 16); xr[(g_) & 3][2] = *(const f32x4*)(xb + ro_ + HALF); xr[(g_) & 3][3] = *(const f32x4*)(xb + ro_ + HALF + 16); } while (0)
        EPO_LOAD(0); EPO_LOAD(1); EPO_LOAD(2);
#pragma unroll
        for (int g = 0; g < 8; ++g) { if (g + 3 < 8) EPO_LOAD(g + 3);
            const int ai = g >> 2, m = g & 3; const size_t ro = (size_t)(row0 + ai * HALF + m * 16) * DM;
            *(f32x4*)(ob + ro) = xr[g & 3][0] + acc[ai][0][m][0]; *(f32x4*)(ob + ro + 16) = xr[g & 3][1] + acc[ai][0][m][1];
            *(f32x4*)(ob + ro + HALF) = xr[g & 3][2] + acc[ai][1][m][0]; *(f32x4*)(ob + ro + HALF + 16) = xr[g & 3][3] + acc[ai][1][m][1]; }
#undef EPO_LOAD
    }
};

template <class Epi, class Sched, bool ALIGN_EPI = false, bool SP2 = false>
__device__ __forceinline__ void gemm_phase(PG8_LAS unsigned char* lds, const Gemm g, const Sched& S, const Epi& E) {
    const int tid = threadIdx.x, wid = __builtin_amdgcn_readfirstlane(tid >> 6), lane = tid & 63, wr = wid >> 2, wc = wid & 3, fr = lane & 15, fq = lane >> 4;
    const int K = g.K, nt = K / BK;
    unsigned voffA[2], voffB[2];
#pragma unroll
    for (int i = 0; i < 2; ++i) { int R, C; stage_rc(tid * 16 + i * 8192, R, C); const int Rb = Epi::PERM ? ((R & ~31) + perm32(R & 31)) : R;
        voffA[i] = (unsigned)(R * K + C) * 2u; voffB[i] = (unsigned)(Rb * K + C) * 2u; }
    const size_t kstep = (size_t)(BK * 2);
    const size_t hstep = (size_t)HALF * K * 2;
    const size_t tstep = 2 * hstep;
    const unsigned ldsw = (unsigned)wid * 1024u;
    const int aoff = lds_byte(wr * 64 + fr, fq * 8), boff = lds_byte(wc * 32 + fr, fq * 8);
#define PG8_SA(b, h) (((b) * 2 + (h)) * HTB)
#define PG8_SB(b, h) ((4 + (b) * 2 + (h)) * HTB)
#define PG8_STAGE(bufoff, gbase, voff) do { _Pragma("unroll") for (int _i = 0; _i < 2; ++_i) \
        __builtin_amdgcn_global_load_lds((const unsigned*)((const char*)(gbase) + (voff)[_i]), (PG8_LAS unsigned*)(lds + (bufoff) + ldsw + _i * 8192), 16, 0, 0); } while (0)
#define PG8_LDA(dst, b, h) do { _Pragma("unroll") for (int m = 0; m < 4; ++m) _Pragma("unroll") for (int k = 0; k < 2; ++k) dst[m][k] = *(const PG8_LAS bf16x8*)(lds + PG8_SA(b, h) + aoff + m * 2048 + k * 1024); } while (0)
#define PG8_LDB(dst, b, h) do { _Pragma("unroll") for (int n = 0; n < 2; ++n) _Pragma("unroll") for (int k = 0; k < 2; ++k) dst[n][k] = *(const PG8_LAS bf16x8*)(lds + PG8_SB(b, h) + boff + n * 2048 + k * 1024); } while (0)
#define PG8_MMA(ai, bj, At, Bt) do { __builtin_amdgcn_s_setprio(1); _Pragma("unroll") for (int m = 0; m < 4; ++m) _Pragma("unroll") for (int n = 0; n < 2; ++n) _Pragma("unroll") for (int k = 0; k < 2; ++k) \
        acc[ai][bj][m][n] = __builtin_amdgcn_mfma_f32_16x16x32_bf16(Bt[n][k], At[m][k], acc[ai][bj][m][n], 0, 0, 0); __builtin_amdgcn_s_setprio(0); } while (0)
#define PG8_WAIT_V(n) asm volatile("s_waitcnt vmcnt(" #n ")" ::: "memory")
#define PG8_WAIT_L(n) asm volatile("s_waitcnt lgkmcnt(" #n ")" ::: "memory")
#define PG8_BAR __builtin_amdgcn_s_barrier()
#define PG8_SCHED __builtin_amdgcn_sched_barrier(0)
    Unit cur, nxt; int ui = 0;
    if (!S.next(0, cur)) return;
    f32x4 acc[2][2][4][2];
#pragma unroll
    for (int a = 0; a < 2; ++a)
#pragma unroll
        for (int b = 0; b < 2; ++b)
#pragma unroll
            for (int m = 0; m < 4; ++m)
#pragma unroll
                for (int n = 0; n < 2; ++n) acc[a][b][m][n] = (f32x4){0.f, 0.f, 0.f, 0.f};
    bf16x8 At[4][2], B0[2][2], B1[2][2];
    const char* cA = (const char*)g.A + (size_t)cur.pm * tstep; const char* cB = (const char*)g.Bt + (size_t)cur.pn * tstep;
    S.a_ready(cur);
    if constexpr (SP2) {
        PG8_STAGE(PG8_SB(0, 0), cB, voffB); PG8_STAGE(PG8_SB(0, 1), cB + hstep, voffB); PG8_STAGE(PG8_SA(0, 0), cA, voffA); PG8_STAGE(PG8_SA(0, 1), cA + hstep, voffA);
        if (wr == 1) PG8_BAR;
        PG8_WAIT_V(2); PG8_BAR;
        PG8_STAGE(PG8_SB(1, 0), cB + kstep, voffB); PG8_STAGE(PG8_SA(1, 0), cA + kstep, voffA); PG8_STAGE(PG8_SB(1, 1), cB + hstep + kstep, voffB);
        PG8_WAIT_V(6); PG8_BAR;
    } else {
        PG8_STAGE(PG8_SB(0, 0), cB, voffB); PG8_STAGE(PG8_SA(0, 0), cA, voffA); PG8_STAGE(PG8_SB(0, 1), cB + hstep, voffB); PG8_STAGE(PG8_SA(0, 1), cA + hstep, voffA);
        if (wr == 1) PG8_BAR;
        PG8_WAIT_V(4); PG8_BAR;
        PG8_STAGE(PG8_SB(1, 0), cB + kstep, voffB); PG8_STAGE(PG8_SA(1, 0), cA + kstep, voffA); PG8_STAGE(PG8_SB(1, 1), cB + hstep + kstep, voffB);
        PG8_WAIT_V(6); PG8_BAR;
    }
    for (;;) {
        const bool has_next = S.next(ui + 1, nxt);
        const char* nA = has_next ? (const char*)g.A + (size_t)nxt.pm * tstep : cA; const char* nB = has_next ? (const char*)g.Bt + (size_t)nxt.pn * tstep : cB;
        for (int t = 0; t < nt; t += 2) {
            const bool last = (t == nt - 2);
            const char* a1 = cA + (size_t)(t + 1) * kstep;
            const char* a2 = last ? nA : cA + (size_t)(t + 2) * kstep; const char* b2 = last ? nB : cB + (size_t)(t + 2) * kstep;
            const char* a3 = a2 + kstep; const char* b3 = b2 + kstep;
            if (last && has_next) S.a_ready(nxt);
            if constexpr (SP2) {
            const int relax_s = __builtin_amdgcn_readfirstlane((Epi::NSTORE > 0 && t == 0 && ui > 0) ? 1 : 0);
#define PG8_WAIT_FIRST() do { if constexpr (Epi::NSTORE >= 32) asm volatile("s_waitcnt vmcnt(40)\n\ts_cmp_lg_u32 %0, 0\n\ts_cbranch_scc1 1f\n\ts_waitcnt vmcnt(8)\n1:" :: "s"(relax_s) : "memory", "scc"); \
            else if constexpr (Epi::NSTORE >= 16) asm volatile("s_waitcnt vmcnt(24)\n\ts_cmp_lg_u32 %0, 0\n\ts_cbranch_scc1 1f\n\ts_waitcnt vmcnt(8)\n1:" :: "s"(relax_s) : "memory", "scc"); \
            else PG8_WAIT_V(8); } while (0)
            PG8_LDB(B0, 0, 0); PG8_LDB(B1, 0, 1); PG8_SCHED; PG8_LDA(At, 0, 0); PG8_STAGE(PG8_SA(1, 1), a1 + hstep, voffA);
            PG8_WAIT_FIRST(); PG8_WAIT_L(0); PG8_BAR; PG8_MMA(0, 0, At, B0); PG8_MMA(0, 1, At, B1); PG8_BAR; PG8_SCHED;
            PG8_LDA(At, 0, 1); PG8_STAGE(PG8_SB(0, 0), b2, voffB); PG8_STAGE(PG8_SB(0, 1), b2 + hstep, voffB); PG8_STAGE(PG8_SA(0, 0), a2, voffA);
            PG8_WAIT_FIRST(); PG8_WAIT_L(0); PG8_BAR; PG8_MMA(1, 0, At, B0); PG8_MMA(1, 1, At, B1); PG8_BAR; PG8_SCHED;
#undef PG8_WAIT_FIRST
            PG8_LDB(B0, 1, 0); PG8_LDB(B1, 1, 1); PG8_SCHED; PG8_LDA(At, 1, 0); PG8_STAGE(PG8_SA(0, 1), a2 + hstep, voffA);
            PG8_WAIT_V(8); PG8_WAIT_L(0); PG8_BAR; PG8_MMA(0, 0, At, B0); PG8_MMA(0, 1, At, B1); PG8_BAR; PG8_SCHED;
            PG8_LDA(At, 1, 1); PG8_STAGE(PG8_SB(1, 0), b3, voffB); PG8_STAGE(PG8_SB(1, 1), b3 + hstep, voffB); PG8_STAGE(PG8_SA(1, 0), a3, voffA);
            PG8_WAIT_V(8); PG8_WAIT_L(0); PG8_BAR; PG8_MMA(1, 0, At, B0); PG8_MMA(1, 1, At, B1); PG8_BAR; PG8_SCHED;
            } else {
            PG8_LDB(B0, 0, 0); PG8_SCHED; PG8_LDA(At, 0, 0); PG8_STAGE(PG8_SA(1, 1), a1 + hstep, voffA);
            PG8_WAIT_L(8); PG8_BAR; PG8_WAIT_L(0); PG8_MMA(0, 0, At, B0); PG8_BAR; PG8_SCHED;
            PG8_LDB(B1, 0, 1); PG8_STAGE(PG8_SB(0, 0), b2, voffB);
            PG8_BAR; PG8_WAIT_L(0); PG8_MMA(0, 1, At, B1); PG8_BAR;
            PG8_LDA(At, 0, 1); PG8_STAGE(PG8_SA(0, 0), a2, voffA);
            PG8_BAR; PG8_WAIT_L(0); PG8_MMA(1, 0, At, B0); PG8_BAR; PG8_SCHED;
            PG8_STAGE(PG8_SB(0, 1), b2 + hstep, voffB);
            PG8_WAIT_V(6); PG8_BAR; PG8_MMA(1, 1, At, B1); PG8_BAR;
            PG8_LDB(B0, 1, 0); PG8_SCHED; PG8_LDA(At, 1, 0); PG8_STAGE(PG8_SA(0, 1), a2 + hstep, voffA);
            PG8_WAIT_L(8); PG8_BAR; PG8_WAIT_L(0); PG8_MMA(0, 0, At, B0); PG8_BAR; PG8_SCHED;
            PG8_LDB(B1, 1, 1); PG8_STAGE(PG8_SB(1, 0), b3, voffB);
            PG8_BAR; PG8_WAIT_L(0); PG8_MMA(0, 1, At, B1); PG8_BAR;
            PG8_LDA(At, 1, 1); PG8_STAGE(PG8_SA(1, 0), a3, voffA);
            PG8_BAR; PG8_WAIT_L(0); PG8_MMA(1, 0, At, B0); PG8_BAR; PG8_SCHED;
            PG8_STAGE(PG8_SB(1, 1), b3 + hstep, voffB);
            PG8_WAIT_V(6); PG8_BAR; PG8_MMA(1, 1, At, B1); PG8_BAR;
            }
        }
        if constexpr (ALIGN_EPI) { if (wr == 0) PG8_BAR; }
        if constexpr (!Epi::AFTER_DRAIN) { E(acc, cur, wr, wc, fr, fq); S.done(cur); }
        if (!has_next) break;
#pragma unroll
        for (int a = 0; a < 2; ++a)
#pragma unroll
            for (int b = 0; b < 2; ++b)
#pragma unroll
                for (int m = 0; m < 4; ++m)
#pragma unroll
                    for (int n = 0; n < 2; ++n) acc[a][b][m][n] = (f32x4){0.f, 0.f, 0.f, 0.f};
        cur = nxt; cA = nA; cB = nB; ++ui;
        if constexpr (ALIGN_EPI) { if (wr == 1) PG8_BAR; }
    }
    PG8_WAIT_V(0);
    if constexpr (!ALIGN_EPI) { if (wr == 0) PG8_BAR; }
    PG8_BAR;
    if constexpr (Epi::AFTER_DRAIN) { E.fused(acc, cur, wr, wc, fr, fq, lds, wid, lane); S.done(cur); }
#undef PG8_SA
#undef PG8_SB
#undef PG8_STAGE
#undef PG8_LDA
#undef PG8_LDB
#undef PG8_MMA
#undef PG8_WAIT_V
#undef PG8_WAIT_L
#undef PG8_BAR
#undef PG8_SCHED
}
}
namespace attn {
using bf16 = __hip_bfloat16;
constexpr int   D = 128, NW = 8, QBLK = 32, KVBLK = 64;
constexpr float SCALE = 0.088388347648318440f;
constexpr float THR = 8.f;
constexpr int SDEPTH = 2;
constexpr int LDQ = 2048, LDK = 256, LDO = 2048, LDZ = 1024;
constexpr size_t SHM_V = KVBLK * D * 2, SHM_K = KVBLK * D * 2, SHM_ATTN = 2 * SHM_V + 2 * SHM_K + NW * 64 * 4;
using bf16x8 = __attribute__((ext_vector_type(8))) short;
using s16x4  = __attribute__((ext_vector_type(4))) short;
using f32x16 = __attribute__((ext_vector_type(16))) float;
using f32x8  = __attribute__((ext_vector_type(8))) float;
using u32x4  = __attribute__((ext_vector_type(4))) unsigned;
#define KSWZ(row, colB) ((row) * 256 + ((colB) ^ (((row) & 7) << 4)))
#define SBAR() __builtin_amdgcn_sched_barrier(0)
__device__ __forceinline__ int crow(int r, int hi) { return (r & 3) + 8 * (r >> 2) + 4 * hi; }
__device__ __forceinline__ unsigned cvtpk(float lo, float hi) {
  unsigned r; asm volatile("v_cvt_pk_bf16_f32 %0, %1, %2" : "=v"(r) : "v"(lo), "v"(hi)); return r;
}
template <typename TIn> struct Stage;
template <> struct Stage<bf16>  { using T = bf16x8;
  __device__ static __forceinline__ T ld8(const bf16* p) { return *reinterpret_cast<const bf16x8*>(p); }
  __device__ static __forceinline__ bf16x8 tobf(T x) { return x; } };
template <> struct Stage<float> { using T = f32x8;
  __device__ static __forceinline__ T ld8(const float* p) { return *reinterpret_cast<const f32x8*>(p); }
  __device__ static __forceinline__ bf16x8 tobf(T x) {
    u32x4 w = {cvtpk(x[0], x[1]), cvtpk(x[2], x[3]), cvtpk(x[4], x[5]), cvtpk(x[6], x[7])}; return *reinterpret_cast<bf16x8*>(&w); } };

__device__ __forceinline__ void partialSM(f32x16& p0, f32x16& p1, float& m_reg, float& mn, float& alpha) {
  constexpr float C = SCALE * 1.4426950408889634f;
#if HY_ATTN_NOMAX
  mn = m_reg; alpha = 1.f;
#else
  float pmax = p0[0]; for (int r = 1; r < 16; ++r) pmax = fmaxf(pmax, p0[r]); for (int r = 0; r < 16; ++r) pmax = fmaxf(pmax, p1[r]);
  { auto rr = __builtin_amdgcn_permlane32_swap(__float_as_uint(pmax), __float_as_uint(pmax), false, false);
    pmax = fmaxf(__uint_as_float(rr[0]), __uint_as_float(rr[1])); }
  if (__builtin_expect(__all(pmax - m_reg <= THR / SCALE), 1)) { mn = m_reg; alpha = 1.f; }
  else { mn = fmaxf(m_reg, pmax); alpha = __builtin_amdgcn_exp2f((m_reg - mn) * C); m_reg = mn; }
#endif
  float mnC = -mn * C;
  for (int r = 0; r < 16; ++r) p0[r] = fmaf(p0[r], C, mnC); for (int r = 0; r < 16; ++r) p1[r] = fmaf(p1[r], C, mnC);
  for (int r = 0; r < 16; ++r) p0[r] = __builtin_amdgcn_exp2f(p0[r]);
}
__device__ __forceinline__ void finishSM(f32x16& p0, f32x16& p1, float alpha, float& l_reg, bf16x8& pa0, bf16x8& pa1, bf16x8& pa2, bf16x8& pa3) {
  for (int r = 0; r < 16; ++r) p1[r] = __builtin_amdgcn_exp2f(p1[r]);
  float ps = 0; for (int r = 0; r < 16; ++r) ps += p0[r]; for (int r = 0; r < 16; ++r) ps += p1[r];
  { auto rr = __builtin_amdgcn_permlane32_swap(__float_as_uint(ps), __float_as_uint(ps), false, false);
    ps = __uint_as_float(rr[0]) + __uint_as_float(rr[1]); }
  l_reg = l_reg * alpha + ps;
#define PK4(P, BASE, OUT) do { unsigned a0 = cvtpk(P[BASE + 0], P[BASE + 1]), a1 = cvtpk(P[BASE + 2], P[BASE + 3]);   \
    unsigned b0 = cvtpk(P[BASE + 4], P[BASE + 5]), b1 = cvtpk(P[BASE + 6], P[BASE + 7]);                              \
    auto r0 = __builtin_amdgcn_permlane32_swap(a0, b0, false, false); auto r1 = __builtin_amdgcn_permlane32_swap(a1, b1, false, false); \
    u32x4 w = {r0[0], r1[0], r0[1], r1[1]}; OUT = *reinterpret_cast<bf16x8*>(&w); } while (0)
  PK4(p0, 0, pa0); PK4(p0, 8, pa1); PK4(p1, 0, pa2); PK4(p1, 8, pa3);
#undef PK4
}
__device__ __forceinline__ void qkt(f32x16& p0, f32x16& p1, const bf16* Ks, const bf16x8* qr, int r32, int hi) {
  p0 = f32x16{}; p1 = f32x16{};
  for (int d0 = 0; d0 < 8; ++d0) { int cb = (d0 * 16 + hi * 8) * 2;
    bf16x8 b0 = *reinterpret_cast<const bf16x8*>((const char*)Ks + KSWZ(r32, cb));
    bf16x8 b1 = *reinterpret_cast<const bf16x8*>((const char*)Ks + KSWZ(32 + r32, cb));
    p0 = __builtin_amdgcn_mfma_f32_32x32x16_bf16(b0, qr[d0], p0, 0, 0, 0);
    p1 = __builtin_amdgcn_mfma_f32_32x32x16_bf16(b1, qr[d0], p1, 0, 0, 0); }
}
__device__ __forceinline__ int v_st(int k, int c) { const int kk = (k & ~0xC) | ((k & 4) << 1) | ((k & 8) >> 1); return ((kk >> 3) * 4 + (c >> 5)) * 512 + ((kk & 7) * 32 + (c & 31)) * 2; }
__device__ __forceinline__ int v_rd_base(int lane) { return ((lane & 3) << 3) | (((lane >> 2) & 3) << 6) | (((lane >> 4) & 1) << 5) | (((lane >> 5) & 1) << 8); }
constexpr int v_rd_off(int d0, int ks, int half) { return d0 * 512 + ks * 4096 + half * 2048; }
template <int OFF> __device__ __forceinline__ s16x4 tr_read(int vb) {
  s16x4 r; asm volatile("ds_read_b64_tr_b16 %0, %1 offset:%2" : "=&v"(r) : "v"(vb), "i"(OFF) : "memory"); return r;
}
template <int D0> __device__ __forceinline__ void pv_one(f32x16& od, int vb, bf16x8 pa0, bf16x8 pa1, bf16x8 pa2, bf16x8 pa3) {
  const s16x4 l0 = tr_read<v_rd_off(D0, 0, 0)>(vb), h0 = tr_read<v_rd_off(D0, 0, 1)>(vb), l1 = tr_read<v_rd_off(D0, 1, 0)>(vb), h1 = tr_read<v_rd_off(D0, 1, 1)>(vb);
  const s16x4 l2 = tr_read<v_rd_off(D0, 2, 0)>(vb), h2 = tr_read<v_rd_off(D0, 2, 1)>(vb), l3 = tr_read<v_rd_off(D0, 3, 0)>(vb), h3 = tr_read<v_rd_off(D0, 3, 1)>(vb);
  asm volatile("s_waitcnt lgkmcnt(0)" ::: "memory"); SBAR();
#define PK(L, H) (bf16x8){L[0], L[1], L[2], L[3], H[0], H[1], H[2], H[3]}
  od = __builtin_amdgcn_mfma_f32_32x32x16_bf16(pa0, PK(l0, h0), od, 0, 0, 0);
  od = __builtin_amdgcn_mfma_f32_32x32x16_bf16(pa1, PK(l1, h1), od, 0, 0, 0);
  od = __builtin_amdgcn_mfma_f32_32x32x16_bf16(pa2, PK(l2, h2), od, 0, 0, 0);
  od = __builtin_amdgcn_mfma_f32_32x32x16_bf16(pa3, PK(l3, h3), od, 0, 0, 0);
#undef PK
}
__device__ __forceinline__ void pv_d0(f32x16* o, int vb, bf16x8 pa0, bf16x8 pa1, bf16x8 pa2, bf16x8 pa3) {
  pv_one<0>(o[0], vb, pa0, pa1, pa2, pa3); pv_one<1>(o[1], vb, pa0, pa1, pa2, pa3); pv_one<2>(o[2], vb, pa0, pa1, pa2, pa3); pv_one<3>(o[3], vb, pa0, pa1, pa2, pa3);
}

template <typename TQ>
__device__ __forceinline__ void attn_dense_body(const TQ* Qb, const bf16* __restrict__ Kh, const bf16* __restrict__ Vh,
                                                unsigned short* Ob, const unsigned short* __restrict__ Zb, int seq, char* lds, float m0raw) {
  using St = Stage<bf16>; using SQ = Stage<TQ>;
  int tid = threadIdx.x; asm volatile("" : "+v"(tid));
  const int wid = tid >> 6, lane = tid & 63, r32 = lane & 31, hi = lane >> 5;
  bf16* V_lds = (bf16*)lds; bf16* K_lds = (bf16*)(lds + 2 * SHM_V);
  float* ws = (float*)(lds + 2 * SHM_V + 2 * SHM_K) + wid * 64; float* li_l = ws; float* al_l = ws + 32;
  float m_reg = HY_ATTN_NOMAX ? m0raw : -1e30f, l_reg = 0; f32x16 o[4] = {}; bf16x8 qr[8];
  const TQ* Qw = Qb + (long)(wid * QBLK + r32) * LDQ + hi * 8;
#pragma unroll
  for (int d0 = 0; d0 < 8; ++d0) qr[d0] = SQ::tobf(SQ::ld8(Qw + d0 * 16));
  const int sr = tid >> 4, sc = (tid & 15) * 8, vst0 = v_st(sr, sc), vst1 = v_st(32 + sr, sc);
  const int vb0 = (int)(uintptr_t)V_lds + v_rd_base(lane);
  struct { typename St::T vs0, vs1, ks0, ks1; } sr_[SDEPTH];
#define SLOAD(i, k0) do { sr_[i].vs0 = St::ld8(&Vh[(long)((k0) + sr) * LDK + sc]); sr_[i].vs1 = St::ld8(&Vh[(long)((k0) + 32 + sr) * LDK + sc]); \
    sr_[i].ks0 = St::ld8(&Kh[(long)((k0) + sr) * LDK + sc]); sr_[i].ks1 = St::ld8(&Kh[(long)((k0) + 32 + sr) * LDK + sc]); } while (0)
#define SWRITE(b, i) do { *(bf16x8*)((char*)V_lds + (b) * SHM_V + vst0) = St::tobf(sr_[i].vs0);          \
    *(bf16x8*)((char*)V_lds + (b) * SHM_V + vst1) = St::tobf(sr_[i].vs1); int kc = sc * 2;               \
    *(bf16x8*)((char*)K_lds + (b) * SHM_K + KSWZ(sr, kc)) = St::tobf(sr_[i].ks0);                       \
    *(bf16x8*)((char*)K_lds + (b) * SHM_K + KSWZ(32 + sr, kc)) = St::tobf(sr_[i].ks1); } while (0)
#define SWAIT() do { if constexpr (SDEPTH == 2) asm volatile("s_waitcnt vmcnt(4)" ::: "memory"); else asm volatile("s_waitcnt vmcnt(0)" ::: "memory"); } while (0)
#if HY_ATTN_NOMAX
#define RESC(a) do { } while (0)
#else
#define RESC(a) do { if (__any((a) < 1.f)) { if (hi == 0) al_l[r32] = (a); asm volatile("s_waitcnt lgkmcnt(0)" ::: "memory"); \
    for (int d = 0; d < 4; ++d) for (int r = 0; r < 16; ++r) o[d][r] *= al_l[crow(r, hi)]; } } while (0)
#endif
  f32x16 pA0, pA1, pB0, pB1; float mnA, mnB, alA, alB; bf16x8 pa0, pa1, pa2, pa3; const int NT = seq / KVBLK;
  constexpr int SE = 0, SO = SDEPTH - 1;
  SLOAD(SE, 0); asm volatile("s_waitcnt vmcnt(0)" ::: "memory"); SWRITE(0, SE); __syncthreads();
  qkt(pA0, pA1, K_lds, qr, r32, hi); partialSM(pA0, pA1, m_reg, mnA, alA);
  SLOAD(SO, KVBLK); if constexpr (SDEPTH == 2) { if (2 < NT) SLOAD(SE, 2 * KVBLK); }
  SWAIT(); SWRITE(1, SO); __syncthreads();
  for (int j = 1; j + 1 < NT; j += 2) {
    SBAR(); qkt(pB0, pB1, (bf16*)((char*)K_lds + SHM_K), qr, r32, hi);
    finishSM(pA0, pA1, alA, l_reg, pa0, pa1, pa2, pa3); SBAR();
    SLOAD(SO, (j + SDEPTH) * KVBLK); SBAR();
    pv_d0(o, vb0, pa0, pa1, pa2, pa3); partialSM(pB0, pB1, m_reg, mnB, alB);
    __syncthreads(); SWAIT(); SWRITE(0, SE);
    RESC(alB); __syncthreads();
    SBAR(); qkt(pA0, pA1, K_lds, qr, r32, hi);
    finishSM(pB0, pB1, alB, l_reg, pa0, pa1, pa2, pa3); SBAR();
    if (SDEPTH == 1 || j + 3 < NT) SLOAD(SE, (j + 1 + SDEPTH) * KVBLK); SBAR();
    pv_d0(o, vb0 + (int)SHM_V, pa0, pa1, pa2, pa3); partialSM(pA0, pA1, m_reg, mnA, alA);
    __syncthreads(); SWAIT(); SWRITE(1, SO);
    RESC(alA); __syncthreads();
  }
  SBAR(); qkt(pB0, pB1, (bf16*)((char*)K_lds + SHM_K), qr, r32, hi);
  finishSM(pA0, pA1, alA, l_reg, pa0, pa1, pa2, pa3); SBAR();
  pv_d0(o, vb0, pa0, pa1, pa2, pa3); partialSM(pB0, pB1, m_reg, mnB, alB);
  __syncthreads(); RESC(alB);
  finishSM(pB0, pB1, alB, l_reg, pa0, pa1, pa2, pa3); SBAR();
  pv_d0(o, vb0 + (int)SHM_V, pa0, pa1, pa2, pa3);
  if (hi == 0) li_l[r32] = l_reg; asm volatile("s_waitcnt lgkmcnt(0)" ::: "memory");
  float rli[16];
#pragma unroll
  for (int r = 0; r < 16; ++r) rli[r] = __builtin_amdgcn_rcpf(li_l[crow(r, hi)]);
  __syncthreads();
  { unsigned short* stg = (unsigned short*)(lds + wid * 8192);
#pragma unroll
    for (int r = 0; r < 16; ++r) { const int orow = crow(r, hi);
#pragma unroll
      for (int d0 = 0; d0 < 4; ++d0) { unsigned u = __builtin_bit_cast(unsigned, o[d0][r] * rli[r]); u = (u + 0x7fffu + ((u >> 16) & 1u)) >> 16; stg[orow * 128 + d0 * 32 + r32] = (unsigned short)u; } }
    asm volatile("s_waitcnt lgkmcnt(0)" ::: "memory");
    unsigned short* Ow = Ob + (long)(wid * QBLK) * LDO; const unsigned short* Zw = Zb + (long)(wid * QBLK) * LDZ;
#pragma unroll 2
    for (int i = 0; i < 8; ++i) { const int row = i * 4 + (lane >> 4), ch = lane & 15;
      const u32x4 ov = *(const u32x4*)(stg + row * 128 + ch * 8); const u32x4 zv = *(const u32x4*)(Zw + (long)row * LDZ + ch * 8); u32x4 w;
#pragma unroll
      for (int e = 0; e < 4; ++e) { const float z0 = __builtin_bit_cast(float, zv[e] << 16), z1 = __builtin_bit_cast(float, zv[e] & 0xffff0000u);
        const float a0 = __builtin_bit_cast(float, ov[e] << 16) * (z0 * __builtin_amdgcn_rcpf(1.f + __expf(-z0))), a1 = __builtin_bit_cast(float, ov[e] & 0xffff0000u) * (z1 * __builtin_amdgcn_rcpf(1.f + __expf(-z1)));
        w[e] = cvtpk(a0, a1); }
      *(u32x4*)(Ow + (long)row * LDO + ch * 8) = w; } }
#undef SLOAD
#undef SWRITE
#undef SWAIT
#undef RESC
}

}
namespace ml {
typedef short bf16x8 __attribute__((ext_vector_type(8)));
typedef short v4i16 __attribute__((ext_vector_type(4)));
typedef float f32x4 __attribute__((ext_vector_type(4)));
typedef float f32x16 __attribute__((ext_vector_type(16)));
typedef unsigned u32x4 __attribute__((ext_vector_type(4)));
typedef unsigned u32x2 __attribute__((ext_vector_type(2)));
#define ML_LAS __attribute__((address_space(3)))
constexpr int BUFB = 65536, Q_OFF = 0, K_OFF = 16384, V_OFF = 32768;
constexpr int P_OFF = 131072, DENP_OFF = P_OFF + 8192, QNP_OFF = DENP_OFF + 512, VEC_OFF = QNP_OFF + 2048, VEC_SLOT = 2 * 256, VR_OFF = VEC_OFF + 2 * VEC_SLOT, NB_OFF = VR_OFF + 8 * 256, LDS_END = NB_OFF + 512;
__device__ __forceinline__ unsigned fxor(unsigned row) { return ((row & 3u) << 2) | ((row >> 2) & 3u); }
__device__ __forceinline__ unsigned off_b(unsigned row, unsigned ch) { return 256u * row + 16u * (ch ^ fxor(row)); }
__device__ __forceinline__ unsigned off_p(unsigned t, unsigned ch) { return 128u * t + 16u * (ch ^ (t & 7u)); }
__device__ __forceinline__ unsigned tr_addr(unsigned lane, unsigned c, unsigned ks, unsigned t) { const unsigned h = lane >> 5, blk = (lane >> 4) & 1u, q = (lane & 15u) >> 2, p = lane & 3u; return off_b(16u * ks + 8u * h + 4u * t + q, 4u * c + 2u * blk + (p >> 1)) + 8u * (p & 1u); }
__device__ __forceinline__ unsigned tr_addr16(unsigned lane, unsigned c, unsigned ks, unsigned t) { const unsigned g = lane >> 4, q = (lane & 15u) >> 2, p = lane & 3u; return off_b(32u * ks + 8u * g + 4u * t + q, 2u * c + (p >> 1)) + 8u * (p & 1u); }
__device__ __forceinline__ v4i16 trrd(ML_LAS unsigned char* p) { return __builtin_amdgcn_ds_read_tr16_b64_v4i16((ML_LAS v4i16*)p); }
template <int OFF> __device__ __forceinline__ v4i16 trra(unsigned addr) { v4i16 r; asm volatile("ds_read_b64_tr_b16 %0, %1 offset:%2" : "=v"(r) : "v"(addr), "i"(OFF) : "memory"); return r; }
__device__ __forceinline__ void glds16(const void* gsrc, unsigned lds_dst) { unsigned keep;
    asm volatile("s_mov_b32 %0, m0\n\ts_mov_b32 m0, %2\n\ts_nop 0\n\tglobal_load_lds_dwordx4 %1, off\n\ts_mov_b32 m0, %0" : "=&s"(keep) : "v"(gsrc), "s"(lds_dst) : "memory"); }
#define ML_TRWAIT() do { asm volatile("s_waitcnt lgkmcnt(0)" ::: "memory"); __builtin_amdgcn_sched_barrier(0); } while (0)
__device__ __forceinline__ bf16x8 cat8(v4i16 lo, v4i16 hi) { return (bf16x8){lo[0], lo[1], lo[2], lo[3], hi[0], hi[1], hi[2], hi[3]}; }
__device__ __forceinline__ unsigned pkbf(float lo, float hi) { unsigned r; asm volatile("v_cvt_pk_bf16_f32 %0, %1, %2" : "=v"(r) : "v"(lo), "v"(hi)); return r; }
__device__ __forceinline__ float s2f(short x) { return __builtin_bit_cast(float, (unsigned)(unsigned short)x << 16); }
__device__ __forceinline__ bf16x8 pack8(float a0, float a1, float a2, float a3, float a4, float a5, float a6, float a7) { u32x4 w = {pkbf(a0, a1), pkbf(a2, a3), pkbf(a4, a5), pkbf(a6, a7)}; return __builtin_bit_cast(bf16x8, w); }
__device__ __forceinline__ float scan_add(float v, int lane) {
#pragma unroll
    for (int o = 1; o < 64; o <<= 1) { const float u = __shfl_up(v, o); if (lane >= o) v += u; }
    return v; }
__device__ __forceinline__ float scan_max(float v, int lane) {
#pragma unroll
    for (int o = 1; o < 64; o <<= 1) { const float u = __shfl_up(v, o); if (lane >= o) v = fmaxf(v, u); }
    return v; }
#define ML_OPAQUE_LANE(ln) unsigned ln = (unsigned)lane; asm volatile("" : "+v"(ln))
__device__ __forceinline__ float rdlane(float v, int l) { return __builtin_bit_cast(float, __builtin_amdgcn_readlane(__builtin_bit_cast(int, v), l)); }

__device__ __forceinline__ void stage(ML_LAS unsigned char* lds, int bsel, int c, int b, int hd, int dir, const unsigned short* MQ, const unsigned short* MK, const unsigned short* MV, int wid, int lane) {
    const int rl = lane >> 4, pos = lane & 15;
#pragma unroll
    for (int half = 0; half < 2; ++half) {
        const int grp = wid + 8 * half, row = 4 * grp + rl, ch = pos ^ ((rl << 2) | (grp & 3));
        const int p = 64 * c + row, tok = dir ? (SEQ - 1 - p) : p; const size_t trow = (size_t)b * SEQ + tok;
        ML_LAS unsigned char* d = lds + bsel * BUFB + grp * 1024;
        __builtin_amdgcn_global_load_lds((const unsigned*)(MQ + trow * 512 + hd * 128 + 8 * ch), (ML_LAS unsigned*)(d + Q_OFF), 16, 0, 0);
        __builtin_amdgcn_global_load_lds((const unsigned*)(MK + trow * 512 + hd * 128 + 8 * ch), (ML_LAS unsigned*)(d + K_OFF), 16, 0, 0);
        __builtin_amdgcn_global_load_lds((const unsigned*)(MV + trow * 1024 + hd * 256 + 8 * ch), (ML_LAS unsigned*)(d + V_OFF), 16, 0, 0);
        __builtin_amdgcn_global_load_lds((const unsigned*)(MV + trow * 1024 + hd * 256 + 128 + 8 * ch), (ML_LAS unsigned*)(d + V_OFF + 16384), 16, 0, 0);
    }
}

#define ML_DPPF(old_, src_, ctrl_, rm_) __builtin_bit_cast(float, __builtin_amdgcn_update_dpp(__builtin_bit_cast(int, (float)(old_)), __builtin_bit_cast(int, (float)(src_)), ctrl_, rm_, 0xf, false))
__device__ __forceinline__ float dscan_add(float v) {
    v += ML_DPPF(0.f, v, 0x111, 0xf); v += ML_DPPF(0.f, v, 0x112, 0xf); v += ML_DPPF(0.f, v, 0x114, 0xf); v += ML_DPPF(0.f, v, 0x118, 0xf);
    v += ML_DPPF(0.f, v, 0x142, 0xa); v += ML_DPPF(0.f, v, 0x143, 0xc); return v; }
__device__ __forceinline__ float dscan_max(float v) { const float NI = -3.0e38f;
    v = fmaxf(v, ML_DPPF(NI, v, 0x111, 0xf)); v = fmaxf(v, ML_DPPF(NI, v, 0x112, 0xf)); v = fmaxf(v, ML_DPPF(NI, v, 0x114, 0xf)); v = fmaxf(v, ML_DPPF(NI, v, 0x118, 0xf));
    v = fmaxf(v, ML_DPPF(NI, v, 0x142, 0xa)); v = fmaxf(v, ML_DPPF(NI, v, 0x143, 0xc)); return v; }

template <int MODE> __device__ __forceinline__ void mlstm_item(unsigned char* ws, ML_LAS unsigned char* lds, int item, int tid) {
    const int lane = tid & 63, wid = __builtin_amdgcn_readfirstlane(tid >> 6);
    const int b = item >> 3, hd = (item >> 1) & 3, dir = item & 1;
    const float* GT = (const float*)(ws + WS_GATES) + dir * 8 + hd;
    ML_LAS float* DENP = (ML_LAS float*)(lds + DENP_OFF); ML_LAS float* QNP = (ML_LAS float*)(lds + QNP_OFF); ML_LAS float* NB = (ML_LAS float*)(lds + NB_OFF + wid * 64);
    unsigned dq0, dq1, dv0, dv1;
    { const int rl = lane >> 4, pos = lane & 15;
      const int g0 = wid, g1 = wid + 8; const int r0 = 4 * g0 + rl, r1 = 4 * g1 + rl; const int c0 = pos ^ ((rl << 2) | (g0 & 3)), c1 = pos ^ ((rl << 2) | (g1 & 3));
      const int m0 = dir ? 63 - r0 : r0, m1 = dir ? 63 - r1 : r1;
      dq0 = (unsigned)(m0 * 1024 + 16 * c0); dq1 = (unsigned)(m1 * 1024 + 16 * c1); dv0 = (unsigned)(m0 * 2048 + 16 * c0); dv1 = (unsigned)(m1 * 2048 + 16 * c1); }
    const unsigned goff = (unsigned)((dir ? 63 - lane : lane) * 64);
    unsigned trL0, trL1, trX;
    { const unsigned h = lane >> 5, blk = (lane >> 4) & 1u, q = (lane & 15u) >> 2, p = lane & 3u; const unsigned A = 256u * (8u * h + q) + 8u * (p & 1u), lo = 2u * blk + (p >> 1);
      trL0 = A + 16u * (lo ^ ((2u * h) & 3u)); trL1 = A + 16u * (lo ^ ((2u * h + 1u) & 3u)) + 1024u; trX = 64u * q; }
    f32x16 C[4]; f32x4 n4 = {0.f, 0.f, 0.f, 0.f};
#pragma unroll
    for (int i = 0; i < 4; ++i) C[i] = (f32x16){0.f};
    const char* gq = (const char*)(ws + WS_MQ) + ((size_t)b * SEQ * 512 + hd * 128) * 2; const char* gk = (const char*)(ws + WS_MK) + ((size_t)b * SEQ * 512 + hd * 128) * 2;
    const char* gv = (const char*)(ws + WS_MV) + ((size_t)b * SEQ * 1024 + hd * 256) * 2; const char* gg = (const char*)GT + (size_t)b * SEQ * 64;
    unsigned char* ho = ws + (dir ? WS_HB : WS_HF) + ((size_t)(b * 4 + hd) * 32) * 32768 + wid * 4096 + lane * 16;
    const unsigned lds0 = (unsigned)(uintptr_t)lds;
#define ML_TB(c_) (MODE == 1 ? (dir ? (SEQ - 64) : 0) : (dir ? (SEQ - 64 * ((c_) + 1)) : 64 * (c_)))
#define ML_STAGE(bsel_, c_) do { const int tb_ = ML_TB(c_); const unsigned d_ = (unsigned)__builtin_amdgcn_readfirstlane((int)(lds0 + (bsel_) * BUFB + wid * 1024)); \
        const char* q_ = gq + (size_t)tb_ * 1024; const char* k_ = gk + (size_t)tb_ * 1024; const char* v_ = gv + (size_t)tb_ * 2048; \
        glds16(q_ + dq0, d_ + Q_OFF); glds16(q_ + dq1, d_ + Q_OFF + 8192); glds16(k_ + dq0, d_ + K_OFF); glds16(k_ + dq1, d_ + K_OFF + 8192); \
        glds16(v_ + dv0, d_ + V_OFF); glds16(v_ + dv1, d_ + V_OFF + 8192); glds16(v_ + 256 + dv0, d_ + V_OFF + 16384); glds16(v_ + 256 + dv1, d_ + V_OFF + 16384 + 8192); } while (0)
#define ML_GATES(c_, gi_, gf_) do { const char* g_ = gg + (size_t)ML_TB(c_) * 64 + goff; gi_ = *(const float*)g_; gf_ = *(const float*)(g_ + 16); } while (0)
#define ML_VEC(cc_, gi_, gf_, sc_out_) do { ML_LAS float* T_ = (ML_LAS float*)(lds + VEC_OFF + ((cc_) & 1) * VEC_SLOT); \
        const float bcs_ = dscan_add(gf_), cx_ = (gi_) - bcs_, cm_ = dscan_max(cx_), M_ = fmaxf(m, cm_); const float g_ = rdlane(bcs_, 63), M63_ = rdlane(M_, 63); \
        T_[lane] = __expf(cx_ - M63_); T_[64 + lane] = __expf(-(bcs_ + M63_)); \
        sc_out_ = __expf(m - M63_); m = g_ + M63_; } while (0)
    float m = 0.f, sc, sc_n = 1.f, gi_a, gf_a, gi_b = 0.f, gf_b = 0.f; u32x4 pend[4] = {{0u, 0u, 0u, 0u}, {0u, 0u, 0u, 0u}, {0u, 0u, 0u, 0u}, {0u, 0u, 0u, 0u}};
    ML_STAGE(0, 0); ML_GATES(0, gi_a, gf_a); ML_VEC(0, gi_a, gf_a, sc); ML_GATES(1, gi_a, gf_a);
    for (int c = 0; c < SEQ / 64; ++c) {
        const int bsel = c & 1;
        ML_LAS unsigned char* bQ = lds + bsel * BUFB + Q_OFF; ML_LAS unsigned char* bK = lds + bsel * BUFB + K_OFF; ML_LAS unsigned char* bV = lds + bsel * BUFB + V_OFF;
        ML_LAS float* VWE = (ML_LAS float*)(lds + VEC_OFF + bsel * VEC_SLOT); ML_LAS float* VEMT = VWE + 64; ML_LAS float* VR = (ML_LAS float*)(lds + VR_OFF + wid * 256);
        asm volatile("s_waitcnt vmcnt(0) lgkmcnt(0)" ::: "memory"); __builtin_amdgcn_s_barrier(); asm volatile("" ::: "memory");
        if (c > 0) { unsigned char* hc = ho + (size_t)(c - 1) * 32768; *(u32x4*)(hc) = pend[0]; *(u32x4*)(hc + 1024) = pend[1]; *(u32x4*)(hc + 2048) = pend[2]; *(u32x4*)(hc + 3072) = pend[3]; }
        if (c + 1 < SEQ / 64) { ML_STAGE(bsel ^ 1, c + 1);
            if (c + 2 < SEQ / 64) ML_GATES(c + 2, gi_b, gf_b);
            ML_VEC(c + 1, gi_a, gf_a, sc_n); }
        if (MODE == 2) { asm volatile("s_waitcnt lgkmcnt(0)" ::: "memory"); __builtin_amdgcn_s_barrier(); continue; }
        { ML_OPAQUE_LANE(ln); const unsigned r15 = ln & 15u, kg = ln >> 4; const int tj = wid >> 1, sb = (wid & 1) * 2; const unsigned t = 16u * tj + r15;
          const unsigned xq = fxor(r15) << 4;
          ML_LAS unsigned char* qrow = bQ + 256u * t;
          bf16x8 qf[4];
#pragma unroll
          for (int ks = 0; ks < 4; ++ks) qf[ks] = *(const ML_LAS bf16x8*)(qrow + (((4u * ks + kg) << 4) ^ xq));
          float dsum = 0.f; const unsigned hb = 8u * (kg & 1u), kh = kg >> 1;
#pragma unroll
          for (int u = 0; u < 2; ++u) { const unsigned si = sb + u; ML_LAS unsigned char* krow = bK + 256u * (16u * si + r15) + hb;
              f32x4 acc = {0.f, 0.f, 0.f, 0.f};
#pragma unroll
              for (int ks = 0; ks < 4; ++ks) { const unsigned g2 = 4u * ks + 2u * kh;
                  const u32x2 lo = *(const ML_LAS u32x2*)(krow + ((g2 << 4) ^ xq)), hi = *(const ML_LAS u32x2*)(krow + (((g2 + 1u) << 4) ^ xq));
                  const u32x4 kw = {lo.x, lo.y, hi.x, hi.y};
                  acc = __builtin_amdgcn_mfma_f32_16x16x32_bf16(__builtin_bit_cast(bf16x8, kw), qf[ks], acc, 0, 0, 0); }
              const unsigned s0 = 16u * si + 4u * kg; const f32x4 ws4 = *(const ML_LAS f32x4*)(VWE + s0);
              float p[4];
#pragma unroll
              for (int r = 0; r < 4; ++r) { p[r] = (s0 + r <= t) ? acc[r] : 0.f; dsum = fmaf(p[r], ws4[r], dsum); }
              const u32x2 pw = {pkbf(p[0], p[1]), pkbf(p[2], p[3])};
              *(ML_LAS u32x2*)(lds + P_OFF + 128u * t + (((2u * si + kh) ^ (t & 7u)) << 4) + hb) = pw; }
          dsum += __shfl_xor(dsum, 16); dsum += __shfl_xor(dsum, 32);
          if (ln < 16u) DENP[(wid & 1) * 64 + t] = dsum; }
        n4 = n4 * sc;
        { ML_OPAQUE_LANE(ln); const unsigned r15 = ln & 15u, kg = ln >> 4; if (r15 == 0) *(ML_LAS f32x4*)(NB + 4 * kg) = n4;
          const f32x4 nA = *(const ML_LAS f32x4*)(NB + 0), nB = *(const ML_LAS f32x4*)(NB + 4), nC = *(const ML_LAS f32x4*)(NB + 8), nD = *(const ML_LAS f32x4*)(NB + 12);
          const unsigned t = ln; ML_LAS unsigned char* qrow = bQ + 256u * t; const unsigned xq = fxor(t) << 4;
          const bf16x8 c0 = *(const ML_LAS bf16x8*)(qrow + (((2u * wid) << 4) ^ xq)), c1 = *(const ML_LAS bf16x8*)(qrow + (((2u * wid + 1u) << 4) ^ xq));
          float qn = 0.f;
#pragma unroll
          for (int e = 0; e < 4; ++e) { qn = fmaf(s2f(c0[e]), nA[e], qn); qn = fmaf(s2f(c0[4 + e]), nC[e], qn); qn = fmaf(s2f(c1[e]), nB[e], qn); qn = fmaf(s2f(c1[4 + e]), nD[e], qn); }
          QNP[wid * 64 + t] = qn; }
        f32x16 Y0, Y1;
        { ML_OPAQUE_LANE(ln); const unsigned r31 = ln & 31u, h5 = ln >> 5; const unsigned xq = fxor(r31) << 4; ML_LAS unsigned char* q0 = bQ + 256u * r31; ML_LAS unsigned char* q1 = q0 + 256u * 32u;
#pragma unroll
          for (int i = 0; i < 4; ++i) { C[i] = C[i] * sc;
#pragma unroll
              for (int s = 0; s < 2; ++s) { const bf16x8 bfr = pack8(C[i][8 * s + 0], C[i][8 * s + 1], C[i][8 * s + 2], C[i][8 * s + 3], C[i][8 * s + 4], C[i][8 * s + 5], C[i][8 * s + 6], C[i][8 * s + 7]);
                  const unsigned co = ((4u * i + 2u * s + h5) << 4) ^ xq;
                  const bf16x8 a0 = *(const ML_LAS bf16x8*)(q0 + co), a1 = *(const ML_LAS bf16x8*)(q1 + co);
                  if (i == 0 && s == 0) { Y0 = __builtin_amdgcn_mfma_f32_32x32x16_bf16(a0, bfr, (f32x16){0.f}, 0, 0, 0); Y1 = __builtin_amdgcn_mfma_f32_32x32x16_bf16(a1, bfr, (f32x16){0.f}, 0, 0, 0); }
                  else { Y0 = __builtin_amdgcn_mfma_f32_32x32x16_bf16(a0, bfr, Y0, 0, 0, 0); Y1 = __builtin_amdgcn_mfma_f32_32x32x16_bf16(a1, bfr, Y1, 0, 0, 0); } } } }
        bf16x8 vw[4];
        { ML_OPAQUE_LANE(ln); const unsigned h5 = ln >> 5, kg = ln >> 4; const unsigned vt = wid >> 2, vc = wid & 3; bf16x8 vf[4];
          ML_LAS unsigned char* v0 = bV + 16384u * vt + ((64u * vc) ^ trX); ML_LAS unsigned char* va = v0 + trL0; ML_LAS unsigned char* vb = v0 + trL1;
#pragma unroll
          for (int ks = 0; ks < 4; ++ks) vf[ks] = cat8(trrd(va + 4096 * ks), trrd(vb + 4096 * ks));
          ML_LAS float* vwe = VWE + 8 * h5;
#pragma unroll
          for (int ks = 0; ks < 4; ++ks) { const f32x4 w0 = *(const ML_LAS f32x4*)(vwe + 16 * ks), w1 = *(const ML_LAS f32x4*)(vwe + 16 * ks + 4);
              vw[ks] = pack8(s2f(vf[ks][0]) * w0[0], s2f(vf[ks][1]) * w0[1], s2f(vf[ks][2]) * w0[2], s2f(vf[ks][3]) * w0[3], s2f(vf[ks][4]) * w1[0], s2f(vf[ks][5]) * w1[1], s2f(vf[ks][6]) * w1[2], s2f(vf[ks][7]) * w1[3]); }
          ML_LAS unsigned char* ka = bK + trL0; ML_LAS unsigned char* kb = bK + trL1;
#pragma unroll
          for (int i = 0; i < 4; ++i) { const unsigned xo = (64u * i) ^ trX;
#pragma unroll
              for (int ks = 0; ks < 4; ++ks) C[i] = __builtin_amdgcn_mfma_f32_32x32x16_bf16(cat8(trrd(ka + xo + 4096 * ks), trrd(kb + xo + 4096 * ks)), vw[ks], C[i], 0, 0, 0); }
          ML_LAS unsigned char* t16a = bK + tr_addr16(ln, wid, 0, 0); ML_LAS unsigned char* t16b = bK + tr_addr16(ln, wid, 0, 1);
#pragma unroll
          for (int ks = 0; ks < 2; ++ks) { const bf16x8 af = cat8(trrd(t16a + 8192 * ks), trrd(t16b + 8192 * ks));
              const f32x4 w0 = *(const ML_LAS f32x4*)(VWE + 32 * ks + 8 * kg), w1 = *(const ML_LAS f32x4*)(VWE + 32 * ks + 8 * kg + 4);
              n4 = __builtin_amdgcn_mfma_f32_16x16x32_bf16(af, pack8(w0[0], w0[1], w0[2], w0[3], w1[0], w1[1], w1[2], w1[3]), n4, 0, 0, 0); } }
        asm volatile("s_waitcnt lgkmcnt(0)" ::: "memory"); __builtin_amdgcn_s_barrier(); asm volatile("" ::: "memory");
        { ML_OPAQUE_LANE(ln); const unsigned r31 = ln & 31u, h5 = ln >> 5;
          ML_LAS unsigned char* p0 = lds + P_OFF + 128u * r31; ML_LAS unsigned char* p1 = p0 + 128u * 32u; const unsigned xp = (r31 & 7u) << 4;
#pragma unroll
          for (int ks = 0; ks < 4; ++ks) { const unsigned co = ((2u * ks + h5) << 4) ^ xp;
              const bf16x8 a0 = *(const ML_LAS bf16x8*)(p0 + co), a1 = *(const ML_LAS bf16x8*)(p1 + co);
              Y0 = __builtin_amdgcn_mfma_f32_32x32x16_bf16(a0, vw[ks], Y0, 0, 0, 0); Y1 = __builtin_amdgcn_mfma_f32_32x32x16_bf16(a1, vw[ks], Y1, 0, 0, 0); } }
        { ML_OPAQUE_LANE(ln); const unsigned t = ln; float qs = 0.f;
#pragma unroll
          for (int w8 = 0; w8 < 8; ++w8) qs += QNP[w8 * 64 + t];
          const float dn = DENP[t] + DENP[64 + t] + qs; VR[t] = 1.f / fmaxf(fabsf(dn), VEMT[t]); }
        { ML_OPAQUE_LANE(ln); const unsigned h5 = ln >> 5; ML_LAS float* vr = VR + 4 * h5;
#pragma unroll
          for (int qp = 0; qp < 2; ++qp) { const f32x4 ra = *(const ML_LAS f32x4*)(vr + 16 * qp), rb = *(const ML_LAS f32x4*)(vr + 16 * qp + 8), rc = *(const ML_LAS f32x4*)(vr + 32 + 16 * qp), rd = *(const ML_LAS f32x4*)(vr + 32 + 16 * qp + 8);
              const int o = 8 * qp;
              const u32x4 w0 = {pkbf(Y0[o + 0] * ra[0], Y0[o + 1] * ra[1]), pkbf(Y0[o + 2] * ra[2], Y0[o + 3] * ra[3]), pkbf(Y0[o + 4] * rb[0], Y0[o + 5] * rb[1]), pkbf(Y0[o + 6] * rb[2], Y0[o + 7] * rb[3])};
              const u32x4 w1 = {pkbf(Y1[o + 0] * rc[0], Y1[o + 1] * rc[1]), pkbf(Y1[o + 2] * rc[2], Y1[o + 3] * rc[3]), pkbf(Y1[o + 4] * rd[0], Y1[o + 5] * rd[1]), pkbf(Y1[o + 6] * rd[2], Y1[o + 7] * rd[3])};
              pend[qp] = w0; pend[2 + qp] = w1; } }
        asm volatile("" : "+v"(gi_b), "+v"(gf_b));
        sc = sc_n; gi_a = gi_b; gf_a = gf_b;
    }
    { unsigned char* hc = ho + (size_t)(SEQ / 64 - 1) * 32768; *(u32x4*)(hc) = pend[0]; *(u32x4*)(hc + 1024) = pend[1]; *(u32x4*)(hc + 2048) = pend[2]; *(u32x4*)(hc + 3072) = pend[3]; }
#undef ML_STAGE
#undef ML_GATES
#undef ML_VEC
#undef ML_TB
    __syncthreads();
}
}

constexpr int NWAVES = 8;
constexpr int RING_BYTES = 131072;
constexpr int LDS_BYTES = 163840;
constexpr int XCH_OFF = RING_BYTES, ROPE_LDS_OFF = XCH_OFF + 8192, QKG_LDS_OFF = ROPE_LDS_OFF + 16384;
static_assert(QKG_LDS_OFF + 1024 <= LDS_BYTES - 16, "in-projection LDS map");
static_assert(ml::LDS_END <= LDS_BYTES, "mLSTM LDS map");
#define LAS __attribute__((address_space(3)))
#define GAS __attribute__((address_space(1)))
typedef unsigned v4u __attribute__((ext_vector_type(4)));
typedef unsigned v2u __attribute__((ext_vector_type(2)));
typedef float f32x4 __attribute__((ext_vector_type(4)));
#define LDS_WAIT() asm volatile("s_waitcnt lgkmcnt(0)" ::: "memory")

struct Args { const float* in[9]; float* out; unsigned char* ws; int ph_lo, ph_hi; };

__device__ __forceinline__ float wave_sum(float v) {
#pragma unroll
    for (int o = 1; o < 64; o <<= 1) v += __shfl_xor(v, o);
    return v;
}

#define XB_TMO      128
#define XB_XCNT(j)  (256  + 64 * (j))
#define XB_XSUB(j)  (1280 + 64 * (j))
#define XB_XGEN(j)  (2304 + 64 * (j))
#define XB_TOP      3328
#define XB_TOPGEN   3392
#define XCD_BAR_WORDS 3456
#define XB_SPIN_CAP (1u << 18)

__device__ __forceinline__ unsigned xb_ld(unsigned* p)              { return __hip_atomic_load(p, __ATOMIC_RELAXED, __HIP_MEMORY_SCOPE_AGENT); }
__device__ __forceinline__ unsigned xb_add(unsigned* p, unsigned v) { return __hip_atomic_fetch_add(p, v, __ATOMIC_RELAXED, __HIP_MEMORY_SCOPE_AGENT); }
__device__ __forceinline__ unsigned xb_xcc_id() { return (unsigned)__builtin_amdgcn_s_getreg((3 << 11) | 20) & 0xFu; }
#define XB_SPIN(cond, bar) do { unsigned _sp = 0; while (cond) { __builtin_amdgcn_s_sleep(1); \
    if ((++_sp & 255u) == 0u) { if (xb_ld(&(bar)[XB_TMO])) break; if (_sp > XB_SPIN_CAP) { atomicAdd(&(bar)[XB_TMO], 1u); break; } } } } while (0)

struct XcdBarrier {
    unsigned* bar; unsigned x;
    volatile LAS unsigned* st;
};

__device__ __forceinline__ XcdBarrier xcd_barrier_post(unsigned* bar, volatile LAS unsigned* st) {
    XcdBarrier b; b.bar = bar; b.x = xb_xcc_id(); b.st = st;
    if (threadIdx.x == 0) (void)xb_add(&bar[XB_XCNT(b.x)], 1u);
    return b;
}
__device__ __forceinline__ void xcd_barrier_complete(unsigned* bar, unsigned x, unsigned& nloc, unsigned& nx) {
    const unsigned G = gridDim.x * gridDim.y * gridDim.z;
    unsigned sum, cnt, mine, sp = 0u;
    for (;;) {
        sum = 0u; cnt = 0u; mine = 0u;
#pragma unroll
        for (unsigned j = 0; j < 16; ++j) { const unsigned c = xb_ld(&bar[XB_XCNT(j)]); sum += c; cnt += (c > 0u) ? 1u : 0u; mine = (j == x) ? c : mine; }
        if (sum == G) break;
        __builtin_amdgcn_s_sleep(1);
        if ((++sp & 255u) == 0u) { if (xb_ld(&bar[XB_TMO])) break; if (sp > XB_SPIN_CAP) { atomicAdd(&bar[XB_TMO], 1u); break; } }
    }
    nloc = mine > 0u ? mine : 1u; nx = cnt > 0u ? cnt : 1u;
}

__device__ __forceinline__ void xcd_barrier(const XcdBarrier& b) {
    asm volatile("s_waitcnt vmcnt(0)" ::: "memory");
    __syncthreads();
    if (threadIdx.x == 0) {
        unsigned* bar = b.bar;
        __builtin_amdgcn_s_waitcnt(0);
        unsigned nloc = b.st[0], nx = b.st[1];
        if (nloc == 0u) { xcd_barrier_complete(bar, b.x, nloc, nx); b.st[0] = nloc; b.st[1] = nx; }
        const unsigned old = xb_add(&bar[XB_XSUB(b.x)], 1u);
        const unsigned gen = old / nloc;
        if (old + 1u == (gen + 1u) * nloc) {
            __builtin_amdgcn_fence(__ATOMIC_RELEASE, "agent");
            asm volatile("s_waitcnt vmcnt(0)" ::: "memory");
            const unsigned og = xb_add(&bar[XB_TOP], 1u);
            const unsigned tg = og / nx;
            if (og + 1u == (tg + 1u) * nx) xb_add(&bar[XB_TOPGEN], 1u);
            else XB_SPIN(xb_ld(&bar[XB_TOPGEN]) == tg, bar);
            __builtin_amdgcn_fence(__ATOMIC_ACQUIRE, "agent");
            xb_add(&bar[XB_XGEN(b.x)], 1u);
            asm volatile("s_waitcnt vmcnt(0)" ::: "memory");
        } else {
            XB_SPIN(xb_ld(&bar[XB_XGEN(b.x)]) == gen, bar);
            __builtin_amdgcn_fence(__ATOMIC_ACQUIRE, "agent");
            asm volatile("s_waitcnt vmcnt(0)" ::: "memory");
        }
    }
    __syncthreads();
}

__device__ __forceinline__ int w1_dest_row(int n) {
    if (!HY_SEPARATE_ROPE && n < 1280) { const int s = n & 255; return (n & ~255) | (s & 0xC3) | ((s & 0x10) << 1) | ((s & 0x0C) << 1) | ((s & 0x20) >> 3); }
    if (n >= 2560 && n < 3072) return (n & ~12) | ((n & 4) << 1) | ((n & 8) >> 1);
    return n;
}
__device__ __forceinline__ void p0_transpose_item(const float* W, int K, int ldw, int nblk, bf16* WT, LAS float* scr, int item, int lane, bool is_w1) {
    const int kb = item / nblk, nb = item % nblk, k0 = 64 * kb, n0 = 32 * nb;
#pragma unroll 8
    for (int i = 0; i < 32; ++i) { const int kk = 2 * i + (lane >> 5); scr[kk * 33 + (lane & 31)] = W[(size_t)(k0 + kk) * ldw + n0 + (lane & 31)]; }
    LDS_WAIT(); asm volatile("" ::: "memory");
    const int c = lane & 7;
#pragma unroll
    for (int j = 0; j < 4; ++j) { const int n = (lane >> 3) + 8 * j; const LAS float* s = scr + (8 * c) * 33 + n;
        const float ws_ = (is_w1 && n0 + n >= 2560 && n0 + n < 3072) ? 0.08838834764831845f : 1.f;
        v4u o; o.x = pk2(s[0 * 33] * ws_, s[1 * 33] * ws_); o.y = pk2(s[2 * 33] * ws_, s[3 * 33] * ws_); o.z = pk2(s[4 * 33] * ws_, s[5 * 33] * ws_); o.w = pk2(s[6 * 33] * ws_, s[7 * 33] * ws_);
        int nr = n0 + n; if (is_w1) nr = w1_dest_row(nr);
        *(v4u*)(WT + (size_t)nr * K + k0 + 8 * c) = o; }
    LDS_WAIT(); asm volatile("" ::: "memory");
}
__device__ __forceinline__ void rms_rows2_to_bf16(const float* xrow0, const float* xrow1, const float* g, bf16* orow0, bf16* orow1, int lane) {
    const f32x4* xa = (const f32x4*)xrow0 + lane; const f32x4* xb = (const f32x4*)xrow1 + lane; const f32x4* gr = (const f32x4*)g + lane;
    f32x4 v[8], w[8]; float s = 0.f, t = 0.f;
#pragma unroll
    for (int j = 0; j < 8; ++j) { v[j] = __builtin_nontemporal_load(xa + 64 * j); w[j] = __builtin_nontemporal_load(xb + 64 * j); }
#pragma unroll
    for (int j = 0; j < 8; ++j) { s += (v[j].x * v[j].x + v[j].y * v[j].y) + (v[j].z * v[j].z + v[j].w * v[j].w); t += (w[j].x * w[j].x + w[j].y * w[j].y) + (w[j].z * w[j].z + w[j].w * w[j].w); }
    const float r0 = 1.f / sqrtf(wave_sum(s) * (1.f / DM) + EPS), r1 = 1.f / sqrtf(wave_sum(t) * (1.f / DM) + EPS);
    v2u* o0 = (v2u*)orow0 + lane; v2u* o1 = (v2u*)orow1 + lane;
#pragma unroll
    for (int j = 0; j < 8; ++j) { const f32x4 gg = gr[64 * j]; v2u a, b;
        a.x = pk2(v[j].x * r0 * gg.x, v[j].y * r0 * gg.y); a.y = pk2(v[j].z * r0 * gg.z, v[j].w * r0 * gg.w); o0[64 * j] = a;
        b.x = pk2(w[j].x * r1 * gg.x, w[j].y * r1 * gg.y); b.y = pk2(w[j].z * r1 * gg.z, w[j].w * r1 * gg.w); o1[64 * j] = b; }
}
__device__ __forceinline__ void p0_prologue(const Args& a, LAS unsigned char* lds, int vcu, int G, int tid, int wave, int lane) {
    unsigned char* ws = a.ws;
    const float* w_in = a.in[3]; const float* w_out = a.in[8]; const float* norm_g = a.in[2];
    bf16* W1t = (bf16*)(ws + WS_W1T); bf16* W2t = (bf16*)(ws + WS_W2T);
    const int gw = vcu * NWAVES + wave, NGW = G * NWAVES; const int gt = vcu * (NWAVES * 64) + tid, NGT = G * NWAVES * 64;
    for (int e = gt; e < 64 * 32; e += NGT) { const int pos = e >> 5, j = e & 31; const float inv = 1.0f / powf(10000.0f, (float)j * (1.0f / 32.0f)); const float ang = (float)pos * inv;
        float* R = (float*)(ws + WS_ROPE); R[2 * e] = cosf(ang); R[2 * e + 1] = sinf(ang); }
    for (int e = gt; e < 16 * DM; e += NGT) { const int g = e >> 11, k = e & (DM - 1); W1t[(size_t)(NP256 + g) * DM + k] = (bf16)f2bf(w_in[(size_t)k * NPROJ + NP256 + g]); }
    LAS float* scr = (LAS float*)(lds + wave * 16384);
    constexpr int I_1 = (DM / 64) * (NP256 / 32), I_2 = (DM / 64) * (DM / 32);
    for (int it = gw; it < I_1 + I_2; it += NGW) {
        if (it < I_1) p0_transpose_item(w_in, DM, NPROJ, NP256 / 32, W1t, scr, it, lane, true);
        else p0_transpose_item(w_out, DM, DM, DM / 32, W2t, scr, it - I_1, lane, false);
    }
    bf16* H = (bf16*)(ws + WS_H);
    for (int m = gw; m < NTOK; m += 2 * NGW) { const int m1 = (m + NGW < NTOK) ? m + NGW : m;
        const float* xr0 = (m < TOK_PROMPT) ? a.in[0] + (size_t)m * DM : a.in[1] + (size_t)(m - TOK_PROMPT) * DM; const float* xr1 = (m1 < TOK_PROMPT) ? a.in[0] + (size_t)m1 * DM : a.in[1] + (size_t)(m1 - TOK_PROMPT) * DM;
        rms_rows2_to_bf16(xr0, xr1, norm_g, H + (size_t)m * DM, H + (size_t)m1 * DM, lane); }
}

__device__ __forceinline__ void p2_qknorm_rope(const Args& a, int vcu, int G, int wave, int lane) {
    unsigned char* ws = a.ws; const float* R = (const float*)(ws + WS_ROPE);
    const int gw = vcu * NWAVES + wave, NGW = G * NWAVES;
    const int fj = lane & 31, c0 = (lane < 32) ? lane : 64 + (lane - 32), c1 = c0 + 32;
    const float gq0 = a.in[5][c0], gq1 = a.in[5][c1], gk0 = a.in[6][c0], gk1 = a.in[6][c1];
    for (int it = gw; it < NTOK * 10; it += NGW) {
        const int t = it / 10, slot = it - t * 10; const int tl = t & (SEQ - 1); const int pos = (lane < 32) ? (tl >> 6) : (tl & 63);
        bf16* p = (slot < 8) ? (bf16*)(ws + WS_MIX) + (size_t)t * 2048 + slot * 128 : (bf16*)(ws + WS_AK) + (size_t)t * 256 + (slot - 8) * 128;
        const float x0 = bf2f(p[c0]), x1 = bf2f(p[c1]);
        const float r = 1.f / sqrtf(wave_sum(x0 * x0 + x1 * x1) * (1.f / 128.f) + EPS);
        const float y0 = x0 * r * ((slot < 8) ? gq0 : gk0), y1 = x1 * r * ((slot < 8) ? gq1 : gk1);
        const float cs = R[2 * (pos * 32 + fj)], sn = R[2 * (pos * 32 + fj) + 1];
        p[c0] = (bf16)f2bf(y0 * cs - y1 * sn); p[c1] = (bf16)f2bf(y1 * cs + y0 * sn);
    }
}

__device__ __forceinline__ void p4_mlstm_recurrent(const Args& a, LAS unsigned char* lds, int vcu, int G, int tid) {
    unsigned char* ws = a.ws;
    const bf16* MQ = (const bf16*)(ws + WS_MQ); const bf16* MK = (const bf16*)(ws + WS_MK); const bf16* MV = (const bf16*)(ws + WS_MV); const float* GT = (const float*)(ws + WS_GATES);
    LAS float* qs = (LAS float*)lds;
    LAS float* ks = qs + 32 * 128;
    LAS float* vs = ks + 32 * 128;
    LAS float* gi = vs + 32 * 256;
    LAS float* gf = gi + 32;
    const int dv = tid >> 1, half = tid & 1;
    for (int item = vcu; item < NSEQ * 8; item += G) {
        const int b = item >> 3, hd = (item >> 1) & 3, dir = item & 1;
        bf16* HO = (bf16*)(ws + (dir ? WS_HB : WS_HF));
        float C[64], nn[64]; float m = 0.f;
#pragma unroll
        for (int j = 0; j < 64; ++j) { C[j] = 0.f; nn[j] = 0.f; }
        for (int p0 = 0; p0 < SEQ; p0 += 32) {
            __syncthreads();
            { const int rr = tid >> 4, c8 = (tid & 15) * 8; const int tok = dir ? (SEQ - 1 - (p0 + rr)) : (p0 + rr); const size_t row = (size_t)b * SEQ + tok;
              const v4u q4 = *(const v4u*)(MQ + row * 512 + hd * 128 + c8), k4 = *(const v4u*)(MK + row * 512 + hd * 128 + c8);
              LAS float* kd = ks + rr * 128 + c8;
              { LAS float* qa = qs + rr * 128 + (c8 & ~8) + ((c8 & 8) >> 1);   qa[0] = bflo(q4.x); qa[1] = bfhi(q4.x); qa[2] = bflo(q4.y); qa[3] = bfhi(q4.y); qa[8] = bflo(q4.z); qa[9] = bfhi(q4.z); qa[10] = bflo(q4.w); qa[11] = bfhi(q4.w); }
              kd[0] = bflo(k4.x); kd[1] = bfhi(k4.x); kd[2] = bflo(k4.y); kd[3] = bfhi(k4.y); kd[4] = bflo(k4.z); kd[5] = bfhi(k4.z); kd[6] = bflo(k4.w); kd[7] = bfhi(k4.w);
              const int c16 = (tid & 15) * 16; LAS float* vd = vs + rr * 256 + c16;
#pragma unroll
              for (int h2 = 0; h2 < 2; ++h2) { const v4u v4 = *(const v4u*)(MV + row * 1024 + hd * 256 + c16 + 8 * h2);
                  vd[8 * h2 + 0] = bflo(v4.x); vd[8 * h2 + 1] = bfhi(v4.x); vd[8 * h2 + 2] = bflo(v4.y); vd[8 * h2 + 3] = bfhi(v4.y); vd[8 * h2 + 4] = bflo(v4.z); vd[8 * h2 + 5] = bfhi(v4.z); vd[8 * h2 + 6] = bflo(v4.w); vd[8 * h2 + 7] = bfhi(v4.w); }
              if (tid < 32) { const int tk = dir ? (SEQ - 1 - (p0 + tid)) : (p0 + tid); const size_t rw = (size_t)b * SEQ + tk; gi[tid] = GT[rw * 16 + dir * 8 + hd]; gf[tid] = GT[rw * 16 + dir * 8 + 4 + hd]; }
            }
            __syncthreads();
            for (int pp = 0; pp < 32; ++pp) {
                const float lf = gf[pp], ii = gi[pp];
                const float mn = fmaxf(lf + m, ii);
                const float ca = expf(lf + m - mn), cb = expf(ii - mn);
                const float bv = cb * vs[pp * 256 + dv];
                float hp = 0.f, qn = 0.f;
                const LAS float* kr = ks + pp * 128 + 64 * half; const LAS float* qr = qs + pp * 128 + 64 * half;
#pragma unroll
                for (int j = 0; j < 64; ++j) { const float kk = kr[j], qq = qr[j];
                    C[j] = fmaf(ca, C[j], kk * bv); nn[j] = fmaf(ca, nn[j], cb * kk); hp = fmaf(qq, C[j], hp); qn = fmaf(qq, nn[j], qn); }
                hp += __shfl_xor(hp, 1); qn += __shfl_xor(qn, 1);
                const float den = fmaxf(fabsf(qn), expf(-mn));
                if (half == 0) { const int pos = p0 + pp, cch = pos >> 6, o = pos & 63, tt = o >> 5, rho = o & 31, q = rho >> 3, hh = (rho >> 2) & 1, e = rho & 3;
                    HO[(((size_t)((b * 4 + hd) * 32 + cch) * 32768) + (dv >> 5) * 4096 + tt * 2048 + (q >> 1) * 1024 + (32 * hh + (dv & 31)) * 16) / 2 + 4 * (q & 1) + e] = (bf16)f2bf(hp / den); }
                m = mn;
            }
        }
    }
}

__device__ __forceinline__ void p5_mlstm_finalize(const Args& a, LAS unsigned char* lds, int vcu, int G, int tid, int wave, int lane) {
    unsigned char* ws = a.ws; const float* mg = a.in[7];
    const bf16* MO = (const bf16*)(ws + WS_MO); const bf16* MZ = (const bf16*)(ws + WS_MZ); bf16* MIX = (bf16*)(ws + WS_MIX);
    LAS float* XS = (LAS float*)lds;
    const int r31 = lane & 31, h5 = lane >> 5, dv0 = 8 * r31;
    constexpr int NIT = NSEQ * 4 * 32;
    v4u f[2][2], bb[2][2];
#define P5_LOAD_H(item_) do { const int bh_ = (item_) >> 5, ck_ = (item_) & 31; \
        const unsigned char* hf_ = ws + WS_HF + ((size_t)bh_ * 32 + ck_) * 32768 + wave * 4096 + lane * 16; const unsigned char* hb_ = ws + WS_HB + ((size_t)bh_ * 32 + (31 - ck_)) * 32768 + wave * 4096 + (lane ^ 32) * 16; \
        _Pragma("unroll") for (int tt = 0; tt < 2; ++tt) _Pragma("unroll") for (int qp = 0; qp < 2; ++qp) { f[tt][qp] = *(const v4u*)(hf_ + tt * 2048 + qp * 1024); bb[tt][qp] = *(const v4u*)(hb_ + (1 - tt) * 2048 + (1 - qp) * 1024); } } while (0)
    if (vcu < NIT) P5_LOAD_H(vcu);
    for (int item = vcu; item < NIT; item += G) {
        const int bh = item >> 5, ck = item & 31, b = bh >> 2, hd = bh & 3;
        v4u mo[4], mz[4];
#pragma unroll
        for (int it = 0; it < 4; ++it) { const int o = it * 16 + wave * 2 + h5; const size_t row = (size_t)b * SEQ + ck * 64 + o;
            mo[it] = *(const v4u*)(MO + row * 1024 + hd * 256 + dv0); mz[it] = *(const v4u*)(MZ + row * 1024 + hd * 256 + dv0); }
        __syncthreads();
#pragma unroll
        for (int tt = 0; tt < 2; ++tt)
#pragma unroll
            for (int qp = 0; qp < 2; ++qp) { const v4u fv = f[tt][qp], bv = bb[tt][qp];
                float fs[8] = {bflo(fv.x), bfhi(fv.x), bflo(fv.y), bfhi(fv.y), bflo(fv.z), bfhi(fv.z), bflo(fv.w), bfhi(fv.w)};
                float bs[8] = {bflo(bv.x), bfhi(bv.x), bflo(bv.y), bfhi(bv.y), bflo(bv.z), bfhi(bv.z), bflo(bv.w), bfhi(bv.w)};
#pragma unroll
                for (int j = 0; j < 8; ++j) { const int o = 32 * tt + 8 * (2 * qp + (j >> 2)) + 4 * h5 + (j & 3); XS[o * 256 + 32 * wave + r31] = fs[j] + bs[7 - j]; } }
        __syncthreads();
        if (item + G < NIT) P5_LOAD_H(item + G);
        const f32x4 g0 = *(const f32x4*)(mg + hd * 256 + dv0), g1 = *(const f32x4*)(mg + hd * 256 + dv0 + 4);
        const float gg[8] = {g0[0], g0[1], g0[2], g0[3], g1[0], g1[1], g1[2], g1[3]};
#pragma unroll
        for (int it = 0; it < 4; ++it) { const int o = it * 16 + wave * 2 + h5; const size_t row = (size_t)b * SEQ + ck * 64 + o;
            const f32x4 x0 = *(const LAS f32x4*)(XS + o * 256 + dv0), x1 = *(const LAS f32x4*)(XS + o * 256 + dv0 + 4);
            float hm[8] = {x0[0], x0[1], x0[2], x0[3], x1[0], x1[1], x1[2], x1[3]};
            const float mo8[8] = {bflo(mo[it].x), bfhi(mo[it].x), bflo(mo[it].y), bfhi(mo[it].y), bflo(mo[it].z), bfhi(mo[it].z), bflo(mo[it].w), bfhi(mo[it].w)};
            const float mz8[8] = {bflo(mz[it].x), bfhi(mz[it].x), bflo(mz[it].y), bfhi(mz[it].y), bflo(mz[it].z), bfhi(mz[it].z), bflo(mz[it].w), bfhi(mz[it].w)};
            float ss = 0.f;
#pragma unroll
            for (int j = 0; j < 8; ++j) { hm[j] = hm[j] * __builtin_amdgcn_rcpf(1.f + __expf(-mo8[j])); ss += hm[j] * hm[j]; }
#pragma unroll
            for (int s = 1; s < 32; s <<= 1) ss += __shfl_xor(ss, s);
            const float r = __builtin_amdgcn_rsqf(ss * (1.f / 256.f) + EPS);
            float ov[8];
#pragma unroll
            for (int j = 0; j < 8; ++j) ov[j] = hm[j] * r * gg[j] * (mz8[j] * __builtin_amdgcn_rcpf(1.f + __expf(-mz8[j])));
            v4u w; w.x = pk2(ov[0], ov[1]); w.y = pk2(ov[2], ov[3]); w.z = pk2(ov[4], ov[5]); w.w = pk2(ov[6], ov[7]);
            *(v4u*)(MIX + row * 2048 + 1024 + hd * 256 + dv0) = w; }
    }
#undef P5_LOAD_H
    __syncthreads();
}

__device__ __forceinline__ void p5_item(const Args& a, LAS unsigned char* lds, int item) {
    int tid_ = threadIdx.x; asm volatile("" : "+v"(tid_));
    const int lane = tid_ & 63, wave = __builtin_amdgcn_readfirstlane(tid_ >> 6);
    unsigned char* ws = a.ws; const float* mg = a.in[7];
    const bf16* MO = (const bf16*)(ws + WS_MO); const bf16* MZ = (const bf16*)(ws + WS_MZ); bf16* MIX = (bf16*)(ws + WS_MIX);
    LAS float* XS = (LAS float*)lds; const int r31 = lane & 31, h5 = lane >> 5, dv0 = 8 * r31;
    const int bh = item >> 5, ck = item & 31, b = bh >> 2, hd = bh & 3;
    const unsigned char* hf_ = ws + WS_HF + ((size_t)bh * 32 + ck) * 32768 + wave * 4096 + lane * 16; const unsigned char* hb_ = ws + WS_HB + ((size_t)bh * 32 + (31 - ck)) * 32768 + wave * 4096 + (lane ^ 32) * 16;
    v4u f[2][2], bb[2][2], mo[4], mz[4];
#pragma unroll
    for (int tt = 0; tt < 2; ++tt)
#pragma unroll
        for (int qp = 0; qp < 2; ++qp) { f[tt][qp] = *(const v4u*)(hf_ + tt * 2048 + qp * 1024); bb[tt][qp] = *(const v4u*)(hb_ + (1 - tt) * 2048 + (1 - qp) * 1024); }
#pragma unroll
    for (int it = 0; it < 4; ++it) { const int o = it * 16 + wave * 2 + h5; const size_t row = (size_t)b * SEQ + ck * 64 + o;
        mo[it] = *(const v4u*)(MO + row * 1024 + hd * 256 + dv0); mz[it] = *(const v4u*)(MZ + row * 1024 + hd * 256 + dv0); }
    __syncthreads();
#pragma unroll
    for (int tt = 0; tt < 2; ++tt)
#pragma unroll
        for (int qp = 0; qp < 2; ++qp) { const v4u fv = f[tt][qp], bv = bb[tt][qp];
            float fs[8] = {bflo(fv.x), bfhi(fv.x), bflo(fv.y), bfhi(fv.y), bflo(fv.z), bfhi(fv.z), bflo(fv.w), bfhi(fv.w)};
            float bs[8] = {bflo(bv.x), bfhi(bv.x), bflo(bv.y), bfhi(bv.y), bflo(bv.z), bfhi(bv.z), bflo(bv.w), bfhi(bv.w)};
#pragma unroll
            for (int j = 0; j < 8; ++j) { const int o = 32 * tt + 8 * (2 * qp + (j >> 2)) + 4 * h5 + (j & 3); XS[o * 256 + 32 * wave + r31] = fs[j] + bs[7 - j]; } }
    __syncthreads();
    const f32x4 g0 = *(const f32x4*)(mg + hd * 256 + dv0), g1 = *(const f32x4*)(mg + hd * 256 + dv0 + 4);
    const float gg[8] = {g0[0], g0[1], g0[2], g0[3], g1[0], g1[1], g1[2], g1[3]};
#pragma unroll
    for (int it = 0; it < 4; ++it) { const int o = it * 16 + wave * 2 + h5; const size_t row = (size_t)b * SEQ + ck * 64 + o;
        const f32x4 x0 = *(const LAS f32x4*)(XS + o * 256 + dv0), x1 = *(const LAS f32x4*)(XS + o * 256 + dv0 + 4);
        float hm[8] = {x0[0], x0[1], x0[2], x0[3], x1[0], x1[1], x1[2], x1[3]};
        const float mo8[8] = {bflo(mo[it].x), bfhi(mo[it].x), bflo(mo[it].y), bfhi(mo[it].y), bflo(mo[it].z), bfhi(mo[it].z), bflo(mo[it].w), bfhi(mo[it].w)};
        const float mz8[8] = {bflo(mz[it].x), bfhi(mz[it].x), bflo(mz[it].y), bfhi(mz[it].y), bflo(mz[it].z), bfhi(mz[it].z), bflo(mz[it].w), bfhi(mz[it].w)};
        float ss = 0.f;
#pragma unroll
        for (int j = 0; j < 8; ++j) { hm[j] = hm[j] * __builtin_amdgcn_rcpf(1.f + __expf(-mo8[j])); ss += hm[j] * hm[j]; }
#pragma unroll
        for (int s = 1; s < 32; s <<= 1) ss += __shfl_xor(ss, s);
        const float r = __builtin_amdgcn_rsqf(ss * (1.f / 256.f) + EPS);
        float ov[8];
#pragma unroll
        for (int j = 0; j < 8; ++j) ov[j] = hm[j] * r * gg[j] * (mz8[j] * __builtin_amdgcn_rcpf(1.f + __expf(-mz8[j])));
        v4u w; w.x = pk2(ov[0], ov[1]); w.y = pk2(ov[2], ov[3]); w.z = pk2(ov[4], ov[5]); w.w = pk2(ov[6], ov[7]);
        *(v4u*)(MIX + row * 2048 + 1024 + hd * 256 + dv0) = w; }
    __syncthreads();
}

__device__ __forceinline__ void p5_batch(const Args& a, LAS unsigned char* lds, int first, int count) {
    if (count <= 0) return;
    int tid_ = threadIdx.x; asm volatile("" : "+v"(tid_));
    const int lane = tid_ & 63, wave = __builtin_amdgcn_readfirstlane(tid_ >> 6);
    unsigned char* ws = a.ws; const float* mg = a.in[7];
    const bf16* MO = (const bf16*)(ws + WS_MO); const bf16* MZ = (const bf16*)(ws + WS_MZ); bf16* MIX = (bf16*)(ws + WS_MIX);
    LAS float* XS = (LAS float*)lds; const int r31 = lane & 31, h5 = lane >> 5, dv0 = 8 * r31;
    v4u f[2][2], bb[2][2];
#define P5B_LOAD_H(item_) do { const int bh_ = (item_) >> 5, ck_ = (item_) & 31; \
        const unsigned char* hf_ = ws + WS_HF + ((size_t)bh_ * 32 + ck_) * 32768 + wave * 4096 + lane * 16; const unsigned char* hb_ = ws + WS_HB + ((size_t)bh_ * 32 + (31 - ck_)) * 32768 + wave * 4096 + (lane ^ 32) * 16; \
        _Pragma("unroll") for (int tt = 0; tt < 2; ++tt) _Pragma("unroll") for (int qp = 0; qp < 2; ++qp) { f[tt][qp] = *(const v4u*)(hf_ + tt * 2048 + qp * 1024); bb[tt][qp] = *(const v4u*)(hb_ + (1 - tt) * 2048 + (1 - qp) * 1024); } } while (0)
    P5B_LOAD_H(first);
    for (int i = 0; i < count; ++i) {
        const int item = first + i, bh = item >> 5, ck = item & 31, b = bh >> 2, hd = bh & 3;
        v4u mo[4], mz[4];
#pragma unroll
        for (int it = 0; it < 4; ++it) { const int o = it * 16 + wave * 2 + h5; const size_t row = (size_t)b * SEQ + ck * 64 + o;
            mo[it] = *(const v4u*)(MO + row * 1024 + hd * 256 + dv0); mz[it] = *(const v4u*)(MZ + row * 1024 + hd * 256 + dv0); }
        __syncthreads();
#pragma unroll
        for (int tt = 0; tt < 2; ++tt)
#pragma unroll
            for (int qp = 0; qp < 2; ++qp) { const v4u fv = f[tt][qp], bv = bb[tt][qp];
                float fs[8] = {bflo(fv.x), bfhi(fv.x), bflo(fv.y), bfhi(fv.y), bflo(fv.z), bfhi(fv.z), bflo(fv.w), bfhi(fv.w)};
                float bs[8] = {bflo(bv.x), bfhi(bv.x), bflo(bv.y), bfhi(bv.y), bflo(bv.z), bfhi(bv.z), bflo(bv.w), bfhi(bv.w)};
#pragma unroll
                for (int j = 0; j < 8; ++j) { const int o = 32 * tt + 8 * (2 * qp + (j >> 2)) + 4 * h5 + (j & 3); XS[o * 256 + 32 * wave + r31] = fs[j] + bs[7 - j]; } }
        __syncthreads();
        if (i + 1 < count) P5B_LOAD_H(item + 1);
        const f32x4 g0 = *(const f32x4*)(mg + hd * 256 + dv0), g1 = *(const f32x4*)(mg + hd * 256 + dv0 + 4);
        const float gg[8] = {g0[0], g0[1], g0[2], g0[3], g1[0], g1[1], g1[2], g1[3]};
#pragma unroll
        for (int it = 0; it < 4; ++it) { const int o = it * 16 + wave * 2 + h5; const size_t row = (size_t)b * SEQ + ck * 64 + o;
            const f32x4 x0 = *(const LAS f32x4*)(XS + o * 256 + dv0), x1 = *(const LAS f32x4*)(XS + o * 256 + dv0 + 4);
            float hm[8] = {x0[0], x0[1], x0[2], x0[3], x1[0], x1[1], x1[2], x1[3]};
            const float mo8[8] = {bflo(mo[it].x), bfhi(mo[it].x), bflo(mo[it].y), bfhi(mo[it].y), bflo(mo[it].z), bfhi(mo[it].z), bflo(mo[it].w), bfhi(mo[it].w)};
            const float mz8[8] = {bflo(mz[it].x), bfhi(mz[it].x), bflo(mz[it].y), bfhi(mz[it].y), bflo(mz[it].z), bfhi(mz[it].z), bflo(mz[it].w), bfhi(mz[it].w)};
            float ss = 0.f;
#pragma unroll
            for (int j = 0; j < 8; ++j) { hm[j] = hm[j] * __builtin_amdgcn_rcpf(1.f + __expf(-mo8[j])); ss += hm[j] * hm[j]; }
#pragma unroll
            for (int s = 1; s < 32; s <<= 1) ss += __shfl_xor(ss, s);
            const float r = __builtin_amdgcn_rsqf(ss * (1.f / 256.f) + EPS);
            float ov[8];
#pragma unroll
            for (int j = 0; j < 8; ++j) ov[j] = hm[j] * r * gg[j] * (mz8[j] * __builtin_amdgcn_rcpf(1.f + __expf(-mz8[j])));
            v4u w; w.x = pk2(ov[0], ov[1]); w.y = pk2(ov[2], ov[3]); w.z = pk2(ov[4], ov[5]); w.w = pk2(ov[6], ov[7]);
            *(v4u*)(MIX + row * 2048 + 1024 + hd * 256 + dv0) = w; }
    }
#undef P5B_LOAD_H
    __syncthreads();
}

__device__ __forceinline__ void gate_rows48(unsigned char* ws, const float* b_gates, int row0, int lane) {
    typedef short bf16x8 __attribute__((ext_vector_type(8)));
    const int r15 = lane & 15, kg = lane >> 4;
    const bf16* a0p = (const bf16*)(ws + WS_H) + (size_t)(row0 + r15) * DM + 8 * kg; const bf16* a1p = a0p + 16 * DM; const bf16* a2p = a0p + 32 * DM;
    const bf16* bp = (const bf16*)(ws + WS_W1T) + (size_t)(NP256 + r15) * DM + 8 * kg;
    f32x4 acc0 = {0.f, 0.f, 0.f, 0.f}, acc1 = {0.f, 0.f, 0.f, 0.f}, acc2 = {0.f, 0.f, 0.f, 0.f};
#pragma unroll 8
    for (int ks = 0; ks < DM / 32; ++ks) { const bf16x8 a0 = *(const bf16x8*)(a0p + 32 * ks), a1 = *(const bf16x8*)(a1p + 32 * ks), a2 = *(const bf16x8*)(a2p + 32 * ks), b = *(const bf16x8*)(bp + 32 * ks);
        acc0 = __builtin_amdgcn_mfma_f32_16x16x32_bf16(a0, b, acc0, 0, 0, 0); acc1 = __builtin_amdgcn_mfma_f32_16x16x32_bf16(a1, b, acc1, 0, 0, 0); acc2 = __builtin_amdgcn_mfma_f32_16x16x32_bf16(a2, b, acc2, 0, 0, 0); }
    const float bias = b_gates[r15]; const bool isf = (r15 >> 2) & 1; float* G = (float*)(ws + WS_GATES) + (size_t)(row0 + 4 * kg) * 16 + r15;
#pragma unroll
    for (int r = 0; r < 4; ++r) { float v0 = acc0[r] + bias, v1 = acc1[r] + bias, v2 = acc2[r] + bias; if (isf) { v0 = log_sigmoid_f(v0); v1 = log_sigmoid_f(v1); v2 = log_sigmoid_f(v2); }
        G[r * 16] = v0; G[(16 + r) * 16] = v1; G[(32 + r) * 16] = v2; }
}

constexpr int N_PHASES = 7;
__global__ void __launch_bounds__(NWAVES * 64, 2) hy_fwd(Args args) {
    extern __shared__ __attribute__((aligned(16))) unsigned char lds_raw[];
    LAS unsigned char* lds = (LAS unsigned char*)lds_raw;
    const int tid = threadIdx.x, lane = tid & 63, wave = __builtin_amdgcn_readfirstlane(tid >> 6);
    const int G = gridDim.x; const int bx = blockIdx.x; const int vcu = (G % 8 == 0) ? (bx % 8) * (G / 8) + bx / 8 : bx;
    unsigned char* ws = args.ws;
    const int lo = args.ph_lo, hi = args.ph_hi;
    unsigned* ctl = (unsigned*)(ws + WS_CTL);
    volatile LAS unsigned* bst = (volatile LAS unsigned*)(lds + LDS_BYTES - 16);
    if (tid == 0) { bst[0] = 0u; bst[1] = 0u; }
    __syncthreads();
    XcdBarrier xbar; xbar.bar = ctl + CW_BAR; xbar.x = 0; xbar.st = bst; bool xposted = false;
    const bool one_launch = (lo == 0 && hi == N_PHASES);
    if (one_launch) { xbar = xcd_barrier_post(ctl + CW_BAR, bst); xposted = true; }
#ifndef HY_PHASE_MASK
#define HY_PHASE_MASK 0x7f
#endif
#define IN(k) (((HY_PHASE_MASK >> (k)) & 1) && lo <= (k) && (k) < hi)
#define BOTH(k) (IN(k) && IN((k) + 1))
#ifndef HY_DUP_MASK
#define HY_DUP_MASK 0
#endif
#ifndef HY_PROBE_NULL
#define HY_PROBE_NULL 0
#endif
#ifndef HY_ML_PROBE_MODE
#define HY_ML_PROBE_MODE 0
#endif
#define DUP(k) (((HY_DUP_MASK) >> (k)) & 1)
#define GRID_BAR_CG() do { cg::this_grid().sync(); } while (0)
#define GRID_BAR() do { if (!xposted) { xbar = xcd_barrier_post(ctl + CW_BAR, bst); xposted = true; } xcd_barrier(xbar); } while (0)

    if (IN(0) && DUP(0)) { p0_prologue(args, lds, vcu, G, tid, wave, lane); __syncthreads(); }
    if (IN(0)) { p0_prologue(args, lds, vcu, G, tid, wave, lane); if (BOTH(0)) GRID_BAR(); }

    if (IN(1) && DUP(1)) {
        { const float* Rg = (const float*)(ws + WS_ROPE); LAS float* Rl = (LAS float*)(lds + ROPE_LDS_OFF); LAS float* Gl = (LAS float*)(lds + QKG_LDS_OFF);
          for (int e = tid; e < 64 * 32 * 2; e += NWAVES * 64) Rl[e] = Rg[e];
          if (tid < 128) { Gl[tid] = args.in[5][tid]; Gl[128 + tid] = args.in[6][tid]; }
          __syncthreads(); }
        pg8::Gemm g{(const pg8::bf16_t*)(ws + WS_H), (const pg8::bf16_t*)(ws + WS_W1T), NTOK, NP256, DM}; pg8::StaticOrder S; S.init(NTOK, NP256, G, bx);
#if HY_PROBE_NULL
        pg8::EpiNull E{}; pg8::gemm_phase<pg8::EpiNull, pg8::StaticOrder, true, true>(lds, g, S, E);
#else
        pg8::EpiProj E{ws, (PG8_LAS float*)(lds + XCH_OFF), (PG8_LAS float*)(lds + ROPE_LDS_OFF), (PG8_LAS float*)(lds + QKG_LDS_OFF)};
        pg8::gemm_phase<pg8::EpiProj, pg8::StaticOrder, true, true>(lds, g, S, E);
#endif
        if (BOTH(1)) GRID_BAR();
    }

    if (IN(1)) {
        { const float* Rg = (const float*)(ws + WS_ROPE); LAS float* Rl = (LAS float*)(lds + ROPE_LDS_OFF); LAS float* Gl = (LAS float*)(lds + QKG_LDS_OFF);
          for (int e = tid; e < 64 * 32 * 2; e += NWAVES * 64) Rl[e] = Rg[e];
          if (tid < 128) { Gl[tid] = args.in[5][tid]; Gl[128 + tid] = args.in[6][tid]; }
          __syncthreads(); }
        pg8::Gemm g{(const pg8::bf16_t*)(ws + WS_H), (const pg8::bf16_t*)(ws + WS_W1T), NTOK, NP256, DM}; pg8::StaticOrder S; S.init(NTOK, NP256, G, bx);
        pg8::EpiProj E{ws, (PG8_LAS float*)(lds + XCH_OFF), (PG8_LAS float*)(lds + ROPE_LDS_OFF), (PG8_LAS float*)(lds + QKG_LDS_OFF)};
        pg8::gemm_phase<pg8::EpiProj, pg8::StaticOrder, true, true>(lds, g, S, E);
        { const int nun = (NTOK / 256) * (NP256 / 256), full = nun / G, rem = nun - full * G, light = G - rem;
          if (bx >= rem) for (int it = (bx - rem) * NWAVES + wave; it < NTOK / 48; it += light * NWAVES) gate_rows48(ws, args.in[4], it * 48, lane); }
        if (BOTH(1)) GRID_BAR();
    }

#if HY_SEPARATE_ROPE
    if (IN(2)) { p2_qknorm_rope(args, vcu, G, wave, lane); if (BOTH(2)) GRID_BAR(); }
#endif

#define ATTN_UNIT(grp_, w_) do { const int b_ = (grp_) >> 1, kvh_ = (grp_) & 1, h_ = kvh_ * 4 + ((w_) >> 3), qb_ = (w_) & 7; const size_t row0_ = (size_t)b_ * SEQ + qb_ * 256; \
        bf16* Q_ = (bf16*)(ws + WS_MIX) + row0_ * 2048 + h_ * 128; const attn::bf16* K_ = (const attn::bf16*)(ws + WS_AK) + (size_t)b_ * SEQ * 256 + kvh_ * 128; \
        const attn::bf16* V_ = (const attn::bf16*)(ws + WS_AV) + (size_t)b_ * SEQ * 256 + kvh_ * 128; const bf16* Z_ = (const bf16*)(ws + WS_AZ) + row0_ * 1024 + h_ * 128; \
        int seqv_ = SEQ; asm volatile("" : "+s"(seqv_)); attn::attn_dense_body<attn::bf16>((const attn::bf16*)Q_, K_, V_, Q_, Z_, seqv_, (char*)lds_raw, attn_m0raw); __syncthreads(); } while (0)
    float attn_m0raw;
    { float gq = 0.f, gk = 0.f; for (int c = 0; c < 128; ++c) { gq = fmaxf(gq, fabsf(args.in[5][c])); gk = fmaxf(gk, fabsf(args.in[6][c])); }
      attn_m0raw = fminf(130.56f * gq * gk, 40.f / attn::SCALE); }
#if HY_SCHED_J
    const bool schedJ = one_launch && G == 256;
    if (schedJ) {
        const int xl = vcu >> 5, s = vcu & 31;
        if (s < 24) ml::mlstm_item<0>(ws, lds, xl * 24 + s, tid);
        else for (int j = 0; j < 2; ++j) ATTN_UNIT(xl, 2 * (s - 24) + j);
        GRID_BAR();
        const int n_rest = (s < 16) ? 6 : 5, n_p5 = (s < 16) ? 8 : 16, p5_0 = (s < 16) ? 8 * (xl * 16 + s) : 1024 + 16 * (xl * 16 + (s - 16));
        int p5_done = 0;
        for (int jr = 0; jr < n_rest; ++jr) {
            if ((jr & 1) == 0) { const int tgt = (n_p5 * ((jr >> 1) + 1)) / 3;
                p5_batch(args, lds, p5_0 + p5_done, tgt - p5_done); p5_done = tgt; }
            const int li = s + 32 * jr;
            const int grp = (li < 16) ? xl : xl + 8 * (1 + ((li - 16) >> 5)), w = (li < 16) ? 16 + li : (li - 16) & 31;
            ATTN_UNIT(grp, w);
        }
        GRID_BAR();
    }
#else
    const bool schedJ = false;
#endif

    if (!schedJ && IN(3)) {
        for (int u = vcu; u < NSEQ * 2 * 32; u += G) ATTN_UNIT(u >> 5, u & 31);
        if (BOTH(3)) GRID_BAR();
    }

    if (!schedJ && IN(4) && DUP(4)) {
#if HY_MLSTM_REF
        p4_mlstm_recurrent(args, lds, vcu, G, tid);
#else
        for (int item = vcu; item < NSEQ * 8; item += G) ml::mlstm_item<HY_ML_PROBE_MODE>(ws, lds, item, tid);
#endif
        if (BOTH(4)) GRID_BAR(); }

    if (!schedJ && IN(4)) {
#if HY_MLSTM_REF
        p4_mlstm_recurrent(args, lds, vcu, G, tid);
#else
        for (int item = vcu; item < NSEQ * 8; item += G) ml::mlstm_item<0>(ws, lds, item, tid);
#endif
        if (BOTH(4)) GRID_BAR(); }

    if (!schedJ && IN(5) && DUP(5)) { p5_mlstm_finalize(args, lds, vcu, G, tid, wave, lane); }
    if (!schedJ && IN(5)) { p5_mlstm_finalize(args, lds, vcu, G, tid, wave, lane); if (BOTH(5)) GRID_BAR(); }

    if (IN(6) && DUP(6)) {
        pg8::Gemm g{(const pg8::bf16_t*)(ws + WS_MIX), (const pg8::bf16_t*)(ws + WS_W2T), NTOK, DM, DM}; pg8::StaticOrder S; S.init(NTOK, DM, G, bx);
        pg8::EpiOut E{args.in[0], args.in[1], args.out};
        pg8::gemm_phase<pg8::EpiOut, pg8::StaticOrder, true, true>(lds, g, S, E);
    }
    if (IN(6)) {
        pg8::Gemm g{(const pg8::bf16_t*)(ws + WS_MIX), (const pg8::bf16_t*)(ws + WS_W2T), NTOK, DM, DM}; pg8::StaticOrder S; S.init(NTOK, DM, G, bx);
        pg8::EpiOut E{args.in[0], args.in[1], args.out};
        pg8::gemm_phase<pg8::EpiOut, pg8::StaticOrder, true, true>(lds, g, S, E);
    }
    if (one_launch && lo < 0) GRID_BAR_CG();
#undef IN
#undef BOTH
}

extern "C" void kernel_launch(void* const* d_in, const int* in_sizes, int n_in, void* d_out, int out_size, void* d_ws, size_t ws_size, hipStream_t stream) {
    static int grid = 0;
    if (grid == 0) {
        if (n_in != 9 || in_sizes[0] != TOK_PROMPT * DM || in_sizes[1] != (NTOK - TOK_PROMPT) * DM || out_size != NTOK * DM || ws_size < WS_END) {
            fprintf(stderr, "kernel_launch: shape mismatch n_in %d in0 %d in1 %d out %d ws %zu (need %zu)\n", n_in, n_in > 0 ? in_sizes[0] : -1, n_in > 1 ? in_sizes[1] : -1, out_size, ws_size, (size_t)WS_END); grid = -1; return; }
        int dev = 0, cus = 0, per_cu = 0;
        if (hipGetDevice(&dev) != hipSuccess || hipDeviceGetAttribute(&cus, hipDeviceAttributeMultiprocessorCount, dev) != hipSuccess) { fprintf(stderr, "kernel_launch: device query failed\n"); grid = -1; return; }
        if (hipFuncSetAttribute((const void*)hy_fwd, hipFuncAttributeMaxDynamicSharedMemorySize, LDS_BYTES) != hipSuccess) { fprintf(stderr, "kernel_launch: hipFuncSetAttribute failed\n"); grid = -1; return; }
        if (hipOccupancyMaxActiveBlocksPerMultiprocessor(&per_cu, (const void*)hy_fwd, NWAVES * 64, LDS_BYTES) != hipSuccess || per_cu < 1) { fprintf(stderr, "kernel_launch: occupancy query says %d\n", per_cu); per_cu = 1; }
        (void)hipGetLastError();
        grid = cus;
    }
    if (grid < 0) return;
    if (hipMemsetAsync((char*)d_ws + WS_CTL, 0, 65536, stream) != hipSuccess) { fprintf(stderr, "kernel_launch: hipMemsetAsync of the control words failed\n"); return; }
    Args a{};
    for (int i = 0; i < 9; ++i) a.in[i] = (const float*)d_in[i];
    a.out = (float*)d_out; a.ws = (unsigned char*)d_ws;
#if HY_N_LAUNCHES == 1
    a.ph_lo = 0; a.ph_hi = N_PHASES;
    void* kargs[] = {&a};
    hipError_t e = hipLaunchCooperativeKernel((const void*)hy_fwd, dim3(grid), dim3(NWAVES * 64), kargs, LDS_BYTES, stream);
    if (e != hipSuccess) fprintf(stderr, "kernel_launch: cooperative launch failed: %s (grid %d)\n", hipGetErrorString(e), grid);
#else
    for (int p = 0; p < N_PHASES; ++p) {
        a.ph_lo = p; a.ph_hi = p + 1;
        hipLaunchKernelGGL(hy_fwd, dim3(grid), dim3(NWAVES * 64), LDS_BYTES, stream, a);
        const hipError_t le = hipPeekAtLastError();
        if (le != hipSuccess) { fprintf(stderr, "kernel_launch: launch %d failed: %s\n", p, hipGetErrorName(le)); break; }
    }
#endif
}
```

```cpp
#include <hip/hip_runtime.h>
#include <hip/hip_bf16.h>
#include <hip/hip_cooperative_groups.h>
#include <cstdio>
#include <cstdint>
#include <cmath>
namespace cg = cooperative_groups;

#ifndef HY_SEPARATE_ROPE
#define HY_SEPARATE_ROPE 0
#endif
#ifndef HY_SCHED_J
#define HY_SCHED_J 1
#endif
#ifndef HY_MLSTM_REF
#define HY_MLSTM_REF 0
#endif
#ifndef HY_N_LAUNCHES
#define HY_N_LAUNCHES 1
#endif

constexpr int SEQ = 2048, NSEQ = 24, NTOK = NSEQ * SEQ, TOK_PROMPT = 8 * SEQ, DM = 2048;
constexpr int NPROJ = 6672, NP256 = 6656;
constexpr float EPS = 1e-6f;

constexpr size_t MiB = 1u << 20;
constexpr size_t WS_CTL = 0, CTL_ZERO_BYTES = 1 * MiB;
constexpr int CW_BAR = 4096, CW_QUEUE = 8192;
constexpr size_t WS_ROPE = 1 * MiB;
constexpr size_t WS_W1T = 2 * MiB;
constexpr size_t WS_W2T = 30 * MiB;
constexpr size_t WS_GATES = 38 * MiB;
constexpr size_t WS_H = 42 * MiB;
constexpr size_t WS_HF = WS_H, WS_HB = WS_H + 96 * MiB;
constexpr size_t WS_MIX = 234 * MiB;
constexpr size_t WS_AK = 426 * MiB, WS_AV = 450 * MiB;
constexpr size_t WS_AZ = 474 * MiB;
constexpr size_t WS_MQ = 570 * MiB, WS_MK = 618 * MiB;
constexpr size_t WS_MV = 666 * MiB, WS_MO = 762 * MiB, WS_MZ = 858 * MiB;
constexpr size_t WS_END = 954 * MiB;

typedef unsigned short bf16;
__device__ __forceinline__ unsigned f2bf(float f) { unsigned u = __builtin_bit_cast(unsigned, f); return (u + 0x7fffu + ((u >> 16) & 1u)) >> 16; }
__device__ __forceinline__ unsigned pk2(float lo, float hi) { return f2bf(lo) | (f2bf(hi) << 16); }
__device__ __forceinline__ float bf2f(unsigned short b) { return __builtin_bit_cast(float, (unsigned)b << 16); }
__device__ __forceinline__ float bflo(unsigned w) { return __builtin_bit_cast(float, w << 16); }
__device__ __forceinline__ float bfhi(unsigned w) { return __builtin_bit_cast(float, w & 0xffff0000u); }
__device__ __forceinline__ float log_sigmoid_f(float x) { return x >= 0.f ? -log1pf(expf(-x)) : x - log1pf(expf(x)); }
namespace pg8 {
#define PG8_LAS __attribute__((address_space(3)))
typedef unsigned short bf16_t;
typedef short bf16x8 __attribute__((ext_vector_type(8)));
typedef float f32x4 __attribute__((ext_vector_type(4)));
typedef unsigned u32x4 __attribute__((ext_vector_type(4)));
constexpr int BM = 256, BK = 64, HALF = 128, HTB = HALF * BK * 2  , STAGE_BYTES = 8 * HTB, NXCD = 8, WGM = 8;

__host__ __device__ __forceinline__ int lds_byte(int r, int c) { const int st = (r >> 4) * 2 + (c >> 5), rr = r & 15, cc = c & 31, ob = rr * 64 + cc * 2; return st * 1024 + (ob ^ (((ob >> 9) & 1) << 5)); }
__host__ __device__ __forceinline__ void stage_rc(int b, int& R, int& C) { const int st = b / 1024, sb = b % 1024, swz = sb ^ (((sb >> 9) & 1) << 5); R = (st >> 1) * 16 + swz / 64; C = (st & 1) * 32 + (swz % 64) / 2; }
__host__ __device__ __forceinline__ int perm32(int rho) { const int n = rho >> 4, i = rho & 15; return 8 * (i >> 2) + 4 * n + (i & 3); }

struct Unit { int pm, pn; };
struct Gemm { const bf16_t* A; const bf16_t* Bt; int M, N, K; };

struct StaticOrder {
    int nM, nN, nwg, G, c;
    __host__ __device__ void init(int M, int N, int G_, int c_) { nM = M / BM; nN = N / BM; nwg = nM * nN; G = G_; c = c_; }
    __host__ __device__ bool next(int i, Unit& u) const {
        const long L = (long)i * G + c; if (L >= nwg) return false;
        int wgid = (int)L; { const int q = nwg / NXCD, r = nwg % NXCD, xcd = wgid % NXCD, off = wgid / NXCD; wgid = (xcd < r ? xcd * (q + 1) : r * (q + 1) + (xcd - r) * q) + off; }
        const int nig = WGM * nN, gid = wgid / nig, fm = gid * WGM, gsz = (nM - fm) < WGM ? (nM - fm) : WGM;
        u.pm = fm + ((wgid % nig) % gsz); u.pn = (wgid % nig) / gsz; return true;
    }
    __device__ __forceinline__ void a_ready(const Unit&) const {}
    __device__ __forceinline__ void done(const Unit&) const {}
};


__device__ __forceinline__ unsigned cvt_pk_bf16(float lo, float hi) { unsigned r; asm volatile("v_cvt_pk_bf16_f32 %0, %1, %2" : "=v"(r) : "v"(lo), "v"(hi)); return r; }

struct EpiProj {
    static constexpr bool PERM = true, AFTER_DRAIN = false; static constexpr int NSTORE = 16;
    unsigned char* ws; PG8_LAS float* xch; PG8_LAS float* ropeL; PG8_LAS float* qkgL;
    __device__ __forceinline__ void operator()(const f32x4 (&acc)[2][2][4][2], const Unit& u, int wr, int wc, int fr, int fq) const {
        const int pn = u.pn; const int row0 = u.pm * BM + wr * 64 + fr;
        if (!HY_SEPARATE_ROPE && pn <= 4) {
            PG8_LAS float* gsrc = qkgL + ((pn < 4) ? 0 : 128); const int cb = 64 * (wc >> 1) + 16 * (wc & 1) + 4 * fq;
            const f32x4 g1 = *(const PG8_LAS f32x4*)(gsrc + cb), g2 = *(const PG8_LAS f32x4*)(gsrc + cb + 32);
#pragma unroll
            for (int ai = 0; ai < 2; ++ai)
#pragma unroll
                for (int m = 0; m < 4; ++m)
#pragma unroll
                    for (int bj = 0; bj < 2; ++bj) { const f32x4 a = acc[ai][bj][m][0], b = acc[ai][bj][m][1];
                        float s = ((a[0] * a[0] + a[1] * a[1]) + (a[2] * a[2] + a[3] * a[3])) + ((b[0] * b[0] + b[1] * b[1]) + (b[2] * b[2] + b[3] * b[3]));
                        s += __shfl_xor(s, 16); s += __shfl_xor(s, 32);
                        if (fq == 0) xch[((ai * HALF + wr * 64 + m * 16 + fr) * 2 + bj) * 4 + wc] = s; }
            asm volatile("s_waitcnt lgkmcnt(0)" ::: "memory"); __builtin_amdgcn_s_barrier(); asm volatile("" ::: "memory");
            bf16_t* base = (bf16_t*)(ws + (pn < 4 ? WS_MIX : WS_AK)); const int ldc = (pn < 4) ? 2048 : 256; const int colt = (pn < 4) ? pn * 256 : 0;
            PG8_LAS float* R = ropeL; const int j0 = 16 * (wc & 1) + 4 * fq;
#pragma unroll
            for (int ai = 0; ai < 2; ++ai)
#pragma unroll
                for (int m = 0; m < 4; ++m) { const int row = row0 + ai * HALF + m * 16; const int tl = row & (SEQ - 1); const int pos = (wc < 2) ? (tl >> 6) : (tl & 63);
                    const f32x4 cs0 = *(const PG8_LAS f32x4*)(R + (pos * 32 + j0) * 2), cs1 = *(const PG8_LAS f32x4*)(R + (pos * 32 + j0) * 2 + 4);
#pragma unroll
                    for (int bj = 0; bj < 2; ++bj) { const f32x4 pt = *(const PG8_LAS f32x4*)(xch + ((ai * HALF + wr * 64 + m * 16 + fr) * 2 + bj) * 4);
                        const float rstd = 1.f / sqrtf(((pt[0] + pt[1]) + (pt[2] + pt[3])) * (1.f / 128.f) + EPS);
                        const f32x4 y1 = acc[ai][bj][m][0] * rstd * g1, y2 = acc[ai][bj][m][1] * rstd * g2;
                        const float o10 = y1[0] * cs0[0] - y2[0] * cs0[1], o11 = y1[1] * cs0[2] - y2[1] * cs0[3], o12 = y1[2] * cs1[0] - y2[2] * cs1[1], o13 = y1[3] * cs1[2] - y2[3] * cs1[3];
                        const float o20 = y2[0] * cs0[0] + y1[0] * cs0[1], o21 = y2[1] * cs0[2] + y1[1] * cs0[3], o22 = y2[2] * cs1[0] + y1[2] * cs1[1], o23 = y2[3] * cs1[2] + y1[3] * cs1[3];
                        bf16_t* dst = base + (size_t)row * ldc + colt + bj * HALF + cb;
                        typedef unsigned u32x2v __attribute__((ext_vector_type(2)));
                        u32x2v w1, w2; w1.x = cvt_pk_bf16(o10, o11); w1.y = cvt_pk_bf16(o12, o13); w2.x = cvt_pk_bf16(o20, o21); w2.y = cvt_pk_bf16(o22, o23);
                        *(u32x2v*)dst = w1; *(u32x2v*)(dst + 32) = w2; } }
            return;
        }
        size_t off; int ldc, colt;
        if (pn < 4)       { off = WS_MIX; ldc = 2048; colt = pn * 256; }
        else if (pn == 4) { off = WS_AK;  ldc = 256;  colt = 0; }
        else if (pn == 5) { off = WS_AV;  ldc = 256;  colt = 0; }
        else if (pn < 10) { off = WS_AZ;  ldc = 1024; colt = (pn - 6) * 256; }
        else if (pn < 12) { off = WS_MQ;  ldc = 512;  colt = (pn - 10) * 256; }
        else if (pn < 14) { off = WS_MK;  ldc = 512;  colt = (pn - 12) * 256; }
        else if (pn < 18) { off = WS_MV;  ldc = 1024; colt = (pn - 14) * 256; }
        else if (pn < 22) { off = WS_MO;  ldc = 1024; colt = (pn - 18) * 256; }
        else              { off = WS_MZ;  ldc = 1024; colt = (pn - 22) * 256; }
        bf16_t* base = (bf16_t*)(ws + off);
        const int col0 = colt + wc * 32 + 8 * fq;
#pragma unroll
        for (int ai = 0; ai < 2; ++ai)
#pragma unroll
            for (int m = 0; m < 4; ++m) { bf16_t* rowp = base + (size_t)(row0 + ai * HALF + m * 16) * ldc + col0;
#pragma unroll
                for (int bj = 0; bj < 2; ++bj) { const f32x4 v0 = acc[ai][bj][m][0], v1 = acc[ai][bj][m][1];
                    u32x4 w; w.x = cvt_pk_bf16(v0[0], v0[1]); w.y = cvt_pk_bf16(v0[2], v0[3]); w.z = cvt_pk_bf16(v1[0], v1[1]); w.w = cvt_pk_bf16(v1[2], v1[3]);
                    *(u32x4*)(rowp + bj * HALF) = w; } }
    }
};
struct EpiNull { static constexpr bool PERM = true, AFTER_DRAIN = false; static constexpr int NSTORE = 0;
    __device__ __forceinline__ void operator()(const f32x4 (&acc)[2][2][4][2], const Unit& u, int wr, int wc, int fr, int fq) const {
#pragma unroll
        for (int ai = 0; ai < 2; ++ai)
#pragma unroll
            for (int bj = 0; bj < 2; ++bj)
#pragma unroll
                for (int m = 0; m < 4; ++m) asm volatile("" :: "v"(acc[ai][bj][m][0]), "v"(acc[ai][bj][m][1])); } };
struct EpiOut {
    static constexpr bool PERM = false, AFTER_DRAIN = false; static constexpr int NSTORE = 32;
    const float* xp; const float* xs; float* out;
    __device__ __forceinline__ void operator()(const f32x4 (&acc)[2][2][4][2], const Unit& u, int wr, int wc, int fr, int fq) const {
        const int row0 = u.pm * BM + wr * 64 + fr; const int col0 = u.pn * BM + wc * 32 + 4 * fq;
        const bool pr = row0 < TOK_PROMPT; const float* xb = (pr ? xp : xs) + col0;
        const size_t xsub = pr ? 0 : (size_t)TOK_PROMPT * DM; float* ob = out + col0;
        f32x4 xr[4][4];
#define EPO_LOAD(g_) do { const size_t ro_ = (size_t)(row0 + ((g_) >> 2) * HALF + ((g_) & 3) * 16) * DM - xsub; \
            xr[(g_) & 3][0] = *(const f32x4*)(xb + ro_); xr[(g_) & 3][1] = *(const f32x4*)(xb + ro_ + 16); xr[(g_) & 3][2] = *(const f32x4*)(xb + ro_ + HALF); xr[(g_) & 3][3] = *(const f32x4*)(xb + ro_ + HALF + 16); } while (0)
        EPO_LOAD(0); EPO_LOAD(1); EPO_LOAD(2);
#pragma unroll
        for (int g = 0; g < 8; ++g) { if (g + 3 < 8) EPO_LOAD(g + 3);
            const int ai = g >> 2, m = g & 3; const size_t ro = (size_t)(row0 + ai * HALF + m * 16) * DM;
            *(f32x4*)(ob + ro) = xr[g & 3][0] + acc[ai][0][m][0]; *(f32x4*)(ob + ro + 16) = xr[g & 3][1] + acc[ai][0][m][1];
            *(f32x4*)(ob + ro + HALF) = xr[g & 3][2] + acc[ai][1][m][0]; *(f32x4*)(ob + ro + HALF + 16) = xr[g & 3][3] + acc[ai][1][m][1]; }
#undef EPO_LOAD
    }
};

template <class Epi, class Sched, bool ALIGN_EPI = false, bool SP2 = false>
__device__ __forceinline__ void gemm_phase(PG8_LAS unsigned char* lds, const Gemm g, const Sched& S, const Epi& E) {
    const int tid = threadIdx.x, wid = __builtin_amdgcn_readfirstlane(tid >> 6), lane = tid & 63, wr = wid >> 2, wc = wid & 3, fr = lane & 15, fq = lane >> 4;
    const int K = g.K, nt = K / BK;
    unsigned voffA[2], voffB[2];
#pragma unroll
    for (int i = 0; i < 2; ++i) { int R, C; stage_rc(tid * 16 + i * 8192, R, C); const int Rb = Epi::PERM ? ((R & ~31) + perm32(R & 31)) : R;
        voffA[i] = (unsigned)(R * K + C) * 2u; voffB[i] = (unsigned)(Rb * K + C) * 2u; }
    const size_t kstep = (size_t)(BK * 2);
    const size_t hstep = (size_t)HALF * K * 2;
    const size_t tstep = 2 * hstep;
    const unsigned ldsw = (unsigned)wid * 1024u;
    const int aoff = lds_byte(wr * 64 + fr, fq * 8), boff = lds_byte(wc * 32 + fr, fq * 8);
#define PG8_SA(b, h) (((b) * 2 + (h)) * HTB)
#define PG8_SB(b, h) ((4 + (b) * 2 + (h)) * HTB)
#define PG8_STAGE(bufoff, gbase, voff) do { _Pragma("unroll") for (int _i = 0; _i < 2; ++_i) \
        __builtin_amdgcn_global_load_lds((const unsigned*)((const char*)(gbase) + (voff)[_i]), (PG8_LAS unsigned*)(lds + (bufoff) + ldsw + _i * 8192), 16, 0, 0); } while (0)
#define PG8_LDA(dst, b, h) do { _Pragma("unroll") for (int m = 0; m < 4; ++m) _Pragma("unroll") for (int k = 0; k < 2; ++k) dst[m][k] = *(const PG8_LAS bf16x8*)(lds + PG8_SA(b, h) + aoff + m * 2048 + k * 1024); } while (0)
#define PG8_LDB(dst, b, h) do { _Pragma("unroll") for (int n = 0; n < 2; ++n) _Pragma("unroll") for (int k = 0; k < 2; ++k) dst[n][k] = *(const PG8_LAS bf16x8*)(lds + PG8_SB(b, h) + boff + n * 2048 + k * 1024); } while (0)
#define PG8_MMA(ai, bj, At, Bt) do { __builtin_amdgcn_s_setprio(1); _Pragma("unroll") for (int m = 0; m < 4; ++m) _Pragma("unroll") for (int n = 0; n < 2; ++n) _Pragma("unroll") for (int k = 0; k < 2; ++k) \
        acc[ai][bj][m][n] = __builtin_amdgcn_mfma_f32_16x16x32_bf16(Bt[n][k], At[m][k], acc[ai][bj][m][n], 0, 0, 0); __builtin_amdgcn_s_setprio(0); } while (0)
#define PG8_WAIT_V(n) asm volatile("s_waitcnt vmcnt(" #n ")" ::: "memory")
#define PG8_WAIT_L(n) asm volatile("s_waitcnt lgkmcnt(" #n ")" ::: "memory")
#define PG8_BAR __builtin_amdgcn_s_barrier()
#define PG8_SCHED __builtin_amdgcn_sched_barrier(0)
    Unit cur, nxt; int ui = 0;
    if (!S.next(0, cur)) return;
    f32x4 acc[2][2][4][2];
#pragma unroll
    for (int a = 0; a < 2; ++a)
#pragma unroll
        for (int b = 0; b < 2; ++b)
#pragma unroll
            for (int m = 0; m < 4; ++m)
#pragma unroll
                for (int n = 0; n < 2; ++n) acc[a][b][m][n] = (f32x4){0.f, 0.f, 0.f, 0.f};
    bf16x8 At[4][2], B0[2][2], B1[2][2];
    const char* cA = (const char*)g.A + (size_t)cur.pm * tstep; const char* cB = (const char*)g.Bt + (size_t)cur.pn * tstep;
    S.a_ready(cur);
    if constexpr (SP2) {
        PG8_STAGE(PG8_SB(0, 0), cB, voffB); PG8_STAGE(PG8_SB(0, 1), cB + hstep, voffB); PG8_STAGE(PG8_SA(0, 0), cA, voffA); PG8_STAGE(PG8_SA(0, 1), cA + hstep, voffA);
        if (wr == 1) PG8_BAR;
        PG8_WAIT_V(2); PG8_BAR;
        PG8_STAGE(PG8_SB(1, 0), cB + kstep, voffB); PG8_STAGE(PG8_SA(1, 0), cA + kstep, voffA); PG8_STAGE(PG8_SB(1, 1), cB + hstep + kstep, voffB);
        PG8_WAIT_V(6); PG8_BAR;
    } else {
        PG8_STAGE(PG8_SB(0, 0), cB, voffB); PG8_STAGE(PG8_SA(0, 0), cA, voffA); PG8_STAGE(PG8_SB(0, 1), cB + hstep, voffB); PG8_STAGE(PG8_SA(0, 1), cA + hstep, voffA);
        if (wr == 1) PG8_BAR;
        PG8_WAIT_V(4); PG8_BAR;
        PG8_STAGE(PG8_SB(1, 0), cB + kstep, voffB); PG8_STAGE(PG8_SA(1, 0), cA + kstep, voffA); PG8_STAGE(PG8_SB(1, 1), cB + hstep + kstep, voffB);
        PG8_WAIT_V(6); PG8_BAR;
    }
    for (;;) {
        const bool has_next = S.next(ui + 1, nxt);
        const char* nA = has_next ? (const char*)g.A + (size_t)nxt.pm * tstep : cA; const char* nB = has_next ? (const char*)g.Bt + (size_t)nxt.pn * tstep : cB;
        for (int t = 0; t < nt; t += 2) {
            const bool last = (t == nt - 2);
            const char* a1 = cA + (size_t)(t + 1) * kstep;
            const char* a2 = last ? nA : cA + (size_t)(t + 2) * kstep; const char* b2 = last ? nB : cB + (size_t)(t + 2) * kstep;
            const char* a3 = a2 + kstep; const char* b3 = b2 + kstep;
            if (last && has_next) S.a_ready(nxt);
            if constexpr (SP2) {
            const int relax_s = __builtin_amdgcn_readfirstlane((Epi::NSTORE > 0 && t == 0 && ui > 0) ? 1 : 0);
#define PG8_WAIT_FIRST() do { if constexpr (Epi::NSTORE >= 32) asm volatile("s_waitcnt vmcnt(40)\n\ts_cmp_lg_u32 %0, 0\n\ts_cbranch_scc1 1f\n\ts_waitcnt vmcnt(8)\n1:" :: "s"(relax_s) : "memory", "scc"); \
            else if constexpr (Epi::NSTORE >= 16) asm volatile("s_waitcnt vmcnt(24)\n\ts_cmp_lg_u32 %0, 0\n\ts_cbranch_scc1 1f\n\ts_waitcnt vmcnt(8)\n1:" :: "s"(relax_s) : "memory", "scc"); \
            else PG8_WAIT_V(8); } while (0)
            PG8_LDB(B0, 0, 0); PG8_LDB(B1, 0, 1); PG8_SCHED; PG8_LDA(At, 0, 0); PG8_STAGE(PG8_SA(1, 1), a1 + hstep, voffA);
            PG8_WAIT_FIRST(); PG8_WAIT_L(0); PG8_BAR; PG8_MMA(0, 0, At, B0); PG8_MMA(0, 1, At, B1); PG8_BAR; PG8_SCHED;
            PG8_LDA(At, 0, 1); PG8_STAGE(PG8_SB(0, 0), b2, voffB); PG8_STAGE(PG8_SB(0, 1), b2 + hstep, voffB); PG8_STAGE(PG8_SA(0, 0), a2, voffA);
            PG8_WAIT_FIRST(); PG8_WAIT_L(0); PG8_BAR; PG8_MMA(1, 0, At, B0); PG8_MMA(1, 1, At, B1); PG8_BAR; PG8_SCHED;
#undef PG8_WAIT_FIRST
            PG8_LDB(B0, 1, 0); PG8_LDB(B1, 1, 1); PG8_SCHED; PG8_LDA(At, 1, 0); PG8_STAGE(PG8_SA(0, 1), a2 + hstep, voffA);
            PG8_WAIT_V(8); PG8_WAIT_L(0); PG8_BAR; PG8_MMA(0, 0, At, B0); PG8_MMA(0, 1, At, B1); PG8_BAR; PG8_SCHED;
            PG8_LDA(At, 1, 1); PG8_STAGE(PG8_SB(1, 0), b3, voffB); PG8_STAGE(PG8_SB(1, 1), b3 + hstep, voffB); PG8_STAGE(PG8_SA(1, 0), a3, voffA);
            PG8_WAIT_V(8); PG8_WAIT_L(0); PG8_BAR; PG8_MMA(1, 0, At, B0); PG8_MMA(1, 1, At, B1); PG8_BAR; PG8_SCHED;
            } else {
            PG8_LDB(B0, 0, 0); PG8_SCHED; PG8_LDA(At, 0, 0); PG8_STAGE(PG8_SA(1, 1), a1 + hstep, voffA);
            PG8_WAIT_L(8); PG8_BAR; PG8_WAIT_L(0); PG8_MMA(0, 0, At, B0); PG8_BAR; PG8_SCHED;
            PG8_LDB(B1, 0, 1); PG8_STAGE(PG8_SB(0, 0), b2, voffB);
            PG8_BAR; PG8_WAIT_L(0); PG8_MMA(0, 1, At, B1); PG8_BAR;
            PG8_LDA(At, 0, 1); PG8_STAGE(PG8_SA(0, 0), a2, voffA);
            PG8_BAR; PG8_WAIT_L(0); PG8_MMA(1, 0, At, B0); PG8_BAR; PG8_SCHED;
            PG8_STAGE(PG8_SB(0, 1), b2 + hstep, voffB);
            PG8_WAIT_V(6); PG8_BAR; PG8_MMA(1, 1, At, B1); PG8_BAR;
            PG8_LDB(B0, 1, 0); PG8_SCHED; PG8_LDA(At, 1, 0); PG8_STAGE(PG8_SA(0, 1), a2 + hstep, voffA);
            PG8_WAIT_L(8); PG8_BAR; PG8_WAIT_L(0); PG8_MMA(0, 0, At, B0); PG8_BAR; PG8_SCHED;
            PG8_LDB(B1, 1, 1); PG8_STAGE(PG8_SB(1, 0), b3, voffB);
            PG8_BAR; PG8_WAIT_L(0); PG8_MMA(0, 1, At, B1); PG8_BAR;
            PG8_LDA(At, 1, 1); PG8_STAGE(PG8_SA(1, 0), a3, voffA);
            PG8_BAR; PG8_WAIT_L(0); PG8_MMA(1, 0, At, B0); PG8_BAR; PG8_SCHED;
            PG8_STAGE(PG8_SB(1, 1), b3 + hstep, voffB);
            PG8_WAIT_V(6); PG8_BAR; PG8_MMA(1, 1, At, B1); PG8_BAR;
            }
        }
        if constexpr (ALIGN_EPI) { if (wr == 0) PG8_BAR; }
        if constexpr (!Epi::AFTER_DRAIN) { E(acc, cur, wr, wc, fr, fq); S.done(cur); }
        if (!has_next) break;
#pragma unroll
        for (int a = 0; a < 2; ++a)
#pragma unroll
            for (int b = 0; b < 2; ++b)
#pragma unroll
                for (int m = 0; m < 4; ++m)
#pragma unroll
                    for (int n = 0; n < 2; ++n) acc[a][b][m][n] = (f32x4){0.f, 0.f, 0.f, 0.f};
        cur = nxt; cA = nA; cB = nB; ++ui;
        if constexpr (ALIGN_EPI) { if (wr == 1) PG8_BAR; }
    }
    PG8_WAIT_V(0);
    if constexpr (!ALIGN_EPI) { if (wr == 0) PG8_BAR; }
    PG8_BAR;
    if constexpr (Epi::AFTER_DRAIN) { E.fused(acc, cur, wr, wc, fr, fq, lds, wid, lane); S.done(cur); }
#undef PG8_SA
#undef PG8_SB
#undef PG8_STAGE
#undef PG8_LDA
#undef PG8_LDB
#undef PG8_MMA
#undef PG8_WAIT_V
#undef PG8_WAIT_L
#undef PG8_BAR
#undef PG8_SCHED
}
}
namespace attn {
using bf16 = __hip_bfloat16;
constexpr int   D = 128, NW = 8, QBLK = 32, KVBLK = 64;
constexpr float SCALE = 0.088388347648318440f;
constexpr float THR = 8.f;
constexpr int SDEPTH = 2;
constexpr int LDQ = 2048, LDK = 256, LDO = 2048, LDZ = 1024;
constexpr size_t SHM_V = KVBLK * D * 2, SHM_K = KVBLK * D * 2, SHM_ATTN = 2 * SHM_V + 2 * SHM_K + NW * 64 * 4;
using bf16x8 = __attribute__((ext_vector_type(8))) short;
using s16x4  = __attribute__((ext_vector_type(4))) short;
using f32x16 = __attribute__((ext_vector_type(16))) float;
using f32x8  = __attribute__((ext_vector_type(8))) float;
using u32x4  = __attribute__((ext_vector_type(4))) unsigned;
#define KSWZ(row, colB) ((row) * 256 + ((colB) ^ (((row) & 7) << 4)))
#define SBAR() __builtin_amdgcn_sched_barrier(0)
__device__ __forceinline__ int crow(int r, int hi) { return (r & 3) + 8 * (r >> 2) + 4 * hi; }
__device__ __forceinline__ unsigned cvtpk(float lo, float hi) {
  unsigned r; asm volatile("v_cvt_pk_bf16_f32 %0, %1, %2" : "=v"(r) : "v"(lo), "v"(hi)); return r;
}
template <typename TIn> struct Stage;
template <> struct Stage<bf16>  { using T = bf16x8;
  __device__ static __forceinline__ T ld8(const bf16* p) { return *reinterpret_cast<const bf16x8*>(p); }
  __device__ static __forceinline__ bf16x8 tobf(T x) { return x; } };
template <> struct Stage<float> { using T = f32x8;
  __device__ static __forceinline__ T ld8(const float* p) { return *reinterpret_cast<const f32x8*>(p); }
  __device__ static __forceinline__ bf16x8 tobf(T x) {
    u32x4 w = {cvtpk(x[0], x[1]), cvtpk(x[2], x[3]), cvtpk(x[4], x[5]), cvtpk(x[6], x[7])}; return *reinterpret_cast<bf16x8*>(&w); } };

__device__ __forceinline__ void partialSM(f32x16& p0, f32x16& p1, float& m_reg, float& mn, float& alpha) {
  constexpr float C = SCALE * 1.4426950408889634f;
  float pmax = p0[0]; for (int r = 1; r < 16; ++r) pmax = fmaxf(pmax, p0[r]); for (int r = 0; r < 16; ++r) pmax = fmaxf(pmax, p1[r]);
  { auto rr = __builtin_amdgcn_permlane32_swap(__float_as_uint(pmax), __float_as_uint(pmax), false, false);
    pmax = fmaxf(__uint_as_float(rr[0]), __uint_as_float(rr[1])); }
  if (__builtin_expect(__all(pmax - m_reg <= THR / SCALE), 1)) { mn = m_reg; alpha = 1.f; }
  else { mn = fmaxf(m_reg, pmax); alpha = __builtin_amdgcn_exp2f((m_reg - mn) * C); m_reg = mn; }
  float mnC = -mn * C;
  for (int r = 0; r < 16; ++r) p0[r] = fmaf(p0[r], C, mnC); for (int r = 0; r < 16; ++r) p1[r] = fmaf(p1[r], C, mnC);
  for (int r = 0; r < 16; ++r) p0[r] = __builtin_amdgcn_exp2f(p0[r]);
}
__device__ __forceinline__ void finishSM(f32x16& p0, f32x16& p1, float alpha, float& l_reg, bf16x8& pa0, bf16x8& pa1, bf16x8& pa2, bf16x8& pa3) {
  for (int r = 0; r < 16; ++r) p1[r] = __builtin_amdgcn_exp2f(p1[r]);
  float ps = 0; for (int r = 0; r < 16; ++r) ps += p0[r]; for (int r = 0; r < 16; ++r) ps += p1[r];
  { auto rr = __builtin_amdgcn_permlane32_swap(__float_as_uint(ps), __float_as_uint(ps), false, false);
    ps = __uint_as_float(rr[0]) + __uint_as_float(rr[1]); }
  l_reg = l_reg * alpha + ps;
#define PK4(P, BASE, OUT) do { unsigned a0 = cvtpk(P[BASE + 0], P[BASE + 1]), a1 = cvtpk(P[BASE + 2], P[BASE + 3]);   \
    unsigned b0 = cvtpk(P[BASE + 4], P[BASE + 5]), b1 = cvtpk(P[BASE + 6], P[BASE + 7]);                              \
    auto r0 = __builtin_amdgcn_permlane32_swap(a0, b0, false, false); auto r1 = __builtin_amdgcn_permlane32_swap(a1, b1, false, false); \
    u32x4 w = {r0[0], r1[0], r0[1], r1[1]}; OUT = *reinterpret_cast<bf16x8*>(&w); } while (0)
  PK4(p0, 0, pa0); PK4(p0, 8, pa1); PK4(p1, 0, pa2); PK4(p1, 8, pa3);
#undef PK4
}
__device__ __forceinline__ void qkt(f32x16& p0, f32x16& p1, const bf16* Ks, const bf16x8* qr, int r32, int hi) {
  p0 = f32x16{}; p1 = f32x16{};
  for (int d0 = 0; d0 < 8; ++d0) { int cb = (d0 * 16 + hi * 8) * 2;
    bf16x8 b0 = *reinterpret_cast<const bf16x8*>((const char*)Ks + KSWZ(r32, cb));
    bf16x8 b1 = *reinterpret_cast<const bf16x8*>((const char*)Ks + KSWZ(32 + r32, cb));
    p0 = __builtin_amdgcn_mfma_f32_32x32x16_bf16(b0, qr[d0], p0, 0, 0, 0);
    p1 = __builtin_amdgcn_mfma_f32_32x32x16_bf16(b1, qr[d0], p1, 0, 0, 0); }
}
__device__ __forceinline__ int v_st(int k, int c) { const int kk = (k & ~0xC) | ((k & 4) << 1) | ((k & 8) >> 1); return ((kk >> 3) * 4 + (c >> 5)) * 512 + ((kk & 7) * 32 + (c & 31)) * 2; }
__device__ __forceinline__ int v_rd_base(int lane) { return ((lane & 3) << 3) | (((lane >> 2) & 3) << 6) | (((lane >> 4) & 1) << 5) | (((lane >> 5) & 1) << 8); }
constexpr int v_rd_off(int d0, int ks, int half) { return d0 * 512 + ks * 4096 + half * 2048; }
template <int OFF> __device__ __forceinline__ s16x4 tr_read(int vb) {
  s16x4 r; asm volatile("ds_read_b64_tr_b16 %0, %1 offset:%2" : "=&v"(r) : "v"(vb), "i"(OFF) : "memory"); return r;
}
template <int D0> __device__ __forceinline__ void pv_one(f32x16& od, int vb, bf16x8 pa0, bf16x8 pa1, bf16x8 pa2, bf16x8 pa3) {
  const s16x4 l0 = tr_read<v_rd_off(D0, 0, 0)>(vb), h0 = tr_read<v_rd_off(D0, 0, 1)>(vb), l1 = tr_read<v_rd_off(D0, 1, 0)>(vb), h1 = tr_read<v_rd_off(D0, 1, 1)>(vb);
  const s16x4 l2 = tr_read<v_rd_off(D0, 2, 0)>(vb), h2 = tr_read<v_rd_off(D0, 2, 1)>(vb), l3 = tr_read<v_rd_off(D0, 3, 0)>(vb), h3 = tr_read<v_rd_off(D0, 3, 1)>(vb);
  asm volatile("s_waitcnt lgkmcnt(0)" ::: "memory"); SBAR();
#define PK(L, H) (bf16x8){L[0], L[1], L[2], L[3], H[0], H[1], H[2], H[3]}
  od = __builtin_amdgcn_mfma_f32_32x32x16_bf16(pa0, PK(l0, h0), od, 0, 0, 0);
  od = __builtin_amdgcn_mfma_f32_32x32x16_bf16(pa1, PK(l1, h1), od, 0, 0, 0);
  od = __builtin_amdgcn_mfma_f32_32x32x16_bf16(pa2, PK(l2, h2), od, 0, 0, 0);
  od = __builtin_amdgcn_mfma_f32_32x32x16_bf16(pa3, PK(l3, h3), od, 0, 0, 0);
#undef PK
}
__device__ __forceinline__ void pv_d0(f32x16* o, int vb, bf16x8 pa0, bf16x8 pa1, bf16x8 pa2, bf16x8 pa3) {
  pv_one<0>(o[0], vb, pa0, pa1, pa2, pa3); pv_one<1>(o[1], vb, pa0, pa1, pa2, pa3); pv_one<2>(o[2], vb, pa0, pa1, pa2, pa3); pv_one<3>(o[3], vb, pa0, pa1, pa2, pa3);
}

template <typename TQ>
__device__ __forceinline__ void attn_dense_body(const TQ* Qb, const bf16* __restrict__ Kh, const bf16* __restrict__ Vh,
                                                unsigned short* Ob, const unsigned short* __restrict__ Zb, int seq, char* lds) {
  using St = Stage<bf16>; using SQ = Stage<TQ>;
  int tid = threadIdx.x; asm volatile("" : "+v"(tid));
  const int wid = tid >> 6, lane = tid & 63, r32 = lane & 31, hi = lane >> 5;
  bf16* V_lds = (bf16*)lds; bf16* K_lds = (bf16*)(lds + 2 * SHM_V);
  float* ws = (float*)(lds + 2 * SHM_V + 2 * SHM_K) + wid * 64; float* li_l = ws; float* al_l = ws + 32;
  float m_reg = -1e30f, l_reg = 0; f32x16 o[4] = {}; bf16x8 qr[8];
  const TQ* Qw = Qb + (long)(wid * QBLK + r32) * LDQ + hi * 8;
#pragma unroll
  for (int d0 = 0; d0 < 8; ++d0) qr[d0] = SQ::tobf(SQ::ld8(Qw + d0 * 16));
  const int sr = tid >> 4, sc = (tid & 15) * 8, vst0 = v_st(sr, sc), vst1 = v_st(32 + sr, sc);
  const int vb0 = (int)(uintptr_t)V_lds + v_rd_base(lane);
  struct { typename St::T vs0, vs1, ks0, ks1; } sr_[SDEPTH];
#define SLOAD(i, k0) do { sr_[i].vs0 = St::ld8(&Vh[(long)((k0) + sr) * LDK + sc]); sr_[i].vs1 = St::ld8(&Vh[(long)((k0) + 32 + sr) * LDK + sc]); \
    sr_[i].ks0 = St::ld8(&Kh[(long)((k0) + sr) * LDK + sc]); sr_[i].ks1 = St::ld8(&Kh[(long)((k0) + 32 + sr) * LDK + sc]); } while (0)
#define SWRITE(b, i) do { *(bf16x8*)((char*)V_lds + (b) * SHM_V + vst0) = St::tobf(sr_[i].vs0);          \
    *(bf16x8*)((char*)V_lds + (b) * SHM_V + vst1) = St::tobf(sr_[i].vs1); int kc = sc * 2;               \
    *(bf16x8*)((char*)K_lds + (b) * SHM_K + KSWZ(sr, kc)) = St::tobf(sr_[i].ks0);                       \
    *(bf16x8*)((char*)K_lds + (b) * SHM_K + KSWZ(32 + sr, kc)) = St::tobf(sr_[i].ks1); } while (0)
#define SWAIT() do { if constexpr (SDEPTH == 2) asm volatile("s_waitcnt vmcnt(4)" ::: "memory"); else asm volatile("s_waitcnt vmcnt(0)" ::: "memory"); } while (0)
#define RESC(a) do { if (__any((a) < 1.f)) { if (hi == 0) al_l[r32] = (a); asm volatile("s_waitcnt lgkmcnt(0)" ::: "memory"); \
    for (int d = 0; d < 4; ++d) for (int r = 0; r < 16; ++r) o[d][r] *= al_l[crow(r, hi)]; } } while (0)
  f32x16 pA0, pA1, pB0, pB1; float mnA, mnB, alA, alB; bf16x8 pa0, pa1, pa2, pa3; const int NT = seq / KVBLK;
  constexpr int SE = 0, SO = SDEPTH - 1;
  SLOAD(SE, 0); asm volatile("s_waitcnt vmcnt(0)" ::: "memory"); SWRITE(0, SE); __syncthreads();
  qkt(pA0, pA1, K_lds, qr, r32, hi); partialSM(pA0, pA1, m_reg, mnA, alA);
  SLOAD(SO, KVBLK); if constexpr (SDEPTH == 2) { if (2 < NT) SLOAD(SE, 2 * KVBLK); }
  SWAIT(); SWRITE(1, SO); __syncthreads();
  for (int j = 1; j + 1 < NT; j += 2) {
    SBAR(); qkt(pB0, pB1, (bf16*)((char*)K_lds + SHM_K), qr, r32, hi);
    finishSM(pA0, pA1, alA, l_reg, pa0, pa1, pa2, pa3); SBAR();
    SLOAD(SO, (j + SDEPTH) * KVBLK); SBAR();
    pv_d0(o, vb0, pa0, pa1, pa2, pa3); partialSM(pB0, pB1, m_reg, mnB, alB);
    __syncthreads(); SWAIT(); SWRITE(0, SE);
    RESC(alB); __syncthreads();
    SBAR(); qkt(pA0, pA1, K_lds, qr, r32, hi);
    finishSM(pB0, pB1, alB, l_reg, pa0, pa1, pa2, pa3); SBAR();
    if (SDEPTH == 1 || j + 3 < NT) SLOAD(SE, (j + 1 + SDEPTH) * KVBLK); SBAR();
    pv_d0(o, vb0 + (int)SHM_V, pa0, pa1, pa2, pa3); partialSM(pA0, pA1, m_reg, mnA, alA);
    __syncthreads(); SWAIT(); SWRITE(1, SO);
    RESC(alA); __syncthreads();
  }
  SBAR(); qkt(pB0, pB1, (bf16*)((char*)K_lds + SHM_K), qr, r32, hi);
  finishSM(pA0, pA1, alA, l_reg, pa0, pa1, pa2, pa3); SBAR();
  pv_d0(o, vb0, pa0, pa1, pa2, pa3); partialSM(pB0, pB1, m_reg, mnB, alB);
  __syncthreads(); RESC(alB);
  finishSM(pB0, pB1, alB, l_reg, pa0, pa1, pa2, pa3); SBAR();
  pv_d0(o, vb0 + (int)SHM_V, pa0, pa1, pa2, pa3);
  if (hi == 0) li_l[r32] = l_reg; asm volatile("s_waitcnt lgkmcnt(0)" ::: "memory");
  float rli[16];
#pragma unroll
  for (int r = 0; r < 16; ++r) rli[r] = __builtin_amdgcn_rcpf(li_l[crow(r, hi)]);
  __syncthreads();
  { unsigned short* stg = (unsigned short*)(lds + wid * 8192);
#pragma unroll
    for (int r = 0; r < 16; ++r) { const int orow = crow(r, hi);
#pragma unroll
      for (int d0 = 0; d0 < 4; ++d0) { unsigned u = __builtin_bit_cast(unsigned, o[d0][r] * rli[r]); u = (u + 0x7fffu + ((u >> 16) & 1u)) >> 16; stg[orow * 128 + d0 * 32 + r32] = (unsigned short)u; } }
    asm volatile("s_waitcnt lgkmcnt(0)" ::: "memory");
    unsigned short* Ow = Ob + (long)(wid * QBLK) * LDO; const unsigned short* Zw = Zb + (long)(wid * QBLK) * LDZ;
#pragma unroll 2
    for (int i = 0; i < 8; ++i) { const int row = i * 4 + (lane >> 4), ch = lane & 15;
      const u32x4 ov = *(const u32x4*)(stg + row * 128 + ch * 8); const u32x4 zv = *(const u32x4*)(Zw + (long)row * LDZ + ch * 8); u32x4 w;
#pragma unroll
      for (int e = 0; e < 4; ++e) { const float z0 = __builtin_bit_cast(float, zv[e] << 16), z1 = __builtin_bit_cast(float, zv[e] & 0xffff0000u);
        const float a0 = __builtin_bit_cast(float, ov[e] << 16) * (z0 * __builtin_amdgcn_rcpf(1.f + __expf(-z0))), a1 = __builtin_bit_cast(float, ov[e] & 0xffff0000u) * (z1 * __builtin_amdgcn_rcpf(1.f + __expf(-z1)));
        w[e] = cvtpk(a0, a1); }
      *(u32x4*)(Ow + (long)row * LDO + ch * 8) = w; } }
#undef SLOAD
#undef SWRITE
#undef SWAIT
#undef RESC
}

}
namespace ml {
typedef short bf16x8 __attribute__((ext_vector_type(8)));
typedef short v4i16 __attribute__((ext_vector_type(4)));
typedef float f32x4 __attribute__((ext_vector_type(4)));
typedef float f32x16 __attribute__((ext_vector_type(16)));
typedef unsigned u32x4 __attribute__((ext_vector_type(4)));
typedef unsigned u32x2 __attribute__((ext_vector_type(2)));
#define ML_LAS __attribute__((address_space(3)))
constexpr int BUFB = 65536, Q_OFF = 0, K_OFF = 16384, V_OFF = 32768;
constexpr int P_OFF = 131072, DENP_OFF = P_OFF + 8192, QNP_OFF = DENP_OFF + 512, VEC_OFF = QNP_OFF + 2048, VEC_SLOT = 2 * 256, VR_OFF = VEC_OFF + 2 * VEC_SLOT, NB_OFF = VR_OFF + 8 * 256, LDS_END = NB_OFF + 512;
__device__ __forceinline__ unsigned fxor(unsigned row) { return ((row & 3u) << 2) | ((row >> 2) & 3u); }
__device__ __forceinline__ unsigned off_b(unsigned row, unsigned ch) { return 256u * row + 16u * (ch ^ fxor(row)); }
__device__ __forceinline__ unsigned off_p(unsigned t, unsigned ch) { return 128u * t + 16u * (ch ^ (t & 7u)); }
__device__ __forceinline__ unsigned tr_addr(unsigned lane, unsigned c, unsigned ks, unsigned t) { const unsigned h = lane >> 5, blk = (lane >> 4) & 1u, q = (lane & 15u) >> 2, p = lane & 3u; return off_b(16u * ks + 8u * h + 4u * t + q, 4u * c + 2u * blk + (p >> 1)) + 8u * (p & 1u); }
__device__ __forceinline__ unsigned tr_addr16(unsigned lane, unsigned c, unsigned ks, unsigned t) { const unsigned g = lane >> 4, q = (lane & 15u) >> 2, p = lane & 3u; return off_b(32u * ks + 8u * g + 4u * t + q, 2u * c + (p >> 1)) + 8u * (p & 1u); }
__device__ __forceinline__ v4i16 trrd(ML_LAS unsigned char* p) { return __builtin_amdgcn_ds_read_tr16_b64_v4i16((ML_LAS v4i16*)p); }
template <int OFF> __device__ __forceinline__ v4i16 trra(unsigned addr) { v4i16 r; asm volatile("ds_read_b64_tr_b16 %0, %1 offset:%2" : "=v"(r) : "v"(addr), "i"(OFF) : "memory"); return r; }
__device__ __forceinline__ void glds16(const void* gsrc, unsigned lds_dst) { unsigned keep;
    asm volatile("s_mov_b32 %0, m0\n\ts_mov_b32 m0, %2\n\ts_nop 0\n\tglobal_load_lds_dwordx4 %1, off\n\ts_mov_b32 m0, %0" : "=&s"(keep) : "v"(gsrc), "s"(lds_dst) : "memory"); }
#define ML_TRWAIT() do { asm volatile("s_waitcnt lgkmcnt(0)" ::: "memory"); __builtin_amdgcn_sched_barrier(0); } while (0)
__device__ __forceinline__ bf16x8 cat8(v4i16 lo, v4i16 hi) { return (bf16x8){lo[0], lo[1], lo[2], lo[3], hi[0], hi[1], hi[2], hi[3]}; }
__device__ __forceinline__ unsigned pkbf(float lo, float hi) { unsigned r; asm volatile("v_cvt_pk_bf16_f32 %0, %1, %2" : "=v"(r) : "v"(lo), "v"(hi)); return r; }
__device__ __forceinline__ float s2f(short x) { return __builtin_bit_cast(float, (unsigned)(unsigned short)x << 16); }
__device__ __forceinline__ bf16x8 pack8(float a0, float a1, float a2, float a3, float a4, float a5, float a6, float a7) { u32x4 w = {pkbf(a0, a1), pkbf(a2, a3), pkbf(a4, a5), pkbf(a6, a7)}; return __builtin_bit_cast(bf16x8, w); }
__device__ __forceinline__ float scan_add(float v, int lane) {
#pragma unroll
    for (int o = 1; o < 64; o <<= 1) { const float u = __shfl_up(v, o); if (lane >= o) v += u; }
    return v; }
__device__ __forceinline__ float scan_max(float v, int lane) {
#pragma unroll
    for (int o = 1; o < 64; o <<= 1) { const float u = __shfl_up(v, o); if (lane >= o) v = fmaxf(v, u); }
    return v; }
#define ML_OPAQUE_LANE(ln) unsigned ln = (unsigned)lane; asm volatile("" : "+v"(ln))
__device__ __forceinline__ float rdlane(float v, int l) { return __builtin_bit_cast(float, __builtin_amdgcn_readlane(__builtin_bit_cast(int, v), l)); }

__device__ __forceinline__ void stage(ML_LAS unsigned char* lds, int bsel, int c, int b, int hd, int dir, const unsigned short* MQ, const unsigned short* MK, const unsigned short* MV, int wid, int lane) {
    const int rl = lane >> 4, pos = lane & 15;
#pragma unroll
    for (int half = 0; half < 2; ++half) {
        const int grp = wid + 8 * half, row = 4 * grp + rl, ch = pos ^ ((rl << 2) | (grp & 3));
        const int p = 64 * c + row, tok = dir ? (SEQ - 1 - p) : p; const size_t trow = (size_t)b * SEQ + tok;
        ML_LAS unsigned char* d = lds + bsel * BUFB + grp * 1024;
        __builtin_amdgcn_global_load_lds((const unsigned*)(MQ + trow * 512 + hd * 128 + 8 * ch), (ML_LAS unsigned*)(d + Q_OFF), 16, 0, 0);
        __builtin_amdgcn_global_load_lds((const unsigned*)(MK + trow * 512 + hd * 128 + 8 * ch), (ML_LAS unsigned*)(d + K_OFF), 16, 0, 0);
        __builtin_amdgcn_global_load_lds((const unsigned*)(MV + trow * 1024 + hd * 256 + 8 * ch), (ML_LAS unsigned*)(d + V_OFF), 16, 0, 0);
        __builtin_amdgcn_global_load_lds((const unsigned*)(MV + trow * 1024 + hd * 256 + 128 + 8 * ch), (ML_LAS unsigned*)(d + V_OFF + 16384), 16, 0, 0);
    }
}

#define ML_DPPF(old_, src_, ctrl_, rm_) __builtin_bit_cast(float, __builtin_amdgcn_update_dpp(__builtin_bit_cast(int, (float)(old_)), __builtin_bit_cast(int, (float)(src_)), ctrl_, rm_, 0xf, false))
__device__ __forceinline__ float dscan_add(float v) {
    v += ML_DPPF(0.f, v, 0x111, 0xf); v += ML_DPPF(0.f, v, 0x112, 0xf); v += ML_DPPF(0.f, v, 0x114, 0xf); v += ML_DPPF(0.f, v, 0x118, 0xf);
    v += ML_DPPF(0.f, v, 0x142, 0xa); v += ML_DPPF(0.f, v, 0x143, 0xc); return v; }
__device__ __forceinline__ float dscan_max(float v) { const float NI = -3.0e38f;
    v = fmaxf(v, ML_DPPF(NI, v, 0x111, 0xf)); v = fmaxf(v, ML_DPPF(NI, v, 0x112, 0xf)); v = fmaxf(v, ML_DPPF(NI, v, 0x114, 0xf)); v = fmaxf(v, ML_DPPF(NI, v, 0x118, 0xf));
    v = fmaxf(v, ML_DPPF(NI, v, 0x142, 0xa)); v = fmaxf(v, ML_DPPF(NI, v, 0x143, 0xc)); return v; }

template <int MODE> __device__ __forceinline__ void mlstm_item(unsigned char* ws, ML_LAS unsigned char* lds, int item, int tid) {
    const int lane = tid & 63, wid = __builtin_amdgcn_readfirstlane(tid >> 6);
    const int b = item >> 3, hd = (item >> 1) & 3, dir = item & 1;
    const float* GT = (const float*)(ws + WS_GATES) + dir * 8 + hd;
    ML_LAS float* DENP = (ML_LAS float*)(lds + DENP_OFF); ML_LAS float* QNP = (ML_LAS float*)(lds + QNP_OFF); ML_LAS float* NB = (ML_LAS float*)(lds + NB_OFF + wid * 64);
    unsigned dq0, dq1, dv0, dv1;
    { const int rl = lane >> 4, pos = lane & 15;
      const int g0 = wid, g1 = wid + 8; const int r0 = 4 * g0 + rl, r1 = 4 * g1 + rl; const int c0 = pos ^ ((rl << 2) | (g0 & 3)), c1 = pos ^ ((rl << 2) | (g1 & 3));
      const int m0 = dir ? 63 - r0 : r0, m1 = dir ? 63 - r1 : r1;
      dq0 = (unsigned)(m0 * 1024 + 16 * c0); dq1 = (unsigned)(m1 * 1024 + 16 * c1); dv0 = (unsigned)(m0 * 2048 + 16 * c0); dv1 = (unsigned)(m1 * 2048 + 16 * c1); }
    const unsigned goff = (unsigned)((dir ? 63 - lane : lane) * 64);
    unsigned trL0, trL1, trX;
    { const unsigned h = lane >> 5, blk = (lane >> 4) & 1u, q = (lane & 15u) >> 2, p = lane & 3u; const unsigned A = 256u * (8u * h + q) + 8u * (p & 1u), lo = 2u * blk + (p >> 1);
      trL0 = A + 16u * (lo ^ ((2u * h) & 3u)); trL1 = A + 16u * (lo ^ ((2u * h + 1u) & 3u)) + 1024u; trX = 64u * q; }
    f32x16 C[4]; f32x4 n4 = {0.f, 0.f, 0.f, 0.f};
#pragma unroll
    for (int i = 0; i < 4; ++i) C[i] = (f32x16){0.f};
    const char* gq = (const char*)(ws + WS_MQ) + ((size_t)b * SEQ * 512 + hd * 128) * 2; const char* gk = (const char*)(ws + WS_MK) + ((size_t)b * SEQ * 512 + hd * 128) * 2;
    const char* gv = (const char*)(ws + WS_MV) + ((size_t)b * SEQ * 1024 + hd * 256) * 2; const char* gg = (const char*)GT + (size_t)b * SEQ * 64;
    unsigned char* ho = ws + (dir ? WS_HB : WS_HF) + ((size_t)(b * 4 + hd) * 32) * 32768 + wid * 4096 + lane * 16;
    const unsigned lds0 = (unsigned)(uintptr_t)lds;
#define ML_TB(c_) (MODE == 1 ? (dir ? (SEQ - 64) : 0) : (dir ? (SEQ - 64 * ((c_) + 1)) : 64 * (c_)))
#define ML_STAGE(bsel_, c_) do { const int tb_ = ML_TB(c_); const unsigned d_ = (unsigned)__builtin_amdgcn_readfirstlane((int)(lds0 + (bsel_) * BUFB + wid * 1024)); \
        const char* q_ = gq + (size_t)tb_ * 1024; const char* k_ = gk + (size_t)tb_ * 1024; const char* v_ = gv + (size_t)tb_ * 2048; \
        glds16(q_ + dq0, d_ + Q_OFF); glds16(q_ + dq1, d_ + Q_OFF + 8192); glds16(k_ + dq0, d_ + K_OFF); glds16(k_ + dq1, d_ + K_OFF + 8192); \
        glds16(v_ + dv0, d_ + V_OFF); glds16(v_ + dv1, d_ + V_OFF + 8192); glds16(v_ + 256 + dv0, d_ + V_OFF + 16384); glds16(v_ + 256 + dv1, d_ + V_OFF + 16384 + 8192); } while (0)
#define ML_GATES(c_, gi_, gf_) do { const char* g_ = gg + (size_t)ML_TB(c_) * 64 + goff; gi_ = *(const float*)g_; gf_ = *(const float*)(g_ + 16); } while (0)
#define ML_VEC(cc_, gi_, gf_, sc_out_) do { ML_LAS float* T_ = (ML_LAS float*)(lds + VEC_OFF + ((cc_) & 1) * VEC_SLOT); \
        const float bcs_ = dscan_add(gf_), cx_ = (gi_) - bcs_, cm_ = dscan_max(cx_), M_ = fmaxf(m, cm_); const float g_ = rdlane(bcs_, 63), M63_ = rdlane(M_, 63); \
        T_[lane] = __expf(cx_ - M63_); T_[64 + lane] = __expf(-(bcs_ + M63_)); \
        sc_out_ = __expf(m - M63_); m = g_ + M63_; } while (0)
    float m = 0.f, sc, sc_n = 1.f, gi_a, gf_a, gi_b = 0.f, gf_b = 0.f; u32x4 pend[4] = {{0u, 0u, 0u, 0u}, {0u, 0u, 0u, 0u}, {0u, 0u, 0u, 0u}, {0u, 0u, 0u, 0u}};
    ML_STAGE(0, 0); ML_GATES(0, gi_a, gf_a); ML_VEC(0, gi_a, gf_a, sc); ML_GATES(1, gi_a, gf_a);
    for (int c = 0; c < SEQ / 64; ++c) {
        const int bsel = c & 1;
        ML_LAS unsigned char* bQ = lds + bsel * BUFB + Q_OFF; ML_LAS unsigned char* bK = lds + bsel * BUFB + K_OFF; ML_LAS unsigned char* bV = lds + bsel * BUFB + V_OFF;
        ML_LAS float* VWE = (ML_LAS float*)(lds + VEC_OFF + bsel * VEC_SLOT); ML_LAS float* VEMT = VWE + 64; ML_LAS float* VR = (ML_LAS float*)(lds + VR_OFF + wid * 256);
        asm volatile("s_waitcnt vmcnt(0) lgkmcnt(0)" ::: "memory"); __builtin_amdgcn_s_barrier(); asm volatile("" ::: "memory");
        if (c > 0) { unsigned char* hc = ho + (size_t)(c - 1) * 32768; *(u32x4*)(hc) = pend[0]; *(u32x4*)(hc + 1024) = pend[1]; *(u32x4*)(hc + 2048) = pend[2]; *(u32x4*)(hc + 3072) = pend[3]; }
        if (c + 1 < SEQ / 64) { ML_STAGE(bsel ^ 1, c + 1);
            if (c + 2 < SEQ / 64) ML_GATES(c + 2, gi_b, gf_b);
            ML_VEC(c + 1, gi_a, gf_a, sc_n); }
        if (MODE == 2) { asm volatile("s_waitcnt lgkmcnt(0)" ::: "memory"); __builtin_amdgcn_s_barrier(); continue; }
        { ML_OPAQUE_LANE(ln); const unsigned r15 = ln & 15u, kg = ln >> 4; const int tj = wid >> 1, sb = (wid & 1) * 2; const unsigned t = 16u * tj + r15;
          const unsigned xq = fxor(r15) << 4;
          ML_LAS unsigned char* qrow = bQ + 256u * t;
          bf16x8 qf[4];
#pragma unroll
          for (int ks = 0; ks < 4; ++ks) qf[ks] = *(const ML_LAS bf16x8*)(qrow + (((4u * ks + kg) << 4) ^ xq));
          float dsum = 0.f; const unsigned hb = 8u * (kg & 1u), kh = kg >> 1;
#pragma unroll
          for (int u = 0; u < 2; ++u) { const unsigned si = sb + u; ML_LAS unsigned char* krow = bK + 256u * (16u * si + r15) + hb;
              f32x4 acc = {0.f, 0.f, 0.f, 0.f};
#pragma unroll
              for (int ks = 0; ks < 4; ++ks) { const unsigned g2 = 4u * ks + 2u * kh;
                  const u32x2 lo = *(const ML_LAS u32x2*)(krow + ((g2 << 4) ^ xq)), hi = *(const ML_LAS u32x2*)(krow + (((g2 + 1u) << 4) ^ xq));
                  const u32x4 kw = {lo.x, lo.y, hi.x, hi.y};
                  acc = __builtin_amdgcn_mfma_f32_16x16x32_bf16(__builtin_bit_cast(bf16x8, kw), qf[ks], acc, 0, 0, 0); }
              const unsigned s0 = 16u * si + 4u * kg; const f32x4 ws4 = *(const ML_LAS f32x4*)(VWE + s0);
              float p[4];
#pragma unroll
              for (int r = 0; r < 4; ++r) { p[r] = (s0 + r <= t) ? acc[r] : 0.f; dsum = fmaf(p[r], ws4[r], dsum); }
              const u32x2 pw = {pkbf(p[0], p[1]), pkbf(p[2], p[3])};
              *(ML_LAS u32x2*)(lds + P_OFF + 128u * t + (((2u * si + kh) ^ (t & 7u)) << 4) + hb) = pw; }
          dsum += __shfl_xor(dsum, 16); dsum += __shfl_xor(dsum, 32);
          if (ln < 16u) DENP[(wid & 1) * 64 + t] = dsum; }
        n4 = n4 * sc;
        { ML_OPAQUE_LANE(ln); const unsigned r15 = ln & 15u, kg = ln >> 4; if (r15 == 0) *(ML_LAS f32x4*)(NB + 4 * kg) = n4;
          const f32x4 nA = *(const ML_LAS f32x4*)(NB + 0), nB = *(const ML_LAS f32x4*)(NB + 4), nC = *(const ML_LAS f32x4*)(NB + 8), nD = *(const ML_LAS f32x4*)(NB + 12);
          const unsigned t = ln; ML_LAS unsigned char* qrow = bQ + 256u * t; const unsigned xq = fxor(t) << 4;
          const bf16x8 c0 = *(const ML_LAS bf16x8*)(qrow + (((2u * wid) << 4) ^ xq)), c1 = *(const ML_LAS bf16x8*)(qrow + (((2u * wid + 1u) << 4) ^ xq));
          float qn = 0.f;
#pragma unroll
          for (int e = 0; e < 4; ++e) { qn = fmaf(s2f(c0[e]), nA[e], qn); qn = fmaf(s2f(c0[4 + e]), nC[e], qn); qn = fmaf(s2f(c1[e]), nB[e], qn); qn = fmaf(s2f(c1[4 + e]), nD[e], qn); }
          QNP[wid * 64 + t] = qn; }
        f32x16 Y0, Y1;
        { ML_OPAQUE_LANE(ln); const unsigned r31 = ln & 31u, h5 = ln >> 5; const unsigned xq = fxor(r31) << 4; ML_LAS unsigned char* q0 = bQ + 256u * r31; ML_LAS unsigned char* q1 = q0 + 256u * 32u;
#pragma unroll
          for (int i = 0; i < 4; ++i) { C[i] = C[i] * sc;
#pragma unroll
              for (int s = 0; s < 2; ++s) { const bf16x8 bfr = pack8(C[i][8 * s + 0], C[i][8 * s + 1], C[i][8 * s + 2], C[i][8 * s + 3], C[i][8 * s + 4], C[i][8 * s + 5], C[i][8 * s + 6], C[i][8 * s + 7]);
                  const unsigned co = ((4u * i + 2u * s + h5) << 4) ^ xq;
                  const bf16x8 a0 = *(const ML_LAS bf16x8*)(q0 + co), a1 = *(const ML_LAS bf16x8*)(q1 + co);
                  if (i == 0 && s == 0) { Y0 = __builtin_amdgcn_mfma_f32_32x32x16_bf16(a0, bfr, (f32x16){0.f}, 0, 0, 0); Y1 = __builtin_amdgcn_mfma_f32_32x32x16_bf16(a1, bfr, (f32x16){0.f}, 0, 0, 0); }
                  else { Y0 = __builtin_amdgcn_mfma_f32_32x32x16_bf16(a0, bfr, Y0, 0, 0, 0); Y1 = __builtin_amdgcn_mfma_f32_32x32x16_bf16(a1, bfr, Y1, 0, 0, 0); } } } }
        bf16x8 vw[4];
        { ML_OPAQUE_LANE(ln); const unsigned h5 = ln >> 5, kg = ln >> 4; const unsigned vt = wid >> 2, vc = wid & 3; bf16x8 vf[4];
          ML_LAS unsigned char* v0 = bV + 16384u * vt + ((64u * vc) ^ trX); ML_LAS unsigned char* va = v0 + trL0; ML_LAS unsigned char* vb = v0 + trL1;
#pragma unroll
          for (int ks = 0; ks < 4; ++ks) vf[ks] = cat8(trrd(va + 4096 * ks), trrd(vb + 4096 * ks));
          ML_LAS float* vwe = VWE + 8 * h5;
#pragma unroll
          for (int ks = 0; ks < 4; ++ks) { const f32x4 w0 = *(const ML_LAS f32x4*)(vwe + 16 * ks), w1 = *(const ML_LAS f32x4*)(vwe + 16 * ks + 4);
              vw[ks] = pack8(s2f(vf[ks][0]) * w0[0], s2f(vf[ks][1]) * w0[1], s2f(vf[ks][2]) * w0[2], s2f(vf[ks][3]) * w0[3], s2f(vf[ks][4]) * w1[0], s2f(vf[ks][5]) * w1[1], s2f(vf[ks][6]) * w1[2], s2f(vf[ks][7]) * w1[3]); }
          ML_LAS unsigned char* ka = bK + trL0; ML_LAS unsigned char* kb = bK + trL1;
#pragma unroll
          for (int i = 0; i < 4; ++i) { const unsigned xo = (64u * i) ^ trX;
#pragma unroll
              for (int ks = 0; ks < 4; ++ks) C[i] = __builtin_amdgcn_mfma_f32_32x32x16_bf16(cat8(trrd(ka + xo + 4096 * ks), trrd(kb + xo + 4096 * ks)), vw[ks], C[i], 0, 0, 0); }
          ML_LAS unsigned char* t16a = bK + tr_addr16(ln, wid, 0, 0); ML_LAS unsigned char* t16b = bK + tr_addr16(ln, wid, 0, 1);
#pragma unroll
          for (int ks = 0; ks < 2; ++ks) { const bf16x8 af = cat8(trrd(t16a + 8192 * ks), trrd(t16b + 8192 * ks));
              const f32x4 w0 = *(const ML_LAS f32x4*)(VWE + 32 * ks + 8 * kg), w1 = *(const ML_LAS f32x4*)(VWE + 32 * ks + 8 * kg + 4);
              n4 = __builtin_amdgcn_mfma_f32_16x16x32_bf16(af, pack8(w0[0], w0[1], w0[2], w0[3], w1[0], w1[1], w1[2], w1[3]), n4, 0, 0, 0); } }
        asm volatile("s_waitcnt lgkmcnt(0)" ::: "memory"); __builtin_amdgcn_s_barrier(); asm volatile("" ::: "memory");
        { ML_OPAQUE_LANE(ln); const unsigned r31 = ln & 31u, h5 = ln >> 5;
          ML_LAS unsigned char* p0 = lds + P_OFF + 128u * r31; ML_LAS unsigned char* p1 = p0 + 128u * 32u; const unsigned xp = (r31 & 7u) << 4;
#pragma unroll
          for (int ks = 0; ks < 4; ++ks) { const unsigned co = ((2u * ks + h5) << 4) ^ xp;
              const bf16x8 a0 = *(const ML_LAS bf16x8*)(p0 + co), a1 = *(const ML_LAS bf16x8*)(p1 + co);
              Y0 = __builtin_amdgcn_mfma_f32_32x32x16_bf16(a0, vw[ks], Y0, 0, 0, 0); Y1 = __builtin_amdgcn_mfma_f32_32x32x16_bf16(a1, vw[ks], Y1, 0, 0, 0); } }
        { ML_OPAQUE_LANE(ln); const unsigned t = ln; float qs = 0.f;
#pragma unroll
          for (int w8 = 0; w8 < 8; ++w8) qs += QNP[w8 * 64 + t];
          const float dn = DENP[t] + DENP[64 + t] + qs; VR[t] = 1.f / fmaxf(fabsf(dn), VEMT[t]); }
        { ML_OPAQUE_LANE(ln); const unsigned h5 = ln >> 5; ML_LAS float* vr = VR + 4 * h5;
#pragma unroll
          for (int qp = 0; qp < 2; ++qp) { const f32x4 ra = *(const ML_LAS f32x4*)(vr + 16 * qp), rb = *(const ML_LAS f32x4*)(vr + 16 * qp + 8), rc = *(const ML_LAS f32x4*)(vr + 32 + 16 * qp), rd = *(const ML_LAS f32x4*)(vr + 32 + 16 * qp + 8);
              const int o = 8 * qp;
              const u32x4 w0 = {pkbf(Y0[o + 0] * ra[0], Y0[o + 1] * ra[1]), pkbf(Y0[o + 2] * ra[2], Y0[o + 3] * ra[3]), pkbf(Y0[o + 4] * rb[0], Y0[o + 5] * rb[1]), pkbf(Y0[o + 6] * rb[2], Y0[o + 7] * rb[3])};
              const u32x4 w1 = {pkbf(Y1[o + 0] * rc[0], Y1[o + 1] * rc[1]), pkbf(Y1[o + 2] * rc[2], Y1[o + 3] * rc[3]), pkbf(Y1[o + 4] * rd[0], Y1[o + 5] * rd[1]), pkbf(Y1[o + 6] * rd[2], Y1[o + 7] * rd[3])};
              pend[qp] = w0; pend[2 + qp] = w1; } }
        asm volatile("" : "+v"(gi_b), "+v"(gf_b));
        sc = sc_n; gi_a = gi_b; gf_a = gf_b;
    }
    { unsigned char* hc = ho + (size_t)(SEQ / 64 - 1) * 32768; *(u32x4*)(hc) = pend[0]; *(u32x4*)(hc + 1024) = pend[1]; *(u32x4*)(hc + 2048) = pend[2]; *(u32x4*)(hc + 3072) = pend[3]; }
#undef ML_STAGE
#undef ML_GATES
#undef ML_VEC
#undef ML_TB
    __syncthreads();
}
}

constexpr int NWAVES = 8;
constexpr int RING_BYTES = 131072;
constexpr int LDS_BYTES = 163840;
constexpr int XCH_OFF = RING_BYTES, ROPE_LDS_OFF = XCH_OFF + 8192, QKG_LDS_OFF = ROPE_LDS_OFF + 16384;
static_assert(QKG_LDS_OFF + 1024 <= LDS_BYTES - 16, "in-projection LDS map");
static_assert(ml::LDS_END <= LDS_BYTES, "mLSTM LDS map");
#define LAS __attribute__((address_space(3)))
#define GAS __attribute__((address_space(1)))
typedef unsigned v4u __attribute__((ext_vector_type(4)));
typedef unsigned v2u __attribute__((ext_vector_type(2)));
typedef float f32x4 __attribute__((ext_vector_type(4)));
#define LDS_WAIT() asm volatile("s_waitcnt lgkmcnt(0)" ::: "memory")

struct Args { const float* in[9]; float* out; unsigned char* ws; int ph_lo, ph_hi; };

__device__ __forceinline__ float wave_sum(float v) {
#pragma unroll
    for (int o = 1; o < 64; o <<= 1) v += __shfl_xor(v, o);
    return v;
}

#define XB_TMO      128
#define XB_XCNT(j)  (256  + 64 * (j))
#define XB_XSUB(j)  (1280 + 64 * (j))
#define XB_XGEN(j)  (2304 + 64 * (j))
#define XB_TOP      3328
#define XB_TOPGEN   3392
#define XCD_BAR_WORDS 3456
#define XB_SPIN_CAP (1u << 18)

__device__ __forceinline__ unsigned xb_ld(unsigned* p)              { return __hip_atomic_load(p, __ATOMIC_RELAXED, __HIP_MEMORY_SCOPE_AGENT); }
__device__ __forceinline__ unsigned xb_add(unsigned* p, unsigned v) { return __hip_atomic_fetch_add(p, v, __ATOMIC_RELAXED, __HIP_MEMORY_SCOPE_AGENT); }
__device__ __forceinline__ unsigned xb_xcc_id() { return (unsigned)__builtin_amdgcn_s_getreg((3 << 11) | 20) & 0xFu; }
#define XB_SPIN(cond, bar) do { unsigned _sp = 0; while (cond) { __builtin_amdgcn_s_sleep(1); \
    if ((++_sp & 255u) == 0u) { if (xb_ld(&(bar)[XB_TMO])) break; if (_sp > XB_SPIN_CAP) { atomicAdd(&(bar)[XB_TMO], 1u); break; } } } } while (0)

struct XcdBarrier {
    unsigned* bar; unsigned x;
    volatile LAS unsigned* st;
};

__device__ __forceinline__ XcdBarrier xcd_barrier_post(unsigned* bar, volatile LAS unsigned* st) {
    XcdBarrier b; b.bar = bar; b.x = xb_xcc_id(); b.st = st;
    if (threadIdx.x == 0) (void)xb_add(&bar[XB_XCNT(b.x)], 1u);
    return b;
}
__device__ __forceinline__ void xcd_barrier_complete(unsigned* bar, unsigned x, unsigned& nloc, unsigned& nx) {
    const unsigned G = gridDim.x * gridDim.y * gridDim.z;
    unsigned sum, cnt, mine, sp = 0u;
    for (;;) {
        sum = 0u; cnt = 0u; mine = 0u;
#pragma unroll
        for (unsigned j = 0; j < 16; ++j) { const unsigned c = xb_ld(&bar[XB_XCNT(j)]); sum += c; cnt += (c > 0u) ? 1u : 0u; mine = (j == x) ? c : mine; }
        if (sum == G) break;
        __builtin_amdgcn_s_sleep(1);
        if ((++sp & 255u) == 0u) { if (xb_ld(&bar[XB_TMO])) break; if (sp > XB_SPIN_CAP) { atomicAdd(&bar[XB_TMO], 1u); break; } }
    }
    nloc = mine > 0u ? mine : 1u; nx = cnt > 0u ? cnt : 1u;
}

__device__ __forceinline__ void xcd_barrier(const XcdBarrier& b) {
    asm volatile("s_waitcnt vmcnt(0)" ::: "memory");
    __syncthreads();
    if (threadIdx.x == 0) {
        unsigned* bar = b.bar;
        __builtin_amdgcn_s_waitcnt(0);
        unsigned nloc = b.st[0], nx = b.st[1];
        if (nloc == 0u) { xcd_barrier_complete(bar, b.x, nloc, nx); b.st[0] = nloc; b.st[1] = nx; }
        const unsigned old = xb_add(&bar[XB_XSUB(b.x)], 1u);
        const unsigned gen = old / nloc;
        if (old + 1u == (gen + 1u) * nloc) {
            __builtin_amdgcn_fence(__ATOMIC_RELEASE, "agent");
            asm volatile("s_waitcnt vmcnt(0)" ::: "memory");
            const unsigned og = xb_add(&bar[XB_TOP], 1u);
            const unsigned tg = og / nx;
            if (og + 1u == (tg + 1u) * nx) xb_add(&bar[XB_TOPGEN], 1u);
            else XB_SPIN(xb_ld(&bar[XB_TOPGEN]) == tg, bar);
            __builtin_amdgcn_fence(__ATOMIC_ACQUIRE, "agent");
            xb_add(&bar[XB_XGEN(b.x)], 1u);
            asm volatile("s_waitcnt vmcnt(0)" ::: "memory");
        } else {
            XB_SPIN(xb_ld(&bar[XB_XGEN(b.x)]) == gen, bar);
            __builtin_amdgcn_fence(__ATOMIC_ACQUIRE, "agent");
            asm volatile("s_waitcnt vmcnt(0)" ::: "memory");
        }
    }
    __syncthreads();
}

__device__ __forceinline__ int w1_dest_row(int n) {
    if (!HY_SEPARATE_ROPE && n < 1280) { const int s = n & 255; return (n & ~255) | (s & 0xC3) | ((s & 0x10) << 1) | ((s & 0x0C) << 1) | ((s & 0x20) >> 3); }
    if (n >= 2560 && n < 3072) return (n & ~12) | ((n & 4) << 1) | ((n & 8) >> 1);
    return n;
}
__device__ __forceinline__ void p0_transpose_item(const float* W, int K, int ldw, int nblk, bf16* WT, LAS float* scr, int item, int lane, bool is_w1) {
    const int kb = item / nblk, nb = item % nblk, k0 = 64 * kb, n0 = 32 * nb;
#pragma unroll 8
    for (int i = 0; i < 32; ++i) { const int kk = 2 * i + (lane >> 5); scr[kk * 33 + (lane & 31)] = W[(size_t)(k0 + kk) * ldw + n0 + (lane & 31)]; }
    LDS_WAIT(); asm volatile("" ::: "memory");
    const int c = lane & 7;
#pragma unroll
    for (int j = 0; j < 4; ++j) { const int n = (lane >> 3) + 8 * j; const LAS float* s = scr + (8 * c) * 33 + n;
        const float ws_ = (is_w1 && n0 + n >= 2560 && n0 + n < 3072) ? 0.08838834764831845f : 1.f;
        v4u o; o.x = pk2(s[0 * 33] * ws_, s[1 * 33] * ws_); o.y = pk2(s[2 * 33] * ws_, s[3 * 33] * ws_); o.z = pk2(s[4 * 33] * ws_, s[5 * 33] * ws_); o.w = pk2(s[6 * 33] * ws_, s[7 * 33] * ws_);
        int nr = n0 + n; if (is_w1) nr = w1_dest_row(nr);
        *(v4u*)(WT + (size_t)nr * K + k0 + 8 * c) = o; }
    LDS_WAIT(); asm volatile("" ::: "memory");
}
__device__ __forceinline__ void rms_rows2_to_bf16(const float* xrow0, const float* xrow1, const float* g, bf16* orow0, bf16* orow1, int lane) {
    const f32x4* xa = (const f32x4*)xrow0 + lane; const f32x4* xb = (const f32x4*)xrow1 + lane; const f32x4* gr = (const f32x4*)g + lane;
    f32x4 v[8], w[8]; float s = 0.f, t = 0.f;
#pragma unroll
    for (int j = 0; j < 8; ++j) { v[j] = __builtin_nontemporal_load(xa + 64 * j); w[j] = __builtin_nontemporal_load(xb + 64 * j); }
#pragma unroll
    for (int j = 0; j < 8; ++j) { s += (v[j].x * v[j].x + v[j].y * v[j].y) + (v[j].z * v[j].z + v[j].w * v[j].w); t += (w[j].x * w[j].x + w[j].y * w[j].y) + (w[j].z * w[j].z + w[j].w * w[j].w); }
    const float r0 = 1.f / sqrtf(wave_sum(s) * (1.f / DM) + EPS), r1 = 1.f / sqrtf(wave_sum(t) * (1.f / DM) + EPS);
    v2u* o0 = (v2u*)orow0 + lane; v2u* o1 = (v2u*)orow1 + lane;
#pragma unroll
    for (int j = 0; j < 8; ++j) { const f32x4 gg = gr[64 * j]; v2u a, b;
        a.x = pk2(v[j].x * r0 * gg.x, v[j].y * r0 * gg.y); a.y = pk2(v[j].z * r0 * gg.z, v[j].w * r0 * gg.w); o0[64 * j] = a;
        b.x = pk2(w[j].x * r1 * gg.x, w[j].y * r1 * gg.y); b.y = pk2(w[j].z * r1 * gg.z, w[j].w * r1 * gg.w); o1[64 * j] = b; }
}
__device__ __forceinline__ void p0_prologue(const Args& a, LAS unsigned char* lds, int vcu, int G, int tid, int wave, int lane) {
    unsigned char* ws = a.ws;
    const float* w_in = a.in[3]; const float* w_out = a.in[8]; const float* norm_g = a.in[2];
    bf16* W1t = (bf16*)(ws + WS_W1T); bf16* W2t = (bf16*)(ws + WS_W2T);
    const int gw = vcu * NWAVES + wave, NGW = G * NWAVES; const int gt = vcu * (NWAVES * 64) + tid, NGT = G * NWAVES * 64;
    for (int e = gt; e < 64 * 32; e += NGT) { const int pos = e >> 5, j = e & 31; const float inv = 1.0f / powf(10000.0f, (float)j * (1.0f / 32.0f)); const float ang = (float)pos * inv;
        float* R = (float*)(ws + WS_ROPE); R[2 * e] = cosf(ang); R[2 * e + 1] = sinf(ang); }
    for (int e = gt; e < 16 * DM; e += NGT) { const int g = e >> 11, k = e & (DM - 1); W1t[(size_t)(NP256 + g) * DM + k] = (bf16)f2bf(w_in[(size_t)k * NPROJ + NP256 + g]); }
    LAS float* scr = (LAS float*)(lds + wave * 16384);
    constexpr int I_1 = (DM / 64) * (NP256 / 32), I_2 = (DM / 64) * (DM / 32);
    for (int it = gw; it < I_1 + I_2; it += NGW) {
        if (it < I_1) p0_transpose_item(w_in, DM, NPROJ, NP256 / 32, W1t, scr, it, lane, true);
        else p0_transpose_item(w_out, DM, DM, DM / 32, W2t, scr, it - I_1, lane, false);
    }
    bf16* H = (bf16*)(ws + WS_H);
    for (int m = gw; m < NTOK; m += 2 * NGW) { const int m1 = (m + NGW < NTOK) ? m + NGW : m;
        const float* xr0 = (m < TOK_PROMPT) ? a.in[0] + (size_t)m * DM : a.in[1] + (size_t)(m - TOK_PROMPT) * DM; const float* xr1 = (m1 < TOK_PROMPT) ? a.in[0] + (size_t)m1 * DM : a.in[1] + (size_t)(m1 - TOK_PROMPT) * DM;
        rms_rows2_to_bf16(xr0, xr1, norm_g, H + (size_t)m * DM, H + (size_t)m1 * DM, lane); }
}

__device__ __forceinline__ void p2_qknorm_rope(const Args& a, int vcu, int G, int wave, int lane) {
    unsigned char* ws = a.ws; const float* R = (const float*)(ws + WS_ROPE);
    const int gw = vcu * NWAVES + wave, NGW = G * NWAVES;
    const int fj = lane & 31, c0 = (lane < 32) ? lane : 64 + (lane - 32), c1 = c0 + 32;
    const float gq0 = a.in[5][c0], gq1 = a.in[5][c1], gk0 = a.in[6][c0], gk1 = a.in[6][c1];
    for (int it = gw; it < NTOK * 10; it += NGW) {
        const int t = it / 10, slot = it - t * 10; const int tl = t & (SEQ - 1); const int pos = (lane < 32) ? (tl >> 6) : (tl & 63);
        bf16* p = (slot < 8) ? (bf16*)(ws + WS_MIX) + (size_t)t * 2048 + slot * 128 : (bf16*)(ws + WS_AK) + (size_t)t * 256 + (slot - 8) * 128;
        const float x0 = bf2f(p[c0]), x1 = bf2f(p[c1]);
        const float r = 1.f / sqrtf(wave_sum(x0 * x0 + x1 * x1) * (1.f / 128.f) + EPS);
        const float y0 = x0 * r * ((slot < 8) ? gq0 : gk0), y1 = x1 * r * ((slot < 8) ? gq1 : gk1);
        const float cs = R[2 * (pos * 32 + fj)], sn = R[2 * (pos * 32 + fj) + 1];
        p[c0] = (bf16)f2bf(y0 * cs - y1 * sn); p[c1] = (bf16)f2bf(y1 * cs + y0 * sn);
    }
}

__device__ __forceinline__ void p4_mlstm_recurrent(const Args& a, LAS unsigned char* lds, int vcu, int G, int tid) {
    unsigned char* ws = a.ws;
    const bf16* MQ = (const bf16*)(ws + WS_MQ); const bf16* MK = (const bf16*)(ws + WS_MK); const bf16* MV = (const bf16*)(ws + WS_MV); const float* GT = (const float*)(ws + WS_GATES);
    LAS float* qs = (LAS float*)lds;
    LAS float* ks = qs + 32 * 128;
    LAS float* vs = ks + 32 * 128;
    LAS float* gi = vs + 32 * 256;
    LAS float* gf = gi + 32;
    const int dv = tid >> 1, half = tid & 1;
    for (int item = vcu; item < NSEQ * 8; item += G) {
        const int b = item >> 3, hd = (item >> 1) & 3, dir = item & 1;
        bf16* HO = (bf16*)(ws + (dir ? WS_HB : WS_HF));
        float C[64], nn[64]; float m = 0.f;
#pragma unroll
        for (int j = 0; j < 64; ++j) { C[j] = 0.f; nn[j] = 0.f; }
        for (int p0 = 0; p0 < SEQ; p0 += 32) {
            __syncthreads();
            { const int rr = tid >> 4, c8 = (tid & 15) * 8; const int tok = dir ? (SEQ - 1 - (p0 + rr)) : (p0 + rr); const size_t row = (size_t)b * SEQ + tok;
              const v4u q4 = *(const v4u*)(MQ + row * 512 + hd * 128 + c8), k4 = *(const v4u*)(MK + row * 512 + hd * 128 + c8);
              LAS float* kd = ks + rr * 128 + c8;
              { LAS float* qa = qs + rr * 128 + (c8 & ~8) + ((c8 & 8) >> 1);   qa[0] = bflo(q4.x); qa[1] = bfhi(q4.x); qa[2] = bflo(q4.y); qa[3] = bfhi(q4.y); qa[8] = bflo(q4.z); qa[9] = bfhi(q4.z); qa[10] = bflo(q4.w); qa[11] = bfhi(q4.w); }
              kd[0] = bflo(k4.x); kd[1] = bfhi(k4.x); kd[2] = bflo(k4.y); kd[3] = bfhi(k4.y); kd[4] = bflo(k4.z); kd[5] = bfhi(k4.z); kd[6] = bflo(k4.w); kd[7] = bfhi(k4.w);
              const int c16 = (tid & 15) * 16; LAS float* vd = vs + rr * 256 + c16;
#pragma unroll
              for (int h2 = 0; h2 < 2; ++h2) { const v4u v4 = *(const v4u*)(MV + row * 1024 + hd * 256 + c16 + 8 * h2);
                  vd[8 * h2 + 0] = bflo(v4.x); vd[8 * h2 + 1] = bfhi(v4.x); vd[8 * h2 + 2] = bflo(v4.y); vd[8 * h2 + 3] = bfhi(v4.y); vd[8 * h2 + 4] = bflo(v4.z); vd[8 * h2 + 5] = bfhi(v4.z); vd[8 * h2 + 6] = bflo(v4.w); vd[8 * h2 + 7] = bfhi(v4.w); }
              if (tid < 32) { const int tk = dir ? (SEQ - 1 - (p0 + tid)) : (p0 + tid); const size_t rw = (size_t)b * SEQ + tk; gi[tid] = GT[rw * 16 + dir * 8 + hd]; gf[tid] = GT[rw * 16 + dir * 8 + 4 + hd]; }
            }
            __syncthreads();
            for (int pp = 0; pp < 32; ++pp) {
                const float lf = gf[pp], ii = gi[pp];
                const float mn = fmaxf(lf + m, ii);
                const float ca = expf(lf + m - mn), cb = expf(ii - mn);
                const float bv = cb * vs[pp * 256 + dv];
                float hp = 0.f, qn = 0.f;
                const LAS float* kr = ks + pp * 128 + 64 * half; const LAS float* qr = qs + pp * 128 + 64 * half;
#pragma unroll
                for (int j = 0; j < 64; ++j) { const float kk = kr[j], qq = qr[j];
                    C[j] = fmaf(ca, C[j], kk * bv); nn[j] = fmaf(ca, nn[j], cb * kk); hp = fmaf(qq, C[j], hp); qn = fmaf(qq, nn[j], qn); }
                hp += __shfl_xor(hp, 1); qn += __shfl_xor(qn, 1);
                const float den = fmaxf(fabsf(qn), expf(-mn));
                if (half == 0) { const int pos = p0 + pp, cch = pos >> 6, o = pos & 63, tt = o >> 5, rho = o & 31, q = rho >> 3, hh = (rho >> 2) & 1, e = rho & 3;
                    HO[(((size_t)((b * 4 + hd) * 32 + cch) * 32768) + (dv >> 5) * 4096 + tt * 2048 + (q >> 1) * 1024 + (32 * hh + (dv & 31)) * 16) / 2 + 4 * (q & 1) + e] = (bf16)f2bf(hp / den); }
                m = mn;
            }
        }
    }
}

__device__ __forceinline__ void p5_mlstm_finalize(const Args& a, LAS unsigned char* lds, int vcu, int G, int tid, int wave, int lane) {
    unsigned char* ws = a.ws; const float* mg = a.in[7];
    const bf16* MO = (const bf16*)(ws + WS_MO); const bf16* MZ = (const bf16*)(ws + WS_MZ); bf16* MIX = (bf16*)(ws + WS_MIX);
    LAS float* XS = (LAS float*)lds;
    const int r31 = lane & 31, h5 = lane >> 5, dv0 = 8 * r31;
    constexpr int NIT = NSEQ * 4 * 32;
    v4u f[2][2], bb[2][2];
#define P5_LOAD_H(item_) do { const int bh_ = (item_) >> 5, ck_ = (item_) & 31; \
        const unsigned char* hf_ = ws + WS_HF + ((size_t)bh_ * 32 + ck_) * 32768 + wave * 4096 + lane * 16; const unsigned char* hb_ = ws + WS_HB + ((size_t)bh_ * 32 + (31 - ck_)) * 32768 + wave * 4096 + (lane ^ 32) * 16; \
        _Pragma("unroll") for (int tt = 0; tt < 2; ++tt) _Pragma("unroll") for (int qp = 0; qp < 2; ++qp) { f[tt][qp] = *(const v4u*)(hf_ + tt * 2048 + qp * 1024); bb[tt][qp] = *(const v4u*)(hb_ + (1 - tt) * 2048 + (1 - qp) * 1024); } } while (0)
    if (vcu < NIT) P5_LOAD_H(vcu);
    for (int item = vcu; item < NIT; item += G) {
        const int bh = item >> 5, ck = item & 31, b = bh >> 2, hd = bh & 3;
        v4u mo[4], mz[4];
#pragma unroll
        for (int it = 0; it < 4; ++it) { const int o = it * 16 + wave * 2 + h5; const size_t row = (size_t)b * SEQ + ck * 64 + o;
            mo[it] = *(const v4u*)(MO + row * 1024 + hd * 256 + dv0); mz[it] = *(const v4u*)(MZ + row * 1024 + hd * 256 + dv0); }
        __syncthreads();
#pragma unroll
        for (int tt = 0; tt < 2; ++tt)
#pragma unroll
            for (int qp = 0; qp < 2; ++qp) { const v4u fv = f[tt][qp], bv = bb[tt][qp];
                float fs[8] = {bflo(fv.x), bfhi(fv.x), bflo(fv.y), bfhi(fv.y), bflo(fv.z), bfhi(fv.z), bflo(fv.w), bfhi(fv.w)};
                float bs[8] = {bflo(bv.x), bfhi(bv.x), bflo(bv.y), bfhi(bv.y), bflo(bv.z), bfhi(bv.z), bflo(bv.w), bfhi(bv.w)};
#pragma unroll
                for (int j = 0; j < 8; ++j) { const int o = 32 * tt + 8 * (2 * qp + (j >> 2)) + 4 * h5 + (j & 3); XS[o * 256 + 32 * wave + r31] = fs[j] + bs[7 - j]; } }
        __syncthreads();
        if (item + G < NIT) P5_LOAD_H(item + G);
        const f32x4 g0 = *(const f32x4*)(mg + hd * 256 + dv0), g1 = *(const f32x4*)(mg + hd * 256 + dv0 + 4);
        const float gg[8] = {g0[0], g0[1], g0[2], g0[3], g1[0], g1[1], g1[2], g1[3]};
#pragma unroll
        for (int it = 0; it < 4; ++it) { const int o = it * 16 + wave * 2 + h5; const size_t row = (size_t)b * SEQ + ck * 64 + o;
            const f32x4 x0 = *(const LAS f32x4*)(XS + o * 256 + dv0), x1 = *(const LAS f32x4*)(XS + o * 256 + dv0 + 4);
            float hm[8] = {x0[0], x0[1], x0[2], x0[3], x1[0], x1[1], x1[2], x1[3]};
            const float mo8[8] = {bflo(mo[it].x), bfhi(mo[it].x), bflo(mo[it].y), bfhi(mo[it].y), bflo(mo[it].z), bfhi(mo[it].z), bflo(mo[it].w), bfhi(mo[it].w)};
            const float mz8[8] = {bflo(mz[it].x), bfhi(mz[it].x), bflo(mz[it].y), bfhi(mz[it].y), bflo(mz[it].z), bfhi(mz[it].z), bflo(mz[it].w), bfhi(mz[it].w)};
            float ss = 0.f;
#pragma unroll
            for (int j = 0; j < 8; ++j) { hm[j] = hm[j] * __builtin_amdgcn_rcpf(1.f + __expf(-mo8[j])); ss += hm[j] * hm[j]; }
#pragma unroll
            for (int s = 1; s < 32; s <<= 1) ss += __shfl_xor(ss, s);
            const float r = __builtin_amdgcn_rsqf(ss * (1.f / 256.f) + EPS);
            float ov[8];
#pragma unroll
            for (int j = 0; j < 8; ++j) ov[j] = hm[j] * r * gg[j] * (mz8[j] * __builtin_amdgcn_rcpf(1.f + __expf(-mz8[j])));
            v4u w; w.x = pk2(ov[0], ov[1]); w.y = pk2(ov[2], ov[3]); w.z = pk2(ov[4], ov[5]); w.w = pk2(ov[6], ov[7]);
            *(v4u*)(MIX + row * 2048 + 1024 + hd * 256 + dv0) = w; }
    }
#undef P5_LOAD_H
    __syncthreads();
}

__device__ __forceinline__ void p5_item(const Args& a, LAS unsigned char* lds, int item) {
    int tid_ = threadIdx.x; asm volatile("" : "+v"(tid_));
    const int lane = tid_ & 63, wave = __builtin_amdgcn_readfirstlane(tid_ >> 6);
    unsigned char* ws = a.ws; const float* mg = a.in[7];
    const bf16* MO = (const bf16*)(ws + WS_MO); const bf16* MZ = (const bf16*)(ws + WS_MZ); bf16* MIX = (bf16*)(ws + WS_MIX);
    LAS float* XS = (LAS float*)lds; const int r31 = lane & 31, h5 = lane >> 5, dv0 = 8 * r31;
    const int bh = item >> 5, ck = item & 31, b = bh >> 2, hd = bh & 3;
    const unsigned char* hf_ = ws + WS_HF + ((size_t)bh * 32 + ck) * 32768 + wave * 4096 + lane * 16; const unsigned char* hb_ = ws + WS_HB + ((size_t)bh * 32 + (31 - ck)) * 32768 + wave * 4096 + (lane ^ 32) * 16;
    v4u f[2][2], bb[2][2], mo[4], mz[4];
#pragma unroll
    for (int tt = 0; tt < 2; ++tt)
#pragma unroll
        for (int qp = 0; qp < 2; ++qp) { f[tt][qp] = *(const v4u*)(hf_ + tt * 2048 + qp * 1024); bb[tt][qp] = *(const v4u*)(hb_ + (1 - tt) * 2048 + (1 - qp) * 1024); }
#pragma unroll
    for (int it = 0; it < 4; ++it) { const int o = it * 16 + wave * 2 + h5; const size_t row = (size_t)b * SEQ + ck * 64 + o;
        mo[it] = *(const v4u*)(MO + row * 1024 + hd * 256 + dv0); mz[it] = *(const v4u*)(MZ + row * 1024 + hd * 256 + dv0); }
    __syncthreads();
#pragma unroll
    for (int tt = 0; tt < 2; ++tt)
#pragma unroll
        for (int qp = 0; qp < 2; ++qp) { const v4u fv = f[tt][qp], bv = bb[tt][qp];
            float fs[8] = {bflo(fv.x), bfhi(fv.x), bflo(fv.y), bfhi(fv.y), bflo(fv.z), bfhi(fv.z), bflo(fv.w), bfhi(fv.w)};
            float bs[8] = {bflo(bv.x), bfhi(bv.x), bflo(bv.y), bfhi(bv.y), bflo(bv.z), bfhi(bv.z), bflo(bv.w), bfhi(bv.w)};
#pragma unroll
            for (int j = 0; j < 8; ++j) { const int o = 32 * tt + 8 * (2 * qp + (j >> 2)) + 4 * h5 + (j & 3); XS[o * 256 + 32 * wave + r31] = fs[j] + bs[7 - j]; } }
    __syncthreads();
    const f32x4 g0 = *(const f32x4*)(mg + hd * 256 + dv0), g1 = *(const f32x4*)(mg + hd * 256 + dv0 + 4);
    const float gg[8] = {g0[0], g0[1], g0[2], g0[3], g1[0], g1[1], g1[2], g1[3]};
#pragma unroll
    for (int it = 0; it < 4; ++it) { const int o = it * 16 + wave * 2 + h5; const size_t row = (size_t)b * SEQ + ck * 64 + o;
        const f32x4 x0 = *(const LAS f32x4*)(XS + o * 256 + dv0), x1 = *(const LAS f32x4*)(XS + o * 256 + dv0 + 4);
        float hm[8] = {x0[0], x0[1], x0[2], x0[3], x1[0], x1[1], x1[2], x1[3]};
        const float mo8[8] = {bflo(mo[it].x), bfhi(mo[it].x), bflo(mo[it].y), bfhi(mo[it].y), bflo(mo[it].z), bfhi(mo[it].z), bflo(mo[it].w), bfhi(mo[it].w)};
        const float mz8[8] = {bflo(mz[it].x), bfhi(mz[it].x), bflo(mz[it].y), bfhi(mz[it].y), bflo(mz[it].z), bfhi(mz[it].z), bflo(mz[it].w), bfhi(mz[it].w)};
        float ss = 0.f;
#pragma unroll
        for (int j = 0; j < 8; ++j) { hm[j] = hm[j] * __builtin_amdgcn_rcpf(1.f + __expf(-mo8[j])); ss += hm[j] * hm[j]; }
#pragma unroll
        for (int s = 1; s < 32; s <<= 1) ss += __shfl_xor(ss, s);
        const float r = __builtin_amdgcn_rsqf(ss * (1.f / 256.f) + EPS);
        float ov[8];
#pragma unroll
        for (int j = 0; j < 8; ++j) ov[j] = hm[j] * r * gg[j] * (mz8[j] * __builtin_amdgcn_rcpf(1.f + __expf(-mz8[j])));
        v4u w; w.x = pk2(ov[0], ov[1]); w.y = pk2(ov[2], ov[3]); w.z = pk2(ov[4], ov[5]); w.w = pk2(ov[6], ov[7]);
        *(v4u*)(MIX + row * 2048 + 1024 + hd * 256 + dv0) = w; }
    __syncthreads();
}

__device__ __forceinline__ void p5_batch(const Args& a, LAS unsigned char* lds, int first, int count) {
    if (count <= 0) return;
    int tid_ = threadIdx.x; asm volatile("" : "+v"(tid_));
    const int lane = tid_ & 63, wave = __builtin_amdgcn_readfirstlane(tid_ >> 6);
    unsigned char* ws = a.ws; const float* mg = a.in[7];
    const bf16* MO = (const bf16*)(ws + WS_MO); const bf16* MZ = (const bf16*)(ws + WS_MZ); bf16* MIX = (bf16*)(ws + WS_MIX);
    LAS float* XS = (LAS float*)lds; const int r31 = lane & 31, h5 = lane >> 5, dv0 = 8 * r31;
    v4u f[2][2], bb[2][2], mo[4], mz[4], mon[4], mzn[4];
#define P5B_LOAD_H(item_) do { const int bh_ = (item_) >> 5, ck_ = (item_) & 31; \
        const unsigned char* hf_ = ws + WS_HF + ((size_t)bh_ * 32 + ck_) * 32768 + wave * 4096 + lane * 16; const unsigned char* hb_ = ws + WS_HB + ((size_t)bh_ * 32 + (31 - ck_)) * 32768 + wave * 4096 + (lane ^ 32) * 16; \
        _Pragma("unroll") for (int tt = 0; tt < 2; ++tt) _Pragma("unroll") for (int qp = 0; qp < 2; ++qp) { f[tt][qp] = *(const v4u*)(hf_ + tt * 2048 + qp * 1024); bb[tt][qp] = *(const v4u*)(hb_ + (1 - tt) * 2048 + (1 - qp) * 1024); } } while (0)
#define P5B_LOAD_G(item_, MO_, MZ_) do { const int bh_ = (item_) >> 5, ck_ = (item_) & 31, b_ = bh_ >> 2, hd_ = bh_ & 3; \
        _Pragma("unroll") for (int it = 0; it < 4; ++it) { const int o_ = it * 16 + wave * 2 + h5; const size_t row_ = (size_t)b_ * SEQ + ck_ * 64 + o_; \
            MO_[it] = *(const v4u*)(MO + row_ * 1024 + hd_ * 256 + dv0); MZ_[it] = *(const v4u*)(MZ + row_ * 1024 + hd_ * 256 + dv0); } } while (0)
    P5B_LOAD_H(first); P5B_LOAD_G(first, mo, mz);
    for (int i = 0; i < count; ++i) {
        const int item = first + i, bh = item >> 5, ck = item & 31, b = bh >> 2, hd = bh & 3;
        __syncthreads();
#pragma unroll
        for (int tt = 0; tt < 2; ++tt)
#pragma unroll
            for (int qp = 0; qp < 2; ++qp) { const v4u fv = f[tt][qp], bv = bb[tt][qp];
                float fs[8] = {bflo(fv.x), bfhi(fv.x), bflo(fv.y), bfhi(fv.y), bflo(fv.z), bfhi(fv.z), bflo(fv.w), bfhi(fv.w)};
                float bs[8] = {bflo(bv.x), bfhi(bv.x), bflo(bv.y), bfhi(bv.y), bflo(bv.z), bfhi(bv.z), bflo(bv.w), bfhi(bv.w)};
#pragma unroll
                for (int j = 0; j < 8; ++j) { const int o = 32 * tt + 8 * (2 * qp + (j >> 2)) + 4 * h5 + (j & 3); XS[o * 256 + 32 * wave + r31] = fs[j] + bs[7 - j]; } }
        __syncthreads();
        if (i + 1 < count) { P5B_LOAD_H(item + 1); P5B_LOAD_G(item + 1, mon, mzn); }
        const f32x4 g0 = *(const f32x4*)(mg + hd * 256 + dv0), g1 = *(const f32x4*)(mg + hd * 256 + dv0 + 4);
        const float gg[8] = {g0[0], g0[1], g0[2], g0[3], g1[0], g1[1], g1[2], g1[3]};
#pragma unroll
        for (int it = 0; it < 4; ++it) { const int o = it * 16 + wave * 2 + h5; const size_t row = (size_t)b * SEQ + ck * 64 + o;
            const f32x4 x0 = *(const LAS f32x4*)(XS + o * 256 + dv0), x1 = *(const LAS f32x4*)(XS + o * 256 + dv0 + 4);
            float hm[8] = {x0[0], x0[1], x0[2], x0[3], x1[0], x1[1], x1[2], x1[3]};
            const float mo8[8] = {bflo(mo[it].x), bfhi(mo[it].x), bflo(mo[it].y), bfhi(mo[it].y), bflo(mo[it].z), bfhi(mo[it].z), bflo(mo[it].w), bfhi(mo[it].w)};
            const float mz8[8] = {bflo(mz[it].x), bfhi(mz[it].x), bflo(mz[it].y), bfhi(mz[it].y), bflo(mz[it].z), bfhi(mz[it].z), bflo(mz[it].w), bfhi(mz[it].w)};
            float ss = 0.f;
#pragma unroll
            for (int j = 0; j < 8; ++j) { hm[j] = hm[j] * __builtin_amdgcn_rcpf(1.f + __expf(-mo8[j])); ss += hm[j] * hm[j]; }
#pragma unroll
            for (int s = 1; s < 32; s <<= 1) ss += __shfl_xor(ss, s);
            const float r = __builtin_amdgcn_rsqf(ss * (1.f / 256.f) + EPS);
            float ov[8];
#pragma unroll
            for (int j = 0; j < 8; ++j) ov[j] = hm[j] * r * gg[j] * (mz8[j] * __builtin_amdgcn_rcpf(1.f + __expf(-mz8[j])));
            v4u w; w.x = pk2(ov[0], ov[1]); w.y = pk2(ov[2], ov[3]); w.z = pk2(ov[4], ov[5]); w.w = pk2(ov[6], ov[7]);
            *(v4u*)(MIX + row * 2048 + 1024 + hd * 256 + dv0) = w; }
#pragma unroll
        for (int it = 0; it < 4; ++it) { mo[it] = mon[it]; mz[it] = mzn[it]; }
    }
#undef P5B_LOAD_H
#undef P5B_LOAD_G
    __syncthreads();
}

__device__ __forceinline__ void gate_rows48(unsigned char* ws, const float* b_gates, int row0, int lane) {
    typedef short bf16x8 __attribute__((ext_vector_type(8)));
    const int r15 = lane & 15, kg = lane >> 4;
    const bf16* a0p = (const bf16*)(ws + WS_H) + (size_t)(row0 + r15) * DM + 8 * kg; const bf16* a1p = a0p + 16 * DM; const bf16* a2p = a0p + 32 * DM;
    const bf16* bp = (const bf16*)(ws + WS_W1T) + (size_t)(NP256 + r15) * DM + 8 * kg;
    f32x4 acc0 = {0.f, 0.f, 0.f, 0.f}, acc1 = {0.f, 0.f, 0.f, 0.f}, acc2 = {0.f, 0.f, 0.f, 0.f};
#pragma unroll 8
    for (int ks = 0; ks < DM / 32; ++ks) { const bf16x8 a0 = *(const bf16x8*)(a0p + 32 * ks), a1 = *(const bf16x8*)(a1p + 32 * ks), a2 = *(const bf16x8*)(a2p + 32 * ks), b = *(const bf16x8*)(bp + 32 * ks);
        acc0 = __builtin_amdgcn_mfma_f32_16x16x32_bf16(a0, b, acc0, 0, 0, 0); acc1 = __builtin_amdgcn_mfma_f32_16x16x32_bf16(a1, b, acc1, 0, 0, 0); acc2 = __builtin_amdgcn_mfma_f32_16x16x32_bf16(a2, b, acc2, 0, 0, 0); }
    const float bias = b_gates[r15]; const bool isf = (r15 >> 2) & 1; float* G = (float*)(ws + WS_GATES) + (size_t)(row0 + 4 * kg) * 16 + r15;
#pragma unroll
    for (int r = 0; r < 4; ++r) { float v0 = acc0[r] + bias, v1 = acc1[r] + bias, v2 = acc2[r] + bias; if (isf) { v0 = log_sigmoid_f(v0); v1 = log_sigmoid_f(v1); v2 = log_sigmoid_f(v2); }
        G[r * 16] = v0; G[(16 + r) * 16] = v1; G[(32 + r) * 16] = v2; }
}

constexpr int N_PHASES = 7;
__global__ void __launch_bounds__(NWAVES * 64, 2) hy_fwd(Args args) {
    extern __shared__ __attribute__((aligned(16))) unsigned char lds_raw[];
    LAS unsigned char* lds = (LAS unsigned char*)lds_raw;
    const int tid = threadIdx.x, lane = tid & 63, wave = __builtin_amdgcn_readfirstlane(tid >> 6);
    const int G = gridDim.x; const int bx = blockIdx.x; const int vcu = (G % 8 == 0) ? (bx % 8) * (G / 8) + bx / 8 : bx;
    unsigned char* ws = args.ws;
    const int lo = args.ph_lo, hi = args.ph_hi;
    unsigned* ctl = (unsigned*)(ws + WS_CTL);
    volatile LAS unsigned* bst = (volatile LAS unsigned*)(lds + LDS_BYTES - 16);
    if (tid == 0) { bst[0] = 0u; bst[1] = 0u; }
    __syncthreads();
    XcdBarrier xbar; xbar.bar = ctl + CW_BAR; xbar.x = 0; xbar.st = bst; bool xposted = false;
    const bool one_launch = (lo == 0 && hi == N_PHASES);
    if (one_launch) { xbar = xcd_barrier_post(ctl + CW_BAR, bst); xposted = true; }
#ifndef HY_PHASE_MASK
#define HY_PHASE_MASK 0x7f
#endif
#define IN(k) (((HY_PHASE_MASK >> (k)) & 1) && lo <= (k) && (k) < hi)
#define BOTH(k) (IN(k) && IN((k) + 1))
#ifndef HY_DUP_MASK
#define HY_DUP_MASK 0
#endif
#ifndef HY_PROBE_NULL
#define HY_PROBE_NULL 0
#endif
#ifndef HY_ML_PROBE_MODE
#define HY_ML_PROBE_MODE 0
#endif
#define DUP(k) (((HY_DUP_MASK) >> (k)) & 1)
#define GRID_BAR_CG() do { cg::this_grid().sync(); } while (0)
#define GRID_BAR() do { if (!xposted) { xbar = xcd_barrier_post(ctl + CW_BAR, bst); xposted = true; } xcd_barrier(xbar); } while (0)

    if (IN(0) && DUP(0)) { p0_prologue(args, lds, vcu, G, tid, wave, lane); __syncthreads(); }
    if (IN(0)) { p0_prologue(args, lds, vcu, G, tid, wave, lane); if (BOTH(0)) GRID_BAR(); }

    if (IN(1) && DUP(1)) {
        { const float* Rg = (const float*)(ws + WS_ROPE); LAS float* Rl = (LAS float*)(lds + ROPE_LDS_OFF); LAS float* Gl = (LAS float*)(lds + QKG_LDS_OFF);
          for (int e = tid; e < 64 * 32 * 2; e += NWAVES * 64) Rl[e] = Rg[e];
          if (tid < 128) { Gl[tid] = args.in[5][tid]; Gl[128 + tid] = args.in[6][tid]; }
          __syncthreads(); }
        pg8::Gemm g{(const pg8::bf16_t*)(ws + WS_H), (const pg8::bf16_t*)(ws + WS_W1T), NTOK, NP256, DM}; pg8::StaticOrder S; S.init(NTOK, NP256, G, bx);
#if HY_PROBE_NULL
        pg8::EpiNull E{}; pg8::gemm_phase<pg8::EpiNull, pg8::StaticOrder, true, true>(lds, g, S, E);
#else
        pg8::EpiProj E{ws, (PG8_LAS float*)(lds + XCH_OFF), (PG8_LAS float*)(lds + ROPE_LDS_OFF), (PG8_LAS float*)(lds + QKG_LDS_OFF)};
        pg8::gemm_phase<pg8::EpiProj, pg8::StaticOrder, true, true>(lds, g, S, E);
#endif
        if (BOTH(1)) GRID_BAR();
    }

    if (IN(1)) {
        { const float* Rg = (const float*)(ws + WS_ROPE); LAS float* Rl = (LAS float*)(lds + ROPE_LDS_OFF); LAS float* Gl = (LAS float*)(lds + QKG_LDS_OFF);
          for (int e = tid; e < 64 * 32 * 2; e += NWAVES * 64) Rl[e] = Rg[e];
          if (tid < 128) { Gl[tid] = args.in[5][tid]; Gl[128 + tid] = args.in[6][tid]; }
          __syncthreads(); }
        pg8::Gemm g{(const pg8::bf16_t*)(ws + WS_H), (const pg8::bf16_t*)(ws + WS_W1T), NTOK, NP256, DM}; pg8::StaticOrder S; S.init(NTOK, NP256, G, bx);
        pg8::EpiProj E{ws, (PG8_LAS float*)(lds + XCH_OFF), (PG8_LAS float*)(lds + ROPE_LDS_OFF), (PG8_LAS float*)(lds + QKG_LDS_OFF)};
        pg8::gemm_phase<pg8::EpiProj, pg8::StaticOrder, true, true>(lds, g, S, E);
        { const int nun = (NTOK / 256) * (NP256 / 256), full = nun / G, rem = nun - full * G, light = G - rem;
          if (bx >= rem) for (int it = (bx - rem) * NWAVES + wave; it < NTOK / 48; it += light * NWAVES) gate_rows48(ws, args.in[4], it * 48, lane); }
        if (BOTH(1)) GRID_BAR();
    }

#if HY_SEPARATE_ROPE
    if (IN(2)) { p2_qknorm_rope(args, vcu, G, wave, lane); if (BOTH(2)) GRID_BAR(); }
#endif

#define ATTN_UNIT(grp_, w_) do { const int b_ = (grp_) >> 1, kvh_ = (grp_) & 1, h_ = kvh_ * 4 + ((w_) >> 3), qb_ = (w_) & 7; const size_t row0_ = (size_t)b_ * SEQ + qb_ * 256; \
        bf16* Q_ = (bf16*)(ws + WS_MIX) + row0_ * 2048 + h_ * 128; const attn::bf16* K_ = (const attn::bf16*)(ws + WS_AK) + (size_t)b_ * SEQ * 256 + kvh_ * 128; \
        const attn::bf16* V_ = (const attn::bf16*)(ws + WS_AV) + (size_t)b_ * SEQ * 256 + kvh_ * 128; const bf16* Z_ = (const bf16*)(ws + WS_AZ) + row0_ * 1024 + h_ * 128; \
        int seqv_ = SEQ; asm volatile("" : "+s"(seqv_)); attn::attn_dense_body<attn::bf16>((const attn::bf16*)Q_, K_, V_, Q_, Z_, seqv_, (char*)lds_raw); __syncthreads(); } while (0)
#if HY_SCHED_J
    const bool schedJ = one_launch && G == 256;
    if (schedJ) {
        const int xl = vcu >> 5, s = vcu & 31;
        if (s < 24) ml::mlstm_item<0>(ws, lds, xl * 24 + s, tid);
        else for (int j = 0; j < 2; ++j) ATTN_UNIT(xl, 2 * (s - 24) + j);
        GRID_BAR();
        const int n_rest = (s < 16) ? 6 : 5, n_p5 = (s < 16) ? 8 : 16, p5_0 = (s < 16) ? 8 * (xl * 16 + s) : 1024 + 16 * (xl * 16 + (s - 16));
        int p5_done = 0;
        for (int jr = 0; jr < n_rest; ++jr) {
            if ((jr & 1) == 0) { const int tgt = (n_p5 * ((jr >> 1) + 1)) / 3;
                p5_batch(args, lds, p5_0 + p5_done, tgt - p5_done); p5_done = tgt; }
            const int li = s + 32 * jr;
            const int grp = (li < 16) ? xl : xl + 8 * (1 + ((li - 16) >> 5)), w = (li < 16) ? 16 + li : (li - 16) & 31;
            ATTN_UNIT(grp, w);
        }
        GRID_BAR();
    }
#else
    const bool schedJ = false;
#endif

    if (!schedJ && IN(3)) {
        for (int u = vcu; u < NSEQ * 2 * 32; u += G) ATTN_UNIT(u >> 5, u & 31);
        if (BOTH(3)) GRID_BAR();
    }

    if (!schedJ && IN(4) && DUP(4)) {
#if HY_MLSTM_REF
        p4_mlstm_recurrent(args, lds, vcu, G, tid);
#else
        for (int item = vcu; item < NSEQ * 8; item += G) ml::mlstm_item<HY_ML_PROBE_MODE>(ws, lds, item, tid);
#endif
        if (BOTH(4)) GRID_BAR(); }

    if (!schedJ && IN(4)) {
#if HY_MLSTM_REF
        p4_mlstm_recurrent(args, lds, vcu, G, tid);
#else
        for (int item = vcu; item < NSEQ * 8; item += G) ml::mlstm_item<0>(ws, lds, item, tid);
#endif
        if (BOTH(4)) GRID_BAR(); }

    if (!schedJ && IN(5) && DUP(5)) { p5_mlstm_finalize(args, lds, vcu, G, tid, wave, lane); }
    if (!schedJ && IN(5)) { p5_mlstm_finalize(args, lds, vcu, G, tid, wave, lane); if (BOTH(5)) GRID_BAR(); }

    if (IN(6) && DUP(6)) {
        pg8::Gemm g{(const pg8::bf16_t*)(ws + WS_MIX), (const pg8::bf16_t*)(ws + WS_W2T), NTOK, DM, DM}; pg8::StaticOrder S; S.init(NTOK, DM, G, bx);
        pg8::EpiOut E{args.in[0], args.in[1], args.out};
        pg8::gemm_phase<pg8::EpiOut, pg8::StaticOrder, true, true>(lds, g, S, E);
    }
    if (IN(6)) {
        pg8::Gemm g{(const pg8::bf16_t*)(ws + WS_MIX), (const pg8::bf16_t*)(ws + WS_W2T), NTOK, DM, DM}; pg8::StaticOrder S; S.init(NTOK, DM, G, bx);
        pg8::EpiOut E{args.in[0], args.in[1], args.out};
        pg8::gemm_phase<pg8::EpiOut, pg8::StaticOrder, true, true>(lds, g, S, E);
    }
    if (one_launch && lo < 0) GRID_BAR_CG();
#undef IN
#undef BOTH
}

extern "C" void kernel_launch(void* const* d_in, const int* in_sizes, int n_in, void* d_out, int out_size, void* d_ws, size_t ws_size, hipStream_t stream) {
    static int grid = 0;
    if (grid == 0) {
        if (n_in != 9 || in_sizes[0] != TOK_PROMPT * DM || in_sizes[1] != (NTOK - TOK_PROMPT) * DM || out_size != NTOK * DM || ws_size < WS_END) {
            fprintf(stderr, "kernel_launch: shape mismatch n_in %d in0 %d in1 %d out %d ws %zu (need %zu)\n", n_in, n_in > 0 ? in_sizes[0] : -1, n_in > 1 ? in_sizes[1] : -1, out_size, ws_size, (size_t)WS_END); grid = -1; return; }
        int dev = 0, cus = 0, per_cu = 0;
        if (hipGetDevice(&dev) != hipSuccess || hipDeviceGetAttribute(&cus, hipDeviceAttributeMultiprocessorCount, dev) != hipSuccess) { fprintf(stderr, "kernel_launch: device query failed\n"); grid = -1; return; }
        if (hipFuncSetAttribute((const void*)hy_fwd, hipFuncAttributeMaxDynamicSharedMemorySize, LDS_BYTES) != hipSuccess) { fprintf(stderr, "kernel_launch: hipFuncSetAttribute failed\n"); grid = -1; return; }
        if (hipOccupancyMaxActiveBlocksPerMultiprocessor(&per_cu, (const void*)hy_fwd, NWAVES * 64, LDS_BYTES) != hipSuccess || per_cu < 1) { fprintf(stderr, "kernel_launch: occupancy query says %d\n", per_cu); per_cu = 1; }
        (void)hipGetLastError();
        grid = cus;
    }
    if (grid < 0) return;
    if (hipMemsetAsync((char*)d_ws + WS_CTL, 0, 65536, stream) != hipSuccess) { fprintf(stderr, "kernel_launch: hipMemsetAsync of the control words failed\n"); return; }
    Args a{};
    for (int i = 0; i < 9; ++i) a.in[i] = (const float*)d_in[i];
    a.out = (float*)d_out; a.ws = (unsigned char*)d_ws;
#if HY_N_LAUNCHES == 1
    a.ph_lo = 0; a.ph_hi = N_PHASES;
    void* kargs[] = {&a};
    hipError_t e = hipLaunchCooperativeKernel((const void*)hy_fwd, dim3(grid), dim3(NWAVES * 64), kargs, LDS_BYTES, stream);
    if (e != hipSuccess) fprintf(stderr, "kernel_launch: cooperative launch failed: %s (grid %d)\n", hipGetErrorString(e), grid);
#else
    for (int p = 0; p < N_PHASES; ++p) {
        a.ph_lo = p; a.ph_hi = p + 1;
        hipLaunchKernelGGL(hy_fwd, dim3(grid), dim3(NWAVES * 64), LDS_BYTES, stream, a);
        const hipError_t le = hipPeekAtLastError();
        if (le != hipSuccess) { fprintf(stderr, "kernel_launch: launch %d failed: %s\n", p, hipGetErrorName(le)); break; }
    }
#endif
}
```

```cpp
#include <hip/hip_runtime.h>
#include <hip/hip_bf16.h>
#include <hip/hip_cooperative_groups.h>
#include <cstdio>
#include <cstdint>
#include <cmath>
namespace cg = cooperative_groups;

#ifndef HY_SEPARATE_ROPE
#define HY_SEPARATE_ROPE 0
#endif
#ifndef HY_SCHED_J
#define HY_SCHED_J 1
#endif
#ifndef HY_MLSTM_REF
#define HY_MLSTM_REF 0
#endif
#ifndef HY_N_LAUNCHES
#define HY_N_LAUNCHES 1
#endif

constexpr int SEQ = 2048, NSEQ = 24, NTOK = NSEQ * SEQ, TOK_PROMPT = 8 * SEQ, DM = 2048;
constexpr int NPROJ = 6672, NP256 = 6656;
constexpr float EPS = 1e-6f;

constexpr size_t MiB = 1u << 20;
constexpr size_t WS_CTL = 0, CTL_ZERO_BYTES = 1 * MiB;
constexpr int CW_BAR = 4096, CW_QUEUE = 8192;
constexpr size_t WS_ROPE = 1 * MiB;
constexpr size_t WS_W1T = 2 * MiB;
constexpr size_t WS_W2T = 30 * MiB;
constexpr size_t WS_GATES = 38 * MiB;
constexpr size_t WS_H = 42 * MiB;
constexpr size_t WS_HF = WS_H, WS_HB = WS_H + 96 * MiB;
constexpr size_t WS_MIX = 234 * MiB;
constexpr size_t WS_AK = 426 * MiB, WS_AV = 450 * MiB;
constexpr size_t WS_AZ = 474 * MiB;
constexpr size_t WS_MQ = 570 * MiB, WS_MK = 618 * MiB;
constexpr size_t WS_MV = 666 * MiB, WS_MO = 762 * MiB, WS_MZ = 858 * MiB;
constexpr size_t WS_END = 954 * MiB;

typedef unsigned short bf16;
__device__ __forceinline__ unsigned f2bf(float f) { unsigned u = __builtin_bit_cast(unsigned, f); return (u + 0x7fffu + ((u >> 16) & 1u)) >> 16; }
__device__ __forceinline__ unsigned pk2(float lo, float hi) { return f2bf(lo) | (f2bf(hi) << 16); }
__device__ __forceinline__ float bf2f(unsigned short b) { return __builtin_bit_cast(float, (unsigned)b << 16); }
__device__ __forceinline__ float bflo(unsigned w) { return __builtin_bit_cast(float, w << 16); }
__device__ __forceinline__ float bfhi(unsigned w) { return __builtin_bit_cast(float, w & 0xffff0000u); }
constexpr int NF8 = 2560;
constexpr float H8_SCALE = 8.f, W8_SCALE = 512.f;
__device__ __forceinline__ unsigned pk4f8(float a, float b, float c, float d) {
    a = __builtin_fminf(__builtin_fmaxf(a, -448.f), 448.f); b = __builtin_fminf(__builtin_fmaxf(b, -448.f), 448.f); c = __builtin_fminf(__builtin_fmaxf(c, -448.f), 448.f); d = __builtin_fminf(__builtin_fmaxf(d, -448.f), 448.f);
    int w = 0; w = __builtin_amdgcn_cvt_pk_fp8_f32(a, b, w, false); w = __builtin_amdgcn_cvt_pk_fp8_f32(c, d, w, true); return (unsigned)w; }
__device__ __forceinline__ float log_sigmoid_f(float x) { return x >= 0.f ? -log1pf(expf(-x)) : x - log1pf(expf(x)); }
namespace pg8 {
#define PG8_LAS __attribute__((address_space(3)))
typedef unsigned short bf16_t;
typedef short bf16x8 __attribute__((ext_vector_type(8)));
typedef float f32x4 __attribute__((ext_vector_type(4)));
typedef unsigned u32x4 __attribute__((ext_vector_type(4)));
typedef int i32x4 __attribute__((ext_vector_type(4)));
constexpr int BM = 256, BK = 64, HALF = 128, HTB = HALF * BK * 2  , STAGE_BYTES = 8 * HTB, NXCD = 8, WGM = 8;

__host__ __device__ __forceinline__ int lds_byte(int r, int c) { const int st = (r >> 4) * 2 + (c >> 5), rr = r & 15, cc = c & 31, ob = rr * 64 + cc * 2; return st * 1024 + (ob ^ (((ob >> 9) & 1) << 5)); }
__host__ __device__ __forceinline__ void stage_rc(int b, int& R, int& C) { const int st = b / 1024, sb = b % 1024, swz = sb ^ (((sb >> 9) & 1) << 5); R = (st >> 1) * 16 + swz / 64; C = (st & 1) * 32 + (swz % 64) / 2; }
__host__ __device__ __forceinline__ int perm32(int rho) { const int n = rho >> 4, i = rho & 15; return 8 * (i >> 2) + 4 * n + (i & 3); }

struct Unit { int pm, pn; };
struct Gemm { const bf16_t* A; const bf16_t* Bt; int M, N, K; };

struct StaticOrder {
    int nM, nN, nwg, G, c;
    __host__ __device__ void init(int M, int N, int G_, int c_) { nM = M / BM; nN = N / BM; nwg = nM * nN; G = G_; c = c_; }
    __host__ __device__ bool next(int i, Unit& u) const {
        const long L = (long)i * G + c; if (L >= nwg) return false;
        int wgid = (int)L; { const int q = nwg / NXCD, r = nwg % NXCD, xcd = wgid % NXCD, off = wgid / NXCD; wgid = (xcd < r ? xcd * (q + 1) : r * (q + 1) + (xcd - r) * q) + off; }
        const int nig = WGM * nN, gid = wgid / nig, fm = gid * WGM, gsz = (nM - fm) < WGM ? (nM - fm) : WGM;
        u.pm = fm + ((wgid % nig) % gsz); u.pn = (wgid % nig) / gsz; return true;
    }
    __device__ __forceinline__ void a_ready(const Unit&) const {}
    __device__ __forceinline__ void done(const Unit&) const {}
};


__device__ __forceinline__ unsigned cvt_pk_bf16(float lo, float hi) { unsigned r; asm volatile("v_cvt_pk_bf16_f32 %0, %1, %2" : "=v"(r) : "v"(lo), "v"(hi)); return r; }

template <int PN0, bool F8>
struct EpiProjT {
    static constexpr bool PERM = true, AFTER_DRAIN = false; static constexpr int NSTORE = 16;
    unsigned char* ws; PG8_LAS float* xch; PG8_LAS float* ropeL; PG8_LAS float* qkgL;
    __device__ __forceinline__ void operator()(const f32x4 (&acc)[2][2][4][2], const Unit& u, int wr, int wc, int fr, int fq) const {
        const int pn = u.pn + PN0; const int row0 = u.pm * BM + wr * 64 + fr;
        constexpr float SC = F8 ? (1.f / 4096.f) : 1.f;
        if (!HY_SEPARATE_ROPE && PN0 <= 4 && pn <= 4) {
            PG8_LAS float* gsrc = qkgL + ((pn < 4) ? 0 : 128); const int cb = 64 * (wc >> 1) + 16 * (wc & 1) + 4 * fq;
            const f32x4 g1 = *(const PG8_LAS f32x4*)(gsrc + cb), g2 = *(const PG8_LAS f32x4*)(gsrc + cb + 32);
#pragma unroll
            for (int ai = 0; ai < 2; ++ai)
#pragma unroll
                for (int m = 0; m < 4; ++m)
#pragma unroll
                    for (int bj = 0; bj < 2; ++bj) { const f32x4 a = acc[ai][bj][m][0] * SC, b = acc[ai][bj][m][1] * SC;
                        float s = ((a[0] * a[0] + a[1] * a[1]) + (a[2] * a[2] + a[3] * a[3])) + ((b[0] * b[0] + b[1] * b[1]) + (b[2] * b[2] + b[3] * b[3]));
                        s += __shfl_xor(s, 16); s += __shfl_xor(s, 32);
                        if (fq == 0) xch[((ai * HALF + wr * 64 + m * 16 + fr) * 2 + bj) * 4 + wc] = s; }
            asm volatile("s_waitcnt lgkmcnt(0)" ::: "memory"); __builtin_amdgcn_s_barrier(); asm volatile("" ::: "memory");
            bf16_t* base = (bf16_t*)(ws + (pn < 4 ? WS_MIX : WS_AK)); const int ldc = (pn < 4) ? 2048 : 256; const int colt = (pn < 4) ? pn * 256 : 0;
            PG8_LAS float* R = ropeL; const int j0 = 16 * (wc & 1) + 4 * fq;
#pragma unroll
            for (int ai = 0; ai < 2; ++ai)
#pragma unroll
                for (int m = 0; m < 4; ++m) { const int row = row0 + ai * HALF + m * 16; const int tl = row & (SEQ - 1); const int pos = (wc < 2) ? (tl >> 6) : (tl & 63);
                    const f32x4 cs0 = *(const PG8_LAS f32x4*)(R + (pos * 32 + j0) * 2), cs1 = *(const PG8_LAS f32x4*)(R + (pos * 32 + j0) * 2 + 4);
#pragma unroll
                    for (int bj = 0; bj < 2; ++bj) { const f32x4 pt = *(const PG8_LAS f32x4*)(xch + ((ai * HALF + wr * 64 + m * 16 + fr) * 2 + bj) * 4);
                        const float rstd = 1.f / sqrtf(((pt[0] + pt[1]) + (pt[2] + pt[3])) * (1.f / 128.f) + EPS);
                        const f32x4 y1 = acc[ai][bj][m][0] * (rstd * SC) * g1, y2 = acc[ai][bj][m][1] * (rstd * SC) * g2;
                        const float o10 = y1[0] * cs0[0] - y2[0] * cs0[1], o11 = y1[1] * cs0[2] - y2[1] * cs0[3], o12 = y1[2] * cs1[0] - y2[2] * cs1[1], o13 = y1[3] * cs1[2] - y2[3] * cs1[3];
                        const float o20 = y2[0] * cs0[0] + y1[0] * cs0[1], o21 = y2[1] * cs0[2] + y1[1] * cs0[3], o22 = y2[2] * cs1[0] + y1[2] * cs1[1], o23 = y2[3] * cs1[2] + y1[3] * cs1[3];
                        bf16_t* dst = base + (size_t)row * ldc + colt + bj * HALF + cb;
                        typedef unsigned u32x2v __attribute__((ext_vector_type(2)));
                        u32x2v w1, w2; w1.x = cvt_pk_bf16(o10, o11); w1.y = cvt_pk_bf16(o12, o13); w2.x = cvt_pk_bf16(o20, o21); w2.y = cvt_pk_bf16(o22, o23);
                        *(u32x2v*)dst = w1; *(u32x2v*)(dst + 32) = w2; } }
            return;
        }
        size_t off; int ldc, colt;
        if (pn < 4)       { off = WS_MIX; ldc = 2048; colt = pn * 256; }
        else if (pn == 4) { off = WS_AK;  ldc = 256;  colt = 0; }
        else if (pn == 5) { off = WS_AV;  ldc = 256;  colt = 0; }
        else if (pn < 10) { off = WS_AZ;  ldc = 1024; colt = (pn - 6) * 256; }
        else if (pn < 12) { off = WS_MQ;  ldc = 512;  colt = (pn - 10) * 256; }
        else if (pn < 14) { off = WS_MK;  ldc = 512;  colt = (pn - 12) * 256; }
        else if (pn < 18) { off = WS_MV;  ldc = 1024; colt = (pn - 14) * 256; }
        else if (pn < 22) { off = WS_MO;  ldc = 1024; colt = (pn - 18) * 256; }
        else              { off = WS_MZ;  ldc = 1024; colt = (pn - 22) * 256; }
        bf16_t* base = (bf16_t*)(ws + off);
        const int col0 = colt + wc * 32 + 8 * fq;
#pragma unroll
        for (int ai = 0; ai < 2; ++ai)
#pragma unroll
            for (int m = 0; m < 4; ++m) { bf16_t* rowp = base + (size_t)(row0 + ai * HALF + m * 16) * ldc + col0;
#pragma unroll
                for (int bj = 0; bj < 2; ++bj) { const f32x4 v0 = acc[ai][bj][m][0] * SC, v1 = acc[ai][bj][m][1] * SC;
                    u32x4 w; w.x = cvt_pk_bf16(v0[0], v0[1]); w.y = cvt_pk_bf16(v0[2], v0[3]); w.z = cvt_pk_bf16(v1[0], v1[1]); w.w = cvt_pk_bf16(v1[2], v1[3]);
                    *(u32x4*)(rowp + bj * HALF) = w; } }
    }
};
struct EpiNull { static constexpr bool PERM = true, AFTER_DRAIN = false; static constexpr int NSTORE = 0;
    __device__ __forceinline__ void operator()(const f32x4 (&acc)[2][2][4][2], const Unit& u, int wr, int wc, int fr, int fq) const {
#pragma unroll
        for (int ai = 0; ai < 2; ++ai)
#pragma unroll
            for (int bj = 0; bj < 2; ++bj)
#pragma unroll
                for (int m = 0; m < 4; ++m) asm volatile("" :: "v"(acc[ai][bj][m][0]), "v"(acc[ai][bj][m][1])); } };
struct EpiOut {
    static constexpr bool PERM = false, AFTER_DRAIN = false; static constexpr int NSTORE = 32;
    const float* xp; const float* xs; float* out;
    __device__ __forceinline__ void operator()(const f32x4 (&acc)[2][2][4][2], const Unit& u, int wr, int wc, int fr, int fq) const {
        const int row0 = u.pm * BM + wr * 64 + fr; const int col0 = u.pn * BM + wc * 32 + 4 * fq;
        const bool pr = row0 < TOK_PROMPT; const float* xb = (pr ? xp : xs) + col0;
        const size_t xsub = pr ? 0 : (size_t)TOK_PROMPT * DM; float* ob = out + col0;
        f32x4 xr[4][4];
#define EPO_LOAD(g_) do { const size_t ro_ = (size_t)(row0 + ((g_) >> 2) * HALF + ((g_) & 3) * 16) * DM - xsub; \
            xr[(g_) & 3][0] = *(const f32x4*)(xb + ro_); xr[(g_) & 3][1] = *(const f32x4*)(xb + ro_ + 16); xr[(g_) & 3][2] = *(const f32x4*)(xb + ro_ + HALF); xr[(g_) & 3][3] = *(const f32x4*)(xb + ro_ + HALF + 16); } while (0)
        EPO_LOAD(0); EPO_LOAD(1); EPO_LOAD(2);
#pragma unroll
        for (int g = 0; g < 8; ++g) { if (g + 3 < 8) EPO_LOAD(g + 3);
            const int ai = g >> 2, m = g & 3; const size_t ro = (size_t)(row0 + ai * HALF + m * 16) * DM;
            *(f32x4*)(ob + ro) = xr[g & 3][0] + acc[ai][0][m][0]; *(f32x4*)(ob + ro + 16) = xr[g & 3][1] + acc[ai][0][m][1];
            *(f32x4*)(ob + ro + HALF) = xr[g & 3][2] + acc[ai][1][m][0]; *(f32x4*)(ob + ro + HALF + 16) = xr[g & 3][3] + acc[ai][1][m][1]; }
#undef EPO_LOAD
    }
};

template <class Epi, class Sched, bool ALIGN_EPI = false, bool SP2 = false, bool F8 = false>
__device__ __forceinline__ void gemm_phase(PG8_LAS unsigned char* lds, const Gemm g, const Sched& S, const Epi& E) {
    int tid_ = threadIdx.x; asm volatile("" : "+v"(tid_));
    const int tid = tid_, wid = __builtin_amdgcn_readfirstlane(tid >> 6), lane = tid & 63, wr = wid >> 2, wc = wid & 3, fr = lane & 15, fq = lane >> 4;
    const int K = g.K, nt = K / BK;
    unsigned voffA[2], voffB[2];
#pragma unroll
    for (int i = 0; i < 2; ++i) { int R, C; stage_rc(tid * 16 + i * 8192, R, C); const int Rb = Epi::PERM ? ((R & ~31) + perm32(R & 31)) : R;
        voffA[i] = (unsigned)(R * K + C) * 2u; voffB[i] = (unsigned)(Rb * K + C) * 2u; }
    const size_t kstep = (size_t)(BK * 2);
    const size_t hstep = (size_t)HALF * K * 2;
    const size_t tstep = 2 * hstep;
    const unsigned ldsw = (unsigned)wid * 1024u;
    const int aoff = lds_byte(wr * 64 + fr, fq * 8), boff = lds_byte(wc * 32 + fr, fq * 8);
#define PG8_SA(b, h) (((b) * 2 + (h)) * HTB)
#define PG8_SB(b, h) ((4 + (b) * 2 + (h)) * HTB)
#define PG8_STAGE(bufoff, gbase, voff) do { _Pragma("unroll") for (int _i = 0; _i < 2; ++_i) \
        __builtin_amdgcn_global_load_lds((const unsigned*)((const char*)(gbase) + (voff)[_i]), (PG8_LAS unsigned*)(lds + (bufoff) + ldsw + _i * 8192), 16, 0, 0); } while (0)
#define PG8_LDA(dst, b, h) do { _Pragma("unroll") for (int m = 0; m < 4; ++m) _Pragma("unroll") for (int k = 0; k < 2; ++k) dst[m][k] = *(const PG8_LAS bf16x8*)(lds + PG8_SA(b, h) + aoff + m * 2048 + k * 1024); } while (0)
#define PG8_LDB(dst, b, h) do { _Pragma("unroll") for (int n = 0; n < 2; ++n) _Pragma("unroll") for (int k = 0; k < 2; ++k) dst[n][k] = *(const PG8_LAS bf16x8*)(lds + PG8_SB(b, h) + boff + n * 2048 + k * 1024); } while (0)
#define PG8_CAT8(x_) __builtin_shufflevector(__builtin_bit_cast(i32x4, (x_)[0]), __builtin_bit_cast(i32x4, (x_)[1]), 0, 1, 2, 3, 4, 5, 6, 7)
#define PG8_MMA(ai, bj, At, Bt) do { __builtin_amdgcn_s_setprio(1); _Pragma("unroll") for (int m = 0; m < 4; ++m) _Pragma("unroll") for (int n = 0; n < 2; ++n) { \
        if constexpr (F8) asm volatile("v_mfma_f32_16x16x128_f8f6f4 %0, %1, %2, %0" : "+v"(acc[ai][bj][m][n]) : "v"(PG8_CAT8(Bt[n])), "v"(PG8_CAT8(At[m]))); \
        else { _Pragma("unroll") for (int k = 0; k < 2; ++k) acc[ai][bj][m][n] = __builtin_amdgcn_mfma_f32_16x16x32_bf16(Bt[n][k], At[m][k], acc[ai][bj][m][n], 0, 0, 0); } } \
        __builtin_amdgcn_s_setprio(0); } while (0)
#define PG8_WAIT_V(n) asm volatile("s_waitcnt vmcnt(" #n ")" ::: "memory")
#define PG8_WAIT_L(n) asm volatile("s_waitcnt lgkmcnt(" #n ")" ::: "memory")
#define PG8_BAR __builtin_amdgcn_s_barrier()
#define PG8_SCHED __builtin_amdgcn_sched_barrier(0)
    Unit cur, nxt; int ui = 0;
    if (!S.next(0, cur)) return;
    f32x4 acc[2][2][4][2];
#pragma unroll
    for (int a = 0; a < 2; ++a)
#pragma unroll
        for (int b = 0; b < 2; ++b)
#pragma unroll
            for (int m = 0; m < 4; ++m)
#pragma unroll
                for (int n = 0; n < 2; ++n) acc[a][b][m][n] = (f32x4){0.f, 0.f, 0.f, 0.f};
    bf16x8 At[4][2], B0[2][2], B1[2][2];
    const char* cA = (const char*)g.A + (size_t)cur.pm * tstep; const char* cB = (const char*)g.Bt + (size_t)cur.pn * tstep;
    S.a_ready(cur);
    if constexpr (SP2) {
        PG8_STAGE(PG8_SB(0, 0), cB, voffB); PG8_STAGE(PG8_SB(0, 1), cB + hstep, voffB); PG8_STAGE(PG8_SA(0, 0), cA, voffA); PG8_STAGE(PG8_SA(0, 1), cA + hstep, voffA);
        if (wr == 1) PG8_BAR;
        PG8_WAIT_V(2); PG8_BAR;
        PG8_STAGE(PG8_SB(1, 0), cB + kstep, voffB); PG8_STAGE(PG8_SA(1, 0), cA + kstep, voffA); PG8_STAGE(PG8_SB(1, 1), cB + hstep + kstep, voffB);
        PG8_WAIT_V(6); PG8_BAR;
    } else {
        PG8_STAGE(PG8_SB(0, 0), cB, voffB); PG8_STAGE(PG8_SA(0, 0), cA, voffA); PG8_STAGE(PG8_SB(0, 1), cB + hstep, voffB); PG8_STAGE(PG8_SA(0, 1), cA + hstep, voffA);
        if (wr == 1) PG8_BAR;
        PG8_WAIT_V(4); PG8_BAR;
        PG8_STAGE(PG8_SB(1, 0), cB + kstep, voffB); PG8_STAGE(PG8_SA(1, 0), cA + kstep, voffA); PG8_STAGE(PG8_SB(1, 1), cB + hstep + kstep, voffB);
        PG8_WAIT_V(6); PG8_BAR;
    }
    for (;;) {
        const bool has_next = S.next(ui + 1, nxt);
        const char* nA = has_next ? (const char*)g.A + (size_t)nxt.pm * tstep : cA; const char* nB = has_next ? (const char*)g.Bt + (size_t)nxt.pn * tstep : cB;
        for (int t = 0; t < nt; t += 2) {
            const bool last = (t == nt - 2);
            const char* a1 = cA + (size_t)(t + 1) * kstep;
            const char* a2 = last ? nA : cA + (size_t)(t + 2) * kstep; const char* b2 = last ? nB : cB + (size_t)(t + 2) * kstep;
            const char* a3 = a2 + kstep; const char* b3 = b2 + kstep;
            if (last && has_next) S.a_ready(nxt);
            if constexpr (SP2) {
            const int relax_s = __builtin_amdgcn_readfirstlane((Epi::NSTORE > 0 && t == 0 && ui > 0) ? 1 : 0);
#define PG8_WAIT_FIRST() do { if constexpr (Epi::NSTORE >= 32) asm volatile("s_waitcnt vmcnt(40)\n\ts_cmp_lg_u32 %0, 0\n\ts_cbranch_scc1 1f\n\ts_waitcnt vmcnt(8)\n1:" :: "s"(relax_s) : "memory", "scc"); \
            else if constexpr (Epi::NSTORE >= 16) asm volatile("s_waitcnt vmcnt(24)\n\ts_cmp_lg_u32 %0, 0\n\ts_cbranch_scc1 1f\n\ts_waitcnt vmcnt(8)\n1:" :: "s"(relax_s) : "memory", "scc"); \
            else PG8_WAIT_V(8); } while (0)
            PG8_LDB(B0, 0, 0); PG8_LDB(B1, 0, 1); PG8_SCHED; PG8_LDA(At, 0, 0); PG8_STAGE(PG8_SA(1, 1), a1 + hstep, voffA);
            PG8_WAIT_FIRST(); PG8_WAIT_L(0); PG8_BAR; PG8_MMA(0, 0, At, B0); PG8_MMA(0, 1, At, B1); PG8_BAR; PG8_SCHED;
            PG8_LDA(At, 0, 1); PG8_STAGE(PG8_SB(0, 0), b2, voffB); PG8_STAGE(PG8_SB(0, 1), b2 + hstep, voffB); PG8_STAGE(PG8_SA(0, 0), a2, voffA);
            PG8_WAIT_FIRST(); PG8_WAIT_L(0); PG8_BAR; PG8_MMA(1, 0, At, B0); PG8_MMA(1, 1, At, B1); PG8_BAR; PG8_SCHED;
#undef PG8_WAIT_FIRST
            PG8_LDB(B0, 1, 0); PG8_LDB(B1, 1, 1); PG8_SCHED; PG8_LDA(At, 1, 0); PG8_STAGE(PG8_SA(0, 1), a2 + hstep, voffA);
            PG8_WAIT_V(8); PG8_WAIT_L(0); PG8_BAR; PG8_MMA(0, 0, At, B0); PG8_MMA(0, 1, At, B1); PG8_BAR; PG8_SCHED;
            PG8_LDA(At, 1, 1); PG8_STAGE(PG8_SB(1, 0), b3, voffB); PG8_STAGE(PG8_SB(1, 1), b3 + hstep, voffB); PG8_STAGE(PG8_SA(1, 0), a3, voffA);
            PG8_WAIT_V(8); PG8_WAIT_L(0); PG8_BAR; PG8_MMA(1, 0, At, B0); PG8_MMA(1, 1, At, B1); PG8_BAR; PG8_SCHED;
            } else {
            PG8_LDB(B0, 0, 0); PG8_SCHED; PG8_LDA(At, 0, 0); PG8_STAGE(PG8_SA(1, 1), a1 + hstep, voffA);
            PG8_WAIT_L(8); PG8_BAR; PG8_WAIT_L(0); PG8_MMA(0, 0, At, B0); PG8_BAR; PG8_SCHED;
            PG8_LDB(B1, 0, 1); PG8_STAGE(PG8_SB(0, 0), b2, voffB);
            PG8_BAR; PG8_WAIT_L(0); PG8_MMA(0, 1, At, B1); PG8_BAR;
            PG8_LDA(At, 0, 1); PG8_STAGE(PG8_SA(0, 0), a2, voffA);
            PG8_BAR; PG8_WAIT_L(0); PG8_MMA(1, 0, At, B0); PG8_BAR; PG8_SCHED;
            PG8_STAGE(PG8_SB(0, 1), b2 + hstep, voffB);
            PG8_WAIT_V(6); PG8_BAR; PG8_MMA(1, 1, At, B1); PG8_BAR;
            PG8_LDB(B0, 1, 0); PG8_SCHED; PG8_LDA(At, 1, 0); PG8_STAGE(PG8_SA(0, 1), a2 + hstep, voffA);
            PG8_WAIT_L(8); PG8_BAR; PG8_WAIT_L(0); PG8_MMA(0, 0, At, B0); PG8_BAR; PG8_SCHED;
            PG8_LDB(B1, 1, 1); PG8_STAGE(PG8_SB(1, 0), b3, voffB);
            PG8_BAR; PG8_WAIT_L(0); PG8_MMA(0, 1, At, B1); PG8_BAR;
            PG8_LDA(At, 1, 1); PG8_STAGE(PG8_SA(1, 0), a3, voffA);
            PG8_BAR; PG8_WAIT_L(0); PG8_MMA(1, 0, At, B0); PG8_BAR; PG8_SCHED;
            PG8_STAGE(PG8_SB(1, 1), b3 + hstep, voffB);
            PG8_WAIT_V(6); PG8_BAR; PG8_MMA(1, 1, At, B1); PG8_BAR;
            }
        }
        if constexpr (F8) asm volatile("s_nop 15\n\ts_nop 15" ::: "memory");
        if constexpr (ALIGN_EPI) { if (wr == 0) PG8_BAR; }
        if constexpr (!Epi::AFTER_DRAIN) { E(acc, cur, wr, wc, fr, fq); S.done(cur); }
        if (!has_next) break;
#pragma unroll
        for (int a = 0; a < 2; ++a)
#pragma unroll
            for (int b = 0; b < 2; ++b)
#pragma unroll
                for (int m = 0; m < 4; ++m)
#pragma unroll
                    for (int n = 0; n < 2; ++n) acc[a][b][m][n] = (f32x4){0.f, 0.f, 0.f, 0.f};
        cur = nxt; cA = nA; cB = nB; ++ui;
        if constexpr (ALIGN_EPI) { if (wr == 1) PG8_BAR; }
    }
    PG8_WAIT_V(0);
    if constexpr (!ALIGN_EPI) { if (wr == 0) PG8_BAR; }
    PG8_BAR;
    if constexpr (Epi::AFTER_DRAIN) { E.fused(acc, cur, wr, wc, fr, fq, lds, wid, lane); S.done(cur); }
#undef PG8_SA
#undef PG8_SB
#undef PG8_STAGE
#undef PG8_LDA
#undef PG8_LDB
#undef PG8_MMA
#undef PG8_CAT8
#undef PG8_WAIT_V
#undef PG8_WAIT_L
#undef PG8_BAR
#undef PG8_SCHED
}
}
namespace attn {
using bf16 = __hip_bfloat16;
constexpr int   D = 128, NW = 8, QBLK = 32, KVBLK = 64;
constexpr float SCALE = 0.088388347648318440f;
constexpr float THR = 8.f;
constexpr int SDEPTH = 2;
constexpr int LDQ = 2048, LDK = 256, LDO = 2048, LDZ = 1024;
constexpr size_t SHM_V = KVBLK * D * 2, SHM_K = KVBLK * D * 2, SHM_ATTN = 2 * SHM_V + 2 * SHM_K + NW * 64 * 4;
using bf16x8 = __attribute__((ext_vector_type(8))) short;
using s16x4  = __attribute__((ext_vector_type(4))) short;
using f32x16 = __attribute__((ext_vector_type(16))) float;
using f32x8  = __attribute__((ext_vector_type(8))) float;
using u32x4  = __attribute__((ext_vector_type(4))) unsigned;
#define KSWZ(row, colB) ((row) * 256 + ((colB) ^ (((row) & 7) << 4)))
#define SBAR() __builtin_amdgcn_sched_barrier(0)
__device__ __forceinline__ int crow(int r, int hi) { return (r & 3) + 8 * (r >> 2) + 4 * hi; }
__device__ __forceinline__ unsigned cvtpk(float lo, float hi) {
  unsigned r; asm volatile("v_cvt_pk_bf16_f32 %0, %1, %2" : "=v"(r) : "v"(lo), "v"(hi)); return r;
}
template <typename TIn> struct Stage;
template <> struct Stage<bf16>  { using T = bf16x8;
  __device__ static __forceinline__ T ld8(const bf16* p) { return *reinterpret_cast<const bf16x8*>(p); }
  __device__ static __forceinline__ bf16x8 tobf(T x) { return x; } };
template <> struct Stage<float> { using T = f32x8;
  __device__ static __forceinline__ T ld8(const float* p) { return *reinterpret_cast<const f32x8*>(p); }
  __device__ static __forceinline__ bf16x8 tobf(T x) {
    u32x4 w = {cvtpk(x[0], x[1]), cvtpk(x[2], x[3]), cvtpk(x[4], x[5]), cvtpk(x[6], x[7])}; return *reinterpret_cast<bf16x8*>(&w); } };

__device__ __forceinline__ void partialSM(f32x16& p0, f32x16& p1, float& m_reg, float& mn, float& alpha) {
  constexpr float C = SCALE * 1.4426950408889634f;
  float pmax = p0[0]; for (int r = 1; r < 16; ++r) pmax = fmaxf(pmax, p0[r]); for (int r = 0; r < 16; ++r) pmax = fmaxf(pmax, p1[r]);
  { auto rr = __builtin_amdgcn_permlane32_swap(__float_as_uint(pmax), __float_as_uint(pmax), false, false);
    pmax = fmaxf(__uint_as_float(rr[0]), __uint_as_float(rr[1])); }
  if (__builtin_expect(__all(pmax - m_reg <= THR / SCALE), 1)) { mn = m_reg; alpha = 1.f; }
  else { mn = fmaxf(m_reg, pmax); alpha = __builtin_amdgcn_exp2f((m_reg - mn) * C); m_reg = mn; }
  float mnC = -mn * C;
  for (int r = 0; r < 16; ++r) p0[r] = fmaf(p0[r], C, mnC); for (int r = 0; r < 16; ++r) p1[r] = fmaf(p1[r], C, mnC);
  for (int r = 0; r < 16; ++r) p0[r] = __builtin_amdgcn_exp2f(p0[r]);
}
__device__ __forceinline__ void finishSM(f32x16& p0, f32x16& p1, float alpha, float& l_reg, bf16x8& pa0, bf16x8& pa1, bf16x8& pa2, bf16x8& pa3) {
  for (int r = 0; r < 16; ++r) p1[r] = __builtin_amdgcn_exp2f(p1[r]);
  float ps = 0; for (int r = 0; r < 16; ++r) ps += p0[r]; for (int r = 0; r < 16; ++r) ps += p1[r];
  { auto rr = __builtin_amdgcn_permlane32_swap(__float_as_uint(ps), __float_as_uint(ps), false, false);
    ps = __uint_as_float(rr[0]) + __uint_as_float(rr[1]); }
  l_reg = l_reg * alpha + ps;
#define PK4(P, BASE, OUT) do { unsigned a0 = cvtpk(P[BASE + 0], P[BASE + 1]), a1 = cvtpk(P[BASE + 2], P[BASE + 3]);   \
    unsigned b0 = cvtpk(P[BASE + 4], P[BASE + 5]), b1 = cvtpk(P[BASE + 6], P[BASE + 7]);                              \
    auto r0 = __builtin_amdgcn_permlane32_swap(a0, b0, false, false); auto r1 = __builtin_amdgcn_permlane32_swap(a1, b1, false, false); \
    u32x4 w = {r0[0], r1[0], r0[1], r1[1]}; OUT = *reinterpret_cast<bf16x8*>(&w); } while (0)
  PK4(p0, 0, pa0); PK4(p0, 8, pa1); PK4(p1, 0, pa2); PK4(p1, 8, pa3);
#undef PK4
}
__device__ __forceinline__ void qkt(f32x16& p0, f32x16& p1, const bf16* Ks, const bf16x8* qr, int r32, int hi) {
  p0 = f32x16{}; p1 = f32x16{};
  for (int d0 = 0; d0 < 8; ++d0) { int cb = (d0 * 16 + hi * 8) * 2;
    bf16x8 b0 = *reinterpret_cast<const bf16x8*>((const char*)Ks + KSWZ(r32, cb));
    bf16x8 b1 = *reinterpret_cast<const bf16x8*>((const char*)Ks + KSWZ(32 + r32, cb));
    p0 = __builtin_amdgcn_mfma_f32_32x32x16_bf16(b0, qr[d0], p0, 0, 0, 0);
    p1 = __builtin_amdgcn_mfma_f32_32x32x16_bf16(b1, qr[d0], p1, 0, 0, 0); }
}
__device__ __forceinline__ int v_st(int k, int c) { const int kk = (k & ~0xC) | ((k & 4) << 1) | ((k & 8) >> 1); return ((kk >> 3) * 4 + (c >> 5)) * 512 + ((kk & 7) * 32 + (c & 31)) * 2; }
__device__ __forceinline__ int v_rd_base(int lane) { return ((lane & 3) << 3) | (((lane >> 2) & 3) << 6) | (((lane >> 4) & 1) << 5) | (((lane >> 5) & 1) << 8); }
constexpr int v_rd_off(int d0, int ks, int half) { return d0 * 512 + ks * 4096 + half * 2048; }
template <int OFF> __device__ __forceinline__ s16x4 tr_read(int vb) {
  s16x4 r; asm volatile("ds_read_b64_tr_b16 %0, %1 offset:%2" : "=&v"(r) : "v"(vb), "i"(OFF) : "memory"); return r;
}
template <int D0> __device__ __forceinline__ void pv_one(f32x16& od, int vb, bf16x8 pa0, bf16x8 pa1, bf16x8 pa2, bf16x8 pa3) {
  const s16x4 l0 = tr_read<v_rd_off(D0, 0, 0)>(vb), h0 = tr_read<v_rd_off(D0, 0, 1)>(vb), l1 = tr_read<v_rd_off(D0, 1, 0)>(vb), h1 = tr_read<v_rd_off(D0, 1, 1)>(vb);
  const s16x4 l2 = tr_read<v_rd_off(D0, 2, 0)>(vb), h2 = tr_read<v_rd_off(D0, 2, 1)>(vb), l3 = tr_read<v_rd_off(D0, 3, 0)>(vb), h3 = tr_read<v_rd_off(D0, 3, 1)>(vb);
  asm volatile("s_waitcnt lgkmcnt(0)" ::: "memory"); SBAR();
#define PK(L, H) (bf16x8){L[0], L[1], L[2], L[3], H[0], H[1], H[2], H[3]}
  od = __builtin_amdgcn_mfma_f32_32x32x16_bf16(pa0, PK(l0, h0), od, 0, 0, 0);
  od = __builtin_amdgcn_mfma_f32_32x32x16_bf16(pa1, PK(l1, h1), od, 0, 0, 0);
  od = __builtin_amdgcn_mfma_f32_32x32x16_bf16(pa2, PK(l2, h2), od, 0, 0, 0);
  od = __builtin_amdgcn_mfma_f32_32x32x16_bf16(pa3, PK(l3, h3), od, 0, 0, 0);
#undef PK
}
__device__ __forceinline__ void pv_d0(f32x16* o, int vb, bf16x8 pa0, bf16x8 pa1, bf16x8 pa2, bf16x8 pa3) {
  pv_one<0>(o[0], vb, pa0, pa1, pa2, pa3); pv_one<1>(o[1], vb, pa0, pa1, pa2, pa3); pv_one<2>(o[2], vb, pa0, pa1, pa2, pa3); pv_one<3>(o[3], vb, pa0, pa1, pa2, pa3);
}

template <typename TQ>
__device__ __forceinline__ void attn_dense_body(const TQ* Qb, const bf16* __restrict__ Kh, const bf16* __restrict__ Vh,
                                                unsigned short* Ob, const unsigned short* __restrict__ Zb, int seq, char* lds) {
  using St = Stage<bf16>; using SQ = Stage<TQ>;
  int tid = threadIdx.x; asm volatile("" : "+v"(tid));
  const int wid = tid >> 6, lane = tid & 63, r32 = lane & 31, hi = lane >> 5;
  bf16* V_lds = (bf16*)lds; bf16* K_lds = (bf16*)(lds + 2 * SHM_V);
  float* ws = (float*)(lds + 2 * SHM_V + 2 * SHM_K) + wid * 64; float* li_l = ws; float* al_l = ws + 32;
  float m_reg = -1e30f, l_reg = 0; f32x16 o[4] = {}; bf16x8 qr[8];
  const TQ* Qw = Qb + (long)(wid * QBLK + r32) * LDQ + hi * 8;
#pragma unroll
  for (int d0 = 0; d0 < 8; ++d0) qr[d0] = SQ::tobf(SQ::ld8(Qw + d0 * 16));
  const int sr = tid >> 4, sc = (tid & 15) * 8, vst0 = v_st(sr, sc), vst1 = v_st(32 + sr, sc);
  const int vb0 = (int)(uintptr_t)V_lds + v_rd_base(lane);
  struct { typename St::T vs0, vs1, ks0, ks1; } sr_[SDEPTH];
#define SLOAD(i, k0) do { sr_[i].vs0 = St::ld8(&Vh[(long)((k0) + sr) * LDK + sc]); sr_[i].vs1 = St::ld8(&Vh[(long)((k0) + 32 + sr) * LDK + sc]); \
    sr_[i].ks0 = St::ld8(&Kh[(long)((k0) + sr) * LDK + sc]); sr_[i].ks1 = St::ld8(&Kh[(long)((k0) + 32 + sr) * LDK + sc]); } while (0)
#define SWRITE(b, i) do { *(bf16x8*)((char*)V_lds + (b) * SHM_V + vst0) = St::tobf(sr_[i].vs0);          \
    *(bf16x8*)((char*)V_lds + (b) * SHM_V + vst1) = St::tobf(sr_[i].vs1); int kc = sc * 2;               \
    *(bf16x8*)((char*)K_lds + (b) * SHM_K + KSWZ(sr, kc)) = St::tobf(sr_[i].ks0);                       \
    *(bf16x8*)((char*)K_lds + (b) * SHM_K + KSWZ(32 + sr, kc)) = St::tobf(sr_[i].ks1); } while (0)
#define SWAIT() do { if constexpr (SDEPTH == 2) asm volatile("s_waitcnt vmcnt(4)" ::: "memory"); else asm volatile("s_waitcnt vmcnt(0)" ::: "memory"); } while (0)
#define RESC(a) do { if (__any((a) < 1.f)) { if (hi == 0) al_l[r32] = (a); asm volatile("s_waitcnt lgkmcnt(0)" ::: "memory"); \
    for (int d = 0; d < 4; ++d) for (int r = 0; r < 16; ++r) o[d][r] *= al_l[crow(r, hi)]; } } while (0)
  f32x16 pA0, pA1, pB0, pB1; float mnA, mnB, alA, alB; bf16x8 pa0, pa1, pa2, pa3; const int NT = seq / KVBLK;
  constexpr int SE = 0, SO = SDEPTH - 1;
  SLOAD(SE, 0); asm volatile("s_waitcnt vmcnt(0)" ::: "memory"); SWRITE(0, SE); __syncthreads();
  qkt(pA0, pA1, K_lds, qr, r32, hi); partialSM(pA0, pA1, m_reg, mnA, alA);
  SLOAD(SO, KVBLK); if constexpr (SDEPTH == 2) { if (2 < NT) SLOAD(SE, 2 * KVBLK); }
  SWAIT(); SWRITE(1, SO); __syncthreads();
  for (int j = 1; j + 1 < NT; j += 2) {
    SBAR(); qkt(pB0, pB1, (bf16*)((char*)K_lds + SHM_K), qr, r32, hi);
    finishSM(pA0, pA1, alA, l_reg, pa0, pa1, pa2, pa3); SBAR();
    SLOAD(SO, (j + SDEPTH) * KVBLK); SBAR();
    pv_d0(o, vb0, pa0, pa1, pa2, pa3); partialSM(pB0, pB1, m_reg, mnB, alB);
    __syncthreads(); SWAIT(); SWRITE(0, SE);
    RESC(alB); __syncthreads();
    SBAR(); qkt(pA0, pA1, K_lds, qr, r32, hi);
    finishSM(pB0, pB1, alB, l_reg, pa0, pa1, pa2, pa3); SBAR();
    if (SDEPTH == 1 || j + 3 < NT) SLOAD(SE, (j + 1 + SDEPTH) * KVBLK); SBAR();
    pv_d0(o, vb0 + (int)SHM_V, pa0, pa1, pa2, pa3); partialSM(pA0, pA1, m_reg, mnA, alA);
    __syncthreads(); SWAIT(); SWRITE(1, SO);
    RESC(alA); __syncthreads();
  }
  SBAR(); qkt(pB0, pB1, (bf16*)((char*)K_lds + SHM_K), qr, r32, hi);
  finishSM(pA0, pA1, alA, l_reg, pa0, pa1, pa2, pa3); SBAR();
  pv_d0(o, vb0, pa0, pa1, pa2, pa3); partialSM(pB0, pB1, m_reg, mnB, alB);
  __syncthreads(); RESC(alB);
  finishSM(pB0, pB1, alB, l_reg, pa0, pa1, pa2, pa3); SBAR();
  pv_d0(o, vb0 + (int)SHM_V, pa0, pa1, pa2, pa3);
  if (hi == 0) li_l[r32] = l_reg; asm volatile("s_waitcnt lgkmcnt(0)" ::: "memory");
  float rli[16];
#pragma unroll
  for (int r = 0; r < 16; ++r) rli[r] = __builtin_amdgcn_rcpf(li_l[crow(r, hi)]);
  __syncthreads();
  { unsigned short* stg = (unsigned short*)(lds + wid * 8192);
#pragma unroll
    for (int r = 0; r < 16; ++r) { const int orow = crow(r, hi);
#pragma unroll
      for (int d0 = 0; d0 < 4; ++d0) { unsigned u = __builtin_bit_cast(unsigned, o[d0][r] * rli[r]); u = (u + 0x7fffu + ((u >> 16) & 1u)) >> 16; stg[orow * 128 + d0 * 32 + r32] = (unsigned short)u; } }
    asm volatile("s_waitcnt lgkmcnt(0)" ::: "memory");
    unsigned short* Ow = Ob + (long)(wid * QBLK) * LDO; const unsigned short* Zw = Zb + (long)(wid * QBLK) * LDZ;
#pragma unroll 2
    for (int i = 0; i < 8; ++i) { const int row = i * 4 + (lane >> 4), ch = lane & 15;
      const u32x4 ov = *(const u32x4*)(stg + row * 128 + ch * 8); const u32x4 zv = *(const u32x4*)(Zw + (long)row * LDZ + ch * 8); u32x4 w;
#pragma unroll
      for (int e = 0; e < 4; ++e) { const float z0 = __builtin_bit_cast(float, zv[e] << 16), z1 = __builtin_bit_cast(float, zv[e] & 0xffff0000u);
        const float a0 = __builtin_bit_cast(float, ov[e] << 16) * (z0 * __builtin_amdgcn_rcpf(1.f + __expf(-z0))), a1 = __builtin_bit_cast(float, ov[e] & 0xffff0000u) * (z1 * __builtin_amdgcn_rcpf(1.f + __expf(-z1)));
        w[e] = cvtpk(a0, a1); }
      *(u32x4*)(Ow + (long)row * LDO + ch * 8) = w; } }
#undef SLOAD
#undef SWRITE
#undef SWAIT
#undef RESC
}

}
namespace ml {
typedef short bf16x8 __attribute__((ext_vector_type(8)));
typedef short v4i16 __attribute__((ext_vector_type(4)));
typedef float f32x4 __attribute__((ext_vector_type(4)));
typedef float f32x16 __attribute__((ext_vector_type(16)));
typedef unsigned u32x4 __attribute__((ext_vector_type(4)));
typedef unsigned u32x2 __attribute__((ext_vector_type(2)));
#define ML_LAS __attribute__((address_space(3)))
constexpr int BUFB = 65536, Q_OFF = 0, K_OFF = 16384, V_OFF = 32768;
constexpr int P_OFF = 131072, DENP_OFF = P_OFF + 8192, QNP_OFF = DENP_OFF + 512, VEC_OFF = QNP_OFF + 2048, VEC_SLOT = 2 * 256, VR_OFF = VEC_OFF + 2 * VEC_SLOT, NB_OFF = VR_OFF + 8 * 256, LDS_END = NB_OFF + 512;
__device__ __forceinline__ unsigned fxor(unsigned row) { return ((row & 3u) << 2) | ((row >> 2) & 3u); }
__device__ __forceinline__ unsigned off_b(unsigned row, unsigned ch) { return 256u * row + 16u * (ch ^ fxor(row)); }
__device__ __forceinline__ unsigned off_p(unsigned t, unsigned ch) { return 128u * t + 16u * (ch ^ (t & 7u)); }
__device__ __forceinline__ unsigned tr_addr(unsigned lane, unsigned c, unsigned ks, unsigned t) { const unsigned h = lane >> 5, blk = (lane >> 4) & 1u, q = (lane & 15u) >> 2, p = lane & 3u; return off_b(16u * ks + 8u * h + 4u * t + q, 4u * c + 2u * blk + (p >> 1)) + 8u * (p & 1u); }
__device__ __forceinline__ unsigned tr_addr16(unsigned lane, unsigned c, unsigned ks, unsigned t) { const unsigned g = lane >> 4, q = (lane & 15u) >> 2, p = lane & 3u; return off_b(32u * ks + 8u * g + 4u * t + q, 2u * c + (p >> 1)) + 8u * (p & 1u); }
__device__ __forceinline__ v4i16 trrd(ML_LAS unsigned char* p) { return __builtin_amdgcn_ds_read_tr16_b64_v4i16((ML_LAS v4i16*)p); }
template <int OFF> __device__ __forceinline__ v4i16 trra(unsigned addr) { v4i16 r; asm volatile("ds_read_b64_tr_b16 %0, %1 offset:%2" : "=v"(r) : "v"(addr), "i"(OFF) : "memory"); return r; }
__device__ __forceinline__ void glds16(const void* gsrc, unsigned lds_dst) { unsigned keep;
    asm volatile("s_mov_b32 %0, m0\n\ts_mov_b32 m0, %2\n\ts_nop 0\n\tglobal_load_lds_dwordx4 %1, off\n\ts_mov_b32 m0, %0" : "=&s"(keep) : "v"(gsrc), "s"(lds_dst) : "memory"); }
#define ML_TRWAIT() do { asm volatile("s_waitcnt lgkmcnt(0)" ::: "memory"); __builtin_amdgcn_sched_barrier(0); } while (0)
__device__ __forceinline__ bf16x8 cat8(v4i16 lo, v4i16 hi) { return (bf16x8){lo[0], lo[1], lo[2], lo[3], hi[0], hi[1], hi[2], hi[3]}; }
__device__ __forceinline__ unsigned pkbf(float lo, float hi) { unsigned r; asm volatile("v_cvt_pk_bf16_f32 %0, %1, %2" : "=v"(r) : "v"(lo), "v"(hi)); return r; }
__device__ __forceinline__ float s2f(short x) { return __builtin_bit_cast(float, (unsigned)(unsigned short)x << 16); }
__device__ __forceinline__ bf16x8 pack8(float a0, float a1, float a2, float a3, float a4, float a5, float a6, float a7) { u32x4 w = {pkbf(a0, a1), pkbf(a2, a3), pkbf(a4, a5), pkbf(a6, a7)}; return __builtin_bit_cast(bf16x8, w); }
__device__ __forceinline__ float scan_add(float v, int lane) {
#pragma unroll
    for (int o = 1; o < 64; o <<= 1) { const float u = __shfl_up(v, o); if (lane >= o) v += u; }
    return v; }
__device__ __forceinline__ float scan_max(float v, int lane) {
#pragma unroll
    for (int o = 1; o < 64; o <<= 1) { const float u = __shfl_up(v, o); if (lane >= o) v = fmaxf(v, u); }
    return v; }
#define ML_OPAQUE_LANE(ln) unsigned ln = (unsigned)lane; asm volatile("" : "+v"(ln))
__device__ __forceinline__ float rdlane(float v, int l) { return __builtin_bit_cast(float, __builtin_amdgcn_readlane(__builtin_bit_cast(int, v), l)); }

__device__ __forceinline__ void stage(ML_LAS unsigned char* lds, int bsel, int c, int b, int hd, int dir, const unsigned short* MQ, const unsigned short* MK, const unsigned short* MV, int wid, int lane) {
    const int rl = lane >> 4, pos = lane & 15;
#pragma unroll
    for (int half = 0; half < 2; ++half) {
        const int grp = wid + 8 * half, row = 4 * grp + rl, ch = pos ^ ((rl << 2) | (grp & 3));
        const int p = 64 * c + row, tok = dir ? (SEQ - 1 - p) : p; const size_t trow = (size_t)b * SEQ + tok;
        ML_LAS unsigned char* d = lds + bsel * BUFB + grp * 1024;
        __builtin_amdgcn_global_load_lds((const unsigned*)(MQ + trow * 512 + hd * 128 + 8 * ch), (ML_LAS unsigned*)(d + Q_OFF), 16, 0, 0);
        __builtin_amdgcn_global_load_lds((const unsigned*)(MK + trow * 512 + hd * 128 + 8 * ch), (ML_LAS unsigned*)(d + K_OFF), 16, 0, 0);
        __builtin_amdgcn_global_load_lds((const unsigned*)(MV + trow * 1024 + hd * 256 + 8 * ch), (ML_LAS unsigned*)(d + V_OFF), 16, 0, 0);
        __builtin_amdgcn_global_load_lds((const unsigned*)(MV + trow * 1024 + hd * 256 + 128 + 8 * ch), (ML_LAS unsigned*)(d + V_OFF + 16384), 16, 0, 0);
    }
}

#define ML_DPPF(old_, src_, ctrl_, rm_) __builtin_bit_cast(float, __builtin_amdgcn_update_dpp(__builtin_bit_cast(int, (float)(old_)), __builtin_bit_cast(int, (float)(src_)), ctrl_, rm_, 0xf, false))
__device__ __forceinline__ float dscan_add(float v) {
    v += ML_DPPF(0.f, v, 0x111, 0xf); v += ML_DPPF(0.f, v, 0x112, 0xf); v += ML_DPPF(0.f, v, 0x114, 0xf); v += ML_DPPF(0.f, v, 0x118, 0xf);
    v += ML_DPPF(0.f, v, 0x142, 0xa); v += ML_DPPF(0.f, v, 0x143, 0xc); return v; }
__device__ __forceinline__ float dscan_max(float v) { const float NI = -3.0e38f;
    v = fmaxf(v, ML_DPPF(NI, v, 0x111, 0xf)); v = fmaxf(v, ML_DPPF(NI, v, 0x112, 0xf)); v = fmaxf(v, ML_DPPF(NI, v, 0x114, 0xf)); v = fmaxf(v, ML_DPPF(NI, v, 0x118, 0xf));
    v = fmaxf(v, ML_DPPF(NI, v, 0x142, 0xa)); v = fmaxf(v, ML_DPPF(NI, v, 0x143, 0xc)); return v; }

template <int MODE> __device__ __forceinline__ void mlstm_item(unsigned char* ws, ML_LAS unsigned char* lds, int item, int tid) {
    const int lane = tid & 63, wid = __builtin_amdgcn_readfirstlane(tid >> 6);
    const int b = item >> 3, hd = (item >> 1) & 3, dir = item & 1;
    const float* GT = (const float*)(ws + WS_GATES) + dir * 8 + hd;
    ML_LAS float* DENP = (ML_LAS float*)(lds + DENP_OFF); ML_LAS float* QNP = (ML_LAS float*)(lds + QNP_OFF); ML_LAS float* NB = (ML_LAS float*)(lds + NB_OFF + wid * 64);
    unsigned dq0, dq1, dv0, dv1;
    { const int rl = lane >> 4, pos = lane & 15;
      const int g0 = wid, g1 = wid + 8; const int r0 = 4 * g0 + rl, r1 = 4 * g1 + rl; const int c0 = pos ^ ((rl << 2) | (g0 & 3)), c1 = pos ^ ((rl << 2) | (g1 & 3));
      const int m0 = dir ? 63 - r0 : r0, m1 = dir ? 63 - r1 : r1;
      dq0 = (unsigned)(m0 * 1024 + 16 * c0); dq1 = (unsigned)(m1 * 1024 + 16 * c1); dv0 = (unsigned)(m0 * 2048 + 16 * c0); dv1 = (unsigned)(m1 * 2048 + 16 * c1); }
    const unsigned goff = (unsigned)((dir ? 63 - lane : lane) * 64);
    unsigned trL0, trL1, trX;
    { const unsigned h = lane >> 5, blk = (lane >> 4) & 1u, q = (lane & 15u) >> 2, p = lane & 3u; const unsigned A = 256u * (8u * h + q) + 8u * (p & 1u), lo = 2u * blk + (p >> 1);
      trL0 = A + 16u * (lo ^ ((2u * h) & 3u)); trL1 = A + 16u * (lo ^ ((2u * h + 1u) & 3u)) + 1024u; trX = 64u * q; }
    f32x16 C[4]; f32x4 n4 = {0.f, 0.f, 0.f, 0.f};
#pragma unroll
    for (int i = 0; i < 4; ++i) C[i] = (f32x16){0.f};
    const char* gq = (const char*)(ws + WS_MQ) + ((size_t)b * SEQ * 512 + hd * 128) * 2; const char* gk = (const char*)(ws + WS_MK) + ((size_t)b * SEQ * 512 + hd * 128) * 2;
    const char* gv = (const char*)(ws + WS_MV) + ((size_t)b * SEQ * 1024 + hd * 256) * 2; const char* gg = (const char*)GT + (size_t)b * SEQ * 64;
    unsigned char* ho = ws + (dir ? WS_HB : WS_HF) + ((size_t)(b * 4 + hd) * 32) * 32768 + wid * 4096 + lane * 16;
    const unsigned lds0 = (unsigned)(uintptr_t)lds;
#define ML_TB(c_) (MODE == 1 ? (dir ? (SEQ - 64) : 0) : (dir ? (SEQ - 64 * ((c_) + 1)) : 64 * (c_)))
#define ML_STAGE(bsel_, c_) do { const int tb_ = ML_TB(c_); const unsigned d_ = (unsigned)__builtin_amdgcn_readfirstlane((int)(lds0 + (bsel_) * BUFB + wid * 1024)); \
        const char* q_ = gq + (size_t)tb_ * 1024; const char* k_ = gk + (size_t)tb_ * 1024; const char* v_ = gv + (size_t)tb_ * 2048; \
        glds16(q_ + dq0, d_ + Q_OFF); glds16(q_ + dq1, d_ + Q_OFF + 8192); glds16(k_ + dq0, d_ + K_OFF); glds16(k_ + dq1, d_ + K_OFF + 8192); \
        glds16(v_ + dv0, d_ + V_OFF); glds16(v_ + dv1, d_ + V_OFF + 8192); glds16(v_ + 256 + dv0, d_ + V_OFF + 16384); glds16(v_ + 256 + dv1, d_ + V_OFF + 16384 + 8192); } while (0)
#define ML_GATES(c_, gi_, gf_) do { const char* g_ = gg + (size_t)ML_TB(c_) * 64 + goff; gi_ = *(const float*)g_; gf_ = *(const float*)(g_ + 16); } while (0)
#define ML_VEC(cc_, gi_, gf_, sc_out_) do { ML_LAS float* T_ = (ML_LAS float*)(lds + VEC_OFF + ((cc_) & 1) * VEC_SLOT); \
        const float bcs_ = dscan_add(gf_), cx_ = (gi_) - bcs_, cm_ = dscan_max(cx_), M_ = fmaxf(m, cm_); const float g_ = rdlane(bcs_, 63), M63_ = rdlane(M_, 63); \
        T_[lane] = __expf(cx_ - M63_); T_[64 + lane] = __expf(-(bcs_ + M63_)); \
        sc_out_ = __expf(m - M63_); m = g_ + M63_; } while (0)
    float m = 0.f, sc, sc_n = 1.f, gi_a, gf_a, gi_b = 0.f, gf_b = 0.f; u32x4 pend[4] = {{0u, 0u, 0u, 0u}, {0u, 0u, 0u, 0u}, {0u, 0u, 0u, 0u}, {0u, 0u, 0u, 0u}};
    ML_STAGE(0, 0); ML_GATES(0, gi_a, gf_a); ML_VEC(0, gi_a, gf_a, sc); ML_GATES(1, gi_a, gf_a);
    for (int c = 0; c < SEQ / 64; ++c) {
        const int bsel = c & 1;
        ML_LAS unsigned char* bQ = lds + bsel * BUFB + Q_OFF; ML_LAS unsigned char* bK = lds + bsel * BUFB + K_OFF; ML_LAS unsigned char* bV = lds + bsel * BUFB + V_OFF;
        ML_LAS float* VWE = (ML_LAS float*)(lds + VEC_OFF + bsel * VEC_SLOT); ML_LAS float* VEMT = VWE + 64; ML_LAS float* VR = (ML_LAS float*)(lds + VR_OFF + wid * 256);
        asm volatile("s_waitcnt vmcnt(0) lgkmcnt(0)" ::: "memory"); __builtin_amdgcn_s_barrier(); asm volatile("" ::: "memory");
        if (c > 0) { unsigned char* hc = ho + (size_t)(c - 1) * 32768; *(u32x4*)(hc) = pend[0]; *(u32x4*)(hc + 1024) = pend[1]; *(u32x4*)(hc + 2048) = pend[2]; *(u32x4*)(hc + 3072) = pend[3]; }
        if (c + 1 < SEQ / 64) { ML_STAGE(bsel ^ 1, c + 1);
            if (c + 2 < SEQ / 64) ML_GATES(c + 2, gi_b, gf_b);
            ML_VEC(c + 1, gi_a, gf_a, sc_n); }
        if (MODE == 2) { asm volatile("s_waitcnt lgkmcnt(0)" ::: "memory"); __builtin_amdgcn_s_barrier(); continue; }
        { ML_OPAQUE_LANE(ln); const unsigned r15 = ln & 15u, kg = ln >> 4; const int tj = wid >> 1, sb = (wid & 1) * 2; const unsigned t = 16u * tj + r15;
          const unsigned xq = fxor(r15) << 4;
          ML_LAS unsigned char* qrow = bQ + 256u * t;
          bf16x8 qf[4];
#pragma unroll
          for (int ks = 0; ks < 4; ++ks) qf[ks] = *(const ML_LAS bf16x8*)(qrow + (((4u * ks + kg) << 4) ^ xq));
          float dsum = 0.f; const unsigned hb = 8u * (kg & 1u), kh = kg >> 1;
#pragma unroll
          for (int u = 0; u < 2; ++u) { const unsigned si = sb + u; ML_LAS unsigned char* krow = bK + 256u * (16u * si + r15) + hb;
              f32x4 acc = {0.f, 0.f, 0.f, 0.f};
#pragma unroll
              for (int ks = 0; ks < 4; ++ks) { const unsigned g2 = 4u * ks + 2u * kh;
                  const u32x2 lo = *(const ML_LAS u32x2*)(krow + ((g2 << 4) ^ xq)), hi = *(const ML_LAS u32x2*)(krow + (((g2 + 1u) << 4) ^ xq));
                  const u32x4 kw = {lo.x, lo.y, hi.x, hi.y};
                  acc = __builtin_amdgcn_mfma_f32_16x16x32_bf16(__builtin_bit_cast(bf16x8, kw), qf[ks], acc, 0, 0, 0); }
              const unsigned s0 = 16u * si + 4u * kg; const f32x4 ws4 = *(const ML_LAS f32x4*)(VWE + s0);
              float p[4];
#pragma unroll
              for (int r = 0; r < 4; ++r) { p[r] = (s0 + r <= t) ? acc[r] : 0.f; dsum = fmaf(p[r], ws4[r], dsum); }
              const u32x2 pw = {pkbf(p[0], p[1]), pkbf(p[2], p[3])};
              *(ML_LAS u32x2*)(lds + P_OFF + 128u * t + (((2u * si + kh) ^ (t & 7u)) << 4) + hb) = pw; }
          dsum += __shfl_xor(dsum, 16); dsum += __shfl_xor(dsum, 32);
          if (ln < 16u) DENP[(wid & 1) * 64 + t] = dsum; }
        n4 = n4 * sc;
        { ML_OPAQUE_LANE(ln); const unsigned r15 = ln & 15u, kg = ln >> 4; if (r15 == 0) *(ML_LAS f32x4*)(NB + 4 * kg) = n4;
          const f32x4 nA = *(const ML_LAS f32x4*)(NB + 0), nB = *(const ML_LAS f32x4*)(NB + 4), nC = *(const ML_LAS f32x4*)(NB + 8), nD = *(const ML_LAS f32x4*)(NB + 12);
          const unsigned t = ln; ML_LAS unsigned char* qrow = bQ + 256u * t; const unsigned xq = fxor(t) << 4;
          const bf16x8 c0 = *(const ML_LAS bf16x8*)(qrow + (((2u * wid) << 4) ^ xq)), c1 = *(const ML_LAS bf16x8*)(qrow + (((2u * wid + 1u) << 4) ^ xq));
          float qn = 0.f;
#pragma unroll
          for (int e = 0; e < 4; ++e) { qn = fmaf(s2f(c0[e]), nA[e], qn); qn = fmaf(s2f(c0[4 + e]), nC[e], qn); qn = fmaf(s2f(c1[e]), nB[e], qn); qn = fmaf(s2f(c1[4 + e]), nD[e], qn); }
          QNP[wid * 64 + t] = qn; }
        f32x16 Y0, Y1;
        { ML_OPAQUE_LANE(ln); const unsigned r31 = ln & 31u, h5 = ln >> 5; const unsigned xq = fxor(r31) << 4; ML_LAS unsigned char* q0 = bQ + 256u * r31; ML_LAS unsigned char* q1 = q0 + 256u * 32u;
#pragma unroll
          for (int i = 0; i < 4; ++i) { C[i] = C[i] * sc;
#pragma unroll
              for (int s = 0; s < 2; ++s) { const bf16x8 bfr = pack8(C[i][8 * s + 0], C[i][8 * s + 1], C[i][8 * s + 2], C[i][8 * s + 3], C[i][8 * s + 4], C[i][8 * s + 5], C[i][8 * s + 6], C[i][8 * s + 7]);
                  const unsigned co = ((4u * i + 2u * s + h5) << 4) ^ xq;
                  const bf16x8 a0 = *(const ML_LAS bf16x8*)(q0 + co), a1 = *(const ML_LAS bf16x8*)(q1 + co);
                  if (i == 0 && s == 0) { Y0 = __builtin_amdgcn_mfma_f32_32x32x16_bf16(a0, bfr, (f32x16){0.f}, 0, 0, 0); Y1 = __builtin_amdgcn_mfma_f32_32x32x16_bf16(a1, bfr, (f32x16){0.f}, 0, 0, 0); }
                  else { Y0 = __builtin_amdgcn_mfma_f32_32x32x16_bf16(a0, bfr, Y0, 0, 0, 0); Y1 = __builtin_amdgcn_mfma_f32_32x32x16_bf16(a1, bfr, Y1, 0, 0, 0); } } } }
        bf16x8 vw[4];
        { ML_OPAQUE_LANE(ln); const unsigned h5 = ln >> 5, kg = ln >> 4; const unsigned vt = wid >> 2, vc = wid & 3; bf16x8 vf[4];
          ML_LAS unsigned char* v0 = bV + 16384u * vt + ((64u * vc) ^ trX); ML_LAS unsigned char* va = v0 + trL0; ML_LAS unsigned char* vb = v0 + trL1;
#pragma unroll
          for (int ks = 0; ks < 4; ++ks) vf[ks] = cat8(trrd(va + 4096 * ks), trrd(vb + 4096 * ks));
          ML_LAS float* vwe = VWE + 8 * h5;
#pragma unroll
          for (int ks = 0; ks < 4; ++ks) { const f32x4 w0 = *(const ML_LAS f32x4*)(vwe + 16 * ks), w1 = *(const ML_LAS f32x4*)(vwe + 16 * ks + 4);
              vw[ks] = pack8(s2f(vf[ks][0]) * w0[0], s2f(vf[ks][1]) * w0[1], s2f(vf[ks][2]) * w0[2], s2f(vf[ks][3]) * w0[3], s2f(vf[ks][4]) * w1[0], s2f(vf[ks][5]) * w1[1], s2f(vf[ks][6]) * w1[2], s2f(vf[ks][7]) * w1[3]); }
          ML_LAS unsigned char* ka = bK + trL0; ML_LAS unsigned char* kb = bK + trL1;
#pragma unroll
          for (int i = 0; i < 4; ++i) { const unsigned xo = (64u * i) ^ trX;
#pragma unroll
              for (int ks = 0; ks < 4; ++ks) C[i] = __builtin_amdgcn_mfma_f32_32x32x16_bf16(cat8(trrd(ka + xo + 4096 * ks), trrd(kb + xo + 4096 * ks)), vw[ks], C[i], 0, 0, 0); }
          ML_LAS unsigned char* t16a = bK + tr_addr16(ln, wid, 0, 0); ML_LAS unsigned char* t16b = bK + tr_addr16(ln, wid, 0, 1);
#pragma unroll
          for (int ks = 0; ks < 2; ++ks) { const bf16x8 af = cat8(trrd(t16a + 8192 * ks), trrd(t16b + 8192 * ks));
              const f32x4 w0 = *(const ML_LAS f32x4*)(VWE + 32 * ks + 8 * kg), w1 = *(const ML_LAS f32x4*)(VWE + 32 * ks + 8 * kg + 4);
              n4 = __builtin_amdgcn_mfma_f32_16x16x32_bf16(af, pack8(w0[0], w0[1], w0[2], w0[3], w1[0], w1[1], w1[2], w1[3]), n4, 0, 0, 0); } }
        asm volatile("s_waitcnt lgkmcnt(0)" ::: "memory"); __builtin_amdgcn_s_barrier(); asm volatile("" ::: "memory");
        { ML_OPAQUE_LANE(ln); const unsigned r31 = ln & 31u, h5 = ln >> 5;
          ML_LAS unsigned char* p0 = lds + P_OFF + 128u * r31; ML_LAS unsigned char* p1 = p0 + 128u * 32u; const unsigned xp = (r31 & 7u) << 4;
#pragma unroll
          for (int ks = 0; ks < 4; ++ks) { const unsigned co = ((2u * ks + h5) << 4) ^ xp;
              const bf16x8 a0 = *(const ML_LAS bf16x8*)(p0 + co), a1 = *(const ML_LAS bf16x8*)(p1 + co);
              Y0 = __builtin_amdgcn_mfma_f32_32x32x16_bf16(a0, vw[ks], Y0, 0, 0, 0); Y1 = __builtin_amdgcn_mfma_f32_32x32x16_bf16(a1, vw[ks], Y1, 0, 0, 0); } }
        { ML_OPAQUE_LANE(ln); const unsigned t = ln; float qs = 0.f;
#pragma unroll
          for (int w8 = 0; w8 < 8; ++w8) qs += QNP[w8 * 64 + t];
          const float dn = DENP[t] + DENP[64 + t] + qs; VR[t] = 1.f / fmaxf(fabsf(dn), VEMT[t]); }
        { ML_OPAQUE_LANE(ln); const unsigned h5 = ln >> 5; ML_LAS float* vr = VR + 4 * h5;
#pragma unroll
          for (int qp = 0; qp < 2; ++qp) { const f32x4 ra = *(const ML_LAS f32x4*)(vr + 16 * qp), rb = *(const ML_LAS f32x4*)(vr + 16 * qp + 8), rc = *(const ML_LAS f32x4*)(vr + 32 + 16 * qp), rd = *(const ML_LAS f32x4*)(vr + 32 + 16 * qp + 8);
              const int o = 8 * qp;
              const u32x4 w0 = {pkbf(Y0[o + 0] * ra[0], Y0[o + 1] * ra[1]), pkbf(Y0[o + 2] * ra[2], Y0[o + 3] * ra[3]), pkbf(Y0[o + 4] * rb[0], Y0[o + 5] * rb[1]), pkbf(Y0[o + 6] * rb[2], Y0[o + 7] * rb[3])};
              const u32x4 w1 = {pkbf(Y1[o + 0] * rc[0], Y1[o + 1] * rc[1]), pkbf(Y1[o + 2] * rc[2], Y1[o + 3] * rc[3]), pkbf(Y1[o + 4] * rd[0], Y1[o + 5] * rd[1]), pkbf(Y1[o + 6] * rd[2], Y1[o + 7] * rd[3])};
              pend[qp] = w0; pend[2 + qp] = w1; } }
        asm volatile("" : "+v"(gi_b), "+v"(gf_b));
        sc = sc_n; gi_a = gi_b; gf_a = gf_b;
    }
    { unsigned char* hc = ho + (size_t)(SEQ / 64 - 1) * 32768; *(u32x4*)(hc) = pend[0]; *(u32x4*)(hc + 1024) = pend[1]; *(u32x4*)(hc + 2048) = pend[2]; *(u32x4*)(hc + 3072) = pend[3]; }
#undef ML_STAGE
#undef ML_GATES
#undef ML_VEC
#undef ML_TB
    __syncthreads();
}
}

constexpr int NWAVES = 8;
constexpr int RING_BYTES = 131072;
constexpr int LDS_BYTES = 163840;
constexpr int XCH_OFF = RING_BYTES, ROPE_LDS_OFF = XCH_OFF + 8192, QKG_LDS_OFF = ROPE_LDS_OFF + 16384;
static_assert(QKG_LDS_OFF + 1024 <= LDS_BYTES - 16, "in-projection LDS map");
static_assert(ml::LDS_END <= LDS_BYTES, "mLSTM LDS map");
#define LAS __attribute__((address_space(3)))
#define GAS __attribute__((address_space(1)))
typedef unsigned v4u __attribute__((ext_vector_type(4)));
typedef unsigned v2u __attribute__((ext_vector_type(2)));
typedef float f32x4 __attribute__((ext_vector_type(4)));
#define LDS_WAIT() asm volatile("s_waitcnt lgkmcnt(0)" ::: "memory")

struct Args { const float* in[9]; float* out; unsigned char* ws; int ph_lo, ph_hi; };

__device__ __forceinline__ float wave_sum(float v) {
#pragma unroll
    for (int o = 1; o < 64; o <<= 1) v += __shfl_xor(v, o);
    return v;
}

#define XB_TMO      128
#define XB_XCNT(j)  (256  + 64 * (j))
#define XB_XSUB(j)  (1280 + 64 * (j))
#define XB_XGEN(j)  (2304 + 64 * (j))
#define XB_TOP      3328
#define XB_TOPGEN   3392
#define XCD_BAR_WORDS 3456
#define XB_SPIN_CAP (1u << 18)

__device__ __forceinline__ unsigned xb_ld(unsigned* p)              { return __hip_atomic_load(p, __ATOMIC_RELAXED, __HIP_MEMORY_SCOPE_AGENT); }
__device__ __forceinline__ unsigned xb_add(unsigned* p, unsigned v) { return __hip_atomic_fetch_add(p, v, __ATOMIC_RELAXED, __HIP_MEMORY_SCOPE_AGENT); }
__device__ __forceinline__ unsigned xb_xcc_id() { return (unsigned)__builtin_amdgcn_s_getreg((3 << 11) | 20) & 0xFu; }
#define XB_SPIN(cond, bar) do { unsigned _sp = 0; while (cond) { __builtin_amdgcn_s_sleep(1); \
    if ((++_sp & 255u) == 0u) { if (xb_ld(&(bar)[XB_TMO])) break; if (_sp > XB_SPIN_CAP) { atomicAdd(&(bar)[XB_TMO], 1u); break; } } } } while (0)

struct XcdBarrier {
    unsigned* bar; unsigned x;
    volatile LAS unsigned* st;
};

__device__ __forceinline__ XcdBarrier xcd_barrier_post(unsigned* bar, volatile LAS unsigned* st) {
    XcdBarrier b; b.bar = bar; b.x = xb_xcc_id(); b.st = st;
    if (threadIdx.x == 0) (void)xb_add(&bar[XB_XCNT(b.x)], 1u);
    return b;
}
__device__ __forceinline__ void xcd_barrier_complete(unsigned* bar, unsigned x, unsigned& nloc, unsigned& nx) {
    const unsigned G = gridDim.x * gridDim.y * gridDim.z;
    unsigned sum, cnt, mine, sp = 0u;
    for (;;) {
        sum = 0u; cnt = 0u; mine = 0u;
#pragma unroll
        for (unsigned j = 0; j < 16; ++j) { const unsigned c = xb_ld(&bar[XB_XCNT(j)]); sum += c; cnt += (c > 0u) ? 1u : 0u; mine = (j == x) ? c : mine; }
        if (sum == G) break;
        __builtin_amdgcn_s_sleep(1);
        if ((++sp & 255u) == 0u) { if (xb_ld(&bar[XB_TMO])) break; if (sp > XB_SPIN_CAP) { atomicAdd(&bar[XB_TMO], 1u); break; } }
    }
    nloc = mine > 0u ? mine : 1u; nx = cnt > 0u ? cnt : 1u;
}

__device__ __forceinline__ void xcd_barrier(const XcdBarrier& b) {
    asm volatile("s_waitcnt vmcnt(0)" ::: "memory");
    __syncthreads();
    if (threadIdx.x == 0) {
        unsigned* bar = b.bar;
        __builtin_amdgcn_s_waitcnt(0);
        unsigned nloc = b.st[0], nx = b.st[1];
        if (nloc == 0u) { xcd_barrier_complete(bar, b.x, nloc, nx); b.st[0] = nloc; b.st[1] = nx; }
        const unsigned old = xb_add(&bar[XB_XSUB(b.x)], 1u);
        const unsigned gen = old / nloc;
        if (old + 1u == (gen + 1u) * nloc) {
            __builtin_amdgcn_fence(__ATOMIC_RELEASE, "agent");
            asm volatile("s_waitcnt vmcnt(0)" ::: "memory");
            const unsigned og = xb_add(&bar[XB_TOP], 1u);
            const unsigned tg = og / nx;
            if (og + 1u == (tg + 1u) * nx) xb_add(&bar[XB_TOPGEN], 1u);
            else XB_SPIN(xb_ld(&bar[XB_TOPGEN]) == tg, bar);
            __builtin_amdgcn_fence(__ATOMIC_ACQUIRE, "agent");
            xb_add(&bar[XB_XGEN(b.x)], 1u);
            asm volatile("s_waitcnt vmcnt(0)" ::: "memory");
        } else {
            XB_SPIN(xb_ld(&bar[XB_XGEN(b.x)]) == gen, bar);
            __builtin_amdgcn_fence(__ATOMIC_ACQUIRE, "agent");
            asm volatile("s_waitcnt vmcnt(0)" ::: "memory");
        }
    }
    __syncthreads();
}

__device__ __forceinline__ int w1_dest_row(int n) {
    if (!HY_SEPARATE_ROPE && n < 1280) { const int s = n & 255; return (n & ~255) | (s & 0xC3) | ((s & 0x10) << 1) | ((s & 0x0C) << 1) | ((s & 0x20) >> 3); }
    if (n >= 2560 && n < 3072) return (n & ~12) | ((n & 4) << 1) | ((n & 8) >> 1);
    return n;
}
__device__ __forceinline__ void p0_transpose_item(const float* W, int K, int ldw, int nblk, bf16* WT, LAS float* scr, int item, int lane, bool is_w1) {
    const int kb = item / nblk, nb = item % nblk, k0 = 64 * kb, n0 = 32 * nb;
#pragma unroll 8
    for (int i = 0; i < 32; ++i) { const int kk = 2 * i + (lane >> 5); scr[kk * 33 + (lane & 31)] = W[(size_t)(k0 + kk) * ldw + n0 + (lane & 31)]; }
    LDS_WAIT(); asm volatile("" ::: "memory");
    const int c = lane & 7;
#pragma unroll
    for (int j = 0; j < 4; ++j) { const int n = (lane >> 3) + 8 * j; const LAS float* s = scr + (8 * c) * 33 + n;
        const float ws_ = (is_w1 && n0 + n >= 2560 && n0 + n < 3072) ? 0.08838834764831845f : 1.f;
        v4u o; o.x = pk2(s[0 * 33] * ws_, s[1 * 33] * ws_); o.y = pk2(s[2 * 33] * ws_, s[3 * 33] * ws_); o.z = pk2(s[4 * 33] * ws_, s[5 * 33] * ws_); o.w = pk2(s[6 * 33] * ws_, s[7 * 33] * ws_);
        int nr = n0 + n; if (is_w1) nr = w1_dest_row(nr);
        if (is_w1 && n0 < NF8) {
            v2u o8; o8.x = pk4f8(s[0 * 33] * W8_SCALE, s[1 * 33] * W8_SCALE, s[2 * 33] * W8_SCALE, s[3 * 33] * W8_SCALE); o8.y = pk4f8(s[4 * 33] * W8_SCALE, s[5 * 33] * W8_SCALE, s[6 * 33] * W8_SCALE, s[7 * 33] * W8_SCALE);
            *(v2u*)((unsigned char*)WT + (size_t)nr * K + k0 + 8 * c) = o8; }
        else *(v4u*)(WT + (size_t)nr * K + k0 + 8 * c) = o; }
    LDS_WAIT(); asm volatile("" ::: "memory");
}
__device__ __forceinline__ void rms_rows2_to_bf16(const float* xrow0, const float* xrow1, const float* g, bf16* orow0, bf16* orow1, unsigned char* frow0, unsigned char* frow1, int lane) {
    const f32x4* xa = (const f32x4*)xrow0 + lane; const f32x4* xb = (const f32x4*)xrow1 + lane; const f32x4* gr = (const f32x4*)g + lane;
    f32x4 v[8], w[8]; float s = 0.f, t = 0.f;
#pragma unroll
    for (int j = 0; j < 8; ++j) { v[j] = __builtin_nontemporal_load(xa + 64 * j); w[j] = __builtin_nontemporal_load(xb + 64 * j); }
#pragma unroll
    for (int j = 0; j < 8; ++j) { s += (v[j].x * v[j].x + v[j].y * v[j].y) + (v[j].z * v[j].z + v[j].w * v[j].w); t += (w[j].x * w[j].x + w[j].y * w[j].y) + (w[j].z * w[j].z + w[j].w * w[j].w); }
    const float r0 = 1.f / sqrtf(wave_sum(s) * (1.f / DM) + EPS), r1 = 1.f / sqrtf(wave_sum(t) * (1.f / DM) + EPS);
    v2u* o0 = (v2u*)orow0 + lane; v2u* o1 = (v2u*)orow1 + lane; unsigned* f0 = (unsigned*)frow0 + lane; unsigned* f1 = (unsigned*)frow1 + lane;
#pragma unroll
    for (int j = 0; j < 8; ++j) { const f32x4 gg = gr[64 * j]; v2u a, b;
        const float a0 = v[j].x * r0 * gg.x, a1 = v[j].y * r0 * gg.y, a2 = v[j].z * r0 * gg.z, a3 = v[j].w * r0 * gg.w;
        const float b0 = w[j].x * r1 * gg.x, b1 = w[j].y * r1 * gg.y, b2 = w[j].z * r1 * gg.z, b3 = w[j].w * r1 * gg.w;
        a.x = pk2(a0, a1); a.y = pk2(a2, a3); o0[64 * j] = a; f0[64 * j] = pk4f8(a0 * H8_SCALE, a1 * H8_SCALE, a2 * H8_SCALE, a3 * H8_SCALE);
        b.x = pk2(b0, b1); b.y = pk2(b2, b3); o1[64 * j] = b; f1[64 * j] = pk4f8(b0 * H8_SCALE, b1 * H8_SCALE, b2 * H8_SCALE, b3 * H8_SCALE); }
}
__device__ __forceinline__ void p0_prologue(const Args& a, LAS unsigned char* lds, int vcu, int G, int tid, int wave, int lane) {
    unsigned char* ws = a.ws;
    const float* w_in = a.in[3]; const float* w_out = a.in[8]; const float* norm_g = a.in[2];
    bf16* W1t = (bf16*)(ws + WS_W1T); bf16* W2t = (bf16*)(ws + WS_W2T);
    const int gw = vcu * NWAVES + wave, NGW = G * NWAVES; const int gt = vcu * (NWAVES * 64) + tid, NGT = G * NWAVES * 64;
    for (int e = gt; e < 64 * 32; e += NGT) { const int pos = e >> 5, j = e & 31; const float inv = 1.0f / powf(10000.0f, (float)j * (1.0f / 32.0f)); const float ang = (float)pos * inv;
        float* R = (float*)(ws + WS_ROPE); R[2 * e] = cosf(ang); R[2 * e + 1] = sinf(ang); }
    for (int e = gt; e < 16 * DM; e += NGT) { const int g = e >> 11, k = e & (DM - 1); W1t[(size_t)(NP256 + g) * DM + k] = (bf16)f2bf(w_in[(size_t)k * NPROJ + NP256 + g]); }
    LAS float* scr = (LAS float*)(lds + wave * 16384);
    constexpr int I_1 = (DM / 64) * (NP256 / 32), I_2 = (DM / 64) * (DM / 32);
    for (int it = gw; it < I_1 + I_2; it += NGW) {
        if (it < I_1) p0_transpose_item(w_in, DM, NPROJ, NP256 / 32, W1t, scr, it, lane, true);
        else p0_transpose_item(w_out, DM, DM, DM / 32, W2t, scr, it - I_1, lane, false);
    }
    bf16* H = (bf16*)(ws + WS_H); unsigned char* H8 = (unsigned char*)a.out;
    for (int m = gw; m < NTOK; m += 2 * NGW) { const int m1 = (m + NGW < NTOK) ? m + NGW : m;
        const float* xr0 = (m < TOK_PROMPT) ? a.in[0] + (size_t)m * DM : a.in[1] + (size_t)(m - TOK_PROMPT) * DM; const float* xr1 = (m1 < TOK_PROMPT) ? a.in[0] + (size_t)m1 * DM : a.in[1] + (size_t)(m1 - TOK_PROMPT) * DM;
        rms_rows2_to_bf16(xr0, xr1, norm_g, H + (size_t)m * DM, H + (size_t)m1 * DM, H8 + (size_t)m * DM, H8 + (size_t)m1 * DM, lane); }
}

__device__ __forceinline__ void p2_qknorm_rope(const Args& a, int vcu, int G, int wave, int lane) {
    unsigned char* ws = a.ws; const float* R = (const float*)(ws + WS_ROPE);
    const int gw = vcu * NWAVES + wave, NGW = G * NWAVES;
    const int fj = lane & 31, c0 = (lane < 32) ? lane : 64 + (lane - 32), c1 = c0 + 32;
    const float gq0 = a.in[5][c0], gq1 = a.in[5][c1], gk0 = a.in[6][c0], gk1 = a.in[6][c1];
    for (int it = gw; it < NTOK * 10; it += NGW) {
        const int t = it / 10, slot = it - t * 10; const int tl = t & (SEQ - 1); const int pos = (lane < 32) ? (tl >> 6) : (tl & 63);
        bf16* p = (slot < 8) ? (bf16*)(ws + WS_MIX) + (size_t)t * 2048 + slot * 128 : (bf16*)(ws + WS_AK) + (size_t)t * 256 + (slot - 8) * 128;
        const float x0 = bf2f(p[c0]), x1 = bf2f(p[c1]);
        const float r = 1.f / sqrtf(wave_sum(x0 * x0 + x1 * x1) * (1.f / 128.f) + EPS);
        const float y0 = x0 * r * ((slot < 8) ? gq0 : gk0), y1 = x1 * r * ((slot < 8) ? gq1 : gk1);
        const float cs = R[2 * (pos * 32 + fj)], sn = R[2 * (pos * 32 + fj) + 1];
        p[c0] = (bf16)f2bf(y0 * cs - y1 * sn); p[c1] = (bf16)f2bf(y1 * cs + y0 * sn);
    }
}

__device__ __forceinline__ void p4_mlstm_recurrent(const Args& a, LAS unsigned char* lds, int vcu, int G, int tid) {
    unsigned char* ws = a.ws;
    const bf16* MQ = (const bf16*)(ws + WS_MQ); const bf16* MK = (const bf16*)(ws + WS_MK); const bf16* MV = (const bf16*)(ws + WS_MV); const float* GT = (const float*)(ws + WS_GATES);
    LAS float* qs = (LAS float*)lds;
    LAS float* ks = qs + 32 * 128;
    LAS float* vs = ks + 32 * 128;
    LAS float* gi = vs + 32 * 256;
    LAS float* gf = gi + 32;
    const int dv = tid >> 1, half = tid & 1;
    for (int item = vcu; item < NSEQ * 8; item += G) {
        const int b = item >> 3, hd = (item >> 1) & 3, dir = item & 1;
        bf16* HO = (bf16*)(ws + (dir ? WS_HB : WS_HF));
        float C[64], nn[64]; float m = 0.f;
#pragma unroll
        for (int j = 0; j < 64; ++j) { C[j] = 0.f; nn[j] = 0.f; }
        for (int p0 = 0; p0 < SEQ; p0 += 32) {
            __syncthreads();
            { const int rr = tid >> 4, c8 = (tid & 15) * 8; const int tok = dir ? (SEQ - 1 - (p0 + rr)) : (p0 + rr); const size_t row = (size_t)b * SEQ + tok;
              const v4u q4 = *(const v4u*)(MQ + row * 512 + hd * 128 + c8), k4 = *(const v4u*)(MK + row * 512 + hd * 128 + c8);
              LAS float* kd = ks + rr * 128 + c8;
              { LAS float* qa = qs + rr * 128 + (c8 & ~8) + ((c8 & 8) >> 1);   qa[0] = bflo(q4.x); qa[1] = bfhi(q4.x); qa[2] = bflo(q4.y); qa[3] = bfhi(q4.y); qa[8] = bflo(q4.z); qa[9] = bfhi(q4.z); qa[10] = bflo(q4.w); qa[11] = bfhi(q4.w); }
              kd[0] = bflo(k4.x); kd[1] = bfhi(k4.x); kd[2] = bflo(k4.y); kd[3] = bfhi(k4.y); kd[4] = bflo(k4.z); kd[5] = bfhi(k4.z); kd[6] = bflo(k4.w); kd[7] = bfhi(k4.w);
              const int c16 = (tid & 15) * 16; LAS float* vd = vs + rr * 256 + c16;
#pragma unroll
              for (int h2 = 0; h2 < 2; ++h2) { const v4u v4 = *(const v4u*)(MV + row * 1024 + hd * 256 + c16 + 8 * h2);
                  vd[8 * h2 + 0] = bflo(v4.x); vd[8 * h2 + 1] = bfhi(v4.x); vd[8 * h2 + 2] = bflo(v4.y); vd[8 * h2 + 3] = bfhi(v4.y); vd[8 * h2 + 4] = bflo(v4.z); vd[8 * h2 + 5] = bfhi(v4.z); vd[8 * h2 + 6] = bflo(v4.w); vd[8 * h2 + 7] = bfhi(v4.w); }
              if (tid < 32) { const int tk = dir ? (SEQ - 1 - (p0 + tid)) : (p0 + tid); const size_t rw = (size_t)b * SEQ + tk; gi[tid] = GT[rw * 16 + dir * 8 + hd]; gf[tid] = GT[rw * 16 + dir * 8 + 4 + hd]; }
            }
            __syncthreads();
            for (int pp = 0; pp < 32; ++pp) {
                const float lf = gf[pp], ii = gi[pp];
                const float mn = fmaxf(lf + m, ii);
                const float ca = expf(lf + m - mn), cb = expf(ii - mn);
                const float bv = cb * vs[pp * 256 + dv];
                float hp = 0.f, qn = 0.f;
                const LAS float* kr = ks + pp * 128 + 64 * half; const LAS float* qr = qs + pp * 128 + 64 * half;
#pragma unroll
                for (int j = 0; j < 64; ++j) { const float kk = kr[j], qq = qr[j];
                    C[j] = fmaf(ca, C[j], kk * bv); nn[j] = fmaf(ca, nn[j], cb * kk); hp = fmaf(qq, C[j], hp); qn = fmaf(qq, nn[j], qn); }
                hp += __shfl_xor(hp, 1); qn += __shfl_xor(qn, 1);
                const float den = fmaxf(fabsf(qn), expf(-mn));
                if (half == 0) { const int pos = p0 + pp, cch = pos >> 6, o = pos & 63, tt = o >> 5, rho = o & 31, q = rho >> 3, hh = (rho >> 2) & 1, e = rho & 3;
                    HO[(((size_t)((b * 4 + hd) * 32 + cch) * 32768) + (dv >> 5) * 4096 + tt * 2048 + (q >> 1) * 1024 + (32 * hh + (dv & 31)) * 16) / 2 + 4 * (q & 1) + e] = (bf16)f2bf(hp / den); }
                m = mn;
            }
        }
    }
}

__device__ __forceinline__ void p5_mlstm_finalize(const Args& a, LAS unsigned char* lds, int vcu, int G, int tid, int wave, int lane) {
    unsigned char* ws = a.ws; const float* mg = a.in[7];
    const bf16* MO = (const bf16*)(ws + WS_MO); const bf16* MZ = (const bf16*)(ws + WS_MZ); bf16* MIX = (bf16*)(ws + WS_MIX);
    LAS float* XS = (LAS float*)lds;
    const int r31 = lane & 31, h5 = lane >> 5, dv0 = 8 * r31;
    constexpr int NIT = NSEQ * 4 * 32;
    v4u f[2][2], bb[2][2];
#define P5_LOAD_H(item_) do { const int bh_ = (item_) >> 5, ck_ = (item_) & 31; \
        const unsigned char* hf_ = ws + WS_HF + ((size_t)bh_ * 32 + ck_) * 32768 + wave * 4096 + lane * 16; const unsigned char* hb_ = ws + WS_HB + ((size_t)bh_ * 32 + (31 - ck_)) * 32768 + wave * 4096 + (lane ^ 32) * 16; \
        _Pragma("unroll") for (int tt = 0; tt < 2; ++tt) _Pragma("unroll") for (int qp = 0; qp < 2; ++qp) { f[tt][qp] = *(const v4u*)(hf_ + tt * 2048 + qp * 1024); bb[tt][qp] = *(const v4u*)(hb_ + (1 - tt) * 2048 + (1 - qp) * 1024); } } while (0)
    if (vcu < NIT) P5_LOAD_H(vcu);
    for (int item = vcu; item < NIT; item += G) {
        const int bh = item >> 5, ck = item & 31, b = bh >> 2, hd = bh & 3;
        v4u mo[4], mz[4];
#pragma unroll
        for (int it = 0; it < 4; ++it) { const int o = it * 16 + wave * 2 + h5; const size_t row = (size_t)b * SEQ + ck * 64 + o;
            mo[it] = *(const v4u*)(MO + row * 1024 + hd * 256 + dv0); mz[it] = *(const v4u*)(MZ + row * 1024 + hd * 256 + dv0); }
        __syncthreads();
#pragma unroll
        for (int tt = 0; tt < 2; ++tt)
#pragma unroll
            for (int qp = 0; qp < 2; ++qp) { const v4u fv = f[tt][qp], bv = bb[tt][qp];
                float fs[8] = {bflo(fv.x), bfhi(fv.x), bflo(fv.y), bfhi(fv.y), bflo(fv.z), bfhi(fv.z), bflo(fv.w), bfhi(fv.w)};
                float bs[8] = {bflo(bv.x), bfhi(bv.x), bflo(bv.y), bfhi(bv.y), bflo(bv.z), bfhi(bv.z), bflo(bv.w), bfhi(bv.w)};
#pragma unroll
                for (int j = 0; j < 8; ++j) { const int o = 32 * tt + 8 * (2 * qp + (j >> 2)) + 4 * h5 + (j & 3); XS[o * 256 + 32 * wave + r31] = fs[j] + bs[7 - j]; } }
        __syncthreads();
        if (item + G < NIT) P5_LOAD_H(item + G);
        const f32x4 g0 = *(const f32x4*)(mg + hd * 256 + dv0), g1 = *(const f32x4*)(mg + hd * 256 + dv0 + 4);
        const float gg[8] = {g0[0], g0[1], g0[2], g0[3], g1[0], g1[1], g1[2], g1[3]};
#pragma unroll
        for (int it = 0; it < 4; ++it) { const int o = it * 16 + wave * 2 + h5; const size_t row = (size_t)b * SEQ + ck * 64 + o;
            const f32x4 x0 = *(const LAS f32x4*)(XS + o * 256 + dv0), x1 = *(const LAS f32x4*)(XS + o * 256 + dv0 + 4);
            float hm[8] = {x0[0], x0[1], x0[2], x0[3], x1[0], x1[1], x1[2], x1[3]};
            const float mo8[8] = {bflo(mo[it].x), bfhi(mo[it].x), bflo(mo[it].y), bfhi(mo[it].y), bflo(mo[it].z), bfhi(mo[it].z), bflo(mo[it].w), bfhi(mo[it].w)};
            const float mz8[8] = {bflo(mz[it].x), bfhi(mz[it].x), bflo(mz[it].y), bfhi(mz[it].y), bflo(mz[it].z), bfhi(mz[it].z), bflo(mz[it].w), bfhi(mz[it].w)};
            float ss = 0.f;
#pragma unroll
            for (int j = 0; j < 8; ++j) { hm[j] = hm[j] * __builtin_amdgcn_rcpf(1.f + __expf(-mo8[j])); ss += hm[j] * hm[j]; }
#pragma unroll
            for (int s = 1; s < 32; s <<= 1) ss += __shfl_xor(ss, s);
            const float r = __builtin_amdgcn_rsqf(ss * (1.f / 256.f) + EPS);
            float ov[8];
#pragma unroll
            for (int j = 0; j < 8; ++j) ov[j] = hm[j] * r * gg[j] * (mz8[j] * __builtin_amdgcn_rcpf(1.f + __expf(-mz8[j])));
            v4u w; w.x = pk2(ov[0], ov[1]); w.y = pk2(ov[2], ov[3]); w.z = pk2(ov[4], ov[5]); w.w = pk2(ov[6], ov[7]);
            *(v4u*)(MIX + row * 2048 + 1024 + hd * 256 + dv0) = w; }
    }
#undef P5_LOAD_H
    __syncthreads();
}

__device__ __forceinline__ void p5_item(const Args& a, LAS unsigned char* lds, int item) {
    int tid_ = threadIdx.x; asm volatile("" : "+v"(tid_));
    const int lane = tid_ & 63, wave = __builtin_amdgcn_readfirstlane(tid_ >> 6);
    unsigned char* ws = a.ws; const float* mg = a.in[7];
    const bf16* MO = (const bf16*)(ws + WS_MO); const bf16* MZ = (const bf16*)(ws + WS_MZ); bf16* MIX = (bf16*)(ws + WS_MIX);
    LAS float* XS = (LAS float*)lds; const int r31 = lane & 31, h5 = lane >> 5, dv0 = 8 * r31;
    const int bh = item >> 5, ck = item & 31, b = bh >> 2, hd = bh & 3;
    const unsigned char* hf_ = ws + WS_HF + ((size_t)bh * 32 + ck) * 32768 + wave * 4096 + lane * 16; const unsigned char* hb_ = ws + WS_HB + ((size_t)bh * 32 + (31 - ck)) * 32768 + wave * 4096 + (lane ^ 32) * 16;
    v4u f[2][2], bb[2][2], mo[4], mz[4];
#pragma unroll
    for (int tt = 0; tt < 2; ++tt)
#pragma unroll
        for (int qp = 0; qp < 2; ++qp) { f[tt][qp] = *(const v4u*)(hf_ + tt * 2048 + qp * 1024); bb[tt][qp] = *(const v4u*)(hb_ + (1 - tt) * 2048 + (1 - qp) * 1024); }
#pragma unroll
    for (int it = 0; it < 4; ++it) { const int o = it * 16 + wave * 2 + h5; const size_t row = (size_t)b * SEQ + ck * 64 + o;
        mo[it] = *(const v4u*)(MO + row * 1024 + hd * 256 + dv0); mz[it] = *(const v4u*)(MZ + row * 1024 + hd * 256 + dv0); }
    __syncthreads();
#pragma unroll
    for (int tt = 0; tt < 2; ++tt)
#pragma unroll
        for (int qp = 0; qp < 2; ++qp) { const v4u fv = f[tt][qp], bv = bb[tt][qp];
            float fs[8] = {bflo(fv.x), bfhi(fv.x), bflo(fv.y), bfhi(fv.y), bflo(fv.z), bfhi(fv.z), bflo(fv.w), bfhi(fv.w)};
            float bs[8] = {bflo(bv.x), bfhi(bv.x), bflo(bv.y), bfhi(bv.y), bflo(bv.z), bfhi(bv.z), bflo(bv.w), bfhi(bv.w)};
#pragma unroll
            for (int j = 0; j < 8; ++j) { const int o = 32 * tt + 8 * (2 * qp + (j >> 2)) + 4 * h5 + (j & 3); XS[o * 256 + 32 * wave + r31] = fs[j] + bs[7 - j]; } }
    __syncthreads();
    const f32x4 g0 = *(const f32x4*)(mg + hd * 256 + dv0), g1 = *(const f32x4*)(mg + hd * 256 + dv0 + 4);
    const float gg[8] = {g0[0], g0[1], g0[2], g0[3], g1[0], g1[1], g1[2], g1[3]};
#pragma unroll
    for (int it = 0; it < 4; ++it) { const int o = it * 16 + wave * 2 + h5; const size_t row = (size_t)b * SEQ + ck * 64 + o;
        const f32x4 x0 = *(const LAS f32x4*)(XS + o * 256 + dv0), x1 = *(const LAS f32x4*)(XS + o * 256 + dv0 + 4);
        float hm[8] = {x0[0], x0[1], x0[2], x0[3], x1[0], x1[1], x1[2], x1[3]};
        const float mo8[8] = {bflo(mo[it].x), bfhi(mo[it].x), bflo(mo[it].y), bfhi(mo[it].y), bflo(mo[it].z), bfhi(mo[it].z), bflo(mo[it].w), bfhi(mo[it].w)};
        const float mz8[8] = {bflo(mz[it].x), bfhi(mz[it].x), bflo(mz[it].y), bfhi(mz[it].y), bflo(mz[it].z), bfhi(mz[it].z), bflo(mz[it].w), bfhi(mz[it].w)};
        float ss = 0.f;
#pragma unroll
        for (int j = 0; j < 8; ++j) { hm[j] = hm[j] * __builtin_amdgcn_rcpf(1.f + __expf(-mo8[j])); ss += hm[j] * hm[j]; }
#pragma unroll
        for (int s = 1; s < 32; s <<= 1) ss += __shfl_xor(ss, s);
        const float r = __builtin_amdgcn_rsqf(ss * (1.f / 256.f) + EPS);
        float ov[8];
#pragma unroll
        for (int j = 0; j < 8; ++j) ov[j] = hm[j] * r * gg[j] * (mz8[j] * __builtin_amdgcn_rcpf(1.f + __expf(-mz8[j])));
        v4u w; w.x = pk2(ov[0], ov[1]); w.y = pk2(ov[2], ov[3]); w.z = pk2(ov[4], ov[5]); w.w = pk2(ov[6], ov[7]);
        *(v4u*)(MIX + row * 2048 + 1024 + hd * 256 + dv0) = w; }
    __syncthreads();
}

__device__ __forceinline__ void p5_batch(const Args& a, LAS unsigned char* lds, int first, int count) {
    if (count <= 0) return;
    int tid_ = threadIdx.x; asm volatile("" : "+v"(tid_));
    const int lane = tid_ & 63, wave = __builtin_amdgcn_readfirstlane(tid_ >> 6);
    unsigned char* ws = a.ws; const float* mg = a.in[7];
    const bf16* MO = (const bf16*)(ws + WS_MO); const bf16* MZ = (const bf16*)(ws + WS_MZ); bf16* MIX = (bf16*)(ws + WS_MIX);
    LAS float* XS = (LAS float*)lds; const int r31 = lane & 31, h5 = lane >> 5, dv0 = 8 * r31;
    v4u f[2][2], bb[2][2];
#define P5B_LOAD_H(item_) do { const int bh_ = (item_) >> 5, ck_ = (item_) & 31; \
        const unsigned char* hf_ = ws + WS_HF + ((size_t)bh_ * 32 + ck_) * 32768 + wave * 4096 + lane * 16; const unsigned char* hb_ = ws + WS_HB + ((size_t)bh_ * 32 + (31 - ck_)) * 32768 + wave * 4096 + (lane ^ 32) * 16; \
        _Pragma("unroll") for (int tt = 0; tt < 2; ++tt) _Pragma("unroll") for (int qp = 0; qp < 2; ++qp) { f[tt][qp] = *(const v4u*)(hf_ + tt * 2048 + qp * 1024); bb[tt][qp] = *(const v4u*)(hb_ + (1 - tt) * 2048 + (1 - qp) * 1024); } } while (0)
    P5B_LOAD_H(first);
    for (int i = 0; i < count; ++i) {
        const int item = first + i, bh = item >> 5, ck = item & 31, b = bh >> 2, hd = bh & 3;
        v4u mo[4], mz[4];
#pragma unroll
        for (int it = 0; it < 4; ++it) { const int o = it * 16 + wave * 2 + h5; const size_t row = (size_t)b * SEQ + ck * 64 + o;
            mo[it] = *(const v4u*)(MO + row * 1024 + hd * 256 + dv0); mz[it] = *(const v4u*)(MZ + row * 1024 + hd * 256 + dv0); }
        __syncthreads();
#pragma unroll
        for (int tt = 0; tt < 2; ++tt)
#pragma unroll
            for (int qp = 0; qp < 2; ++qp) { const v4u fv = f[tt][qp], bv = bb[tt][qp];
                float fs[8] = {bflo(fv.x), bfhi(fv.x), bflo(fv.y), bfhi(fv.y), bflo(fv.z), bfhi(fv.z), bflo(fv.w), bfhi(fv.w)};
                float bs[8] = {bflo(bv.x), bfhi(bv.x), bflo(bv.y), bfhi(bv.y), bflo(bv.z), bfhi(bv.z), bflo(bv.w), bfhi(bv.w)};
#pragma unroll
                for (int j = 0; j < 8; ++j) { const int o = 32 * tt + 8 * (2 * qp + (j >> 2)) + 4 * h5 + (j & 3); XS[o * 256 + 32 * wave + r31] = fs[j] + bs[7 - j]; } }
        __syncthreads();
        if (i + 1 < count) P5B_LOAD_H(item + 1);
        const f32x4 g0 = *(const f32x4*)(mg + hd * 256 + dv0), g1 = *(const f32x4*)(mg + hd * 256 + dv0 + 4);
        const float gg[8] = {g0[0], g0[1], g0[2], g0[3], g1[0], g1[1], g1[2], g1[3]};
#pragma unroll
        for (int it = 0; it < 4; ++it) { const int o = it * 16 + wave * 2 + h5; const size_t row = (size_t)b * SEQ + ck * 64 + o;
            const f32x4 x0 = *(const LAS f32x4*)(XS + o * 256 + dv0), x1 = *(const LAS f32x4*)(XS + o * 256 + dv0 + 4);
            float hm[8] = {x0[0], x0[1], x0[2], x0[3], x1[0], x1[1], x1[2], x1[3]};
            const float mo8[8] = {bflo(mo[it].x), bfhi(mo[it].x), bflo(mo[it].y), bfhi(mo[it].y), bflo(mo[it].z), bfhi(mo[it].z), bflo(mo[it].w), bfhi(mo[it].w)};
            const float mz8[8] = {bflo(mz[it].x), bfhi(mz[it].x), bflo(mz[it].y), bfhi(mz[it].y), bflo(mz[it].z), bfhi(mz[it].z), bflo(mz[it].w), bfhi(mz[it].w)};
            float ss = 0.f;
#pragma unroll
            for (int j = 0; j < 8; ++j) { hm[j] = hm[j] * __builtin_amdgcn_rcpf(1.f + __expf(-mo8[j])); ss += hm[j] * hm[j]; }
#pragma unroll
            for (int s = 1; s < 32; s <<= 1) ss += __shfl_xor(ss, s);
            const float r = __builtin_amdgcn_rsqf(ss * (1.f / 256.f) + EPS);
            float ov[8];
#pragma unroll
            for (int j = 0; j < 8; ++j) ov[j] = hm[j] * r * gg[j] * (mz8[j] * __builtin_amdgcn_rcpf(1.f + __expf(-mz8[j])));
            v4u w; w.x = pk2(ov[0], ov[1]); w.y = pk2(ov[2], ov[3]); w.z = pk2(ov[4], ov[5]); w.w = pk2(ov[6], ov[7]);
            *(v4u*)(MIX + row * 2048 + 1024 + hd * 256 + dv0) = w; }
    }
#undef P5B_LOAD_H
    __syncthreads();
}

__device__ __forceinline__ void gate_rows48(unsigned char* ws, const float* b_gates, int row0, int lane) {
    typedef short bf16x8 __attribute__((ext_vector_type(8)));
    const int r15 = lane & 15, kg = lane >> 4;
    const bf16* a0p = (const bf16*)(ws + WS_H) + (size_t)(row0 + r15) * DM + 8 * kg; const bf16* a1p = a0p + 16 * DM; const bf16* a2p = a0p + 32 * DM;
    const bf16* bp = (const bf16*)(ws + WS_W1T) + (size_t)(NP256 + r15) * DM + 8 * kg;
    f32x4 acc0 = {0.f, 0.f, 0.f, 0.f}, acc1 = {0.f, 0.f, 0.f, 0.f}, acc2 = {0.f, 0.f, 0.f, 0.f};
#pragma unroll 8
    for (int ks = 0; ks < DM / 32; ++ks) { const bf16x8 a0 = *(const bf16x8*)(a0p + 32 * ks), a1 = *(const bf16x8*)(a1p + 32 * ks), a2 = *(const bf16x8*)(a2p + 32 * ks), b = *(const bf16x8*)(bp + 32 * ks);
        acc0 = __builtin_amdgcn_mfma_f32_16x16x32_bf16(a0, b, acc0, 0, 0, 0); acc1 = __builtin_amdgcn_mfma_f32_16x16x32_bf16(a1, b, acc1, 0, 0, 0); acc2 = __builtin_amdgcn_mfma_f32_16x16x32_bf16(a2, b, acc2, 0, 0, 0); }
    const float bias = b_gates[r15]; const bool isf = (r15 >> 2) & 1; float* G = (float*)(ws + WS_GATES) + (size_t)(row0 + 4 * kg) * 16 + r15;
#pragma unroll
    for (int r = 0; r < 4; ++r) { float v0 = acc0[r] + bias, v1 = acc1[r] + bias, v2 = acc2[r] + bias; if (isf) { v0 = log_sigmoid_f(v0); v1 = log_sigmoid_f(v1); v2 = log_sigmoid_f(v2); }
        G[r * 16] = v0; G[(16 + r) * 16] = v1; G[(32 + r) * 16] = v2; }
}

constexpr int N_PHASES = 7;
__global__ void __launch_bounds__(NWAVES * 64, 2) hy_fwd(Args args) {
    extern __shared__ __attribute__((aligned(16))) unsigned char lds_raw[];
    LAS unsigned char* lds = (LAS unsigned char*)lds_raw;
    const int tid = threadIdx.x, lane = tid & 63, wave = __builtin_amdgcn_readfirstlane(tid >> 6);
    const int G = gridDim.x; const int bx = blockIdx.x; const int vcu = (G % 8 == 0) ? (bx % 8) * (G / 8) + bx / 8 : bx;
    unsigned char* ws = args.ws;
    const int lo = args.ph_lo, hi = args.ph_hi;
    unsigned* ctl = (unsigned*)(ws + WS_CTL);
    volatile LAS unsigned* bst = (volatile LAS unsigned*)(lds + LDS_BYTES - 16);
    if (tid == 0) { bst[0] = 0u; bst[1] = 0u; }
    __syncthreads();
    XcdBarrier xbar; xbar.bar = ctl + CW_BAR; xbar.x = 0; xbar.st = bst; bool xposted = false;
    const bool one_launch = (lo == 0 && hi == N_PHASES);
    if (one_launch) { xbar = xcd_barrier_post(ctl + CW_BAR, bst); xposted = true; }
#ifndef HY_PHASE_MASK
#define HY_PHASE_MASK 0x7f
#endif
#define IN(k) (((HY_PHASE_MASK >> (k)) & 1) && lo <= (k) && (k) < hi)
#define BOTH(k) (IN(k) && IN((k) + 1))
#ifndef HY_DUP_MASK
#define HY_DUP_MASK 0
#endif
#ifndef HY_PROBE_NULL
#define HY_PROBE_NULL 0
#endif
#ifndef HY_ML_PROBE_MODE
#define HY_ML_PROBE_MODE 0
#endif
#define DUP(k) (((HY_DUP_MASK) >> (k)) & 1)
#define GRID_BAR_CG() do { cg::this_grid().sync(); } while (0)
#define GRID_BAR() do { if (!xposted) { xbar = xcd_barrier_post(ctl + CW_BAR, bst); xposted = true; } xcd_barrier(xbar); } while (0)

    if (IN(0) && DUP(0)) { p0_prologue(args, lds, vcu, G, tid, wave, lane); __syncthreads(); }
    if (IN(0)) { p0_prologue(args, lds, vcu, G, tid, wave, lane); if (BOTH(0)) GRID_BAR(); }

    if (IN(1)) {
        { const float* Rg = (const float*)(ws + WS_ROPE); LAS float* Rl = (LAS float*)(lds + ROPE_LDS_OFF); LAS float* Gl = (LAS float*)(lds + QKG_LDS_OFF);
          for (int e = tid; e < 64 * 32 * 2; e += NWAVES * 64) Rl[e] = Rg[e];
          if (tid < 128) { Gl[tid] = args.in[5][tid]; Gl[128 + tid] = args.in[6][tid]; }
          __syncthreads(); }
        { pg8::Gemm g{(const pg8::bf16_t*)args.out, (const pg8::bf16_t*)(ws + WS_W1T), NTOK, NF8, DM / 2}; pg8::StaticOrder S; S.init(NTOK, NF8, G, bx);
          pg8::EpiProjT<0, true> E{ws, (PG8_LAS float*)(lds + XCH_OFF), (PG8_LAS float*)(lds + ROPE_LDS_OFF), (PG8_LAS float*)(lds + QKG_LDS_OFF)};
          pg8::gemm_phase<pg8::EpiProjT<0, true>, pg8::StaticOrder, true, true, true>(lds, g, S, E); }
        { pg8::Gemm g{(const pg8::bf16_t*)(ws + WS_H), (const pg8::bf16_t*)(ws + WS_W1T) + (size_t)NF8 * DM, NTOK, NP256 - NF8, DM}; pg8::StaticOrder S; S.init(NTOK, NP256 - NF8, G, bx);
          pg8::EpiProjT<NF8 / 256, false> E{ws, (PG8_LAS float*)(lds + XCH_OFF), (PG8_LAS float*)(lds + ROPE_LDS_OFF), (PG8_LAS float*)(lds + QKG_LDS_OFF)};
          pg8::gemm_phase<pg8::EpiProjT<NF8 / 256, false>, pg8::StaticOrder, true, true, false>(lds, g, S, E); }
        { const int nun = (NTOK / 256) * (NF8 / 256), full = nun / G, rem = nun - full * G, light = G - rem;
          if (bx >= rem) for (int it = (bx - rem) * NWAVES + wave; it < NTOK / 48; it += light * NWAVES) gate_rows48(ws, args.in[4], it * 48, lane); }
        if (BOTH(1)) GRID_BAR();
    }

#if HY_SEPARATE_ROPE
    if (IN(2)) { p2_qknorm_rope(args, vcu, G, wave, lane); if (BOTH(2)) GRID_BAR(); }
#endif

#define ATTN_UNIT(grp_, w_) do { const int b_ = (grp_) >> 1, kvh_ = (grp_) & 1, h_ = kvh_ * 4 + ((w_) >> 3), qb_ = (w_) & 7; const size_t row0_ = (size_t)b_ * SEQ + qb_ * 256; \
        bf16* Q_ = (bf16*)(ws + WS_MIX) + row0_ * 2048 + h_ * 128; const attn::bf16* K_ = (const attn::bf16*)(ws + WS_AK) + (size_t)b_ * SEQ * 256 + kvh_ * 128; \
        const attn::bf16* V_ = (const attn::bf16*)(ws + WS_AV) + (size_t)b_ * SEQ * 256 + kvh_ * 128; const bf16* Z_ = (const bf16*)(ws + WS_AZ) + row0_ * 1024 + h_ * 128; \
        int seqv_ = SEQ; asm volatile("" : "+s"(seqv_)); attn::attn_dense_body<attn::bf16>((const attn::bf16*)Q_, K_, V_, Q_, Z_, seqv_, (char*)lds_raw); __syncthreads(); } while (0)
#if HY_SCHED_J
    const bool schedJ = one_launch && G == 256;
    if (schedJ) {
        const int xl = vcu >> 5, s = vcu & 31;
        if (s < 24) ml::mlstm_item<0>(ws, lds, xl * 24 + s, tid);
        else for (int j = 0; j < 2; ++j) ATTN_UNIT(xl, 2 * (s - 24) + j);
        GRID_BAR();
        const int n_rest = (s < 16) ? 6 : 5, n_p5 = (s < 16) ? 8 : 16, p5_0 = (s < 16) ? 8 * (xl * 16 + s) : 1024 + 16 * (xl * 16 + (s - 16));
        int p5_done = 0;
        for (int jr = 0; jr < n_rest; ++jr) {
            if ((jr & 1) == 0) { const int tgt = (n_p5 * ((jr >> 1) + 1)) / 3;
                p5_batch(args, lds, p5_0 + p5_done, tgt - p5_done); p5_done = tgt; }
            const int li = s + 32 * jr;
            const int grp = (li < 16) ? xl : xl + 8 * (1 + ((li - 16) >> 5)), w = (li < 16) ? 16 + li : (li - 16) & 31;
            ATTN_UNIT(grp, w);
        }
        GRID_BAR();
    }
#else
    const bool schedJ = false;
#endif

    if (!schedJ && IN(3)) {
        for (int u = vcu; u < NSEQ * 2 * 32; u += G) ATTN_UNIT(u >> 5, u & 31);
        if (BOTH(3)) GRID_BAR();
    }

    if (!schedJ && IN(4) && DUP(4)) {
#if HY_MLSTM_REF
        p4_mlstm_recurrent(args, lds, vcu, G, tid);
#else
        for (int item = vcu; item < NSEQ * 8; item += G) ml::mlstm_item<HY_ML_PROBE_MODE>(ws, lds, item, tid);
#endif
        if (BOTH(4)) GRID_BAR(); }

    if (!schedJ && IN(4)) {
#if HY_MLSTM_REF
        p4_mlstm_recurrent(args, lds, vcu, G, tid);
#else
        for (int item = vcu; item < NSEQ * 8; item += G) ml::mlstm_item<0>(ws, lds, item, tid);
#endif
        if (BOTH(4)) GRID_BAR(); }

    if (!schedJ && IN(5) && DUP(5)) { p5_mlstm_finalize(args, lds, vcu, G, tid, wave, lane); }
    if (!schedJ && IN(5)) { p5_mlstm_finalize(args, lds, vcu, G, tid, wave, lane); if (BOTH(5)) GRID_BAR(); }

    if (IN(6) && DUP(6)) {
        pg8::Gemm g{(const pg8::bf16_t*)(ws + WS_MIX), (const pg8::bf16_t*)(ws + WS_W2T), NTOK, DM, DM}; pg8::StaticOrder S; S.init(NTOK, DM, G, bx);
        pg8::EpiOut E{args.in[0], args.in[1], args.out};
        pg8::gemm_phase<pg8::EpiOut, pg8::StaticOrder, true, true>(lds, g, S, E);
    }
    if (IN(6)) {
        pg8::Gemm g{(const pg8::bf16_t*)(ws + WS_MIX), (const pg8::bf16_t*)(ws + WS_W2T), NTOK, DM, DM}; pg8::StaticOrder S; S.init(NTOK, DM, G, bx);
        pg8::EpiOut E{args.in[0], args.in[1], args.out};
        pg8::gemm_phase<pg8::EpiOut, pg8::StaticOrder, true, true>(lds, g, S, E);
    }
    if (one_launch && lo < 0) GRID_BAR_CG();
#undef IN
#undef BOTH
}

extern "C" void kernel_launch(void* const* d_in, const int* in_sizes, int n_in, void* d_out, int out_size, void* d_ws, size_t ws_size, hipStream_t stream) {
    static int grid = 0;
    if (grid == 0) {
        if (n_in != 9 || in_sizes[0] != TOK_PROMPT * DM || in_sizes[1] != (NTOK - TOK_PROMPT) * DM || out_size != NTOK * DM || ws_size < WS_END) {
            fprintf(stderr, "kernel_launch: shape mismatch n_in %d in0 %d in1 %d out %d ws %zu (need %zu)\n", n_in, n_in > 0 ? in_sizes[0] : -1, n_in > 1 ? in_sizes[1] : -1, out_size, ws_size, (size_t)WS_END); grid = -1; return; }
        int dev = 0, cus = 0, per_cu = 0;
        if (hipGetDevice(&dev) != hipSuccess || hipDeviceGetAttribute(&cus, hipDeviceAttributeMultiprocessorCount, dev) != hipSuccess) { fprintf(stderr, "kernel_launch: device query failed\n"); grid = -1; return; }
        if (hipFuncSetAttribute((const void*)hy_fwd, hipFuncAttributeMaxDynamicSharedMemorySize, LDS_BYTES) != hipSuccess) { fprintf(stderr, "kernel_launch: hipFuncSetAttribute failed\n"); grid = -1; return; }
        if (hipOccupancyMaxActiveBlocksPerMultiprocessor(&per_cu, (const void*)hy_fwd, NWAVES * 64, LDS_BYTES) != hipSuccess || per_cu < 1) { fprintf(stderr, "kernel_launch: occupancy query says %d\n", per_cu); per_cu = 1; }
        (void)hipGetLastError();
        grid = cus;
    }
    if (grid < 0) return;
    if (hipMemsetAsync((char*)d_ws + WS_CTL, 0, 65536, stream) != hipSuccess) { fprintf(stderr, "kernel_launch: hipMemsetAsync of the control words failed\n"); return; }
    Args a{};
    for (int i = 0; i < 9; ++i) a.in[i] = (const float*)d_in[i];
    a.out = (float*)d_out; a.ws = (unsigned char*)d_ws;
#if HY_N_LAUNCHES == 1
    a.ph_lo = 0; a.ph_hi = N_PHASES;
    void* kargs[] = {&a};
    hipError_t e = hipLaunchCooperativeKernel((const void*)hy_fwd, dim3(grid), dim3(NWAVES * 64), kargs, LDS_BYTES, stream);
    if (e != hipSuccess) fprintf(stderr, "kernel_launch: cooperative launch failed: %s (grid %d)\n", hipGetErrorString(e), grid);
#else
    for (int p = 0; p < N_PHASES; ++p) {
        a.ph_lo = p; a.ph_hi = p + 1;
        hipLaunchKernelGGL(hy_fwd, dim3(grid), dim3(NWAVES * 64), LDS_BYTES, stream, a);
        const hipError_t le = hipPeekAtLastError();
        if (le != hipSuccess) { fprintf(stderr, "kernel_launch: launch %d failed: %s\n", p, hipGetErrorName(le)); break; }
    }
#endif
}
```

```cpp
#include <hip/hip_runtime.h>
#include <hip/hip_bf16.h>
#include <hip/hip_cooperative_groups.h>
#include <cstdio>
#include <cstdint>
#include <cmath>
namespace cg = cooperative_groups;

#ifndef HY_SEPARATE_ROPE
#define HY_SEPARATE_ROPE 0
#endif
#ifndef HY_SCHED_J
#define HY_SCHED_J 1
#endif
#ifndef HY_MLSTM_REF
#define HY_MLSTM_REF 0
#endif
#ifndef HY_N_LAUNCHES
#define HY_N_LAUNCHES 1
#endif

constexpr int SEQ = 2048, NSEQ = 24, NTOK = NSEQ * SEQ, TOK_PROMPT = 8 * SEQ, DM = 2048;
constexpr int NPROJ = 6672, NP256 = 6656;
constexpr float EPS = 1e-6f;

constexpr size_t MiB = 1u << 20;
constexpr size_t WS_CTL = 0, CTL_ZERO_BYTES = 1 * MiB;
constexpr int CW_BAR = 4096, CW_QUEUE = 8192;
constexpr size_t WS_ROPE = 1 * MiB;
constexpr size_t WS_W8T = 2 * MiB;
constexpr size_t WS_W1B = 14 * MiB;
constexpr size_t WS_WGT = 18 * MiB;
constexpr size_t WS_SW = 19 * MiB;
constexpr size_t WS_SA = 20 * MiB;
constexpr size_t WS_W2T = 30 * MiB;
constexpr size_t WS_GATES = 38 * MiB;
constexpr size_t WS_H = 42 * MiB;
constexpr size_t WS_HF = WS_H, WS_HB = WS_H + 96 * MiB;
constexpr size_t WS_MIX = 234 * MiB;
constexpr size_t WS_AK = 426 * MiB, WS_AV = 450 * MiB;
constexpr size_t WS_AZ = 474 * MiB;
constexpr size_t WS_MQ = 570 * MiB, WS_MK = 618 * MiB;
constexpr size_t WS_MV = 666 * MiB, WS_MO = 762 * MiB, WS_MZ = 858 * MiB;
constexpr size_t WS_END = 954 * MiB;

typedef unsigned short bf16;
__device__ __forceinline__ unsigned f2bf(float f) { unsigned u = __builtin_bit_cast(unsigned, f); return (u + 0x7fffu + ((u >> 16) & 1u)) >> 16; }
__device__ __forceinline__ unsigned pk2(float lo, float hi) { return f2bf(lo) | (f2bf(hi) << 16); }
__device__ __forceinline__ float bf2f(unsigned short b) { return __builtin_bit_cast(float, (unsigned)b << 16); }
__device__ __forceinline__ float bflo(unsigned w) { return __builtin_bit_cast(float, w << 16); }
__device__ __forceinline__ float bfhi(unsigned w) { return __builtin_bit_cast(float, w & 0xffff0000u); }
constexpr int NQA = 2560, NB0 = 2560, NB1 = 3584, NQ8 = 5632;
__device__ __forceinline__ unsigned pk4f8(float a, float b, float c, float d) {
    a = __builtin_fminf(__builtin_fmaxf(a, -448.f), 448.f); b = __builtin_fminf(__builtin_fmaxf(b, -448.f), 448.f); c = __builtin_fminf(__builtin_fmaxf(c, -448.f), 448.f); d = __builtin_fminf(__builtin_fmaxf(d, -448.f), 448.f);
    int w = 0; w = __builtin_amdgcn_cvt_pk_fp8_f32(a, b, w, false); w = __builtin_amdgcn_cvt_pk_fp8_f32(c, d, w, true); return (unsigned)w; }
__device__ __forceinline__ float log_sigmoid_f(float x) { return x >= 0.f ? -log1pf(expf(-x)) : x - log1pf(expf(x)); }
namespace pg8 {
#define PG8_LAS __attribute__((address_space(3)))
typedef unsigned short bf16_t;
typedef short bf16x8 __attribute__((ext_vector_type(8)));
typedef float f32x4 __attribute__((ext_vector_type(4)));
typedef unsigned u32x4 __attribute__((ext_vector_type(4)));
typedef int i32x4 __attribute__((ext_vector_type(4)));
constexpr int BM = 256, BK = 64, HALF = 128, HTB = HALF * BK * 2  , STAGE_BYTES = 8 * HTB, NXCD = 8, WGM = 8;

__host__ __device__ __forceinline__ int lds_byte(int r, int c) { const int st = (r >> 4) * 2 + (c >> 5), rr = r & 15, cc = c & 31, ob = rr * 64 + cc * 2; return st * 1024 + (ob ^ (((ob >> 9) & 1) << 5)); }
__host__ __device__ __forceinline__ void stage_rc(int b, int& R, int& C) { const int st = b / 1024, sb = b % 1024, swz = sb ^ (((sb >> 9) & 1) << 5); R = (st >> 1) * 16 + swz / 64; C = (st & 1) * 32 + (swz % 64) / 2; }
__host__ __device__ __forceinline__ int perm32(int rho) { const int n = rho >> 4, i = rho & 15; return 8 * (i >> 2) + 4 * n + (i & 3); }

struct Unit { int pm, pn; };
struct Gemm { const bf16_t* A; const bf16_t* Bt; int M, N, K; };

struct StaticOrder {
    int nM, nN, nwg, G, c;
    __host__ __device__ void init(int M, int N, int G_, int c_) { nM = M / BM; nN = N / BM; nwg = nM * nN; G = G_; c = c_; }
    __host__ __device__ bool next(int i, Unit& u) const {
        const long L = (long)i * G + c; if (L >= nwg) return false;
        int wgid = (int)L; { const int q = nwg / NXCD, r = nwg % NXCD, xcd = wgid % NXCD, off = wgid / NXCD; wgid = (xcd < r ? xcd * (q + 1) : r * (q + 1) + (xcd - r) * q) + off; }
        const int nig = WGM * nN, gid = wgid / nig, fm = gid * WGM, gsz = (nM - fm) < WGM ? (nM - fm) : WGM;
        u.pm = fm + ((wgid % nig) % gsz); u.pn = (wgid % nig) / gsz; return true;
    }
    __device__ __forceinline__ void a_ready(const Unit&) const {}
    __device__ __forceinline__ void done(const Unit&) const {}
};


__device__ __forceinline__ unsigned cvt_pk_bf16(float lo, float hi) { unsigned r; asm volatile("v_cvt_pk_bf16_f32 %0, %1, %2" : "=v"(r) : "v"(lo), "v"(hi)); return r; }

template <int PN0, int MODE>
struct EpiProjT {
    static constexpr bool PERM = true, AFTER_DRAIN = false, PREFETCH = (MODE == 2); static constexpr int NSTORE = 16;
    unsigned char* ws; PG8_LAS float* xch; PG8_LAS float* ropeL; PG8_LAS float* qkgL;
    PG8_LAS float* scl; const float* SA; const float* SW;
    __device__ __forceinline__ void prefetch(const Unit& u, int ui, int wid, int lane) const {
        const float* src = (wid < 4) ? SA + (size_t)u.pm * BM + wid * 64 + lane : SW + u.pn * BM + (wid - 4) * 64 + lane;
        __builtin_amdgcn_global_load_lds((const unsigned*)src, (PG8_LAS unsigned*)(scl + (ui & 1) * 512 + wid * 64), 4, 0, 0); }
    __device__ __forceinline__ void operator()(const f32x4 (&acc)[2][2][4][2], const Unit& u, int wr, int wc, int fr, int fq, int par = 0) const {
        const int pn = (MODE == 2) ? (u.pn < 10 ? u.pn : u.pn + 4) : u.pn + PN0; const int row0 = u.pm * BM + wr * 64 + fr;
        constexpr float SC = (MODE == 1) ? (1.f / 4096.f) : 1.f;
        float sa[2][4]; f32x4 sw[2][2];
        if constexpr (MODE == 2) { PG8_LAS float* T = scl + par * 512;
#pragma unroll
            for (int ai = 0; ai < 2; ++ai)
#pragma unroll
                for (int m = 0; m < 4; ++m) sa[ai][m] = T[ai * HALF + wr * 64 + m * 16 + fr];
#pragma unroll
            for (int bj = 0; bj < 2; ++bj)
#pragma unroll
                for (int n = 0; n < 2; ++n) sw[bj][n] = *(const PG8_LAS f32x4*)(T + 256 + bj * HALF + wc * 32 + 8 * fq + 4 * n); }
        auto val = [&](int ai, int bj, int m, int n) -> f32x4 {
            if constexpr (MODE == 2) { const i32x4 iv = __builtin_bit_cast(i32x4, acc[ai][bj][m][n]); const f32x4 f = {(float)iv[0], (float)iv[1], (float)iv[2], (float)iv[3]}; return f * sa[ai][m] * sw[bj][n]; }
            else return acc[ai][bj][m][n] * SC; };
        if (!HY_SEPARATE_ROPE && PN0 <= 4 && pn <= 4) {
            PG8_LAS float* gsrc = qkgL + ((pn < 4) ? 0 : 128); const int cb = 64 * (wc >> 1) + 16 * (wc & 1) + 4 * fq;
            const f32x4 g1 = *(const PG8_LAS f32x4*)(gsrc + cb), g2 = *(const PG8_LAS f32x4*)(gsrc + cb + 32);
#pragma unroll
            for (int ai = 0; ai < 2; ++ai)
#pragma unroll
                for (int m = 0; m < 4; ++m)
#pragma unroll
                    for (int bj = 0; bj < 2; ++bj) { const f32x4 a = val(ai, bj, m, 0), b = val(ai, bj, m, 1);
                        float s = ((a[0] * a[0] + a[1] * a[1]) + (a[2] * a[2] + a[3] * a[3])) + ((b[0] * b[0] + b[1] * b[1]) + (b[2] * b[2] + b[3] * b[3]));
                        s += __shfl_xor(s, 16); s += __shfl_xor(s, 32);
                        if (fq == 0) xch[((ai * HALF + wr * 64 + m * 16 + fr) * 2 + bj) * 4 + wc] = s; }
            asm volatile("s_waitcnt lgkmcnt(0)" ::: "memory"); __builtin_amdgcn_s_barrier(); asm volatile("" ::: "memory");
            bf16_t* base = (bf16_t*)(ws + (pn < 4 ? WS_MIX : WS_AK)); const int ldc = (pn < 4) ? 2048 : 256; const int colt = (pn < 4) ? pn * 256 : 0;
            PG8_LAS float* R = ropeL; const int j0 = 16 * (wc & 1) + 4 * fq;
#pragma unroll
            for (int ai = 0; ai < 2; ++ai)
#pragma unroll
                for (int m = 0; m < 4; ++m) { const int row = row0 + ai * HALF + m * 16; const int tl = row & (SEQ - 1); const int pos = (wc < 2) ? (tl >> 6) : (tl & 63);
                    const f32x4 cs0 = *(const PG8_LAS f32x4*)(R + (pos * 32 + j0) * 2), cs1 = *(const PG8_LAS f32x4*)(R + (pos * 32 + j0) * 2 + 4);
#pragma unroll
                    for (int bj = 0; bj < 2; ++bj) { const f32x4 pt = *(const PG8_LAS f32x4*)(xch + ((ai * HALF + wr * 64 + m * 16 + fr) * 2 + bj) * 4);
                        const float rstd = 1.f / sqrtf(((pt[0] + pt[1]) + (pt[2] + pt[3])) * (1.f / 128.f) + EPS);
                        const f32x4 y1 = val(ai, bj, m, 0) * rstd * g1, y2 = val(ai, bj, m, 1) * rstd * g2;
                        const float o10 = y1[0] * cs0[0] - y2[0] * cs0[1], o11 = y1[1] * cs0[2] - y2[1] * cs0[3], o12 = y1[2] * cs1[0] - y2[2] * cs1[1], o13 = y1[3] * cs1[2] - y2[3] * cs1[3];
                        const float o20 = y2[0] * cs0[0] + y1[0] * cs0[1], o21 = y2[1] * cs0[2] + y1[1] * cs0[3], o22 = y2[2] * cs1[0] + y1[2] * cs1[1], o23 = y2[3] * cs1[2] + y1[3] * cs1[3];
                        bf16_t* dst = base + (size_t)row * ldc + colt + bj * HALF + cb;
                        typedef unsigned u32x2v __attribute__((ext_vector_type(2)));
                        u32x2v w1, w2; w1.x = cvt_pk_bf16(o10, o11); w1.y = cvt_pk_bf16(o12, o13); w2.x = cvt_pk_bf16(o20, o21); w2.y = cvt_pk_bf16(o22, o23);
                        *(u32x2v*)dst = w1; *(u32x2v*)(dst + 32) = w2; } }
            return;
        }
        size_t off; int ldc, colt;
        if (pn < 4)       { off = WS_MIX; ldc = 2048; colt = pn * 256; }
        else if (pn == 4) { off = WS_AK;  ldc = 256;  colt = 0; }
        else if (pn == 5) { off = WS_AV;  ldc = 256;  colt = 0; }
        else if (pn < 10) { off = WS_AZ;  ldc = 1024; colt = (pn - 6) * 256; }
        else if (pn < 12) { off = WS_MQ;  ldc = 512;  colt = (pn - 10) * 256; }
        else if (pn < 14) { off = WS_MK;  ldc = 512;  colt = (pn - 12) * 256; }
        else if (pn < 18) { off = WS_MV;  ldc = 1024; colt = (pn - 14) * 256; }
        else if (pn < 22) { off = WS_MO;  ldc = 1024; colt = (pn - 18) * 256; }
        else              { off = WS_MZ;  ldc = 1024; colt = (pn - 22) * 256; }
        bf16_t* base = (bf16_t*)(ws + off);
        const int col0 = colt + wc * 32 + 8 * fq;
#pragma unroll
        for (int ai = 0; ai < 2; ++ai)
#pragma unroll
            for (int m = 0; m < 4; ++m) { bf16_t* rowp = base + (size_t)(row0 + ai * HALF + m * 16) * ldc + col0;
#pragma unroll
                for (int bj = 0; bj < 2; ++bj) { const f32x4 v0 = val(ai, bj, m, 0), v1 = val(ai, bj, m, 1);
                    u32x4 w; w.x = cvt_pk_bf16(v0[0], v0[1]); w.y = cvt_pk_bf16(v0[2], v0[3]); w.z = cvt_pk_bf16(v1[0], v1[1]); w.w = cvt_pk_bf16(v1[2], v1[3]);
                    *(u32x4*)(rowp + bj * HALF) = w; } }
    }
};
struct EpiNull { static constexpr bool PERM = true, AFTER_DRAIN = false, PREFETCH = false; static constexpr int NSTORE = 0;
    __device__ __forceinline__ void operator()(const f32x4 (&acc)[2][2][4][2], const Unit& u, int wr, int wc, int fr, int fq) const {
#pragma unroll
        for (int ai = 0; ai < 2; ++ai)
#pragma unroll
            for (int bj = 0; bj < 2; ++bj)
#pragma unroll
                for (int m = 0; m < 4; ++m) asm volatile("" :: "v"(acc[ai][bj][m][0]), "v"(acc[ai][bj][m][1])); } };
struct EpiOut {
    static constexpr bool PERM = false, AFTER_DRAIN = false, PREFETCH = false; static constexpr int NSTORE = 32;
    const float* xp; const float* xs; float* out;
    __device__ __forceinline__ void operator()(const f32x4 (&acc)[2][2][4][2], const Unit& u, int wr, int wc, int fr, int fq) const {
        const int row0 = u.pm * BM + wr * 64 + fr; const int col0 = u.pn * BM + wc * 32 + 4 * fq;
        const bool pr = row0 < TOK_PROMPT; const float* xb = (pr ? xp : xs) + col0;
        const size_t xsub = pr ? 0 : (size_t)TOK_PROMPT * DM; float* ob = out + col0;
        f32x4 xr[4][4];
#define EPO_LOAD(g_) do { const size_t ro_ = (size_t)(row0 + ((g_) >> 2) * HALF + ((g_) & 3) * 16) * DM - xsub; \
            xr[(g_) & 3][0] = *(const f32x4*)(xb + ro_); xr[(g_) & 3][1] = *(const f32x4*)(xb + ro_ + 16); xr[(g_) & 3][2] = *(const f32x4*)(xb + ro_ + HALF); xr[(g_) & 3][3] = *(const f32x4*)(xb + ro_ + HALF + 16); } while (0)
        EPO_LOAD(0); EPO_LOAD(1); EPO_LOAD(2);
#pragma unroll
        for (int g = 0; g < 8; ++g) { if (g + 3 < 8) EPO_LOAD(g + 3);
            const int ai = g >> 2, m = g & 3; const size_t ro = (size_t)(row0 + ai * HALF + m * 16) * DM;
            *(f32x4*)(ob + ro) = xr[g & 3][0] + acc[ai][0][m][0]; *(f32x4*)(ob + ro + 16) = xr[g & 3][1] + acc[ai][0][m][1];
            *(f32x4*)(ob + ro + HALF) = xr[g & 3][2] + acc[ai][1][m][0]; *(f32x4*)(ob + ro + HALF + 16) = xr[g & 3][3] + acc[ai][1][m][1]; }
#undef EPO_LOAD
    }
};

template <class Epi, class Sched, bool ALIGN_EPI = false, bool SP2 = false, int MODE = 0>
__device__ __forceinline__ void gemm_phase(PG8_LAS unsigned char* lds, const Gemm g, const Sched& S, const Epi& E) {
    int tid_ = threadIdx.x; asm volatile("" : "+v"(tid_));
    const int tid = tid_, wid = __builtin_amdgcn_readfirstlane(tid >> 6), lane = tid & 63, wr = wid >> 2, wc = wid & 3, fr = lane & 15, fq = lane >> 4;
    const int K = g.K, nt = K / BK;
    unsigned voffA[2], voffB[2];
#pragma unroll
    for (int i = 0; i < 2; ++i) { int R, C; stage_rc(tid * 16 + i * 8192, R, C); const int Rb = Epi::PERM ? ((R & ~31) + perm32(R & 31)) : R;
        voffA[i] = (unsigned)(R * K + C) * 2u; voffB[i] = (unsigned)(Rb * K + C) * 2u; }
    const size_t kstep = (size_t)(BK * 2);
    const size_t hstep = (size_t)HALF * K * 2;
    const size_t tstep = 2 * hstep;
    const unsigned ldsw = (unsigned)wid * 1024u;
    const int aoff = lds_byte(wr * 64 + fr, fq * 8), boff = lds_byte(wc * 32 + fr, fq * 8);
#define PG8_SA(b, h) (((b) * 2 + (h)) * HTB)
#define PG8_SB(b, h) ((4 + (b) * 2 + (h)) * HTB)
#define PG8_STAGE(bufoff, gbase, voff) do { _Pragma("unroll") for (int _i = 0; _i < 2; ++_i) \
        __builtin_amdgcn_global_load_lds((const unsigned*)((const char*)(gbase) + (voff)[_i]), (PG8_LAS unsigned*)(lds + (bufoff) + ldsw + _i * 8192), 16, 0, 0); } while (0)
#define PG8_LDA(dst, b, h) do { _Pragma("unroll") for (int m = 0; m < 4; ++m) _Pragma("unroll") for (int k = 0; k < 2; ++k) dst[m][k] = *(const PG8_LAS bf16x8*)(lds + PG8_SA(b, h) + aoff + m * 2048 + k * 1024); } while (0)
#define PG8_LDB(dst, b, h) do { _Pragma("unroll") for (int n = 0; n < 2; ++n) _Pragma("unroll") for (int k = 0; k < 2; ++k) dst[n][k] = *(const PG8_LAS bf16x8*)(lds + PG8_SB(b, h) + boff + n * 2048 + k * 1024); } while (0)
#define PG8_CAT8(x_) __builtin_shufflevector(__builtin_bit_cast(i32x4, (x_)[0]), __builtin_bit_cast(i32x4, (x_)[1]), 0, 1, 2, 3, 4, 5, 6, 7)
#define PG8_MMA(ai, bj, At, Bt) do { __builtin_amdgcn_s_setprio(1); _Pragma("unroll") for (int m = 0; m < 4; ++m) _Pragma("unroll") for (int n = 0; n < 2; ++n) { \
        if constexpr (MODE == 1) asm volatile("s_nop 1\n\tv_mfma_f32_16x16x128_f8f6f4 %0, %1, %2, %0" : "+v"(acc[ai][bj][m][n]) : "v"(PG8_CAT8(Bt[n])), "v"(PG8_CAT8(At[m]))); \
        else if constexpr (MODE == 2) { } \
        else { _Pragma("unroll") for (int k = 0; k < 2; ++k) acc[ai][bj][m][n] = __builtin_amdgcn_mfma_f32_16x16x32_bf16(Bt[n][k], At[m][k], acc[ai][bj][m][n], 0, 0, 0); } } \
        if constexpr (MODE == 2) { _Pragma("unroll") for (int k = 0; k < 2; ++k) _Pragma("unroll") for (int m = 0; m < 4; ++m) _Pragma("unroll") for (int n = 0; n < 2; ++n) \
            asm volatile("s_nop 1\n\tv_mfma_i32_16x16x64_i8 %0, %1, %2, %0" : "+v"(acc[ai][bj][m][n]) : "v"(Bt[n][k]), "v"(At[m][k])); } \
        __builtin_amdgcn_s_setprio(0); } while (0)
#define PG8_WAIT_V(n) asm volatile("s_waitcnt vmcnt(" #n ")" ::: "memory")
#define PG8_WAIT_L(n) asm volatile("s_waitcnt lgkmcnt(" #n ")" ::: "memory")
#define PG8_BAR __builtin_amdgcn_s_barrier()
#define PG8_SCHED __builtin_amdgcn_sched_barrier(0)
    Unit cur, nxt; int ui = 0;
    if (!S.next(0, cur)) return;
    f32x4 acc[2][2][4][2];
#pragma unroll
    for (int a = 0; a < 2; ++a)
#pragma unroll
        for (int b = 0; b < 2; ++b)
#pragma unroll
            for (int m = 0; m < 4; ++m)
#pragma unroll
                for (int n = 0; n < 2; ++n) acc[a][b][m][n] = (f32x4){0.f, 0.f, 0.f, 0.f};
    bf16x8 At[4][2], B0[2][2], B1[2][2];
    const char* cA = (const char*)g.A + (size_t)cur.pm * tstep; const char* cB = (const char*)g.Bt + (size_t)cur.pn * tstep;
    S.a_ready(cur);
    if constexpr (SP2) {
        PG8_STAGE(PG8_SB(0, 0), cB, voffB); PG8_STAGE(PG8_SB(0, 1), cB + hstep, voffB); PG8_STAGE(PG8_SA(0, 0), cA, voffA); PG8_STAGE(PG8_SA(0, 1), cA + hstep, voffA);
        if (wr == 1) PG8_BAR;
        PG8_WAIT_V(2); PG8_BAR;
        PG8_STAGE(PG8_SB(1, 0), cB + kstep, voffB); PG8_STAGE(PG8_SA(1, 0), cA + kstep, voffA); PG8_STAGE(PG8_SB(1, 1), cB + hstep + kstep, voffB);
        PG8_WAIT_V(6); PG8_BAR;
    } else {
        PG8_STAGE(PG8_SB(0, 0), cB, voffB); PG8_STAGE(PG8_SA(0, 0), cA, voffA); PG8_STAGE(PG8_SB(0, 1), cB + hstep, voffB); PG8_STAGE(PG8_SA(0, 1), cA + hstep, voffA);
        if (wr == 1) PG8_BAR;
        PG8_WAIT_V(4); PG8_BAR;
        PG8_STAGE(PG8_SB(1, 0), cB + kstep, voffB); PG8_STAGE(PG8_SA(1, 0), cA + kstep, voffA); PG8_STAGE(PG8_SB(1, 1), cB + hstep + kstep, voffB);
        PG8_WAIT_V(6); PG8_BAR;
    }
    for (;;) {
        const bool has_next = S.next(ui + 1, nxt);
        const char* nA = has_next ? (const char*)g.A + (size_t)nxt.pm * tstep : cA; const char* nB = has_next ? (const char*)g.Bt + (size_t)nxt.pn * tstep : cB;
        for (int t = 0; t < nt; t += 2) {
            const bool last = (t == nt - 2);
            const char* a1 = cA + (size_t)(t + 1) * kstep;
            const char* a2 = last ? nA : cA + (size_t)(t + 2) * kstep; const char* b2 = last ? nB : cB + (size_t)(t + 2) * kstep;
            const char* a3 = a2 + kstep; const char* b3 = b2 + kstep;
            if (last && has_next) S.a_ready(nxt);
            if constexpr (SP2) {
            const int relax_s = __builtin_amdgcn_readfirstlane((Epi::NSTORE > 0 && t == 0 && ui > 0) ? 1 : 0);
#define PG8_WAIT_FIRST() do { if constexpr (Epi::NSTORE >= 32) asm volatile("s_waitcnt vmcnt(40)\n\ts_cmp_lg_u32 %0, 0\n\ts_cbranch_scc1 1f\n\ts_waitcnt vmcnt(8)\n1:" :: "s"(relax_s) : "memory", "scc"); \
            else if constexpr (Epi::NSTORE >= 16) asm volatile("s_waitcnt vmcnt(24)\n\ts_cmp_lg_u32 %0, 0\n\ts_cbranch_scc1 1f\n\ts_waitcnt vmcnt(8)\n1:" :: "s"(relax_s) : "memory", "scc"); \
            else PG8_WAIT_V(8); } while (0)
            PG8_LDB(B0, 0, 0); PG8_LDB(B1, 0, 1); PG8_SCHED; PG8_LDA(At, 0, 0); PG8_STAGE(PG8_SA(1, 1), a1 + hstep, voffA);
            PG8_WAIT_FIRST(); PG8_WAIT_L(0); PG8_BAR; PG8_MMA(0, 0, At, B0); PG8_MMA(0, 1, At, B1); PG8_BAR; PG8_SCHED;
            PG8_LDA(At, 0, 1); PG8_STAGE(PG8_SB(0, 0), b2, voffB); PG8_STAGE(PG8_SB(0, 1), b2 + hstep, voffB); PG8_STAGE(PG8_SA(0, 0), a2, voffA);
            PG8_WAIT_FIRST(); PG8_WAIT_L(0); PG8_BAR; PG8_MMA(1, 0, At, B0); PG8_MMA(1, 1, At, B1); PG8_BAR; PG8_SCHED;
#undef PG8_WAIT_FIRST
            if constexpr (Epi::PREFETCH) { if (t == 0) E.prefetch(cur, ui, wid, lane); }
            PG8_LDB(B0, 1, 0); PG8_LDB(B1, 1, 1); PG8_SCHED; PG8_LDA(At, 1, 0); PG8_STAGE(PG8_SA(0, 1), a2 + hstep, voffA);
            PG8_WAIT_V(8); PG8_WAIT_L(0); PG8_BAR; PG8_MMA(0, 0, At, B0); PG8_MMA(0, 1, At, B1); PG8_BAR; PG8_SCHED;
            PG8_LDA(At, 1, 1); PG8_STAGE(PG8_SB(1, 0), b3, voffB); PG8_STAGE(PG8_SB(1, 1), b3 + hstep, voffB); PG8_STAGE(PG8_SA(1, 0), a3, voffA);
            PG8_WAIT_V(8); PG8_WAIT_L(0); PG8_BAR; PG8_MMA(1, 0, At, B0); PG8_MMA(1, 1, At, B1); PG8_BAR; PG8_SCHED;
            } else {
            PG8_LDB(B0, 0, 0); PG8_SCHED; PG8_LDA(At, 0, 0); PG8_STAGE(PG8_SA(1, 1), a1 + hstep, voffA);
            PG8_WAIT_L(8); PG8_BAR; PG8_WAIT_L(0); PG8_MMA(0, 0, At, B0); PG8_BAR; PG8_SCHED;
            PG8_LDB(B1, 0, 1); PG8_STAGE(PG8_SB(0, 0), b2, voffB);
            PG8_BAR; PG8_WAIT_L(0); PG8_MMA(0, 1, At, B1); PG8_BAR;
            PG8_LDA(At, 0, 1); PG8_STAGE(PG8_SA(0, 0), a2, voffA);
            PG8_BAR; PG8_WAIT_L(0); PG8_MMA(1, 0, At, B0); PG8_BAR; PG8_SCHED;
            PG8_STAGE(PG8_SB(0, 1), b2 + hstep, voffB);
            PG8_WAIT_V(6); PG8_BAR; PG8_MMA(1, 1, At, B1); PG8_BAR;
            PG8_LDB(B0, 1, 0); PG8_SCHED; PG8_LDA(At, 1, 0); PG8_STAGE(PG8_SA(0, 1), a2 + hstep, voffA);
            PG8_WAIT_L(8); PG8_BAR; PG8_WAIT_L(0); PG8_MMA(0, 0, At, B0); PG8_BAR; PG8_SCHED;
            PG8_LDB(B1, 1, 1); PG8_STAGE(PG8_SB(1, 0), b3, voffB);
            PG8_BAR; PG8_WAIT_L(0); PG8_MMA(0, 1, At, B1); PG8_BAR;
            PG8_LDA(At, 1, 1); PG8_STAGE(PG8_SA(1, 0), a3, voffA);
            PG8_BAR; PG8_WAIT_L(0); PG8_MMA(1, 0, At, B0); PG8_BAR; PG8_SCHED;
            PG8_STAGE(PG8_SB(1, 1), b3 + hstep, voffB);
            PG8_WAIT_V(6); PG8_BAR; PG8_MMA(1, 1, At, B1); PG8_BAR;
            }
        }
        if constexpr (MODE != 0) asm volatile("s_nop 15\n\ts_nop 15" ::: "memory");
        if constexpr (ALIGN_EPI) { if (wr == 0) PG8_BAR; }
        if constexpr (!Epi::AFTER_DRAIN) { if constexpr (Epi::PREFETCH) E(acc, cur, wr, wc, fr, fq, ui & 1); else E(acc, cur, wr, wc, fr, fq); S.done(cur); }
        if (!has_next) break;
#pragma unroll
        for (int a = 0; a < 2; ++a)
#pragma unroll
            for (int b = 0; b < 2; ++b)
#pragma unroll
                for (int m = 0; m < 4; ++m)
#pragma unroll
                    for (int n = 0; n < 2; ++n) acc[a][b][m][n] = (f32x4){0.f, 0.f, 0.f, 0.f};
        cur = nxt; cA = nA; cB = nB; ++ui;
        if constexpr (ALIGN_EPI) { if (wr == 1) PG8_BAR; }
    }
    PG8_WAIT_V(0);
    if constexpr (!ALIGN_EPI) { if (wr == 0) PG8_BAR; }
    PG8_BAR;
    if constexpr (Epi::AFTER_DRAIN) { E.fused(acc, cur, wr, wc, fr, fq, lds, wid, lane); S.done(cur); }
#undef PG8_SA
#undef PG8_SB
#undef PG8_STAGE
#undef PG8_LDA
#undef PG8_LDB
#undef PG8_MMA
#undef PG8_CAT8
#undef PG8_WAIT_V
#undef PG8_WAIT_L
#undef PG8_BAR
#undef PG8_SCHED
}
}
namespace attn {
using bf16 = __hip_bfloat16;
constexpr int   D = 128, NW = 8, QBLK = 32, KVBLK = 64;
constexpr float SCALE = 0.088388347648318440f;
constexpr float THR = 8.f;
constexpr int SDEPTH = 2;
constexpr int LDQ = 2048, LDK = 256, LDO = 2048, LDZ = 1024;
constexpr size_t SHM_V = KVBLK * D * 2, SHM_K = KVBLK * D * 2, SHM_ATTN = 2 * SHM_V + 2 * SHM_K + NW * 64 * 4;
using bf16x8 = __attribute__((ext_vector_type(8))) short;
using s16x4  = __attribute__((ext_vector_type(4))) short;
using f32x16 = __attribute__((ext_vector_type(16))) float;
using f32x8  = __attribute__((ext_vector_type(8))) float;
using u32x4  = __attribute__((ext_vector_type(4))) unsigned;
#define KSWZ(row, colB) ((row) * 256 + ((colB) ^ (((row) & 7) << 4)))
#define SBAR() __builtin_amdgcn_sched_barrier(0)
__device__ __forceinline__ int crow(int r, int hi) { return (r & 3) + 8 * (r >> 2) + 4 * hi; }
__device__ __forceinline__ unsigned cvtpk(float lo, float hi) {
  unsigned r; asm volatile("v_cvt_pk_bf16_f32 %0, %1, %2" : "=v"(r) : "v"(lo), "v"(hi)); return r;
}
template <typename TIn> struct Stage;
template <> struct Stage<bf16>  { using T = bf16x8;
  __device__ static __forceinline__ T ld8(const bf16* p) { return *reinterpret_cast<const bf16x8*>(p); }
  __device__ static __forceinline__ bf16x8 tobf(T x) { return x; } };
template <> struct Stage<float> { using T = f32x8;
  __device__ static __forceinline__ T ld8(const float* p) { return *reinterpret_cast<const f32x8*>(p); }
  __device__ static __forceinline__ bf16x8 tobf(T x) {
    u32x4 w = {cvtpk(x[0], x[1]), cvtpk(x[2], x[3]), cvtpk(x[4], x[5]), cvtpk(x[6], x[7])}; return *reinterpret_cast<bf16x8*>(&w); } };

__device__ __forceinline__ void partialSM(f32x16& p0, f32x16& p1, float& m_reg, float& mn, float& alpha) {
  constexpr float C = SCALE * 1.4426950408889634f;
  float pmax = p0[0]; for (int r = 1; r < 16; ++r) pmax = fmaxf(pmax, p0[r]); for (int r = 0; r < 16; ++r) pmax = fmaxf(pmax, p1[r]);
  { auto rr = __builtin_amdgcn_permlane32_swap(__float_as_uint(pmax), __float_as_uint(pmax), false, false);
    pmax = fmaxf(__uint_as_float(rr[0]), __uint_as_float(rr[1])); }
  if (__builtin_expect(__all(pmax - m_reg <= THR / SCALE), 1)) { mn = m_reg; alpha = 1.f; }
  else { mn = fmaxf(m_reg, pmax); alpha = __builtin_amdgcn_exp2f((m_reg - mn) * C); m_reg = mn; }
  float mnC = -mn * C;
  for (int r = 0; r < 16; ++r) p0[r] = fmaf(p0[r], C, mnC); for (int r = 0; r < 16; ++r) p1[r] = fmaf(p1[r], C, mnC);
  for (int r = 0; r < 16; ++r) p0[r] = __builtin_amdgcn_exp2f(p0[r]);
}
__device__ __forceinline__ void finishSM(f32x16& p0, f32x16& p1, float alpha, float& l_reg, bf16x8& pa0, bf16x8& pa1, bf16x8& pa2, bf16x8& pa3) {
  for (int r = 0; r < 16; ++r) p1[r] = __builtin_amdgcn_exp2f(p1[r]);
  float ps = 0; for (int r = 0; r < 16; ++r) ps += p0[r]; for (int r = 0; r < 16; ++r) ps += p1[r];
  { auto rr = __builtin_amdgcn_permlane32_swap(__float_as_uint(ps), __float_as_uint(ps), false, false);
    ps = __uint_as_float(rr[0]) + __uint_as_float(rr[1]); }
  l_reg = l_reg * alpha + ps;
#define PK4(P, BASE, OUT) do { unsigned a0 = cvtpk(P[BASE + 0], P[BASE + 1]), a1 = cvtpk(P[BASE + 2], P[BASE + 3]);   \
    unsigned b0 = cvtpk(P[BASE + 4], P[BASE + 5]), b1 = cvtpk(P[BASE + 6], P[BASE + 7]);                              \
    auto r0 = __builtin_amdgcn_permlane32_swap(a0, b0, false, false); auto r1 = __builtin_amdgcn_permlane32_swap(a1, b1, false, false); \
    u32x4 w = {r0[0], r1[0], r0[1], r1[1]}; OUT = *reinterpret_cast<bf16x8*>(&w); } while (0)
  PK4(p0, 0, pa0); PK4(p0, 8, pa1); PK4(p1, 0, pa2); PK4(p1, 8, pa3);
#undef PK4
}
__device__ __forceinline__ void qkt(f32x16& p0, f32x16& p1, const bf16* Ks, const bf16x8* qr, int r32, int hi) {
  p0 = f32x16{}; p1 = f32x16{};
  for (int d0 = 0; d0 < 8; ++d0) { int cb = (d0 * 16 + hi * 8) * 2;
    bf16x8 b0 = *reinterpret_cast<const bf16x8*>((const char*)Ks + KSWZ(r32, cb));
    bf16x8 b1 = *reinterpret_cast<const bf16x8*>((const char*)Ks + KSWZ(32 + r32, cb));
    p0 = __builtin_amdgcn_mfma_f32_32x32x16_bf16(b0, qr[d0], p0, 0, 0, 0);
    p1 = __builtin_amdgcn_mfma_f32_32x32x16_bf16(b1, qr[d0], p1, 0, 0, 0); }
}
__device__ __forceinline__ int v_st(int k, int c) { const int kk = (k & ~0xC) | ((k & 4) << 1) | ((k & 8) >> 1); return ((kk >> 3) * 4 + (c >> 5)) * 512 + ((kk & 7) * 32 + (c & 31)) * 2; }
__device__ __forceinline__ int v_rd_base(int lane) { return ((lane & 3) << 3) | (((lane >> 2) & 3) << 6) | (((lane >> 4) & 1) << 5) | (((lane >> 5) & 1) << 8); }
constexpr int v_rd_off(int d0, int ks, int half) { return d0 * 512 + ks * 4096 + half * 2048; }
template <int OFF> __device__ __forceinline__ s16x4 tr_read(int vb) {
  s16x4 r; asm volatile("ds_read_b64_tr_b16 %0, %1 offset:%2" : "=&v"(r) : "v"(vb), "i"(OFF) : "memory"); return r;
}
template <int D0> __device__ __forceinline__ void pv_one(f32x16& od, int vb, bf16x8 pa0, bf16x8 pa1, bf16x8 pa2, bf16x8 pa3) {
  const s16x4 l0 = tr_read<v_rd_off(D0, 0, 0)>(vb), h0 = tr_read<v_rd_off(D0, 0, 1)>(vb), l1 = tr_read<v_rd_off(D0, 1, 0)>(vb), h1 = tr_read<v_rd_off(D0, 1, 1)>(vb);
  const s16x4 l2 = tr_read<v_rd_off(D0, 2, 0)>(vb), h2 = tr_read<v_rd_off(D0, 2, 1)>(vb), l3 = tr_read<v_rd_off(D0, 3, 0)>(vb), h3 = tr_read<v_rd_off(D0, 3, 1)>(vb);
  asm volatile("s_waitcnt lgkmcnt(0)" ::: "memory"); SBAR();
#define PK(L, H) (bf16x8){L[0], L[1], L[2], L[3], H[0], H[1], H[2], H[3]}
  od = __builtin_amdgcn_mfma_f32_32x32x16_bf16(pa0, PK(l0, h0), od, 0, 0, 0);
  od = __builtin_amdgcn_mfma_f32_32x32x16_bf16(pa1, PK(l1, h1), od, 0, 0, 0);
  od = __builtin_amdgcn_mfma_f32_32x32x16_bf16(pa2, PK(l2, h2), od, 0, 0, 0);
  od = __builtin_amdgcn_mfma_f32_32x32x16_bf16(pa3, PK(l3, h3), od, 0, 0, 0);
#undef PK
}
__device__ __forceinline__ void pv_d0(f32x16* o, int vb, bf16x8 pa0, bf16x8 pa1, bf16x8 pa2, bf16x8 pa3) {
  pv_one<0>(o[0], vb, pa0, pa1, pa2, pa3); pv_one<1>(o[1], vb, pa0, pa1, pa2, pa3); pv_one<2>(o[2], vb, pa0, pa1, pa2, pa3); pv_one<3>(o[3], vb, pa0, pa1, pa2, pa3);
}

template <typename TQ>
__device__ __forceinline__ void attn_dense_body(const TQ* Qb, const bf16* __restrict__ Kh, const bf16* __restrict__ Vh,
                                                unsigned short* Ob, const unsigned short* __restrict__ Zb, int seq, char* lds) {
  using St = Stage<bf16>; using SQ = Stage<TQ>;
  int tid = threadIdx.x; asm volatile("" : "+v"(tid));
  const int wid = tid >> 6, lane = tid & 63, r32 = lane & 31, hi = lane >> 5;
  bf16* V_lds = (bf16*)lds; bf16* K_lds = (bf16*)(lds + 2 * SHM_V);
  float* ws = (float*)(lds + 2 * SHM_V + 2 * SHM_K) + wid * 64; float* li_l = ws; float* al_l = ws + 32;
  float m_reg = -1e30f, l_reg = 0; f32x16 o[4] = {}; bf16x8 qr[8];
  const TQ* Qw = Qb + (long)(wid * QBLK + r32) * LDQ + hi * 8;
#pragma unroll
  for (int d0 = 0; d0 < 8; ++d0) qr[d0] = SQ::tobf(SQ::ld8(Qw + d0 * 16));
  const int sr = tid >> 4, sc = (tid & 15) * 8, vst0 = v_st(sr, sc), vst1 = v_st(32 + sr, sc);
  const int vb0 = (int)(uintptr_t)V_lds + v_rd_base(lane);
  struct { typename St::T vs0, vs1, ks0, ks1; } sr_[SDEPTH];
#define SLOAD(i, k0) do { sr_[i].vs0 = St::ld8(&Vh[(long)((k0) + sr) * LDK + sc]); sr_[i].vs1 = St::ld8(&Vh[(long)((k0) + 32 + sr) * LDK + sc]); \
    sr_[i].ks0 = St::ld8(&Kh[(long)((k0) + sr) * LDK + sc]); sr_[i].ks1 = St::ld8(&Kh[(long)((k0) + 32 + sr) * LDK + sc]); } while (0)
#define SWRITE(b, i) do { *(bf16x8*)((char*)V_lds + (b) * SHM_V + vst0) = St::tobf(sr_[i].vs0);          \
    *(bf16x8*)((char*)V_lds + (b) * SHM_V + vst1) = St::tobf(sr_[i].vs1); int kc = sc * 2;               \
    *(bf16x8*)((char*)K_lds + (b) * SHM_K + KSWZ(sr, kc)) = St::tobf(sr_[i].ks0);                       \
    *(bf16x8*)((char*)K_lds + (b) * SHM_K + KSWZ(32 + sr, kc)) = St::tobf(sr_[i].ks1); } while (0)
#define SWAIT() do { if constexpr (SDEPTH == 2) asm volatile("s_waitcnt vmcnt(4)" ::: "memory"); else asm volatile("s_waitcnt vmcnt(0)" ::: "memory"); } while (0)
#define RESC(a) do { if (__any((a) < 1.f)) { if (hi == 0) al_l[r32] = (a); asm volatile("s_waitcnt lgkmcnt(0)" ::: "memory"); \
    for (int d = 0; d < 4; ++d) for (int r = 0; r < 16; ++r) o[d][r] *= al_l[crow(r, hi)]; } } while (0)
  f32x16 pA0, pA1, pB0, pB1; float mnA, mnB, alA, alB; bf16x8 pa0, pa1, pa2, pa3; const int NT = seq / KVBLK;
  constexpr int SE = 0, SO = SDEPTH - 1;
  SLOAD(SE, 0); asm volatile("s_waitcnt vmcnt(0)" ::: "memory"); SWRITE(0, SE); __syncthreads();
  qkt(pA0, pA1, K_lds, qr, r32, hi); partialSM(pA0, pA1, m_reg, mnA, alA);
  SLOAD(SO, KVBLK); if constexpr (SDEPTH == 2) { if (2 < NT) SLOAD(SE, 2 * KVBLK); }
  SWAIT(); SWRITE(1, SO); __syncthreads();
  for (int j = 1; j + 1 < NT; j += 2) {
    SBAR(); qkt(pB0, pB1, (bf16*)((char*)K_lds + SHM_K), qr, r32, hi);
    finishSM(pA0, pA1, alA, l_reg, pa0, pa1, pa2, pa3); SBAR();
    SLOAD(SO, (j + SDEPTH) * KVBLK); SBAR();
    pv_d0(o, vb0, pa0, pa1, pa2, pa3); partialSM(pB0, pB1, m_reg, mnB, alB);
    __syncthreads(); SWAIT(); SWRITE(0, SE);
    RESC(alB); __syncthreads();
    SBAR(); qkt(pA0, pA1, K_lds, qr, r32, hi);
    finishSM(pB0, pB1, alB, l_reg, pa0, pa1, pa2, pa3); SBAR();
    if (SDEPTH == 1 || j + 3 < NT) SLOAD(SE, (j + 1 + SDEPTH) * KVBLK); SBAR();
    pv_d0(o, vb0 + (int)SHM_V, pa0, pa1, pa2, pa3); partialSM(pA0, pA1, m_reg, mnA, alA);
    __syncthreads(); SWAIT(); SWRITE(1, SO);
    RESC(alA); __syncthreads();
  }
  SBAR(); qkt(pB0, pB1, (bf16*)((char*)K_lds + SHM_K), qr, r32, hi);
  finishSM(pA0, pA1, alA, l_reg, pa0, pa1, pa2, pa3); SBAR();
  pv_d0(o, vb0, pa0, pa1, pa2, pa3); partialSM(pB0, pB1, m_reg, mnB, alB);
  __syncthreads(); RESC(alB);
  finishSM(pB0, pB1, alB, l_reg, pa0, pa1, pa2, pa3); SBAR();
  pv_d0(o, vb0 + (int)SHM_V, pa0, pa1, pa2, pa3);
  if (hi == 0) li_l[r32] = l_reg; asm volatile("s_waitcnt lgkmcnt(0)" ::: "memory");
  float rli[16];
#pragma unroll
  for (int r = 0; r < 16; ++r) rli[r] = __builtin_amdgcn_rcpf(li_l[crow(r, hi)]);
  __syncthreads();
  { unsigned short* stg = (unsigned short*)(lds + wid * 8192);
#pragma unroll
    for (int r = 0; r < 16; ++r) { const int orow = crow(r, hi);
#pragma unroll
      for (int d0 = 0; d0 < 4; ++d0) { unsigned u = __builtin_bit_cast(unsigned, o[d0][r] * rli[r]); u = (u + 0x7fffu + ((u >> 16) & 1u)) >> 16; stg[orow * 128 + d0 * 32 + r32] = (unsigned short)u; } }
    asm volatile("s_waitcnt lgkmcnt(0)" ::: "memory");
    unsigned short* Ow = Ob + (long)(wid * QBLK) * LDO; const unsigned short* Zw = Zb + (long)(wid * QBLK) * LDZ;
#pragma unroll 2
    for (int i = 0; i < 8; ++i) { const int row = i * 4 + (lane >> 4), ch = lane & 15;
      const u32x4 ov = *(const u32x4*)(stg + row * 128 + ch * 8); const u32x4 zv = *(const u32x4*)(Zw + (long)row * LDZ + ch * 8); u32x4 w;
#pragma unroll
      for (int e = 0; e < 4; ++e) { const float z0 = __builtin_bit_cast(float, zv[e] << 16), z1 = __builtin_bit_cast(float, zv[e] & 0xffff0000u);
        const float a0 = __builtin_bit_cast(float, ov[e] << 16) * (z0 * __builtin_amdgcn_rcpf(1.f + __expf(-z0))), a1 = __builtin_bit_cast(float, ov[e] & 0xffff0000u) * (z1 * __builtin_amdgcn_rcpf(1.f + __expf(-z1)));
        w[e] = cvtpk(a0, a1); }
      *(u32x4*)(Ow + (long)row * LDO + ch * 8) = w; } }
#undef SLOAD
#undef SWRITE
#undef SWAIT
#undef RESC
}

}
namespace ml {
typedef short bf16x8 __attribute__((ext_vector_type(8)));
typedef short v4i16 __attribute__((ext_vector_type(4)));
typedef float f32x4 __attribute__((ext_vector_type(4)));
typedef float f32x16 __attribute__((ext_vector_type(16)));
typedef unsigned u32x4 __attribute__((ext_vector_type(4)));
typedef unsigned u32x2 __attribute__((ext_vector_type(2)));
#define ML_LAS __attribute__((address_space(3)))
constexpr int BUFB = 65536, Q_OFF = 0, K_OFF = 16384, V_OFF = 32768;
constexpr int P_OFF = 131072, DENP_OFF = P_OFF + 8192, QNP_OFF = DENP_OFF + 512, VEC_OFF = QNP_OFF + 2048, VEC_SLOT = 2 * 256, VR_OFF = VEC_OFF + 2 * VEC_SLOT, NB_OFF = VR_OFF + 8 * 256, LDS_END = NB_OFF + 512;
__device__ __forceinline__ unsigned fxor(unsigned row) { return ((row & 3u) << 2) | ((row >> 2) & 3u); }
__device__ __forceinline__ unsigned off_b(unsigned row, unsigned ch) { return 256u * row + 16u * (ch ^ fxor(row)); }
__device__ __forceinline__ unsigned off_p(unsigned t, unsigned ch) { return 128u * t + 16u * (ch ^ (t & 7u)); }
__device__ __forceinline__ unsigned tr_addr(unsigned lane, unsigned c, unsigned ks, unsigned t) { const unsigned h = lane >> 5, blk = (lane >> 4) & 1u, q = (lane & 15u) >> 2, p = lane & 3u; return off_b(16u * ks + 8u * h + 4u * t + q, 4u * c + 2u * blk + (p >> 1)) + 8u * (p & 1u); }
__device__ __forceinline__ unsigned tr_addr16(unsigned lane, unsigned c, unsigned ks, unsigned t) { const unsigned g = lane >> 4, q = (lane & 15u) >> 2, p = lane & 3u; return off_b(32u * ks + 8u * g + 4u * t + q, 2u * c + (p >> 1)) + 8u * (p & 1u); }
__device__ __forceinline__ v4i16 trrd(ML_LAS unsigned char* p) { return __builtin_amdgcn_ds_read_tr16_b64_v4i16((ML_LAS v4i16*)p); }
template <int OFF> __device__ __forceinline__ v4i16 trra(unsigned addr) { v4i16 r; asm volatile("ds_read_b64_tr_b16 %0, %1 offset:%2" : "=v"(r) : "v"(addr), "i"(OFF) : "memory"); return r; }
__device__ __forceinline__ void glds16(const void* gsrc, unsigned lds_dst) { unsigned keep;
    asm volatile("s_mov_b32 %0, m0\n\ts_mov_b32 m0, %2\n\ts_nop 0\n\tglobal_load_lds_dwordx4 %1, off\n\ts_mov_b32 m0, %0" : "=&s"(keep) : "v"(gsrc), "s"(lds_dst) : "memory"); }
#define ML_TRWAIT() do { asm volatile("s_waitcnt lgkmcnt(0)" ::: "memory"); __builtin_amdgcn_sched_barrier(0); } while (0)
__device__ __forceinline__ bf16x8 cat8(v4i16 lo, v4i16 hi) { return (bf16x8){lo[0], lo[1], lo[2], lo[3], hi[0], hi[1], hi[2], hi[3]}; }
__device__ __forceinline__ unsigned pkbf(float lo, float hi) { unsigned r; asm volatile("v_cvt_pk_bf16_f32 %0, %1, %2" : "=v"(r) : "v"(lo), "v"(hi)); return r; }
__device__ __forceinline__ float s2f(short x) { return __builtin_bit_cast(float, (unsigned)(unsigned short)x << 16); }
__device__ __forceinline__ bf16x8 pack8(float a0, float a1, float a2, float a3, float a4, float a5, float a6, float a7) { u32x4 w = {pkbf(a0, a1), pkbf(a2, a3), pkbf(a4, a5), pkbf(a6, a7)}; return __builtin_bit_cast(bf16x8, w); }
__device__ __forceinline__ float scan_add(float v, int lane) {
#pragma unroll
    for (int o = 1; o < 64; o <<= 1) { const float u = __shfl_up(v, o); if (lane >= o) v += u; }
    return v; }
__device__ __forceinline__ float scan_max(float v, int lane) {
#pragma unroll
    for (int o = 1; o < 64; o <<= 1) { const float u = __shfl_up(v, o); if (lane >= o) v = fmaxf(v, u); }
    return v; }
#define ML_OPAQUE_LANE(ln) unsigned ln = (unsigned)lane; asm volatile("" : "+v"(ln))
__device__ __forceinline__ float rdlane(float v, int l) { return __builtin_bit_cast(float, __builtin_amdgcn_readlane(__builtin_bit_cast(int, v), l)); }

__device__ __forceinline__ void stage(ML_LAS unsigned char* lds, int bsel, int c, int b, int hd, int dir, const unsigned short* MQ, const unsigned short* MK, const unsigned short* MV, int wid, int lane) {
    const int rl = lane >> 4, pos = lane & 15;
#pragma unroll
    for (int half = 0; half < 2; ++half) {
        const int grp = wid + 8 * half, row = 4 * grp + rl, ch = pos ^ ((rl << 2) | (grp & 3));
        const int p = 64 * c + row, tok = dir ? (SEQ - 1 - p) : p; const size_t trow = (size_t)b * SEQ + tok;
        ML_LAS unsigned char* d = lds + bsel * BUFB + grp * 1024;
        __builtin_amdgcn_global_load_lds((const unsigned*)(MQ + trow * 512 + hd * 128 + 8 * ch), (ML_LAS unsigned*)(d + Q_OFF), 16, 0, 0);
        __builtin_amdgcn_global_load_lds((const unsigned*)(MK + trow * 512 + hd * 128 + 8 * ch), (ML_LAS unsigned*)(d + K_OFF), 16, 0, 0);
        __builtin_amdgcn_global_load_lds((const unsigned*)(MV + trow * 1024 + hd * 256 + 8 * ch), (ML_LAS unsigned*)(d + V_OFF), 16, 0, 0);
        __builtin_amdgcn_global_load_lds((const unsigned*)(MV + trow * 1024 + hd * 256 + 128 + 8 * ch), (ML_LAS unsigned*)(d + V_OFF + 16384), 16, 0, 0);
    }
}

#define ML_DPPF(old_, src_, ctrl_, rm_) __builtin_bit_cast(float, __builtin_amdgcn_update_dpp(__builtin_bit_cast(int, (float)(old_)), __builtin_bit_cast(int, (float)(src_)), ctrl_, rm_, 0xf, false))
__device__ __forceinline__ float dscan_add(float v) {
    v += ML_DPPF(0.f, v, 0x111, 0xf); v += ML_DPPF(0.f, v, 0x112, 0xf); v += ML_DPPF(0.f, v, 0x114, 0xf); v += ML_DPPF(0.f, v, 0x118, 0xf);
    v += ML_DPPF(0.f, v, 0x142, 0xa); v += ML_DPPF(0.f, v, 0x143, 0xc); return v; }
__device__ __forceinline__ float dscan_max(float v) { const float NI = -3.0e38f;
    v = fmaxf(v, ML_DPPF(NI, v, 0x111, 0xf)); v = fmaxf(v, ML_DPPF(NI, v, 0x112, 0xf)); v = fmaxf(v, ML_DPPF(NI, v, 0x114, 0xf)); v = fmaxf(v, ML_DPPF(NI, v, 0x118, 0xf));
    v = fmaxf(v, ML_DPPF(NI, v, 0x142, 0xa)); v = fmaxf(v, ML_DPPF(NI, v, 0x143, 0xc)); return v; }

template <int MODE> __device__ __forceinline__ void mlstm_item(unsigned char* ws, ML_LAS unsigned char* lds, int item, int tid) {
    const int lane = tid & 63, wid = __builtin_amdgcn_readfirstlane(tid >> 6);
    const int b = item >> 3, hd = (item >> 1) & 3, dir = item & 1;
    const float* GT = (const float*)(ws + WS_GATES) + dir * 8 + hd;
    ML_LAS float* DENP = (ML_LAS float*)(lds + DENP_OFF); ML_LAS float* QNP = (ML_LAS float*)(lds + QNP_OFF); ML_LAS float* NB = (ML_LAS float*)(lds + NB_OFF + wid * 64);
    unsigned dq0, dq1, dv0, dv1;
    { const int rl = lane >> 4, pos = lane & 15;
      const int g0 = wid, g1 = wid + 8; const int r0 = 4 * g0 + rl, r1 = 4 * g1 + rl; const int c0 = pos ^ ((rl << 2) | (g0 & 3)), c1 = pos ^ ((rl << 2) | (g1 & 3));
      const int m0 = dir ? 63 - r0 : r0, m1 = dir ? 63 - r1 : r1;
      dq0 = (unsigned)(m0 * 1024 + 16 * c0); dq1 = (unsigned)(m1 * 1024 + 16 * c1); dv0 = (unsigned)(m0 * 2048 + 16 * c0); dv1 = (unsigned)(m1 * 2048 + 16 * c1); }
    const unsigned goff = (unsigned)((dir ? 63 - lane : lane) * 64);
    unsigned trL0, trL1, trX;
    { const unsigned h = lane >> 5, blk = (lane >> 4) & 1u, q = (lane & 15u) >> 2, p = lane & 3u; const unsigned A = 256u * (8u * h + q) + 8u * (p & 1u), lo = 2u * blk + (p >> 1);
      trL0 = A + 16u * (lo ^ ((2u * h) & 3u)); trL1 = A + 16u * (lo ^ ((2u * h + 1u) & 3u)) + 1024u; trX = 64u * q; }
    f32x16 C[4]; f32x4 n4 = {0.f, 0.f, 0.f, 0.f};
#pragma unroll
    for (int i = 0; i < 4; ++i) C[i] = (f32x16){0.f};
    const char* gq = (const char*)(ws + WS_MQ) + ((size_t)b * SEQ * 512 + hd * 128) * 2; const char* gk = (const char*)(ws + WS_MK) + ((size_t)b * SEQ * 512 + hd * 128) * 2;
    const char* gv = (const char*)(ws + WS_MV) + ((size_t)b * SEQ * 1024 + hd * 256) * 2; const char* gg = (const char*)GT + (size_t)b * SEQ * 64;
    unsigned char* ho = ws + (dir ? WS_HB : WS_HF) + ((size_t)(b * 4 + hd) * 32) * 32768 + wid * 4096 + lane * 16;
    const unsigned lds0 = (unsigned)(uintptr_t)lds;
#define ML_TB(c_) (MODE == 1 ? (dir ? (SEQ - 64) : 0) : (dir ? (SEQ - 64 * ((c_) + 1)) : 64 * (c_)))
#define ML_STAGE(bsel_, c_) do { const int tb_ = ML_TB(c_); const unsigned d_ = (unsigned)__builtin_amdgcn_readfirstlane((int)(lds0 + (bsel_) * BUFB + wid * 1024)); \
        const char* q_ = gq + (size_t)tb_ * 1024; const char* k_ = gk + (size_t)tb_ * 1024; const char* v_ = gv + (size_t)tb_ * 2048; \
        glds16(q_ + dq0, d_ + Q_OFF); glds16(q_ + dq1, d_ + Q_OFF + 8192); glds16(k_ + dq0, d_ + K_OFF); glds16(k_ + dq1, d_ + K_OFF + 8192); \
        glds16(v_ + dv0, d_ + V_OFF); glds16(v_ + dv1, d_ + V_OFF + 8192); glds16(v_ + 256 + dv0, d_ + V_OFF + 16384); glds16(v_ + 256 + dv1, d_ + V_OFF + 16384 + 8192); } while (0)
#define ML_GATES(c_, gi_, gf_) do { const char* g_ = gg + (size_t)ML_TB(c_) * 64 + goff; gi_ = *(const float*)g_; gf_ = *(const float*)(g_ + 16); } while (0)
#define ML_VEC(cc_, gi_, gf_, sc_out_) do { ML_LAS float* T_ = (ML_LAS float*)(lds + VEC_OFF + ((cc_) & 1) * VEC_SLOT); \
        const float bcs_ = dscan_add(gf_), cx_ = (gi_) - bcs_, cm_ = dscan_max(cx_), M_ = fmaxf(m, cm_); const float g_ = rdlane(bcs_, 63), M63_ = rdlane(M_, 63); \
        T_[lane] = __expf(cx_ - M63_); T_[64 + lane] = __expf(-(bcs_ + M63_)); \
        sc_out_ = __expf(m - M63_); m = g_ + M63_; } while (0)
    float m = 0.f, sc, sc_n = 1.f, gi_a, gf_a, gi_b = 0.f, gf_b = 0.f; u32x4 pend[4] = {{0u, 0u, 0u, 0u}, {0u, 0u, 0u, 0u}, {0u, 0u, 0u, 0u}, {0u, 0u, 0u, 0u}};
    ML_STAGE(0, 0); ML_GATES(0, gi_a, gf_a); ML_VEC(0, gi_a, gf_a, sc); ML_GATES(1, gi_a, gf_a);
    for (int c = 0; c < SEQ / 64; ++c) {
        const int bsel = c & 1;
        ML_LAS unsigned char* bQ = lds + bsel * BUFB + Q_OFF; ML_LAS unsigned char* bK = lds + bsel * BUFB + K_OFF; ML_LAS unsigned char* bV = lds + bsel * BUFB + V_OFF;
        ML_LAS float* VWE = (ML_LAS float*)(lds + VEC_OFF + bsel * VEC_SLOT); ML_LAS float* VEMT = VWE + 64; ML_LAS float* VR = (ML_LAS float*)(lds + VR_OFF + wid * 256);
        asm volatile("s_waitcnt vmcnt(0) lgkmcnt(0)" ::: "memory"); __builtin_amdgcn_s_barrier(); asm volatile("" ::: "memory");
        if (c > 0) { unsigned char* hc = ho + (size_t)(c - 1) * 32768; *(u32x4*)(hc) = pend[0]; *(u32x4*)(hc + 1024) = pend[1]; *(u32x4*)(hc + 2048) = pend[2]; *(u32x4*)(hc + 3072) = pend[3]; }
        if (c + 1 < SEQ / 64) { ML_STAGE(bsel ^ 1, c + 1);
            if (c + 2 < SEQ / 64) ML_GATES(c + 2, gi_b, gf_b);
            ML_VEC(c + 1, gi_a, gf_a, sc_n); }
        if (MODE == 2) { asm volatile("s_waitcnt lgkmcnt(0)" ::: "memory"); __builtin_amdgcn_s_barrier(); continue; }
        { ML_OPAQUE_LANE(ln); const unsigned r15 = ln & 15u, kg = ln >> 4; const int tj = wid >> 1, sb = (wid & 1) * 2; const unsigned t = 16u * tj + r15;
          const unsigned xq = fxor(r15) << 4;
          ML_LAS unsigned char* qrow = bQ + 256u * t;
          bf16x8 qf[4];
#pragma unroll
          for (int ks = 0; ks < 4; ++ks) qf[ks] = *(const ML_LAS bf16x8*)(qrow + (((4u * ks + kg) << 4) ^ xq));
          float dsum = 0.f; const unsigned hb = 8u * (kg & 1u), kh = kg >> 1;
#pragma unroll
          for (int u = 0; u < 2; ++u) { const unsigned si = sb + u; ML_LAS unsigned char* krow = bK + 256u * (16u * si + r15) + hb;
              f32x4 acc = {0.f, 0.f, 0.f, 0.f};
#pragma unroll
              for (int ks = 0; ks < 4; ++ks) { const unsigned g2 = 4u * ks + 2u * kh;
                  const u32x2 lo = *(const ML_LAS u32x2*)(krow + ((g2 << 4) ^ xq)), hi = *(const ML_LAS u32x2*)(krow + (((g2 + 1u) << 4) ^ xq));
                  const u32x4 kw = {lo.x, lo.y, hi.x, hi.y};
                  acc = __builtin_amdgcn_mfma_f32_16x16x32_bf16(__builtin_bit_cast(bf16x8, kw), qf[ks], acc, 0, 0, 0); }
              const unsigned s0 = 16u * si + 4u * kg; const f32x4 ws4 = *(const ML_LAS f32x4*)(VWE + s0);
              float p[4];
#pragma unroll
              for (int r = 0; r < 4; ++r) { p[r] = (s0 + r <= t) ? acc[r] : 0.f; dsum = fmaf(p[r], ws4[r], dsum); }
              const u32x2 pw = {pkbf(p[0], p[1]), pkbf(p[2], p[3])};
              *(ML_LAS u32x2*)(lds + P_OFF + 128u * t + (((2u * si + kh) ^ (t & 7u)) << 4) + hb) = pw; }
          dsum += __shfl_xor(dsum, 16); dsum += __shfl_xor(dsum, 32);
          if (ln < 16u) DENP[(wid & 1) * 64 + t] = dsum; }
        n4 = n4 * sc;
        { ML_OPAQUE_LANE(ln); const unsigned r15 = ln & 15u, kg = ln >> 4; if (r15 == 0) *(ML_LAS f32x4*)(NB + 4 * kg) = n4;
          const f32x4 nA = *(const ML_LAS f32x4*)(NB + 0), nB = *(const ML_LAS f32x4*)(NB + 4), nC = *(const ML_LAS f32x4*)(NB + 8), nD = *(const ML_LAS f32x4*)(NB + 12);
          const unsigned t = ln; ML_LAS unsigned char* qrow = bQ + 256u * t; const unsigned xq = fxor(t) << 4;
          const bf16x8 c0 = *(const ML_LAS bf16x8*)(qrow + (((2u * wid) << 4) ^ xq)), c1 = *(const ML_LAS bf16x8*)(qrow + (((2u * wid + 1u) << 4) ^ xq));
          float qn = 0.f;
#pragma unroll
          for (int e = 0; e < 4; ++e) { qn = fmaf(s2f(c0[e]), nA[e], qn); qn = fmaf(s2f(c0[4 + e]), nC[e], qn); qn = fmaf(s2f(c1[e]), nB[e], qn); qn = fmaf(s2f(c1[4 + e]), nD[e], qn); }
          QNP[wid * 64 + t] = qn; }
        f32x16 Y0, Y1;
        { ML_OPAQUE_LANE(ln); const unsigned r31 = ln & 31u, h5 = ln >> 5; const unsigned xq = fxor(r31) << 4; ML_LAS unsigned char* q0 = bQ + 256u * r31; ML_LAS unsigned char* q1 = q0 + 256u * 32u;
#pragma unroll
          for (int i = 0; i < 4; ++i) { C[i] = C[i] * sc;
#pragma unroll
              for (int s = 0; s < 2; ++s) { const bf16x8 bfr = pack8(C[i][8 * s + 0], C[i][8 * s + 1], C[i][8 * s + 2], C[i][8 * s + 3], C[i][8 * s + 4], C[i][8 * s + 5], C[i][8 * s + 6], C[i][8 * s + 7]);
                  const unsigned co = ((4u * i + 2u * s + h5) << 4) ^ xq;
                  const bf16x8 a0 = *(const ML_LAS bf16x8*)(q0 + co), a1 = *(const ML_LAS bf16x8*)(q1 + co);
                  if (i == 0 && s == 0) { Y0 = __builtin_amdgcn_mfma_f32_32x32x16_bf16(a0, bfr, (f32x16){0.f}, 0, 0, 0); Y1 = __builtin_amdgcn_mfma_f32_32x32x16_bf16(a1, bfr, (f32x16){0.f}, 0, 0, 0); }
                  else { Y0 = __builtin_amdgcn_mfma_f32_32x32x16_bf16(a0, bfr, Y0, 0, 0, 0); Y1 = __builtin_amdgcn_mfma_f32_32x32x16_bf16(a1, bfr, Y1, 0, 0, 0); } } } }
        bf16x8 vw[4];
        { ML_OPAQUE_LANE(ln); const unsigned h5 = ln >> 5, kg = ln >> 4; const unsigned vt = wid >> 2, vc = wid & 3; bf16x8 vf[4];
          ML_LAS unsigned char* v0 = bV + 16384u * vt + ((64u * vc) ^ trX); ML_LAS unsigned char* va = v0 + trL0; ML_LAS unsigned char* vb = v0 + trL1;
#pragma unroll
          for (int ks = 0; ks < 4; ++ks) vf[ks] = cat8(trrd(va + 4096 * ks), trrd(vb + 4096 * ks));
          ML_LAS float* vwe = VWE + 8 * h5;
#pragma unroll
          for (int ks = 0; ks < 4; ++ks) { const f32x4 w0 = *(const ML_LAS f32x4*)(vwe + 16 * ks), w1 = *(const ML_LAS f32x4*)(vwe + 16 * ks + 4);
              vw[ks] = pack8(s2f(vf[ks][0]) * w0[0], s2f(vf[ks][1]) * w0[1], s2f(vf[ks][2]) * w0[2], s2f(vf[ks][3]) * w0[3], s2f(vf[ks][4]) * w1[0], s2f(vf[ks][5]) * w1[1], s2f(vf[ks][6]) * w1[2], s2f(vf[ks][7]) * w1[3]); }
          ML_LAS unsigned char* ka = bK + trL0; ML_LAS unsigned char* kb = bK + trL1;
#pragma unroll
          for (int i = 0; i < 4; ++i) { const unsigned xo = (64u * i) ^ trX;
#pragma unroll
              for (int ks = 0; ks < 4; ++ks) C[i] = __builtin_amdgcn_mfma_f32_32x32x16_bf16(cat8(trrd(ka + xo + 4096 * ks), trrd(kb + xo + 4096 * ks)), vw[ks], C[i], 0, 0, 0); }
          ML_LAS unsigned char* t16a = bK + tr_addr16(ln, wid, 0, 0); ML_LAS unsigned char* t16b = bK + tr_addr16(ln, wid, 0, 1);
#pragma unroll
          for (int ks = 0; ks < 2; ++ks) { const bf16x8 af = cat8(trrd(t16a + 8192 * ks), trrd(t16b + 8192 * ks));
              const f32x4 w0 = *(const ML_LAS f32x4*)(VWE + 32 * ks + 8 * kg), w1 = *(const ML_LAS f32x4*)(VWE + 32 * ks + 8 * kg + 4);
              n4 = __builtin_amdgcn_mfma_f32_16x16x32_bf16(af, pack8(w0[0], w0[1], w0[2], w0[3], w1[0], w1[1], w1[2], w1[3]), n4, 0, 0, 0); } }
        asm volatile("s_waitcnt lgkmcnt(0)" ::: "memory"); __builtin_amdgcn_s_barrier(); asm volatile("" ::: "memory");
        { ML_OPAQUE_LANE(ln); const unsigned r31 = ln & 31u, h5 = ln >> 5;
          ML_LAS unsigned char* p0 = lds + P_OFF + 128u * r31; ML_LAS unsigned char* p1 = p0 + 128u * 32u; const unsigned xp = (r31 & 7u) << 4;
#pragma unroll
          for (int ks = 0; ks < 4; ++ks) { const unsigned co = ((2u * ks + h5) << 4) ^ xp;
              const bf16x8 a0 = *(const ML_LAS bf16x8*)(p0 + co), a1 = *(const ML_LAS bf16x8*)(p1 + co);
              Y0 = __builtin_amdgcn_mfma_f32_32x32x16_bf16(a0, vw[ks], Y0, 0, 0, 0); Y1 = __builtin_amdgcn_mfma_f32_32x32x16_bf16(a1, vw[ks], Y1, 0, 0, 0); } }
        { ML_OPAQUE_LANE(ln); const unsigned t = ln; float qs = 0.f;
#pragma unroll
          for (int w8 = 0; w8 < 8; ++w8) qs += QNP[w8 * 64 + t];
          const float dn = DENP[t] + DENP[64 + t] + qs; VR[t] = 1.f / fmaxf(fabsf(dn), VEMT[t]); }
        { ML_OPAQUE_LANE(ln); const unsigned h5 = ln >> 5; ML_LAS float* vr = VR + 4 * h5;
#pragma unroll
          for (int qp = 0; qp < 2; ++qp) { const f32x4 ra = *(const ML_LAS f32x4*)(vr + 16 * qp), rb = *(const ML_LAS f32x4*)(vr + 16 * qp + 8), rc = *(const ML_LAS f32x4*)(vr + 32 + 16 * qp), rd = *(const ML_LAS f32x4*)(vr + 32 + 16 * qp + 8);
              const int o = 8 * qp;
              const u32x4 w0 = {pkbf(Y0[o + 0] * ra[0], Y0[o + 1] * ra[1]), pkbf(Y0[o + 2] * ra[2], Y0[o + 3] * ra[3]), pkbf(Y0[o + 4] * rb[0], Y0[o + 5] * rb[1]), pkbf(Y0[o + 6] * rb[2], Y0[o + 7] * rb[3])};
              const u32x4 w1 = {pkbf(Y1[o + 0] * rc[0], Y1[o + 1] * rc[1]), pkbf(Y1[o + 2] * rc[2], Y1[o + 3] * rc[3]), pkbf(Y1[o + 4] * rd[0], Y1[o + 5] * rd[1]), pkbf(Y1[o + 6] * rd[2], Y1[o + 7] * rd[3])};
              pend[qp] = w0; pend[2 + qp] = w1; } }
        asm volatile("" : "+v"(gi_b), "+v"(gf_b));
        sc = sc_n; gi_a = gi_b; gf_a = gf_b;
    }
    { unsigned char* hc = ho + (size_t)(SEQ / 64 - 1) * 32768; *(u32x4*)(hc) = pend[0]; *(u32x4*)(hc + 1024) = pend[1]; *(u32x4*)(hc + 2048) = pend[2]; *(u32x4*)(hc + 3072) = pend[3]; }
#undef ML_STAGE
#undef ML_GATES
#undef ML_VEC
#undef ML_TB
    __syncthreads();
}
}

constexpr int NWAVES = 8;
constexpr int RING_BYTES = 131072;
constexpr int LDS_BYTES = 163840;
constexpr int XCH_OFF = RING_BYTES, ROPE_LDS_OFF = XCH_OFF + 8192, QKG_LDS_OFF = ROPE_LDS_OFF + 16384, SCL_LDS_OFF = QKG_LDS_OFF + 1024;
static_assert(SCL_LDS_OFF + 4096 <= LDS_BYTES - 16, "in-projection LDS map");
static_assert(ml::LDS_END <= LDS_BYTES, "mLSTM LDS map");
#define LAS __attribute__((address_space(3)))
#define GAS __attribute__((address_space(1)))
typedef unsigned v4u __attribute__((ext_vector_type(4)));
typedef unsigned v2u __attribute__((ext_vector_type(2)));
typedef float f32x4 __attribute__((ext_vector_type(4)));
#define LDS_WAIT() asm volatile("s_waitcnt lgkmcnt(0)" ::: "memory")

struct Args { const float* in[9]; float* out; unsigned char* ws; int ph_lo, ph_hi; };

__device__ __forceinline__ float wave_sum(float v) {
#pragma unroll
    for (int o = 1; o < 64; o <<= 1) v += __shfl_xor(v, o);
    return v;
}

#define XB_TMO      128
#define XB_XCNT(j)  (256  + 64 * (j))
#define XB_XSUB(j)  (1280 + 64 * (j))
#define XB_XGEN(j)  (2304 + 64 * (j))
#define XB_TOP      3328
#define XB_TOPGEN   3392
#define XCD_BAR_WORDS 3456
#define XB_SPIN_CAP (1u << 18)

__device__ __forceinline__ unsigned xb_ld(unsigned* p)              { return __hip_atomic_load(p, __ATOMIC_RELAXED, __HIP_MEMORY_SCOPE_AGENT); }
__device__ __forceinline__ unsigned xb_add(unsigned* p, unsigned v) { return __hip_atomic_fetch_add(p, v, __ATOMIC_RELAXED, __HIP_MEMORY_SCOPE_AGENT); }
__device__ __forceinline__ unsigned xb_xcc_id() { return (unsigned)__builtin_amdgcn_s_getreg((3 << 11) | 20) & 0xFu; }
#define XB_SPIN(cond, bar) do { unsigned _sp = 0; while (cond) { __builtin_amdgcn_s_sleep(1); \
    if ((++_sp & 255u) == 0u) { if (xb_ld(&(bar)[XB_TMO])) break; if (_sp > XB_SPIN_CAP) { atomicAdd(&(bar)[XB_TMO], 1u); break; } } } } while (0)

struct XcdBarrier {
    unsigned* bar; unsigned x;
    volatile LAS unsigned* st;
};

__device__ __forceinline__ XcdBarrier xcd_barrier_post(unsigned* bar, volatile LAS unsigned* st) {
    XcdBarrier b; b.bar = bar; b.x = xb_xcc_id(); b.st = st;
    if (threadIdx.x == 0) (void)xb_add(&bar[XB_XCNT(b.x)], 1u);
    return b;
}
__device__ __forceinline__ void xcd_barrier_complete(unsigned* bar, unsigned x, unsigned& nloc, unsigned& nx) {
    const unsigned G = gridDim.x * gridDim.y * gridDim.z;
    unsigned sum, cnt, mine, sp = 0u;
    for (;;) {
        sum = 0u; cnt = 0u; mine = 0u;
#pragma unroll
        for (unsigned j = 0; j < 16; ++j) { const unsigned c = xb_ld(&bar[XB_XCNT(j)]); sum += c; cnt += (c > 0u) ? 1u : 0u; mine = (j == x) ? c : mine; }
        if (sum == G) break;
        __builtin_amdgcn_s_sleep(1);
        if ((++sp & 255u) == 0u) { if (xb_ld(&bar[XB_TMO])) break; if (sp > XB_SPIN_CAP) { atomicAdd(&bar[XB_TMO], 1u); break; } }
    }
    nloc = mine > 0u ? mine : 1u; nx = cnt > 0u ? cnt : 1u;
}

__device__ __forceinline__ void xcd_barrier(const XcdBarrier& b) {
    asm volatile("s_waitcnt vmcnt(0)" ::: "memory");
    __syncthreads();
    if (threadIdx.x == 0) {
        unsigned* bar = b.bar;
        __builtin_amdgcn_s_waitcnt(0);
        unsigned nloc = b.st[0], nx = b.st[1];
        if (nloc == 0u) { xcd_barrier_complete(bar, b.x, nloc, nx); b.st[0] = nloc; b.st[1] = nx; }
        const unsigned old = xb_add(&bar[XB_XSUB(b.x)], 1u);
        const unsigned gen = old / nloc;
        if (old + 1u == (gen + 1u) * nloc) {
            __builtin_amdgcn_fence(__ATOMIC_RELEASE, "agent");
            asm volatile("s_waitcnt vmcnt(0)" ::: "memory");
            const unsigned og = xb_add(&bar[XB_TOP], 1u);
            const unsigned tg = og / nx;
            if (og + 1u == (tg + 1u) * nx) xb_add(&bar[XB_TOPGEN], 1u);
            else XB_SPIN(xb_ld(&bar[XB_TOPGEN]) == tg, bar);
            __builtin_amdgcn_fence(__ATOMIC_ACQUIRE, "agent");
            xb_add(&bar[XB_XGEN(b.x)], 1u);
            asm volatile("s_waitcnt vmcnt(0)" ::: "memory");
        } else {
            XB_SPIN(xb_ld(&bar[XB_XGEN(b.x)]) == gen, bar);
            __builtin_amdgcn_fence(__ATOMIC_ACQUIRE, "agent");
            asm volatile("s_waitcnt vmcnt(0)" ::: "memory");
        }
    }
    __syncthreads();
}

__device__ __forceinline__ int w1_dest_row(int n) {
    if (!HY_SEPARATE_ROPE && n < 1280) { const int s = n & 255; return (n & ~255) | (s & 0xC3) | ((s & 0x10) << 1) | ((s & 0x0C) << 1) | ((s & 0x20) >> 3); }
    if (n >= 2560 && n < 3072) return (n & ~12) | ((n & 4) << 1) | ((n & 8) >> 1);
    return n;
}
__device__ __forceinline__ int q8_dest_row(int n) { return n < NQA ? w1_dest_row(n) : n - (NB1 - NB0); }
__device__ __forceinline__ unsigned pk4i8(float a, float b, float c, float d) {
    int ia = (int)__builtin_rintf(a), ib = (int)__builtin_rintf(b), ic = (int)__builtin_rintf(c), id = (int)__builtin_rintf(d);
    ia = ia < -127 ? -127 : (ia > 127 ? 127 : ia); ib = ib < -127 ? -127 : (ib > 127 ? 127 : ib); ic = ic < -127 ? -127 : (ic > 127 ? 127 : ic); id = id < -127 ? -127 : (id > 127 ? 127 : id);
    return ((unsigned)ia & 0xffu) | (((unsigned)ib & 0xffu) << 8) | (((unsigned)ic & 0xffu) << 16) | ((unsigned)id << 24); }
template <int MODE>
__device__ __forceinline__ void p0_transpose_item(const float* W, int K, int ldw, int kb, int n0, void* WT, LAS float* scr, int lane, const LAS float* cinv) {
    const int k0 = 64 * kb;
#pragma unroll 8
    for (int i = 0; i < 32; ++i) { const int kk = 2 * i + (lane >> 5); scr[kk * 33 + (lane & 31)] = W[(size_t)(k0 + kk) * ldw + n0 + (lane & 31)]; }
    LDS_WAIT(); asm volatile("" ::: "memory");
    const int c = lane & 7;
#pragma unroll
    for (int j = 0; j < 4; ++j) { const int n = (lane >> 3) + 8 * j; const LAS float* s = scr + (8 * c) * 33 + n;
        if constexpr (MODE == 2) { const float ci = cinv[n];
            v2u o8; o8.x = pk4i8(s[0 * 33] * ci, s[1 * 33] * ci, s[2 * 33] * ci, s[3 * 33] * ci); o8.y = pk4i8(s[4 * 33] * ci, s[5 * 33] * ci, s[6 * 33] * ci, s[7 * 33] * ci);
            *(v2u*)((unsigned char*)WT + (size_t)q8_dest_row(n0 + n) * K + k0 + 8 * c) = o8; }
        else { const float ws_ = (MODE == 1 && n0 + n < 3072) ? 0.08838834764831845f : 1.f;
            v4u o; o.x = pk2(s[0 * 33] * ws_, s[1 * 33] * ws_); o.y = pk2(s[2 * 33] * ws_, s[3 * 33] * ws_); o.z = pk2(s[4 * 33] * ws_, s[5 * 33] * ws_); o.w = pk2(s[6 * 33] * ws_, s[7 * 33] * ws_);
            const int nr = (MODE == 1) ? w1_dest_row(n0 + n) - NB0 : n0 + n;
            *(v4u*)((bf16*)WT + (size_t)nr * K + k0 + 8 * c) = o; } }
    LDS_WAIT(); asm volatile("" ::: "memory");
}
__device__ __forceinline__ void p0_q8_colblock(const float* w_in, unsigned char* ws, LAS unsigned char* lds, int cb, int tid, int wave, int lane) {
    const int n0 = cb < NQA / 32 ? 32 * cb : NB1 + 32 * (cb - NQA / 32);
    LAS float* red = (LAS float*)(lds + 8 * 16384);
    const int c4 = (lane & 7) * 4, kr = lane >> 3;
    const float* src = w_in + (size_t)(256 * wave + kr) * NPROJ + n0 + c4;
    f32x4 mx = {0.f, 0.f, 0.f, 0.f};
#pragma unroll 8
    for (int i = 0; i < 32; ++i) { const f32x4 v = *(const f32x4*)(src + (size_t)(8 * i) * NPROJ);
        mx.x = fmaxf(mx.x, fabsf(v.x)); mx.y = fmaxf(mx.y, fabsf(v.y)); mx.z = fmaxf(mx.z, fabsf(v.z)); mx.w = fmaxf(mx.w, fabsf(v.w)); }
#pragma unroll
    for (int o = 8; o < 64; o <<= 1) { mx.x = fmaxf(mx.x, __shfl_xor(mx.x, o)); mx.y = fmaxf(mx.y, __shfl_xor(mx.y, o)); mx.z = fmaxf(mx.z, __shfl_xor(mx.z, o)); mx.w = fmaxf(mx.w, __shfl_xor(mx.w, o)); }
    if (lane < 8) *(LAS f32x4*)(red + wave * 32 + c4) = mx;
    __syncthreads();
    if (tid < 32) { float m = red[tid];
#pragma unroll
        for (int w = 1; w < 8; ++w) m = fmaxf(m, red[w * 32 + tid]);
        m = fmaxf(m, 1e-30f); red[256 + tid] = 127.f / m; ((float*)(ws + WS_SW))[q8_dest_row(n0 + tid)] = m * (1.f / 127.f); }
    __syncthreads();
    LAS float* scr = (LAS float*)(lds + wave * 16384);
    for (int i = 0; i < 4; ++i) p0_transpose_item<2>(w_in, DM, NPROJ, 4 * wave + i, n0, ws + WS_W8T, scr, lane, red + 256);
    __syncthreads();
}
__device__ __forceinline__ float wave_max(float v) {
#pragma unroll
    for (int o = 1; o < 64; o <<= 1) v = fmaxf(v, __shfl_xor(v, o));
    return v;
}
__device__ __forceinline__ void rms_rows2_to_bf16(const float* xrow0, const float* xrow1, const float* g, bf16* orow0, bf16* orow1, unsigned char* frow0, unsigned char* frow1, float* sa0, float* sa1, int lane) {
    const f32x4* xa = (const f32x4*)xrow0 + lane; const f32x4* xb = (const f32x4*)xrow1 + lane; const f32x4* gr = (const f32x4*)g + lane;
    f32x4 v[8], w[8]; float s = 0.f, t = 0.f;
#pragma unroll
    for (int j = 0; j < 8; ++j) { v[j] = __builtin_nontemporal_load(xa + 64 * j); w[j] = __builtin_nontemporal_load(xb + 64 * j); }
#pragma unroll
    for (int j = 0; j < 8; ++j) { s += (v[j].x * v[j].x + v[j].y * v[j].y) + (v[j].z * v[j].z + v[j].w * v[j].w); t += (w[j].x * w[j].x + w[j].y * w[j].y) + (w[j].z * w[j].z + w[j].w * w[j].w); }
    const float r0 = 1.f / sqrtf(wave_sum(s) * (1.f / DM) + EPS), r1 = 1.f / sqrtf(wave_sum(t) * (1.f / DM) + EPS);
    float m0 = 0.f, m1 = 0.f;
#pragma unroll
    for (int j = 0; j < 8; ++j) { const f32x4 gg = gr[64 * j]; v[j] = v[j] * r0 * gg; w[j] = w[j] * r1 * gg;
        m0 = fmaxf(fmaxf(m0, fmaxf(fabsf(v[j].x), fabsf(v[j].y))), fmaxf(fabsf(v[j].z), fabsf(v[j].w))); m1 = fmaxf(fmaxf(m1, fmaxf(fabsf(w[j].x), fabsf(w[j].y))), fmaxf(fabsf(w[j].z), fabsf(w[j].w))); }
    m0 = fmaxf(wave_max(m0), 1e-30f); m1 = fmaxf(wave_max(m1), 1e-30f);
    const float i0 = 127.f / m0, i1 = 127.f / m1;
    if (lane == 0) { *sa0 = m0 * (1.f / 127.f); *sa1 = m1 * (1.f / 127.f); }
    v2u* o0 = (v2u*)orow0 + lane; v2u* o1 = (v2u*)orow1 + lane; unsigned* f0 = (unsigned*)frow0 + lane; unsigned* f1 = (unsigned*)frow1 + lane;
#pragma unroll
    for (int j = 0; j < 8; ++j) { v2u a, b;
        a.x = pk2(v[j].x, v[j].y); a.y = pk2(v[j].z, v[j].w); o0[64 * j] = a; f0[64 * j] = pk4i8(v[j].x * i0, v[j].y * i0, v[j].z * i0, v[j].w * i0);
        b.x = pk2(w[j].x, w[j].y); b.y = pk2(w[j].z, w[j].w); o1[64 * j] = b; f1[64 * j] = pk4i8(w[j].x * i1, w[j].y * i1, w[j].z * i1, w[j].w * i1); }
}
__device__ __forceinline__ void p0_prologue(const Args& a, LAS unsigned char* lds, int vcu, int G, int tid, int wave, int lane) {
    unsigned char* ws = a.ws;
    const float* w_in = a.in[3]; const float* w_out = a.in[8]; const float* norm_g = a.in[2];
    bf16* W2t = (bf16*)(ws + WS_W2T);
    const int gw = vcu * NWAVES + wave, NGW = G * NWAVES; const int gt = vcu * (NWAVES * 64) + tid, NGT = G * NWAVES * 64;
    for (int e = gt; e < 64 * 32; e += NGT) { const int pos = e >> 5, j = e & 31; const float inv = 1.0f / powf(10000.0f, (float)j * (1.0f / 32.0f)); const float ang = (float)pos * inv;
        float* R = (float*)(ws + WS_ROPE); R[2 * e] = cosf(ang); R[2 * e + 1] = sinf(ang); }
    for (int e = gt; e < 16 * DM; e += NGT) { const int g = e >> 11, k = e & (DM - 1); ((bf16*)(ws + WS_WGT))[(size_t)g * DM + k] = (bf16)f2bf(w_in[(size_t)k * NPROJ + NP256 + g]); }
    for (int cb = vcu; cb < NQ8 / 32; cb += G) p0_q8_colblock(w_in, ws, lds, cb, tid, wave, lane);
    LAS float* scr = (LAS float*)(lds + wave * 16384);
    constexpr int I_1 = (DM / 64) * ((NB1 - NB0) / 32), I_2 = (DM / 64) * (DM / 32);
    for (int it = gw; it < I_1 + I_2; it += NGW) {
        if (it < I_1) p0_transpose_item<1>(w_in, DM, NPROJ, it / ((NB1 - NB0) / 32), NB0 + 32 * (it % ((NB1 - NB0) / 32)), ws + WS_W1B, scr, lane, nullptr);
        else p0_transpose_item<0>(w_out, DM, DM, (it - I_1) / (DM / 32), 32 * ((it - I_1) % (DM / 32)), W2t, scr, lane, nullptr);
    }
    bf16* H = (bf16*)(ws + WS_H); unsigned char* H8 = (unsigned char*)a.out; float* SA = (float*)(ws + WS_SA);
    for (int m = gw; m < NTOK; m += 2 * NGW) { const int m1 = (m + NGW < NTOK) ? m + NGW : m;
        const float* xr0 = (m < TOK_PROMPT) ? a.in[0] + (size_t)m * DM : a.in[1] + (size_t)(m - TOK_PROMPT) * DM; const float* xr1 = (m1 < TOK_PROMPT) ? a.in[0] + (size_t)m1 * DM : a.in[1] + (size_t)(m1 - TOK_PROMPT) * DM;
        rms_rows2_to_bf16(xr0, xr1, norm_g, H + (size_t)m * DM, H + (size_t)m1 * DM, H8 + (size_t)m * DM, H8 + (size_t)m1 * DM, SA + m, SA + m1, lane); }
}

__device__ __forceinline__ void p2_qknorm_rope(const Args& a, int vcu, int G, int wave, int lane) {
    unsigned char* ws = a.ws; const float* R = (const float*)(ws + WS_ROPE);
    const int gw = vcu * NWAVES + wave, NGW = G * NWAVES;
    const int fj = lane & 31, c0 = (lane < 32) ? lane : 64 + (lane - 32), c1 = c0 + 32;
    const float gq0 = a.in[5][c0], gq1 = a.in[5][c1], gk0 = a.in[6][c0], gk1 = a.in[6][c1];
    for (int it = gw; it < NTOK * 10; it += NGW) {
        const int t = it / 10, slot = it - t * 10; const int tl = t & (SEQ - 1); const int pos = (lane < 32) ? (tl >> 6) : (tl & 63);
        bf16* p = (slot < 8) ? (bf16*)(ws + WS_MIX) + (size_t)t * 2048 + slot * 128 : (bf16*)(ws + WS_AK) + (size_t)t * 256 + (slot - 8) * 128;
        const float x0 = bf2f(p[c0]), x1 = bf2f(p[c1]);
        const float r = 1.f / sqrtf(wave_sum(x0 * x0 + x1 * x1) * (1.f / 128.f) + EPS);
        const float y0 = x0 * r * ((slot < 8) ? gq0 : gk0), y1 = x1 * r * ((slot < 8) ? gq1 : gk1);
        const float cs = R[2 * (pos * 32 + fj)], sn = R[2 * (pos * 32 + fj) + 1];
        p[c0] = (bf16)f2bf(y0 * cs - y1 * sn); p[c1] = (bf16)f2bf(y1 * cs + y0 * sn);
    }
}

__device__ __forceinline__ void p4_mlstm_recurrent(const Args& a, LAS unsigned char* lds, int vcu, int G, int tid) {
    unsigned char* ws = a.ws;
    const bf16* MQ = (const bf16*)(ws + WS_MQ); const bf16* MK = (const bf16*)(ws + WS_MK); const bf16* MV = (const bf16*)(ws + WS_MV); const float* GT = (const float*)(ws + WS_GATES);
    LAS float* qs = (LAS float*)lds;
    LAS float* ks = qs + 32 * 128;
    LAS float* vs = ks + 32 * 128;
    LAS float* gi = vs + 32 * 256;
    LAS float* gf = gi + 32;
    const int dv = tid >> 1, half = tid & 1;
    for (int item = vcu; item < NSEQ * 8; item += G) {
        const int b = item >> 3, hd = (item >> 1) & 3, dir = item & 1;
        bf16* HO = (bf16*)(ws + (dir ? WS_HB : WS_HF));
        float C[64], nn[64]; float m = 0.f;
#pragma unroll
        for (int j = 0; j < 64; ++j) { C[j] = 0.f; nn[j] = 0.f; }
        for (int p0 = 0; p0 < SEQ; p0 += 32) {
            __syncthreads();
            { const int rr = tid >> 4, c8 = (tid & 15) * 8; const int tok = dir ? (SEQ - 1 - (p0 + rr)) : (p0 + rr); const size_t row = (size_t)b * SEQ + tok;
              const v4u q4 = *(const v4u*)(MQ + row * 512 + hd * 128 + c8), k4 = *(const v4u*)(MK + row * 512 + hd * 128 + c8);
              LAS float* kd = ks + rr * 128 + c8;
              { LAS float* qa = qs + rr * 128 + (c8 & ~8) + ((c8 & 8) >> 1);   qa[0] = bflo(q4.x); qa[1] = bfhi(q4.x); qa[2] = bflo(q4.y); qa[3] = bfhi(q4.y); qa[8] = bflo(q4.z); qa[9] = bfhi(q4.z); qa[10] = bflo(q4.w); qa[11] = bfhi(q4.w); }
              kd[0] = bflo(k4.x); kd[1] = bfhi(k4.x); kd[2] = bflo(k4.y); kd[3] = bfhi(k4.y); kd[4] = bflo(k4.z); kd[5] = bfhi(k4.z); kd[6] = bflo(k4.w); kd[7] = bfhi(k4.w);
              const int c16 = (tid & 15) * 16; LAS float* vd = vs + rr * 256 + c16;
#pragma unroll
              for (int h2 = 0; h2 < 2; ++h2) { const v4u v4 = *(const v4u*)(MV + row * 1024 + hd * 256 + c16 + 8 * h2);
                  vd[8 * h2 + 0] = bflo(v4.x); vd[8 * h2 + 1] = bfhi(v4.x); vd[8 * h2 + 2] = bflo(v4.y); vd[8 * h2 + 3] = bfhi(v4.y); vd[8 * h2 + 4] = bflo(v4.z); vd[8 * h2 + 5] = bfhi(v4.z); vd[8 * h2 + 6] = bflo(v4.w); vd[8 * h2 + 7] = bfhi(v4.w); }
              if (tid < 32) { const int tk = dir ? (SEQ - 1 - (p0 + tid)) : (p0 + tid); const size_t rw = (size_t)b * SEQ + tk; gi[tid] = GT[rw * 16 + dir * 8 + hd]; gf[tid] = GT[rw * 16 + dir * 8 + 4 + hd]; }
            }
            __syncthreads();
            for (int pp = 0; pp < 32; ++pp) {
                const float lf = gf[pp], ii = gi[pp];
                const float mn = fmaxf(lf + m, ii);
                const float ca = expf(lf + m - mn), cb = expf(ii - mn);
                const float bv = cb * vs[pp * 256 + dv];
                float hp = 0.f, qn = 0.f;
                const LAS float* kr = ks + pp * 128 + 64 * half; const LAS float* qr = qs + pp * 128 + 64 * half;
#pragma unroll
                for (int j = 0; j < 64; ++j) { const float kk = kr[j], qq = qr[j];
                    C[j] = fmaf(ca, C[j], kk * bv); nn[j] = fmaf(ca, nn[j], cb * kk); hp = fmaf(qq, C[j], hp); qn = fmaf(qq, nn[j], qn); }
                hp += __shfl_xor(hp, 1); qn += __shfl_xor(qn, 1);
                const float den = fmaxf(fabsf(qn), expf(-mn));
                if (half == 0) { const int pos = p0 + pp, cch = pos >> 6, o = pos & 63, tt = o >> 5, rho = o & 31, q = rho >> 3, hh = (rho >> 2) & 1, e = rho & 3;
                    HO[(((size_t)((b * 4 + hd) * 32 + cch) * 32768) + (dv >> 5) * 4096 + tt * 2048 + (q >> 1) * 1024 + (32 * hh + (dv & 31)) * 16) / 2 + 4 * (q & 1) + e] = (bf16)f2bf(hp / den); }
                m = mn;
            }
        }
    }
}

__device__ __forceinline__ void p5_mlstm_finalize(const Args& a, LAS unsigned char* lds, int vcu, int G, int tid, int wave, int lane) {
    unsigned char* ws = a.ws; const float* mg = a.in[7];
    const bf16* MO = (const bf16*)(ws + WS_MO); const bf16* MZ = (const bf16*)(ws + WS_MZ); bf16* MIX = (bf16*)(ws + WS_MIX);
    LAS float* XS = (LAS float*)lds;
    const int r31 = lane & 31, h5 = lane >> 5, dv0 = 8 * r31;
    constexpr int NIT = NSEQ * 4 * 32;
    v4u f[2][2], bb[2][2];
#define P5_LOAD_H(item_) do { const int bh_ = (item_) >> 5, ck_ = (item_) & 31; \
        const unsigned char* hf_ = ws + WS_HF + ((size_t)bh_ * 32 + ck_) * 32768 + wave * 4096 + lane * 16; const unsigned char* hb_ = ws + WS_HB + ((size_t)bh_ * 32 + (31 - ck_)) * 32768 + wave * 4096 + (lane ^ 32) * 16; \
        _Pragma("unroll") for (int tt = 0; tt < 2; ++tt) _Pragma("unroll") for (int qp = 0; qp < 2; ++qp) { f[tt][qp] = *(const v4u*)(hf_ + tt * 2048 + qp * 1024); bb[tt][qp] = *(const v4u*)(hb_ + (1 - tt) * 2048 + (1 - qp) * 1024); } } while (0)
    if (vcu < NIT) P5_LOAD_H(vcu);
    for (int item = vcu; item < NIT; item += G) {
        const int bh = item >> 5, ck = item & 31, b = bh >> 2, hd = bh & 3;
        v4u mo[4], mz[4];
#pragma unroll
        for (int it = 0; it < 4; ++it) { const int o = it * 16 + wave * 2 + h5; const size_t row = (size_t)b * SEQ + ck * 64 + o;
            mo[it] = *(const v4u*)(MO + row * 1024 + hd * 256 + dv0); mz[it] = *(const v4u*)(MZ + row * 1024 + hd * 256 + dv0); }
        __syncthreads();
#pragma unroll
        for (int tt = 0; tt < 2; ++tt)
#pragma unroll
            for (int qp = 0; qp < 2; ++qp) { const v4u fv = f[tt][qp], bv = bb[tt][qp];
                float fs[8] = {bflo(fv.x), bfhi(fv.x), bflo(fv.y), bfhi(fv.y), bflo(fv.z), bfhi(fv.z), bflo(fv.w), bfhi(fv.w)};
                float bs[8] = {bflo(bv.x), bfhi(bv.x), bflo(bv.y), bfhi(bv.y), bflo(bv.z), bfhi(bv.z), bflo(bv.w), bfhi(bv.w)};
#pragma unroll
                for (int j = 0; j < 8; ++j) { const int o = 32 * tt + 8 * (2 * qp + (j >> 2)) + 4 * h5 + (j & 3); XS[o * 256 + 32 * wave + r31] = fs[j] + bs[7 - j]; } }
        __syncthreads();
        if (item + G < NIT) P5_LOAD_H(item + G);
        const f32x4 g0 = *(const f32x4*)(mg + hd * 256 + dv0), g1 = *(const f32x4*)(mg + hd * 256 + dv0 + 4);
        const float gg[8] = {g0[0], g0[1], g0[2], g0[3], g1[0], g1[1], g1[2], g1[3]};
#pragma unroll
        for (int it = 0; it < 4; ++it) { const int o = it * 16 + wave * 2 + h5; const size_t row = (size_t)b * SEQ + ck * 64 + o;
            const f32x4 x0 = *(const LAS f32x4*)(XS + o * 256 + dv0), x1 = *(const LAS f32x4*)(XS + o * 256 + dv0 + 4);
            float hm[8] = {x0[0], x0[1], x0[2], x0[3], x1[0], x1[1], x1[2], x1[3]};
            const float mo8[8] = {bflo(mo[it].x), bfhi(mo[it].x), bflo(mo[it].y), bfhi(mo[it].y), bflo(mo[it].z), bfhi(mo[it].z), bflo(mo[it].w), bfhi(mo[it].w)};
            const float mz8[8] = {bflo(mz[it].x), bfhi(mz[it].x), bflo(mz[it].y), bfhi(mz[it].y), bflo(mz[it].z), bfhi(mz[it].z), bflo(mz[it].w), bfhi(mz[it].w)};
            float ss = 0.f;
#pragma unroll
            for (int j = 0; j < 8; ++j) { hm[j] = hm[j] * __builtin_amdgcn_rcpf(1.f + __expf(-mo8[j])); ss += hm[j] * hm[j]; }
#pragma unroll
            for (int s = 1; s < 32; s <<= 1) ss += __shfl_xor(ss, s);
            const float r = __builtin_amdgcn_rsqf(ss * (1.f / 256.f) + EPS);
            float ov[8];
#pragma unroll
            for (int j = 0; j < 8; ++j) ov[j] = hm[j] * r * gg[j] * (mz8[j] * __builtin_amdgcn_rcpf(1.f + __expf(-mz8[j])));
            v4u w; w.x = pk2(ov[0], ov[1]); w.y = pk2(ov[2], ov[3]); w.z = pk2(ov[4], ov[5]); w.w = pk2(ov[6], ov[7]);
            *(v4u*)(MIX + row * 2048 + 1024 + hd * 256 + dv0) = w; }
    }
#undef P5_LOAD_H
    __syncthreads();
}

__device__ __forceinline__ void p5_item(const Args& a, LAS unsigned char* lds, int item) {
    int tid_ = threadIdx.x; asm volatile("" : "+v"(tid_));
    const int lane = tid_ & 63, wave = __builtin_amdgcn_readfirstlane(tid_ >> 6);
    unsigned char* ws = a.ws; const float* mg = a.in[7];
    const bf16* MO = (const bf16*)(ws + WS_MO); const bf16* MZ = (const bf16*)(ws + WS_MZ); bf16* MIX = (bf16*)(ws + WS_MIX);
    LAS float* XS = (LAS float*)lds; const int r31 = lane & 31, h5 = lane >> 5, dv0 = 8 * r31;
    const int bh = item >> 5, ck = item & 31, b = bh >> 2, hd = bh & 3;
    const unsigned char* hf_ = ws + WS_HF + ((size_t)bh * 32 + ck) * 32768 + wave * 4096 + lane * 16; const unsigned char* hb_ = ws + WS_HB + ((size_t)bh * 32 + (31 - ck)) * 32768 + wave * 4096 + (lane ^ 32) * 16;
    v4u f[2][2], bb[2][2], mo[4], mz[4];
#pragma unroll
    for (int tt = 0; tt < 2; ++tt)
#pragma unroll
        for (int qp = 0; qp < 2; ++qp) { f[tt][qp] = *(const v4u*)(hf_ + tt * 2048 + qp * 1024); bb[tt][qp] = *(const v4u*)(hb_ + (1 - tt) * 2048 + (1 - qp) * 1024); }
#pragma unroll
    for (int it = 0; it < 4; ++it) { const int o = it * 16 + wave * 2 + h5; const size_t row = (size_t)b * SEQ + ck * 64 + o;
        mo[it] = *(const v4u*)(MO + row * 1024 + hd * 256 + dv0); mz[it] = *(const v4u*)(MZ + row * 1024 + hd * 256 + dv0); }
    __syncthreads();
#pragma unroll
    for (int tt = 0; tt < 2; ++tt)
#pragma unroll
        for (int qp = 0; qp < 2; ++qp) { const v4u fv = f[tt][qp], bv = bb[tt][qp];
            float fs[8] = {bflo(fv.x), bfhi(fv.x), bflo(fv.y), bfhi(fv.y), bflo(fv.z), bfhi(fv.z), bflo(fv.w), bfhi(fv.w)};
            float bs[8] = {bflo(bv.x), bfhi(bv.x), bflo(bv.y), bfhi(bv.y), bflo(bv.z), bfhi(bv.z), bflo(bv.w), bfhi(bv.w)};
#pragma unroll
            for (int j = 0; j < 8; ++j) { const int o = 32 * tt + 8 * (2 * qp + (j >> 2)) + 4 * h5 + (j & 3); XS[o * 256 + 32 * wave + r31] = fs[j] + bs[7 - j]; } }
    __syncthreads();
    const f32x4 g0 = *(const f32x4*)(mg + hd * 256 + dv0), g1 = *(const f32x4*)(mg + hd * 256 + dv0 + 4);
    const float gg[8] = {g0[0], g0[1], g0[2], g0[3], g1[0], g1[1], g1[2], g1[3]};
#pragma unroll
    for (int it = 0; it < 4; ++it) { const int o = it * 16 + wave * 2 + h5; const size_t row = (size_t)b * SEQ + ck * 64 + o;
        const f32x4 x0 = *(const LAS f32x4*)(XS + o * 256 + dv0), x1 = *(const LAS f32x4*)(XS + o * 256 + dv0 + 4);
        float hm[8] = {x0[0], x0[1], x0[2], x0[3], x1[0], x1[1], x1[2], x1[3]};
        const float mo8[8] = {bflo(mo[it].x), bfhi(mo[it].x), bflo(mo[it].y), bfhi(mo[it].y), bflo(mo[it].z), bfhi(mo[it].z), bflo(mo[it].w), bfhi(mo[it].w)};
        const float mz8[8] = {bflo(mz[it].x), bfhi(mz[it].x), bflo(mz[it].y), bfhi(mz[it].y), bflo(mz[it].z), bfhi(mz[it].z), bflo(mz[it].w), bfhi(mz[it].w)};
        float ss = 0.f;
#pragma unroll
        for (int j = 0; j < 8; ++j) { hm[j] = hm[j] * __builtin_amdgcn_rcpf(1.f + __expf(-mo8[j])); ss += hm[j] * hm[j]; }
#pragma unroll
        for (int s = 1; s < 32; s <<= 1) ss += __shfl_xor(ss, s);
        const float r = __builtin_amdgcn_rsqf(ss * (1.f / 256.f) + EPS);
        float ov[8];
#pragma unroll
        for (int j = 0; j < 8; ++j) ov[j] = hm[j] * r * gg[j] * (mz8[j] * __builtin_amdgcn_rcpf(1.f + __expf(-mz8[j])));
        v4u w; w.x = pk2(ov[0], ov[1]); w.y = pk2(ov[2], ov[3]); w.z = pk2(ov[4], ov[5]); w.w = pk2(ov[6], ov[7]);
        *(v4u*)(MIX + row * 2048 + 1024 + hd * 256 + dv0) = w; }
    __syncthreads();
}

__device__ __forceinline__ void p5_batch(const Args& a, LAS unsigned char* lds, int first, int count) {
    if (count <= 0) return;
    int tid_ = threadIdx.x; asm volatile("" : "+v"(tid_));
    const int lane = tid_ & 63, wave = __builtin_amdgcn_readfirstlane(tid_ >> 6);
    unsigned char* ws = a.ws; const float* mg = a.in[7];
    const bf16* MO = (const bf16*)(ws + WS_MO); const bf16* MZ = (const bf16*)(ws + WS_MZ); bf16* MIX = (bf16*)(ws + WS_MIX);
    LAS float* XS = (LAS float*)lds; const int r31 = lane & 31, h5 = lane >> 5, dv0 = 8 * r31;
    v4u f[2][2], bb[2][2];
#define P5B_LOAD_H(item_) do { const int bh_ = (item_) >> 5, ck_ = (item_) & 31; \
        const unsigned char* hf_ = ws + WS_HF + ((size_t)bh_ * 32 + ck_) * 32768 + wave * 4096 + lane * 16; const unsigned char* hb_ = ws + WS_HB + ((size_t)bh_ * 32 + (31 - ck_)) * 32768 + wave * 4096 + (lane ^ 32) * 16; \
        _Pragma("unroll") for (int tt = 0; tt < 2; ++tt) _Pragma("unroll") for (int qp = 0; qp < 2; ++qp) { f[tt][qp] = *(const v4u*)(hf_ + tt * 2048 + qp * 1024); bb[tt][qp] = *(const v4u*)(hb_ + (1 - tt) * 2048 + (1 - qp) * 1024); } } while (0)
    P5B_LOAD_H(first);
    for (int i = 0; i < count; ++i) {
        const int item = first + i, bh = item >> 5, ck = item & 31, b = bh >> 2, hd = bh & 3;
        v4u mo[4], mz[4];
#pragma unroll
        for (int it = 0; it < 4; ++it) { const int o = it * 16 + wave * 2 + h5; const size_t row = (size_t)b * SEQ + ck * 64 + o;
            mo[it] = *(const v4u*)(MO + row * 1024 + hd * 256 + dv0); mz[it] = *(const v4u*)(MZ + row * 1024 + hd * 256 + dv0); }
        __syncthreads();
#pragma unroll
        for (int tt = 0; tt < 2; ++tt)
#pragma unroll
            for (int qp = 0; qp < 2; ++qp) { const v4u fv = f[tt][qp], bv = bb[tt][qp];
                float fs[8] = {bflo(fv.x), bfhi(fv.x), bflo(fv.y), bfhi(fv.y), bflo(fv.z), bfhi(fv.z), bflo(fv.w), bfhi(fv.w)};
                float bs[8] = {bflo(bv.x), bfhi(bv.x), bflo(bv.y), bfhi(bv.y), bflo(bv.z), bfhi(bv.z), bflo(bv.w), bfhi(bv.w)};
#pragma unroll
                for (int j = 0; j < 8; ++j) { const int o = 32 * tt + 8 * (2 * qp + (j >> 2)) + 4 * h5 + (j & 3); XS[o * 256 + 32 * wave + r31] = fs[j] + bs[7 - j]; } }
        __syncthreads();
        if (i + 1 < count) P5B_LOAD_H(item + 1);
        const f32x4 g0 = *(const f32x4*)(mg + hd * 256 + dv0), g1 = *(const f32x4*)(mg + hd * 256 + dv0 + 4);
        const float gg[8] = {g0[0], g0[1], g0[2], g0[3], g1[0], g1[1], g1[2], g1[3]};
#pragma unroll
        for (int it = 0; it < 4; ++it) { const int o = it * 16 + wave * 2 + h5; const size_t row = (size_t)b * SEQ + ck * 64 + o;
            const f32x4 x0 = *(const LAS f32x4*)(XS + o * 256 + dv0), x1 = *(const LAS f32x4*)(XS + o * 256 + dv0 + 4);
            float hm[8] = {x0[0], x0[1], x0[2], x0[3], x1[0], x1[1], x1[2], x1[3]};
            const float mo8[8] = {bflo(mo[it].x), bfhi(mo[it].x), bflo(mo[it].y), bfhi(mo[it].y), bflo(mo[it].z), bfhi(mo[it].z), bflo(mo[it].w), bfhi(mo[it].w)};
            const float mz8[8] = {bflo(mz[it].x), bfhi(mz[it].x), bflo(mz[it].y), bfhi(mz[it].y), bflo(mz[it].z), bfhi(mz[it].z), bflo(mz[it].w), bfhi(mz[it].w)};
            float ss = 0.f;
#pragma unroll
            for (int j = 0; j < 8; ++j) { hm[j] = hm[j] * __builtin_amdgcn_rcpf(1.f + __expf(-mo8[j])); ss += hm[j] * hm[j]; }
#pragma unroll
            for (int s = 1; s < 32; s <<= 1) ss += __shfl_xor(ss, s);
            const float r = __builtin_amdgcn_rsqf(ss * (1.f / 256.f) + EPS);
            float ov[8];
#pragma unroll
            for (int j = 0; j < 8; ++j) ov[j] = hm[j] * r * gg[j] * (mz8[j] * __builtin_amdgcn_rcpf(1.f + __expf(-mz8[j])));
            v4u w; w.x = pk2(ov[0], ov[1]); w.y = pk2(ov[2], ov[3]); w.z = pk2(ov[4], ov[5]); w.w = pk2(ov[6], ov[7]);
            *(v4u*)(MIX + row * 2048 + 1024 + hd * 256 + dv0) = w; }
    }
#undef P5B_LOAD_H
    __syncthreads();
}

__device__ __forceinline__ void gate_rows48(unsigned char* ws, const float* b_gates, int row0, int lane) {
    typedef short bf16x8 __attribute__((ext_vector_type(8)));
    const int r15 = lane & 15, kg = lane >> 4;
    const bf16* a0p = (const bf16*)(ws + WS_H) + (size_t)(row0 + r15) * DM + 8 * kg; const bf16* a1p = a0p + 16 * DM; const bf16* a2p = a0p + 32 * DM;
    const bf16* bp = (const bf16*)(ws + WS_WGT) + (size_t)r15 * DM + 8 * kg;
    f32x4 acc0 = {0.f, 0.f, 0.f, 0.f}, acc1 = {0.f, 0.f, 0.f, 0.f}, acc2 = {0.f, 0.f, 0.f, 0.f};
#pragma unroll 8
    for (int ks = 0; ks < DM / 32; ++ks) { const bf16x8 a0 = *(const bf16x8*)(a0p + 32 * ks), a1 = *(const bf16x8*)(a1p + 32 * ks), a2 = *(const bf16x8*)(a2p + 32 * ks), b = *(const bf16x8*)(bp + 32 * ks);
        acc0 = __builtin_amdgcn_mfma_f32_16x16x32_bf16(a0, b, acc0, 0, 0, 0); acc1 = __builtin_amdgcn_mfma_f32_16x16x32_bf16(a1, b, acc1, 0, 0, 0); acc2 = __builtin_amdgcn_mfma_f32_16x16x32_bf16(a2, b, acc2, 0, 0, 0); }
    const float bias = b_gates[r15]; const bool isf = (r15 >> 2) & 1; float* G = (float*)(ws + WS_GATES) + (size_t)(row0 + 4 * kg) * 16 + r15;
#pragma unroll
    for (int r = 0; r < 4; ++r) { float v0 = acc0[r] + bias, v1 = acc1[r] + bias, v2 = acc2[r] + bias; if (isf) { v0 = log_sigmoid_f(v0); v1 = log_sigmoid_f(v1); v2 = log_sigmoid_f(v2); }
        G[r * 16] = v0; G[(16 + r) * 16] = v1; G[(32 + r) * 16] = v2; }
}

constexpr int N_PHASES = 7;
__global__ void __launch_bounds__(NWAVES * 64, 2) hy_fwd(Args args) {
    extern __shared__ __attribute__((aligned(16))) unsigned char lds_raw[];
    LAS unsigned char* lds = (LAS unsigned char*)lds_raw;
    const int tid = threadIdx.x, lane = tid & 63, wave = __builtin_amdgcn_readfirstlane(tid >> 6);
    const int G = gridDim.x; const int bx = blockIdx.x; const int vcu = (G % 8 == 0) ? (bx % 8) * (G / 8) + bx / 8 : bx;
    unsigned char* ws = args.ws;
    const int lo = args.ph_lo, hi = args.ph_hi;
    unsigned* ctl = (unsigned*)(ws + WS_CTL);
    volatile LAS unsigned* bst = (volatile LAS unsigned*)(lds + LDS_BYTES - 16);
    if (tid == 0) { bst[0] = 0u; bst[1] = 0u; }
    __syncthreads();
    XcdBarrier xbar; xbar.bar = ctl + CW_BAR; xbar.x = 0; xbar.st = bst; bool xposted = false;
    const bool one_launch = (lo == 0 && hi == N_PHASES);
    if (one_launch) { xbar = xcd_barrier_post(ctl + CW_BAR, bst); xposted = true; }
#ifndef HY_PHASE_MASK
#define HY_PHASE_MASK 0x7f
#endif
#define IN(k) (((HY_PHASE_MASK >> (k)) & 1) && lo <= (k) && (k) < hi)
#define BOTH(k) (IN(k) && IN((k) + 1))
#ifndef HY_DUP_MASK
#define HY_DUP_MASK 0
#endif
#ifndef HY_PROBE_NULL
#define HY_PROBE_NULL 0
#endif
#ifndef HY_ML_PROBE_MODE
#define HY_ML_PROBE_MODE 0
#endif
#define DUP(k) (((HY_DUP_MASK) >> (k)) & 1)
#define GRID_BAR_CG() do { cg::this_grid().sync(); } while (0)
#define GRID_BAR() do { if (!xposted) { xbar = xcd_barrier_post(ctl + CW_BAR, bst); xposted = true; } xcd_barrier(xbar); } while (0)

    if (IN(0) && DUP(0)) { p0_prologue(args, lds, vcu, G, tid, wave, lane); __syncthreads(); }
    if (IN(0)) { p0_prologue(args, lds, vcu, G, tid, wave, lane); if (BOTH(0)) GRID_BAR(); }

    if (IN(1)) {
        { const float* Rg = (const float*)(ws + WS_ROPE); LAS float* Rl = (LAS float*)(lds + ROPE_LDS_OFF); LAS float* Gl = (LAS float*)(lds + QKG_LDS_OFF);
          for (int e = tid; e < 64 * 32 * 2; e += NWAVES * 64) Rl[e] = Rg[e];
          if (tid < 128) { Gl[tid] = args.in[5][tid]; Gl[128 + tid] = args.in[6][tid]; }
          __syncthreads(); }
        { pg8::Gemm g{(const pg8::bf16_t*)args.out, (const pg8::bf16_t*)(ws + WS_W8T), NTOK, NQ8, DM / 2}; pg8::StaticOrder S; S.init(NTOK, NQ8, G, bx);
          pg8::EpiProjT<0, 2> E{ws, (PG8_LAS float*)(lds + XCH_OFF), (PG8_LAS float*)(lds + ROPE_LDS_OFF), (PG8_LAS float*)(lds + QKG_LDS_OFF), (PG8_LAS float*)(lds + SCL_LDS_OFF), (const float*)(ws + WS_SA), (const float*)(ws + WS_SW)};
          pg8::gemm_phase<pg8::EpiProjT<0, 2>, pg8::StaticOrder, true, true, 2>(lds, g, S, E); }
        { pg8::Gemm g{(const pg8::bf16_t*)(ws + WS_H), (const pg8::bf16_t*)(ws + WS_W1B), NTOK, NB1 - NB0, DM}; pg8::StaticOrder S; S.init(NTOK, NB1 - NB0, G, bx);
          pg8::EpiProjT<NB0 / 256, 0> E{ws, (PG8_LAS float*)(lds + XCH_OFF), (PG8_LAS float*)(lds + ROPE_LDS_OFF), (PG8_LAS float*)(lds + QKG_LDS_OFF), nullptr, nullptr, nullptr};
          pg8::gemm_phase<pg8::EpiProjT<NB0 / 256, 0>, pg8::StaticOrder, true, true, 0>(lds, g, S, E); }
        { const int nun = (NTOK / 256) * (NQ8 / 256), full = nun / G, rem = nun - full * G, light = G - rem;
          if (bx >= rem) for (int it = (bx - rem) * NWAVES + wave; it < NTOK / 48; it += light * NWAVES) gate_rows48(ws, args.in[4], it * 48, lane); }
        if (BOTH(1)) GRID_BAR();
    }

#if HY_SEPARATE_ROPE
    if (IN(2)) { p2_qknorm_rope(args, vcu, G, wave, lane); if (BOTH(2)) GRID_BAR(); }
#endif

#define ATTN_UNIT(grp_, w_) do { const int b_ = (grp_) >> 1, kvh_ = (grp_) & 1, h_ = kvh_ * 4 + ((w_) >> 3), qb_ = (w_) & 7; const size_t row0_ = (size_t)b_ * SEQ + qb_ * 256; \
        bf16* Q_ = (bf16*)(ws + WS_MIX) + row0_ * 2048 + h_ * 128; const attn::bf16* K_ = (const attn::bf16*)(ws + WS_AK) + (size_t)b_ * SEQ * 256 + kvh_ * 128; \
        const attn::bf16* V_ = (const attn::bf16*)(ws + WS_AV) + (size_t)b_ * SEQ * 256 + kvh_ * 128; const bf16* Z_ = (const bf16*)(ws + WS_AZ) + row0_ * 1024 + h_ * 128; \
        int seqv_ = SEQ; asm volatile("" : "+s"(seqv_)); attn::attn_dense_body<attn::bf16>((const attn::bf16*)Q_, K_, V_, Q_, Z_, seqv_, (char*)lds_raw); __syncthreads(); } while (0)
#if HY_SCHED_J
    const bool schedJ = one_launch && G == 256;
    if (schedJ) {
        const int xl = vcu >> 5, s = vcu & 31;
        if (s < 24) ml::mlstm_item<0>(ws, lds, xl * 24 + s, tid);
        else for (int j = 0; j < 2; ++j) ATTN_UNIT(xl, 2 * (s - 24) + j);
        GRID_BAR();
        const int n_rest = (s < 16) ? 6 : 5, n_p5 = (s < 16) ? 8 : 16, p5_0 = (s < 16) ? 8 * (xl * 16 + s) : 1024 + 16 * (xl * 16 + (s - 16));
        int p5_done = 0;
        for (int jr = 0; jr < n_rest; ++jr) {
            if ((jr & 1) == 0) { const int tgt = (n_p5 * ((jr >> 1) + 1)) / 3;
                p5_batch(args, lds, p5_0 + p5_done, tgt - p5_done); p5_done = tgt; }
            const int li = s + 32 * jr;
            const int grp = (li < 16) ? xl : xl + 8 * (1 + ((li - 16) >> 5)), w = (li < 16) ? 16 + li : (li - 16) & 31;
            ATTN_UNIT(grp, w);
        }
        GRID_BAR();
    }
#else
    const bool schedJ = false;
#endif

    if (!schedJ && IN(3)) {
        for (int u = vcu; u < NSEQ * 2 * 32; u += G) ATTN_UNIT(u >> 5, u & 31);
        if (BOTH(3)) GRID_BAR();
    }

    if (!schedJ && IN(4) && DUP(4)) {
#if HY_MLSTM_REF
        p4_mlstm_recurrent(args, lds, vcu, G, tid);
#else
        for (int item = vcu; item < NSEQ * 8; item += G) ml::mlstm_item<HY_ML_PROBE_MODE>(ws, lds, item, tid);
#endif
        if (BOTH(4)) GRID_BAR(); }

    if (!schedJ && IN(4)) {
#if HY_MLSTM_REF
        p4_mlstm_recurrent(args, lds, vcu, G, tid);
#else
        for (int item = vcu; item < NSEQ * 8; item += G) ml::mlstm_item<0>(ws, lds, item, tid);
#endif
        if (BOTH(4)) GRID_BAR(); }

    if (!schedJ && IN(5) && DUP(5)) { p5_mlstm_finalize(args, lds, vcu, G, tid, wave, lane); }
    if (!schedJ && IN(5)) { p5_mlstm_finalize(args, lds, vcu, G, tid, wave, lane); if (BOTH(5)) GRID_BAR(); }

    if (IN(6) && DUP(6)) {
        pg8::Gemm g{(const pg8::bf16_t*)(ws + WS_MIX), (const pg8::bf16_t*)(ws + WS_W2T), NTOK, DM, DM}; pg8::StaticOrder S; S.init(NTOK, DM, G, bx);
        pg8::EpiOut E{args.in[0], args.in[1], args.out};
        pg8::gemm_phase<pg8::EpiOut, pg8::StaticOrder, true, true>(lds, g, S, E);
    }
    if (IN(6)) {
        pg8::Gemm g{(const pg8::bf16_t*)(ws + WS_MIX), (const pg8::bf16_t*)(ws + WS_W2T), NTOK, DM, DM}; pg8::StaticOrder S; S.init(NTOK, DM, G, bx);
        pg8::EpiOut E{args.in[0], args.in[1], args.out};
        pg8::gemm_phase<pg8::EpiOut, pg8::StaticOrder, true, true>(lds, g, S, E);
    }
    if (one_launch && lo < 0) GRID_BAR_CG();
#undef IN
#undef BOTH
}

extern "C" void kernel_launch(void* const* d_in, const int* in_sizes, int n_in, void* d_out, int out_size, void* d_ws, size_t ws_size, hipStream_t stream) {
    static int grid = 0;
    if (grid == 0) {
        if (n_in != 9 || in_sizes[0] != TOK_PROMPT * DM || in_sizes[1] != (NTOK - TOK_PROMPT) * DM || out_size != NTOK * DM || ws_size < WS_END) {
            fprintf(stderr, "kernel_launch: shape mismatch n_in %d in0 %d in1 %d out %d ws %zu (need %zu)\n", n_in, n_in > 0 ? in_sizes[0] : -1, n_in > 1 ? in_sizes[1] : -1, out_size, ws_size, (size_t)WS_END); grid = -1; return; }
        int dev = 0, cus = 0, per_cu = 0;
        if (hipGetDevice(&dev) != hipSuccess || hipDeviceGetAttribute(&cus, hipDeviceAttributeMultiprocessorCount, dev) != hipSuccess) { fprintf(stderr, "kernel_launch: device query failed\n"); grid = -1; return; }
        if (hipFuncSetAttribute((const void*)hy_fwd, hipFuncAttributeMaxDynamicSharedMemorySize, LDS_BYTES) != hipSuccess) { fprintf(stderr, "kernel_launch: hipFuncSetAttribute failed\n"); grid = -1; return; }
        if (hipOccupancyMaxActiveBlocksPerMultiprocessor(&per_cu, (const void*)hy_fwd, NWAVES * 64, LDS_BYTES) != hipSuccess || per_cu < 1) { fprintf(stderr, "kernel_launch: occupancy query says %d\n", per_cu); per_cu = 1; }
        (void)hipGetLastError();
        grid = cus;
    }
    if (grid < 0) return;
    if (hipMemsetAsync((char*)d_ws + WS_CTL, 0, 65536, stream) != hipSuccess) { fprintf(stderr, "kernel_launch: hipMemsetAsync of the control words failed\n"); return; }
    Args a{};
    for (int i = 0; i < 9; ++i) a.in[i] = (const float*)d_in[i];
    a.out = (float*)d_out; a.ws = (unsigned char*)d_ws;
#if HY_N_LAUNCHES == 1
    a.ph_lo = 0; a.ph_hi = N_PHASES;
    void* kargs[] = {&a};
    hipError_t e = hipLaunchCooperativeKernel((const void*)hy_fwd, dim3(grid), dim3(NWAVES * 64), kargs, LDS_BYTES, stream);
    if (e != hipSuccess) fprintf(stderr, "kernel_launch: cooperative launch failed: %s (grid %d)\n", hipGetErrorString(e), grid);
#else
    for (int p = 0; p < N_PHASES; ++p) {
        a.ph_lo = p; a.ph_hi = p + 1;
        hipLaunchKernelGGL(hy_fwd, dim3(grid), dim3(NWAVES * 64), LDS_BYTES, stream, a);
        const hipError_t le = hipPeekAtLastError();
        if (le != hipSuccess) { fprintf(stderr, "kernel_launch: launch %d failed: %s\n", p, hipGetErrorName(le)); break; }
    }
#endif
}
```

```cpp
#include <hip/hip_runtime.h>
#include <hip/hip_bf16.h>
#include <hip/hip_cooperative_groups.h>
#include <cstdio>
#include <cstdint>
#include <cmath>
namespace cg = cooperative_groups;

#ifndef HY_SEPARATE_ROPE
#define HY_SEPARATE_ROPE 0
#endif
#ifndef HY_SCHED_J
#define HY_SCHED_J 1
#endif
#ifndef HY_MLSTM_REF
#define HY_MLSTM_REF 0
#endif
#ifndef HY_N_LAUNCHES
#define HY_N_LAUNCHES 1
#endif

constexpr int SEQ = 2048, NSEQ = 24, NTOK = NSEQ * SEQ, TOK_PROMPT = 8 * SEQ, DM = 2048;
constexpr int NPROJ = 6672, NP256 = 6656;
constexpr float EPS = 1e-6f;

constexpr size_t MiB = 1u << 20;
constexpr size_t WS_CTL = 0, CTL_ZERO_BYTES = 1 * MiB;
constexpr int CW_BAR = 4096, CW_QUEUE = 8192;
constexpr size_t WS_ROPE = 1 * MiB;
constexpr size_t WS_W8T = 2 * MiB;
constexpr size_t WS_W1B = 14 * MiB;
constexpr size_t WS_WGT = 18 * MiB;
constexpr size_t WS_SW = 19 * MiB;
constexpr size_t WS_SA = 20 * MiB;
constexpr size_t WS_W2T = 30 * MiB;
constexpr size_t WS_GATES = 38 * MiB;
constexpr size_t WS_H = 42 * MiB;
constexpr size_t WS_HF = WS_H, WS_HB = WS_H + 96 * MiB;
constexpr size_t WS_MIX = 234 * MiB;
constexpr size_t DO_H8 = 0, DO_Q = 96 * MiB;
constexpr float A8_SCALE = 256.f, W8_SCALE = 512.f;
constexpr size_t WS_AK = 426 * MiB, WS_AV = 450 * MiB;
constexpr size_t WS_AZ = 474 * MiB;
constexpr size_t WS_MQ = 570 * MiB, WS_MK = 618 * MiB;
constexpr size_t WS_MV = 666 * MiB, WS_MO = 762 * MiB, WS_MZ = 858 * MiB;
constexpr size_t WS_END = 954 * MiB;

typedef unsigned short bf16;
__device__ __forceinline__ unsigned f2bf(float f) { unsigned u = __builtin_bit_cast(unsigned, f); return (u + 0x7fffu + ((u >> 16) & 1u)) >> 16; }
__device__ __forceinline__ unsigned pk2(float lo, float hi) { return f2bf(lo) | (f2bf(hi) << 16); }
__device__ __forceinline__ float bf2f(unsigned short b) { return __builtin_bit_cast(float, (unsigned)b << 16); }
__device__ __forceinline__ float bflo(unsigned w) { return __builtin_bit_cast(float, w << 16); }
__device__ __forceinline__ float bfhi(unsigned w) { return __builtin_bit_cast(float, w & 0xffff0000u); }
constexpr int NQA = 2560, NB0 = 2560, NB1 = 3584, NQ8 = 5632;
__device__ __forceinline__ unsigned pk4f8(float a, float b, float c, float d) {
    a = __builtin_fminf(__builtin_fmaxf(a, -448.f), 448.f); b = __builtin_fminf(__builtin_fmaxf(b, -448.f), 448.f); c = __builtin_fminf(__builtin_fmaxf(c, -448.f), 448.f); d = __builtin_fminf(__builtin_fmaxf(d, -448.f), 448.f);
    int w = 0; w = __builtin_amdgcn_cvt_pk_fp8_f32(a, b, w, false); w = __builtin_amdgcn_cvt_pk_fp8_f32(c, d, w, true); return (unsigned)w; }
__device__ __forceinline__ float log_sigmoid_f(float x) { return x >= 0.f ? -log1pf(expf(-x)) : x - log1pf(expf(x)); }
namespace pg8 {
#define PG8_LAS __attribute__((address_space(3)))
typedef unsigned short bf16_t;
typedef short bf16x8 __attribute__((ext_vector_type(8)));
typedef float f32x4 __attribute__((ext_vector_type(4)));
typedef unsigned u32x4 __attribute__((ext_vector_type(4)));
typedef int i32x4 __attribute__((ext_vector_type(4)));
constexpr int F8_TILES = 8;
constexpr int BM = 256, BK = 64, HALF = 128, HTB = HALF * BK * 2  , STAGE_BYTES = 8 * HTB, NXCD = 8, WGM = 8;

__host__ __device__ __forceinline__ int lds_byte(int r, int c) { const int st = (r >> 4) * 2 + (c >> 5), rr = r & 15, cc = c & 31, ob = rr * 64 + cc * 2; return st * 1024 + (ob ^ (((ob >> 9) & 1) << 5)); }
__host__ __device__ __forceinline__ void stage_rc(int b, int& R, int& C) { const int st = b / 1024, sb = b % 1024, swz = sb ^ (((sb >> 9) & 1) << 5); R = (st >> 1) * 16 + swz / 64; C = (st & 1) * 32 + (swz % 64) / 2; }
__host__ __device__ __forceinline__ int perm32(int rho) { const int n = rho >> 4, i = rho & 15; return 8 * (i >> 2) + 4 * n + (i & 3); }

struct Unit { int pm, pn; };
struct Gemm { const bf16_t* A; const bf16_t* Bt; int M, N, K, kt; };

struct StaticOrder {
    int nM, nN, nwg, G, c;
    __host__ __device__ void init(int M, int N, int G_, int c_) { nM = M / BM; nN = N / BM; nwg = nM * nN; G = G_; c = c_; }
    __host__ __device__ bool next(int i, Unit& u) const {
        const long L = (long)i * G + c; if (L >= nwg) return false;
        int wgid = (int)L; { const int q = nwg / NXCD, r = nwg % NXCD, xcd = wgid % NXCD, off = wgid / NXCD; wgid = (xcd < r ? xcd * (q + 1) : r * (q + 1) + (xcd - r) * q) + off; }
        const int nig = WGM * nN, gid = wgid / nig, fm = gid * WGM, gsz = (nM - fm) < WGM ? (nM - fm) : WGM;
        u.pm = fm + ((wgid % nig) % gsz); u.pn = (wgid % nig) / gsz; return true;
    }
    __device__ __forceinline__ void a_ready(const Unit&) const {}
    __device__ __forceinline__ void done(const Unit&) const {}
};


__device__ __forceinline__ unsigned cvt_pk_bf16(float lo, float hi) { unsigned r; asm volatile("v_cvt_pk_bf16_f32 %0, %1, %2" : "=v"(r) : "v"(lo), "v"(hi)); return r; }

template <int PN0, int MODE>
struct EpiProjT {
    static constexpr bool PERM = true, AFTER_DRAIN = false, PREFETCH = (MODE == 2); static constexpr int NSTORE = 16;
    unsigned char* ws; PG8_LAS float* xch; PG8_LAS float* ropeL; PG8_LAS float* qkgL;
    unsigned char* qb;
    PG8_LAS float* scl; const float* SA; const float* SW;
    __device__ __forceinline__ void prefetch(const Unit& u, int ui, int wid, int lane) const {
        const float* src = (wid < 4) ? SA + (size_t)u.pm * BM + wid * 64 + lane : SW + u.pn * BM + (wid - 4) * 64 + lane;
        __builtin_amdgcn_global_load_lds((const unsigned*)src, (PG8_LAS unsigned*)(scl + (ui & 1) * 512 + wid * 64), 4, 0, 0); }
    __device__ __forceinline__ void operator()(const f32x4 (&acc)[2][2][4][2], const Unit& u, int wr, int wc, int fr, int fq, int par = 0) const {
        const int pn = (MODE == 2) ? (u.pn < 10 ? u.pn : u.pn + 4) : u.pn + PN0; const int row0 = u.pm * BM + wr * 64 + fr;
        constexpr float SC = (MODE == 1) ? (1.f / 4096.f) : 1.f;
        float sa[2][4]; f32x4 sw[2][2];
        if constexpr (MODE == 2) { PG8_LAS float* T = scl + par * 512;
#pragma unroll
            for (int ai = 0; ai < 2; ++ai)
#pragma unroll
                for (int m = 0; m < 4; ++m) sa[ai][m] = T[ai * HALF + wr * 64 + m * 16 + fr];
#pragma unroll
            for (int bj = 0; bj < 2; ++bj)
#pragma unroll
                for (int n = 0; n < 2; ++n) sw[bj][n] = *(const PG8_LAS f32x4*)(T + 256 + bj * HALF + wc * 32 + 8 * fq + 4 * n); }
        auto val = [&](int ai, int bj, int m, int n) -> f32x4 {
            if constexpr (MODE == 2) { const i32x4 iv = __builtin_bit_cast(i32x4, acc[ai][bj][m][n]); const f32x4 f = {(float)iv[0], (float)iv[1], (float)iv[2], (float)iv[3]}; return f * sa[ai][m] * sw[bj][n]; }
            else return acc[ai][bj][m][n] * SC; };
        if (!HY_SEPARATE_ROPE && PN0 <= 4 && pn <= 4) {
            PG8_LAS float* gsrc = qkgL + ((pn < 4) ? 0 : 128); const int cb = 64 * (wc >> 1) + 16 * (wc & 1) + 4 * fq;
            const f32x4 g1 = *(const PG8_LAS f32x4*)(gsrc + cb), g2 = *(const PG8_LAS f32x4*)(gsrc + cb + 32);
#pragma unroll
            for (int ai = 0; ai < 2; ++ai)
#pragma unroll
                for (int m = 0; m < 4; ++m)
#pragma unroll
                    for (int bj = 0; bj < 2; ++bj) { const f32x4 a = val(ai, bj, m, 0), b = val(ai, bj, m, 1);
                        float s = ((a[0] * a[0] + a[1] * a[1]) + (a[2] * a[2] + a[3] * a[3])) + ((b[0] * b[0] + b[1] * b[1]) + (b[2] * b[2] + b[3] * b[3]));
                        s += __shfl_xor(s, 16); s += __shfl_xor(s, 32);
                        if (fq == 0) xch[((ai * HALF + wr * 64 + m * 16 + fr) * 2 + bj) * 4 + wc] = s; }
            asm volatile("s_waitcnt lgkmcnt(0)" ::: "memory"); __builtin_amdgcn_s_barrier(); asm volatile("" ::: "memory");
            bf16_t* base = (bf16_t*)(pn < 4 ? qb : ws + WS_AK); const int ldc = (pn < 4) ? 1024 : 256; const int colt = (pn < 4) ? pn * 256 : 0;
            PG8_LAS float* R = ropeL; const int j0 = 16 * (wc & 1) + 4 * fq;
#pragma unroll
            for (int ai = 0; ai < 2; ++ai)
#pragma unroll
                for (int m = 0; m < 4; ++m) { const int row = row0 + ai * HALF + m * 16; const int tl = row & (SEQ - 1); const int pos = (wc < 2) ? (tl >> 6) : (tl & 63);
                    const f32x4 cs0 = *(const PG8_LAS f32x4*)(R + (pos * 32 + j0) * 2), cs1 = *(const PG8_LAS f32x4*)(R + (pos * 32 + j0) * 2 + 4);
#pragma unroll
                    for (int bj = 0; bj < 2; ++bj) { const f32x4 pt = *(const PG8_LAS f32x4*)(xch + ((ai * HALF + wr * 64 + m * 16 + fr) * 2 + bj) * 4);
                        const float rstd = 1.f / sqrtf(((pt[0] + pt[1]) + (pt[2] + pt[3])) * (1.f / 128.f) + EPS);
                        const f32x4 y1 = val(ai, bj, m, 0) * rstd * g1, y2 = val(ai, bj, m, 1) * rstd * g2;
                        const float o10 = y1[0] * cs0[0] - y2[0] * cs0[1], o11 = y1[1] * cs0[2] - y2[1] * cs0[3], o12 = y1[2] * cs1[0] - y2[2] * cs1[1], o13 = y1[3] * cs1[2] - y2[3] * cs1[3];
                        const float o20 = y2[0] * cs0[0] + y1[0] * cs0[1], o21 = y2[1] * cs0[2] + y1[1] * cs0[3], o22 = y2[2] * cs1[0] + y1[2] * cs1[1], o23 = y2[3] * cs1[2] + y1[3] * cs1[3];
                        bf16_t* dst = base + (size_t)row * ldc + colt + bj * HALF + cb;
                        typedef unsigned u32x2v __attribute__((ext_vector_type(2)));
                        u32x2v w1, w2; w1.x = cvt_pk_bf16(o10, o11); w1.y = cvt_pk_bf16(o12, o13); w2.x = cvt_pk_bf16(o20, o21); w2.y = cvt_pk_bf16(o22, o23);
                        *(u32x2v*)dst = w1; *(u32x2v*)(dst + 32) = w2; } }
            return;
        }
        size_t off; int ldc, colt;
        if (pn < 4)       { off = 0; ldc = 1024; colt = pn * 256; }
        else if (pn == 4) { off = WS_AK;  ldc = 256;  colt = 0; }
        else if (pn == 5) { off = WS_AV;  ldc = 256;  colt = 0; }
        else if (pn < 10) { off = WS_AZ;  ldc = 1024; colt = (pn - 6) * 256; }
        else if (pn < 12) { off = WS_MQ;  ldc = 512;  colt = (pn - 10) * 256; }
        else if (pn < 14) { off = WS_MK;  ldc = 512;  colt = (pn - 12) * 256; }
        else if (pn < 18) { off = WS_MV;  ldc = 1024; colt = (pn - 14) * 256; }
        else if (pn < 22) { off = WS_MO;  ldc = 1024; colt = (pn - 18) * 256; }
        else              { off = WS_MZ;  ldc = 1024; colt = (pn - 22) * 256; }
        bf16_t* base = (bf16_t*)(pn < 4 ? qb : ws + off);
        const int col0 = colt + wc * 32 + 8 * fq;
#pragma unroll
        for (int ai = 0; ai < 2; ++ai)
#pragma unroll
            for (int m = 0; m < 4; ++m) { bf16_t* rowp = base + (size_t)(row0 + ai * HALF + m * 16) * ldc + col0;
#pragma unroll
                for (int bj = 0; bj < 2; ++bj) { const f32x4 v0 = val(ai, bj, m, 0), v1 = val(ai, bj, m, 1);
                    u32x4 w; w.x = cvt_pk_bf16(v0[0], v0[1]); w.y = cvt_pk_bf16(v0[2], v0[3]); w.z = cvt_pk_bf16(v1[0], v1[1]); w.w = cvt_pk_bf16(v1[2], v1[3]);
                    *(u32x4*)(rowp + bj * HALF) = w; } }
    }
};
struct EpiNull { static constexpr bool PERM = true, AFTER_DRAIN = false, PREFETCH = false; static constexpr int NSTORE = 0;
    __device__ __forceinline__ void operator()(const f32x4 (&acc)[2][2][4][2], const Unit& u, int wr, int wc, int fr, int fq) const {
#pragma unroll
        for (int ai = 0; ai < 2; ++ai)
#pragma unroll
            for (int bj = 0; bj < 2; ++bj)
#pragma unroll
                for (int m = 0; m < 4; ++m) asm volatile("" :: "v"(acc[ai][bj][m][0]), "v"(acc[ai][bj][m][1])); } };
struct EpiOut {
    static constexpr bool PERM = false, AFTER_DRAIN = false, PREFETCH = false; static constexpr int NSTORE = 32;
    const float* xp; const float* xs; float* out;
    __device__ __forceinline__ void operator()(const f32x4 (&acc)[2][2][4][2], const Unit& u, int wr, int wc, int fr, int fq) const {
        const int row0 = u.pm * BM + wr * 64 + fr; const int col0 = u.pn * BM + wc * 32 + 4 * fq;
        const bool pr = row0 < TOK_PROMPT; const float* xb = (pr ? xp : xs) + col0;
        const size_t xsub = pr ? 0 : (size_t)TOK_PROMPT * DM; float* ob = out + col0;
        f32x4 xr[4][4];
#define EPO_LOAD(g_) do { const size_t ro_ = (size_t)(row0 + ((g_) >> 2) * HALF + ((g_) & 3) * 16) * DM - xsub; \
            xr[(g_) & 3][0] = *(const f32x4*)(xb + ro_); xr[(g_) & 3][1] = *(const f32x4*)(xb + ro_ + 16); xr[(g_) & 3][2] = *(const f32x4*)(xb + ro_ + HALF); xr[(g_) & 3][3] = *(const f32x4*)(xb + ro_ + HALF + 16); } while (0)
        EPO_LOAD(0); EPO_LOAD(1); EPO_LOAD(2);
#pragma unroll
        for (int g = 0; g < 8; ++g) { if (g + 3 < 8) EPO_LOAD(g + 3);
            const int ai = g >> 2, m = g & 3; const size_t ro = (size_t)(row0 + ai * HALF + m * 16) * DM;
            *(f32x4*)(ob + ro) = xr[g & 3][0] + acc[ai][0][m][0]; *(f32x4*)(ob + ro + 16) = xr[g & 3][1] + acc[ai][0][m][1];
            *(f32x4*)(ob + ro + HALF) = xr[g & 3][2] + acc[ai][1][m][0]; *(f32x4*)(ob + ro + HALF + 16) = xr[g & 3][3] + acc[ai][1][m][1]; }
#undef EPO_LOAD
    }
};

template <class Epi, class Sched, bool ALIGN_EPI = false, bool SP2 = false, int MODE = 0>
__device__ __forceinline__ void gemm_phase(PG8_LAS unsigned char* lds, const Gemm g, const Sched& S, const Epi& E) {
    int tid_ = threadIdx.x; asm volatile("" : "+v"(tid_));
    const int tid = tid_, wid = __builtin_amdgcn_readfirstlane(tid >> 6), lane = tid & 63, wr = wid >> 2, wc = wid & 3, fr = lane & 15, fq = lane >> 4;
    const int K = g.K, nt = g.kt;
    unsigned voffA[2], voffB[2];
#pragma unroll
    for (int i = 0; i < 2; ++i) { int R, C; stage_rc(tid * 16 + i * 8192, R, C); const int Rb = Epi::PERM ? ((R & ~31) + perm32(R & 31)) : R;
        voffA[i] = (unsigned)(R * K + C) * 2u; voffB[i] = (unsigned)(Rb * K + C) * 2u; }
    const size_t kstep = (size_t)(BK * 2);
    const size_t hstep = (size_t)HALF * K * 2;
    const size_t tstep = 2 * hstep;
    const unsigned ldsw = (unsigned)wid * 1024u;
    const int aoff = lds_byte(wr * 64 + fr, fq * 8), boff = lds_byte(wc * 32 + fr, fq * 8);
#define PG8_SA(b, h) (((b) * 2 + (h)) * HTB)
#define PG8_SB(b, h) ((4 + (b) * 2 + (h)) * HTB)
#define PG8_STAGE(bufoff, gbase, voff) do { _Pragma("unroll") for (int _i = 0; _i < 2; ++_i) \
        __builtin_amdgcn_global_load_lds((const unsigned*)((const char*)(gbase) + (voff)[_i]), (PG8_LAS unsigned*)(lds + (bufoff) + ldsw + _i * 8192), 16, 0, 0); } while (0)
#define PG8_LDA(dst, b, h) do { _Pragma("unroll") for (int m = 0; m < 4; ++m) _Pragma("unroll") for (int k = 0; k < 2; ++k) dst[m][k] = *(const PG8_LAS bf16x8*)(lds + PG8_SA(b, h) + aoff + m * 2048 + k * 1024); } while (0)
#define PG8_LDB(dst, b, h) do { _Pragma("unroll") for (int n = 0; n < 2; ++n) _Pragma("unroll") for (int k = 0; k < 2; ++k) dst[n][k] = *(const PG8_LAS bf16x8*)(lds + PG8_SB(b, h) + boff + n * 2048 + k * 1024); } while (0)
#define PG8_CAT8(x_) __builtin_shufflevector(__builtin_bit_cast(i32x4, (x_)[0]), __builtin_bit_cast(i32x4, (x_)[1]), 0, 1, 2, 3, 4, 5, 6, 7)
#define PG8_MMA_F8(ai, bj, At, Bt) do { _Pragma("unroll") for (int m = 0; m < 4; ++m) _Pragma("unroll") for (int n = 0; n < 2; ++n) \
        asm volatile("s_nop 1\n\tv_mfma_f32_16x16x128_f8f6f4 %0, %1, %2, %0" : "+v"(acc[ai][bj][m][n]) : "v"(PG8_CAT8(Bt[n])), "v"(PG8_CAT8(At[m]))); } while (0)
#define PG8_MMA_I8(ai, bj, At, Bt) do { _Pragma("unroll") for (int k = 0; k < 2; ++k) _Pragma("unroll") for (int m = 0; m < 4; ++m) _Pragma("unroll") for (int n = 0; n < 2; ++n) \
        asm volatile("s_nop 1\n\tv_mfma_i32_16x16x64_i8 %0, %1, %2, %0" : "+v"(acc[ai][bj][m][n]) : "v"(Bt[n][k]), "v"(At[m][k])); } while (0)
#define PG8_MMA_BF(ai, bj, At, Bt) do { _Pragma("unroll") for (int m = 0; m < 4; ++m) _Pragma("unroll") for (int n = 0; n < 2; ++n) _Pragma("unroll") for (int k = 0; k < 2; ++k) \
        acc[ai][bj][m][n] = __builtin_amdgcn_mfma_f32_16x16x32_bf16(Bt[n][k], At[m][k], acc[ai][bj][m][n], 0, 0, 0); } while (0)
#define PG8_MMA(ai, bj, At, Bt) do { __builtin_amdgcn_s_setprio(1); \
        if constexpr (MODE == 1) PG8_MMA_F8(ai, bj, At, Bt); else if constexpr (MODE == 2) PG8_MMA_I8(ai, bj, At, Bt); else PG8_MMA_BF(ai, bj, At, Bt); \
        __builtin_amdgcn_s_setprio(0); } while (0)
#define PG8_MMAW_F8(ai, bj, At, Bt) do { __builtin_amdgcn_s_setprio(1); PG8_MMA_F8(ai, bj, At, Bt); __builtin_amdgcn_s_setprio(0); } while (0)
#define PG8_MMAW_BF(ai, bj, At, Bt) do { __builtin_amdgcn_s_setprio(1); PG8_MMA_BF(ai, bj, At, Bt); __builtin_amdgcn_s_setprio(0); } while (0)
#define PG8_WAIT_V(n) asm volatile("s_waitcnt vmcnt(" #n ")" ::: "memory")
#define PG8_WAIT_L(n) asm volatile("s_waitcnt lgkmcnt(" #n ")" ::: "memory")
#define PG8_BAR __builtin_amdgcn_s_barrier()
#define PG8_SCHED __builtin_amdgcn_sched_barrier(0)
    Unit cur, nxt; int ui = 0;
    if (!S.next(0, cur)) return;
    f32x4 acc[2][2][4][2];
#pragma unroll
    for (int a = 0; a < 2; ++a)
#pragma unroll
        for (int b = 0; b < 2; ++b)
#pragma unroll
            for (int m = 0; m < 4; ++m)
#pragma unroll
                for (int n = 0; n < 2; ++n) acc[a][b][m][n] = (f32x4){0.f, 0.f, 0.f, 0.f};
    bf16x8 At[4][2], B0[2][2], B1[2][2];
    const char* cA = (const char*)g.A + (size_t)cur.pm * tstep; const char* cB = (const char*)g.Bt + (size_t)cur.pn * tstep;
    S.a_ready(cur);
    if constexpr (SP2) {
        PG8_STAGE(PG8_SB(0, 0), cB, voffB); PG8_STAGE(PG8_SB(0, 1), cB + hstep, voffB); PG8_STAGE(PG8_SA(0, 0), cA, voffA); PG8_STAGE(PG8_SA(0, 1), cA + hstep, voffA);
        if (wr == 1) PG8_BAR;
        PG8_WAIT_V(2); PG8_BAR;
        PG8_STAGE(PG8_SB(1, 0), cB + kstep, voffB); PG8_STAGE(PG8_SA(1, 0), cA + kstep, voffA); PG8_STAGE(PG8_SB(1, 1), cB + hstep + kstep, voffB);
        PG8_WAIT_V(6); PG8_BAR;
    } else {
        PG8_STAGE(PG8_SB(0, 0), cB, voffB); PG8_STAGE(PG8_SA(0, 0), cA, voffA); PG8_STAGE(PG8_SB(0, 1), cB + hstep, voffB); PG8_STAGE(PG8_SA(0, 1), cA + hstep, voffA);
        if (wr == 1) PG8_BAR;
        PG8_WAIT_V(4); PG8_BAR;
        PG8_STAGE(PG8_SB(1, 0), cB + kstep, voffB); PG8_STAGE(PG8_SA(1, 0), cA + kstep, voffA); PG8_STAGE(PG8_SB(1, 1), cB + hstep + kstep, voffB);
        PG8_WAIT_V(6); PG8_BAR;
    }
    for (;;) {
        const bool has_next = S.next(ui + 1, nxt);
        const char* nA = has_next ? (const char*)g.A + (size_t)nxt.pm * tstep : cA; const char* nB = has_next ? (const char*)g.Bt + (size_t)nxt.pn * tstep : cB;
        static_assert(SP2, "gemm_phase: only the SP2 K-loop is carried");
#define PG8_WAIT_FIRST() do { if constexpr (Epi::NSTORE >= 32) asm volatile("s_waitcnt vmcnt(40)\n\ts_cmp_lg_u32 %0, 0\n\ts_cbranch_scc1 1f\n\ts_waitcnt vmcnt(8)\n1:" :: "s"(relax_s) : "memory", "scc"); \
            else if constexpr (Epi::NSTORE >= 16) asm volatile("s_waitcnt vmcnt(24)\n\ts_cmp_lg_u32 %0, 0\n\ts_cbranch_scc1 1f\n\ts_waitcnt vmcnt(8)\n1:" :: "s"(relax_s) : "memory", "scc"); \
            else PG8_WAIT_V(8); } while (0)
#define PG8_TRIP(MMAX) do { \
            const bool last = (t == nt - 2); \
            const char* a1 = cA + (size_t)(t + 1) * kstep; \
            const char* a2 = last ? nA : cA + (size_t)(t + 2) * kstep; const char* b2 = last ? nB : cB + (size_t)(t + 2) * kstep; \
            const char* a3 = a2 + kstep; const char* b3 = b2 + kstep; \
            if (last && has_next) S.a_ready(nxt); \
            const int relax_s = __builtin_amdgcn_readfirstlane((Epi::NSTORE > 0 && t == 0 && ui > 0) ? 1 : 0); \
            PG8_LDB(B0, 0, 0); PG8_LDB(B1, 0, 1); PG8_SCHED; PG8_LDA(At, 0, 0); PG8_STAGE(PG8_SA(1, 1), a1 + hstep, voffA); \
            PG8_WAIT_FIRST(); PG8_WAIT_L(0); PG8_BAR; MMAX(0, 0, At, B0); MMAX(0, 1, At, B1); PG8_BAR; PG8_SCHED; \
            PG8_LDA(At, 0, 1); PG8_STAGE(PG8_SB(0, 0), b2, voffB); PG8_STAGE(PG8_SB(0, 1), b2 + hstep, voffB); PG8_STAGE(PG8_SA(0, 0), a2, voffA); \
            PG8_WAIT_FIRST(); PG8_WAIT_L(0); PG8_BAR; MMAX(1, 0, At, B0); MMAX(1, 1, At, B1); PG8_BAR; PG8_SCHED; \
            if constexpr (Epi::PREFETCH) { if (t == 0) E.prefetch(cur, ui, wid, lane); } \
            PG8_LDB(B0, 1, 0); PG8_LDB(B1, 1, 1); PG8_SCHED; PG8_LDA(At, 1, 0); PG8_STAGE(PG8_SA(0, 1), a2 + hstep, voffA); \
            PG8_WAIT_V(8); PG8_WAIT_L(0); PG8_BAR; MMAX(0, 0, At, B0); MMAX(0, 1, At, B1); PG8_BAR; PG8_SCHED; \
            PG8_LDA(At, 1, 1); PG8_STAGE(PG8_SB(1, 0), b3, voffB); PG8_STAGE(PG8_SB(1, 1), b3 + hstep, voffB); PG8_STAGE(PG8_SA(1, 0), a3, voffA); \
            PG8_WAIT_V(8); PG8_WAIT_L(0); PG8_BAR; MMAX(1, 0, At, B0); MMAX(1, 1, At, B1); PG8_BAR; PG8_SCHED; } while (0)
        if constexpr (MODE == 3) {
            for (int t = 0; t < F8_TILES; t += 2) PG8_TRIP(PG8_MMAW_F8);
            asm volatile("s_nop 15\n\ts_nop 15" ::: "memory"); PG8_SCHED;
#pragma unroll
            for (int a = 0; a < 2; ++a)
#pragma unroll
                for (int b = 0; b < 2; ++b)
#pragma unroll
                    for (int m = 0; m < 4; ++m)
#pragma unroll
                        for (int n = 0; n < 2; ++n) acc[a][b][m][n] *= (1.f / (A8_SCALE * W8_SCALE));
            for (int t = F8_TILES; t < nt; t += 2) PG8_TRIP(PG8_MMAW_BF);
        } else { for (int t = 0; t < nt; t += 2) PG8_TRIP(PG8_MMA); }
#undef PG8_TRIP
#undef PG8_WAIT_FIRST
        if constexpr (MODE == 1 || MODE == 2) { asm volatile("s_nop 15\n\ts_nop 15" ::: "memory"); PG8_SCHED; }
        if constexpr (ALIGN_EPI) { if (wr == 0) PG8_BAR; }
        if constexpr (!Epi::AFTER_DRAIN) { if constexpr (Epi::PREFETCH) E(acc, cur, wr, wc, fr, fq, ui & 1); else E(acc, cur, wr, wc, fr, fq); S.done(cur); }
        if (!has_next) break;
#pragma unroll
        for (int a = 0; a < 2; ++a)
#pragma unroll
            for (int b = 0; b < 2; ++b)
#pragma unroll
                for (int m = 0; m < 4; ++m)
#pragma unroll
                    for (int n = 0; n < 2; ++n) acc[a][b][m][n] = (f32x4){0.f, 0.f, 0.f, 0.f};
        cur = nxt; cA = nA; cB = nB; ++ui;
        if constexpr (ALIGN_EPI) { if (wr == 1) PG8_BAR; }
    }
    PG8_WAIT_V(0);
    if constexpr (!ALIGN_EPI) { if (wr == 0) PG8_BAR; }
    PG8_BAR;
    if constexpr (Epi::AFTER_DRAIN) { E.fused(acc, cur, wr, wc, fr, fq, lds, wid, lane); S.done(cur); }
#undef PG8_SA
#undef PG8_SB
#undef PG8_STAGE
#undef PG8_LDA
#undef PG8_LDB
#undef PG8_MMA
#undef PG8_MMAW_F8
#undef PG8_MMAW_BF
#undef PG8_MMA_F8
#undef PG8_MMA_I8
#undef PG8_MMA_BF
#undef PG8_CAT8
#undef PG8_WAIT_V
#undef PG8_WAIT_L
#undef PG8_BAR
#undef PG8_SCHED
}
}
namespace attn {
using bf16 = __hip_bfloat16;
constexpr int   D = 128, NW = 8, QBLK = 32, KVBLK = 64;
constexpr float SCALE = 0.088388347648318440f;
constexpr float THR = 8.f;
constexpr int SDEPTH = 2;
constexpr int LDQ = 1024, LDK = 256, LDO = 4096, LDZ = 1024;
constexpr size_t SHM_V = KVBLK * D * 2, SHM_K = KVBLK * D * 2, SHM_ATTN = 2 * SHM_V + 2 * SHM_K + NW * 64 * 4;
using bf16x8 = __attribute__((ext_vector_type(8))) short;
using s16x4  = __attribute__((ext_vector_type(4))) short;
using f32x16 = __attribute__((ext_vector_type(16))) float;
using f32x8  = __attribute__((ext_vector_type(8))) float;
using u32x4  = __attribute__((ext_vector_type(4))) unsigned;
#define KSWZ(row, colB) ((row) * 256 + ((colB) ^ (((row) & 7) << 4)))
#define SBAR() __builtin_amdgcn_sched_barrier(0)
__device__ __forceinline__ int crow(int r, int hi) { return (r & 3) + 8 * (r >> 2) + 4 * hi; }
__device__ __forceinline__ unsigned cvtpk(float lo, float hi) {
  unsigned r; asm volatile("v_cvt_pk_bf16_f32 %0, %1, %2" : "=v"(r) : "v"(lo), "v"(hi)); return r;
}
template <typename TIn> struct Stage;
template <> struct Stage<bf16>  { using T = bf16x8;
  __device__ static __forceinline__ T ld8(const bf16* p) { return *reinterpret_cast<const bf16x8*>(p); }
  __device__ static __forceinline__ bf16x8 tobf(T x) { return x; } };
template <> struct Stage<float> { using T = f32x8;
  __device__ static __forceinline__ T ld8(const float* p) { return *reinterpret_cast<const f32x8*>(p); }
  __device__ static __forceinline__ bf16x8 tobf(T x) {
    u32x4 w = {cvtpk(x[0], x[1]), cvtpk(x[2], x[3]), cvtpk(x[4], x[5]), cvtpk(x[6], x[7])}; return *reinterpret_cast<bf16x8*>(&w); } };

__device__ __forceinline__ void partialSM(f32x16& p0, f32x16& p1, float& m_reg, float& mn, float& alpha) {
  constexpr float C = SCALE * 1.4426950408889634f;
  float pmax = p0[0]; for (int r = 1; r < 16; ++r) pmax = fmaxf(pmax, p0[r]); for (int r = 0; r < 16; ++r) pmax = fmaxf(pmax, p1[r]);
  { auto rr = __builtin_amdgcn_permlane32_swap(__float_as_uint(pmax), __float_as_uint(pmax), false, false);
    pmax = fmaxf(__uint_as_float(rr[0]), __uint_as_float(rr[1])); }
  if (__builtin_expect(__all(pmax - m_reg <= THR / SCALE), 1)) { mn = m_reg; alpha = 1.f; }
  else { mn = fmaxf(m_reg, pmax); alpha = __builtin_amdgcn_exp2f((m_reg - mn) * C); m_reg = mn; }
  float mnC = -mn * C;
  for (int r = 0; r < 16; ++r) p0[r] = fmaf(p0[r], C, mnC); for (int r = 0; r < 16; ++r) p1[r] = fmaf(p1[r], C, mnC);
  for (int r = 0; r < 16; ++r) p0[r] = __builtin_amdgcn_exp2f(p0[r]);
}
__device__ __forceinline__ void finishSM(f32x16& p0, f32x16& p1, float alpha, float& l_reg, bf16x8& pa0, bf16x8& pa1, bf16x8& pa2, bf16x8& pa3) {
  for (int r = 0; r < 16; ++r) p1[r] = __builtin_amdgcn_exp2f(p1[r]);
  float ps = 0; for (int r = 0; r < 16; ++r) ps += p0[r]; for (int r = 0; r < 16; ++r) ps += p1[r];
  { auto rr = __builtin_amdgcn_permlane32_swap(__float_as_uint(ps), __float_as_uint(ps), false, false);
    ps = __uint_as_float(rr[0]) + __uint_as_float(rr[1]); }
  l_reg = l_reg * alpha + ps;
#define PK4(P, BASE, OUT) do { unsigned a0 = cvtpk(P[BASE + 0], P[BASE + 1]), a1 = cvtpk(P[BASE + 2], P[BASE + 3]);   \
    unsigned b0 = cvtpk(P[BASE + 4], P[BASE + 5]), b1 = cvtpk(P[BASE + 6], P[BASE + 7]);                              \
    auto r0 = __builtin_amdgcn_permlane32_swap(a0, b0, false, false); auto r1 = __builtin_amdgcn_permlane32_swap(a1, b1, false, false); \
    u32x4 w = {r0[0], r1[0], r0[1], r1[1]}; OUT = *reinterpret_cast<bf16x8*>(&w); } while (0)
  PK4(p0, 0, pa0); PK4(p0, 8, pa1); PK4(p1, 0, pa2); PK4(p1, 8, pa3);
#undef PK4
}
__device__ __forceinline__ void qkt(f32x16& p0, f32x16& p1, const bf16* Ks, const bf16x8* qr, int r32, int hi) {
  p0 = f32x16{}; p1 = f32x16{};
  for (int d0 = 0; d0 < 8; ++d0) { int cb = (d0 * 16 + hi * 8) * 2;
    bf16x8 b0 = *reinterpret_cast<const bf16x8*>((const char*)Ks + KSWZ(r32, cb));
    bf16x8 b1 = *reinterpret_cast<const bf16x8*>((const char*)Ks + KSWZ(32 + r32, cb));
    p0 = __builtin_amdgcn_mfma_f32_32x32x16_bf16(b0, qr[d0], p0, 0, 0, 0);
    p1 = __builtin_amdgcn_mfma_f32_32x32x16_bf16(b1, qr[d0], p1, 0, 0, 0); }
}
__device__ __forceinline__ int v_st(int k, int c) { const int kk = (k & ~0xC) | ((k & 4) << 1) | ((k & 8) >> 1); return ((kk >> 3) * 4 + (c >> 5)) * 512 + ((kk & 7) * 32 + (c & 31)) * 2; }
__device__ __forceinline__ int v_rd_base(int lane) { return ((lane & 3) << 3) | (((lane >> 2) & 3) << 6) | (((lane >> 4) & 1) << 5) | (((lane >> 5) & 1) << 8); }
constexpr int v_rd_off(int d0, int ks, int half) { return d0 * 512 + ks * 4096 + half * 2048; }
template <int OFF> __device__ __forceinline__ s16x4 tr_read(int vb) {
  s16x4 r; asm volatile("ds_read_b64_tr_b16 %0, %1 offset:%2" : "=&v"(r) : "v"(vb), "i"(OFF) : "memory"); return r;
}
template <int D0> __device__ __forceinline__ void pv_one(f32x16& od, int vb, bf16x8 pa0, bf16x8 pa1, bf16x8 pa2, bf16x8 pa3) {
  const s16x4 l0 = tr_read<v_rd_off(D0, 0, 0)>(vb), h0 = tr_read<v_rd_off(D0, 0, 1)>(vb), l1 = tr_read<v_rd_off(D0, 1, 0)>(vb), h1 = tr_read<v_rd_off(D0, 1, 1)>(vb);
  const s16x4 l2 = tr_read<v_rd_off(D0, 2, 0)>(vb), h2 = tr_read<v_rd_off(D0, 2, 1)>(vb), l3 = tr_read<v_rd_off(D0, 3, 0)>(vb), h3 = tr_read<v_rd_off(D0, 3, 1)>(vb);
  asm volatile("s_waitcnt lgkmcnt(0)" ::: "memory"); SBAR();
#define PK(L, H) (bf16x8){L[0], L[1], L[2], L[3], H[0], H[1], H[2], H[3]}
  od = __builtin_amdgcn_mfma_f32_32x32x16_bf16(pa0, PK(l0, h0), od, 0, 0, 0);
  od = __builtin_amdgcn_mfma_f32_32x32x16_bf16(pa1, PK(l1, h1), od, 0, 0, 0);
  od = __builtin_amdgcn_mfma_f32_32x32x16_bf16(pa2, PK(l2, h2), od, 0, 0, 0);
  od = __builtin_amdgcn_mfma_f32_32x32x16_bf16(pa3, PK(l3, h3), od, 0, 0, 0);
#undef PK
}
__device__ __forceinline__ void pv_d0(f32x16* o, int vb, bf16x8 pa0, bf16x8 pa1, bf16x8 pa2, bf16x8 pa3) {
  pv_one<0>(o[0], vb, pa0, pa1, pa2, pa3); pv_one<1>(o[1], vb, pa0, pa1, pa2, pa3); pv_one<2>(o[2], vb, pa0, pa1, pa2, pa3); pv_one<3>(o[3], vb, pa0, pa1, pa2, pa3);
}

template <typename TQ>
__device__ __forceinline__ void attn_dense_body(const TQ* Qb, const bf16* __restrict__ Kh, const bf16* __restrict__ Vh,
                                                unsigned char* Ob, const unsigned short* __restrict__ Zb, int seq, char* lds) {
  using St = Stage<bf16>; using SQ = Stage<TQ>;
  int tid = threadIdx.x; asm volatile("" : "+v"(tid));
  const int wid = tid >> 6, lane = tid & 63, r32 = lane & 31, hi = lane >> 5;
  bf16* V_lds = (bf16*)lds; bf16* K_lds = (bf16*)(lds + 2 * SHM_V);
  float* ws = (float*)(lds + 2 * SHM_V + 2 * SHM_K) + wid * 64; float* li_l = ws; float* al_l = ws + 32;
  float m_reg = -1e30f, l_reg = 0; f32x16 o[4] = {}; bf16x8 qr[8];
  const TQ* Qw = Qb + (long)(wid * QBLK + r32) * LDQ + hi * 8;
#pragma unroll
  for (int d0 = 0; d0 < 8; ++d0) qr[d0] = SQ::tobf(SQ::ld8(Qw + d0 * 16));
  const int sr = tid >> 4, sc = (tid & 15) * 8, vst0 = v_st(sr, sc), vst1 = v_st(32 + sr, sc);
  const int vb0 = (int)(uintptr_t)V_lds + v_rd_base(lane);
  struct { typename St::T vs0, vs1, ks0, ks1; } sr_[SDEPTH];
#define SLOAD(i, k0) do { sr_[i].vs0 = St::ld8(&Vh[(long)((k0) + sr) * LDK + sc]); sr_[i].vs1 = St::ld8(&Vh[(long)((k0) + 32 + sr) * LDK + sc]); \
    sr_[i].ks0 = St::ld8(&Kh[(long)((k0) + sr) * LDK + sc]); sr_[i].ks1 = St::ld8(&Kh[(long)((k0) + 32 + sr) * LDK + sc]); } while (0)
#define SWRITE(b, i) do { *(bf16x8*)((char*)V_lds + (b) * SHM_V + vst0) = St::tobf(sr_[i].vs0);          \
    *(bf16x8*)((char*)V_lds + (b) * SHM_V + vst1) = St::tobf(sr_[i].vs1); int kc = sc * 2;               \
    *(bf16x8*)((char*)K_lds + (b) * SHM_K + KSWZ(sr, kc)) = St::tobf(sr_[i].ks0);                       \
    *(bf16x8*)((char*)K_lds + (b) * SHM_K + KSWZ(32 + sr, kc)) = St::tobf(sr_[i].ks1); } while (0)
#define SWAIT() do { if constexpr (SDEPTH == 2) asm volatile("s_waitcnt vmcnt(4)" ::: "memory"); else asm volatile("s_waitcnt vmcnt(0)" ::: "memory"); } while (0)
#define RESC(a) do { if (__any((a) < 1.f)) { if (hi == 0) al_l[r32] = (a); asm volatile("s_waitcnt lgkmcnt(0)" ::: "memory"); \
    for (int d = 0; d < 4; ++d) for (int r = 0; r < 16; ++r) o[d][r] *= al_l[crow(r, hi)]; } } while (0)
  f32x16 pA0, pA1, pB0, pB1; float mnA, mnB, alA, alB; bf16x8 pa0, pa1, pa2, pa3; const int NT = seq / KVBLK;
  constexpr int SE = 0, SO = SDEPTH - 1;
  SLOAD(SE, 0); asm volatile("s_waitcnt vmcnt(0)" ::: "memory"); SWRITE(0, SE); __syncthreads();
  qkt(pA0, pA1, K_lds, qr, r32, hi); partialSM(pA0, pA1, m_reg, mnA, alA);
  SLOAD(SO, KVBLK); if constexpr (SDEPTH == 2) { if (2 < NT) SLOAD(SE, 2 * KVBLK); }
  SWAIT(); SWRITE(1, SO); __syncthreads();
  for (int j = 1; j + 1 < NT; j += 2) {
    SBAR(); qkt(pB0, pB1, (bf16*)((char*)K_lds + SHM_K), qr, r32, hi);
    finishSM(pA0, pA1, alA, l_reg, pa0, pa1, pa2, pa3); SBAR();
    SLOAD(SO, (j + SDEPTH) * KVBLK); SBAR();
    pv_d0(o, vb0, pa0, pa1, pa2, pa3); partialSM(pB0, pB1, m_reg, mnB, alB);
    __syncthreads(); SWAIT(); SWRITE(0, SE);
    RESC(alB); __syncthreads();
    SBAR(); qkt(pA0, pA1, K_lds, qr, r32, hi);
    finishSM(pB0, pB1, alB, l_reg, pa0, pa1, pa2, pa3); SBAR();
    if (SDEPTH == 1 || j + 3 < NT) SLOAD(SE, (j + 1 + SDEPTH) * KVBLK); SBAR();
    pv_d0(o, vb0 + (int)SHM_V, pa0, pa1, pa2, pa3); partialSM(pA0, pA1, m_reg, mnA, alA);
    __syncthreads(); SWAIT(); SWRITE(1, SO);
    RESC(alA); __syncthreads();
  }
  SBAR(); qkt(pB0, pB1, (bf16*)((char*)K_lds + SHM_K), qr, r32, hi);
  finishSM(pA0, pA1, alA, l_reg, pa0, pa1, pa2, pa3); SBAR();
  pv_d0(o, vb0, pa0, pa1, pa2, pa3); partialSM(pB0, pB1, m_reg, mnB, alB);
  __syncthreads(); RESC(alB);
  finishSM(pB0, pB1, alB, l_reg, pa0, pa1, pa2, pa3); SBAR();
  pv_d0(o, vb0 + (int)SHM_V, pa0, pa1, pa2, pa3);
  if (hi == 0) li_l[r32] = l_reg; asm volatile("s_waitcnt lgkmcnt(0)" ::: "memory");
  float rli[16];
#pragma unroll
  for (int r = 0; r < 16; ++r) rli[r] = __builtin_amdgcn_rcpf(li_l[crow(r, hi)]);
  __syncthreads();
  { unsigned short* stg = (unsigned short*)(lds + wid * 8192);
#pragma unroll
    for (int r = 0; r < 16; ++r) { const int orow = crow(r, hi);
#pragma unroll
      for (int d0 = 0; d0 < 4; ++d0) { unsigned u = __builtin_bit_cast(unsigned, o[d0][r] * rli[r]); u = (u + 0x7fffu + ((u >> 16) & 1u)) >> 16; stg[orow * 128 + d0 * 32 + r32] = (unsigned short)u; } }
    asm volatile("s_waitcnt lgkmcnt(0)" ::: "memory");
    unsigned char* Ow = Ob + (long)(wid * QBLK) * LDO; const unsigned short* Zw = Zb + (long)(wid * QBLK) * LDZ;
#pragma unroll 2
    for (int i = 0; i < 8; ++i) { const int row = i * 4 + (lane >> 4), ch = lane & 15;
      const u32x4 ov = *(const u32x4*)(stg + row * 128 + ch * 8); const u32x4 zv = *(const u32x4*)(Zw + (long)row * LDZ + ch * 8); float g8[8];
#pragma unroll
      for (int e = 0; e < 4; ++e) { const float z0 = __builtin_bit_cast(float, zv[e] << 16), z1 = __builtin_bit_cast(float, zv[e] & 0xffff0000u);
        g8[2 * e] = __builtin_bit_cast(float, ov[e] << 16) * (z0 * __builtin_amdgcn_rcpf(1.f + __expf(-z0))) * A8_SCALE; g8[2 * e + 1] = __builtin_bit_cast(float, ov[e] & 0xffff0000u) * (z1 * __builtin_amdgcn_rcpf(1.f + __expf(-z1))) * A8_SCALE; }
      typedef unsigned u32x2o __attribute__((ext_vector_type(2)));
      u32x2o w; w.x = pk4f8(g8[0], g8[1], g8[2], g8[3]); w.y = pk4f8(g8[4], g8[5], g8[6], g8[7]);
      *(u32x2o*)(Ow + (long)row * LDO + ch * 8) = w; } }
#undef SLOAD
#undef SWRITE
#undef SWAIT
#undef RESC
}

}
namespace ml {
typedef short bf16x8 __attribute__((ext_vector_type(8)));
typedef short v4i16 __attribute__((ext_vector_type(4)));
typedef float f32x4 __attribute__((ext_vector_type(4)));
typedef float f32x16 __attribute__((ext_vector_type(16)));
typedef unsigned u32x4 __attribute__((ext_vector_type(4)));
typedef unsigned u32x2 __attribute__((ext_vector_type(2)));
#define ML_LAS __attribute__((address_space(3)))
constexpr int BUFB = 65536, Q_OFF = 0, K_OFF = 16384, V_OFF = 32768;
constexpr int P_OFF = 131072, DENP_OFF = P_OFF + 8192, QNP_OFF = DENP_OFF + 512, VEC_OFF = QNP_OFF + 2048, VEC_SLOT = 2 * 256, VR_OFF = VEC_OFF + 2 * VEC_SLOT, NB_OFF = VR_OFF + 8 * 256, LDS_END = NB_OFF + 512;
__device__ __forceinline__ unsigned fxor(unsigned row) { return ((row & 3u) << 2) | ((row >> 2) & 3u); }
__device__ __forceinline__ unsigned off_b(unsigned row, unsigned ch) { return 256u * row + 16u * (ch ^ fxor(row)); }
__device__ __forceinline__ unsigned off_p(unsigned t, unsigned ch) { return 128u * t + 16u * (ch ^ (t & 7u)); }
__device__ __forceinline__ unsigned tr_addr(unsigned lane, unsigned c, unsigned ks, unsigned t) { const unsigned h = lane >> 5, blk = (lane >> 4) & 1u, q = (lane & 15u) >> 2, p = lane & 3u; return off_b(16u * ks + 8u * h + 4u * t + q, 4u * c + 2u * blk + (p >> 1)) + 8u * (p & 1u); }
__device__ __forceinline__ unsigned tr_addr16(unsigned lane, unsigned c, unsigned ks, unsigned t) { const unsigned g = lane >> 4, q = (lane & 15u) >> 2, p = lane & 3u; return off_b(32u * ks + 8u * g + 4u * t + q, 2u * c + (p >> 1)) + 8u * (p & 1u); }
__device__ __forceinline__ v4i16 trrd(ML_LAS unsigned char* p) { return __builtin_amdgcn_ds_read_tr16_b64_v4i16((ML_LAS v4i16*)p); }
template <int OFF> __device__ __forceinline__ v4i16 trra(unsigned addr) { v4i16 r; asm volatile("ds_read_b64_tr_b16 %0, %1 offset:%2" : "=v"(r) : "v"(addr), "i"(OFF) : "memory"); return r; }
__device__ __forceinline__ void glds16(const void* gsrc, unsigned lds_dst) { unsigned keep;
    asm volatile("s_mov_b32 %0, m0\n\ts_mov_b32 m0, %2\n\ts_nop 0\n\tglobal_load_lds_dwordx4 %1, off\n\ts_mov_b32 m0, %0" : "=&s"(keep) : "v"(gsrc), "s"(lds_dst) : "memory"); }
#define ML_TRWAIT() do { asm volatile("s_waitcnt lgkmcnt(0)" ::: "memory"); __builtin_amdgcn_sched_barrier(0); } while (0)
__device__ __forceinline__ bf16x8 cat8(v4i16 lo, v4i16 hi) { return (bf16x8){lo[0], lo[1], lo[2], lo[3], hi[0], hi[1], hi[2], hi[3]}; }
__device__ __forceinline__ unsigned pkbf(float lo, float hi) { unsigned r; asm volatile("v_cvt_pk_bf16_f32 %0, %1, %2" : "=v"(r) : "v"(lo), "v"(hi)); return r; }
__device__ __forceinline__ float s2f(short x) { return __builtin_bit_cast(float, (unsigned)(unsigned short)x << 16); }
__device__ __forceinline__ bf16x8 pack8(float a0, float a1, float a2, float a3, float a4, float a5, float a6, float a7) { u32x4 w = {pkbf(a0, a1), pkbf(a2, a3), pkbf(a4, a5), pkbf(a6, a7)}; return __builtin_bit_cast(bf16x8, w); }
__device__ __forceinline__ float scan_add(float v, int lane) {
#pragma unroll
    for (int o = 1; o < 64; o <<= 1) { const float u = __shfl_up(v, o); if (lane >= o) v += u; }
    return v; }
__device__ __forceinline__ float scan_max(float v, int lane) {
#pragma unroll
    for (int o = 1; o < 64; o <<= 1) { const float u = __shfl_up(v, o); if (lane >= o) v = fmaxf(v, u); }
    return v; }
#define ML_OPAQUE_LANE(ln) unsigned ln = (unsigned)lane; asm volatile("" : "+v"(ln))
__device__ __forceinline__ float rdlane(float v, int l) { return __builtin_bit_cast(float, __builtin_amdgcn_readlane(__builtin_bit_cast(int, v), l)); }

__device__ __forceinline__ void stage(ML_LAS unsigned char* lds, int bsel, int c, int b, int hd, int dir, const unsigned short* MQ, const unsigned short* MK, const unsigned short* MV, int wid, int lane) {
    const int rl = lane >> 4, pos = lane & 15;
#pragma unroll
    for (int half = 0; half < 2; ++half) {
        const int grp = wid + 8 * half, row = 4 * grp + rl, ch = pos ^ ((rl << 2) | (grp & 3));
        const int p = 64 * c + row, tok = dir ? (SEQ - 1 - p) : p; const size_t trow = (size_t)b * SEQ + tok;
        ML_LAS unsigned char* d = lds + bsel * BUFB + grp * 1024;
        __builtin_amdgcn_global_load_lds((const unsigned*)(MQ + trow * 512 + hd * 128 + 8 * ch), (ML_LAS unsigned*)(d + Q_OFF), 16, 0, 0);
        __builtin_amdgcn_global_load_lds((const unsigned*)(MK + trow * 512 + hd * 128 + 8 * ch), (ML_LAS unsigned*)(d + K_OFF), 16, 0, 0);
        __builtin_amdgcn_global_load_lds((const unsigned*)(MV + trow * 1024 + hd * 256 + 8 * ch), (ML_LAS unsigned*)(d + V_OFF), 16, 0, 0);
        __builtin_amdgcn_global_load_lds((const unsigned*)(MV + trow * 1024 + hd * 256 + 128 + 8 * ch), (ML_LAS unsigned*)(d + V_OFF + 16384), 16, 0, 0);
    }
}

#define ML_DPPF(old_, src_, ctrl_, rm_) __builtin_bit_cast(float, __builtin_amdgcn_update_dpp(__builtin_bit_cast(int, (float)(old_)), __builtin_bit_cast(int, (float)(src_)), ctrl_, rm_, 0xf, false))
__device__ __forceinline__ float dscan_add(float v) {
    v += ML_DPPF(0.f, v, 0x111, 0xf); v += ML_DPPF(0.f, v, 0x112, 0xf); v += ML_DPPF(0.f, v, 0x114, 0xf); v += ML_DPPF(0.f, v, 0x118, 0xf);
    v += ML_DPPF(0.f, v, 0x142, 0xa); v += ML_DPPF(0.f, v, 0x143, 0xc); return v; }
__device__ __forceinline__ float dscan_max(float v) { const float NI = -3.0e38f;
    v = fmaxf(v, ML_DPPF(NI, v, 0x111, 0xf)); v = fmaxf(v, ML_DPPF(NI, v, 0x112, 0xf)); v = fmaxf(v, ML_DPPF(NI, v, 0x114, 0xf)); v = fmaxf(v, ML_DPPF(NI, v, 0x118, 0xf));
    v = fmaxf(v, ML_DPPF(NI, v, 0x142, 0xa)); v = fmaxf(v, ML_DPPF(NI, v, 0x143, 0xc)); return v; }

template <int MODE> __device__ __forceinline__ void mlstm_item(unsigned char* ws, ML_LAS unsigned char* lds, int item, int tid) {
    const int lane = tid & 63, wid = __builtin_amdgcn_readfirstlane(tid >> 6);
    const int b = item >> 3, hd = (item >> 1) & 3, dir = item & 1;
    const float* GT = (const float*)(ws + WS_GATES) + dir * 8 + hd;
    ML_LAS float* DENP = (ML_LAS float*)(lds + DENP_OFF); ML_LAS float* QNP = (ML_LAS float*)(lds + QNP_OFF); ML_LAS float* NB = (ML_LAS float*)(lds + NB_OFF + wid * 64);
    unsigned dq0, dq1, dv0, dv1;
    { const int rl = lane >> 4, pos = lane & 15;
      const int g0 = wid, g1 = wid + 8; const int r0 = 4 * g0 + rl, r1 = 4 * g1 + rl; const int c0 = pos ^ ((rl << 2) | (g0 & 3)), c1 = pos ^ ((rl << 2) | (g1 & 3));
      const int m0 = dir ? 63 - r0 : r0, m1 = dir ? 63 - r1 : r1;
      dq0 = (unsigned)(m0 * 1024 + 16 * c0); dq1 = (unsigned)(m1 * 1024 + 16 * c1); dv0 = (unsigned)(m0 * 2048 + 16 * c0); dv1 = (unsigned)(m1 * 2048 + 16 * c1); }
    const unsigned goff = (unsigned)((dir ? 63 - lane : lane) * 64);
    unsigned trL0, trL1, trX;
    { const unsigned h = lane >> 5, blk = (lane >> 4) & 1u, q = (lane & 15u) >> 2, p = lane & 3u; const unsigned A = 256u * (8u * h + q) + 8u * (p & 1u), lo = 2u * blk + (p >> 1);
      trL0 = A + 16u * (lo ^ ((2u * h) & 3u)); trL1 = A + 16u * (lo ^ ((2u * h + 1u) & 3u)) + 1024u; trX = 64u * q; }
    f32x16 C[4]; f32x4 n4 = {0.f, 0.f, 0.f, 0.f};
#pragma unroll
    for (int i = 0; i < 4; ++i) C[i] = (f32x16){0.f};
    const char* gq = (const char*)(ws + WS_MQ) + ((size_t)b * SEQ * 512 + hd * 128) * 2; const char* gk = (const char*)(ws + WS_MK) + ((size_t)b * SEQ * 512 + hd * 128) * 2;
    const char* gv = (const char*)(ws + WS_MV) + ((size_t)b * SEQ * 1024 + hd * 256) * 2; const char* gg = (const char*)GT + (size_t)b * SEQ * 64;
    unsigned char* ho = ws + (dir ? WS_HB : WS_HF) + ((size_t)(b * 4 + hd) * 32) * 32768 + wid * 4096 + lane * 16;
    const unsigned lds0 = (unsigned)(uintptr_t)lds;
#define ML_TB(c_) (MODE == 1 ? (dir ? (SEQ - 64) : 0) : (dir ? (SEQ - 64 * ((c_) + 1)) : 64 * (c_)))
#define ML_STAGE(bsel_, c_) do { const int tb_ = ML_TB(c_); const unsigned d_ = (unsigned)__builtin_amdgcn_readfirstlane((int)(lds0 + (bsel_) * BUFB + wid * 1024)); \
        const char* q_ = gq + (size_t)tb_ * 1024; const char* k_ = gk + (size_t)tb_ * 1024; const char* v_ = gv + (size_t)tb_ * 2048; \
        glds16(q_ + dq0, d_ + Q_OFF); glds16(q_ + dq1, d_ + Q_OFF + 8192); glds16(k_ + dq0, d_ + K_OFF); glds16(k_ + dq1, d_ + K_OFF + 8192); \
        glds16(v_ + dv0, d_ + V_OFF); glds16(v_ + dv1, d_ + V_OFF + 8192); glds16(v_ + 256 + dv0, d_ + V_OFF + 16384); glds16(v_ + 256 + dv1, d_ + V_OFF + 16384 + 8192); } while (0)
#define ML_GATES(c_, gi_, gf_) do { const char* g_ = gg + (size_t)ML_TB(c_) * 64 + goff; gi_ = *(const float*)g_; gf_ = *(const float*)(g_ + 16); } while (0)
#define ML_VEC(cc_, gi_, gf_, sc_out_) do { ML_LAS float* T_ = (ML_LAS float*)(lds + VEC_OFF + ((cc_) & 1) * VEC_SLOT); \
        const float bcs_ = dscan_add(gf_), cx_ = (gi_) - bcs_, cm_ = dscan_max(cx_), M_ = fmaxf(m, cm_); const float g_ = rdlane(bcs_, 63), M63_ = rdlane(M_, 63); \
        T_[lane] = __expf(cx_ - M63_); T_[64 + lane] = __expf(-(bcs_ + M63_)); \
        sc_out_ = __expf(m - M63_); m = g_ + M63_; } while (0)
    float m = 0.f, sc, sc_n = 1.f, gi_a, gf_a, gi_b = 0.f, gf_b = 0.f; u32x4 pend[4] = {{0u, 0u, 0u, 0u}, {0u, 0u, 0u, 0u}, {0u, 0u, 0u, 0u}, {0u, 0u, 0u, 0u}};
    ML_STAGE(0, 0); ML_GATES(0, gi_a, gf_a); ML_VEC(0, gi_a, gf_a, sc); ML_GATES(1, gi_a, gf_a);
    for (int c = 0; c < SEQ / 64; ++c) {
        const int bsel = c & 1;
        ML_LAS unsigned char* bQ = lds + bsel * BUFB + Q_OFF; ML_LAS unsigned char* bK = lds + bsel * BUFB + K_OFF; ML_LAS unsigned char* bV = lds + bsel * BUFB + V_OFF;
        ML_LAS float* VWE = (ML_LAS float*)(lds + VEC_OFF + bsel * VEC_SLOT); ML_LAS float* VEMT = VWE + 64; ML_LAS float* VR = (ML_LAS float*)(lds + VR_OFF + wid * 256);
        asm volatile("s_waitcnt vmcnt(0) lgkmcnt(0)" ::: "memory"); __builtin_amdgcn_s_barrier(); asm volatile("" ::: "memory");
        if (c > 0) { unsigned char* hc = ho + (size_t)(c - 1) * 32768; *(u32x4*)(hc) = pend[0]; *(u32x4*)(hc + 1024) = pend[1]; *(u32x4*)(hc + 2048) = pend[2]; *(u32x4*)(hc + 3072) = pend[3]; }
        if (c + 1 < SEQ / 64) { ML_STAGE(bsel ^ 1, c + 1);
            if (c + 2 < SEQ / 64) ML_GATES(c + 2, gi_b, gf_b);
            ML_VEC(c + 1, gi_a, gf_a, sc_n); }
        if (MODE == 2) { asm volatile("s_waitcnt lgkmcnt(0)" ::: "memory"); __builtin_amdgcn_s_barrier(); continue; }
        { ML_OPAQUE_LANE(ln); const unsigned r15 = ln & 15u, kg = ln >> 4; const int tj = wid >> 1, sb = (wid & 1) * 2; const unsigned t = 16u * tj + r15;
          const unsigned xq = fxor(r15) << 4;
          ML_LAS unsigned char* qrow = bQ + 256u * t;
          bf16x8 qf[4];
#pragma unroll
          for (int ks = 0; ks < 4; ++ks) qf[ks] = *(const ML_LAS bf16x8*)(qrow + (((4u * ks + kg) << 4) ^ xq));
          float dsum = 0.f; const unsigned hb = 8u * (kg & 1u), kh = kg >> 1;
#pragma unroll
          for (int u = 0; u < 2; ++u) { const unsigned si = sb + u; ML_LAS unsigned char* krow = bK + 256u * (16u * si + r15) + hb;
              f32x4 acc = {0.f, 0.f, 0.f, 0.f};
#pragma unroll
              for (int ks = 0; ks < 4; ++ks) { const unsigned g2 = 4u * ks + 2u * kh;
                  const u32x2 lo = *(const ML_LAS u32x2*)(krow + ((g2 << 4) ^ xq)), hi = *(const ML_LAS u32x2*)(krow + (((g2 + 1u) << 4) ^ xq));
                  const u32x4 kw = {lo.x, lo.y, hi.x, hi.y};
                  acc = __builtin_amdgcn_mfma_f32_16x16x32_bf16(__builtin_bit_cast(bf16x8, kw), qf[ks], acc, 0, 0, 0); }
              const unsigned s0 = 16u * si + 4u * kg; const f32x4 ws4 = *(const ML_LAS f32x4*)(VWE + s0);
              float p[4];
#pragma unroll
              for (int r = 0; r < 4; ++r) { p[r] = (s0 + r <= t) ? acc[r] : 0.f; dsum = fmaf(p[r], ws4[r], dsum); }
              const u32x2 pw = {pkbf(p[0], p[1]), pkbf(p[2], p[3])};
              *(ML_LAS u32x2*)(lds + P_OFF + 128u * t + (((2u * si + kh) ^ (t & 7u)) << 4) + hb) = pw; }
          dsum += __shfl_xor(dsum, 16); dsum += __shfl_xor(dsum, 32);
          if (ln < 16u) DENP[(wid & 1) * 64 + t] = dsum; }
        n4 = n4 * sc;
        { ML_OPAQUE_LANE(ln); const unsigned r15 = ln & 15u, kg = ln >> 4; if (r15 == 0) *(ML_LAS f32x4*)(NB + 4 * kg) = n4;
          const f32x4 nA = *(const ML_LAS f32x4*)(NB + 0), nB = *(const ML_LAS f32x4*)(NB + 4), nC = *(const ML_LAS f32x4*)(NB + 8), nD = *(const ML_LAS f32x4*)(NB + 12);
          const unsigned t = ln; ML_LAS unsigned char* qrow = bQ + 256u * t; const unsigned xq = fxor(t) << 4;
          const bf16x8 c0 = *(const ML_LAS bf16x8*)(qrow + (((2u * wid) << 4) ^ xq)), c1 = *(const ML_LAS bf16x8*)(qrow + (((2u * wid + 1u) << 4) ^ xq));
          float qn = 0.f;
#pragma unroll
          for (int e = 0; e < 4; ++e) { qn = fmaf(s2f(c0[e]), nA[e], qn); qn = fmaf(s2f(c0[4 + e]), nC[e], qn); qn = fmaf(s2f(c1[e]), nB[e], qn); qn = fmaf(s2f(c1[4 + e]), nD[e], qn); }
          QNP[wid * 64 + t] = qn; }
        f32x16 Y0, Y1;
        { ML_OPAQUE_LANE(ln); const unsigned r31 = ln & 31u, h5 = ln >> 5; const unsigned xq = fxor(r31) << 4; ML_LAS unsigned char* q0 = bQ + 256u * r31; ML_LAS unsigned char* q1 = q0 + 256u * 32u;
#pragma unroll
          for (int i = 0; i < 4; ++i) { C[i] = C[i] * sc;
#pragma unroll
              for (int s = 0; s < 2; ++s) { const bf16x8 bfr = pack8(C[i][8 * s + 0], C[i][8 * s + 1], C[i][8 * s + 2], C[i][8 * s + 3], C[i][8 * s + 4], C[i][8 * s + 5], C[i][8 * s + 6], C[i][8 * s + 7]);
                  const unsigned co = ((4u * i + 2u * s + h5) << 4) ^ xq;
                  const bf16x8 a0 = *(const ML_LAS bf16x8*)(q0 + co), a1 = *(const ML_LAS bf16x8*)(q1 + co);
                  if (i == 0 && s == 0) { Y0 = __builtin_amdgcn_mfma_f32_32x32x16_bf16(a0, bfr, (f32x16){0.f}, 0, 0, 0); Y1 = __builtin_amdgcn_mfma_f32_32x32x16_bf16(a1, bfr, (f32x16){0.f}, 0, 0, 0); }
                  else { Y0 = __builtin_amdgcn_mfma_f32_32x32x16_bf16(a0, bfr, Y0, 0, 0, 0); Y1 = __builtin_amdgcn_mfma_f32_32x32x16_bf16(a1, bfr, Y1, 0, 0, 0); } } } }
        bf16x8 vw[4];
        { ML_OPAQUE_LANE(ln); const unsigned h5 = ln >> 5, kg = ln >> 4; const unsigned vt = wid >> 2, vc = wid & 3; bf16x8 vf[4];
          ML_LAS unsigned char* v0 = bV + 16384u * vt + ((64u * vc) ^ trX); ML_LAS unsigned char* va = v0 + trL0; ML_LAS unsigned char* vb = v0 + trL1;
#pragma unroll
          for (int ks = 0; ks < 4; ++ks) vf[ks] = cat8(trrd(va + 4096 * ks), trrd(vb + 4096 * ks));
          ML_LAS float* vwe = VWE + 8 * h5;
#pragma unroll
          for (int ks = 0; ks < 4; ++ks) { const f32x4 w0 = *(const ML_LAS f32x4*)(vwe + 16 * ks), w1 = *(const ML_LAS f32x4*)(vwe + 16 * ks + 4);
              vw[ks] = pack8(s2f(vf[ks][0]) * w0[0], s2f(vf[ks][1]) * w0[1], s2f(vf[ks][2]) * w0[2], s2f(vf[ks][3]) * w0[3], s2f(vf[ks][4]) * w1[0], s2f(vf[ks][5]) * w1[1], s2f(vf[ks][6]) * w1[2], s2f(vf[ks][7]) * w1[3]); }
          ML_LAS unsigned char* ka = bK + trL0; ML_LAS unsigned char* kb = bK + trL1;
#pragma unroll
          for (int i = 0; i < 4; ++i) { const unsigned xo = (64u * i) ^ trX;
#pragma unroll
              for (int ks = 0; ks < 4; ++ks) C[i] = __builtin_amdgcn_mfma_f32_32x32x16_bf16(cat8(trrd(ka + xo + 4096 * ks), trrd(kb + xo + 4096 * ks)), vw[ks], C[i], 0, 0, 0); }
          ML_LAS unsigned char* t16a = bK + tr_addr16(ln, wid, 0, 0); ML_LAS unsigned char* t16b = bK + tr_addr16(ln, wid, 0, 1);
#pragma unroll
          for (int ks = 0; ks < 2; ++ks) { const bf16x8 af = cat8(trrd(t16a + 8192 * ks), trrd(t16b + 8192 * ks));
              const f32x4 w0 = *(const ML_LAS f32x4*)(VWE + 32 * ks + 8 * kg), w1 = *(const ML_LAS f32x4*)(VWE + 32 * ks + 8 * kg + 4);
              n4 = __builtin_amdgcn_mfma_f32_16x16x32_bf16(af, pack8(w0[0], w0[1], w0[2], w0[3], w1[0], w1[1], w1[2], w1[3]), n4, 0, 0, 0); } }
        asm volatile("s_waitcnt lgkmcnt(0)" ::: "memory"); __builtin_amdgcn_s_barrier(); asm volatile("" ::: "memory");
        { ML_OPAQUE_LANE(ln); const unsigned r31 = ln & 31u, h5 = ln >> 5;
          ML_LAS unsigned char* p0 = lds + P_OFF + 128u * r31; ML_LAS unsigned char* p1 = p0 + 128u * 32u; const unsigned xp = (r31 & 7u) << 4;
#pragma unroll
          for (int ks = 0; ks < 4; ++ks) { const unsigned co = ((2u * ks + h5) << 4) ^ xp;
              const bf16x8 a0 = *(const ML_LAS bf16x8*)(p0 + co), a1 = *(const ML_LAS bf16x8*)(p1 + co);
              Y0 = __builtin_amdgcn_mfma_f32_32x32x16_bf16(a0, vw[ks], Y0, 0, 0, 0); Y1 = __builtin_amdgcn_mfma_f32_32x32x16_bf16(a1, vw[ks], Y1, 0, 0, 0); } }
        { ML_OPAQUE_LANE(ln); const unsigned t = ln; float qs = 0.f;
#pragma unroll
          for (int w8 = 0; w8 < 8; ++w8) qs += QNP[w8 * 64 + t];
          const float dn = DENP[t] + DENP[64 + t] + qs; VR[t] = 1.f / fmaxf(fabsf(dn), VEMT[t]); }
        { ML_OPAQUE_LANE(ln); const unsigned h5 = ln >> 5; ML_LAS float* vr = VR + 4 * h5;
#pragma unroll
          for (int qp = 0; qp < 2; ++qp) { const f32x4 ra = *(const ML_LAS f32x4*)(vr + 16 * qp), rb = *(const ML_LAS f32x4*)(vr + 16 * qp + 8), rc = *(const ML_LAS f32x4*)(vr + 32 + 16 * qp), rd = *(const ML_LAS f32x4*)(vr + 32 + 16 * qp + 8);
              const int o = 8 * qp;
              const u32x4 w0 = {pkbf(Y0[o + 0] * ra[0], Y0[o + 1] * ra[1]), pkbf(Y0[o + 2] * ra[2], Y0[o + 3] * ra[3]), pkbf(Y0[o + 4] * rb[0], Y0[o + 5] * rb[1]), pkbf(Y0[o + 6] * rb[2], Y0[o + 7] * rb[3])};
              const u32x4 w1 = {pkbf(Y1[o + 0] * rc[0], Y1[o + 1] * rc[1]), pkbf(Y1[o + 2] * rc[2], Y1[o + 3] * rc[3]), pkbf(Y1[o + 4] * rd[0], Y1[o + 5] * rd[1]), pkbf(Y1[o + 6] * rd[2], Y1[o + 7] * rd[3])};
              pend[qp] = w0; pend[2 + qp] = w1; } }
        asm volatile("" : "+v"(gi_b), "+v"(gf_b));
        sc = sc_n; gi_a = gi_b; gf_a = gf_b;
    }
    { unsigned char* hc = ho + (size_t)(SEQ / 64 - 1) * 32768; *(u32x4*)(hc) = pend[0]; *(u32x4*)(hc + 1024) = pend[1]; *(u32x4*)(hc + 2048) = pend[2]; *(u32x4*)(hc + 3072) = pend[3]; }
#undef ML_STAGE
#undef ML_GATES
#undef ML_VEC
#undef ML_TB
    __syncthreads();
}
}

constexpr int NWAVES = 8;
constexpr int RING_BYTES = 131072;
constexpr int LDS_BYTES = 163840;
constexpr int XCH_OFF = RING_BYTES, ROPE_LDS_OFF = XCH_OFF + 8192, QKG_LDS_OFF = ROPE_LDS_OFF + 16384, SCL_LDS_OFF = QKG_LDS_OFF + 1024;
static_assert(SCL_LDS_OFF + 4096 <= LDS_BYTES - 16, "in-projection LDS map");
static_assert(ml::LDS_END <= LDS_BYTES, "mLSTM LDS map");
#define LAS __attribute__((address_space(3)))
#define GAS __attribute__((address_space(1)))
typedef unsigned v4u __attribute__((ext_vector_type(4)));
typedef unsigned v2u __attribute__((ext_vector_type(2)));
typedef float f32x4 __attribute__((ext_vector_type(4)));
#define LDS_WAIT() asm volatile("s_waitcnt lgkmcnt(0)" ::: "memory")

struct Args { const float* in[9]; float* out; unsigned char* ws; int ph_lo, ph_hi; };

__device__ __forceinline__ float wave_sum(float v) {
#pragma unroll
    for (int o = 1; o < 64; o <<= 1) v += __shfl_xor(v, o);
    return v;
}

#define XB_TMO      128
#define XB_XCNT(j)  (256  + 64 * (j))
#define XB_XSUB(j)  (1280 + 64 * (j))
#define XB_XGEN(j)  (2304 + 64 * (j))
#define XB_TOP      3328
#define XB_TOPGEN   3392
#define XCD_BAR_WORDS 3456
#define XB_SPIN_CAP (1u << 18)

__device__ __forceinline__ unsigned xb_ld(unsigned* p)              { return __hip_atomic_load(p, __ATOMIC_RELAXED, __HIP_MEMORY_SCOPE_AGENT); }
__device__ __forceinline__ unsigned xb_add(unsigned* p, unsigned v) { return __hip_atomic_fetch_add(p, v, __ATOMIC_RELAXED, __HIP_MEMORY_SCOPE_AGENT); }
__device__ __forceinline__ unsigned xb_xcc_id() { return (unsigned)__builtin_amdgcn_s_getreg((3 << 11) | 20) & 0xFu; }
#define XB_SPIN(cond, bar) do { unsigned _sp = 0; while (cond) { __builtin_amdgcn_s_sleep(1); \
    if ((++_sp & 255u) == 0u) { if (xb_ld(&(bar)[XB_TMO])) break; if (_sp > XB_SPIN_CAP) { atomicAdd(&(bar)[XB_TMO], 1u); break; } } } } while (0)

struct XcdBarrier {
    unsigned* bar; unsigned x;
    volatile LAS unsigned* st;
};

__device__ __forceinline__ XcdBarrier xcd_barrier_post(unsigned* bar, volatile LAS unsigned* st) {
    XcdBarrier b; b.bar = bar; b.x = xb_xcc_id(); b.st = st;
    if (threadIdx.x == 0) (void)xb_add(&bar[XB_XCNT(b.x)], 1u);
    return b;
}
__device__ __forceinline__ void xcd_barrier_complete(unsigned* bar, unsigned x, unsigned& nloc, unsigned& nx) {
    const unsigned G = gridDim.x * gridDim.y * gridDim.z;
    unsigned sum, cnt, mine, sp = 0u;
    for (;;) {
        sum = 0u; cnt = 0u; mine = 0u;
#pragma unroll
        for (unsigned j = 0; j < 16; ++j) { const unsigned c = xb_ld(&bar[XB_XCNT(j)]); sum += c; cnt += (c > 0u) ? 1u : 0u; mine = (j == x) ? c : mine; }
        if (sum == G) break;
        __builtin_amdgcn_s_sleep(1);
        if ((++sp & 255u) == 0u) { if (xb_ld(&bar[XB_TMO])) break; if (sp > XB_SPIN_CAP) { atomicAdd(&bar[XB_TMO], 1u); break; } }
    }
    nloc = mine > 0u ? mine : 1u; nx = cnt > 0u ? cnt : 1u;
}

__device__ __forceinline__ void xcd_barrier(const XcdBarrier& b) {
    asm volatile("s_waitcnt vmcnt(0)" ::: "memory");
    __syncthreads();
    if (threadIdx.x == 0) {
        unsigned* bar = b.bar;
        __builtin_amdgcn_s_waitcnt(0);
        unsigned nloc = b.st[0], nx = b.st[1];
        if (nloc == 0u) { xcd_barrier_complete(bar, b.x, nloc, nx); b.st[0] = nloc; b.st[1] = nx; }
        const unsigned old = xb_add(&bar[XB_XSUB(b.x)], 1u);
        const unsigned gen = old / nloc;
        if (old + 1u == (gen + 1u) * nloc) {
            __builtin_amdgcn_fence(__ATOMIC_RELEASE, "agent");
            asm volatile("s_waitcnt vmcnt(0)" ::: "memory");
            const unsigned og = xb_add(&bar[XB_TOP], 1u);
            const unsigned tg = og / nx;
            if (og + 1u == (tg + 1u) * nx) xb_add(&bar[XB_TOPGEN], 1u);
            else XB_SPIN(xb_ld(&bar[XB_TOPGEN]) == tg, bar);
            __builtin_amdgcn_fence(__ATOMIC_ACQUIRE, "agent");
            xb_add(&bar[XB_XGEN(b.x)], 1u);
            asm volatile("s_waitcnt vmcnt(0)" ::: "memory");
        } else {
            XB_SPIN(xb_ld(&bar[XB_XGEN(b.x)]) == gen, bar);
            __builtin_amdgcn_fence(__ATOMIC_ACQUIRE, "agent");
            asm volatile("s_waitcnt vmcnt(0)" ::: "memory");
        }
    }
    __syncthreads();
}

__device__ __forceinline__ int w1_dest_row(int n) {
    if (!HY_SEPARATE_ROPE && n < 1280) { const int s = n & 255; return (n & ~255) | (s & 0xC3) | ((s & 0x10) << 1) | ((s & 0x0C) << 1) | ((s & 0x20) >> 3); }
    if (n >= 2560 && n < 3072) return (n & ~12) | ((n & 4) << 1) | ((n & 8) >> 1);
    return n;
}
__device__ __forceinline__ int q8_dest_row(int n) { return n < NQA ? w1_dest_row(n) : n - (NB1 - NB0); }
__device__ __forceinline__ unsigned pk4i8(float a, float b, float c, float d) {
    int ia = (int)__builtin_rintf(a), ib = (int)__builtin_rintf(b), ic = (int)__builtin_rintf(c), id = (int)__builtin_rintf(d);
    ia = ia < -127 ? -127 : (ia > 127 ? 127 : ia); ib = ib < -127 ? -127 : (ib > 127 ? 127 : ib); ic = ic < -127 ? -127 : (ic > 127 ? 127 : ic); id = id < -127 ? -127 : (id > 127 ? 127 : id);
    return ((unsigned)ia & 0xffu) | (((unsigned)ib & 0xffu) << 8) | (((unsigned)ic & 0xffu) << 16) | ((unsigned)id << 24); }
template <int MODE>
__device__ __forceinline__ void p0_transpose_item(const float* W, int K, int ldw, int kb, int n0, void* WT, LAS float* scr, int lane, const LAS float* cinv) {
    const int k0 = 64 * kb;
#pragma unroll 8
    for (int i = 0; i < 32; ++i) { const int kk = 2 * i + (lane >> 5); scr[kk * 33 + (lane & 31)] = W[(size_t)(k0 + kk) * ldw + n0 + (lane & 31)]; }
    LDS_WAIT(); asm volatile("" ::: "memory");
    const int c = lane & 7;
#pragma unroll
    for (int j = 0; j < 4; ++j) { const int n = (lane >> 3) + 8 * j; const LAS float* s = scr + (8 * c) * 33 + n;
        if constexpr (MODE == 2) { const float ci = cinv[n];
            v2u o8; o8.x = pk4i8(s[0 * 33] * ci, s[1 * 33] * ci, s[2 * 33] * ci, s[3 * 33] * ci); o8.y = pk4i8(s[4 * 33] * ci, s[5 * 33] * ci, s[6 * 33] * ci, s[7 * 33] * ci);
            *(v2u*)((unsigned char*)WT + (size_t)q8_dest_row(n0 + n) * K + k0 + 8 * c) = o8; }
        else if constexpr (MODE == 3) { unsigned char* rowp = (unsigned char*)WT + (size_t)(n0 + n) * 4096;
            if (kb < 16) { v2u o8; o8.x = pk4f8(s[0 * 33] * W8_SCALE, s[1 * 33] * W8_SCALE, s[2 * 33] * W8_SCALE, s[3 * 33] * W8_SCALE); o8.y = pk4f8(s[4 * 33] * W8_SCALE, s[5 * 33] * W8_SCALE, s[6 * 33] * W8_SCALE, s[7 * 33] * W8_SCALE);
                *(v2u*)(rowp + k0 + 8 * c) = o8; }
            else { v4u o; o.x = pk2(s[0 * 33], s[1 * 33]); o.y = pk2(s[2 * 33], s[3 * 33]); o.z = pk2(s[4 * 33], s[5 * 33]); o.w = pk2(s[6 * 33], s[7 * 33]);
                *(v4u*)(rowp + 1024 + (size_t)(k0 - 1024 + 8 * c) * 2) = o; } }
        else { const float ws_ = (MODE == 1 && n0 + n < 3072) ? 0.08838834764831845f : 1.f;
            v4u o; o.x = pk2(s[0 * 33] * ws_, s[1 * 33] * ws_); o.y = pk2(s[2 * 33] * ws_, s[3 * 33] * ws_); o.z = pk2(s[4 * 33] * ws_, s[5 * 33] * ws_); o.w = pk2(s[6 * 33] * ws_, s[7 * 33] * ws_);
            const int nr = (MODE == 1) ? w1_dest_row(n0 + n) - NB0 : n0 + n;
            *(v4u*)((bf16*)WT + (size_t)nr * K + k0 + 8 * c) = o; } }
    LDS_WAIT(); asm volatile("" ::: "memory");
}
__device__ __forceinline__ void p0_q8_colblock(const float* w_in, unsigned char* ws, LAS unsigned char* lds, int cb, int tid, int wave, int lane) {
    const int n0 = cb < NQA / 32 ? 32 * cb : NB1 + 32 * (cb - NQA / 32);
    LAS float* red = (LAS float*)(lds + 8 * 16384);
    const int c4 = (lane & 7) * 4, kr = lane >> 3;
    const float* src = w_in + (size_t)(256 * wave + kr) * NPROJ + n0 + c4;
    f32x4 mx = {0.f, 0.f, 0.f, 0.f};
#pragma unroll 8
    for (int i = 0; i < 32; ++i) { const f32x4 v = *(const f32x4*)(src + (size_t)(8 * i) * NPROJ);
        mx.x = fmaxf(mx.x, fabsf(v.x)); mx.y = fmaxf(mx.y, fabsf(v.y)); mx.z = fmaxf(mx.z, fabsf(v.z)); mx.w = fmaxf(mx.w, fabsf(v.w)); }
#pragma unroll
    for (int o = 8; o < 64; o <<= 1) { mx.x = fmaxf(mx.x, __shfl_xor(mx.x, o)); mx.y = fmaxf(mx.y, __shfl_xor(mx.y, o)); mx.z = fmaxf(mx.z, __shfl_xor(mx.z, o)); mx.w = fmaxf(mx.w, __shfl_xor(mx.w, o)); }
    if (lane < 8) *(LAS f32x4*)(red + wave * 32 + c4) = mx;
    __syncthreads();
    if (tid < 32) { float m = red[tid];
#pragma unroll
        for (int w = 1; w < 8; ++w) m = fmaxf(m, red[w * 32 + tid]);
        m = fmaxf(m, 1e-30f); red[256 + tid] = 127.f / m; ((float*)(ws + WS_SW))[q8_dest_row(n0 + tid)] = m * (1.f / 127.f); }
    __syncthreads();
    LAS float* scr = (LAS float*)(lds + wave * 16384);
    for (int i = 0; i < 4; ++i) p0_transpose_item<2>(w_in, DM, NPROJ, 4 * wave + i, n0, ws + WS_W8T, scr, lane, red + 256);
    __syncthreads();
}
__device__ __forceinline__ float wave_max(float v) {
#pragma unroll
    for (int o = 1; o < 64; o <<= 1) v = fmaxf(v, __shfl_xor(v, o));
    return v;
}
__device__ __forceinline__ void rms_rows2_to_bf16(const float* xrow0, const float* xrow1, const float* g, bf16* orow0, bf16* orow1, unsigned char* frow0, unsigned char* frow1, float* sa0, float* sa1, int lane) {
    const f32x4* xa = (const f32x4*)xrow0 + lane; const f32x4* xb = (const f32x4*)xrow1 + lane; const f32x4* gr = (const f32x4*)g + lane;
    f32x4 v[8], w[8]; float s = 0.f, t = 0.f;
#pragma unroll
    for (int j = 0; j < 8; ++j) { v[j] = __builtin_nontemporal_load(xa + 64 * j); w[j] = __builtin_nontemporal_load(xb + 64 * j); }
#pragma unroll
    for (int j = 0; j < 8; ++j) { s += (v[j].x * v[j].x + v[j].y * v[j].y) + (v[j].z * v[j].z + v[j].w * v[j].w); t += (w[j].x * w[j].x + w[j].y * w[j].y) + (w[j].z * w[j].z + w[j].w * w[j].w); }
    const float r0 = 1.f / sqrtf(wave_sum(s) * (1.f / DM) + EPS), r1 = 1.f / sqrtf(wave_sum(t) * (1.f / DM) + EPS);
    float m0 = 0.f, m1 = 0.f;
#pragma unroll
    for (int j = 0; j < 8; ++j) { const f32x4 gg = gr[64 * j]; v[j] = v[j] * r0 * gg; w[j] = w[j] * r1 * gg;
        m0 = fmaxf(fmaxf(m0, fmaxf(fabsf(v[j].x), fabsf(v[j].y))), fmaxf(fabsf(v[j].z), fabsf(v[j].w))); m1 = fmaxf(fmaxf(m1, fmaxf(fabsf(w[j].x), fabsf(w[j].y))), fmaxf(fabsf(w[j].z), fabsf(w[j].w))); }
    m0 = fmaxf(wave_max(m0), 1e-30f); m1 = fmaxf(wave_max(m1), 1e-30f);
    const float i0 = 127.f / m0, i1 = 127.f / m1;
    if (lane == 0) { *sa0 = m0 * (1.f / 127.f); *sa1 = m1 * (1.f / 127.f); }
    v2u* o0 = (v2u*)orow0 + lane; v2u* o1 = (v2u*)orow1 + lane; unsigned* f0 = (unsigned*)frow0 + lane; unsigned* f1 = (unsigned*)frow1 + lane;
#pragma unroll
    for (int j = 0; j < 8; ++j) { v2u a, b;
        a.x = pk2(v[j].x, v[j].y); a.y = pk2(v[j].z, v[j].w); o0[64 * j] = a; f0[64 * j] = pk4i8(v[j].x * i0, v[j].y * i0, v[j].z * i0, v[j].w * i0);
        b.x = pk2(w[j].x, w[j].y); b.y = pk2(w[j].z, w[j].w); o1[64 * j] = b; f1[64 * j] = pk4i8(w[j].x * i1, w[j].y * i1, w[j].z * i1, w[j].w * i1); }
}
__device__ __forceinline__ void p0_prologue(const Args& a, LAS unsigned char* lds, int vcu, int G, int tid, int wave, int lane) {
    unsigned char* ws = a.ws;
    const float* w_in = a.in[3]; const float* w_out = a.in[8]; const float* norm_g = a.in[2];
    bf16* W2t = (bf16*)(ws + WS_W2T);
    const int gw = vcu * NWAVES + wave, NGW = G * NWAVES; const int gt = vcu * (NWAVES * 64) + tid, NGT = G * NWAVES * 64;
    for (int e = gt; e < 64 * 32; e += NGT) { const int pos = e >> 5, j = e & 31; const float inv = 1.0f / powf(10000.0f, (float)j * (1.0f / 32.0f)); const float ang = (float)pos * inv;
        float* R = (float*)(ws + WS_ROPE); R[2 * e] = cosf(ang); R[2 * e + 1] = sinf(ang); }
    for (int e = gt; e < 16 * DM; e += NGT) { const int g = e >> 11, k = e & (DM - 1); ((bf16*)(ws + WS_WGT))[(size_t)g * DM + k] = (bf16)f2bf(w_in[(size_t)k * NPROJ + NP256 + g]); }
    for (int cb = vcu; cb < NQ8 / 32; cb += G) p0_q8_colblock(w_in, ws, lds, cb, tid, wave, lane);
    LAS float* scr = (LAS float*)(lds + wave * 16384);
    constexpr int I_1 = (DM / 64) * ((NB1 - NB0) / 32), I_2 = (DM / 64) * (DM / 32);
    for (int it = gw; it < I_1 + I_2; it += NGW) {
        if (it < I_1) p0_transpose_item<1>(w_in, DM, NPROJ, it / ((NB1 - NB0) / 32), NB0 + 32 * (it % ((NB1 - NB0) / 32)), ws + WS_W1B, scr, lane, nullptr);
        else p0_transpose_item<3>(w_out, DM, DM, (it - I_1) / (DM / 32), 32 * ((it - I_1) % (DM / 32)), W2t, scr, lane, nullptr);
    }
    bf16* H = (bf16*)(ws + WS_H); unsigned char* H8 = (unsigned char*)a.out; float* SA = (float*)(ws + WS_SA);
    for (int m = gw; m < NTOK; m += 2 * NGW) { const int m1 = (m + NGW < NTOK) ? m + NGW : m;
        const float* xr0 = (m < TOK_PROMPT) ? a.in[0] + (size_t)m * DM : a.in[1] + (size_t)(m - TOK_PROMPT) * DM; const float* xr1 = (m1 < TOK_PROMPT) ? a.in[0] + (size_t)m1 * DM : a.in[1] + (size_t)(m1 - TOK_PROMPT) * DM;
        rms_rows2_to_bf16(xr0, xr1, norm_g, H + (size_t)m * DM, H + (size_t)m1 * DM, H8 + (size_t)m * DM, H8 + (size_t)m1 * DM, SA + m, SA + m1, lane); }
}

__device__ __forceinline__ void p2_qknorm_rope(const Args& a, int vcu, int G, int wave, int lane) {
    unsigned char* ws = a.ws; const float* R = (const float*)(ws + WS_ROPE);
    const int gw = vcu * NWAVES + wave, NGW = G * NWAVES;
    const int fj = lane & 31, c0 = (lane < 32) ? lane : 64 + (lane - 32), c1 = c0 + 32;
    const float gq0 = a.in[5][c0], gq1 = a.in[5][c1], gk0 = a.in[6][c0], gk1 = a.in[6][c1];
    for (int it = gw; it < NTOK * 10; it += NGW) {
        const int t = it / 10, slot = it - t * 10; const int tl = t & (SEQ - 1); const int pos = (lane < 32) ? (tl >> 6) : (tl & 63);
        bf16* p = (slot < 8) ? (bf16*)((unsigned char*)a.out + DO_Q) + (size_t)t * 1024 + slot * 128 : (bf16*)(ws + WS_AK) + (size_t)t * 256 + (slot - 8) * 128;
        const float x0 = bf2f(p[c0]), x1 = bf2f(p[c1]);
        const float r = 1.f / sqrtf(wave_sum(x0 * x0 + x1 * x1) * (1.f / 128.f) + EPS);
        const float y0 = x0 * r * ((slot < 8) ? gq0 : gk0), y1 = x1 * r * ((slot < 8) ? gq1 : gk1);
        const float cs = R[2 * (pos * 32 + fj)], sn = R[2 * (pos * 32 + fj) + 1];
        p[c0] = (bf16)f2bf(y0 * cs - y1 * sn); p[c1] = (bf16)f2bf(y1 * cs + y0 * sn);
    }
}

__device__ __forceinline__ void p4_mlstm_recurrent(const Args& a, LAS unsigned char* lds, int vcu, int G, int tid) {
    unsigned char* ws = a.ws;
    const bf16* MQ = (const bf16*)(ws + WS_MQ); const bf16* MK = (const bf16*)(ws + WS_MK); const bf16* MV = (const bf16*)(ws + WS_MV); const float* GT = (const float*)(ws + WS_GATES);
    LAS float* qs = (LAS float*)lds;
    LAS float* ks = qs + 32 * 128;
    LAS float* vs = ks + 32 * 128;
    LAS float* gi = vs + 32 * 256;
    LAS float* gf = gi + 32;
    const int dv = tid >> 1, half = tid & 1;
    for (int item = vcu; item < NSEQ * 8; item += G) {
        const int b = item >> 3, hd = (item >> 1) & 3, dir = item & 1;
        bf16* HO = (bf16*)(ws + (dir ? WS_HB : WS_HF));
        float C[64], nn[64]; float m = 0.f;
#pragma unroll
        for (int j = 0; j < 64; ++j) { C[j] = 0.f; nn[j] = 0.f; }
        for (int p0 = 0; p0 < SEQ; p0 += 32) {
            __syncthreads();
            { const int rr = tid >> 4, c8 = (tid & 15) * 8; const int tok = dir ? (SEQ - 1 - (p0 + rr)) : (p0 + rr); const size_t row = (size_t)b * SEQ + tok;
              const v4u q4 = *(const v4u*)(MQ + row * 512 + hd * 128 + c8), k4 = *(const v4u*)(MK + row * 512 + hd * 128 + c8);
              LAS float* kd = ks + rr * 128 + c8;
              { LAS float* qa = qs + rr * 128 + (c8 & ~8) + ((c8 & 8) >> 1);   qa[0] = bflo(q4.x); qa[1] = bfhi(q4.x); qa[2] = bflo(q4.y); qa[3] = bfhi(q4.y); qa[8] = bflo(q4.z); qa[9] = bfhi(q4.z); qa[10] = bflo(q4.w); qa[11] = bfhi(q4.w); }
              kd[0] = bflo(k4.x); kd[1] = bfhi(k4.x); kd[2] = bflo(k4.y); kd[3] = bfhi(k4.y); kd[4] = bflo(k4.z); kd[5] = bfhi(k4.z); kd[6] = bflo(k4.w); kd[7] = bfhi(k4.w);
              const int c16 = (tid & 15) * 16; LAS float* vd = vs + rr * 256 + c16;
#pragma unroll
              for (int h2 = 0; h2 < 2; ++h2) { const v4u v4 = *(const v4u*)(MV + row * 1024 + hd * 256 + c16 + 8 * h2);
                  vd[8 * h2 + 0] = bflo(v4.x); vd[8 * h2 + 1] = bfhi(v4.x); vd[8 * h2 + 2] = bflo(v4.y); vd[8 * h2 + 3] = bfhi(v4.y); vd[8 * h2 + 4] = bflo(v4.z); vd[8 * h2 + 5] = bfhi(v4.z); vd[8 * h2 + 6] = bflo(v4.w); vd[8 * h2 + 7] = bfhi(v4.w); }
              if (tid < 32) { const int tk = dir ? (SEQ - 1 - (p0 + tid)) : (p0 + tid); const size_t rw = (size_t)b * SEQ + tk; gi[tid] = GT[rw * 16 + dir * 8 + hd]; gf[tid] = GT[rw * 16 + dir * 8 + 4 + hd]; }
            }
            __syncthreads();
            for (int pp = 0; pp < 32; ++pp) {
                const float lf = gf[pp], ii = gi[pp];
                const float mn = fmaxf(lf + m, ii);
                const float ca = expf(lf + m - mn), cb = expf(ii - mn);
                const float bv = cb * vs[pp * 256 + dv];
                float hp = 0.f, qn = 0.f;
                const LAS float* kr = ks + pp * 128 + 64 * half; const LAS float* qr = qs + pp * 128 + 64 * half;
#pragma unroll
                for (int j = 0; j < 64; ++j) { const float kk = kr[j], qq = qr[j];
                    C[j] = fmaf(ca, C[j], kk * bv); nn[j] = fmaf(ca, nn[j], cb * kk); hp = fmaf(qq, C[j], hp); qn = fmaf(qq, nn[j], qn); }
                hp += __shfl_xor(hp, 1); qn += __shfl_xor(qn, 1);
                const float den = fmaxf(fabsf(qn), expf(-mn));
                if (half == 0) { const int pos = p0 + pp, cch = pos >> 6, o = pos & 63, tt = o >> 5, rho = o & 31, q = rho >> 3, hh = (rho >> 2) & 1, e = rho & 3;
                    HO[(((size_t)((b * 4 + hd) * 32 + cch) * 32768) + (dv >> 5) * 4096 + tt * 2048 + (q >> 1) * 1024 + (32 * hh + (dv & 31)) * 16) / 2 + 4 * (q & 1) + e] = (bf16)f2bf(hp / den); }
                m = mn;
            }
        }
    }
}

__device__ __forceinline__ void p5_mlstm_finalize(const Args& a, LAS unsigned char* lds, int vcu, int G, int tid, int wave, int lane) {
    unsigned char* ws = a.ws; const float* mg = a.in[7];
    const bf16* MO = (const bf16*)(ws + WS_MO); const bf16* MZ = (const bf16*)(ws + WS_MZ); bf16* MIX = (bf16*)(ws + WS_MIX);
    LAS float* XS = (LAS float*)lds;
    const int r31 = lane & 31, h5 = lane >> 5, dv0 = 8 * r31;
    constexpr int NIT = NSEQ * 4 * 32;
    v4u f[2][2], bb[2][2];
#define P5_LOAD_H(item_) do { const int bh_ = (item_) >> 5, ck_ = (item_) & 31; \
        const unsigned char* hf_ = ws + WS_HF + ((size_t)bh_ * 32 + ck_) * 32768 + wave * 4096 + lane * 16; const unsigned char* hb_ = ws + WS_HB + ((size_t)bh_ * 32 + (31 - ck_)) * 32768 + wave * 4096 + (lane ^ 32) * 16; \
        _Pragma("unroll") for (int tt = 0; tt < 2; ++tt) _Pragma("unroll") for (int qp = 0; qp < 2; ++qp) { f[tt][qp] = *(const v4u*)(hf_ + tt * 2048 + qp * 1024); bb[tt][qp] = *(const v4u*)(hb_ + (1 - tt) * 2048 + (1 - qp) * 1024); } } while (0)
    if (vcu < NIT) P5_LOAD_H(vcu);
    for (int item = vcu; item < NIT; item += G) {
        const int bh = item >> 5, ck = item & 31, b = bh >> 2, hd = bh & 3;
        v4u mo[4], mz[4];
#pragma unroll
        for (int it = 0; it < 4; ++it) { const int o = it * 16 + wave * 2 + h5; const size_t row = (size_t)b * SEQ + ck * 64 + o;
            mo[it] = *(const v4u*)(MO + row * 1024 + hd * 256 + dv0); mz[it] = *(const v4u*)(MZ + row * 1024 + hd * 256 + dv0); }
        __syncthreads();
#pragma unroll
        for (int tt = 0; tt < 2; ++tt)
#pragma unroll
            for (int qp = 0; qp < 2; ++qp) { const v4u fv = f[tt][qp], bv = bb[tt][qp];
                float fs[8] = {bflo(fv.x), bfhi(fv.x), bflo(fv.y), bfhi(fv.y), bflo(fv.z), bfhi(fv.z), bflo(fv.w), bfhi(fv.w)};
                float bs[8] = {bflo(bv.x), bfhi(bv.x), bflo(bv.y), bfhi(bv.y), bflo(bv.z), bfhi(bv.z), bflo(bv.w), bfhi(bv.w)};
#pragma unroll
                for (int j = 0; j < 8; ++j) { const int o = 32 * tt + 8 * (2 * qp + (j >> 2)) + 4 * h5 + (j & 3); XS[o * 256 + 32 * wave + r31] = fs[j] + bs[7 - j]; } }
        __syncthreads();
        if (item + G < NIT) P5_LOAD_H(item + G);
        const f32x4 g0 = *(const f32x4*)(mg + hd * 256 + dv0), g1 = *(const f32x4*)(mg + hd * 256 + dv0 + 4);
        const float gg[8] = {g0[0], g0[1], g0[2], g0[3], g1[0], g1[1], g1[2], g1[3]};
#pragma unroll
        for (int it = 0; it < 4; ++it) { const int o = it * 16 + wave * 2 + h5; const size_t row = (size_t)b * SEQ + ck * 64 + o;
            const f32x4 x0 = *(const LAS f32x4*)(XS + o * 256 + dv0), x1 = *(const LAS f32x4*)(XS + o * 256 + dv0 + 4);
            float hm[8] = {x0[0], x0[1], x0[2], x0[3], x1[0], x1[1], x1[2], x1[3]};
            const float mo8[8] = {bflo(mo[it].x), bfhi(mo[it].x), bflo(mo[it].y), bfhi(mo[it].y), bflo(mo[it].z), bfhi(mo[it].z), bflo(mo[it].w), bfhi(mo[it].w)};
            const float mz8[8] = {bflo(mz[it].x), bfhi(mz[it].x), bflo(mz[it].y), bfhi(mz[it].y), bflo(mz[it].z), bfhi(mz[it].z), bflo(mz[it].w), bfhi(mz[it].w)};
            float ss = 0.f;
#pragma unroll
            for (int j = 0; j < 8; ++j) { hm[j] = hm[j] * __builtin_amdgcn_rcpf(1.f + __expf(-mo8[j])); ss += hm[j] * hm[j]; }
#pragma unroll
            for (int s = 1; s < 32; s <<= 1) ss += __shfl_xor(ss, s);
            const float r = __builtin_amdgcn_rsqf(ss * (1.f / 256.f) + EPS);
            float ov[8];
#pragma unroll
            for (int j = 0; j < 8; ++j) ov[j] = hm[j] * r * gg[j] * (mz8[j] * __builtin_amdgcn_rcpf(1.f + __expf(-mz8[j])));
            v4u w; w.x = pk2(ov[0], ov[1]); w.y = pk2(ov[2], ov[3]); w.z = pk2(ov[4], ov[5]); w.w = pk2(ov[6], ov[7]);
            *(v4u*)(MIX + row * 2048 + 512 + hd * 256 + dv0) = w; }
    }
#undef P5_LOAD_H
    __syncthreads();
}

__device__ __forceinline__ void p5_item(const Args& a, LAS unsigned char* lds, int item) {
    int tid_ = threadIdx.x; asm volatile("" : "+v"(tid_));
    const int lane = tid_ & 63, wave = __builtin_amdgcn_readfirstlane(tid_ >> 6);
    unsigned char* ws = a.ws; const float* mg = a.in[7];
    const bf16* MO = (const bf16*)(ws + WS_MO); const bf16* MZ = (const bf16*)(ws + WS_MZ); bf16* MIX = (bf16*)(ws + WS_MIX);
    LAS float* XS = (LAS float*)lds; const int r31 = lane & 31, h5 = lane >> 5, dv0 = 8 * r31;
    const int bh = item >> 5, ck = item & 31, b = bh >> 2, hd = bh & 3;
    const unsigned char* hf_ = ws + WS_HF + ((size_t)bh * 32 + ck) * 32768 + wave * 4096 + lane * 16; const unsigned char* hb_ = ws + WS_HB + ((size_t)bh * 32 + (31 - ck)) * 32768 + wave * 4096 + (lane ^ 32) * 16;
    v4u f[2][2], bb[2][2], mo[4], mz[4];
#pragma unroll
    for (int tt = 0; tt < 2; ++tt)
#pragma unroll
        for (int qp = 0; qp < 2; ++qp) { f[tt][qp] = *(const v4u*)(hf_ + tt * 2048 + qp * 1024); bb[tt][qp] = *(const v4u*)(hb_ + (1 - tt) * 2048 + (1 - qp) * 1024); }
#pragma unroll
    for (int it = 0; it < 4; ++it) { const int o = it * 16 + wave * 2 + h5; const size_t row = (size_t)b * SEQ + ck * 64 + o;
        mo[it] = *(const v4u*)(MO + row * 1024 + hd * 256 + dv0); mz[it] = *(const v4u*)(MZ + row * 1024 + hd * 256 + dv0); }
    __syncthreads();
#pragma unroll
    for (int tt = 0; tt < 2; ++tt)
#pragma unroll
        for (int qp = 0; qp < 2; ++qp) { const v4u fv = f[tt][qp], bv = bb[tt][qp];
            float fs[8] = {bflo(fv.x), bfhi(fv.x), bflo(fv.y), bfhi(fv.y), bflo(fv.z), bfhi(fv.z), bflo(fv.w), bfhi(fv.w)};
            float bs[8] = {bflo(bv.x), bfhi(bv.x), bflo(bv.y), bfhi(bv.y), bflo(bv.z), bfhi(bv.z), bflo(bv.w), bfhi(bv.w)};
#pragma unroll
            for (int j = 0; j < 8; ++j) { const int o = 32 * tt + 8 * (2 * qp + (j >> 2)) + 4 * h5 + (j & 3); XS[o * 256 + 32 * wave + r31] = fs[j] + bs[7 - j]; } }
    __syncthreads();
    const f32x4 g0 = *(const f32x4*)(mg + hd * 256 + dv0), g1 = *(const f32x4*)(mg + hd * 256 + dv0 + 4);
    const float gg[8] = {g0[0], g0[1], g0[2], g0[3], g1[0], g1[1], g1[2], g1[3]};
#pragma unroll
    for (int it = 0; it < 4; ++it) { const int o = it * 16 + wave * 2 + h5; const size_t row = (size_t)b * SEQ + ck * 64 + o;
        const f32x4 x0 = *(const LAS f32x4*)(XS + o * 256 + dv0), x1 = *(const LAS f32x4*)(XS + o * 256 + dv0 + 4);
        float hm[8] = {x0[0], x0[1], x0[2], x0[3], x1[0], x1[1], x1[2], x1[3]};
        const float mo8[8] = {bflo(mo[it].x), bfhi(mo[it].x), bflo(mo[it].y), bfhi(mo[it].y), bflo(mo[it].z), bfhi(mo[it].z), bflo(mo[it].w), bfhi(mo[it].w)};
        const float mz8[8] = {bflo(mz[it].x), bfhi(mz[it].x), bflo(mz[it].y), bfhi(mz[it].y), bflo(mz[it].z), bfhi(mz[it].z), bflo(mz[it].w), bfhi(mz[it].w)};
        float ss = 0.f;
#pragma unroll
        for (int j = 0; j < 8; ++j) { hm[j] = hm[j] * __builtin_amdgcn_rcpf(1.f + __expf(-mo8[j])); ss += hm[j] * hm[j]; }
#pragma unroll
        for (int s = 1; s < 32; s <<= 1) ss += __shfl_xor(ss, s);
        const float r = __builtin_amdgcn_rsqf(ss * (1.f / 256.f) + EPS);
        float ov[8];
#pragma unroll
        for (int j = 0; j < 8; ++j) ov[j] = hm[j] * r * gg[j] * (mz8[j] * __builtin_amdgcn_rcpf(1.f + __expf(-mz8[j])));
        v4u w; w.x = pk2(ov[0], ov[1]); w.y = pk2(ov[2], ov[3]); w.z = pk2(ov[4], ov[5]); w.w = pk2(ov[6], ov[7]);
        *(v4u*)(MIX + row * 2048 + 512 + hd * 256 + dv0) = w; }
    __syncthreads();
}

__device__ __forceinline__ void p5_batch(const Args& a, LAS unsigned char* lds, int first, int count) {
    if (count <= 0) return;
    int tid_ = threadIdx.x; asm volatile("" : "+v"(tid_));
    const int lane = tid_ & 63, wave = __builtin_amdgcn_readfirstlane(tid_ >> 6);
    unsigned char* ws = a.ws; const float* mg = a.in[7];
    const bf16* MO = (const bf16*)(ws + WS_MO); const bf16* MZ = (const bf16*)(ws + WS_MZ); bf16* MIX = (bf16*)(ws + WS_MIX);
    LAS float* XS = (LAS float*)lds; const int r31 = lane & 31, h5 = lane >> 5, dv0 = 8 * r31;
    v4u f[2][2], bb[2][2];
#define P5B_LOAD_H(item_) do { const int bh_ = (item_) >> 5, ck_ = (item_) & 31; \
        const unsigned char* hf_ = ws + WS_HF + ((size_t)bh_ * 32 + ck_) * 32768 + wave * 4096 + lane * 16; const unsigned char* hb_ = ws + WS_HB + ((size_t)bh_ * 32 + (31 - ck_)) * 32768 + wave * 4096 + (lane ^ 32) * 16; \
        _Pragma("unroll") for (int tt = 0; tt < 2; ++tt) _Pragma("unroll") for (int qp = 0; qp < 2; ++qp) { f[tt][qp] = *(const v4u*)(hf_ + tt * 2048 + qp * 1024); bb[tt][qp] = *(const v4u*)(hb_ + (1 - tt) * 2048 + (1 - qp) * 1024); } } while (0)
    P5B_LOAD_H(first);
    for (int i = 0; i < count; ++i) {
        const int item = first + i, bh = item >> 5, ck = item & 31, b = bh >> 2, hd = bh & 3;
        v4u mo[4], mz[4];
#pragma unroll
        for (int it = 0; it < 4; ++it) { const int o = it * 16 + wave * 2 + h5; const size_t row = (size_t)b * SEQ + ck * 64 + o;
            mo[it] = *(const v4u*)(MO + row * 1024 + hd * 256 + dv0); mz[it] = *(const v4u*)(MZ + row * 1024 + hd * 256 + dv0); }
        __syncthreads();
#pragma unroll
        for (int tt = 0; tt < 2; ++tt)
#pragma unroll
            for (int qp = 0; qp < 2; ++qp) { const v4u fv = f[tt][qp], bv = bb[tt][qp];
                float fs[8] = {bflo(fv.x), bfhi(fv.x), bflo(fv.y), bfhi(fv.y), bflo(fv.z), bfhi(fv.z), bflo(fv.w), bfhi(fv.w)};
                float bs[8] = {bflo(bv.x), bfhi(bv.x), bflo(bv.y), bfhi(bv.y), bflo(bv.z), bfhi(bv.z), bflo(bv.w), bfhi(bv.w)};
#pragma unroll
                for (int j = 0; j < 8; ++j) { const int o = 32 * tt + 8 * (2 * qp + (j >> 2)) + 4 * h5 + (j & 3); XS[o * 256 + 32 * wave + r31] = fs[j] + bs[7 - j]; } }
        __syncthreads();
        if (i + 1 < count) P5B_LOAD_H(item + 1);
        const f32x4 g0 = *(const f32x4*)(mg + hd * 256 + dv0), g1 = *(const f32x4*)(mg + hd * 256 + dv0 + 4);
        const float gg[8] = {g0[0], g0[1], g0[2], g0[3], g1[0], g1[1], g1[2], g1[3]};
#pragma unroll
        for (int it = 0; it < 4; ++it) { const int o = it * 16 + wave * 2 + h5; const size_t row = (size_t)b * SEQ + ck * 64 + o;
            const f32x4 x0 = *(const LAS f32x4*)(XS + o * 256 + dv0), x1 = *(const LAS f32x4*)(XS + o * 256 + dv0 + 4);
            float hm[8] = {x0[0], x0[1], x0[2], x0[3], x1[0], x1[1], x1[2], x1[3]};
            const float mo8[8] = {bflo(mo[it].x), bfhi(mo[it].x), bflo(mo[it].y), bfhi(mo[it].y), bflo(mo[it].z), bfhi(mo[it].z), bflo(mo[it].w), bfhi(mo[it].w)};
            const float mz8[8] = {bflo(mz[it].x), bfhi(mz[it].x), bflo(mz[it].y), bfhi(mz[it].y), bflo(mz[it].z), bfhi(mz[it].z), bflo(mz[it].w), bfhi(mz[it].w)};
            float ss = 0.f;
#pragma unroll
            for (int j = 0; j < 8; ++j) { hm[j] = hm[j] * __builtin_amdgcn_rcpf(1.f + __expf(-mo8[j])); ss += hm[j] * hm[j]; }
#pragma unroll
            for (int s = 1; s < 32; s <<= 1) ss += __shfl_xor(ss, s);
            const float r = __builtin_amdgcn_rsqf(ss * (1.f / 256.f) + EPS);
            float ov[8];
#pragma unroll
            for (int j = 0; j < 8; ++j) ov[j] = hm[j] * r * gg[j] * (mz8[j] * __builtin_amdgcn_rcpf(1.f + __expf(-mz8[j])));
            v4u w; w.x = pk2(ov[0], ov[1]); w.y = pk2(ov[2], ov[3]); w.z = pk2(ov[4], ov[5]); w.w = pk2(ov[6], ov[7]);
            *(v4u*)(MIX + row * 2048 + 512 + hd * 256 + dv0) = w; }
    }
#undef P5B_LOAD_H
    __syncthreads();
}

__device__ __forceinline__ void gate_rows48(unsigned char* ws, const float* b_gates, int row0, int lane) {
    typedef short bf16x8 __attribute__((ext_vector_type(8)));
    const int r15 = lane & 15, kg = lane >> 4;
    const bf16* a0p = (const bf16*)(ws + WS_H) + (size_t)(row0 + r15) * DM + 8 * kg; const bf16* a1p = a0p + 16 * DM; const bf16* a2p = a0p + 32 * DM;
    const bf16* bp = (const bf16*)(ws + WS_WGT) + (size_t)r15 * DM + 8 * kg;
    f32x4 acc0 = {0.f, 0.f, 0.f, 0.f}, acc1 = {0.f, 0.f, 0.f, 0.f}, acc2 = {0.f, 0.f, 0.f, 0.f};
#pragma unroll 8
    for (int ks = 0; ks < DM / 32; ++ks) { const bf16x8 a0 = *(const bf16x8*)(a0p + 32 * ks), a1 = *(const bf16x8*)(a1p + 32 * ks), a2 = *(const bf16x8*)(a2p + 32 * ks), b = *(const bf16x8*)(bp + 32 * ks);
        acc0 = __builtin_amdgcn_mfma_f32_16x16x32_bf16(a0, b, acc0, 0, 0, 0); acc1 = __builtin_amdgcn_mfma_f32_16x16x32_bf16(a1, b, acc1, 0, 0, 0); acc2 = __builtin_amdgcn_mfma_f32_16x16x32_bf16(a2, b, acc2, 0, 0, 0); }
    const float bias = b_gates[r15]; const bool isf = (r15 >> 2) & 1; float* G = (float*)(ws + WS_GATES) + (size_t)(row0 + 4 * kg) * 16 + r15;
#pragma unroll
    for (int r = 0; r < 4; ++r) { float v0 = acc0[r] + bias, v1 = acc1[r] + bias, v2 = acc2[r] + bias; if (isf) { v0 = log_sigmoid_f(v0); v1 = log_sigmoid_f(v1); v2 = log_sigmoid_f(v2); }
        G[r * 16] = v0; G[(16 + r) * 16] = v1; G[(32 + r) * 16] = v2; }
}

constexpr int N_PHASES = 7;
__global__ void __launch_bounds__(NWAVES * 64, 2) hy_fwd(Args args) {
    extern __shared__ __attribute__((aligned(16))) unsigned char lds_raw[];
    LAS unsigned char* lds = (LAS unsigned char*)lds_raw;
    const int tid = threadIdx.x, lane = tid & 63, wave = __builtin_amdgcn_readfirstlane(tid >> 6);
    const int G = gridDim.x; const int bx = blockIdx.x; const int vcu = (G % 8 == 0) ? (bx % 8) * (G / 8) + bx / 8 : bx;
    unsigned char* ws = args.ws;
    const int lo = args.ph_lo, hi = args.ph_hi;
    unsigned* ctl = (unsigned*)(ws + WS_CTL);
    volatile LAS unsigned* bst = (volatile LAS unsigned*)(lds + LDS_BYTES - 16);
    if (tid == 0) { bst[0] = 0u; bst[1] = 0u; }
    __syncthreads();
    XcdBarrier xbar; xbar.bar = ctl + CW_BAR; xbar.x = 0; xbar.st = bst; bool xposted = false;
    const bool one_launch = (lo == 0 && hi == N_PHASES);
    if (one_launch) { xbar = xcd_barrier_post(ctl + CW_BAR, bst); xposted = true; }
#ifndef HY_PHASE_MASK
#define HY_PHASE_MASK 0x7f
#endif
#define IN(k) (((HY_PHASE_MASK >> (k)) & 1) && lo <= (k) && (k) < hi)
#define BOTH(k) (IN(k) && IN((k) + 1))
#ifndef HY_DUP_MASK
#define HY_DUP_MASK 0
#endif
#ifndef HY_PROBE_NULL
#define HY_PROBE_NULL 0
#endif
#ifndef HY_ML_PROBE_MODE
#define HY_ML_PROBE_MODE 0
#endif
#define DUP(k) (((HY_DUP_MASK) >> (k)) & 1)
#define GRID_BAR_CG() do { cg::this_grid().sync(); } while (0)
#define GRID_BAR() do { if (!xposted) { xbar = xcd_barrier_post(ctl + CW_BAR, bst); xposted = true; } xcd_barrier(xbar); } while (0)

    if (IN(0) && DUP(0)) { p0_prologue(args, lds, vcu, G, tid, wave, lane); __syncthreads(); }
    if (IN(0)) { p0_prologue(args, lds, vcu, G, tid, wave, lane); if (BOTH(0)) GRID_BAR(); }

    if (IN(1)) {
        { const float* Rg = (const float*)(ws + WS_ROPE); LAS float* Rl = (LAS float*)(lds + ROPE_LDS_OFF); LAS float* Gl = (LAS float*)(lds + QKG_LDS_OFF);
          for (int e = tid; e < 64 * 32 * 2; e += NWAVES * 64) Rl[e] = Rg[e];
          if (tid < 128) { Gl[tid] = args.in[5][tid]; Gl[128 + tid] = args.in[6][tid]; }
          __syncthreads(); }
        { pg8::Gemm g{(const pg8::bf16_t*)((unsigned char*)args.out + DO_H8), (const pg8::bf16_t*)(ws + WS_W8T), NTOK, NQ8, DM / 2, DM / 128}; pg8::StaticOrder S; S.init(NTOK, NQ8, G, bx);
          pg8::EpiProjT<0, 2> E{ws, (PG8_LAS float*)(lds + XCH_OFF), (PG8_LAS float*)(lds + ROPE_LDS_OFF), (PG8_LAS float*)(lds + QKG_LDS_OFF), (unsigned char*)args.out + DO_Q, (PG8_LAS float*)(lds + SCL_LDS_OFF), (const float*)(ws + WS_SA), (const float*)(ws + WS_SW)};
          pg8::gemm_phase<pg8::EpiProjT<0, 2>, pg8::StaticOrder, true, true, 2>(lds, g, S, E); }
        { pg8::Gemm g{(const pg8::bf16_t*)(ws + WS_H), (const pg8::bf16_t*)(ws + WS_W1B), NTOK, NB1 - NB0, DM, DM / 64}; pg8::StaticOrder S; S.init(NTOK, NB1 - NB0, G, bx);
          pg8::EpiProjT<NB0 / 256, 0> E{ws, (PG8_LAS float*)(lds + XCH_OFF), (PG8_LAS float*)(lds + ROPE_LDS_OFF), (PG8_LAS float*)(lds + QKG_LDS_OFF), (unsigned char*)args.out + DO_Q, nullptr, nullptr, nullptr};
          pg8::gemm_phase<pg8::EpiProjT<NB0 / 256, 0>, pg8::StaticOrder, true, true, 0>(lds, g, S, E); }
        { const int nun = (NTOK / 256) * (NQ8 / 256), full = nun / G, rem = nun - full * G, light = G - rem;
          if (bx >= rem) for (int it = (bx - rem) * NWAVES + wave; it < NTOK / 48; it += light * NWAVES) gate_rows48(ws, args.in[4], it * 48, lane); }
        if (BOTH(1)) GRID_BAR();
    }

#if HY_SEPARATE_ROPE
    if (IN(2)) { p2_qknorm_rope(args, vcu, G, wave, lane); if (BOTH(2)) GRID_BAR(); }
#endif

#define ATTN_UNIT(grp_, w_) do { const int b_ = (grp_) >> 1, kvh_ = (grp_) & 1, h_ = kvh_ * 4 + ((w_) >> 3), qb_ = (w_) & 7; const size_t row0_ = (size_t)b_ * SEQ + qb_ * 256; \
        const bf16* Q_ = (const bf16*)((unsigned char*)args.out + DO_Q) + row0_ * 1024 + h_ * 128; unsigned char* O_ = ws + WS_MIX + row0_ * 4096 + h_ * 128; const attn::bf16* K_ = (const attn::bf16*)(ws + WS_AK) + (size_t)b_ * SEQ * 256 + kvh_ * 128; \
        const attn::bf16* V_ = (const attn::bf16*)(ws + WS_AV) + (size_t)b_ * SEQ * 256 + kvh_ * 128; const bf16* Z_ = (const bf16*)(ws + WS_AZ) + row0_ * 1024 + h_ * 128; \
        int seqv_ = SEQ; asm volatile("" : "+s"(seqv_)); attn::attn_dense_body<attn::bf16>((const attn::bf16*)Q_, K_, V_, O_, Z_, seqv_, (char*)lds_raw); __syncthreads(); } while (0)
#if HY_SCHED_J
    const bool schedJ = one_launch && G == 256;
    if (schedJ) {
        const int xl = vcu >> 5, s = vcu & 31;
        if (s < 24) ml::mlstm_item<0>(ws, lds, xl * 24 + s, tid);
        else for (int j = 0; j < 2; ++j) ATTN_UNIT(xl, 2 * (s - 24) + j);
        GRID_BAR();
        const int n_rest = (s < 16) ? 6 : 5, n_p5 = (s < 16) ? 8 : 16, p5_0 = (s < 16) ? 8 * (xl * 16 + s) : 1024 + 16 * (xl * 16 + (s - 16));
        int p5_done = 0;
        for (int jr = 0; jr < n_rest; ++jr) {
            if ((jr & 1) == 0) { const int tgt = (n_p5 * ((jr >> 1) + 1)) / 3;
                p5_batch(args, lds, p5_0 + p5_done, tgt - p5_done); p5_done = tgt; }
            const int li = s + 32 * jr;
            const int grp = (li < 16) ? xl : xl + 8 * (1 + ((li - 16) >> 5)), w = (li < 16) ? 16 + li : (li - 16) & 31;
            ATTN_UNIT(grp, w);
        }
        GRID_BAR();
    }
#else
    const bool schedJ = false;
#endif

    if (!schedJ && IN(3)) {
        for (int u = vcu; u < NSEQ * 2 * 32; u += G) ATTN_UNIT(u >> 5, u & 31);
        if (BOTH(3)) GRID_BAR();
    }

    if (!schedJ && IN(4) && DUP(4)) {
#if HY_MLSTM_REF
        p4_mlstm_recurrent(args, lds, vcu, G, tid);
#else
        for (int item = vcu; item < NSEQ * 8; item += G) ml::mlstm_item<HY_ML_PROBE_MODE>(ws, lds, item, tid);
#endif
        if (BOTH(4)) GRID_BAR(); }

    if (!schedJ && IN(4)) {
#if HY_MLSTM_REF
        p4_mlstm_recurrent(args, lds, vcu, G, tid);
#else
        for (int item = vcu; item < NSEQ * 8; item += G) ml::mlstm_item<0>(ws, lds, item, tid);
#endif
        if (BOTH(4)) GRID_BAR(); }

    if (!schedJ && IN(5) && DUP(5)) { p5_mlstm_finalize(args, lds, vcu, G, tid, wave, lane); }
    if (!schedJ && IN(5)) { p5_mlstm_finalize(args, lds, vcu, G, tid, wave, lane); if (BOTH(5)) GRID_BAR(); }

    if (IN(6)) {
        pg8::Gemm g{(const pg8::bf16_t*)(ws + WS_MIX), (const pg8::bf16_t*)(ws + WS_W2T), NTOK, DM, DM, pg8::F8_TILES + 1024 / 64}; pg8::StaticOrder S; S.init(NTOK, DM, G, bx);
        pg8::EpiOut E{args.in[0], args.in[1], args.out};
        pg8::gemm_phase<pg8::EpiOut, pg8::StaticOrder, true, true, 3>(lds, g, S, E);
    }
    if (one_launch && lo < 0) GRID_BAR_CG();
#undef IN
#undef BOTH
}

extern "C" void kernel_launch(void* const* d_in, const int* in_sizes, int n_in, void* d_out, int out_size, void* d_ws, size_t ws_size, hipStream_t stream) {
    static int grid = 0;
    if (grid == 0) {
        if (n_in != 9 || in_sizes[0] != TOK_PROMPT * DM || in_sizes[1] != (NTOK - TOK_PROMPT) * DM || out_size != NTOK * DM || ws_size < WS_END) {
            fprintf(stderr, "kernel_launch: shape mismatch n_in %d in0 %d in1 %d out %d ws %zu (need %zu)\n", n_in, n_in > 0 ? in_sizes[0] : -1, n_in > 1 ? in_sizes[1] : -1, out_size, ws_size, (size_t)WS_END); grid = -1; return; }
        int dev = 0, cus = 0, per_cu = 0;
        if (hipGetDevice(&dev) != hipSuccess || hipDeviceGetAttribute(&cus, hipDeviceAttributeMultiprocessorCount, dev) != hipSuccess) { fprintf(stderr, "kernel_launch: device query failed\n"); grid = -1; return; }
        if (hipFuncSetAttribute((const void*)hy_fwd, hipFuncAttributeMaxDynamicSharedMemorySize, LDS_BYTES) != hipSuccess) { fprintf(stderr, "kernel_launch: hipFuncSetAttribute failed\n"); grid = -1; return; }
        if (hipOccupancyMaxActiveBlocksPerMultiprocessor(&per_cu, (const void*)hy_fwd, NWAVES * 64, LDS_BYTES) != hipSuccess || per_cu < 1) { fprintf(stderr, "kernel_launch: occupancy query says %d\n", per_cu); per_cu = 1; }
        (void)hipGetLastError();
        grid = cus;
    }
    if (grid < 0) return;
    if (hipMemsetAsync((char*)d_ws + WS_CTL, 0, 65536, stream) != hipSuccess) { fprintf(stderr, "kernel_launch: hipMemsetAsync of the control words failed\n"); return; }
    Args a{};
    for (int i = 0; i < 9; ++i) a.in[i] = (const float*)d_in[i];
    a.out = (float*)d_out; a.ws = (unsigned char*)d_ws;
#if HY_N_LAUNCHES == 1
    a.ph_lo = 0; a.ph_hi = N_PHASES;
    void* kargs[] = {&a};
    hipError_t e = hipLaunchCooperativeKernel((const void*)hy_fwd, dim3(grid), dim3(NWAVES * 64), kargs, LDS_BYTES, stream);
    if (e != hipSuccess) fprintf(stderr, "kernel_launch: cooperative launch failed: %s (grid %d)\n", hipGetErrorString(e), grid);
#else
    for (int p = 0; p < N_PHASES; ++p) {
        a.ph_lo = p; a.ph_hi = p + 1;
        hipLaunchKernelGGL(hy_fwd, dim3(grid), dim3(NWAVES * 64), LDS_BYTES, stream, a);
        const hipError_t le = hipPeekAtLastError();
        if (le != hipSuccess) { fprintf(stderr, "kernel_launch: launch %d failed: %s\n", p, hipGetErrorName(le)); break; }
    }
#endif
}
```

```cpp
#include <hip/hip_runtime.h>
#include <hip/hip_bf16.h>
#include <hip/hip_cooperative_groups.h>
#include <cstdio>
#include <cstdint>
#include <cmath>
namespace cg = cooperative_groups;

#ifndef HY_SEPARATE_ROPE
#define HY_SEPARATE_ROPE 0
#endif
#ifndef HY_SCHED_J
#define HY_SCHED_J 1
#endif
#ifndef HY_MLSTM_REF
#define HY_MLSTM_REF 0
#endif
#ifndef HY_N_LAUNCHES
#define HY_N_LAUNCHES 1
#endif

constexpr int SEQ = 2048, NSEQ = 24, NTOK = NSEQ * SEQ, TOK_PROMPT = 8 * SEQ, DM = 2048;
constexpr int NPROJ = 6672, NP256 = 6656;
constexpr float EPS = 1e-6f;

constexpr size_t MiB = 1u << 20;
constexpr size_t WS_CTL = 0, CTL_ZERO_BYTES = 1 * MiB;
constexpr int CW_BAR = 4096, CW_QUEUE = 8192;
constexpr size_t WS_ROPE = 1 * MiB;
constexpr size_t WS_W8T = 2 * MiB;
constexpr size_t WS_W1B = 14 * MiB;
constexpr size_t WS_WGT = 18 * MiB;
constexpr size_t WS_SW = 19 * MiB;
constexpr size_t WS_SA = 20 * MiB;
constexpr size_t WS_W2T = 30 * MiB;
constexpr size_t WS_GATES = 38 * MiB;
constexpr size_t WS_H = 42 * MiB;
constexpr size_t WS_HF = WS_H, WS_HB = WS_H + 96 * MiB;
constexpr size_t WS_MIX = 234 * MiB;
constexpr size_t DO_H8 = 0, DO_Q = 96 * MiB;
constexpr float A8_SCALE = 256.f, W8_SCALE = 512.f;
constexpr size_t WS_AK = 426 * MiB, WS_AV = 450 * MiB;
constexpr size_t WS_AZ = 474 * MiB;
constexpr size_t WS_MQ = 570 * MiB, WS_MK = 618 * MiB;
constexpr size_t WS_MV = 666 * MiB, WS_MO = 762 * MiB, WS_MZ = 858 * MiB;
constexpr size_t WS_END = 954 * MiB;

typedef unsigned short bf16;
__device__ __forceinline__ unsigned f2bf(float f) { unsigned u = __builtin_bit_cast(unsigned, f); return (u + 0x7fffu + ((u >> 16) & 1u)) >> 16; }
__device__ __forceinline__ unsigned pk2(float lo, float hi) { return f2bf(lo) | (f2bf(hi) << 16); }
__device__ __forceinline__ float bf2f(unsigned short b) { return __builtin_bit_cast(float, (unsigned)b << 16); }
__device__ __forceinline__ float bflo(unsigned w) { return __builtin_bit_cast(float, w << 16); }
__device__ __forceinline__ float bfhi(unsigned w) { return __builtin_bit_cast(float, w & 0xffff0000u); }
constexpr int NQA = 2560, NB0 = 2560, NB1 = 3584, NQ8 = 5632;
__device__ __forceinline__ unsigned pk4f8(float a, float b, float c, float d) {
    a = __builtin_fminf(__builtin_fmaxf(a, -448.f), 448.f); b = __builtin_fminf(__builtin_fmaxf(b, -448.f), 448.f); c = __builtin_fminf(__builtin_fmaxf(c, -448.f), 448.f); d = __builtin_fminf(__builtin_fmaxf(d, -448.f), 448.f);
    int w = 0; w = __builtin_amdgcn_cvt_pk_fp8_f32(a, b, w, false); w = __builtin_amdgcn_cvt_pk_fp8_f32(c, d, w, true); return (unsigned)w; }
__device__ __forceinline__ float log_sigmoid_f(float x) { return x >= 0.f ? -log1pf(expf(-x)) : x - log1pf(expf(x)); }
namespace pg8 {
#define PG8_LAS __attribute__((address_space(3)))
typedef unsigned short bf16_t;
typedef short bf16x8 __attribute__((ext_vector_type(8)));
typedef float f32x4 __attribute__((ext_vector_type(4)));
typedef unsigned u32x4 __attribute__((ext_vector_type(4)));
typedef int i32x4 __attribute__((ext_vector_type(4)));
constexpr int F8_TILES = 8;
constexpr int BM = 256, BK = 64, HALF = 128, HTB = HALF * BK * 2  , STAGE_BYTES = 8 * HTB, NXCD = 8, WGM = 8;

__host__ __device__ __forceinline__ int lds_byte(int r, int c) { const int st = (r >> 4) * 2 + (c >> 5), rr = r & 15, cc = c & 31, ob = rr * 64 + cc * 2; return st * 1024 + (ob ^ (((ob >> 9) & 1) << 5)); }
__host__ __device__ __forceinline__ void stage_rc(int b, int& R, int& C) { const int st = b / 1024, sb = b % 1024, swz = sb ^ (((sb >> 9) & 1) << 5); R = (st >> 1) * 16 + swz / 64; C = (st & 1) * 32 + (swz % 64) / 2; }
__host__ __device__ __forceinline__ int perm32(int rho) { const int n = rho >> 4, i = rho & 15; return 8 * (i >> 2) + 4 * n + (i & 3); }

struct Unit { int pm, pn; };
struct Gemm { const bf16_t* A; const bf16_t* Bt; int M, N, K, kt; };

struct StaticOrder {
    int nM, nN, nwg, G, c;
    __host__ __device__ void init(int M, int N, int G_, int c_) { nM = M / BM; nN = N / BM; nwg = nM * nN; G = G_; c = c_; }
    __host__ __device__ bool next(int i, Unit& u) const {
        const long L = (long)i * G + c; if (L >= nwg) return false;
        int wgid = (int)L; { const int q = nwg / NXCD, r = nwg % NXCD, xcd = wgid % NXCD, off = wgid / NXCD; wgid = (xcd < r ? xcd * (q + 1) : r * (q + 1) + (xcd - r) * q) + off; }
        const int nig = WGM * nN, gid = wgid / nig, fm = gid * WGM, gsz = (nM - fm) < WGM ? (nM - fm) : WGM;
        u.pm = fm + ((wgid % nig) % gsz); u.pn = (wgid % nig) / gsz; return true;
    }
    __device__ __forceinline__ void a_ready(const Unit&) const {}
    __device__ __forceinline__ void done(const Unit&) const {}
};


__device__ __forceinline__ unsigned cvt_pk_bf16(float lo, float hi) { unsigned r; asm volatile("v_cvt_pk_bf16_f32 %0, %1, %2" : "=v"(r) : "v"(lo), "v"(hi)); return r; }

template <int PN0, int MODE>
struct EpiProjT {
    static constexpr bool PERM = true, AFTER_DRAIN = false, PREFETCH = (MODE == 2); static constexpr int NSTORE = 16;
    unsigned char* ws; PG8_LAS float* xch; PG8_LAS float* ropeL; PG8_LAS float* qkgL;
    unsigned char* qb;
    PG8_LAS float* scl; const float* SA; const float* SW;
    __device__ __forceinline__ void prefetch(const Unit& u, int ui, int wid, int lane) const {
        const float* src = (wid < 4) ? SA + (size_t)u.pm * BM + wid * 64 + lane : SW + u.pn * BM + (wid - 4) * 64 + lane;
        __builtin_amdgcn_global_load_lds((const unsigned*)src, (PG8_LAS unsigned*)(scl + (ui & 1) * 512 + wid * 64), 4, 0, 0); }
    __device__ __forceinline__ void operator()(const f32x4 (&acc)[2][2][4][2], const Unit& u, int wr, int wc, int fr, int fq, int par = 0) const {
        const int pn = (MODE == 2) ? (u.pn < 10 ? u.pn : u.pn + 4) : u.pn + PN0; const int row0 = u.pm * BM + wr * 64 + fr;
        constexpr float SC = (MODE == 1) ? (1.f / 4096.f) : 1.f;
        float sa[2][4]; f32x4 sw[2][2];
        if constexpr (MODE == 2) { PG8_LAS float* T = scl + par * 512;
#pragma unroll
            for (int ai = 0; ai < 2; ++ai)
#pragma unroll
                for (int m = 0; m < 4; ++m) sa[ai][m] = T[ai * HALF + wr * 64 + m * 16 + fr];
#pragma unroll
            for (int bj = 0; bj < 2; ++bj)
#pragma unroll
                for (int n = 0; n < 2; ++n) sw[bj][n] = *(const PG8_LAS f32x4*)(T + 256 + bj * HALF + wc * 32 + 8 * fq + 4 * n); }
        auto val = [&](int ai, int bj, int m, int n) -> f32x4 {
            if constexpr (MODE == 2) { const i32x4 iv = __builtin_bit_cast(i32x4, acc[ai][bj][m][n]); const f32x4 f = {(float)iv[0], (float)iv[1], (float)iv[2], (float)iv[3]}; return f * sa[ai][m] * sw[bj][n]; }
            else return acc[ai][bj][m][n] * SC; };
        if (!HY_SEPARATE_ROPE && PN0 <= 4 && pn <= 4) {
            PG8_LAS float* gsrc = qkgL + ((pn < 4) ? 0 : 128); const int cb = 64 * (wc >> 1) + 16 * (wc & 1) + 4 * fq;
            const f32x4 g1 = *(const PG8_LAS f32x4*)(gsrc + cb), g2 = *(const PG8_LAS f32x4*)(gsrc + cb + 32);
#pragma unroll
            for (int ai = 0; ai < 2; ++ai)
#pragma unroll
                for (int m = 0; m < 4; ++m)
#pragma unroll
                    for (int bj = 0; bj < 2; ++bj) { const f32x4 a = val(ai, bj, m, 0), b = val(ai, bj, m, 1);
                        float s = ((a[0] * a[0] + a[1] * a[1]) + (a[2] * a[2] + a[3] * a[3])) + ((b[0] * b[0] + b[1] * b[1]) + (b[2] * b[2] + b[3] * b[3]));
                        s += __shfl_xor(s, 16); s += __shfl_xor(s, 32);
                        if (fq == 0) xch[((ai * HALF + wr * 64 + m * 16 + fr) * 2 + bj) * 4 + wc] = s; }
            asm volatile("s_waitcnt lgkmcnt(0)" ::: "memory"); __builtin_amdgcn_s_barrier(); asm volatile("" ::: "memory");
            bf16_t* base = (bf16_t*)(pn < 4 ? qb : ws + WS_AK); const int ldc = (pn < 4) ? 1024 : 256; const int colt = (pn < 4) ? pn * 256 : 0;
            PG8_LAS float* R = ropeL; const int j0 = 16 * (wc & 1) + 4 * fq;
#pragma unroll
            for (int ai = 0; ai < 2; ++ai)
#pragma unroll
                for (int m = 0; m < 4; ++m) { const int row = row0 + ai * HALF + m * 16; const int tl = row & (SEQ - 1); const int pos = (wc < 2) ? (tl >> 6) : (tl & 63);
                    const f32x4 cs0 = *(const PG8_LAS f32x4*)(R + (pos * 32 + j0) * 2), cs1 = *(const PG8_LAS f32x4*)(R + (pos * 32 + j0) * 2 + 4);
#pragma unroll
                    for (int bj = 0; bj < 2; ++bj) { const f32x4 pt = *(const PG8_LAS f32x4*)(xch + ((ai * HALF + wr * 64 + m * 16 + fr) * 2 + bj) * 4);
                        const float rstd = 1.f / sqrtf(((pt[0] + pt[1]) + (pt[2] + pt[3])) * (1.f / 128.f) + EPS);
                        const f32x4 y1 = val(ai, bj, m, 0) * rstd * g1, y2 = val(ai, bj, m, 1) * rstd * g2;
                        const float o10 = y1[0] * cs0[0] - y2[0] * cs0[1], o11 = y1[1] * cs0[2] - y2[1] * cs0[3], o12 = y1[2] * cs1[0] - y2[2] * cs1[1], o13 = y1[3] * cs1[2] - y2[3] * cs1[3];
                        const float o20 = y2[0] * cs0[0] + y1[0] * cs0[1], o21 = y2[1] * cs0[2] + y1[1] * cs0[3], o22 = y2[2] * cs1[0] + y1[2] * cs1[1], o23 = y2[3] * cs1[2] + y1[3] * cs1[3];
                        bf16_t* dst = base + (size_t)row * ldc + colt + bj * HALF + cb;
                        typedef unsigned u32x2v __attribute__((ext_vector_type(2)));
                        u32x2v w1, w2; w1.x = cvt_pk_bf16(o10, o11); w1.y = cvt_pk_bf16(o12, o13); w2.x = cvt_pk_bf16(o20, o21); w2.y = cvt_pk_bf16(o22, o23);
                        *(u32x2v*)dst = w1; *(u32x2v*)(dst + 32) = w2; } }
            return;
        }
        size_t off; int ldc, colt;
        if (pn < 4)       { off = 0; ldc = 1024; colt = pn * 256; }
        else if (pn == 4) { off = WS_AK;  ldc = 256;  colt = 0; }
        else if (pn == 5) { off = WS_AV;  ldc = 256;  colt = 0; }
        else if (pn < 10) { off = WS_AZ;  ldc = 1024; colt = (pn - 6) * 256; }
        else if (pn < 12) { off = WS_MQ;  ldc = 512;  colt = (pn - 10) * 256; }
        else if (pn < 14) { off = WS_MK;  ldc = 512;  colt = (pn - 12) * 256; }
        else if (pn < 18) { off = WS_MV;  ldc = 1024; colt = (pn - 14) * 256; }
        else if (pn < 22) { off = WS_MO;  ldc = 1024; colt = (pn - 18) * 256; }
        else              { off = WS_MZ;  ldc = 1024; colt = (pn - 22) * 256; }
        bf16_t* base = (bf16_t*)(pn < 4 ? qb : ws + off);
        const int col0 = colt + wc * 32 + 8 * fq;
#pragma unroll
        for (int ai = 0; ai < 2; ++ai)
#pragma unroll
            for (int m = 0; m < 4; ++m) { bf16_t* rowp = base + (size_t)(row0 + ai * HALF + m * 16) * ldc + col0;
#pragma unroll
                for (int bj = 0; bj < 2; ++bj) { const f32x4 v0 = val(ai, bj, m, 0), v1 = val(ai, bj, m, 1);
                    u32x4 w; w.x = cvt_pk_bf16(v0[0], v0[1]); w.y = cvt_pk_bf16(v0[2], v0[3]); w.z = cvt_pk_bf16(v1[0], v1[1]); w.w = cvt_pk_bf16(v1[2], v1[3]);
                    *(u32x4*)(rowp + bj * HALF) = w; } }
    }
};
struct EpiNull { static constexpr bool PERM = true, AFTER_DRAIN = false, PREFETCH = false; static constexpr int NSTORE = 0;
    __device__ __forceinline__ void operator()(const f32x4 (&acc)[2][2][4][2], const Unit& u, int wr, int wc, int fr, int fq) const {
#pragma unroll
        for (int ai = 0; ai < 2; ++ai)
#pragma unroll
            for (int bj = 0; bj < 2; ++bj)
#pragma unroll
                for (int m = 0; m < 4; ++m) asm volatile("" :: "v"(acc[ai][bj][m][0]), "v"(acc[ai][bj][m][1])); } };
struct EpiOut {
    static constexpr bool PERM = false, AFTER_DRAIN = false, PREFETCH = false; static constexpr int NSTORE = 32;
    const float* xp; const float* xs; float* out;
    __device__ __forceinline__ void operator()(const f32x4 (&acc)[2][2][4][2], const Unit& u, int wr, int wc, int fr, int fq) const {
        const int row0 = u.pm * BM + wr * 64 + fr; const int col0 = u.pn * BM + wc * 32 + 4 * fq;
        const bool pr = row0 < TOK_PROMPT; const float* xb = (pr ? xp : xs) + col0;
        const size_t xsub = pr ? 0 : (size_t)TOK_PROMPT * DM; float* ob = out + col0;
        f32x4 xr[4][4];
#define EPO_LOAD(g_) do { const size_t ro_ = (size_t)(row0 + ((g_) >> 2) * HALF + ((g_) & 3) * 16) * DM - xsub; \
            xr[(g_) & 3][0] = *(const f32x4*)(xb + ro_); xr[(g_) & 3][1] = *(const f32x4*)(xb + ro_ + 16); xr[(g_) & 3][2] = *(const f32x4*)(xb + ro_ + HALF); xr[(g_) & 3][3] = *(const f32x4*)(xb + ro_ + HALF + 16); } while (0)
        EPO_LOAD(0); EPO_LOAD(1); EPO_LOAD(2);
#pragma unroll
        for (int g = 0; g < 8; ++g) { if (g + 3 < 8) EPO_LOAD(g + 3);
            const int ai = g >> 2, m = g & 3; const size_t ro = (size_t)(row0 + ai * HALF + m * 16) * DM;
            *(f32x4*)(ob + ro) = xr[g & 3][0] + acc[ai][0][m][0]; *(f32x4*)(ob + ro + 16) = xr[g & 3][1] + acc[ai][0][m][1];
            *(f32x4*)(ob + ro + HALF) = xr[g & 3][2] + acc[ai][1][m][0]; *(f32x4*)(ob + ro + HALF + 16) = xr[g & 3][3] + acc[ai][1][m][1]; }
#undef EPO_LOAD
    }
};

template <class Epi, class Sched, bool ALIGN_EPI = false, bool SP2 = false, int MODE = 0>
__device__ __forceinline__ void gemm_phase(PG8_LAS unsigned char* lds, const Gemm g, const Sched& S, const Epi& E) {
    int tid_ = threadIdx.x; asm volatile("" : "+v"(tid_));
    const int tid = tid_, wid = __builtin_amdgcn_readfirstlane(tid >> 6), lane = tid & 63, wr = wid >> 2, wc = wid & 3, fr = lane & 15, fq = lane >> 4;
    const int K = g.K, nt = g.kt;
    unsigned voffA[2], voffB[2];
#pragma unroll
    for (int i = 0; i < 2; ++i) { int R, C; stage_rc(tid * 16 + i * 8192, R, C); const int Rb = Epi::PERM ? ((R & ~31) + perm32(R & 31)) : R;
        voffA[i] = (unsigned)(R * K + C) * 2u; voffB[i] = (unsigned)(Rb * K + C) * 2u; }
    const size_t kstep = (size_t)(BK * 2);
    const size_t hstep = (size_t)HALF * K * 2;
    const size_t tstep = 2 * hstep;
    const unsigned ldsw = (unsigned)wid * 1024u;
    const int aoff = lds_byte(wr * 64 + fr, fq * 8), boff = lds_byte(wc * 32 + fr, fq * 8);
#define PG8_SA(b, h) (((b) * 2 + (h)) * HTB)
#define PG8_SB(b, h) ((4 + (b) * 2 + (h)) * HTB)
#define PG8_STAGE(bufoff, gbase, voff) do { _Pragma("unroll") for (int _i = 0; _i < 2; ++_i) \
        __builtin_amdgcn_global_load_lds((const unsigned*)((const char*)(gbase) + (voff)[_i]), (PG8_LAS unsigned*)(lds + (bufoff) + ldsw + _i * 8192), 16, 0, 0); } while (0)
#define PG8_LDA(dst, b, h) do { _Pragma("unroll") for (int m = 0; m < 4; ++m) _Pragma("unroll") for (int k = 0; k < 2; ++k) dst[m][k] = *(const PG8_LAS bf16x8*)(lds + PG8_SA(b, h) + aoff + m * 2048 + k * 1024); } while (0)
#define PG8_LDB(dst, b, h) do { _Pragma("unroll") for (int n = 0; n < 2; ++n) _Pragma("unroll") for (int k = 0; k < 2; ++k) dst[n][k] = *(const PG8_LAS bf16x8*)(lds + PG8_SB(b, h) + boff + n * 2048 + k * 1024); } while (0)
#define PG8_CAT8(x_) __builtin_shufflevector(__builtin_bit_cast(i32x4, (x_)[0]), __builtin_bit_cast(i32x4, (x_)[1]), 0, 1, 2, 3, 4, 5, 6, 7)
#define PG8_MMA_F8(ai, bj, At, Bt) do { _Pragma("unroll") for (int m = 0; m < 4; ++m) _Pragma("unroll") for (int n = 0; n < 2; ++n) \
        asm volatile("v_mfma_f32_16x16x128_f8f6f4 %0, %1, %2, %0" : "+v"(acc[ai][bj][m][n]) : "v"(PG8_CAT8(Bt[n])), "v"(PG8_CAT8(At[m]))); } while (0)
#define PG8_MMA_I8(ai, bj, At, Bt) do { _Pragma("unroll") for (int k = 0; k < 2; ++k) _Pragma("unroll") for (int m = 0; m < 4; ++m) _Pragma("unroll") for (int n = 0; n < 2; ++n) \
        asm volatile("v_mfma_i32_16x16x64_i8 %0, %1, %2, %0" : "+v"(acc[ai][bj][m][n]) : "v"(Bt[n][k]), "v"(At[m][k])); } while (0)
#define PG8_MMA_BF(ai, bj, At, Bt) do { _Pragma("unroll") for (int m = 0; m < 4; ++m) _Pragma("unroll") for (int n = 0; n < 2; ++n) _Pragma("unroll") for (int k = 0; k < 2; ++k) \
        acc[ai][bj][m][n] = __builtin_amdgcn_mfma_f32_16x16x32_bf16(Bt[n][k], At[m][k], acc[ai][bj][m][n], 0, 0, 0); } while (0)
#define PG8_MMA(ai, bj, At, Bt) do { __builtin_amdgcn_s_setprio(1); \
        if constexpr (MODE == 1) PG8_MMA_F8(ai, bj, At, Bt); else if constexpr (MODE == 2) PG8_MMA_I8(ai, bj, At, Bt); else PG8_MMA_BF(ai, bj, At, Bt); \
        __builtin_amdgcn_s_setprio(0); } while (0)
#define PG8_MMAW_F8(ai, bj, At, Bt) do { __builtin_amdgcn_s_setprio(1); PG8_MMA_F8(ai, bj, At, Bt); __builtin_amdgcn_s_setprio(0); } while (0)
#define PG8_MMAW_BF(ai, bj, At, Bt) do { __builtin_amdgcn_s_setprio(1); PG8_MMA_BF(ai, bj, At, Bt); __builtin_amdgcn_s_setprio(0); } while (0)
#define PG8_WAIT_V(n) asm volatile("s_waitcnt vmcnt(" #n ")" ::: "memory")
#define PG8_WAIT_L(n) asm volatile("s_waitcnt lgkmcnt(" #n ")" ::: "memory")
#define PG8_BAR __builtin_amdgcn_s_barrier()
#define PG8_SCHED __builtin_amdgcn_sched_barrier(0)
    Unit cur, nxt; int ui = 0;
    if (!S.next(0, cur)) return;
    f32x4 acc[2][2][4][2];
#pragma unroll
    for (int a = 0; a < 2; ++a)
#pragma unroll
        for (int b = 0; b < 2; ++b)
#pragma unroll
            for (int m = 0; m < 4; ++m)
#pragma unroll
                for (int n = 0; n < 2; ++n) { acc[a][b][m][n] = (f32x4){0.f, 0.f, 0.f, 0.f}; if constexpr (MODE != 0) asm volatile("" : "+v"(acc[a][b][m][n])); }
    bf16x8 At[4][2], B0[2][2], B1[2][2];
    const char* cA = (const char*)g.A + (size_t)cur.pm * tstep; const char* cB = (const char*)g.Bt + (size_t)cur.pn * tstep;
    S.a_ready(cur);
    if constexpr (SP2) {
        PG8_STAGE(PG8_SB(0, 0), cB, voffB); PG8_STAGE(PG8_SB(0, 1), cB + hstep, voffB); PG8_STAGE(PG8_SA(0, 0), cA, voffA); PG8_STAGE(PG8_SA(0, 1), cA + hstep, voffA);
        if (wr == 1) PG8_BAR;
        PG8_WAIT_V(2); PG8_BAR;
        PG8_STAGE(PG8_SB(1, 0), cB + kstep, voffB); PG8_STAGE(PG8_SA(1, 0), cA + kstep, voffA); PG8_STAGE(PG8_SB(1, 1), cB + hstep + kstep, voffB);
        PG8_WAIT_V(6); PG8_BAR;
    } else {
        PG8_STAGE(PG8_SB(0, 0), cB, voffB); PG8_STAGE(PG8_SA(0, 0), cA, voffA); PG8_STAGE(PG8_SB(0, 1), cB + hstep, voffB); PG8_STAGE(PG8_SA(0, 1), cA + hstep, voffA);
        if (wr == 1) PG8_BAR;
        PG8_WAIT_V(4); PG8_BAR;
        PG8_STAGE(PG8_SB(1, 0), cB + kstep, voffB); PG8_STAGE(PG8_SA(1, 0), cA + kstep, voffA); PG8_STAGE(PG8_SB(1, 1), cB + hstep + kstep, voffB);
        PG8_WAIT_V(6); PG8_BAR;
    }
    for (;;) {
        const bool has_next = S.next(ui + 1, nxt);
        const char* nA = has_next ? (const char*)g.A + (size_t)nxt.pm * tstep : cA; const char* nB = has_next ? (const char*)g.Bt + (size_t)nxt.pn * tstep : cB;
        static_assert(SP2, "gemm_phase: only the SP2 K-loop is carried");
#define PG8_WAIT_FIRST() do { if constexpr (Epi::NSTORE >= 32) asm volatile("s_waitcnt vmcnt(40)\n\ts_cmp_lg_u32 %0, 0\n\ts_cbranch_scc1 1f\n\ts_waitcnt vmcnt(8)\n1:" :: "s"(relax_s) : "memory", "scc"); \
            else if constexpr (Epi::NSTORE >= 16) asm volatile("s_waitcnt vmcnt(24)\n\ts_cmp_lg_u32 %0, 0\n\ts_cbranch_scc1 1f\n\ts_waitcnt vmcnt(8)\n1:" :: "s"(relax_s) : "memory", "scc"); \
            else PG8_WAIT_V(8); } while (0)
#define PG8_TRIP(MMAX) do { \
            const bool last = (t == nt - 2); \
            const char* a1 = cA + (size_t)(t + 1) * kstep; \
            const char* a2 = last ? nA : cA + (size_t)(t + 2) * kstep; const char* b2 = last ? nB : cB + (size_t)(t + 2) * kstep; \
            const char* a3 = a2 + kstep; const char* b3 = b2 + kstep; \
            if (last && has_next) S.a_ready(nxt); \
            const int relax_s = __builtin_amdgcn_readfirstlane((Epi::NSTORE > 0 && t == 0 && ui > 0) ? 1 : 0); \
            PG8_LDB(B0, 0, 0); PG8_LDB(B1, 0, 1); PG8_SCHED; PG8_LDA(At, 0, 0); PG8_STAGE(PG8_SA(1, 1), a1 + hstep, voffA); \
            PG8_WAIT_FIRST(); PG8_WAIT_L(0); PG8_BAR; MMAX(0, 0, At, B0); MMAX(0, 1, At, B1); PG8_BAR; PG8_SCHED; \
            PG8_LDA(At, 0, 1); PG8_STAGE(PG8_SB(0, 0), b2, voffB); PG8_STAGE(PG8_SB(0, 1), b2 + hstep, voffB); PG8_STAGE(PG8_SA(0, 0), a2, voffA); \
            PG8_WAIT_FIRST(); PG8_WAIT_L(0); PG8_BAR; MMAX(1, 0, At, B0); MMAX(1, 1, At, B1); PG8_BAR; PG8_SCHED; \
            if constexpr (Epi::PREFETCH) { if (t == 0) E.prefetch(cur, ui, wid, lane); } \
            PG8_LDB(B0, 1, 0); PG8_LDB(B1, 1, 1); PG8_SCHED; PG8_LDA(At, 1, 0); PG8_STAGE(PG8_SA(0, 1), a2 + hstep, voffA); \
            PG8_WAIT_V(8); PG8_WAIT_L(0); PG8_BAR; MMAX(0, 0, At, B0); MMAX(0, 1, At, B1); PG8_BAR; PG8_SCHED; \
            PG8_LDA(At, 1, 1); PG8_STAGE(PG8_SB(1, 0), b3, voffB); PG8_STAGE(PG8_SB(1, 1), b3 + hstep, voffB); PG8_STAGE(PG8_SA(1, 0), a3, voffA); \
            PG8_WAIT_V(8); PG8_WAIT_L(0); PG8_BAR; MMAX(1, 0, At, B0); MMAX(1, 1, At, B1); PG8_BAR; PG8_SCHED; } while (0)
        if constexpr (MODE == 3) {
            for (int t = 0; t < F8_TILES; t += 2) PG8_TRIP(PG8_MMAW_F8);
            asm volatile("s_nop 15\n\ts_nop 15" ::: "memory"); PG8_SCHED;
#pragma unroll
            for (int a = 0; a < 2; ++a)
#pragma unroll
                for (int b = 0; b < 2; ++b)
#pragma unroll
                    for (int m = 0; m < 4; ++m)
#pragma unroll
                        for (int n = 0; n < 2; ++n) acc[a][b][m][n] *= (1.f / (A8_SCALE * W8_SCALE));
            for (int t = F8_TILES; t < nt; t += 2) PG8_TRIP(PG8_MMAW_BF);
        } else { for (int t = 0; t < nt; t += 2) PG8_TRIP(PG8_MMA); }
#undef PG8_TRIP
#undef PG8_WAIT_FIRST
        if constexpr (MODE == 1 || MODE == 2) { asm volatile("s_nop 15\n\ts_nop 15" ::: "memory"); PG8_SCHED; }
        if constexpr (ALIGN_EPI) { if (wr == 0) PG8_BAR; }
        if constexpr (!Epi::AFTER_DRAIN) { if constexpr (Epi::PREFETCH) E(acc, cur, wr, wc, fr, fq, ui & 1); else E(acc, cur, wr, wc, fr, fq); S.done(cur); }
        if (!has_next) break;
#pragma unroll
        for (int a = 0; a < 2; ++a)
#pragma unroll
            for (int b = 0; b < 2; ++b)
#pragma unroll
                for (int m = 0; m < 4; ++m)
#pragma unroll
                    for (int n = 0; n < 2; ++n) { acc[a][b][m][n] = (f32x4){0.f, 0.f, 0.f, 0.f}; if constexpr (MODE != 0) asm volatile("" : "+v"(acc[a][b][m][n])); }
        cur = nxt; cA = nA; cB = nB; ++ui;
        if constexpr (ALIGN_EPI) { if (wr == 1) PG8_BAR; }
    }
    PG8_WAIT_V(0);
    if constexpr (!ALIGN_EPI) { if (wr == 0) PG8_BAR; }
    PG8_BAR;
    if constexpr (Epi::AFTER_DRAIN) { E.fused(acc, cur, wr, wc, fr, fq, lds, wid, lane); S.done(cur); }
#undef PG8_SA
#undef PG8_SB
#undef PG8_STAGE
#undef PG8_LDA
#undef PG8_LDB
#undef PG8_MMA
#undef PG8_MMAW_F8
#undef PG8_MMAW_BF
#undef PG8_MMA_F8
#undef PG8_MMA_I8
#undef PG8_MMA_BF
#undef PG8_CAT8
#undef PG8_WAIT_V
#undef PG8_WAIT_L
#undef PG8_BAR
#undef PG8_SCHED
}
}
namespace attn {
using bf16 = __hip_bfloat16;
constexpr int   D = 128, NW = 8, QBLK = 32, KVBLK = 64;
constexpr float SCALE = 0.088388347648318440f;
constexpr float THR = 8.f;
constexpr int SDEPTH = 2;
constexpr int LDQ = 1024, LDK = 256, LDO = 4096, LDZ = 1024;
constexpr size_t SHM_V = KVBLK * D * 2, SHM_K = KVBLK * D * 2, SHM_ATTN = 2 * SHM_V + 2 * SHM_K + NW * 64 * 4;
using bf16x8 = __attribute__((ext_vector_type(8))) short;
using s16x4  = __attribute__((ext_vector_type(4))) short;
using f32x16 = __attribute__((ext_vector_type(16))) float;
using f32x8  = __attribute__((ext_vector_type(8))) float;
using u32x4  = __attribute__((ext_vector_type(4))) unsigned;
#define KSWZ(row, colB) ((row) * 256 + ((colB) ^ (((row) & 7) << 4)))
#define SBAR() __builtin_amdgcn_sched_barrier(0)
__device__ __forceinline__ int crow(int r, int hi) { return (r & 3) + 8 * (r >> 2) + 4 * hi; }
__device__ __forceinline__ unsigned cvtpk(float lo, float hi) {
  unsigned r; asm volatile("v_cvt_pk_bf16_f32 %0, %1, %2" : "=v"(r) : "v"(lo), "v"(hi)); return r;
}
template <typename TIn> struct Stage;
template <> struct Stage<bf16>  { using T = bf16x8;
  __device__ static __forceinline__ T ld8(const bf16* p) { return *reinterpret_cast<const bf16x8*>(p); }
  __device__ static __forceinline__ bf16x8 tobf(T x) { return x; } };
template <> struct Stage<float> { using T = f32x8;
  __device__ static __forceinline__ T ld8(const float* p) { return *reinterpret_cast<const f32x8*>(p); }
  __device__ static __forceinline__ bf16x8 tobf(T x) {
    u32x4 w = {cvtpk(x[0], x[1]), cvtpk(x[2], x[3]), cvtpk(x[4], x[5]), cvtpk(x[6], x[7])}; return *reinterpret_cast<bf16x8*>(&w); } };

__device__ __forceinline__ void partialSM(f32x16& p0, f32x16& p1, float& m_reg, float& mn, float& alpha) {
  constexpr float C = SCALE * 1.4426950408889634f;
  float pmax = p0[0]; for (int r = 1; r < 16; ++r) pmax = fmaxf(pmax, p0[r]); for (int r = 0; r < 16; ++r) pmax = fmaxf(pmax, p1[r]);
  { auto rr = __builtin_amdgcn_permlane32_swap(__float_as_uint(pmax), __float_as_uint(pmax), false, false);
    pmax = fmaxf(__uint_as_float(rr[0]), __uint_as_float(rr[1])); }
  if (__builtin_expect(__all(pmax - m_reg <= THR / SCALE), 1)) { mn = m_reg; alpha = 1.f; }
  else { mn = fmaxf(m_reg, pmax); alpha = __builtin_amdgcn_exp2f((m_reg - mn) * C); m_reg = mn; }
  float mnC = -mn * C;
  for (int r = 0; r < 16; ++r) p0[r] = fmaf(p0[r], C, mnC); for (int r = 0; r < 16; ++r) p1[r] = fmaf(p1[r], C, mnC);
  for (int r = 0; r < 16; ++r) p0[r] = __builtin_amdgcn_exp2f(p0[r]);
}
__device__ __forceinline__ void finishSM(f32x16& p0, f32x16& p1, float alpha, float& l_reg, bf16x8& pa0, bf16x8& pa1, bf16x8& pa2, bf16x8& pa3) {
  for (int r = 0; r < 16; ++r) p1[r] = __builtin_amdgcn_exp2f(p1[r]);
  float ps = 0; for (int r = 0; r < 16; ++r) ps += p0[r]; for (int r = 0; r < 16; ++r) ps += p1[r];
  { auto rr = __builtin_amdgcn_permlane32_swap(__float_as_uint(ps), __float_as_uint(ps), false, false);
    ps = __uint_as_float(rr[0]) + __uint_as_float(rr[1]); }
  l_reg = l_reg * alpha + ps;
#define PK4(P, BASE, OUT) do { unsigned a0 = cvtpk(P[BASE + 0], P[BASE + 1]), a1 = cvtpk(P[BASE + 2], P[BASE + 3]);   \
    unsigned b0 = cvtpk(P[BASE + 4], P[BASE + 5]), b1 = cvtpk(P[BASE + 6], P[BASE + 7]);                              \
    auto r0 = __builtin_amdgcn_permlane32_swap(a0, b0, false, false); auto r1 = __builtin_amdgcn_permlane32_swap(a1, b1, false, false); \
    u32x4 w = {r0[0], r1[0], r0[1], r1[1]}; OUT = *reinterpret_cast<bf16x8*>(&w); } while (0)
  PK4(p0, 0, pa0); PK4(p0, 8, pa1); PK4(p1, 0, pa2); PK4(p1, 8, pa3);
#undef PK4
}
__device__ __forceinline__ void qkt(f32x16& p0, f32x16& p1, const bf16* Ks, const bf16x8* qr, int r32, int hi) {
  p0 = f32x16{}; p1 = f32x16{};
  for (int d0 = 0; d0 < 8; ++d0) { int cb = (d0 * 16 + hi * 8) * 2;
    bf16x8 b0 = *reinterpret_cast<const bf16x8*>((const char*)Ks + KSWZ(r32, cb));
    bf16x8 b1 = *reinterpret_cast<const bf16x8*>((const char*)Ks + KSWZ(32 + r32, cb));
    p0 = __builtin_amdgcn_mfma_f32_32x32x16_bf16(b0, qr[d0], p0, 0, 0, 0);
    p1 = __builtin_amdgcn_mfma_f32_32x32x16_bf16(b1, qr[d0], p1, 0, 0, 0); }
}
__device__ __forceinline__ int v_st(int k, int c) { const int kk = (k & ~0xC) | ((k & 4) << 1) | ((k & 8) >> 1); return ((kk >> 3) * 4 + (c >> 5)) * 512 + ((kk & 7) * 32 + (c & 31)) * 2; }
__device__ __forceinline__ int v_rd_base(int lane) { return ((lane & 3) << 3) | (((lane >> 2) & 3) << 6) | (((lane >> 4) & 1) << 5) | (((lane >> 5) & 1) << 8); }
constexpr int v_rd_off(int d0, int ks, int half) { return d0 * 512 + ks * 4096 + half * 2048; }
template <int OFF> __device__ __forceinline__ s16x4 tr_read(int vb) {
  s16x4 r; asm volatile("ds_read_b64_tr_b16 %0, %1 offset:%2" : "=&v"(r) : "v"(vb), "i"(OFF) : "memory"); return r;
}
template <int D0> __device__ __forceinline__ void pv_one(f32x16& od, int vb, bf16x8 pa0, bf16x8 pa1, bf16x8 pa2, bf16x8 pa3) {
  const s16x4 l0 = tr_read<v_rd_off(D0, 0, 0)>(vb), h0 = tr_read<v_rd_off(D0, 0, 1)>(vb), l1 = tr_read<v_rd_off(D0, 1, 0)>(vb), h1 = tr_read<v_rd_off(D0, 1, 1)>(vb);
  const s16x4 l2 = tr_read<v_rd_off(D0, 2, 0)>(vb), h2 = tr_read<v_rd_off(D0, 2, 1)>(vb), l3 = tr_read<v_rd_off(D0, 3, 0)>(vb), h3 = tr_read<v_rd_off(D0, 3, 1)>(vb);
  asm volatile("s_waitcnt lgkmcnt(0)" ::: "memory"); SBAR();
#define PK(L, H) (bf16x8){L[0], L[1], L[2], L[3], H[0], H[1], H[2], H[3]}
  od = __builtin_amdgcn_mfma_f32_32x32x16_bf16(pa0, PK(l0, h0), od, 0, 0, 0);
  od = __builtin_amdgcn_mfma_f32_32x32x16_bf16(pa1, PK(l1, h1), od, 0, 0, 0);
  od = __builtin_amdgcn_mfma_f32_32x32x16_bf16(pa2, PK(l2, h2), od, 0, 0, 0);
  od = __builtin_amdgcn_mfma_f32_32x32x16_bf16(pa3, PK(l3, h3), od, 0, 0, 0);
#undef PK
}
__device__ __forceinline__ void pv_d0(f32x16* o, int vb, bf16x8 pa0, bf16x8 pa1, bf16x8 pa2, bf16x8 pa3) {
  pv_one<0>(o[0], vb, pa0, pa1, pa2, pa3); pv_one<1>(o[1], vb, pa0, pa1, pa2, pa3); pv_one<2>(o[2], vb, pa0, pa1, pa2, pa3); pv_one<3>(o[3], vb, pa0, pa1, pa2, pa3);
}

template <typename TQ>
__device__ __forceinline__ void attn_dense_body(const TQ* Qb, const bf16* __restrict__ Kh, const bf16* __restrict__ Vh,
                                                unsigned char* Ob, const unsigned short* __restrict__ Zb, int seq, char* lds) {
  using St = Stage<bf16>; using SQ = Stage<TQ>;
  int tid = threadIdx.x; asm volatile("" : "+v"(tid));
  const int wid = tid >> 6, lane = tid & 63, r32 = lane & 31, hi = lane >> 5;
  bf16* V_lds = (bf16*)lds; bf16* K_lds = (bf16*)(lds + 2 * SHM_V);
  float* ws = (float*)(lds + 2 * SHM_V + 2 * SHM_K) + wid * 64; float* li_l = ws; float* al_l = ws + 32;
  float m_reg = -1e30f, l_reg = 0; f32x16 o[4] = {}; bf16x8 qr[8];
  const TQ* Qw = Qb + (long)(wid * QBLK + r32) * LDQ + hi * 8;
#pragma unroll
  for (int d0 = 0; d0 < 8; ++d0) qr[d0] = SQ::tobf(SQ::ld8(Qw + d0 * 16));
  const int sr = tid >> 4, sc = (tid & 15) * 8, vst0 = v_st(sr, sc), vst1 = v_st(32 + sr, sc);
  const int vb0 = (int)(uintptr_t)V_lds + v_rd_base(lane);
  struct { typename St::T vs0, vs1, ks0, ks1; } sr_[SDEPTH];
#define SLOAD(i, k0) do { sr_[i].vs0 = St::ld8(&Vh[(long)((k0) + sr) * LDK + sc]); sr_[i].vs1 = St::ld8(&Vh[(long)((k0) + 32 + sr) * LDK + sc]); \
    sr_[i].ks0 = St::ld8(&Kh[(long)((k0) + sr) * LDK + sc]); sr_[i].ks1 = St::ld8(&Kh[(long)((k0) + 32 + sr) * LDK + sc]); } while (0)
#define SWRITE(b, i) do { *(bf16x8*)((char*)V_lds + (b) * SHM_V + vst0) = St::tobf(sr_[i].vs0);          \
    *(bf16x8*)((char*)V_lds + (b) * SHM_V + vst1) = St::tobf(sr_[i].vs1); int kc = sc * 2;               \
    *(bf16x8*)((char*)K_lds + (b) * SHM_K + KSWZ(sr, kc)) = St::tobf(sr_[i].ks0);                       \
    *(bf16x8*)((char*)K_lds + (b) * SHM_K + KSWZ(32 + sr, kc)) = St::tobf(sr_[i].ks1); } while (0)
#define SWAIT() do { if constexpr (SDEPTH == 2) asm volatile("s_waitcnt vmcnt(4)" ::: "memory"); else asm volatile("s_waitcnt vmcnt(0)" ::: "memory"); } while (0)
#define RESC(a) do { if (__any((a) < 1.f)) { if (hi == 0) al_l[r32] = (a); asm volatile("s_waitcnt lgkmcnt(0)" ::: "memory"); \
    for (int d = 0; d < 4; ++d) for (int r = 0; r < 16; ++r) o[d][r] *= al_l[crow(r, hi)]; } } while (0)
  f32x16 pA0, pA1, pB0, pB1; float mnA, mnB, alA, alB; bf16x8 pa0, pa1, pa2, pa3; const int NT = seq / KVBLK;
  constexpr int SE = 0, SO = SDEPTH - 1;
  SLOAD(SE, 0); asm volatile("s_waitcnt vmcnt(0)" ::: "memory"); SWRITE(0, SE); __syncthreads();
  qkt(pA0, pA1, K_lds, qr, r32, hi); partialSM(pA0, pA1, m_reg, mnA, alA);
  SLOAD(SO, KVBLK); if constexpr (SDEPTH == 2) { if (2 < NT) SLOAD(SE, 2 * KVBLK); }
  SWAIT(); SWRITE(1, SO); __syncthreads();
  for (int j = 1; j + 1 < NT; j += 2) {
    SBAR(); qkt(pB0, pB1, (bf16*)((char*)K_lds + SHM_K), qr, r32, hi);
    finishSM(pA0, pA1, alA, l_reg, pa0, pa1, pa2, pa3); SBAR();
    SLOAD(SO, (j + SDEPTH) * KVBLK); SBAR();
    pv_d0(o, vb0, pa0, pa1, pa2, pa3); partialSM(pB0, pB1, m_reg, mnB, alB);
    __syncthreads(); SWAIT(); SWRITE(0, SE);
    RESC(alB); __syncthreads();
    SBAR(); qkt(pA0, pA1, K_lds, qr, r32, hi);
    finishSM(pB0, pB1, alB, l_reg, pa0, pa1, pa2, pa3); SBAR();
    if (SDEPTH == 1 || j + 3 < NT) SLOAD(SE, (j + 1 + SDEPTH) * KVBLK); SBAR();
    pv_d0(o, vb0 + (int)SHM_V, pa0, pa1, pa2, pa3); partialSM(pA0, pA1, m_reg, mnA, alA);
    __syncthreads(); SWAIT(); SWRITE(1, SO);
    RESC(alA); __syncthreads();
  }
  SBAR(); qkt(pB0, pB1, (bf16*)((char*)K_lds + SHM_K), qr, r32, hi);
  finishSM(pA0, pA1, alA, l_reg, pa0, pa1, pa2, pa3); SBAR();
  pv_d0(o, vb0, pa0, pa1, pa2, pa3); partialSM(pB0, pB1, m_reg, mnB, alB);
  __syncthreads(); RESC(alB);
  finishSM(pB0, pB1, alB, l_reg, pa0, pa1, pa2, pa3); SBAR();
  pv_d0(o, vb0 + (int)SHM_V, pa0, pa1, pa2, pa3);
  if (hi == 0) li_l[r32] = l_reg; asm volatile("s_waitcnt lgkmcnt(0)" ::: "memory");
  float rli[16];
#pragma unroll
  for (int r = 0; r < 16; ++r) rli[r] = __builtin_amdgcn_rcpf(li_l[crow(r, hi)]);
  __syncthreads();
  { unsigned short* stg = (unsigned short*)(lds + wid * 8192);
#pragma unroll
    for (int r = 0; r < 16; ++r) { const int orow = crow(r, hi);
#pragma unroll
      for (int d0 = 0; d0 < 4; ++d0) { unsigned u = __builtin_bit_cast(unsigned, o[d0][r] * rli[r]); u = (u + 0x7fffu + ((u >> 16) & 1u)) >> 16; stg[orow * 128 + d0 * 32 + r32] = (unsigned short)u; } }
    asm volatile("s_waitcnt lgkmcnt(0)" ::: "memory");
    unsigned char* Ow = Ob + (long)(wid * QBLK) * LDO; const unsigned short* Zw = Zb + (long)(wid * QBLK) * LDZ;
#pragma unroll 2
    for (int i = 0; i < 8; ++i) { const int row = i * 4 + (lane >> 4), ch = lane & 15;
      const u32x4 ov = *(const u32x4*)(stg + row * 128 + ch * 8); const u32x4 zv = *(const u32x4*)(Zw + (long)row * LDZ + ch * 8); float g8[8];
#pragma unroll
      for (int e = 0; e < 4; ++e) { const float z0 = __builtin_bit_cast(float, zv[e] << 16), z1 = __builtin_bit_cast(float, zv[e] & 0xffff0000u);
        g8[2 * e] = __builtin_bit_cast(float, ov[e] << 16) * (z0 * __builtin_amdgcn_rcpf(1.f + __expf(-z0))) * A8_SCALE; g8[2 * e + 1] = __builtin_bit_cast(float, ov[e] & 0xffff0000u) * (z1 * __builtin_amdgcn_rcpf(1.f + __expf(-z1))) * A8_SCALE; }
      typedef unsigned u32x2o __attribute__((ext_vector_type(2)));
      u32x2o w; w.x = pk4f8(g8[0], g8[1], g8[2], g8[3]); w.y = pk4f8(g8[4], g8[5], g8[6], g8[7]);
      *(u32x2o*)(Ow + (long)row * LDO + ch * 8) = w; } }
#undef SLOAD
#undef SWRITE
#undef SWAIT
#undef RESC
}

}
namespace ml {
typedef short bf16x8 __attribute__((ext_vector_type(8)));
typedef short v4i16 __attribute__((ext_vector_type(4)));
typedef float f32x4 __attribute__((ext_vector_type(4)));
typedef float f32x16 __attribute__((ext_vector_type(16)));
typedef unsigned u32x4 __attribute__((ext_vector_type(4)));
typedef unsigned u32x2 __attribute__((ext_vector_type(2)));
#define ML_LAS __attribute__((address_space(3)))
constexpr int BUFB = 65536, Q_OFF = 0, K_OFF = 16384, V_OFF = 32768;
constexpr int P_OFF = 131072, DENP_OFF = P_OFF + 8192, QNP_OFF = DENP_OFF + 512, VEC_OFF = QNP_OFF + 2048, VEC_SLOT = 2 * 256, VR_OFF = VEC_OFF + 2 * VEC_SLOT, NB_OFF = VR_OFF + 8 * 256, LDS_END = NB_OFF + 512;
__device__ __forceinline__ unsigned fxor(unsigned row) { return ((row & 3u) << 2) | ((row >> 2) & 3u); }
__device__ __forceinline__ unsigned off_b(unsigned row, unsigned ch) { return 256u * row + 16u * (ch ^ fxor(row)); }
__device__ __forceinline__ unsigned off_p(unsigned t, unsigned ch) { return 128u * t + 16u * (ch ^ (t & 7u)); }
__device__ __forceinline__ unsigned tr_addr(unsigned lane, unsigned c, unsigned ks, unsigned t) { const unsigned h = lane >> 5, blk = (lane >> 4) & 1u, q = (lane & 15u) >> 2, p = lane & 3u; return off_b(16u * ks + 8u * h + 4u * t + q, 4u * c + 2u * blk + (p >> 1)) + 8u * (p & 1u); }
__device__ __forceinline__ unsigned tr_addr16(unsigned lane, unsigned c, unsigned ks, unsigned t) { const unsigned g = lane >> 4, q = (lane & 15u) >> 2, p = lane & 3u; return off_b(32u * ks + 8u * g + 4u * t + q, 2u * c + (p >> 1)) + 8u * (p & 1u); }
__device__ __forceinline__ v4i16 trrd(ML_LAS unsigned char* p) { return __builtin_amdgcn_ds_read_tr16_b64_v4i16((ML_LAS v4i16*)p); }
template <int OFF> __device__ __forceinline__ v4i16 trra(unsigned addr) { v4i16 r; asm volatile("ds_read_b64_tr_b16 %0, %1 offset:%2" : "=v"(r) : "v"(addr), "i"(OFF) : "memory"); return r; }
__device__ __forceinline__ void glds16(const void* gsrc, unsigned lds_dst) { unsigned keep;
    asm volatile("s_mov_b32 %0, m0\n\ts_mov_b32 m0, %2\n\ts_nop 0\n\tglobal_load_lds_dwordx4 %1, off\n\ts_mov_b32 m0, %0" : "=&s"(keep) : "v"(gsrc), "s"(lds_dst) : "memory"); }
#define ML_TRWAIT() do { asm volatile("s_waitcnt lgkmcnt(0)" ::: "memory"); __builtin_amdgcn_sched_barrier(0); } while (0)
__device__ __forceinline__ bf16x8 cat8(v4i16 lo, v4i16 hi) { return (bf16x8){lo[0], lo[1], lo[2], lo[3], hi[0], hi[1], hi[2], hi[3]}; }
__device__ __forceinline__ unsigned pkbf(float lo, float hi) { unsigned r; asm volatile("v_cvt_pk_bf16_f32 %0, %1, %2" : "=v"(r) : "v"(lo), "v"(hi)); return r; }
__device__ __forceinline__ float s2f(short x) { return __builtin_bit_cast(float, (unsigned)(unsigned short)x << 16); }
__device__ __forceinline__ bf16x8 pack8(float a0, float a1, float a2, float a3, float a4, float a5, float a6, float a7) { u32x4 w = {pkbf(a0, a1), pkbf(a2, a3), pkbf(a4, a5), pkbf(a6, a7)}; return __builtin_bit_cast(bf16x8, w); }
__device__ __forceinline__ float scan_add(float v, int lane) {
#pragma unroll
    for (int o = 1; o < 64; o <<= 1) { const float u = __shfl_up(v, o); if (lane >= o) v += u; }
    return v; }
__device__ __forceinline__ float scan_max(float v, int lane) {
#pragma unroll
    for (int o = 1; o < 64; o <<= 1) { const float u = __shfl_up(v, o); if (lane >= o) v = fmaxf(v, u); }
    return v; }
#define ML_OPAQUE_LANE(ln) unsigned ln = (unsigned)lane; asm volatile("" : "+v"(ln))
__device__ __forceinline__ float rdlane(float v, int l) { return __builtin_bit_cast(float, __builtin_amdgcn_readlane(__builtin_bit_cast(int, v), l)); }

__device__ __forceinline__ void stage(ML_LAS unsigned char* lds, int bsel, int c, int b, int hd, int dir, const unsigned short* MQ, const unsigned short* MK, const unsigned short* MV, int wid, int lane) {
    const int rl = lane >> 4, pos = lane & 15;
#pragma unroll
    for (int half = 0; half < 2; ++half) {
        const int grp = wid + 8 * half, row = 4 * grp + rl, ch = pos ^ ((rl << 2) | (grp & 3));
        const int p = 64 * c + row, tok = dir ? (SEQ - 1 - p) : p; const size_t trow = (size_t)b * SEQ + tok;
        ML_LAS unsigned char* d = lds + bsel * BUFB + grp * 1024;
        __builtin_amdgcn_global_load_lds((const unsigned*)(MQ + trow * 512 + hd * 128 + 8 * ch), (ML_LAS unsigned*)(d + Q_OFF), 16, 0, 0);
        __builtin_amdgcn_global_load_lds((const unsigned*)(MK + trow * 512 + hd * 128 + 8 * ch), (ML_LAS unsigned*)(d + K_OFF), 16, 0, 0);
        __builtin_amdgcn_global_load_lds((const unsigned*)(MV + trow * 1024 + hd * 256 + 8 * ch), (ML_LAS unsigned*)(d + V_OFF), 16, 0, 0);
        __builtin_amdgcn_global_load_lds((const unsigned*)(MV + trow * 1024 + hd * 256 + 128 + 8 * ch), (ML_LAS unsigned*)(d + V_OFF + 16384), 16, 0, 0);
    }
}

#define ML_DPPF(old_, src_, ctrl_, rm_) __builtin_bit_cast(float, __builtin_amdgcn_update_dpp(__builtin_bit_cast(int, (float)(old_)), __builtin_bit_cast(int, (float)(src_)), ctrl_, rm_, 0xf, false))
__device__ __forceinline__ float dscan_add(float v) {
    v += ML_DPPF(0.f, v, 0x111, 0xf); v += ML_DPPF(0.f, v, 0x112, 0xf); v += ML_DPPF(0.f, v, 0x114, 0xf); v += ML_DPPF(0.f, v, 0x118, 0xf);
    v += ML_DPPF(0.f, v, 0x142, 0xa); v += ML_DPPF(0.f, v, 0x143, 0xc); return v; }
__device__ __forceinline__ float dscan_max(float v) { const float NI = -3.0e38f;
    v = fmaxf(v, ML_DPPF(NI, v, 0x111, 0xf)); v = fmaxf(v, ML_DPPF(NI, v, 0x112, 0xf)); v = fmaxf(v, ML_DPPF(NI, v, 0x114, 0xf)); v = fmaxf(v, ML_DPPF(NI, v, 0x118, 0xf));
    v = fmaxf(v, ML_DPPF(NI, v, 0x142, 0xa)); v = fmaxf(v, ML_DPPF(NI, v, 0x143, 0xc)); return v; }

template <int MODE> __device__ __forceinline__ void mlstm_item(unsigned char* ws, ML_LAS unsigned char* lds, int item, int tid) {
    const int lane = tid & 63, wid = __builtin_amdgcn_readfirstlane(tid >> 6);
    const int b = item >> 3, hd = (item >> 1) & 3, dir = item & 1;
    const float* GT = (const float*)(ws + WS_GATES) + dir * 8 + hd;
    ML_LAS float* DENP = (ML_LAS float*)(lds + DENP_OFF); ML_LAS float* QNP = (ML_LAS float*)(lds + QNP_OFF); ML_LAS float* NB = (ML_LAS float*)(lds + NB_OFF + wid * 64);
    unsigned dq0, dq1, dv0, dv1;
    { const int rl = lane >> 4, pos = lane & 15;
      const int g0 = wid, g1 = wid + 8; const int r0 = 4 * g0 + rl, r1 = 4 * g1 + rl; const int c0 = pos ^ ((rl << 2) | (g0 & 3)), c1 = pos ^ ((rl << 2) | (g1 & 3));
      const int m0 = dir ? 63 - r0 : r0, m1 = dir ? 63 - r1 : r1;
      dq0 = (unsigned)(m0 * 1024 + 16 * c0); dq1 = (unsigned)(m1 * 1024 + 16 * c1); dv0 = (unsigned)(m0 * 2048 + 16 * c0); dv1 = (unsigned)(m1 * 2048 + 16 * c1); }
    const unsigned goff = (unsigned)((dir ? 63 - lane : lane) * 64);
    unsigned trL0, trL1, trX;
    { const unsigned h = lane >> 5, blk = (lane >> 4) & 1u, q = (lane & 15u) >> 2, p = lane & 3u; const unsigned A = 256u * (8u * h + q) + 8u * (p & 1u), lo = 2u * blk + (p >> 1);
      trL0 = A + 16u * (lo ^ ((2u * h) & 3u)); trL1 = A + 16u * (lo ^ ((2u * h + 1u) & 3u)) + 1024u; trX = 64u * q; }
    f32x16 C[4]; f32x4 n4 = {0.f, 0.f, 0.f, 0.f};
#pragma unroll
    for (int i = 0; i < 4; ++i) C[i] = (f32x16){0.f};
    const char* gq = (const char*)(ws + WS_MQ) + ((size_t)b * SEQ * 512 + hd * 128) * 2; const char* gk = (const char*)(ws + WS_MK) + ((size_t)b * SEQ * 512 + hd * 128) * 2;
    const char* gv = (const char*)(ws + WS_MV) + ((size_t)b * SEQ * 1024 + hd * 256) * 2; const char* gg = (const char*)GT + (size_t)b * SEQ * 64;
    unsigned char* ho = ws + (dir ? WS_HB : WS_HF) + ((size_t)(b * 4 + hd) * 32) * 32768 + wid * 4096 + lane * 16;
    const unsigned lds0 = (unsigned)(uintptr_t)lds;
#define ML_TB(c_) (MODE == 1 ? (dir ? (SEQ - 64) : 0) : (dir ? (SEQ - 64 * ((c_) + 1)) : 64 * (c_)))
#define ML_STAGE(bsel_, c_) do { const int tb_ = ML_TB(c_); const unsigned d_ = (unsigned)__builtin_amdgcn_readfirstlane((int)(lds0 + (bsel_) * BUFB + wid * 1024)); \
        const char* q_ = gq + (size_t)tb_ * 1024; const char* k_ = gk + (size_t)tb_ * 1024; const char* v_ = gv + (size_t)tb_ * 2048; \
        glds16(q_ + dq0, d_ + Q_OFF); glds16(q_ + dq1, d_ + Q_OFF + 8192); glds16(k_ + dq0, d_ + K_OFF); glds16(k_ + dq1, d_ + K_OFF + 8192); \
        glds16(v_ + dv0, d_ + V_OFF); glds16(v_ + dv1, d_ + V_OFF + 8192); glds16(v_ + 256 + dv0, d_ + V_OFF + 16384); glds16(v_ + 256 + dv1, d_ + V_OFF + 16384 + 8192); } while (0)
#define ML_GATES(c_, gi_, gf_) do { const char* g_ = gg + (size_t)ML_TB(c_) * 64 + goff; gi_ = *(const float*)g_; gf_ = *(const float*)(g_ + 16); } while (0)
#define ML_VEC(cc_, gi_, gf_, sc_out_) do { ML_LAS float* T_ = (ML_LAS float*)(lds + VEC_OFF + ((cc_) & 1) * VEC_SLOT); \
        const float bcs_ = dscan_add(gf_), cx_ = (gi_) - bcs_, cm_ = dscan_max(cx_), M_ = fmaxf(m, cm_); const float g_ = rdlane(bcs_, 63), M63_ = rdlane(M_, 63); \
        T_[lane] = __expf(cx_ - M63_); T_[64 + lane] = __expf(-(bcs_ + M63_)); \
        sc_out_ = __expf(m - M63_); m = g_ + M63_; } while (0)
    float m = 0.f, sc, sc_n = 1.f, gi_a, gf_a, gi_b = 0.f, gf_b = 0.f; u32x4 pend[4] = {{0u, 0u, 0u, 0u}, {0u, 0u, 0u, 0u}, {0u, 0u, 0u, 0u}, {0u, 0u, 0u, 0u}};
    ML_STAGE(0, 0); ML_GATES(0, gi_a, gf_a); ML_VEC(0, gi_a, gf_a, sc); ML_GATES(1, gi_a, gf_a);
    for (int c = 0; c < SEQ / 64; ++c) {
        const int bsel = c & 1;
        ML_LAS unsigned char* bQ = lds + bsel * BUFB + Q_OFF; ML_LAS unsigned char* bK = lds + bsel * BUFB + K_OFF; ML_LAS unsigned char* bV = lds + bsel * BUFB + V_OFF;
        ML_LAS float* VWE = (ML_LAS float*)(lds + VEC_OFF + bsel * VEC_SLOT); ML_LAS float* VEMT = VWE + 64; ML_LAS float* VR = (ML_LAS float*)(lds + VR_OFF + wid * 256);
        asm volatile("s_waitcnt vmcnt(0) lgkmcnt(0)" ::: "memory"); __builtin_amdgcn_s_barrier(); asm volatile("" ::: "memory");
        if (c > 0) { unsigned char* hc = ho + (size_t)(c - 1) * 32768; *(u32x4*)(hc) = pend[0]; *(u32x4*)(hc + 1024) = pend[1]; *(u32x4*)(hc + 2048) = pend[2]; *(u32x4*)(hc + 3072) = pend[3]; }
        if (c + 1 < SEQ / 64) { ML_STAGE(bsel ^ 1, c + 1);
            if (c + 2 < SEQ / 64) ML_GATES(c + 2, gi_b, gf_b);
            ML_VEC(c + 1, gi_a, gf_a, sc_n); }
        if (MODE == 2) { asm volatile("s_waitcnt lgkmcnt(0)" ::: "memory"); __builtin_amdgcn_s_barrier(); continue; }
        { ML_OPAQUE_LANE(ln); const unsigned r15 = ln & 15u, kg = ln >> 4; const int tj = wid >> 1, sb = (wid & 1) * 2; const unsigned t = 16u * tj + r15;
          const unsigned xq = fxor(r15) << 4;
          ML_LAS unsigned char* qrow = bQ + 256u * t;
          bf16x8 qf[4];
#pragma unroll
          for (int ks = 0; ks < 4; ++ks) qf[ks] = *(const ML_LAS bf16x8*)(qrow + (((4u * ks + kg) << 4) ^ xq));
          float dsum = 0.f; const unsigned hb = 8u * (kg & 1u), kh = kg >> 1;
#pragma unroll
          for (int u = 0; u < 2; ++u) { const unsigned si = sb + u; ML_LAS unsigned char* krow = bK + 256u * (16u * si + r15) + hb;
              f32x4 acc = {0.f, 0.f, 0.f, 0.f};
#pragma unroll
              for (int ks = 0; ks < 4; ++ks) { const unsigned g2 = 4u * ks + 2u * kh;
                  const u32x2 lo = *(const ML_LAS u32x2*)(krow + ((g2 << 4) ^ xq)), hi = *(const ML_LAS u32x2*)(krow + (((g2 + 1u) << 4) ^ xq));
                  const u32x4 kw = {lo.x, lo.y, hi.x, hi.y};
                  acc = __builtin_amdgcn_mfma_f32_16x16x32_bf16(__builtin_bit_cast(bf16x8, kw), qf[ks], acc, 0, 0, 0); }
              const unsigned s0 = 16u * si + 4u * kg; const f32x4 ws4 = *(const ML_LAS f32x4*)(VWE + s0);
              float p[4];
#pragma unroll
              for (int r = 0; r < 4; ++r) { p[r] = (s0 + r <= t) ? acc[r] : 0.f; dsum = fmaf(p[r], ws4[r], dsum); }
              const u32x2 pw = {pkbf(p[0], p[1]), pkbf(p[2], p[3])};
              *(ML_LAS u32x2*)(lds + P_OFF + 128u * t + (((2u * si + kh) ^ (t & 7u)) << 4) + hb) = pw; }
          dsum += __shfl_xor(dsum, 16); dsum += __shfl_xor(dsum, 32);
          if (ln < 16u) DENP[(wid & 1) * 64 + t] = dsum; }
        n4 = n4 * sc;
        { ML_OPAQUE_LANE(ln); const unsigned r15 = ln & 15u, kg = ln >> 4; if (r15 == 0) *(ML_LAS f32x4*)(NB + 4 * kg) = n4;
          const f32x4 nA = *(const ML_LAS f32x4*)(NB + 0), nB = *(const ML_LAS f32x4*)(NB + 4), nC = *(const ML_LAS f32x4*)(NB + 8), nD = *(const ML_LAS f32x4*)(NB + 12);
          const unsigned t = ln; ML_LAS unsigned char* qrow = bQ + 256u * t; const unsigned xq = fxor(t) << 4;
          const bf16x8 c0 = *(const ML_LAS bf16x8*)(qrow + (((2u * wid) << 4) ^ xq)), c1 = *(const ML_LAS bf16x8*)(qrow + (((2u * wid + 1u) << 4) ^ xq));
          float qn = 0.f;
#pragma unroll
          for (int e = 0; e < 4; ++e) { qn = fmaf(s2f(c0[e]), nA[e], qn); qn = fmaf(s2f(c0[4 + e]), nC[e], qn); qn = fmaf(s2f(c1[e]), nB[e], qn); qn = fmaf(s2f(c1[4 + e]), nD[e], qn); }
          QNP[wid * 64 + t] = qn; }
        f32x16 Y0, Y1;
        { ML_OPAQUE_LANE(ln); const unsigned r31 = ln & 31u, h5 = ln >> 5; const unsigned xq = fxor(r31) << 4; ML_LAS unsigned char* q0 = bQ + 256u * r31; ML_LAS unsigned char* q1 = q0 + 256u * 32u;
#pragma unroll
          for (int i = 0; i < 4; ++i) { C[i] = C[i] * sc;
#pragma unroll
              for (int s = 0; s < 2; ++s) { const bf16x8 bfr = pack8(C[i][8 * s + 0], C[i][8 * s + 1], C[i][8 * s + 2], C[i][8 * s + 3], C[i][8 * s + 4], C[i][8 * s + 5], C[i][8 * s + 6], C[i][8 * s + 7]);
                  const unsigned co = ((4u * i + 2u * s + h5) << 4) ^ xq;
                  const bf16x8 a0 = *(const ML_LAS bf16x8*)(q0 + co), a1 = *(const ML_LAS bf16x8*)(q1 + co);
                  if (i == 0 && s == 0) { Y0 = __builtin_amdgcn_mfma_f32_32x32x16_bf16(a0, bfr, (f32x16){0.f}, 0, 0, 0); Y1 = __builtin_amdgcn_mfma_f32_32x32x16_bf16(a1, bfr, (f32x16){0.f}, 0, 0, 0); }
                  else { Y0 = __builtin_amdgcn_mfma_f32_32x32x16_bf16(a0, bfr, Y0, 0, 0, 0); Y1 = __builtin_amdgcn_mfma_f32_32x32x16_bf16(a1, bfr, Y1, 0, 0, 0); } } } }
        bf16x8 vw[4];
        { ML_OPAQUE_LANE(ln); const unsigned h5 = ln >> 5, kg = ln >> 4; const unsigned vt = wid >> 2, vc = wid & 3; bf16x8 vf[4];
          ML_LAS unsigned char* v0 = bV + 16384u * vt + ((64u * vc) ^ trX); ML_LAS unsigned char* va = v0 + trL0; ML_LAS unsigned char* vb = v0 + trL1;
#pragma unroll
          for (int ks = 0; ks < 4; ++ks) vf[ks] = cat8(trrd(va + 4096 * ks), trrd(vb + 4096 * ks));
          ML_LAS float* vwe = VWE + 8 * h5;
#pragma unroll
          for (int ks = 0; ks < 4; ++ks) { const f32x4 w0 = *(const ML_LAS f32x4*)(vwe + 16 * ks), w1 = *(const ML_LAS f32x4*)(vwe + 16 * ks + 4);
              vw[ks] = pack8(s2f(vf[ks][0]) * w0[0], s2f(vf[ks][1]) * w0[1], s2f(vf[ks][2]) * w0[2], s2f(vf[ks][3]) * w0[3], s2f(vf[ks][4]) * w1[0], s2f(vf[ks][5]) * w1[1], s2f(vf[ks][6]) * w1[2], s2f(vf[ks][7]) * w1[3]); }
          ML_LAS unsigned char* ka = bK + trL0; ML_LAS unsigned char* kb = bK + trL1;
#pragma unroll
          for (int i = 0; i < 4; ++i) { const unsigned xo = (64u * i) ^ trX;
#pragma unroll
              for (int ks = 0; ks < 4; ++ks) C[i] = __builtin_amdgcn_mfma_f32_32x32x16_bf16(cat8(trrd(ka + xo + 4096 * ks), trrd(kb + xo + 4096 * ks)), vw[ks], C[i], 0, 0, 0); }
          ML_LAS unsigned char* t16a = bK + tr_addr16(ln, wid, 0, 0); ML_LAS unsigned char* t16b = bK + tr_addr16(ln, wid, 0, 1);
#pragma unroll
          for (int ks = 0; ks < 2; ++ks) { const bf16x8 af = cat8(trrd(t16a + 8192 * ks), trrd(t16b + 8192 * ks));
              const f32x4 w0 = *(const ML_LAS f32x4*)(VWE + 32 * ks + 8 * kg), w1 = *(const ML_LAS f32x4*)(VWE + 32 * ks + 8 * kg + 4);
              n4 = __builtin_amdgcn_mfma_f32_16x16x32_bf16(af, pack8(w0[0], w0[1], w0[2], w0[3], w1[0], w1[1], w1[2], w1[3]), n4, 0, 0, 0); } }
        asm volatile("s_waitcnt lgkmcnt(0)" ::: "memory"); __builtin_amdgcn_s_barrier(); asm volatile("" ::: "memory");
        { ML_OPAQUE_LANE(ln); const unsigned r31 = ln & 31u, h5 = ln >> 5;
          ML_LAS unsigned char* p0 = lds + P_OFF + 128u * r31; ML_LAS unsigned char* p1 = p0 + 128u * 32u; const unsigned xp = (r31 & 7u) << 4;
#pragma unroll
          for (int ks = 0; ks < 4; ++ks) { const unsigned co = ((2u * ks + h5) << 4) ^ xp;
              const bf16x8 a0 = *(const ML_LAS bf16x8*)(p0 + co), a1 = *(const ML_LAS bf16x8*)(p1 + co);
              Y0 = __builtin_amdgcn_mfma_f32_32x32x16_bf16(a0, vw[ks], Y0, 0, 0, 0); Y1 = __builtin_amdgcn_mfma_f32_32x32x16_bf16(a1, vw[ks], Y1, 0, 0, 0); } }
        { ML_OPAQUE_LANE(ln); const unsigned t = ln; float qs = 0.f;
#pragma unroll
          for (int w8 = 0; w8 < 8; ++w8) qs += QNP[w8 * 64 + t];
          const float dn = DENP[t] + DENP[64 + t] + qs; VR[t] = 1.f / fmaxf(fabsf(dn), VEMT[t]); }
        { ML_OPAQUE_LANE(ln); const unsigned h5 = ln >> 5; ML_LAS float* vr = VR + 4 * h5;
#pragma unroll
          for (int qp = 0; qp < 2; ++qp) { const f32x4 ra = *(const ML_LAS f32x4*)(vr + 16 * qp), rb = *(const ML_LAS f32x4*)(vr + 16 * qp + 8), rc = *(const ML_LAS f32x4*)(vr + 32 + 16 * qp), rd = *(const ML_LAS f32x4*)(vr + 32 + 16 * qp + 8);
              const int o = 8 * qp;
              const u32x4 w0 = {pkbf(Y0[o + 0] * ra[0], Y0[o + 1] * ra[1]), pkbf(Y0[o + 2] * ra[2], Y0[o + 3] * ra[3]), pkbf(Y0[o + 4] * rb[0], Y0[o + 5] * rb[1]), pkbf(Y0[o + 6] * rb[2], Y0[o + 7] * rb[3])};
              const u32x4 w1 = {pkbf(Y1[o + 0] * rc[0], Y1[o + 1] * rc[1]), pkbf(Y1[o + 2] * rc[2], Y1[o + 3] * rc[3]), pkbf(Y1[o + 4] * rd[0], Y1[o + 5] * rd[1]), pkbf(Y1[o + 6] * rd[2], Y1[o + 7] * rd[3])};
              pend[qp] = w0; pend[2 + qp] = w1; } }
        asm volatile("" : "+v"(gi_b), "+v"(gf_b));
        sc = sc_n; gi_a = gi_b; gf_a = gf_b;
    }
    { unsigned char* hc = ho + (size_t)(SEQ / 64 - 1) * 32768; *(u32x4*)(hc) = pend[0]; *(u32x4*)(hc + 1024) = pend[1]; *(u32x4*)(hc + 2048) = pend[2]; *(u32x4*)(hc + 3072) = pend[3]; }
#undef ML_STAGE
#undef ML_GATES
#undef ML_VEC
#undef ML_TB
    __syncthreads();
}
}

constexpr int NWAVES = 8;
constexpr int RING_BYTES = 131072;
constexpr int LDS_BYTES = 163840;
constexpr int XCH_OFF = RING_BYTES, ROPE_LDS_OFF = XCH_OFF + 8192, QKG_LDS_OFF = ROPE_LDS_OFF + 16384, SCL_LDS_OFF = QKG_LDS_OFF + 1024;
static_assert(SCL_LDS_OFF + 4096 <= LDS_BYTES - 16, "in-projection LDS map");
static_assert(ml::LDS_END <= LDS_BYTES, "mLSTM LDS map");
#define LAS __attribute__((address_space(3)))
#define GAS __attribute__((address_space(1)))
typedef unsigned v4u __attribute__((ext_vector_type(4)));
typedef unsigned v2u __attribute__((ext_vector_type(2)));
typedef float f32x4 __attribute__((ext_vector_type(4)));
#define LDS_WAIT() asm volatile("s_waitcnt lgkmcnt(0)" ::: "memory")

struct Args { const float* in[9]; float* out; unsigned char* ws; int ph_lo, ph_hi; };

__device__ __forceinline__ float wave_sum(float v) {
#pragma unroll
    for (int o = 1; o < 64; o <<= 1) v += __shfl_xor(v, o);
    return v;
}

#define XB_TMO      128
#define XB_XCNT(j)  (256  + 64 * (j))
#define XB_XSUB(j)  (1280 + 64 * (j))
#define XB_XGEN(j)  (2304 + 64 * (j))
#define XB_TOP      3328
#define XB_TOPGEN   3392
#define XCD_BAR_WORDS 3456
#define XB_SPIN_CAP (1u << 18)

__device__ __forceinline__ unsigned xb_ld(unsigned* p)              { return __hip_atomic_load(p, __ATOMIC_RELAXED, __HIP_MEMORY_SCOPE_AGENT); }
__device__ __forceinline__ unsigned xb_add(unsigned* p, unsigned v) { return __hip_atomic_fetch_add(p, v, __ATOMIC_RELAXED, __HIP_MEMORY_SCOPE_AGENT); }
__device__ __forceinline__ unsigned xb_xcc_id() { return (unsigned)__builtin_amdgcn_s_getreg((3 << 11) | 20) & 0xFu; }
#define XB_SPIN(cond, bar) do { unsigned _sp = 0; while (cond) { __builtin_amdgcn_s_sleep(1); \
    if ((++_sp & 255u) == 0u) { if (xb_ld(&(bar)[XB_TMO])) break; if (_sp > XB_SPIN_CAP) { atomicAdd(&(bar)[XB_TMO], 1u); break; } } } } while (0)

struct XcdBarrier {
    unsigned* bar; unsigned x;
    volatile LAS unsigned* st;
};

__device__ __forceinline__ XcdBarrier xcd_barrier_post(unsigned* bar, volatile LAS unsigned* st) {
    XcdBarrier b; b.bar = bar; b.x = xb_xcc_id(); b.st = st;
    if (threadIdx.x == 0) (void)xb_add(&bar[XB_XCNT(b.x)], 1u);
    return b;
}
__device__ __forceinline__ void xcd_barrier_complete(unsigned* bar, unsigned x, unsigned& nloc, unsigned& nx) {
    const unsigned G = gridDim.x * gridDim.y * gridDim.z;
    unsigned sum, cnt, mine, sp = 0u;
    for (;;) {
        sum = 0u; cnt = 0u; mine = 0u;
#pragma unroll
        for (unsigned j = 0; j < 16; ++j) { const unsigned c = xb_ld(&bar[XB_XCNT(j)]); sum += c; cnt += (c > 0u) ? 1u : 0u; mine = (j == x) ? c : mine; }
        if (sum == G) break;
        __builtin_amdgcn_s_sleep(1);
        if ((++sp & 255u) == 0u) { if (xb_ld(&bar[XB_TMO])) break; if (sp > XB_SPIN_CAP) { atomicAdd(&bar[XB_TMO], 1u); break; } }
    }
    nloc = mine > 0u ? mine : 1u; nx = cnt > 0u ? cnt : 1u;
}

__device__ __forceinline__ void xcd_barrier(const XcdBarrier& b) {
    asm volatile("s_waitcnt vmcnt(0)" ::: "memory");
    __syncthreads();
    if (threadIdx.x == 0) {
        unsigned* bar = b.bar;
        __builtin_amdgcn_s_waitcnt(0);
        unsigned nloc = b.st[0], nx = b.st[1];
        if (nloc == 0u) { xcd_barrier_complete(bar, b.x, nloc, nx); b.st[0] = nloc; b.st[1] = nx; }
        const unsigned old = xb_add(&bar[XB_XSUB(b.x)], 1u);
        const unsigned gen = old / nloc;
        if (old + 1u == (gen + 1u) * nloc) {
            __builtin_amdgcn_fence(__ATOMIC_RELEASE, "agent");
            asm volatile("s_waitcnt vmcnt(0)" ::: "memory");
            const unsigned og = xb_add(&bar[XB_TOP], 1u);
            const unsigned tg = og / nx;
            if (og + 1u == (tg + 1u) * nx) xb_add(&bar[XB_TOPGEN], 1u);
            else XB_SPIN(xb_ld(&bar[XB_TOPGEN]) == tg, bar);
            __builtin_amdgcn_fence(__ATOMIC_ACQUIRE, "agent");
            xb_add(&bar[XB_XGEN(b.x)], 1u);
            asm volatile("s_waitcnt vmcnt(0)" ::: "memory");
        } else {
            XB_SPIN(xb_ld(&bar[XB_XGEN(b.x)]) == gen, bar);
            __builtin_amdgcn_fence(__ATOMIC_ACQUIRE, "agent");
            asm volatile("s_waitcnt vmcnt(0)" ::: "memory");
        }
    }
    __syncthreads();
}

__device__ __forceinline__ int w1_dest_row(int n) {
    if (!HY_SEPARATE_ROPE && n < 1280) { const int s = n & 255; return (n & ~255) | (s & 0xC3) | ((s & 0x10) << 1) | ((s & 0x0C) << 1) | ((s & 0x20) >> 3); }
    if (n >= 2560 && n < 3072) return (n & ~12) | ((n & 4) << 1) | ((n & 8) >> 1);
    return n;
}
__device__ __forceinline__ int q8_dest_row(int n) { return n < NQA ? w1_dest_row(n) : n - (NB1 - NB0); }
__device__ __forceinline__ unsigned pk4i8(float a, float b, float c, float d) {
    int ia = (int)__builtin_rintf(a), ib = (int)__builtin_rintf(b), ic = (int)__builtin_rintf(c), id = (int)__builtin_rintf(d);
    ia = ia < -127 ? -127 : (ia > 127 ? 127 : ia); ib = ib < -127 ? -127 : (ib > 127 ? 127 : ib); ic = ic < -127 ? -127 : (ic > 127 ? 127 : ic); id = id < -127 ? -127 : (id > 127 ? 127 : id);
    return ((unsigned)ia & 0xffu) | (((unsigned)ib & 0xffu) << 8) | (((unsigned)ic & 0xffu) << 16) | ((unsigned)id << 24); }
template <int MODE>
__device__ __forceinline__ void p0_transpose_item(const float* W, int K, int ldw, int kb, int n0, void* WT, LAS float* scr, int lane, const LAS float* cinv) {
    const int k0 = 64 * kb;
#pragma unroll 8
    for (int i = 0; i < 32; ++i) { const int kk = 2 * i + (lane >> 5); scr[kk * 33 + (lane & 31)] = W[(size_t)(k0 + kk) * ldw + n0 + (lane & 31)]; }
    LDS_WAIT(); asm volatile("" ::: "memory");
    const int c = lane & 7;
#pragma unroll
    for (int j = 0; j < 4; ++j) { const int n = (lane >> 3) + 8 * j; const LAS float* s = scr + (8 * c) * 33 + n;
        if constexpr (MODE == 2) { const float ci = cinv[n];
            v2u o8; o8.x = pk4i8(s[0 * 33] * ci, s[1 * 33] * ci, s[2 * 33] * ci, s[3 * 33] * ci); o8.y = pk4i8(s[4 * 33] * ci, s[5 * 33] * ci, s[6 * 33] * ci, s[7 * 33] * ci);
            *(v2u*)((unsigned char*)WT + (size_t)q8_dest_row(n0 + n) * K + k0 + 8 * c) = o8; }
        else if constexpr (MODE == 3) { unsigned char* rowp = (unsigned char*)WT + (size_t)(n0 + n) * 4096;
            if (kb < 16) { v2u o8; o8.x = pk4f8(s[0 * 33] * W8_SCALE, s[1 * 33] * W8_SCALE, s[2 * 33] * W8_SCALE, s[3 * 33] * W8_SCALE); o8.y = pk4f8(s[4 * 33] * W8_SCALE, s[5 * 33] * W8_SCALE, s[6 * 33] * W8_SCALE, s[7 * 33] * W8_SCALE);
                *(v2u*)(rowp + k0 + 8 * c) = o8; }
            else { v4u o; o.x = pk2(s[0 * 33], s[1 * 33]); o.y = pk2(s[2 * 33], s[3 * 33]); o.z = pk2(s[4 * 33], s[5 * 33]); o.w = pk2(s[6 * 33], s[7 * 33]);
                *(v4u*)(rowp + 1024 + (size_t)(k0 - 1024 + 8 * c) * 2) = o; } }
        else { const float ws_ = (MODE == 1 && n0 + n < 3072) ? 0.08838834764831845f : 1.f;
            v4u o; o.x = pk2(s[0 * 33] * ws_, s[1 * 33] * ws_); o.y = pk2(s[2 * 33] * ws_, s[3 * 33] * ws_); o.z = pk2(s[4 * 33] * ws_, s[5 * 33] * ws_); o.w = pk2(s[6 * 33] * ws_, s[7 * 33] * ws_);
            const int nr = (MODE == 1) ? w1_dest_row(n0 + n) - NB0 : n0 + n;
            *(v4u*)((bf16*)WT + (size_t)nr * K + k0 + 8 * c) = o; } }
    LDS_WAIT(); asm volatile("" ::: "memory");
}
__device__ __forceinline__ void p0_q8_colblock(const float* w_in, unsigned char* ws, LAS unsigned char* lds, int cb, int tid, int wave, int lane) {
    const int n0 = cb < NQA / 32 ? 32 * cb : NB1 + 32 * (cb - NQA / 32);
    LAS float* red = (LAS float*)(lds + 8 * 16384);
    const int c4 = (lane & 7) * 4, kr = lane >> 3;
    const float* src = w_in + (size_t)(256 * wave + kr) * NPROJ + n0 + c4;
    f32x4 mx = {0.f, 0.f, 0.f, 0.f};
#pragma unroll 8
    for (int i = 0; i < 32; ++i) { const f32x4 v = *(const f32x4*)(src + (size_t)(8 * i) * NPROJ);
        mx.x = fmaxf(mx.x, fabsf(v.x)); mx.y = fmaxf(mx.y, fabsf(v.y)); mx.z = fmaxf(mx.z, fabsf(v.z)); mx.w = fmaxf(mx.w, fabsf(v.w)); }
#pragma unroll
    for (int o = 8; o < 64; o <<= 1) { mx.x = fmaxf(mx.x, __shfl_xor(mx.x, o)); mx.y = fmaxf(mx.y, __shfl_xor(mx.y, o)); mx.z = fmaxf(mx.z, __shfl_xor(mx.z, o)); mx.w = fmaxf(mx.w, __shfl_xor(mx.w, o)); }
    if (lane < 8) *(LAS f32x4*)(red + wave * 32 + c4) = mx;
    __syncthreads();
    if (tid < 32) { float m = red[tid];
#pragma unroll
        for (int w = 1; w < 8; ++w) m = fmaxf(m, red[w * 32 + tid]);
        m = fmaxf(m, 1e-30f); red[256 + tid] = 127.f / m; ((float*)(ws + WS_SW))[q8_dest_row(n0 + tid)] = m * (1.f / 127.f); }
    __syncthreads();
    LAS float* scr = (LAS float*)(lds + wave * 16384);
    for (int i = 0; i < 4; ++i) p0_transpose_item<2>(w_in, DM, NPROJ, 4 * wave + i, n0, ws + WS_W8T, scr, lane, red + 256);
    __syncthreads();
}
__device__ __forceinline__ float wave_max(float v) {
#pragma unroll
    for (int o = 1; o < 64; o <<= 1) v = fmaxf(v, __shfl_xor(v, o));
    return v;
}
__device__ __forceinline__ void rms_rows2_to_bf16(const float* xrow0, const float* xrow1, const float* g, bf16* orow0, bf16* orow1, unsigned char* frow0, unsigned char* frow1, float* sa0, float* sa1, int lane) {
    const f32x4* xa = (const f32x4*)xrow0 + lane; const f32x4* xb = (const f32x4*)xrow1 + lane; const f32x4* gr = (const f32x4*)g + lane;
    f32x4 v[8], w[8]; float s = 0.f, t = 0.f;
#pragma unroll
    for (int j = 0; j < 8; ++j) { v[j] = __builtin_nontemporal_load(xa + 64 * j); w[j] = __builtin_nontemporal_load(xb + 64 * j); }
#pragma unroll
    for (int j = 0; j < 8; ++j) { s += (v[j].x * v[j].x + v[j].y * v[j].y) + (v[j].z * v[j].z + v[j].w * v[j].w); t += (w[j].x * w[j].x + w[j].y * w[j].y) + (w[j].z * w[j].z + w[j].w * w[j].w); }
    const float r0 = 1.f / sqrtf(wave_sum(s) * (1.f / DM) + EPS), r1 = 1.f / sqrtf(wave_sum(t) * (1.f / DM) + EPS);
    float m0 = 0.f, m1 = 0.f;
#pragma unroll
    for (int j = 0; j < 8; ++j) { const f32x4 gg = gr[64 * j]; v[j] = v[j] * r0 * gg; w[j] = w[j] * r1 * gg;
        m0 = fmaxf(fmaxf(m0, fmaxf(fabsf(v[j].x), fabsf(v[j].y))), fmaxf(fabsf(v[j].z), fabsf(v[j].w))); m1 = fmaxf(fmaxf(m1, fmaxf(fabsf(w[j].x), fabsf(w[j].y))), fmaxf(fabsf(w[j].z), fabsf(w[j].w))); }
    m0 = fmaxf(wave_max(m0), 1e-30f); m1 = fmaxf(wave_max(m1), 1e-30f);
    const float i0 = 127.f / m0, i1 = 127.f / m1;
    if (lane == 0) { *sa0 = m0 * (1.f / 127.f); *sa1 = m1 * (1.f / 127.f); }
    v2u* o0 = (v2u*)orow0 + lane; v2u* o1 = (v2u*)orow1 + lane; unsigned* f0 = (unsigned*)frow0 + lane; unsigned* f1 = (unsigned*)frow1 + lane;
#pragma unroll
    for (int j = 0; j < 8; ++j) { v2u a, b;
        a.x = pk2(v[j].x, v[j].y); a.y = pk2(v[j].z, v[j].w); o0[64 * j] = a; f0[64 * j] = pk4i8(v[j].x * i0, v[j].y * i0, v[j].z * i0, v[j].w * i0);
        b.x = pk2(w[j].x, w[j].y); b.y = pk2(w[j].z, w[j].w); o1[64 * j] = b; f1[64 * j] = pk4i8(w[j].x * i1, w[j].y * i1, w[j].z * i1, w[j].w * i1); }
}
__device__ __forceinline__ void p0_prologue(const Args& a, LAS unsigned char* lds, int vcu, int G, int tid, int wave, int lane) {
    unsigned char* ws = a.ws;
    const float* w_in = a.in[3]; const float* w_out = a.in[8]; const float* norm_g = a.in[2];
    bf16* W2t = (bf16*)(ws + WS_W2T);
    const int gw = vcu * NWAVES + wave, NGW = G * NWAVES; const int gt = vcu * (NWAVES * 64) + tid, NGT = G * NWAVES * 64;
    for (int e = gt; e < 64 * 32; e += NGT) { const int pos = e >> 5, j = e & 31; const float inv = 1.0f / powf(10000.0f, (float)j * (1.0f / 32.0f)); const float ang = (float)pos * inv;
        float* R = (float*)(ws + WS_ROPE); R[2 * e] = cosf(ang); R[2 * e + 1] = sinf(ang); }
    for (int e = gt; e < 16 * DM; e += NGT) { const int g = e >> 11, k = e & (DM - 1); ((bf16*)(ws + WS_WGT))[(size_t)g * DM + k] = (bf16)f2bf(w_in[(size_t)k * NPROJ + NP256 + g]); }
    for (int cb = vcu; cb < NQ8 / 32; cb += G) p0_q8_colblock(w_in, ws, lds, cb, tid, wave, lane);
    LAS float* scr = (LAS float*)(lds + wave * 16384);
    constexpr int I_1 = (DM / 64) * ((NB1 - NB0) / 32), I_2 = (DM / 64) * (DM / 32);
    for (int it = gw; it < I_1 + I_2; it += NGW) {
        if (it < I_1) p0_transpose_item<1>(w_in, DM, NPROJ, it / ((NB1 - NB0) / 32), NB0 + 32 * (it % ((NB1 - NB0) / 32)), ws + WS_W1B, scr, lane, nullptr);
        else p0_transpose_item<3>(w_out, DM, DM, (it - I_1) / (DM / 32), 32 * ((it - I_1) % (DM / 32)), W2t, scr, lane, nullptr);
    }
    bf16* H = (bf16*)(ws + WS_H); unsigned char* H8 = (unsigned char*)a.out; float* SA = (float*)(ws + WS_SA);
    for (int m = gw; m < NTOK; m += 2 * NGW) { const int m1 = (m + NGW < NTOK) ? m + NGW : m;
        const float* xr0 = (m < TOK_PROMPT) ? a.in[0] + (size_t)m * DM : a.in[1] + (size_t)(m - TOK_PROMPT) * DM; const float* xr1 = (m1 < TOK_PROMPT) ? a.in[0] + (size_t)m1 * DM : a.in[1] + (size_t)(m1 - TOK_PROMPT) * DM;
        rms_rows2_to_bf16(xr0, xr1, norm_g, H + (size_t)m * DM, H + (size_t)m1 * DM, H8 + (size_t)m * DM, H8 + (size_t)m1 * DM, SA + m, SA + m1, lane); }
}

__device__ __forceinline__ void p2_qknorm_rope(const Args& a, int vcu, int G, int wave, int lane) {
    unsigned char* ws = a.ws; const float* R = (const float*)(ws + WS_ROPE);
    const int gw = vcu * NWAVES + wave, NGW = G * NWAVES;
    const int fj = lane & 31, c0 = (lane < 32) ? lane : 64 + (lane - 32), c1 = c0 + 32;
    const float gq0 = a.in[5][c0], gq1 = a.in[5][c1], gk0 = a.in[6][c0], gk1 = a.in[6][c1];
    for (int it = gw; it < NTOK * 10; it += NGW) {
        const int t = it / 10, slot = it - t * 10; const int tl = t & (SEQ - 1); const int pos = (lane < 32) ? (tl >> 6) : (tl & 63);
        bf16* p = (slot < 8) ? (bf16*)((unsigned char*)a.out + DO_Q) + (size_t)t * 1024 + slot * 128 : (bf16*)(ws + WS_AK) + (size_t)t * 256 + (slot - 8) * 128;
        const float x0 = bf2f(p[c0]), x1 = bf2f(p[c1]);
        const float r = 1.f / sqrtf(wave_sum(x0 * x0 + x1 * x1) * (1.f / 128.f) + EPS);
        const float y0 = x0 * r * ((slot < 8) ? gq0 : gk0), y1 = x1 * r * ((slot < 8) ? gq1 : gk1);
        const float cs = R[2 * (pos * 32 + fj)], sn = R[2 * (pos * 32 + fj) + 1];
        p[c0] = (bf16)f2bf(y0 * cs - y1 * sn); p[c1] = (bf16)f2bf(y1 * cs + y0 * sn);
    }
}

__device__ __forceinline__ void p4_mlstm_recurrent(const Args& a, LAS unsigned char* lds, int vcu, int G, int tid) {
    unsigned char* ws = a.ws;
    const bf16* MQ = (const bf16*)(ws + WS_MQ); const bf16* MK = (const bf16*)(ws + WS_MK); const bf16* MV = (const bf16*)(ws + WS_MV); const float* GT = (const float*)(ws + WS_GATES);
    LAS float* qs = (LAS float*)lds;
    LAS float* ks = qs + 32 * 128;
    LAS float* vs = ks + 32 * 128;
    LAS float* gi = vs + 32 * 256;
    LAS float* gf = gi + 32;
    const int dv = tid >> 1, half = tid & 1;
    for (int item = vcu; item < NSEQ * 8; item += G) {
        const int b = item >> 3, hd = (item >> 1) & 3, dir = item & 1;
        bf16* HO = (bf16*)(ws + (dir ? WS_HB : WS_HF));
        float C[64], nn[64]; float m = 0.f;
#pragma unroll
        for (int j = 0; j < 64; ++j) { C[j] = 0.f; nn[j] = 0.f; }
        for (int p0 = 0; p0 < SEQ; p0 += 32) {
            __syncthreads();
            { const int rr = tid >> 4, c8 = (tid & 15) * 8; const int tok = dir ? (SEQ - 1 - (p0 + rr)) : (p0 + rr); const size_t row = (size_t)b * SEQ + tok;
              const v4u q4 = *(const v4u*)(MQ + row * 512 + hd * 128 + c8), k4 = *(const v4u*)(MK + row * 512 + hd * 128 + c8);
              LAS float* kd = ks + rr * 128 + c8;
              { LAS float* qa = qs + rr * 128 + (c8 & ~8) + ((c8 & 8) >> 1);   qa[0] = bflo(q4.x); qa[1] = bfhi(q4.x); qa[2] = bflo(q4.y); qa[3] = bfhi(q4.y); qa[8] = bflo(q4.z); qa[9] = bfhi(q4.z); qa[10] = bflo(q4.w); qa[11] = bfhi(q4.w); }
              kd[0] = bflo(k4.x); kd[1] = bfhi(k4.x); kd[2] = bflo(k4.y); kd[3] = bfhi(k4.y); kd[4] = bflo(k4.z); kd[5] = bfhi(k4.z); kd[6] = bflo(k4.w); kd[7] = bfhi(k4.w);
              const int c16 = (tid & 15) * 16; LAS float* vd = vs + rr * 256 + c16;
#pragma unroll
              for (int h2 = 0; h2 < 2; ++h2) { const v4u v4 = *(const v4u*)(MV + row * 1024 + hd * 256 + c16 + 8 * h2);
                  vd[8 * h2 + 0] = bflo(v4.x); vd[8 * h2 + 1] = bfhi(v4.x); vd[8 * h2 + 2] = bflo(v4.y); vd[8 * h2 + 3] = bfhi(v4.y); vd[8 * h2 + 4] = bflo(v4.z); vd[8 * h2 + 5] = bfhi(v4.z); vd[8 * h2 + 6] = bflo(v4.w); vd[8 * h2 + 7] = bfhi(v4.w); }
              if (tid < 32) { const int tk = dir ? (SEQ - 1 - (p0 + tid)) : (p0 + tid); const size_t rw = (size_t)b * SEQ + tk; gi[tid] = GT[rw * 16 + dir * 8 + hd]; gf[tid] = GT[rw * 16 + dir * 8 + 4 + hd]; }
            }
            __syncthreads();
            for (int pp = 0; pp < 32; ++pp) {
                const float lf = gf[pp], ii = gi[pp];
                const float mn = fmaxf(lf + m, ii);
                const float ca = expf(lf + m - mn), cb = expf(ii - mn);
                const float bv = cb * vs[pp * 256 + dv];
                float hp = 0.f, qn = 0.f;
                const LAS float* kr = ks + pp * 128 + 64 * half; const LAS float* qr = qs + pp * 128 + 64 * half;
#pragma unroll
                for (int j = 0; j < 64; ++j) { const float kk = kr[j], qq = qr[j];
                    C[j] = fmaf(ca, C[j], kk * bv); nn[j] = fmaf(ca, nn[j], cb * kk); hp = fmaf(qq, C[j], hp); qn = fmaf(qq, nn[j], qn); }
                hp += __shfl_xor(hp, 1); qn += __shfl_xor(qn, 1);
                const float den = fmaxf(fabsf(qn), expf(-mn));
                if (half == 0) { const int pos = p0 + pp, cch = pos >> 6, o = pos & 63, tt = o >> 5, rho = o & 31, q = rho >> 3, hh = (rho >> 2) & 1, e = rho & 3;
                    HO[(((size_t)((b * 4 + hd) * 32 + cch) * 32768) + (dv >> 5) * 4096 + tt * 2048 + (q >> 1) * 1024 + (32 * hh + (dv & 31)) * 16) / 2 + 4 * (q & 1) + e] = (bf16)f2bf(hp / den); }
                m = mn;
            }
        }
    }
}

__device__ __forceinline__ void p5_mlstm_finalize(const Args& a, LAS unsigned char* lds, int vcu, int G, int tid, int wave, int lane) {
    unsigned char* ws = a.ws; const float* mg = a.in[7];
    const bf16* MO = (const bf16*)(ws + WS_MO); const bf16* MZ = (const bf16*)(ws + WS_MZ); bf16* MIX = (bf16*)(ws + WS_MIX);
    LAS float* XS = (LAS float*)lds;
    const int r31 = lane & 31, h5 = lane >> 5, dv0 = 8 * r31;
    constexpr int NIT = NSEQ * 4 * 32;
    v4u f[2][2], bb[2][2];
#define P5_LOAD_H(item_) do { const int bh_ = (item_) >> 5, ck_ = (item_) & 31; \
        const unsigned char* hf_ = ws + WS_HF + ((size_t)bh_ * 32 + ck_) * 32768 + wave * 4096 + lane * 16; const unsigned char* hb_ = ws + WS_HB + ((size_t)bh_ * 32 + (31 - ck_)) * 32768 + wave * 4096 + (lane ^ 32) * 16; \
        _Pragma("unroll") for (int tt = 0; tt < 2; ++tt) _Pragma("unroll") for (int qp = 0; qp < 2; ++qp) { f[tt][qp] = *(const v4u*)(hf_ + tt * 2048 + qp * 1024); bb[tt][qp] = *(const v4u*)(hb_ + (1 - tt) * 2048 + (1 - qp) * 1024); } } while (0)
    if (vcu < NIT) P5_LOAD_H(vcu);
    for (int item = vcu; item < NIT; item += G) {
        const int bh = item >> 5, ck = item & 31, b = bh >> 2, hd = bh & 3;
        v4u mo[4], mz[4];
#pragma unroll
        for (int it = 0; it < 4; ++it) { const int o = it * 16 + wave * 2 + h5; const size_t row = (size_t)b * SEQ + ck * 64 + o;
            mo[it] = *(const v4u*)(MO + row * 1024 + hd * 256 + dv0); mz[it] = *(const v4u*)(MZ + row * 1024 + hd * 256 + dv0); }
        __syncthreads();
#pragma unroll
        for (int tt = 0; tt < 2; ++tt)
#pragma unroll
            for (int qp = 0; qp < 2; ++qp) { const v4u fv = f[tt][qp], bv = bb[tt][qp];
                float fs[8] = {bflo(fv.x), bfhi(fv.x), bflo(fv.y), bfhi(fv.y), bflo(fv.z), bfhi(fv.z), bflo(fv.w), bfhi(fv.w)};
                float bs[8] = {bflo(bv.x), bfhi(bv.x), bflo(bv.y), bfhi(bv.y), bflo(bv.z), bfhi(bv.z), bflo(bv.w), bfhi(bv.w)};
#pragma unroll
                for (int j = 0; j < 8; ++j) { const int o = 32 * tt + 8 * (2 * qp + (j >> 2)) + 4 * h5 + (j & 3); XS[o * 256 + 32 * wave + r31] = fs[j] + bs[7 - j]; } }
        __syncthreads();
        if (item + G < NIT) P5_LOAD_H(item + G);
        const f32x4 g0 = *(const f32x4*)(mg + hd * 256 + dv0), g1 = *(const f32x4*)(mg + hd * 256 + dv0 + 4);
        const float gg[8] = {g0[0], g0[1], g0[2], g0[3], g1[0], g1[1], g1[2], g1[3]};
#pragma unroll
        for (int it = 0; it < 4; ++it) { const int o = it * 16 + wave * 2 + h5; const size_t row = (size_t)b * SEQ + ck * 64 + o;
            const f32x4 x0 = *(const LAS f32x4*)(XS + o * 256 + dv0), x1 = *(const LAS f32x4*)(XS + o * 256 + dv0 + 4);
            float hm[8] = {x0[0], x0[1], x0[2], x0[3], x1[0], x1[1], x1[2], x1[3]};
            const float mo8[8] = {bflo(mo[it].x), bfhi(mo[it].x), bflo(mo[it].y), bfhi(mo[it].y), bflo(mo[it].z), bfhi(mo[it].z), bflo(mo[it].w), bfhi(mo[it].w)};
            const float mz8[8] = {bflo(mz[it].x), bfhi(mz[it].x), bflo(mz[it].y), bfhi(mz[it].y), bflo(mz[it].z), bfhi(mz[it].z), bflo(mz[it].w), bfhi(mz[it].w)};
            float ss = 0.f;
#pragma unroll
            for (int j = 0; j < 8; ++j) { hm[j] = hm[j] * __builtin_amdgcn_rcpf(1.f + __expf(-mo8[j])); ss += hm[j] * hm[j]; }
#pragma unroll
            for (int s = 1; s < 32; s <<= 1) ss += __shfl_xor(ss, s);
            const float r = __builtin_amdgcn_rsqf(ss * (1.f / 256.f) + EPS);
            float ov[8];
#pragma unroll
            for (int j = 0; j < 8; ++j) ov[j] = hm[j] * r * gg[j] * (mz8[j] * __builtin_amdgcn_rcpf(1.f + __expf(-mz8[j])));
            v4u w; w.x = pk2(ov[0], ov[1]); w.y = pk2(ov[2], ov[3]); w.z = pk2(ov[4], ov[5]); w.w = pk2(ov[6], ov[7]);
            *(v4u*)(MIX + row * 2048 + 512 + hd * 256 + dv0) = w; }
    }
#undef P5_LOAD_H
    __syncthreads();
}

__device__ __forceinline__ void p5_item(const Args& a, LAS unsigned char* lds, int item) {
    int tid_ = threadIdx.x; asm volatile("" : "+v"(tid_));
    const int lane = tid_ & 63, wave = __builtin_amdgcn_readfirstlane(tid_ >> 6);
    unsigned char* ws = a.ws; const float* mg = a.in[7];
    const bf16* MO = (const bf16*)(ws + WS_MO); const bf16* MZ = (const bf16*)(ws + WS_MZ); bf16* MIX = (bf16*)(ws + WS_MIX);
    LAS float* XS = (LAS float*)lds; const int r31 = lane & 31, h5 = lane >> 5, dv0 = 8 * r31;
    const int bh = item >> 5, ck = item & 31, b = bh >> 2, hd = bh & 3;
    const unsigned char* hf_ = ws + WS_HF + ((size_t)bh * 32 + ck) * 32768 + wave * 4096 + lane * 16; const unsigned char* hb_ = ws + WS_HB + ((size_t)bh * 32 + (31 - ck)) * 32768 + wave * 4096 + (lane ^ 32) * 16;
    v4u f[2][2], bb[2][2], mo[4], mz[4];
#pragma unroll
    for (int tt = 0; tt < 2; ++tt)
#pragma unroll
        for (int qp = 0; qp < 2; ++qp) { f[tt][qp] = *(const v4u*)(hf_ + tt * 2048 + qp * 1024); bb[tt][qp] = *(const v4u*)(hb_ + (1 - tt) * 2048 + (1 - qp) * 1024); }
#pragma unroll
    for (int it = 0; it < 4; ++it) { const int o = it * 16 + wave * 2 + h5; const size_t row = (size_t)b * SEQ + ck * 64 + o;
        mo[it] = *(const v4u*)(MO + row * 1024 + hd * 256 + dv0); mz[it] = *(const v4u*)(MZ + row * 1024 + hd * 256 + dv0); }
    __syncthreads();
#pragma unroll
    for (int tt = 0; tt < 2; ++tt)
#pragma unroll
        for (int qp = 0; qp < 2; ++qp) { const v4u fv = f[tt][qp], bv = bb[tt][qp];
            float fs[8] = {bflo(fv.x), bfhi(fv.x), bflo(fv.y), bfhi(fv.y), bflo(fv.z), bfhi(fv.z), bflo(fv.w), bfhi(fv.w)};
            float bs[8] = {bflo(bv.x), bfhi(bv.x), bflo(bv.y), bfhi(bv.y), bflo(bv.z), bfhi(bv.z), bflo(bv.w), bfhi(bv.w)};
#pragma unroll
            for (int j = 0; j < 8; ++j) { const int o = 32 * tt + 8 * (2 * qp + (j >> 2)) + 4 * h5 + (j & 3); XS[o * 256 + 32 * wave + r31] = fs[j] + bs[7 - j]; } }
    __syncthreads();
    const f32x4 g0 = *(const f32x4*)(mg + hd * 256 + dv0), g1 = *(const f32x4*)(mg + hd * 256 + dv0 + 4);
    const float gg[8] = {g0[0], g0[1], g0[2], g0[3], g1[0], g1[1], g1[2], g1[3]};
#pragma unroll
    for (int it = 0; it < 4; ++it) { const int o = it * 16 + wave * 2 + h5; const size_t row = (size_t)b * SEQ + ck * 64 + o;
        const f32x4 x0 = *(const LAS f32x4*)(XS + o * 256 + dv0), x1 = *(const LAS f32x4*)(XS + o * 256 + dv0 + 4);
        float hm[8] = {x0[0], x0[1], x0[2], x0[3], x1[0], x1[1], x1[2], x1[3]};
        const float mo8[8] = {bflo(mo[it].x), bfhi(mo[it].x), bflo(mo[it].y), bfhi(mo[it].y), bflo(mo[it].z), bfhi(mo[it].z), bflo(mo[it].w), bfhi(mo[it].w)};
        const float mz8[8] = {bflo(mz[it].x), bfhi(mz[it].x), bflo(mz[it].y), bfhi(mz[it].y), bflo(mz[it].z), bfhi(mz[it].z), bflo(mz[it].w), bfhi(mz[it].w)};
        float ss = 0.f;
#pragma unroll
        for (int j = 0; j < 8; ++j) { hm[j] = hm[j] * __builtin_amdgcn_rcpf(1.f + __expf(-mo8[j])); ss += hm[j] * hm[j]; }
#pragma unroll
        for (int s = 1; s < 32; s <<= 1) ss += __shfl_xor(ss, s);
        const float r = __builtin_amdgcn_rsqf(ss * (1.f / 256.f) + EPS);
        float ov[8];
#pragma unroll
        for (int j = 0; j < 8; ++j) ov[j] = hm[j] * r * gg[j] * (mz8[j] * __builtin_amdgcn_rcpf(1.f + __expf(-mz8[j])));
        v4u w; w.x = pk2(ov[0], ov[1]); w.y = pk2(ov[2], ov[3]); w.z = pk2(ov[4], ov[5]); w.w = pk2(ov[6], ov[7]);
        *(v4u*)(MIX + row * 2048 + 512 + hd * 256 + dv0) = w; }
    __syncthreads();
}

__device__ __forceinline__ void p5_batch(const Args& a, LAS unsigned char* lds, int first, int count) {
    if (count <= 0) return;
    int tid_ = threadIdx.x; asm volatile("" : "+v"(tid_));
    const int lane = tid_ & 63, wave = __builtin_amdgcn_readfirstlane(tid_ >> 6);
    unsigned char* ws = a.ws; const float* mg = a.in[7];
    const bf16* MO = (const bf16*)(ws + WS_MO); const bf16* MZ = (const bf16*)(ws + WS_MZ); bf16* MIX = (bf16*)(ws + WS_MIX);
    LAS float* XS = (LAS float*)lds; const int r31 = lane & 31, h5 = lane >> 5, dv0 = 8 * r31;
    v4u f[2][2], bb[2][2];
#define P5B_LOAD_H(item_) do { const int bh_ = (item_) >> 5, ck_ = (item_) & 31; \
        const unsigned char* hf_ = ws + WS_HF + ((size_t)bh_ * 32 + ck_) * 32768 + wave * 4096 + lane * 16; const unsigned char* hb_ = ws + WS_HB + ((size_t)bh_ * 32 + (31 - ck_)) * 32768 + wave * 4096 + (lane ^ 32) * 16; \
        _Pragma("unroll") for (int tt = 0; tt < 2; ++tt) _Pragma("unroll") for (int qp = 0; qp < 2; ++qp) { f[tt][qp] = *(const v4u*)(hf_ + tt * 2048 + qp * 1024); bb[tt][qp] = *(const v4u*)(hb_ + (1 - tt) * 2048 + (1 - qp) * 1024); } } while (0)
    P5B_LOAD_H(first);
    for (int i = 0; i < count; ++i) {
        const int item = first + i, bh = item >> 5, ck = item & 31, b = bh >> 2, hd = bh & 3;
        v4u mo[4], mz[4];
#pragma unroll
        for (int it = 0; it < 4; ++it) { const int o = it * 16 + wave * 2 + h5; const size_t row = (size_t)b * SEQ + ck * 64 + o;
            mo[it] = *(const v4u*)(MO + row * 1024 + hd * 256 + dv0); mz[it] = *(const v4u*)(MZ + row * 1024 + hd * 256 + dv0); }
        __syncthreads();
#pragma unroll
        for (int tt = 0; tt < 2; ++tt)
#pragma unroll
            for (int qp = 0; qp < 2; ++qp) { const v4u fv = f[tt][qp], bv = bb[tt][qp];
                float fs[8] = {bflo(fv.x), bfhi(fv.x), bflo(fv.y), bfhi(fv.y), bflo(fv.z), bfhi(fv.z), bflo(fv.w), bfhi(fv.w)};
                float bs[8] = {bflo(bv.x), bfhi(bv.x), bflo(bv.y), bfhi(bv.y), bflo(bv.z), bfhi(bv.z), bflo(bv.w), bfhi(bv.w)};
#pragma unroll
                for (int j = 0; j < 8; ++j) { const int o = 32 * tt + 8 * (2 * qp + (j >> 2)) + 4 * h5 + (j & 3); XS[o * 256 + 32 * wave + r31] = fs[j] + bs[7 - j]; } }
        __syncthreads();
        if (i + 1 < count) P5B_LOAD_H(item + 1);
        const f32x4 g0 = *(const f32x4*)(mg + hd * 256 + dv0), g1 = *(const f32x4*)(mg + hd * 256 + dv0 + 4);
        const float gg[8] = {g0[0], g0[1], g0[2], g0[3], g1[0], g1[1], g1[2], g1[3]};
#pragma unroll
        for (int it = 0; it < 4; ++it) { const int o = it * 16 + wave * 2 + h5; const size_t row = (size_t)b * SEQ + ck * 64 + o;
            const f32x4 x0 = *(const LAS f32x4*)(XS + o * 256 + dv0), x1 = *(const LAS f32x4*)(XS + o * 256 + dv0 + 4);
            float hm[8] = {x0[0], x0[1], x0[2], x0[3], x1[0], x1[1], x1[2], x1[3]};
            const float mo8[8] = {bflo(mo[it].x), bfhi(mo[it].x), bflo(mo[it].y), bfhi(mo[it].y), bflo(mo[it].z), bfhi(mo[it].z), bflo(mo[it].w), bfhi(mo[it].w)};
            const float mz8[8] = {bflo(mz[it].x), bfhi(mz[it].x), bflo(mz[it].y), bfhi(mz[it].y), bflo(mz[it].z), bfhi(mz[it].z), bflo(mz[it].w), bfhi(mz[it].w)};
            float ss = 0.f;
#pragma unroll
            for (int j = 0; j < 8; ++j) { hm[j] = hm[j] * __builtin_amdgcn_rcpf(1.f + __expf(-mo8[j])); ss += hm[j] * hm[j]; }
#pragma unroll
            for (int s = 1; s < 32; s <<= 1) ss += __shfl_xor(ss, s);
            const float r = __builtin_amdgcn_rsqf(ss * (1.f / 256.f) + EPS);
            float ov[8];
#pragma unroll
            for (int j = 0; j < 8; ++j) ov[j] = hm[j] * r * gg[j] * (mz8[j] * __builtin_amdgcn_rcpf(1.f + __expf(-mz8[j])));
            v4u w; w.x = pk2(ov[0], ov[1]); w.y = pk2(ov[2], ov[3]); w.z = pk2(ov[4], ov[5]); w.w = pk2(ov[6], ov[7]);
            *(v4u*)(MIX + row * 2048 + 512 + hd * 256 + dv0) = w; }
    }
#undef P5B_LOAD_H
    __syncthreads();
}

__device__ __forceinline__ void gate_rows48(unsigned char* ws, const float* b_gates, int row0, int lane) {
    typedef short bf16x8 __attribute__((ext_vector_type(8)));
    const int r15 = lane & 15, kg = lane >> 4;
    const bf16* a0p = (const bf16*)(ws + WS_H) + (size_t)(row0 + r15) * DM + 8 * kg; const bf16* a1p = a0p + 16 * DM; const bf16* a2p = a0p + 32 * DM;
    const bf16* bp = (const bf16*)(ws + WS_WGT) + (size_t)r15 * DM + 8 * kg;
    f32x4 acc0 = {0.f, 0.f, 0.f, 0.f}, acc1 = {0.f, 0.f, 0.f, 0.f}, acc2 = {0.f, 0.f, 0.f, 0.f};
#pragma unroll 8
    for (int ks = 0; ks < DM / 32; ++ks) { const bf16x8 a0 = *(const bf16x8*)(a0p + 32 * ks), a1 = *(const bf16x8*)(a1p + 32 * ks), a2 = *(const bf16x8*)(a2p + 32 * ks), b = *(const bf16x8*)(bp + 32 * ks);
        acc0 = __builtin_amdgcn_mfma_f32_16x16x32_bf16(a0, b, acc0, 0, 0, 0); acc1 = __builtin_amdgcn_mfma_f32_16x16x32_bf16(a1, b, acc1, 0, 0, 0); acc2 = __builtin_amdgcn_mfma_f32_16x16x32_bf16(a2, b, acc2, 0, 0, 0); }
    const float bias = b_gates[r15]; const bool isf = (r15 >> 2) & 1; float* G = (float*)(ws + WS_GATES) + (size_t)(row0 + 4 * kg) * 16 + r15;
#pragma unroll
    for (int r = 0; r < 4; ++r) { float v0 = acc0[r] + bias, v1 = acc1[r] + bias, v2 = acc2[r] + bias; if (isf) { v0 = log_sigmoid_f(v0); v1 = log_sigmoid_f(v1); v2 = log_sigmoid_f(v2); }
        G[r * 16] = v0; G[(16 + r) * 16] = v1; G[(32 + r) * 16] = v2; }
}

constexpr int N_PHASES = 7;
__global__ void __launch_bounds__(NWAVES * 64, 2) hy_fwd(Args args) {
    extern __shared__ __attribute__((aligned(16))) unsigned char lds_raw[];
    LAS unsigned char* lds = (LAS unsigned char*)lds_raw;
    const int tid = threadIdx.x, lane = tid & 63, wave = __builtin_amdgcn_readfirstlane(tid >> 6);
    const int G = gridDim.x; const int bx = blockIdx.x; const int vcu = (G % 8 == 0) ? (bx % 8) * (G / 8) + bx / 8 : bx;
    unsigned char* ws = args.ws;
    const int lo = args.ph_lo, hi = args.ph_hi;
    unsigned* ctl = (unsigned*)(ws + WS_CTL);
    volatile LAS unsigned* bst = (volatile LAS unsigned*)(lds + LDS_BYTES - 16);
    if (tid == 0) { bst[0] = 0u; bst[1] = 0u; }
    __syncthreads();
    XcdBarrier xbar; xbar.bar = ctl + CW_BAR; xbar.x = 0; xbar.st = bst; bool xposted = false;
    const bool one_launch = (lo == 0 && hi == N_PHASES);
    if (one_launch) { xbar = xcd_barrier_post(ctl + CW_BAR, bst); xposted = true; }
#ifndef HY_PHASE_MASK
#define HY_PHASE_MASK 0x7f
#endif
#define IN(k) (((HY_PHASE_MASK >> (k)) & 1) && lo <= (k) && (k) < hi)
#define BOTH(k) (IN(k) && IN((k) + 1))
#ifndef HY_DUP_MASK
#define HY_DUP_MASK 0
#endif
#ifndef HY_PROBE_NULL
#define HY_PROBE_NULL 0
#endif
#ifndef HY_ML_PROBE_MODE
#define HY_ML_PROBE_MODE 0
#endif
#define DUP(k) (((HY_DUP_MASK) >> (k)) & 1)
#define GRID_BAR_CG() do { cg::this_grid().sync(); } while (0)
#define GRID_BAR() do { if (!xposted) { xbar = xcd_barrier_post(ctl + CW_BAR, bst); xposted = true; } xcd_barrier(xbar); } while (0)

    if (IN(0) && DUP(0)) { p0_prologue(args, lds, vcu, G, tid, wave, lane); __syncthreads(); }
    if (IN(0)) { p0_prologue(args, lds, vcu, G, tid, wave, lane); if (BOTH(0)) GRID_BAR(); }

    if (IN(1)) {
        { const float* Rg = (const float*)(ws + WS_ROPE); LAS float* Rl = (LAS float*)(lds + ROPE_LDS_OFF); LAS float* Gl = (LAS float*)(lds + QKG_LDS_OFF);
          for (int e = tid; e < 64 * 32 * 2; e += NWAVES * 64) Rl[e] = Rg[e];
          if (tid < 128) { Gl[tid] = args.in[5][tid]; Gl[128 + tid] = args.in[6][tid]; }
          __syncthreads(); }
        { pg8::Gemm g{(const pg8::bf16_t*)((unsigned char*)args.out + DO_H8), (const pg8::bf16_t*)(ws + WS_W8T), NTOK, NQ8, DM / 2, DM / 128}; pg8::StaticOrder S; S.init(NTOK, NQ8, G, bx);
          pg8::EpiProjT<0, 2> E{ws, (PG8_LAS float*)(lds + XCH_OFF), (PG8_LAS float*)(lds + ROPE_LDS_OFF), (PG8_LAS float*)(lds + QKG_LDS_OFF), (unsigned char*)args.out + DO_Q, (PG8_LAS float*)(lds + SCL_LDS_OFF), (const float*)(ws + WS_SA), (const float*)(ws + WS_SW)};
          pg8::gemm_phase<pg8::EpiProjT<0, 2>, pg8::StaticOrder, true, true, 2>(lds, g, S, E); }
        { pg8::Gemm g{(const pg8::bf16_t*)(ws + WS_H), (const pg8::bf16_t*)(ws + WS_W1B), NTOK, NB1 - NB0, DM, DM / 64}; pg8::StaticOrder S; S.init(NTOK, NB1 - NB0, G, bx);
          pg8::EpiProjT<NB0 / 256, 0> E{ws, (PG8_LAS float*)(lds + XCH_OFF), (PG8_LAS float*)(lds + ROPE_LDS_OFF), (PG8_LAS float*)(lds + QKG_LDS_OFF), (unsigned char*)args.out + DO_Q, nullptr, nullptr, nullptr};
          pg8::gemm_phase<pg8::EpiProjT<NB0 / 256, 0>, pg8::StaticOrder, true, true, 0>(lds, g, S, E); }
        { const int nun = (NTOK / 256) * (NQ8 / 256), full = nun / G, rem = nun - full * G, light = G - rem;
          if (bx >= rem) for (int it = (bx - rem) * NWAVES + wave; it < NTOK / 48; it += light * NWAVES) gate_rows48(ws, args.in[4], it * 48, lane); }
        if (BOTH(1)) GRID_BAR();
    }

#if HY_SEPARATE_ROPE
    if (IN(2)) { p2_qknorm_rope(args, vcu, G, wave, lane); if (BOTH(2)) GRID_BAR(); }
#endif

#define ATTN_UNIT(grp_, w_) do { const int b_ = (grp_) >> 1, kvh_ = (grp_) & 1, h_ = kvh_ * 4 + ((w_) >> 3), qb_ = (w_) & 7; const size_t row0_ = (size_t)b_ * SEQ + qb_ * 256; \
        const bf16* Q_ = (const bf16*)((unsigned char*)args.out + DO_Q) + row0_ * 1024 + h_ * 128; unsigned char* O_ = ws + WS_MIX + row0_ * 4096 + h_ * 128; const attn::bf16* K_ = (const attn::bf16*)(ws + WS_AK) + (size_t)b_ * SEQ * 256 + kvh_ * 128; \
        const attn::bf16* V_ = (const attn::bf16*)(ws + WS_AV) + (size_t)b_ * SEQ * 256 + kvh_ * 128; const bf16* Z_ = (const bf16*)(ws + WS_AZ) + row0_ * 1024 + h_ * 128; \
        int seqv_ = SEQ; asm volatile("" : "+s"(seqv_)); attn::attn_dense_body<attn::bf16>((const attn::bf16*)Q_, K_, V_, O_, Z_, seqv_, (char*)lds_raw); __syncthreads(); } while (0)
#if HY_SCHED_J
    const bool schedJ = one_launch && G == 256;
    if (schedJ) {
        const int xl = vcu >> 5, s = vcu & 31;
        if (s < 24) ml::mlstm_item<0>(ws, lds, xl * 24 + s, tid);
        else for (int j = 0; j < 2; ++j) ATTN_UNIT(xl, 2 * (s - 24) + j);
        GRID_BAR();
        const int n_rest = (s < 16) ? 6 : 5, n_p5 = (s < 16) ? 8 : 16, p5_0 = (s < 16) ? 8 * (xl * 16 + s) : 1024 + 16 * (xl * 16 + (s - 16));
        int p5_done = 0;
        for (int jr = 0; jr < n_rest; ++jr) {
            if ((jr & 1) == 0) { const int tgt = (n_p5 * ((jr >> 1) + 1)) / 3;
                p5_batch(args, lds, p5_0 + p5_done, tgt - p5_done); p5_done = tgt; }
            const int li = s + 32 * jr;
            const int grp = (li < 16) ? xl : xl + 8 * (1 + ((li - 16) >> 5)), w = (li < 16) ? 16 + li : (li - 16) & 31;
            ATTN_UNIT(grp, w);
        }
        GRID_BAR();
    }
#else
    const bool schedJ = false;
#endif

    if (!schedJ && IN(3)) {
        for (int u = vcu; u < NSEQ * 2 * 32; u += G) ATTN_UNIT(u >> 5, u & 31);
        if (BOTH(3)) GRID_BAR();
    }

    if (!schedJ && IN(4) && DUP(4)) {
#if HY_MLSTM_REF
        p4_mlstm_recurrent(args, lds, vcu, G, tid);
#else
        for (int item = vcu; item < NSEQ * 8; item += G) ml::mlstm_item<HY_ML_PROBE_MODE>(ws, lds, item, tid);
#endif
        if (BOTH(4)) GRID_BAR(); }

    if (!schedJ && IN(4)) {
#if HY_MLSTM_REF
        p4_mlstm_recurrent(args, lds, vcu, G, tid);
#else
        for (int item = vcu; item < NSEQ * 8; item += G) ml::mlstm_item<0>(ws, lds, item, tid);
#endif
        if (BOTH(4)) GRID_BAR(); }

    if (!schedJ && IN(5) && DUP(5)) { p5_mlstm_finalize(args, lds, vcu, G, tid, wave, lane); }
    if (!schedJ && IN(5)) { p5_mlstm_finalize(args, lds, vcu, G, tid, wave, lane); if (BOTH(5)) GRID_BAR(); }

    if (IN(6)) {
        pg8::Gemm g{(const pg8::bf16_t*)(ws + WS_MIX), (const pg8::bf16_t*)(ws + WS_W2T), NTOK, DM, DM, pg8::F8_TILES + 1024 / 64}; pg8::StaticOrder S; S.init(NTOK, DM, G, bx);
        pg8::EpiOut E{args.in[0], args.in[1], args.out};
        pg8::gemm_phase<pg8::EpiOut, pg8::StaticOrder, true, true, 3>(lds, g, S, E);
    }
    if (one_launch && lo < 0) GRID_BAR_CG();
#undef IN
#undef BOTH
}

extern "C" void kernel_launch(void* const* d_in, const int* in_sizes, int n_in, void* d_out, int out_size, void* d_ws, size_t ws_size, hipStream_t stream) {
    static int grid = 0;
    if (grid == 0) {
        if (n_in != 9 || in_sizes[0] != TOK_PROMPT * DM || in_sizes[1] != (NTOK - TOK_PROMPT) * DM || out_size != NTOK * DM || ws_size < WS_END) {
            fprintf(stderr, "kernel_launch: shape mismatch n_in %d in0 %d in1 %d out %d ws %zu (need %zu)\n", n_in, n_in > 0 ? in_sizes[0] : -1, n_in > 1 ? in_sizes[1] : -1, out_size, ws_size, (size_t)WS_END); grid = -1; return; }
        int dev = 0, cus = 0, per_cu = 0;
        if (hipGetDevice(&dev) != hipSuccess || hipDeviceGetAttribute(&cus, hipDeviceAttributeMultiprocessorCount, dev) != hipSuccess) { fprintf(stderr, "kernel_launch: device query failed\n"); grid = -1; return; }
        if (hipFuncSetAttribute((const void*)hy_fwd, hipFuncAttributeMaxDynamicSharedMemorySize, LDS_BYTES) != hipSuccess) { fprintf(stderr, "kernel_launch: hipFuncSetAttribute failed\n"); grid = -1; return; }
        if (hipOccupancyMaxActiveBlocksPerMultiprocessor(&per_cu, (const void*)hy_fwd, NWAVES * 64, LDS_BYTES) != hipSuccess || per_cu < 1) { fprintf(stderr, "kernel_launch: occupancy query says %d\n", per_cu); per_cu = 1; }
        (void)hipGetLastError();
        grid = cus;
    }
    if (grid < 0) return;
    if (hipMemsetAsync((char*)d_ws + WS_CTL, 0, 65536, stream) != hipSuccess) { fprintf(stderr, "kernel_launch: hipMemsetAsync of the control words failed\n"); return; }
    Args a{};
    for (int i = 0; i < 9; ++i) a.in[i] = (const float*)d_in[i];
    a.out = (float*)d_out; a.ws = (unsigned char*)d_ws;
#if HY_N_LAUNCHES == 1
    a.ph_lo = 0; a.ph_hi = N_PHASES;
    void* kargs[] = {&a};
    hipError_t e = hipLaunchCooperativeKernel((const void*)hy_fwd, dim3(grid), dim3(NWAVES * 64), kargs, LDS_BYTES, stream);
    if (e != hipSuccess) fprintf(stderr, "kernel_launch: cooperative launch failed: %s (grid %d)\n", hipGetErrorString(e), grid);
#else
    for (int p = 0; p < N_PHASES; ++p) {
        a.ph_lo = p; a.ph_hi = p + 1;
        hipLaunchKernelGGL(hy_fwd, dim3(grid), dim3(NWAVES * 64), LDS_BYTES, stream, a);
        const hipError_t le = hipPeekAtLastError();
        if (le != hipSuccess) { fprintf(stderr, "kernel_launch: launch %d failed: %s\n", p, hipGetErrorName(le)); break; }
    }
#endif
}
```

```cpp
#include <hip/hip_runtime.h>
#include <hip/hip_bf16.h>
#include <hip/hip_cooperative_groups.h>
#include <cstdio>
#include <cstdint>
#include <cmath>
namespace cg = cooperative_groups;

#ifndef HY_SEPARATE_ROPE
#define HY_SEPARATE_ROPE 0
#endif
#ifndef HY_SCHED_J
#define HY_SCHED_J 1
#endif
#ifndef HY_MLSTM_REF
#define HY_MLSTM_REF 0
#endif
#ifndef HY_N_LAUNCHES
#define HY_N_LAUNCHES 1
#endif

constexpr int SEQ = 2048, NSEQ = 24, NTOK = NSEQ * SEQ, TOK_PROMPT = 8 * SEQ, DM = 2048;
constexpr int NPROJ = 6672, NP256 = 6656;
constexpr float EPS = 1e-6f;

constexpr size_t MiB = 1u << 20;
constexpr size_t WS_CTL = 0, CTL_ZERO_BYTES = 1 * MiB;
constexpr int CW_BAR = 4096, CW_QUEUE = 8192;
constexpr size_t WS_ROPE = 1 * MiB;
constexpr size_t WS_W8T = 2 * MiB;
constexpr size_t WS_W1B = 14 * MiB;
constexpr size_t WS_WGT = 18 * MiB;
constexpr size_t WS_SW = 19 * MiB;
constexpr size_t WS_SA = 20 * MiB;
constexpr size_t WS_W2T = 30 * MiB;
constexpr size_t WS_GATES = 38 * MiB;
constexpr size_t WS_H = 42 * MiB;
constexpr size_t WS_HF = WS_H, WS_HB = WS_H + 96 * MiB;
constexpr size_t WS_MIX = 234 * MiB;
constexpr size_t DO_H8 = 0, DO_Q = 96 * MiB;
constexpr float QK8_SCALE = 16.f;
constexpr float A8_SCALE = 256.f, W8_SCALE = 512.f;
constexpr size_t WS_AK = 426 * MiB, WS_AV = 450 * MiB;
constexpr size_t WS_AZ = 474 * MiB;
constexpr size_t WS_MQ = 570 * MiB, WS_MK = 618 * MiB;
constexpr size_t WS_MV = 666 * MiB, WS_MO = 762 * MiB, WS_MZ = 858 * MiB;
constexpr size_t WS_END = 954 * MiB;

typedef unsigned short bf16;
__device__ __forceinline__ unsigned f2bf(float f) { unsigned u = __builtin_bit_cast(unsigned, f); return (u + 0x7fffu + ((u >> 16) & 1u)) >> 16; }
__device__ __forceinline__ unsigned pk2(float lo, float hi) { return f2bf(lo) | (f2bf(hi) << 16); }
__device__ __forceinline__ float bf2f(unsigned short b) { return __builtin_bit_cast(float, (unsigned)b << 16); }
__device__ __forceinline__ float bflo(unsigned w) { return __builtin_bit_cast(float, w << 16); }
__device__ __forceinline__ float bfhi(unsigned w) { return __builtin_bit_cast(float, w & 0xffff0000u); }
constexpr int NQA = 2560, NB0 = 2560, NB1 = 3584, NQ8 = 5632;
__device__ __forceinline__ unsigned pk4f8(float a, float b, float c, float d) {
    a = __builtin_fminf(__builtin_fmaxf(a, -448.f), 448.f); b = __builtin_fminf(__builtin_fmaxf(b, -448.f), 448.f); c = __builtin_fminf(__builtin_fmaxf(c, -448.f), 448.f); d = __builtin_fminf(__builtin_fmaxf(d, -448.f), 448.f);
    int w = 0; w = __builtin_amdgcn_cvt_pk_fp8_f32(a, b, w, false); w = __builtin_amdgcn_cvt_pk_fp8_f32(c, d, w, true); return (unsigned)w; }
__device__ __forceinline__ float log_sigmoid_f(float x) { return x >= 0.f ? -log1pf(expf(-x)) : x - log1pf(expf(x)); }
namespace pg8 {
#define PG8_LAS __attribute__((address_space(3)))
typedef unsigned short bf16_t;
typedef short bf16x8 __attribute__((ext_vector_type(8)));
typedef float f32x4 __attribute__((ext_vector_type(4)));
typedef unsigned u32x4 __attribute__((ext_vector_type(4)));
typedef int i32x4 __attribute__((ext_vector_type(4)));
constexpr int F8_TILES = 8;
constexpr int BM = 256, BK = 64, HALF = 128, HTB = HALF * BK * 2  , STAGE_BYTES = 8 * HTB, NXCD = 8, WGM = 8;

__host__ __device__ __forceinline__ int lds_byte(int r, int c) { const int st = (r >> 4) * 2 + (c >> 5), rr = r & 15, cc = c & 31, ob = rr * 64 + cc * 2; return st * 1024 + (ob ^ (((ob >> 9) & 1) << 5)); }
__host__ __device__ __forceinline__ void stage_rc(int b, int& R, int& C) { const int st = b / 1024, sb = b % 1024, swz = sb ^ (((sb >> 9) & 1) << 5); R = (st >> 1) * 16 + swz / 64; C = (st & 1) * 32 + (swz % 64) / 2; }
__host__ __device__ __forceinline__ int perm32(int rho) { const int n = rho >> 4, i = rho & 15; return 8 * (i >> 2) + 4 * n + (i & 3); }

struct Unit { int pm, pn; };
struct Gemm { const bf16_t* A; const bf16_t* Bt; int M, N, K, kt; };

struct StaticOrder {
    int nM, nN, nwg, G, c;
    __host__ __device__ void init(int M, int N, int G_, int c_) { nM = M / BM; nN = N / BM; nwg = nM * nN; G = G_; c = c_; }
    __host__ __device__ bool next(int i, Unit& u) const {
        const long L = (long)i * G + c; if (L >= nwg) return false;
        int wgid = (int)L; { const int q = nwg / NXCD, r = nwg % NXCD, xcd = wgid % NXCD, off = wgid / NXCD; wgid = (xcd < r ? xcd * (q + 1) : r * (q + 1) + (xcd - r) * q) + off; }
        const int nig = WGM * nN, gid = wgid / nig, fm = gid * WGM, gsz = (nM - fm) < WGM ? (nM - fm) : WGM;
        u.pm = fm + ((wgid % nig) % gsz); u.pn = (wgid % nig) / gsz; return true;
    }
    __device__ __forceinline__ void a_ready(const Unit&) const {}
    __device__ __forceinline__ void done(const Unit&) const {}
};


__device__ __forceinline__ unsigned cvt_pk_bf16(float lo, float hi) { unsigned r; asm volatile("v_cvt_pk_bf16_f32 %0, %1, %2" : "=v"(r) : "v"(lo), "v"(hi)); return r; }

template <int PN0, int MODE>
struct EpiProjT {
    static constexpr bool PERM = true, AFTER_DRAIN = false, PREFETCH = (MODE == 2); static constexpr int NSTORE = 16;
    unsigned char* ws; PG8_LAS float* xch; PG8_LAS float* ropeL; PG8_LAS float* qkgL;
    unsigned char* qb;
    PG8_LAS float* scl; const float* SA; const float* SW;
    __device__ __forceinline__ void prefetch(const Unit& u, int ui, int wid, int lane) const {
        const float* src = (wid < 4) ? SA + (size_t)u.pm * BM + wid * 64 + lane : SW + u.pn * BM + (wid - 4) * 64 + lane;
        __builtin_amdgcn_global_load_lds((const unsigned*)src, (PG8_LAS unsigned*)(scl + (ui & 1) * 512 + wid * 64), 4, 0, 0); }
    __device__ __forceinline__ void operator()(const f32x4 (&acc)[2][2][4][2], const Unit& u, int wr, int wc, int fr, int fq, int par = 0) const {
        const int pn = (MODE == 2) ? (u.pn < 10 ? u.pn : u.pn + 4) : u.pn + PN0; const int row0 = u.pm * BM + wr * 64 + fr;
        constexpr float SC = (MODE == 1) ? (1.f / 4096.f) : 1.f;
        float sa[2][4]; f32x4 sw[2][2];
        if constexpr (MODE == 2) { PG8_LAS float* T = scl + par * 512;
#pragma unroll
            for (int ai = 0; ai < 2; ++ai)
#pragma unroll
                for (int m = 0; m < 4; ++m) sa[ai][m] = T[ai * HALF + wr * 64 + m * 16 + fr];
#pragma unroll
            for (int bj = 0; bj < 2; ++bj)
#pragma unroll
                for (int n = 0; n < 2; ++n) sw[bj][n] = *(const PG8_LAS f32x4*)(T + 256 + bj * HALF + wc * 32 + 8 * fq + 4 * n); }
        auto val = [&](int ai, int bj, int m, int n) -> f32x4 {
            if constexpr (MODE == 2) { const i32x4 iv = __builtin_bit_cast(i32x4, acc[ai][bj][m][n]); const f32x4 f = {(float)iv[0], (float)iv[1], (float)iv[2], (float)iv[3]}; return f * sa[ai][m] * sw[bj][n]; }
            else return acc[ai][bj][m][n] * SC; };
        if (!HY_SEPARATE_ROPE && PN0 <= 4 && pn <= 4) {
            PG8_LAS float* gsrc = qkgL + ((pn < 4) ? 0 : 128); const int cb = 64 * (wc >> 1) + 16 * (wc & 1) + 4 * fq;
            const f32x4 g1 = *(const PG8_LAS f32x4*)(gsrc + cb), g2 = *(const PG8_LAS f32x4*)(gsrc + cb + 32);
#pragma unroll
            for (int ai = 0; ai < 2; ++ai)
#pragma unroll
                for (int m = 0; m < 4; ++m)
#pragma unroll
                    for (int bj = 0; bj < 2; ++bj) { const f32x4 a = val(ai, bj, m, 0), b = val(ai, bj, m, 1);
                        float s = ((a[0] * a[0] + a[1] * a[1]) + (a[2] * a[2] + a[3] * a[3])) + ((b[0] * b[0] + b[1] * b[1]) + (b[2] * b[2] + b[3] * b[3]));
                        s += __shfl_xor(s, 16); s += __shfl_xor(s, 32);
                        if (fq == 0) xch[((ai * HALF + wr * 64 + m * 16 + fr) * 2 + bj) * 4 + wc] = s; }
            asm volatile("s_waitcnt lgkmcnt(0)" ::: "memory"); __builtin_amdgcn_s_barrier(); asm volatile("" ::: "memory");
            unsigned char* base = pn < 4 ? qb : ws + WS_AK; const int ldc = (pn < 4) ? 1024 : 256; const int colt = (pn < 4) ? pn * 256 : 0;
            PG8_LAS float* R = ropeL; const int j0 = 16 * (wc & 1) + 4 * fq;
#pragma unroll
            for (int ai = 0; ai < 2; ++ai)
#pragma unroll
                for (int m = 0; m < 4; ++m) { const int row = row0 + ai * HALF + m * 16; const int tl = row & (SEQ - 1); const int pos = (wc < 2) ? (tl >> 6) : (tl & 63);
                    const f32x4 cs0 = *(const PG8_LAS f32x4*)(R + (pos * 32 + j0) * 2), cs1 = *(const PG8_LAS f32x4*)(R + (pos * 32 + j0) * 2 + 4);
#pragma unroll
                    for (int bj = 0; bj < 2; ++bj) { const f32x4 pt = *(const PG8_LAS f32x4*)(xch + ((ai * HALF + wr * 64 + m * 16 + fr) * 2 + bj) * 4);
                        const float rstd = 1.f / sqrtf(((pt[0] + pt[1]) + (pt[2] + pt[3])) * (1.f / 128.f) + EPS);
                        const f32x4 y1 = val(ai, bj, m, 0) * rstd * g1, y2 = val(ai, bj, m, 1) * rstd * g2;
                        const float o10 = y1[0] * cs0[0] - y2[0] * cs0[1], o11 = y1[1] * cs0[2] - y2[1] * cs0[3], o12 = y1[2] * cs1[0] - y2[2] * cs1[1], o13 = y1[3] * cs1[2] - y2[3] * cs1[3];
                        const float o20 = y2[0] * cs0[0] + y1[0] * cs0[1], o21 = y2[1] * cs0[2] + y1[1] * cs0[3], o22 = y2[2] * cs1[0] + y1[2] * cs1[1], o23 = y2[3] * cs1[2] + y1[3] * cs1[3];
                        unsigned char* dst = base + (size_t)row * ldc + colt + bj * HALF + cb;
                        *(unsigned*)dst = pk4f8(o10 * QK8_SCALE, o11 * QK8_SCALE, o12 * QK8_SCALE, o13 * QK8_SCALE); *(unsigned*)(dst + 32) = pk4f8(o20 * QK8_SCALE, o21 * QK8_SCALE, o22 * QK8_SCALE, o23 * QK8_SCALE); } }
            return;
        }
        size_t off; int ldc, colt;
        if (pn < 4)       { off = 0; ldc = 1024; colt = pn * 256; }
        else if (pn == 4) { off = WS_AK;  ldc = 256;  colt = 0; }
        else if (pn == 5) { off = WS_AV;  ldc = 256;  colt = 0; }
        else if (pn < 10) { off = WS_AZ;  ldc = 1024; colt = (pn - 6) * 256; }
        else if (pn < 12) { off = WS_MQ;  ldc = 512;  colt = (pn - 10) * 256; }
        else if (pn < 14) { off = WS_MK;  ldc = 512;  colt = (pn - 12) * 256; }
        else if (pn < 18) { off = WS_MV;  ldc = 1024; colt = (pn - 14) * 256; }
        else if (pn < 22) { off = WS_MO;  ldc = 1024; colt = (pn - 18) * 256; }
        else              { off = WS_MZ;  ldc = 1024; colt = (pn - 22) * 256; }
        bf16_t* base = (bf16_t*)(pn < 4 ? qb : ws + off);
        const int col0 = colt + wc * 32 + 8 * fq;
#pragma unroll
        for (int ai = 0; ai < 2; ++ai)
#pragma unroll
            for (int m = 0; m < 4; ++m) { bf16_t* rowp = base + (size_t)(row0 + ai * HALF + m * 16) * ldc + col0;
#pragma unroll
                for (int bj = 0; bj < 2; ++bj) { const f32x4 v0 = val(ai, bj, m, 0), v1 = val(ai, bj, m, 1);
                    u32x4 w; w.x = cvt_pk_bf16(v0[0], v0[1]); w.y = cvt_pk_bf16(v0[2], v0[3]); w.z = cvt_pk_bf16(v1[0], v1[1]); w.w = cvt_pk_bf16(v1[2], v1[3]);
                    *(u32x4*)(rowp + bj * HALF) = w; } }
    }
};
struct EpiNull { static constexpr bool PERM = true, AFTER_DRAIN = false, PREFETCH = false; static constexpr int NSTORE = 0;
    __device__ __forceinline__ void operator()(const f32x4 (&acc)[2][2][4][2], const Unit& u, int wr, int wc, int fr, int fq) const {
#pragma unroll
        for (int ai = 0; ai < 2; ++ai)
#pragma unroll
            for (int bj = 0; bj < 2; ++bj)
#pragma unroll
                for (int m = 0; m < 4; ++m) asm volatile("" :: "v"(acc[ai][bj][m][0]), "v"(acc[ai][bj][m][1])); } };
struct EpiOut {
    static constexpr bool PERM = false, AFTER_DRAIN = false, PREFETCH = false; static constexpr int NSTORE = 32;
    const float* xp; const float* xs; float* out;
    __device__ __forceinline__ void operator()(const f32x4 (&acc)[2][2][4][2], const Unit& u, int wr, int wc, int fr, int fq) const {
        const int row0 = u.pm * BM + wr * 64 + fr; const int col0 = u.pn * BM + wc * 32 + 4 * fq;
        const bool pr = row0 < TOK_PROMPT; const float* xb = (pr ? xp : xs) + col0;
        const size_t xsub = pr ? 0 : (size_t)TOK_PROMPT * DM; float* ob = out + col0;
        f32x4 xr[4][4];
#define EPO_LOAD(g_) do { const size_t ro_ = (size_t)(row0 + ((g_) >> 2) * HALF + ((g_) & 3) * 16) * DM - xsub; \
            xr[(g_) & 3][0] = *(const f32x4*)(xb + ro_); xr[(g_) & 3][1] = *(const f32x4*)(xb + ro_ + 16); xr[(g_) & 3][2] = *(const f32x4*)(xb + ro_ + HALF); xr[(g_) & 3][3] = *(const f32x4*)(xb + ro_ + HALF + 16); } while (0)
        EPO_LOAD(0); EPO_LOAD(1); EPO_LOAD(2);
#pragma unroll
        for (int g = 0; g < 8; ++g) { if (g + 3 < 8) EPO_LOAD(g + 3);
            const int ai = g >> 2, m = g & 3; const size_t ro = (size_t)(row0 + ai * HALF + m * 16) * DM;
            *(f32x4*)(ob + ro) = xr[g & 3][0] + acc[ai][0][m][0]; *(f32x4*)(ob + ro + 16) = xr[g & 3][1] + acc[ai][0][m][1];
            *(f32x4*)(ob + ro + HALF) = xr[g & 3][2] + acc[ai][1][m][0]; *(f32x4*)(ob + ro + HALF + 16) = xr[g & 3][3] + acc[ai][1][m][1]; }
#undef EPO_LOAD
    }
};

template <class Epi, class Sched, bool ALIGN_EPI = false, bool SP2 = false, int MODE = 0>
__device__ __forceinline__ void gemm_phase(PG8_LAS unsigned char* lds, const Gemm g, const Sched& S, const Epi& E) {
    int tid_ = threadIdx.x; asm volatile("" : "+v"(tid_));
    const int tid = tid_, wid = __builtin_amdgcn_readfirstlane(tid >> 6), lane = tid & 63, wr = wid >> 2, wc = wid & 3, fr = lane & 15, fq = lane >> 4;
    const int K = g.K, nt = g.kt;
    unsigned voffA[2], voffB[2];
#pragma unroll
    for (int i = 0; i < 2; ++i) { int R, C; stage_rc(tid * 16 + i * 8192, R, C); const int Rb = Epi::PERM ? ((R & ~31) + perm32(R & 31)) : R;
        voffA[i] = (unsigned)(R * K + C) * 2u; voffB[i] = (unsigned)(Rb * K + C) * 2u; }
    const size_t kstep = (size_t)(BK * 2);
    const size_t hstep = (size_t)HALF * K * 2;
    const size_t tstep = 2 * hstep;
    const unsigned ldsw = (unsigned)wid * 1024u;
    const int aoff = lds_byte(wr * 64 + fr, fq * 8), boff = lds_byte(wc * 32 + fr, fq * 8);
#define PG8_SA(b, h) (((b) * 2 + (h)) * HTB)
#define PG8_SB(b, h) ((4 + (b) * 2 + (h)) * HTB)
#define PG8_STAGE(bufoff, gbase, voff) do { _Pragma("unroll") for (int _i = 0; _i < 2; ++_i) \
        __builtin_amdgcn_global_load_lds((const unsigned*)((const char*)(gbase) + (voff)[_i]), (PG8_LAS unsigned*)(lds + (bufoff) + ldsw + _i * 8192), 16, 0, 0); } while (0)
#define PG8_LDA(dst, b, h) do { _Pragma("unroll") for (int m = 0; m < 4; ++m) _Pragma("unroll") for (int k = 0; k < 2; ++k) dst[m][k] = *(const PG8_LAS bf16x8*)(lds + PG8_SA(b, h) + aoff + m * 2048 + k * 1024); } while (0)
#define PG8_LDB(dst, b, h) do { _Pragma("unroll") for (int n = 0; n < 2; ++n) _Pragma("unroll") for (int k = 0; k < 2; ++k) dst[n][k] = *(const PG8_LAS bf16x8*)(lds + PG8_SB(b, h) + boff + n * 2048 + k * 1024); } while (0)
#define PG8_CAT8(x_) __builtin_shufflevector(__builtin_bit_cast(i32x4, (x_)[0]), __builtin_bit_cast(i32x4, (x_)[1]), 0, 1, 2, 3, 4, 5, 6, 7)
#define PG8_MMA_F8(ai, bj, At, Bt) do { _Pragma("unroll") for (int m = 0; m < 4; ++m) _Pragma("unroll") for (int n = 0; n < 2; ++n) \
        asm volatile("v_mfma_f32_16x16x128_f8f6f4 %0, %1, %2, %0" : "+v"(acc[ai][bj][m][n]) : "v"(PG8_CAT8(Bt[n])), "v"(PG8_CAT8(At[m]))); } while (0)
#define PG8_MMA_I8(ai, bj, At, Bt) do { _Pragma("unroll") for (int k = 0; k < 2; ++k) _Pragma("unroll") for (int m = 0; m < 4; ++m) _Pragma("unroll") for (int n = 0; n < 2; ++n) \
        asm volatile("v_mfma_i32_16x16x64_i8 %0, %1, %2, %0" : "+v"(acc[ai][bj][m][n]) : "v"(Bt[n][k]), "v"(At[m][k])); } while (0)
#define PG8_MMA_BF(ai, bj, At, Bt) do { _Pragma("unroll") for (int m = 0; m < 4; ++m) _Pragma("unroll") for (int n = 0; n < 2; ++n) _Pragma("unroll") for (int k = 0; k < 2; ++k) \
        acc[ai][bj][m][n] = __builtin_amdgcn_mfma_f32_16x16x32_bf16(Bt[n][k], At[m][k], acc[ai][bj][m][n], 0, 0, 0); } while (0)
#define PG8_MMA(ai, bj, At, Bt) do { __builtin_amdgcn_s_setprio(1); \
        if constexpr (MODE == 1) PG8_MMA_F8(ai, bj, At, Bt); else if constexpr (MODE == 2) PG8_MMA_I8(ai, bj, At, Bt); else PG8_MMA_BF(ai, bj, At, Bt); \
        __builtin_amdgcn_s_setprio(0); } while (0)
#define PG8_MMAW_F8(ai, bj, At, Bt) do { __builtin_amdgcn_s_setprio(1); PG8_MMA_F8(ai, bj, At, Bt); __builtin_amdgcn_s_setprio(0); } while (0)
#define PG8_MMAW_BF(ai, bj, At, Bt) do { __builtin_amdgcn_s_setprio(1); PG8_MMA_BF(ai, bj, At, Bt); __builtin_amdgcn_s_setprio(0); } while (0)
#define PG8_WAIT_V(n) asm volatile("s_waitcnt vmcnt(" #n ")" ::: "memory")
#define PG8_WAIT_L(n) asm volatile("s_waitcnt lgkmcnt(" #n ")" ::: "memory")
#define PG8_BAR __builtin_amdgcn_s_barrier()
#define PG8_SCHED __builtin_amdgcn_sched_barrier(0)
    Unit cur, nxt; int ui = 0;
    if (!S.next(0, cur)) return;
    f32x4 acc[2][2][4][2];
#pragma unroll
    for (int a = 0; a < 2; ++a)
#pragma unroll
        for (int b = 0; b < 2; ++b)
#pragma unroll
            for (int m = 0; m < 4; ++m)
#pragma unroll
                for (int n = 0; n < 2; ++n) { acc[a][b][m][n] = (f32x4){0.f, 0.f, 0.f, 0.f}; if constexpr (MODE != 0) asm volatile("" : "+v"(acc[a][b][m][n])); }
    bf16x8 At[4][2], B0[2][2], B1[2][2];
    const char* cA = (const char*)g.A + (size_t)cur.pm * tstep; const char* cB = (const char*)g.Bt + (size_t)cur.pn * tstep;
    S.a_ready(cur);
    if constexpr (SP2) {
        PG8_STAGE(PG8_SB(0, 0), cB, voffB); PG8_STAGE(PG8_SB(0, 1), cB + hstep, voffB); PG8_STAGE(PG8_SA(0, 0), cA, voffA); PG8_STAGE(PG8_SA(0, 1), cA + hstep, voffA);
        if (wr == 1) PG8_BAR;
        PG8_WAIT_V(2); PG8_BAR;
        PG8_STAGE(PG8_SB(1, 0), cB + kstep, voffB); PG8_STAGE(PG8_SA(1, 0), cA + kstep, voffA); PG8_STAGE(PG8_SB(1, 1), cB + hstep + kstep, voffB);
        PG8_WAIT_V(6); PG8_BAR;
    } else {
        PG8_STAGE(PG8_SB(0, 0), cB, voffB); PG8_STAGE(PG8_SA(0, 0), cA, voffA); PG8_STAGE(PG8_SB(0, 1), cB + hstep, voffB); PG8_STAGE(PG8_SA(0, 1), cA + hstep, voffA);
        if (wr == 1) PG8_BAR;
        PG8_WAIT_V(4); PG8_BAR;
        PG8_STAGE(PG8_SB(1, 0), cB + kstep, voffB); PG8_STAGE(PG8_SA(1, 0), cA + kstep, voffA); PG8_STAGE(PG8_SB(1, 1), cB + hstep + kstep, voffB);
        PG8_WAIT_V(6); PG8_BAR;
    }
    for (;;) {
        const bool has_next = S.next(ui + 1, nxt);
        const char* nA = has_next ? (const char*)g.A + (size_t)nxt.pm * tstep : cA; const char* nB = has_next ? (const char*)g.Bt + (size_t)nxt.pn * tstep : cB;
        static_assert(SP2, "gemm_phase: only the SP2 K-loop is carried");
#define PG8_WAIT_FIRST() do { if constexpr (Epi::NSTORE >= 32) asm volatile("s_waitcnt vmcnt(40)\n\ts_cmp_lg_u32 %0, 0\n\ts_cbranch_scc1 1f\n\ts_waitcnt vmcnt(8)\n1:" :: "s"(relax_s) : "memory", "scc"); \
            else if constexpr (Epi::NSTORE >= 16) asm volatile("s_waitcnt vmcnt(24)\n\ts_cmp_lg_u32 %0, 0\n\ts_cbranch_scc1 1f\n\ts_waitcnt vmcnt(8)\n1:" :: "s"(relax_s) : "memory", "scc"); \
            else PG8_WAIT_V(8); } while (0)
#define PG8_TRIP(MMAX) do { \
            const bool last = (t == nt - 2); \
            const char* a1 = cA + (size_t)(t + 1) * kstep; \
            const char* a2 = last ? nA : cA + (size_t)(t + 2) * kstep; const char* b2 = last ? nB : cB + (size_t)(t + 2) * kstep; \
            const char* a3 = a2 + kstep; const char* b3 = b2 + kstep; \
            if (last && has_next) S.a_ready(nxt); \
            const int relax_s = __builtin_amdgcn_readfirstlane((Epi::NSTORE > 0 && t == 0 && ui > 0) ? 1 : 0); \
            PG8_LDB(B0, 0, 0); PG8_LDB(B1, 0, 1); PG8_SCHED; PG8_LDA(At, 0, 0); PG8_STAGE(PG8_SA(1, 1), a1 + hstep, voffA); \
            PG8_WAIT_FIRST(); PG8_WAIT_L(0); PG8_BAR; MMAX(0, 0, At, B0); MMAX(0, 1, At, B1); PG8_BAR; PG8_SCHED; \
            PG8_LDA(At, 0, 1); PG8_STAGE(PG8_SB(0, 0), b2, voffB); PG8_STAGE(PG8_SB(0, 1), b2 + hstep, voffB); PG8_STAGE(PG8_SA(0, 0), a2, voffA); \
            PG8_WAIT_FIRST(); PG8_WAIT_L(0); PG8_BAR; MMAX(1, 0, At, B0); MMAX(1, 1, At, B1); PG8_BAR; PG8_SCHED; \
            if constexpr (Epi::PREFETCH) { if (t == 0) E.prefetch(cur, ui, wid, lane); } \
            PG8_LDB(B0, 1, 0); PG8_LDB(B1, 1, 1); PG8_SCHED; PG8_LDA(At, 1, 0); PG8_STAGE(PG8_SA(0, 1), a2 + hstep, voffA); \
            PG8_WAIT_V(8); PG8_WAIT_L(0); PG8_BAR; MMAX(0, 0, At, B0); MMAX(0, 1, At, B1); PG8_BAR; PG8_SCHED; \
            PG8_LDA(At, 1, 1); PG8_STAGE(PG8_SB(1, 0), b3, voffB); PG8_STAGE(PG8_SB(1, 1), b3 + hstep, voffB); PG8_STAGE(PG8_SA(1, 0), a3, voffA); \
            PG8_WAIT_V(8); PG8_WAIT_L(0); PG8_BAR; MMAX(1, 0, At, B0); MMAX(1, 1, At, B1); PG8_BAR; PG8_SCHED; } while (0)
        if constexpr (MODE == 3) {
            for (int t = 0; t < F8_TILES; t += 2) PG8_TRIP(PG8_MMAW_F8);
            asm volatile("s_nop 15\n\ts_nop 15" ::: "memory"); PG8_SCHED;
#pragma unroll
            for (int a = 0; a < 2; ++a)
#pragma unroll
                for (int b = 0; b < 2; ++b)
#pragma unroll
                    for (int m = 0; m < 4; ++m)
#pragma unroll
                        for (int n = 0; n < 2; ++n) acc[a][b][m][n] *= (1.f / (A8_SCALE * W8_SCALE));
            for (int t = F8_TILES; t < nt; t += 2) PG8_TRIP(PG8_MMAW_BF);
        } else { for (int t = 0; t < nt; t += 2) PG8_TRIP(PG8_MMA); }
#undef PG8_TRIP
#undef PG8_WAIT_FIRST
        if constexpr (MODE == 1 || MODE == 2) { asm volatile("s_nop 15\n\ts_nop 15" ::: "memory"); PG8_SCHED; }
        if constexpr (ALIGN_EPI) { if (wr == 0) PG8_BAR; }
        if constexpr (!Epi::AFTER_DRAIN) { if constexpr (Epi::PREFETCH) E(acc, cur, wr, wc, fr, fq, ui & 1); else E(acc, cur, wr, wc, fr, fq); S.done(cur); }
        if (!has_next) break;
#pragma unroll
        for (int a = 0; a < 2; ++a)
#pragma unroll
            for (int b = 0; b < 2; ++b)
#pragma unroll
                for (int m = 0; m < 4; ++m)
#pragma unroll
                    for (int n = 0; n < 2; ++n) { acc[a][b][m][n] = (f32x4){0.f, 0.f, 0.f, 0.f}; if constexpr (MODE != 0) asm volatile("" : "+v"(acc[a][b][m][n])); }
        cur = nxt; cA = nA; cB = nB; ++ui;
        if constexpr (ALIGN_EPI) { if (wr == 1) PG8_BAR; }
    }
    PG8_WAIT_V(0);
    if constexpr (!ALIGN_EPI) { if (wr == 0) PG8_BAR; }
    PG8_BAR;
    if constexpr (Epi::AFTER_DRAIN) { E.fused(acc, cur, wr, wc, fr, fq, lds, wid, lane); S.done(cur); }
#undef PG8_SA
#undef PG8_SB
#undef PG8_STAGE
#undef PG8_LDA
#undef PG8_LDB
#undef PG8_MMA
#undef PG8_MMAW_F8
#undef PG8_MMAW_BF
#undef PG8_MMA_F8
#undef PG8_MMA_I8
#undef PG8_MMA_BF
#undef PG8_CAT8
#undef PG8_WAIT_V
#undef PG8_WAIT_L
#undef PG8_BAR
#undef PG8_SCHED
}
}
namespace attn {
using bf16 = __hip_bfloat16;
constexpr int   D = 128, NW = 8, QBLK = 32, KVBLK = 64;
constexpr float SCALE = 0.088388347648318440f / (QK8_SCALE * QK8_SCALE);
constexpr float THR = 8.f;
constexpr int SDEPTH = 2;
constexpr int LDQ = 1024, LDK = 256, LDO = 4096, LDZ = 1024;
constexpr size_t SHM_V = KVBLK * D * 2, SHM_K = KVBLK * D, SHM_ATTN = 65536 + NW * 64 * 4;
using bf16x8 = __attribute__((ext_vector_type(8))) short;
using s16x4  = __attribute__((ext_vector_type(4))) short;
using f32x16 = __attribute__((ext_vector_type(16))) float;
using f32x8  = __attribute__((ext_vector_type(8))) float;
using u32x4  = __attribute__((ext_vector_type(4))) unsigned;
#define KSWZ(row, colB) ((row) * 128 + ((colB) ^ ((((row) >> 1) & 7) << 4)))
typedef int i32x8 __attribute__((ext_vector_type(8)));
typedef int i32x4a __attribute__((ext_vector_type(4)));
#define SBAR() __builtin_amdgcn_sched_barrier(0)
__device__ __forceinline__ int crow(int r, int hi) { return (r & 3) + 8 * (r >> 2) + 4 * hi; }
__device__ __forceinline__ unsigned cvtpk(float lo, float hi) {
  unsigned r; asm volatile("v_cvt_pk_bf16_f32 %0, %1, %2" : "=v"(r) : "v"(lo), "v"(hi)); return r;
}
template <typename TIn> struct Stage;
template <> struct Stage<bf16>  { using T = bf16x8;
  __device__ static __forceinline__ T ld8(const bf16* p) { return *reinterpret_cast<const bf16x8*>(p); }
  __device__ static __forceinline__ bf16x8 tobf(T x) { return x; } };
template <> struct Stage<float> { using T = f32x8;
  __device__ static __forceinline__ T ld8(const float* p) { return *reinterpret_cast<const f32x8*>(p); }
  __device__ static __forceinline__ bf16x8 tobf(T x) {
    u32x4 w = {cvtpk(x[0], x[1]), cvtpk(x[2], x[3]), cvtpk(x[4], x[5]), cvtpk(x[6], x[7])}; return *reinterpret_cast<bf16x8*>(&w); } };

__device__ __forceinline__ void partialSM(f32x16& p0, f32x16& p1, float& m_reg, float& mn, float& alpha) {
  constexpr float C = SCALE * 1.4426950408889634f;
  float pmax = p0[0]; for (int r = 1; r < 16; ++r) pmax = fmaxf(pmax, p0[r]); for (int r = 0; r < 16; ++r) pmax = fmaxf(pmax, p1[r]);
  { auto rr = __builtin_amdgcn_permlane32_swap(__float_as_uint(pmax), __float_as_uint(pmax), false, false);
    pmax = fmaxf(__uint_as_float(rr[0]), __uint_as_float(rr[1])); }
  if (__builtin_expect(__all(pmax - m_reg <= THR / SCALE), 1)) { mn = m_reg; alpha = 1.f; }
  else { mn = fmaxf(m_reg, pmax); alpha = __builtin_amdgcn_exp2f((m_reg - mn) * C); m_reg = mn; }
  float mnC = -mn * C;
  for (int r = 0; r < 16; ++r) p0[r] = fmaf(p0[r], C, mnC); for (int r = 0; r < 16; ++r) p1[r] = fmaf(p1[r], C, mnC);
  for (int r = 0; r < 16; ++r) p0[r] = __builtin_amdgcn_exp2f(p0[r]);
}
__device__ __forceinline__ void finishSM(f32x16& p0, f32x16& p1, float alpha, float& l_reg, bf16x8& pa0, bf16x8& pa1, bf16x8& pa2, bf16x8& pa3) {
  for (int r = 0; r < 16; ++r) p1[r] = __builtin_amdgcn_exp2f(p1[r]);
  float ps = 0; for (int r = 0; r < 16; ++r) ps += p0[r]; for (int r = 0; r < 16; ++r) ps += p1[r];
  { auto rr = __builtin_amdgcn_permlane32_swap(__float_as_uint(ps), __float_as_uint(ps), false, false);
    ps = __uint_as_float(rr[0]) + __uint_as_float(rr[1]); }
  l_reg = l_reg * alpha + ps;
#define PK4(P, BASE, OUT) do { unsigned a0 = cvtpk(P[BASE + 0], P[BASE + 1]), a1 = cvtpk(P[BASE + 2], P[BASE + 3]);   \
    unsigned b0 = cvtpk(P[BASE + 4], P[BASE + 5]), b1 = cvtpk(P[BASE + 6], P[BASE + 7]);                              \
    auto r0 = __builtin_amdgcn_permlane32_swap(a0, b0, false, false); auto r1 = __builtin_amdgcn_permlane32_swap(a1, b1, false, false); \
    u32x4 w = {r0[0], r1[0], r0[1], r1[1]}; OUT = *reinterpret_cast<bf16x8*>(&w); } while (0)
  PK4(p0, 0, pa0); PK4(p0, 8, pa1); PK4(p1, 0, pa2); PK4(p1, 8, pa3);
#undef PK4
}
__device__ __forceinline__ void qkt(f32x16& p0, f32x16& p1, const unsigned char* Ks, const i32x8* qf, int r32, int hi) {
  i32x8 ka[2], kb[2];
#pragma unroll
  for (int s = 0; s < 2; ++s) { const int cb = 64 * s + 32 * hi;
    const i32x4a a0 = *reinterpret_cast<const i32x4a*>(Ks + KSWZ(r32, cb)), a1 = *reinterpret_cast<const i32x4a*>(Ks + KSWZ(r32, cb + 16));
    const i32x4a b0 = *reinterpret_cast<const i32x4a*>(Ks + KSWZ(32 + r32, cb)), b1 = *reinterpret_cast<const i32x4a*>(Ks + KSWZ(32 + r32, cb + 16));
    ka[s] = __builtin_shufflevector(a0, a1, 0, 1, 2, 3, 4, 5, 6, 7); kb[s] = __builtin_shufflevector(b0, b1, 0, 1, 2, 3, 4, 5, 6, 7); }
  asm volatile("v_mfma_f32_32x32x64_f8f6f4 %0, %1, %2, 0" : "=&v"(p0) : "v"(ka[0]), "v"(qf[0]));
  asm volatile("v_mfma_f32_32x32x64_f8f6f4 %0, %1, %2, 0" : "=&v"(p1) : "v"(kb[0]), "v"(qf[0]));
  asm volatile("v_mfma_f32_32x32x64_f8f6f4 %0, %1, %2, %0" : "+v"(p0) : "v"(ka[1]), "v"(qf[1]));
  asm volatile("v_mfma_f32_32x32x64_f8f6f4 %0, %1, %2, %0\n\ts_nop 15\n\ts_nop 7" : "+v"(p1) : "v"(kb[1]), "v"(qf[1]));
}
__device__ __forceinline__ int v_st(int k, int c) { const int kk = (k & ~0xC) | ((k & 4) << 1) | ((k & 8) >> 1); return ((kk >> 3) * 4 + (c >> 5)) * 512 + ((kk & 7) * 32 + (c & 31)) * 2; }
__device__ __forceinline__ int v_rd_base(int lane) { return ((lane & 3) << 3) | (((lane >> 2) & 3) << 6) | (((lane >> 4) & 1) << 5) | (((lane >> 5) & 1) << 8); }
constexpr int v_rd_off(int d0, int ks, int half) { return d0 * 512 + ks * 4096 + half * 2048; }
template <int OFF> __device__ __forceinline__ s16x4 tr_read(int vb) {
  s16x4 r; asm volatile("ds_read_b64_tr_b16 %0, %1 offset:%2" : "=&v"(r) : "v"(vb), "i"(OFF) : "memory"); return r;
}
template <int D0> __device__ __forceinline__ void pv_one(f32x16& od, int vb, bf16x8 pa0, bf16x8 pa1, bf16x8 pa2, bf16x8 pa3) {
  const s16x4 l0 = tr_read<v_rd_off(D0, 0, 0)>(vb), h0 = tr_read<v_rd_off(D0, 0, 1)>(vb), l1 = tr_read<v_rd_off(D0, 1, 0)>(vb), h1 = tr_read<v_rd_off(D0, 1, 1)>(vb);
  const s16x4 l2 = tr_read<v_rd_off(D0, 2, 0)>(vb), h2 = tr_read<v_rd_off(D0, 2, 1)>(vb), l3 = tr_read<v_rd_off(D0, 3, 0)>(vb), h3 = tr_read<v_rd_off(D0, 3, 1)>(vb);
  asm volatile("s_waitcnt lgkmcnt(0)" ::: "memory"); SBAR();
#define PK(L, H) (bf16x8){L[0], L[1], L[2], L[3], H[0], H[1], H[2], H[3]}
  od = __builtin_amdgcn_mfma_f32_32x32x16_bf16(pa0, PK(l0, h0), od, 0, 0, 0);
  od = __builtin_amdgcn_mfma_f32_32x32x16_bf16(pa1, PK(l1, h1), od, 0, 0, 0);
  od = __builtin_amdgcn_mfma_f32_32x32x16_bf16(pa2, PK(l2, h2), od, 0, 0, 0);
  od = __builtin_amdgcn_mfma_f32_32x32x16_bf16(pa3, PK(l3, h3), od, 0, 0, 0);
#undef PK
}
__device__ __forceinline__ void pv_d0(f32x16* o, int vb, bf16x8 pa0, bf16x8 pa1, bf16x8 pa2, bf16x8 pa3) {
  pv_one<0>(o[0], vb, pa0, pa1, pa2, pa3); pv_one<1>(o[1], vb, pa0, pa1, pa2, pa3); pv_one<2>(o[2], vb, pa0, pa1, pa2, pa3); pv_one<3>(o[3], vb, pa0, pa1, pa2, pa3);
}

template <typename TQ>
__device__ __forceinline__ void attn_dense_body(const unsigned char* __restrict__ Qb, const unsigned char* __restrict__ Kh, const bf16* __restrict__ Vh,
                                                unsigned char* Ob, const unsigned short* __restrict__ Zb, int seq, char* lds) {
  using St = Stage<bf16>; using SQ = Stage<TQ>;
  int tid = threadIdx.x; asm volatile("" : "+v"(tid));
  const int wid = tid >> 6, lane = tid & 63, r32 = lane & 31, hi = lane >> 5;
  bf16* V_lds = (bf16*)lds; unsigned char* K_lds = (unsigned char*)(lds + 2 * SHM_V);
  float* ws = (float*)(lds + 65536) + wid * 64; float* li_l = ws; float* al_l = ws + 32;
  float m_reg = -1e30f, l_reg = 0; f32x16 o[4] = {}; i32x8 qr[2];
  const unsigned char* Qw = Qb + (long)(wid * QBLK + r32) * LDQ + hi * 32;
#pragma unroll
  for (int s2 = 0; s2 < 2; ++s2) { const i32x4a lo = *reinterpret_cast<const i32x4a*>(Qw + 64 * s2), hi4 = *reinterpret_cast<const i32x4a*>(Qw + 64 * s2 + 16); qr[s2] = __builtin_shufflevector(lo, hi4, 0, 1, 2, 3, 4, 5, 6, 7); }
  const int sr = tid >> 4, sc = (tid & 15) * 8, vst0 = v_st(sr, sc), vst1 = v_st(32 + sr, sc);
  const int kr = tid >> 3, kc = (tid & 7) * 16, kst = KSWZ(kr, kc);
  const int vb0 = (int)(uintptr_t)V_lds + v_rd_base(lane);
  struct { typename St::T vs0, vs1; i32x4a ks; } sr_[SDEPTH];
#define SLOAD(i, k0) do { sr_[i].vs0 = St::ld8(&Vh[(long)((k0) + sr) * LDK + sc]); sr_[i].vs1 = St::ld8(&Vh[(long)((k0) + 32 + sr) * LDK + sc]); \
    sr_[i].ks = *reinterpret_cast<const i32x4a*>(Kh + (long)((k0) + kr) * LDK + kc); } while (0)
#define SWRITE(b, i) do { *(bf16x8*)((char*)V_lds + (b) * SHM_V + vst0) = St::tobf(sr_[i].vs0);          \
    *(bf16x8*)((char*)V_lds + (b) * SHM_V + vst1) = St::tobf(sr_[i].vs1);                                \
    *(i32x4a*)(K_lds + (b) * SHM_K + kst) = sr_[i].ks; } while (0)
#define SWAIT() do { if constexpr (SDEPTH == 2) asm volatile("s_waitcnt vmcnt(3)" ::: "memory"); else asm volatile("s_waitcnt vmcnt(0)" ::: "memory"); } while (0)
#define RESC(a) do { if (__any((a) < 1.f)) { if (hi == 0) al_l[r32] = (a); asm volatile("s_waitcnt lgkmcnt(0)" ::: "memory"); \
    for (int d = 0; d < 4; ++d) for (int r = 0; r < 16; ++r) o[d][r] *= al_l[crow(r, hi)]; } } while (0)
  f32x16 pA0, pA1, pB0, pB1; float mnA, mnB, alA, alB; bf16x8 pa0, pa1, pa2, pa3; const int NT = seq / KVBLK;
  constexpr int SE = 0, SO = SDEPTH - 1;
  SLOAD(SE, 0); asm volatile("s_waitcnt vmcnt(0)" ::: "memory"); SWRITE(0, SE); __syncthreads();
  qkt(pA0, pA1, K_lds, qr, r32, hi); partialSM(pA0, pA1, m_reg, mnA, alA);
  SLOAD(SO, KVBLK); if constexpr (SDEPTH == 2) { if (2 < NT) SLOAD(SE, 2 * KVBLK); }
  SWAIT(); SWRITE(1, SO); __syncthreads();
  for (int j = 1; j + 1 < NT; j += 2) {
    SBAR(); qkt(pB0, pB1, K_lds + SHM_K, qr, r32, hi);
    finishSM(pA0, pA1, alA, l_reg, pa0, pa1, pa2, pa3); SBAR();
    SLOAD(SO, (j + SDEPTH) * KVBLK); SBAR();
    pv_d0(o, vb0, pa0, pa1, pa2, pa3); partialSM(pB0, pB1, m_reg, mnB, alB);
    __syncthreads(); SWAIT(); SWRITE(0, SE);
    RESC(alB); __syncthreads();
    SBAR(); qkt(pA0, pA1, K_lds, qr, r32, hi);
    finishSM(pB0, pB1, alB, l_reg, pa0, pa1, pa2, pa3); SBAR();
    if (SDEPTH == 1 || j + 3 < NT) SLOAD(SE, (j + 1 + SDEPTH) * KVBLK); SBAR();
    pv_d0(o, vb0 + (int)SHM_V, pa0, pa1, pa2, pa3); partialSM(pA0, pA1, m_reg, mnA, alA);
    __syncthreads(); SWAIT(); SWRITE(1, SO);
    RESC(alA); __syncthreads();
  }
  SBAR(); qkt(pB0, pB1, K_lds + SHM_K, qr, r32, hi);
  finishSM(pA0, pA1, alA, l_reg, pa0, pa1, pa2, pa3); SBAR();
  pv_d0(o, vb0, pa0, pa1, pa2, pa3); partialSM(pB0, pB1, m_reg, mnB, alB);
  __syncthreads(); RESC(alB);
  finishSM(pB0, pB1, alB, l_reg, pa0, pa1, pa2, pa3); SBAR();
  pv_d0(o, vb0 + (int)SHM_V, pa0, pa1, pa2, pa3);
  if (hi == 0) li_l[r32] = l_reg; asm volatile("s_waitcnt lgkmcnt(0)" ::: "memory");
  float rli[16];
#pragma unroll
  for (int r = 0; r < 16; ++r) rli[r] = __builtin_amdgcn_rcpf(li_l[crow(r, hi)]);
  __syncthreads();
  { unsigned short* stg = (unsigned short*)(lds + wid * 8192);
#pragma unroll
    for (int r = 0; r < 16; ++r) { const int orow = crow(r, hi);
#pragma unroll
      for (int d0 = 0; d0 < 4; ++d0) { unsigned u = __builtin_bit_cast(unsigned, o[d0][r] * rli[r]); u = (u + 0x7fffu + ((u >> 16) & 1u)) >> 16; stg[orow * 128 + d0 * 32 + r32] = (unsigned short)u; } }
    asm volatile("s_waitcnt lgkmcnt(0)" ::: "memory");
    unsigned char* Ow = Ob + (long)(wid * QBLK) * LDO; const unsigned short* Zw = Zb + (long)(wid * QBLK) * LDZ;
#pragma unroll 2
    for (int i = 0; i < 8; ++i) { const int row = i * 4 + (lane >> 4), ch = lane & 15;
      const u32x4 ov = *(const u32x4*)(stg + row * 128 + ch * 8); const u32x4 zv = *(const u32x4*)(Zw + (long)row * LDZ + ch * 8); float g8[8];
#pragma unroll
      for (int e = 0; e < 4; ++e) { const float z0 = __builtin_bit_cast(float, zv[e] << 16), z1 = __builtin_bit_cast(float, zv[e] & 0xffff0000u);
        g8[2 * e] = __builtin_bit_cast(float, ov[e] << 16) * (z0 * __builtin_amdgcn_rcpf(1.f + __expf(-z0))) * A8_SCALE; g8[2 * e + 1] = __builtin_bit_cast(float, ov[e] & 0xffff0000u) * (z1 * __builtin_amdgcn_rcpf(1.f + __expf(-z1))) * A8_SCALE; }
      typedef unsigned u32x2o __attribute__((ext_vector_type(2)));
      u32x2o w; w.x = pk4f8(g8[0], g8[1], g8[2], g8[3]); w.y = pk4f8(g8[4], g8[5], g8[6], g8[7]);
      *(u32x2o*)(Ow + (long)row * LDO + ch * 8) = w; } }
#undef SLOAD
#undef SWRITE
#undef SWAIT
#undef RESC
}

}
namespace ml {
typedef short bf16x8 __attribute__((ext_vector_type(8)));
typedef short v4i16 __attribute__((ext_vector_type(4)));
typedef float f32x4 __attribute__((ext_vector_type(4)));
typedef float f32x16 __attribute__((ext_vector_type(16)));
typedef unsigned u32x4 __attribute__((ext_vector_type(4)));
typedef unsigned u32x2 __attribute__((ext_vector_type(2)));
#define ML_LAS __attribute__((address_space(3)))
constexpr int BUFB = 65536, Q_OFF = 0, K_OFF = 16384, V_OFF = 32768;
constexpr int P_OFF = 131072, DENP_OFF = P_OFF + 8192, QNP_OFF = DENP_OFF + 512, VEC_OFF = QNP_OFF + 2048, VEC_SLOT = 2 * 256, VR_OFF = VEC_OFF + 2 * VEC_SLOT, NB_OFF = VR_OFF + 8 * 256, LDS_END = NB_OFF + 512;
__device__ __forceinline__ unsigned fxor(unsigned row) { return ((row & 3u) << 2) | ((row >> 2) & 3u); }
__device__ __forceinline__ unsigned off_b(unsigned row, unsigned ch) { return 256u * row + 16u * (ch ^ fxor(row)); }
__device__ __forceinline__ unsigned off_p(unsigned t, unsigned ch) { return 128u * t + 16u * (ch ^ (t & 7u)); }
__device__ __forceinline__ unsigned tr_addr(unsigned lane, unsigned c, unsigned ks, unsigned t) { const unsigned h = lane >> 5, blk = (lane >> 4) & 1u, q = (lane & 15u) >> 2, p = lane & 3u; return off_b(16u * ks + 8u * h + 4u * t + q, 4u * c + 2u * blk + (p >> 1)) + 8u * (p & 1u); }
__device__ __forceinline__ unsigned tr_addr16(unsigned lane, unsigned c, unsigned ks, unsigned t) { const unsigned g = lane >> 4, q = (lane & 15u) >> 2, p = lane & 3u; return off_b(32u * ks + 8u * g + 4u * t + q, 2u * c + (p >> 1)) + 8u * (p & 1u); }
__device__ __forceinline__ v4i16 trrd(ML_LAS unsigned char* p) { return __builtin_amdgcn_ds_read_tr16_b64_v4i16((ML_LAS v4i16*)p); }
template <int OFF> __device__ __forceinline__ v4i16 trra(unsigned addr) { v4i16 r; asm volatile("ds_read_b64_tr_b16 %0, %1 offset:%2" : "=v"(r) : "v"(addr), "i"(OFF) : "memory"); return r; }
__device__ __forceinline__ void glds16(const void* gsrc, unsigned lds_dst) { unsigned keep;
    asm volatile("s_mov_b32 %0, m0\n\ts_mov_b32 m0, %2\n\ts_nop 0\n\tglobal_load_lds_dwordx4 %1, off\n\ts_mov_b32 m0, %0" : "=&s"(keep) : "v"(gsrc), "s"(lds_dst) : "memory"); }
#define ML_TRWAIT() do { asm volatile("s_waitcnt lgkmcnt(0)" ::: "memory"); __builtin_amdgcn_sched_barrier(0); } while (0)
__device__ __forceinline__ bf16x8 cat8(v4i16 lo, v4i16 hi) { return (bf16x8){lo[0], lo[1], lo[2], lo[3], hi[0], hi[1], hi[2], hi[3]}; }
__device__ __forceinline__ unsigned pkbf(float lo, float hi) { unsigned r; asm volatile("v_cvt_pk_bf16_f32 %0, %1, %2" : "=v"(r) : "v"(lo), "v"(hi)); return r; }
__device__ __forceinline__ float s2f(short x) { return __builtin_bit_cast(float, (unsigned)(unsigned short)x << 16); }
__device__ __forceinline__ bf16x8 pack8(float a0, float a1, float a2, float a3, float a4, float a5, float a6, float a7) { u32x4 w = {pkbf(a0, a1), pkbf(a2, a3), pkbf(a4, a5), pkbf(a6, a7)}; return __builtin_bit_cast(bf16x8, w); }
__device__ __forceinline__ float scan_add(float v, int lane) {
#pragma unroll
    for (int o = 1; o < 64; o <<= 1) { const float u = __shfl_up(v, o); if (lane >= o) v += u; }
    return v; }
__device__ __forceinline__ float scan_max(float v, int lane) {
#pragma unroll
    for (int o = 1; o < 64; o <<= 1) { const float u = __shfl_up(v, o); if (lane >= o) v = fmaxf(v, u); }
    return v; }
#define ML_OPAQUE_LANE(ln) unsigned ln = (unsigned)lane; asm volatile("" : "+v"(ln))
__device__ __forceinline__ float rdlane(float v, int l) { return __builtin_bit_cast(float, __builtin_amdgcn_readlane(__builtin_bit_cast(int, v), l)); }

__device__ __forceinline__ void stage(ML_LAS unsigned char* lds, int bsel, int c, int b, int hd, int dir, const unsigned short* MQ, const unsigned short* MK, const unsigned short* MV, int wid, int lane) {
    const int rl = lane >> 4, pos = lane & 15;
#pragma unroll
    for (int half = 0; half < 2; ++half) {
        const int grp = wid + 8 * half, row = 4 * grp + rl, ch = pos ^ ((rl << 2) | (grp & 3));
        const int p = 64 * c + row, tok = dir ? (SEQ - 1 - p) : p; const size_t trow = (size_t)b * SEQ + tok;
        ML_LAS unsigned char* d = lds + bsel * BUFB + grp * 1024;
        __builtin_amdgcn_global_load_lds((const unsigned*)(MQ + trow * 512 + hd * 128 + 8 * ch), (ML_LAS unsigned*)(d + Q_OFF), 16, 0, 0);
        __builtin_amdgcn_global_load_lds((const unsigned*)(MK + trow * 512 + hd * 128 + 8 * ch), (ML_LAS unsigned*)(d + K_OFF), 16, 0, 0);
        __builtin_amdgcn_global_load_lds((const unsigned*)(MV + trow * 1024 + hd * 256 + 8 * ch), (ML_LAS unsigned*)(d + V_OFF), 16, 0, 0);
        __builtin_amdgcn_global_load_lds((const unsigned*)(MV + trow * 1024 + hd * 256 + 128 + 8 * ch), (ML_LAS unsigned*)(d + V_OFF + 16384), 16, 0, 0);
    }
}

#define ML_DPPF(old_, src_, ctrl_, rm_) __builtin_bit_cast(float, __builtin_amdgcn_update_dpp(__builtin_bit_cast(int, (float)(old_)), __builtin_bit_cast(int, (float)(src_)), ctrl_, rm_, 0xf, false))
__device__ __forceinline__ float dscan_add(float v) {
    v += ML_DPPF(0.f, v, 0x111, 0xf); v += ML_DPPF(0.f, v, 0x112, 0xf); v += ML_DPPF(0.f, v, 0x114, 0xf); v += ML_DPPF(0.f, v, 0x118, 0xf);
    v += ML_DPPF(0.f, v, 0x142, 0xa); v += ML_DPPF(0.f, v, 0x143, 0xc); return v; }
__device__ __forceinline__ float dscan_max(float v) { const float NI = -3.0e38f;
    v = fmaxf(v, ML_DPPF(NI, v, 0x111, 0xf)); v = fmaxf(v, ML_DPPF(NI, v, 0x112, 0xf)); v = fmaxf(v, ML_DPPF(NI, v, 0x114, 0xf)); v = fmaxf(v, ML_DPPF(NI, v, 0x118, 0xf));
    v = fmaxf(v, ML_DPPF(NI, v, 0x142, 0xa)); v = fmaxf(v, ML_DPPF(NI, v, 0x143, 0xc)); return v; }

template <int MODE> __device__ __forceinline__ void mlstm_item(unsigned char* ws, ML_LAS unsigned char* lds, int item, int tid) {
    const int lane = tid & 63, wid = __builtin_amdgcn_readfirstlane(tid >> 6);
    const int b = item >> 3, hd = (item >> 1) & 3, dir = item & 1;
    const float* GT = (const float*)(ws + WS_GATES) + dir * 8 + hd;
    ML_LAS float* DENP = (ML_LAS float*)(lds + DENP_OFF); ML_LAS float* QNP = (ML_LAS float*)(lds + QNP_OFF); ML_LAS float* NB = (ML_LAS float*)(lds + NB_OFF + wid * 64);
    unsigned dq0, dq1, dv0, dv1;
    { const int rl = lane >> 4, pos = lane & 15;
      const int g0 = wid, g1 = wid + 8; const int r0 = 4 * g0 + rl, r1 = 4 * g1 + rl; const int c0 = pos ^ ((rl << 2) | (g0 & 3)), c1 = pos ^ ((rl << 2) | (g1 & 3));
      const int m0 = dir ? 63 - r0 : r0, m1 = dir ? 63 - r1 : r1;
      dq0 = (unsigned)(m0 * 1024 + 16 * c0); dq1 = (unsigned)(m1 * 1024 + 16 * c1); dv0 = (unsigned)(m0 * 2048 + 16 * c0); dv1 = (unsigned)(m1 * 2048 + 16 * c1); }
    const unsigned goff = (unsigned)((dir ? 63 - lane : lane) * 64);
    unsigned trL0, trL1, trX;
    { const unsigned h = lane >> 5, blk = (lane >> 4) & 1u, q = (lane & 15u) >> 2, p = lane & 3u; const unsigned A = 256u * (8u * h + q) + 8u * (p & 1u), lo = 2u * blk + (p >> 1);
      trL0 = A + 16u * (lo ^ ((2u * h) & 3u)); trL1 = A + 16u * (lo ^ ((2u * h + 1u) & 3u)) + 1024u; trX = 64u * q; }
    f32x16 C[4]; f32x4 n4 = {0.f, 0.f, 0.f, 0.f};
#pragma unroll
    for (int i = 0; i < 4; ++i) C[i] = (f32x16){0.f};
    const char* gq = (const char*)(ws + WS_MQ) + ((size_t)b * SEQ * 512 + hd * 128) * 2; const char* gk = (const char*)(ws + WS_MK) + ((size_t)b * SEQ * 512 + hd * 128) * 2;
    const char* gv = (const char*)(ws + WS_MV) + ((size_t)b * SEQ * 1024 + hd * 256) * 2; const char* gg = (const char*)GT + (size_t)b * SEQ * 64;
    unsigned char* ho = ws + (dir ? WS_HB : WS_HF) + ((size_t)(b * 4 + hd) * 32) * 32768 + wid * 4096 + lane * 16;
    const unsigned lds0 = (unsigned)(uintptr_t)lds;
#define ML_TB(c_) (MODE == 1 ? (dir ? (SEQ - 64) : 0) : (dir ? (SEQ - 64 * ((c_) + 1)) : 64 * (c_)))
#define ML_STAGE(bsel_, c_) do { const int tb_ = ML_TB(c_); const unsigned d_ = (unsigned)__builtin_amdgcn_readfirstlane((int)(lds0 + (bsel_) * BUFB + wid * 1024)); \
        const char* q_ = gq + (size_t)tb_ * 1024; const char* k_ = gk + (size_t)tb_ * 1024; const char* v_ = gv + (size_t)tb_ * 2048; \
        glds16(q_ + dq0, d_ + Q_OFF); glds16(q_ + dq1, d_ + Q_OFF + 8192); glds16(k_ + dq0, d_ + K_OFF); glds16(k_ + dq1, d_ + K_OFF + 8192); \
        glds16(v_ + dv0, d_ + V_OFF); glds16(v_ + dv1, d_ + V_OFF + 8192); glds16(v_ + 256 + dv0, d_ + V_OFF + 16384); glds16(v_ + 256 + dv1, d_ + V_OFF + 16384 + 8192); } while (0)
#define ML_GATES(c_, gi_, gf_) do { const char* g_ = gg + (size_t)ML_TB(c_) * 64 + goff; gi_ = *(const float*)g_; gf_ = *(const float*)(g_ + 16); } while (0)
#define ML_VEC(cc_, gi_, gf_, sc_out_) do { ML_LAS float* T_ = (ML_LAS float*)(lds + VEC_OFF + ((cc_) & 1) * VEC_SLOT); \
        const float bcs_ = dscan_add(gf_), cx_ = (gi_) - bcs_, cm_ = dscan_max(cx_), M_ = fmaxf(m, cm_); const float g_ = rdlane(bcs_, 63), M63_ = rdlane(M_, 63); \
        T_[lane] = __expf(cx_ - M63_); T_[64 + lane] = __expf(-(bcs_ + M63_)); \
        sc_out_ = __expf(m - M63_); m = g_ + M63_; } while (0)
    float m = 0.f, sc, sc_n = 1.f, gi_a, gf_a, gi_b = 0.f, gf_b = 0.f; u32x4 pend[4] = {{0u, 0u, 0u, 0u}, {0u, 0u, 0u, 0u}, {0u, 0u, 0u, 0u}, {0u, 0u, 0u, 0u}};
    ML_STAGE(0, 0); ML_GATES(0, gi_a, gf_a); ML_VEC(0, gi_a, gf_a, sc); ML_GATES(1, gi_a, gf_a);
    for (int c = 0; c < SEQ / 64; ++c) {
        const int bsel = c & 1;
        ML_LAS unsigned char* bQ = lds + bsel * BUFB + Q_OFF; ML_LAS unsigned char* bK = lds + bsel * BUFB + K_OFF; ML_LAS unsigned char* bV = lds + bsel * BUFB + V_OFF;
        ML_LAS float* VWE = (ML_LAS float*)(lds + VEC_OFF + bsel * VEC_SLOT); ML_LAS float* VEMT = VWE + 64; ML_LAS float* VR = (ML_LAS float*)(lds + VR_OFF + wid * 256);
        asm volatile("s_waitcnt vmcnt(0) lgkmcnt(0)" ::: "memory"); __builtin_amdgcn_s_barrier(); asm volatile("" ::: "memory");
        if (c > 0) { unsigned char* hc = ho + (size_t)(c - 1) * 32768; *(u32x4*)(hc) = pend[0]; *(u32x4*)(hc + 1024) = pend[1]; *(u32x4*)(hc + 2048) = pend[2]; *(u32x4*)(hc + 3072) = pend[3]; }
        if (c + 1 < SEQ / 64) { ML_STAGE(bsel ^ 1, c + 1);
            if (c + 2 < SEQ / 64) ML_GATES(c + 2, gi_b, gf_b);
            ML_VEC(c + 1, gi_a, gf_a, sc_n); }
        if (MODE == 2) { asm volatile("s_waitcnt lgkmcnt(0)" ::: "memory"); __builtin_amdgcn_s_barrier(); continue; }
        { ML_OPAQUE_LANE(ln); const unsigned r15 = ln & 15u, kg = ln >> 4; const int tj = wid >> 1, sb = (wid & 1) * 2; const unsigned t = 16u * tj + r15;
          const unsigned xq = fxor(r15) << 4;
          ML_LAS unsigned char* qrow = bQ + 256u * t;
          bf16x8 qf[4];
#pragma unroll
          for (int ks = 0; ks < 4; ++ks) qf[ks] = *(const ML_LAS bf16x8*)(qrow + (((4u * ks + kg) << 4) ^ xq));
          float dsum = 0.f; const unsigned hb = 8u * (kg & 1u), kh = kg >> 1;
#pragma unroll
          for (int u = 0; u < 2; ++u) { const unsigned si = sb + u; ML_LAS unsigned char* krow = bK + 256u * (16u * si + r15) + hb;
              f32x4 acc = {0.f, 0.f, 0.f, 0.f};
#pragma unroll
              for (int ks = 0; ks < 4; ++ks) { const unsigned g2 = 4u * ks + 2u * kh;
                  const u32x2 lo = *(const ML_LAS u32x2*)(krow + ((g2 << 4) ^ xq)), hi = *(const ML_LAS u32x2*)(krow + (((g2 + 1u) << 4) ^ xq));
                  const u32x4 kw = {lo.x, lo.y, hi.x, hi.y};
                  acc = __builtin_amdgcn_mfma_f32_16x16x32_bf16(__builtin_bit_cast(bf16x8, kw), qf[ks], acc, 0, 0, 0); }
              const unsigned s0 = 16u * si + 4u * kg; const f32x4 ws4 = *(const ML_LAS f32x4*)(VWE + s0);
              float p[4];
#pragma unroll
              for (int r = 0; r < 4; ++r) { p[r] = (s0 + r <= t) ? acc[r] : 0.f; dsum = fmaf(p[r], ws4[r], dsum); }
              const u32x2 pw = {pkbf(p[0], p[1]), pkbf(p[2], p[3])};
              *(ML_LAS u32x2*)(lds + P_OFF + 128u * t + (((2u * si + kh) ^ (t & 7u)) << 4) + hb) = pw; }
          dsum += __shfl_xor(dsum, 16); dsum += __shfl_xor(dsum, 32);
          if (ln < 16u) DENP[(wid & 1) * 64 + t] = dsum; }
        n4 = n4 * sc;
        { ML_OPAQUE_LANE(ln); const unsigned r15 = ln & 15u, kg = ln >> 4; if (r15 == 0) *(ML_LAS f32x4*)(NB + 4 * kg) = n4;
          const f32x4 nA = *(const ML_LAS f32x4*)(NB + 0), nB = *(const ML_LAS f32x4*)(NB + 4), nC = *(const ML_LAS f32x4*)(NB + 8), nD = *(const ML_LAS f32x4*)(NB + 12);
          const unsigned t = ln; ML_LAS unsigned char* qrow = bQ + 256u * t; const unsigned xq = fxor(t) << 4;
          const bf16x8 c0 = *(const ML_LAS bf16x8*)(qrow + (((2u * wid) << 4) ^ xq)), c1 = *(const ML_LAS bf16x8*)(qrow + (((2u * wid + 1u) << 4) ^ xq));
          float qn = 0.f;
#pragma unroll
          for (int e = 0; e < 4; ++e) { qn = fmaf(s2f(c0[e]), nA[e], qn); qn = fmaf(s2f(c0[4 + e]), nC[e], qn); qn = fmaf(s2f(c1[e]), nB[e], qn); qn = fmaf(s2f(c1[4 + e]), nD[e], qn); }
          QNP[wid * 64 + t] = qn; }
        f32x16 Y0, Y1;
        { ML_OPAQUE_LANE(ln); const unsigned r31 = ln & 31u, h5 = ln >> 5; const unsigned xq = fxor(r31) << 4; ML_LAS unsigned char* q0 = bQ + 256u * r31; ML_LAS unsigned char* q1 = q0 + 256u * 32u;
#pragma unroll
          for (int i = 0; i < 4; ++i) { C[i] = C[i] * sc;
#pragma unroll
              for (int s = 0; s < 2; ++s) { const bf16x8 bfr = pack8(C[i][8 * s + 0], C[i][8 * s + 1], C[i][8 * s + 2], C[i][8 * s + 3], C[i][8 * s + 4], C[i][8 * s + 5], C[i][8 * s + 6], C[i][8 * s + 7]);
                  const unsigned co = ((4u * i + 2u * s + h5) << 4) ^ xq;
                  const bf16x8 a0 = *(const ML_LAS bf16x8*)(q0 + co), a1 = *(const ML_LAS bf16x8*)(q1 + co);
                  if (i == 0 && s == 0) { Y0 = __builtin_amdgcn_mfma_f32_32x32x16_bf16(a0, bfr, (f32x16){0.f}, 0, 0, 0); Y1 = __builtin_amdgcn_mfma_f32_32x32x16_bf16(a1, bfr, (f32x16){0.f}, 0, 0, 0); }
                  else { Y0 = __builtin_amdgcn_mfma_f32_32x32x16_bf16(a0, bfr, Y0, 0, 0, 0); Y1 = __builtin_amdgcn_mfma_f32_32x32x16_bf16(a1, bfr, Y1, 0, 0, 0); } } } }
        bf16x8 vw[4];
        { ML_OPAQUE_LANE(ln); const unsigned h5 = ln >> 5, kg = ln >> 4; const unsigned vt = wid >> 2, vc = wid & 3; bf16x8 vf[4];
          ML_LAS unsigned char* v0 = bV + 16384u * vt + ((64u * vc) ^ trX); ML_LAS unsigned char* va = v0 + trL0; ML_LAS unsigned char* vb = v0 + trL1;
#pragma unroll
          for (int ks = 0; ks < 4; ++ks) vf[ks] = cat8(trrd(va + 4096 * ks), trrd(vb + 4096 * ks));
          ML_LAS float* vwe = VWE + 8 * h5;
#pragma unroll
          for (int ks = 0; ks < 4; ++ks) { const f32x4 w0 = *(const ML_LAS f32x4*)(vwe + 16 * ks), w1 = *(const ML_LAS f32x4*)(vwe + 16 * ks + 4);
              vw[ks] = pack8(s2f(vf[ks][0]) * w0[0], s2f(vf[ks][1]) * w0[1], s2f(vf[ks][2]) * w0[2], s2f(vf[ks][3]) * w0[3], s2f(vf[ks][4]) * w1[0], s2f(vf[ks][5]) * w1[1], s2f(vf[ks][6]) * w1[2], s2f(vf[ks][7]) * w1[3]); }
          ML_LAS unsigned char* ka = bK + trL0; ML_LAS unsigned char* kb = bK + trL1;
#pragma unroll
          for (int i = 0; i < 4; ++i) { const unsigned xo = (64u * i) ^ trX;
#pragma unroll
              for (int ks = 0; ks < 4; ++ks) C[i] = __builtin_amdgcn_mfma_f32_32x32x16_bf16(cat8(trrd(ka + xo + 4096 * ks), trrd(kb + xo + 4096 * ks)), vw[ks], C[i], 0, 0, 0); }
          ML_LAS unsigned char* t16a = bK + tr_addr16(ln, wid, 0, 0); ML_LAS unsigned char* t16b = bK + tr_addr16(ln, wid, 0, 1);
#pragma unroll
          for (int ks = 0; ks < 2; ++ks) { const bf16x8 af = cat8(trrd(t16a + 8192 * ks), trrd(t16b + 8192 * ks));
              const f32x4 w0 = *(const ML_LAS f32x4*)(VWE + 32 * ks + 8 * kg), w1 = *(const ML_LAS f32x4*)(VWE + 32 * ks + 8 * kg + 4);
              n4 = __builtin_amdgcn_mfma_f32_16x16x32_bf16(af, pack8(w0[0], w0[1], w0[2], w0[3], w1[0], w1[1], w1[2], w1[3]), n4, 0, 0, 0); } }
        asm volatile("s_waitcnt lgkmcnt(0)" ::: "memory"); __builtin_amdgcn_s_barrier(); asm volatile("" ::: "memory");
        { ML_OPAQUE_LANE(ln); const unsigned r31 = ln & 31u, h5 = ln >> 5;
          ML_LAS unsigned char* p0 = lds + P_OFF + 128u * r31; ML_LAS unsigned char* p1 = p0 + 128u * 32u; const unsigned xp = (r31 & 7u) << 4;
#pragma unroll
          for (int ks = 0; ks < 4; ++ks) { const unsigned co = ((2u * ks + h5) << 4) ^ xp;
              const bf16x8 a0 = *(const ML_LAS bf16x8*)(p0 + co), a1 = *(const ML_LAS bf16x8*)(p1 + co);
              Y0 = __builtin_amdgcn_mfma_f32_32x32x16_bf16(a0, vw[ks], Y0, 0, 0, 0); Y1 = __builtin_amdgcn_mfma_f32_32x32x16_bf16(a1, vw[ks], Y1, 0, 0, 0); } }
        { ML_OPAQUE_LANE(ln); const unsigned t = ln; float qs = 0.f;
#pragma unroll
          for (int w8 = 0; w8 < 8; ++w8) qs += QNP[w8 * 64 + t];
          const float dn = DENP[t] + DENP[64 + t] + qs; VR[t] = 1.f / fmaxf(fabsf(dn), VEMT[t]); }
        { ML_OPAQUE_LANE(ln); const unsigned h5 = ln >> 5; ML_LAS float* vr = VR + 4 * h5;
#pragma unroll
          for (int qp = 0; qp < 2; ++qp) { const f32x4 ra = *(const ML_LAS f32x4*)(vr + 16 * qp), rb = *(const ML_LAS f32x4*)(vr + 16 * qp + 8), rc = *(const ML_LAS f32x4*)(vr + 32 + 16 * qp), rd = *(const ML_LAS f32x4*)(vr + 32 + 16 * qp + 8);
              const int o = 8 * qp;
              const u32x4 w0 = {pkbf(Y0[o + 0] * ra[0], Y0[o + 1] * ra[1]), pkbf(Y0[o + 2] * ra[2], Y0[o + 3] * ra[3]), pkbf(Y0[o + 4] * rb[0], Y0[o + 5] * rb[1]), pkbf(Y0[o + 6] * rb[2], Y0[o + 7] * rb[3])};
              const u32x4 w1 = {pkbf(Y1[o + 0] * rc[0], Y1[o + 1] * rc[1]), pkbf(Y1[o + 2] * rc[2], Y1[o + 3] * rc[3]), pkbf(Y1[o + 4] * rd[0], Y1[o + 5] * rd[1]), pkbf(Y1[o + 6] * rd[2], Y1[o + 7] * rd[3])};
              pend[qp] = w0; pend[2 + qp] = w1; } }
        asm volatile("" : "+v"(gi_b), "+v"(gf_b));
        sc = sc_n; gi_a = gi_b; gf_a = gf_b;
    }
    { unsigned char* hc = ho + (size_t)(SEQ / 64 - 1) * 32768; *(u32x4*)(hc) = pend[0]; *(u32x4*)(hc + 1024) = pend[1]; *(u32x4*)(hc + 2048) = pend[2]; *(u32x4*)(hc + 3072) = pend[3]; }
#undef ML_STAGE
#undef ML_GATES
#undef ML_VEC
#undef ML_TB
    __syncthreads();
}
}

constexpr int NWAVES = 8;
constexpr int RING_BYTES = 131072;
constexpr int LDS_BYTES = 163840;
constexpr int XCH_OFF = RING_BYTES, ROPE_LDS_OFF = XCH_OFF + 8192, QKG_LDS_OFF = ROPE_LDS_OFF + 16384, SCL_LDS_OFF = QKG_LDS_OFF + 1024;
static_assert(SCL_LDS_OFF + 4096 <= LDS_BYTES - 16, "in-projection LDS map");
static_assert(ml::LDS_END <= LDS_BYTES, "mLSTM LDS map");
#define LAS __attribute__((address_space(3)))
#define GAS __attribute__((address_space(1)))
typedef unsigned v4u __attribute__((ext_vector_type(4)));
typedef unsigned v2u __attribute__((ext_vector_type(2)));
typedef float f32x4 __attribute__((ext_vector_type(4)));
#define LDS_WAIT() asm volatile("s_waitcnt lgkmcnt(0)" ::: "memory")

struct Args { const float* in[9]; float* out; unsigned char* ws; int ph_lo, ph_hi; };

__device__ __forceinline__ float wave_sum(float v) {
#pragma unroll
    for (int o = 1; o < 64; o <<= 1) v += __shfl_xor(v, o);
    return v;
}

#define XB_TMO      128
#define XB_XCNT(j)  (256  + 64 * (j))
#define XB_XSUB(j)  (1280 + 64 * (j))
#define XB_XGEN(j)  (2304 + 64 * (j))
#define XB_TOP      3328
#define XB_TOPGEN   3392
#define XCD_BAR_WORDS 3456
#define XB_SPIN_CAP (1u << 18)

__device__ __forceinline__ unsigned xb_ld(unsigned* p)              { return __hip_atomic_load(p, __ATOMIC_RELAXED, __HIP_MEMORY_SCOPE_AGENT); }
__device__ __forceinline__ unsigned xb_add(unsigned* p, unsigned v) { return __hip_atomic_fetch_add(p, v, __ATOMIC_RELAXED, __HIP_MEMORY_SCOPE_AGENT); }
__device__ __forceinline__ unsigned xb_xcc_id() { return (unsigned)__builtin_amdgcn_s_getreg((3 << 11) | 20) & 0xFu; }
#define XB_SPIN(cond, bar) do { unsigned _sp = 0; while (cond) { __builtin_amdgcn_s_sleep(1); \
    if ((++_sp & 255u) == 0u) { if (xb_ld(&(bar)[XB_TMO])) break; if (_sp > XB_SPIN_CAP) { atomicAdd(&(bar)[XB_TMO], 1u); break; } } } } while (0)

struct XcdBarrier {
    unsigned* bar; unsigned x;
    volatile LAS unsigned* st;
};

__device__ __forceinline__ XcdBarrier xcd_barrier_post(unsigned* bar, volatile LAS unsigned* st) {
    XcdBarrier b; b.bar = bar; b.x = xb_xcc_id(); b.st = st;
    if (threadIdx.x == 0) (void)xb_add(&bar[XB_XCNT(b.x)], 1u);
    return b;
}
__device__ __forceinline__ void xcd_barrier_complete(unsigned* bar, unsigned x, unsigned& nloc, unsigned& nx) {
    const unsigned G = gridDim.x * gridDim.y * gridDim.z;
    unsigned sum, cnt, mine, sp = 0u;
    for (;;) {
        sum = 0u; cnt = 0u; mine = 0u;
#pragma unroll
        for (unsigned j = 0; j < 16; ++j) { const unsigned c = xb_ld(&bar[XB_XCNT(j)]); sum += c; cnt += (c > 0u) ? 1u : 0u; mine = (j == x) ? c : mine; }
        if (sum == G) break;
        __builtin_amdgcn_s_sleep(1);
        if ((++sp & 255u) == 0u) { if (xb_ld(&bar[XB_TMO])) break; if (sp > XB_SPIN_CAP) { atomicAdd(&bar[XB_TMO], 1u); break; } }
    }
    nloc = mine > 0u ? mine : 1u; nx = cnt > 0u ? cnt : 1u;
}

__device__ __forceinline__ void xcd_barrier(const XcdBarrier& b) {
    asm volatile("s_waitcnt vmcnt(0)" ::: "memory");
    __syncthreads();
    if (threadIdx.x == 0) {
        unsigned* bar = b.bar;
        __builtin_amdgcn_s_waitcnt(0);
        unsigned nloc = b.st[0], nx = b.st[1];
        if (nloc == 0u) { xcd_barrier_complete(bar, b.x, nloc, nx); b.st[0] = nloc; b.st[1] = nx; }
        const unsigned old = xb_add(&bar[XB_XSUB(b.x)], 1u);
        const unsigned gen = old / nloc;
        if (old + 1u == (gen + 1u) * nloc) {
            __builtin_amdgcn_fence(__ATOMIC_RELEASE, "agent");
            asm volatile("s_waitcnt vmcnt(0)" ::: "memory");
            const unsigned og = xb_add(&bar[XB_TOP], 1u);
            const unsigned tg = og / nx;
            if (og + 1u == (tg + 1u) * nx) xb_add(&bar[XB_TOPGEN], 1u);
            else XB_SPIN(xb_ld(&bar[XB_TOPGEN]) == tg, bar);
            __builtin_amdgcn_fence(__ATOMIC_ACQUIRE, "agent");
            xb_add(&bar[XB_XGEN(b.x)], 1u);
            asm volatile("s_waitcnt vmcnt(0)" ::: "memory");
        } else {
            XB_SPIN(xb_ld(&bar[XB_XGEN(b.x)]) == gen, bar);
            __builtin_amdgcn_fence(__ATOMIC_ACQUIRE, "agent");
            asm volatile("s_waitcnt vmcnt(0)" ::: "memory");
        }
    }
    __syncthreads();
}

__device__ __forceinline__ int w1_dest_row(int n) {
    if (!HY_SEPARATE_ROPE && n < 1280) { const int s = n & 255; return (n & ~255) | (s & 0xC3) | ((s & 0x10) << 1) | ((s & 0x0C) << 1) | ((s & 0x20) >> 3); }
    if (n >= 2560 && n < 3072) return (n & ~12) | ((n & 4) << 1) | ((n & 8) >> 1);
    return n;
}
__device__ __forceinline__ int q8_dest_row(int n) { return n < NQA ? w1_dest_row(n) : n - (NB1 - NB0); }
__device__ __forceinline__ unsigned pk4i8(float a, float b, float c, float d) {
    int ia = (int)__builtin_rintf(a), ib = (int)__builtin_rintf(b), ic = (int)__builtin_rintf(c), id = (int)__builtin_rintf(d);
    ia = ia < -127 ? -127 : (ia > 127 ? 127 : ia); ib = ib < -127 ? -127 : (ib > 127 ? 127 : ib); ic = ic < -127 ? -127 : (ic > 127 ? 127 : ic); id = id < -127 ? -127 : (id > 127 ? 127 : id);
    return ((unsigned)ia & 0xffu) | (((unsigned)ib & 0xffu) << 8) | (((unsigned)ic & 0xffu) << 16) | ((unsigned)id << 24); }
template <int MODE>
__device__ __forceinline__ void p0_transpose_item(const float* W, int K, int ldw, int kb, int n0, void* WT, LAS float* scr, int lane, const LAS float* cinv) {
    const int k0 = 64 * kb;
#pragma unroll 8
    for (int i = 0; i < 32; ++i) { const int kk = 2 * i + (lane >> 5); scr[kk * 33 + (lane & 31)] = W[(size_t)(k0 + kk) * ldw + n0 + (lane & 31)]; }
    LDS_WAIT(); asm volatile("" ::: "memory");
    const int c = lane & 7;
#pragma unroll
    for (int j = 0; j < 4; ++j) { const int n = (lane >> 3) + 8 * j; const LAS float* s = scr + (8 * c) * 33 + n;
        if constexpr (MODE == 2) { const float ci = cinv[n];
            v2u o8; o8.x = pk4i8(s[0 * 33] * ci, s[1 * 33] * ci, s[2 * 33] * ci, s[3 * 33] * ci); o8.y = pk4i8(s[4 * 33] * ci, s[5 * 33] * ci, s[6 * 33] * ci, s[7 * 33] * ci);
            *(v2u*)((unsigned char*)WT + (size_t)q8_dest_row(n0 + n) * K + k0 + 8 * c) = o8; }
        else if constexpr (MODE == 3) { unsigned char* rowp = (unsigned char*)WT + (size_t)(n0 + n) * 4096;
            if (kb < 16) { v2u o8; o8.x = pk4f8(s[0 * 33] * W8_SCALE, s[1 * 33] * W8_SCALE, s[2 * 33] * W8_SCALE, s[3 * 33] * W8_SCALE); o8.y = pk4f8(s[4 * 33] * W8_SCALE, s[5 * 33] * W8_SCALE, s[6 * 33] * W8_SCALE, s[7 * 33] * W8_SCALE);
                *(v2u*)(rowp + k0 + 8 * c) = o8; }
            else { v4u o; o.x = pk2(s[0 * 33], s[1 * 33]); o.y = pk2(s[2 * 33], s[3 * 33]); o.z = pk2(s[4 * 33], s[5 * 33]); o.w = pk2(s[6 * 33], s[7 * 33]);
                *(v4u*)(rowp + 1024 + (size_t)(k0 - 1024 + 8 * c) * 2) = o; } }
        else { const float ws_ = (MODE == 1 && n0 + n < 3072) ? 0.08838834764831845f : 1.f;
            v4u o; o.x = pk2(s[0 * 33] * ws_, s[1 * 33] * ws_); o.y = pk2(s[2 * 33] * ws_, s[3 * 33] * ws_); o.z = pk2(s[4 * 33] * ws_, s[5 * 33] * ws_); o.w = pk2(s[6 * 33] * ws_, s[7 * 33] * ws_);
            const int nr = (MODE == 1) ? w1_dest_row(n0 + n) - NB0 : n0 + n;
            *(v4u*)((bf16*)WT + (size_t)nr * K + k0 + 8 * c) = o; } }
    LDS_WAIT(); asm volatile("" ::: "memory");
}
__device__ __forceinline__ void p0_q8_colblock(const float* w_in, unsigned char* ws, LAS unsigned char* lds, int cb, int tid, int wave, int lane) {
    const int n0 = cb < NQA / 32 ? 32 * cb : NB1 + 32 * (cb - NQA / 32);
    LAS float* red = (LAS float*)(lds + 8 * 16384);
    const int c4 = (lane & 7) * 4, kr = lane >> 3;
    const float* src = w_in + (size_t)(256 * wave + kr) * NPROJ + n0 + c4;
    f32x4 mx = {0.f, 0.f, 0.f, 0.f};
#pragma unroll 8
    for (int i = 0; i < 32; ++i) { const f32x4 v = *(const f32x4*)(src + (size_t)(8 * i) * NPROJ);
        mx.x = fmaxf(mx.x, fabsf(v.x)); mx.y = fmaxf(mx.y, fabsf(v.y)); mx.z = fmaxf(mx.z, fabsf(v.z)); mx.w = fmaxf(mx.w, fabsf(v.w)); }
#pragma unroll
    for (int o = 8; o < 64; o <<= 1) { mx.x = fmaxf(mx.x, __shfl_xor(mx.x, o)); mx.y = fmaxf(mx.y, __shfl_xor(mx.y, o)); mx.z = fmaxf(mx.z, __shfl_xor(mx.z, o)); mx.w = fmaxf(mx.w, __shfl_xor(mx.w, o)); }
    if (lane < 8) *(LAS f32x4*)(red + wave * 32 + c4) = mx;
    __syncthreads();
    if (tid < 32) { float m = red[tid];
#pragma unroll
        for (int w = 1; w < 8; ++w) m = fmaxf(m, red[w * 32 + tid]);
        m = fmaxf(m, 1e-30f); red[256 + tid] = 127.f / m; ((float*)(ws + WS_SW))[q8_dest_row(n0 + tid)] = m * (1.f / 127.f); }
    __syncthreads();
    LAS float* scr = (LAS float*)(lds + wave * 16384);
    for (int i = 0; i < 4; ++i) p0_transpose_item<2>(w_in, DM, NPROJ, 4 * wave + i, n0, ws + WS_W8T, scr, lane, red + 256);
    __syncthreads();
}
__device__ __forceinline__ float wave_max(float v) {
#pragma unroll
    for (int o = 1; o < 64; o <<= 1) v = fmaxf(v, __shfl_xor(v, o));
    return v;
}
__device__ __forceinline__ void rms_rows2_to_bf16(const float* xrow0, const float* xrow1, const float* g, bf16* orow0, bf16* orow1, unsigned char* frow0, unsigned char* frow1, float* sa0, float* sa1, int lane) {
    const f32x4* xa = (const f32x4*)xrow0 + lane; const f32x4* xb = (const f32x4*)xrow1 + lane; const f32x4* gr = (const f32x4*)g + lane;
    f32x4 v[8], w[8]; float s = 0.f, t = 0.f;
#pragma unroll
    for (int j = 0; j < 8; ++j) { v[j] = __builtin_nontemporal_load(xa + 64 * j); w[j] = __builtin_nontemporal_load(xb + 64 * j); }
#pragma unroll
    for (int j = 0; j < 8; ++j) { s += (v[j].x * v[j].x + v[j].y * v[j].y) + (v[j].z * v[j].z + v[j].w * v[j].w); t += (w[j].x * w[j].x + w[j].y * w[j].y) + (w[j].z * w[j].z + w[j].w * w[j].w); }
    const float r0 = 1.f / sqrtf(wave_sum(s) * (1.f / DM) + EPS), r1 = 1.f / sqrtf(wave_sum(t) * (1.f / DM) + EPS);
    float m0 = 0.f, m1 = 0.f;
#pragma unroll
    for (int j = 0; j < 8; ++j) { const f32x4 gg = gr[64 * j]; v[j] = v[j] * r0 * gg; w[j] = w[j] * r1 * gg;
        m0 = fmaxf(fmaxf(m0, fmaxf(fabsf(v[j].x), fabsf(v[j].y))), fmaxf(fabsf(v[j].z), fabsf(v[j].w))); m1 = fmaxf(fmaxf(m1, fmaxf(fabsf(w[j].x), fabsf(w[j].y))), fmaxf(fabsf(w[j].z), fabsf(w[j].w))); }
    m0 = fmaxf(wave_max(m0), 1e-30f); m1 = fmaxf(wave_max(m1), 1e-30f);
    const float i0 = 127.f / m0, i1 = 127.f / m1;
    if (lane == 0) { *sa0 = m0 * (1.f / 127.f); *sa1 = m1 * (1.f / 127.f); }
    v2u* o0 = (v2u*)orow0 + lane; v2u* o1 = (v2u*)orow1 + lane; unsigned* f0 = (unsigned*)frow0 + lane; unsigned* f1 = (unsigned*)frow1 + lane;
#pragma unroll
    for (int j = 0; j < 8; ++j) { v2u a, b;
        a.x = pk2(v[j].x, v[j].y); a.y = pk2(v[j].z, v[j].w); o0[64 * j] = a; f0[64 * j] = pk4i8(v[j].x * i0, v[j].y * i0, v[j].z * i0, v[j].w * i0);
        b.x = pk2(w[j].x, w[j].y); b.y = pk2(w[j].z, w[j].w); o1[64 * j] = b; f1[64 * j] = pk4i8(w[j].x * i1, w[j].y * i1, w[j].z * i1, w[j].w * i1); }
}
__device__ __forceinline__ void p0_prologue(const Args& a, LAS unsigned char* lds, int vcu, int G, int tid, int wave, int lane) {
    unsigned char* ws = a.ws;
    const float* w_in = a.in[3]; const float* w_out = a.in[8]; const float* norm_g = a.in[2];
    bf16* W2t = (bf16*)(ws + WS_W2T);
    const int gw = vcu * NWAVES + wave, NGW = G * NWAVES; const int gt = vcu * (NWAVES * 64) + tid, NGT = G * NWAVES * 64;
    for (int e = gt; e < 64 * 32; e += NGT) { const int pos = e >> 5, j = e & 31; const float inv = 1.0f / powf(10000.0f, (float)j * (1.0f / 32.0f)); const float ang = (float)pos * inv;
        float* R = (float*)(ws + WS_ROPE); R[2 * e] = cosf(ang); R[2 * e + 1] = sinf(ang); }
    for (int e = gt; e < 16 * DM; e += NGT) { const int g = e >> 11, k = e & (DM - 1); ((bf16*)(ws + WS_WGT))[(size_t)g * DM + k] = (bf16)f2bf(w_in[(size_t)k * NPROJ + NP256 + g]); }
    for (int cb = vcu; cb < NQ8 / 32; cb += G) p0_q8_colblock(w_in, ws, lds, cb, tid, wave, lane);
    LAS float* scr = (LAS float*)(lds + wave * 16384);
    constexpr int I_1 = (DM / 64) * ((NB1 - NB0) / 32), I_2 = (DM / 64) * (DM / 32);
    for (int it = gw; it < I_1 + I_2; it += NGW) {
        if (it < I_1) p0_transpose_item<1>(w_in, DM, NPROJ, it / ((NB1 - NB0) / 32), NB0 + 32 * (it % ((NB1 - NB0) / 32)), ws + WS_W1B, scr, lane, nullptr);
        else p0_transpose_item<3>(w_out, DM, DM, (it - I_1) / (DM / 32), 32 * ((it - I_1) % (DM / 32)), W2t, scr, lane, nullptr);
    }
    bf16* H = (bf16*)(ws + WS_H); unsigned char* H8 = (unsigned char*)a.out; float* SA = (float*)(ws + WS_SA);
    for (int m = gw; m < NTOK; m += 2 * NGW) { const int m1 = (m + NGW < NTOK) ? m + NGW : m;
        const float* xr0 = (m < TOK_PROMPT) ? a.in[0] + (size_t)m * DM : a.in[1] + (size_t)(m - TOK_PROMPT) * DM; const float* xr1 = (m1 < TOK_PROMPT) ? a.in[0] + (size_t)m1 * DM : a.in[1] + (size_t)(m1 - TOK_PROMPT) * DM;
        rms_rows2_to_bf16(xr0, xr1, norm_g, H + (size_t)m * DM, H + (size_t)m1 * DM, H8 + (size_t)m * DM, H8 + (size_t)m1 * DM, SA + m, SA + m1, lane); }
}

__device__ __forceinline__ void p2_qknorm_rope(const Args& a, int vcu, int G, int wave, int lane) {
    unsigned char* ws = a.ws; const float* R = (const float*)(ws + WS_ROPE);
    const int gw = vcu * NWAVES + wave, NGW = G * NWAVES;
    const int fj = lane & 31, c0 = (lane < 32) ? lane : 64 + (lane - 32), c1 = c0 + 32;
    const float gq0 = a.in[5][c0], gq1 = a.in[5][c1], gk0 = a.in[6][c0], gk1 = a.in[6][c1];
    for (int it = gw; it < NTOK * 10; it += NGW) {
        const int t = it / 10, slot = it - t * 10; const int tl = t & (SEQ - 1); const int pos = (lane < 32) ? (tl >> 6) : (tl & 63);
        bf16* p = (slot < 8) ? (bf16*)((unsigned char*)a.out + DO_Q) + (size_t)t * 1024 + slot * 128 : (bf16*)(ws + WS_AK) + (size_t)t * 256 + (slot - 8) * 128;
        const float x0 = bf2f(p[c0]), x1 = bf2f(p[c1]);
        const float r = 1.f / sqrtf(wave_sum(x0 * x0 + x1 * x1) * (1.f / 128.f) + EPS);
        const float y0 = x0 * r * ((slot < 8) ? gq0 : gk0), y1 = x1 * r * ((slot < 8) ? gq1 : gk1);
        const float cs = R[2 * (pos * 32 + fj)], sn = R[2 * (pos * 32 + fj) + 1];
        p[c0] = (bf16)f2bf(y0 * cs - y1 * sn); p[c1] = (bf16)f2bf(y1 * cs + y0 * sn);
    }
}

__device__ __forceinline__ void p4_mlstm_recurrent(const Args& a, LAS unsigned char* lds, int vcu, int G, int tid) {
    unsigned char* ws = a.ws;
    const bf16* MQ = (const bf16*)(ws + WS_MQ); const bf16* MK = (const bf16*)(ws + WS_MK); const bf16* MV = (const bf16*)(ws + WS_MV); const float* GT = (const float*)(ws + WS_GATES);
    LAS float* qs = (LAS float*)lds;
    LAS float* ks = qs + 32 * 128;
    LAS float* vs = ks + 32 * 128;
    LAS float* gi = vs + 32 * 256;
    LAS float* gf = gi + 32;
    const int dv = tid >> 1, half = tid & 1;
    for (int item = vcu; item < NSEQ * 8; item += G) {
        const int b = item >> 3, hd = (item >> 1) & 3, dir = item & 1;
        bf16* HO = (bf16*)(ws + (dir ? WS_HB : WS_HF));
        float C[64], nn[64]; float m = 0.f;
#pragma unroll
        for (int j = 0; j < 64; ++j) { C[j] = 0.f; nn[j] = 0.f; }
        for (int p0 = 0; p0 < SEQ; p0 += 32) {
            __syncthreads();
            { const int rr = tid >> 4, c8 = (tid & 15) * 8; const int tok = dir ? (SEQ - 1 - (p0 + rr)) : (p0 + rr); const size_t row = (size_t)b * SEQ + tok;
              const v4u q4 = *(const v4u*)(MQ + row * 512 + hd * 128 + c8), k4 = *(const v4u*)(MK + row * 512 + hd * 128 + c8);
              LAS float* kd = ks + rr * 128 + c8;
              { LAS float* qa = qs + rr * 128 + (c8 & ~8) + ((c8 & 8) >> 1);   qa[0] = bflo(q4.x); qa[1] = bfhi(q4.x); qa[2] = bflo(q4.y); qa[3] = bfhi(q4.y); qa[8] = bflo(q4.z); qa[9] = bfhi(q4.z); qa[10] = bflo(q4.w); qa[11] = bfhi(q4.w); }
              kd[0] = bflo(k4.x); kd[1] = bfhi(k4.x); kd[2] = bflo(k4.y); kd[3] = bfhi(k4.y); kd[4] = bflo(k4.z); kd[5] = bfhi(k4.z); kd[6] = bflo(k4.w); kd[7] = bfhi(k4.w);
              const int c16 = (tid & 15) * 16; LAS float* vd = vs + rr * 256 + c16;
#pragma unroll
              for (int h2 = 0; h2 < 2; ++h2) { const v4u v4 = *(const v4u*)(MV + row * 1024 + hd * 256 + c16 + 8 * h2);
                  vd[8 * h2 + 0] = bflo(v4.x); vd[8 * h2 + 1] = bfhi(v4.x); vd[8 * h2 + 2] = bflo(v4.y); vd[8 * h2 + 3] = bfhi(v4.y); vd[8 * h2 + 4] = bflo(v4.z); vd[8 * h2 + 5] = bfhi(v4.z); vd[8 * h2 + 6] = bflo(v4.w); vd[8 * h2 + 7] = bfhi(v4.w); }
              if (tid < 32) { const int tk = dir ? (SEQ - 1 - (p0 + tid)) : (p0 + tid); const size_t rw = (size_t)b * SEQ + tk; gi[tid] = GT[rw * 16 + dir * 8 + hd]; gf[tid] = GT[rw * 16 + dir * 8 + 4 + hd]; }
            }
            __syncthreads();
            for (int pp = 0; pp < 32; ++pp) {
                const float lf = gf[pp], ii = gi[pp];
                const float mn = fmaxf(lf + m, ii);
                const float ca = expf(lf + m - mn), cb = expf(ii - mn);
                const float bv = cb * vs[pp * 256 + dv];
                float hp = 0.f, qn = 0.f;
                const LAS float* kr = ks + pp * 128 + 64 * half; const LAS float* qr = qs + pp * 128 + 64 * half;
#pragma unroll
                for (int j = 0; j < 64; ++j) { const float kk = kr[j], qq = qr[j];
                    C[j] = fmaf(ca, C[j], kk * bv); nn[j] = fmaf(ca, nn[j], cb * kk); hp = fmaf(qq, C[j], hp); qn = fmaf(qq, nn[j], qn); }
                hp += __shfl_xor(hp, 1); qn += __shfl_xor(qn, 1);
                const float den = fmaxf(fabsf(qn), expf(-mn));
                if (half == 0) { const int pos = p0 + pp, cch = pos >> 6, o = pos & 63, tt = o >> 5, rho = o & 31, q = rho >> 3, hh = (rho >> 2) & 1, e = rho & 3;
                    HO[(((size_t)((b * 4 + hd) * 32 + cch) * 32768) + (dv >> 5) * 4096 + tt * 2048 + (q >> 1) * 1024 + (32 * hh + (dv & 31)) * 16) / 2 + 4 * (q & 1) + e] = (bf16)f2bf(hp / den); }
                m = mn;
            }
        }
    }
}

__device__ __forceinline__ void p5_mlstm_finalize(const Args& a, LAS unsigned char* lds, int vcu, int G, int tid, int wave, int lane) {
    unsigned char* ws = a.ws; const float* mg = a.in[7];
    const bf16* MO = (const bf16*)(ws + WS_MO); const bf16* MZ = (const bf16*)(ws + WS_MZ); bf16* MIX = (bf16*)(ws + WS_MIX);
    LAS float* XS = (LAS float*)lds;
    const int r31 = lane & 31, h5 = lane >> 5, dv0 = 8 * r31;
    constexpr int NIT = NSEQ * 4 * 32;
    v4u f[2][2], bb[2][2];
#define P5_LOAD_H(item_) do { const int bh_ = (item_) >> 5, ck_ = (item_) & 31; \
        const unsigned char* hf_ = ws + WS_HF + ((size_t)bh_ * 32 + ck_) * 32768 + wave * 4096 + lane * 16; const unsigned char* hb_ = ws + WS_HB + ((size_t)bh_ * 32 + (31 - ck_)) * 32768 + wave * 4096 + (lane ^ 32) * 16; \
        _Pragma("unroll") for (int tt = 0; tt < 2; ++tt) _Pragma("unroll") for (int qp = 0; qp < 2; ++qp) { f[tt][qp] = *(const v4u*)(hf_ + tt * 2048 + qp * 1024); bb[tt][qp] = *(const v4u*)(hb_ + (1 - tt) * 2048 + (1 - qp) * 1024); } } while (0)
    if (vcu < NIT) P5_LOAD_H(vcu);
    for (int item = vcu; item < NIT; item += G) {
        const int bh = item >> 5, ck = item & 31, b = bh >> 2, hd = bh & 3;
        v4u mo[4], mz[4];
#pragma unroll
        for (int it = 0; it < 4; ++it) { const int o = it * 16 + wave * 2 + h5; const size_t row = (size_t)b * SEQ + ck * 64 + o;
            mo[it] = *(const v4u*)(MO + row * 1024 + hd * 256 + dv0); mz[it] = *(const v4u*)(MZ + row * 1024 + hd * 256 + dv0); }
        __syncthreads();
#pragma unroll
        for (int tt = 0; tt < 2; ++tt)
#pragma unroll
            for (int qp = 0; qp < 2; ++qp) { const v4u fv = f[tt][qp], bv = bb[tt][qp];
                float fs[8] = {bflo(fv.x), bfhi(fv.x), bflo(fv.y), bfhi(fv.y), bflo(fv.z), bfhi(fv.z), bflo(fv.w), bfhi(fv.w)};
                float bs[8] = {bflo(bv.x), bfhi(bv.x), bflo(bv.y), bfhi(bv.y), bflo(bv.z), bfhi(bv.z), bflo(bv.w), bfhi(bv.w)};
#pragma unroll
                for (int j = 0; j < 8; ++j) { const int o = 32 * tt + 8 * (2 * qp + (j >> 2)) + 4 * h5 + (j & 3); XS[o * 256 + 32 * wave + r31] = fs[j] + bs[7 - j]; } }
        __syncthreads();
        if (item + G < NIT) P5_LOAD_H(item + G);
        const f32x4 g0 = *(const f32x4*)(mg + hd * 256 + dv0), g1 = *(const f32x4*)(mg + hd * 256 + dv0 + 4);
        const float gg[8] = {g0[0], g0[1], g0[2], g0[3], g1[0], g1[1], g1[2], g1[3]};
#pragma unroll
        for (int it = 0; it < 4; ++it) { const int o = it * 16 + wave * 2 + h5; const size_t row = (size_t)b * SEQ + ck * 64 + o;
            const f32x4 x0 = *(const LAS f32x4*)(XS + o * 256 + dv0), x1 = *(const LAS f32x4*)(XS + o * 256 + dv0 + 4);
            float hm[8] = {x0[0], x0[1], x0[2], x0[3], x1[0], x1[1], x1[2], x1[3]};
            const float mo8[8] = {bflo(mo[it].x), bfhi(mo[it].x), bflo(mo[it].y), bfhi(mo[it].y), bflo(mo[it].z), bfhi(mo[it].z), bflo(mo[it].w), bfhi(mo[it].w)};
            const float mz8[8] = {bflo(mz[it].x), bfhi(mz[it].x), bflo(mz[it].y), bfhi(mz[it].y), bflo(mz[it].z), bfhi(mz[it].z), bflo(mz[it].w), bfhi(mz[it].w)};
            float ss = 0.f;
#pragma unroll
            for (int j = 0; j < 8; ++j) { hm[j] = hm[j] * __builtin_amdgcn_rcpf(1.f + __expf(-mo8[j])); ss += hm[j] * hm[j]; }
#pragma unroll
            for (int s = 1; s < 32; s <<= 1) ss += __shfl_xor(ss, s);
            const float r = __builtin_amdgcn_rsqf(ss * (1.f / 256.f) + EPS);
            float ov[8];
#pragma unroll
            for (int j = 0; j < 8; ++j) ov[j] = hm[j] * r * gg[j] * (mz8[j] * __builtin_amdgcn_rcpf(1.f + __expf(-mz8[j])));
            v4u w; w.x = pk2(ov[0], ov[1]); w.y = pk2(ov[2], ov[3]); w.z = pk2(ov[4], ov[5]); w.w = pk2(ov[6], ov[7]);
            *(v4u*)(MIX + row * 2048 + 512 + hd * 256 + dv0) = w; }
    }
#undef P5_LOAD_H
    __syncthreads();
}

__device__ __forceinline__ void p5_item(const Args& a, LAS unsigned char* lds, int item) {
    int tid_ = threadIdx.x; asm volatile("" : "+v"(tid_));
    const int lane = tid_ & 63, wave = __builtin_amdgcn_readfirstlane(tid_ >> 6);
    unsigned char* ws = a.ws; const float* mg = a.in[7];
    const bf16* MO = (const bf16*)(ws + WS_MO); const bf16* MZ = (const bf16*)(ws + WS_MZ); bf16* MIX = (bf16*)(ws + WS_MIX);
    LAS float* XS = (LAS float*)lds; const int r31 = lane & 31, h5 = lane >> 5, dv0 = 8 * r31;
    const int bh = item >> 5, ck = item & 31, b = bh >> 2, hd = bh & 3;
    const unsigned char* hf_ = ws + WS_HF + ((size_t)bh * 32 + ck) * 32768 + wave * 4096 + lane * 16; const unsigned char* hb_ = ws + WS_HB + ((size_t)bh * 32 + (31 - ck)) * 32768 + wave * 4096 + (lane ^ 32) * 16;
    v4u f[2][2], bb[2][2], mo[4], mz[4];
#pragma unroll
    for (int tt = 0; tt < 2; ++tt)
#pragma unroll
        for (int qp = 0; qp < 2; ++qp) { f[tt][qp] = *(const v4u*)(hf_ + tt * 2048 + qp * 1024); bb[tt][qp] = *(const v4u*)(hb_ + (1 - tt) * 2048 + (1 - qp) * 1024); }
#pragma unroll
    for (int it = 0; it < 4; ++it) { const int o = it * 16 + wave * 2 + h5; const size_t row = (size_t)b * SEQ + ck * 64 + o;
        mo[it] = *(const v4u*)(MO + row * 1024 + hd * 256 + dv0); mz[it] = *(const v4u*)(MZ + row * 1024 + hd * 256 + dv0); }
    __syncthreads();
#pragma unroll
    for (int tt = 0; tt < 2; ++tt)
#pragma unroll
        for (int qp = 0; qp < 2; ++qp) { const v4u fv = f[tt][qp], bv = bb[tt][qp];
            float fs[8] = {bflo(fv.x), bfhi(fv.x), bflo(fv.y), bfhi(fv.y), bflo(fv.z), bfhi(fv.z), bflo(fv.w), bfhi(fv.w)};
            float bs[8] = {bflo(bv.x), bfhi(bv.x), bflo(bv.y), bfhi(bv.y), bflo(bv.z), bfhi(bv.z), bflo(bv.w), bfhi(bv.w)};
#pragma unroll
            for (int j = 0; j < 8; ++j) { const int o = 32 * tt + 8 * (2 * qp + (j >> 2)) + 4 * h5 + (j & 3); XS[o * 256 + 32 * wave + r31] = fs[j] + bs[7 - j]; } }
    __syncthreads();
    const f32x4 g0 = *(const f32x4*)(mg + hd * 256 + dv0), g1 = *(const f32x4*)(mg + hd * 256 + dv0 + 4);
    const float gg[8] = {g0[0], g0[1], g0[2], g0[3], g1[0], g1[1], g1[2], g1[3]};
#pragma unroll
    for (int it = 0; it < 4; ++it) { const int o = it * 16 + wave * 2 + h5; const size_t row = (size_t)b * SEQ + ck * 64 + o;
        const f32x4 x0 = *(const LAS f32x4*)(XS + o * 256 + dv0), x1 = *(const LAS f32x4*)(XS + o * 256 + dv0 + 4);
        float hm[8] = {x0[0], x0[1], x0[2], x0[3], x1[0], x1[1], x1[2], x1[3]};
        const float mo8[8] = {bflo(mo[it].x), bfhi(mo[it].x), bflo(mo[it].y), bfhi(mo[it].y), bflo(mo[it].z), bfhi(mo[it].z), bflo(mo[it].w), bfhi(mo[it].w)};
        const float mz8[8] = {bflo(mz[it].x), bfhi(mz[it].x), bflo(mz[it].y), bfhi(mz[it].y), bflo(mz[it].z), bfhi(mz[it].z), bflo(mz[it].w), bfhi(mz[it].w)};
        float ss = 0.f;
#pragma unroll
        for (int j = 0; j < 8; ++j) { hm[j] = hm[j] * __builtin_amdgcn_rcpf(1.f + __expf(-mo8[j])); ss += hm[j] * hm[j]; }
#pragma unroll
        for (int s = 1; s < 32; s <<= 1) ss += __shfl_xor(ss, s);
        const float r = __builtin_amdgcn_rsqf(ss * (1.f / 256.f) + EPS);
        float ov[8];
#pragma unroll
        for (int j = 0; j < 8; ++j) ov[j] = hm[j] * r * gg[j] * (mz8[j] * __builtin_amdgcn_rcpf(1.f + __expf(-mz8[j])));
        v4u w; w.x = pk2(ov[0], ov[1]); w.y = pk2(ov[2], ov[3]); w.z = pk2(ov[4], ov[5]); w.w = pk2(ov[6], ov[7]);
        *(v4u*)(MIX + row * 2048 + 512 + hd * 256 + dv0) = w; }
    __syncthreads();
}

__device__ __forceinline__ void p5_batch(const Args& a, LAS unsigned char* lds, int first, int count) {
    if (count <= 0) return;
    int tid_ = threadIdx.x; asm volatile("" : "+v"(tid_));
    const int lane = tid_ & 63, wave = __builtin_amdgcn_readfirstlane(tid_ >> 6);
    unsigned char* ws = a.ws; const float* mg = a.in[7];
    const bf16* MO = (const bf16*)(ws + WS_MO); const bf16* MZ = (const bf16*)(ws + WS_MZ); bf16* MIX = (bf16*)(ws + WS_MIX);
    LAS float* XS = (LAS float*)lds; const int r31 = lane & 31, h5 = lane >> 5, dv0 = 8 * r31;
    v4u f[2][2], bb[2][2];
#define P5B_LOAD_H(item_) do { const int bh_ = (item_) >> 5, ck_ = (item_) & 31; \
        const unsigned char* hf_ = ws + WS_HF + ((size_t)bh_ * 32 + ck_) * 32768 + wave * 4096 + lane * 16; const unsigned char* hb_ = ws + WS_HB + ((size_t)bh_ * 32 + (31 - ck_)) * 32768 + wave * 4096 + (lane ^ 32) * 16; \
        _Pragma("unroll") for (int tt = 0; tt < 2; ++tt) _Pragma("unroll") for (int qp = 0; qp < 2; ++qp) { f[tt][qp] = *(const v4u*)(hf_ + tt * 2048 + qp * 1024); bb[tt][qp] = *(const v4u*)(hb_ + (1 - tt) * 2048 + (1 - qp) * 1024); } } while (0)
    P5B_LOAD_H(first);
    for (int i = 0; i < count; ++i) {
        const int item = first + i, bh = item >> 5, ck = item & 31, b = bh >> 2, hd = bh & 3;
        v4u mo[4], mz[4];
#pragma unroll
        for (int it = 0; it < 4; ++it) { const int o = it * 16 + wave * 2 + h5; const size_t row = (size_t)b * SEQ + ck * 64 + o;
            mo[it] = *(const v4u*)(MO + row * 1024 + hd * 256 + dv0); mz[it] = *(const v4u*)(MZ + row * 1024 + hd * 256 + dv0); }
        __syncthreads();
#pragma unroll
        for (int tt = 0; tt < 2; ++tt)
#pragma unroll
            for (int qp = 0; qp < 2; ++qp) { const v4u fv = f[tt][qp], bv = bb[tt][qp];
                float fs[8] = {bflo(fv.x), bfhi(fv.x), bflo(fv.y), bfhi(fv.y), bflo(fv.z), bfhi(fv.z), bflo(fv.w), bfhi(fv.w)};
                float bs[8] = {bflo(bv.x), bfhi(bv.x), bflo(bv.y), bfhi(bv.y), bflo(bv.z), bfhi(bv.z), bflo(bv.w), bfhi(bv.w)};
#pragma unroll
                for (int j = 0; j < 8; ++j) { const int o = 32 * tt + 8 * (2 * qp + (j >> 2)) + 4 * h5 + (j & 3); XS[o * 256 + 32 * wave + r31] = fs[j] + bs[7 - j]; } }
        __syncthreads();
        if (i + 1 < count) P5B_LOAD_H(item + 1);
        const f32x4 g0 = *(const f32x4*)(mg + hd * 256 + dv0), g1 = *(const f32x4*)(mg + hd * 256 + dv0 + 4);
        const float gg[8] = {g0[0], g0[1], g0[2], g0[3], g1[0], g1[1], g1[2], g1[3]};
#pragma unroll
        for (int it = 0; it < 4; ++it) { const int o = it * 16 + wave * 2 + h5; const size_t row = (size_t)b * SEQ + ck * 64 + o;
            const f32x4 x0 = *(const LAS f32x4*)(XS + o * 256 + dv0), x1 = *(const LAS f32x4*)(XS + o * 256 + dv0 + 4);
            float hm[8] = {x0[0], x0[1], x0[2], x0[3], x1[0], x1[1], x1[2], x1[3]};
            const float mo8[8] = {bflo(mo[it].x), bfhi(mo[it].x), bflo(mo[it].y), bfhi(mo[it].y), bflo(mo[it].z), bfhi(mo[it].z), bflo(mo[it].w), bfhi(mo[it].w)};
            const float mz8[8] = {bflo(mz[it].x), bfhi(mz[it].x), bflo(mz[it].y), bfhi(mz[it].y), bflo(mz[it].z), bfhi(mz[it].z), bflo(mz[it].w), bfhi(mz[it].w)};
            float ss = 0.f;
#pragma unroll
            for (int j = 0; j < 8; ++j) { hm[j] = hm[j] * __builtin_amdgcn_rcpf(1.f + __expf(-mo8[j])); ss += hm[j] * hm[j]; }
#pragma unroll
            for (int s = 1; s < 32; s <<= 1) ss += __shfl_xor(ss, s);
            const float r = __builtin_amdgcn_rsqf(ss * (1.f / 256.f) + EPS);
            float ov[8];
#pragma unroll
            for (int j = 0; j < 8; ++j) ov[j] = hm[j] * r * gg[j] * (mz8[j] * __builtin_amdgcn_rcpf(1.f + __expf(-mz8[j])));
            v4u w; w.x = pk2(ov[0], ov[1]); w.y = pk2(ov[2], ov[3]); w.z = pk2(ov[4], ov[5]); w.w = pk2(ov[6], ov[7]);
            *(v4u*)(MIX + row * 2048 + 512 + hd * 256 + dv0) = w; }
    }
#undef P5B_LOAD_H
    __syncthreads();
}

__device__ __forceinline__ void gate_rows48(unsigned char* ws, const float* b_gates, int row0, int lane) {
    typedef short bf16x8 __attribute__((ext_vector_type(8)));
    const int r15 = lane & 15, kg = lane >> 4;
    const bf16* a0p = (const bf16*)(ws + WS_H) + (size_t)(row0 + r15) * DM + 8 * kg; const bf16* a1p = a0p + 16 * DM; const bf16* a2p = a0p + 32 * DM;
    const bf16* bp = (const bf16*)(ws + WS_WGT) + (size_t)r15 * DM + 8 * kg;
    f32x4 acc0 = {0.f, 0.f, 0.f, 0.f}, acc1 = {0.f, 0.f, 0.f, 0.f}, acc2 = {0.f, 0.f, 0.f, 0.f};
#pragma unroll 8
    for (int ks = 0; ks < DM / 32; ++ks) { const bf16x8 a0 = *(const bf16x8*)(a0p + 32 * ks), a1 = *(const bf16x8*)(a1p + 32 * ks), a2 = *(const bf16x8*)(a2p + 32 * ks), b = *(const bf16x8*)(bp + 32 * ks);
        acc0 = __builtin_amdgcn_mfma_f32_16x16x32_bf16(a0, b, acc0, 0, 0, 0); acc1 = __builtin_amdgcn_mfma_f32_16x16x32_bf16(a1, b, acc1, 0, 0, 0); acc2 = __builtin_amdgcn_mfma_f32_16x16x32_bf16(a2, b, acc2, 0, 0, 0); }
    const float bias = b_gates[r15]; const bool isf = (r15 >> 2) & 1; float* G = (float*)(ws + WS_GATES) + (size_t)(row0 + 4 * kg) * 16 + r15;
#pragma unroll
    for (int r = 0; r < 4; ++r) { float v0 = acc0[r] + bias, v1 = acc1[r] + bias, v2 = acc2[r] + bias; if (isf) { v0 = log_sigmoid_f(v0); v1 = log_sigmoid_f(v1); v2 = log_sigmoid_f(v2); }
        G[r * 16] = v0; G[(16 + r) * 16] = v1; G[(32 + r) * 16] = v2; }
}

constexpr int N_PHASES = 7;
__global__ void __launch_bounds__(NWAVES * 64, 2) hy_fwd(Args args) {
    extern __shared__ __attribute__((aligned(16))) unsigned char lds_raw[];
    LAS unsigned char* lds = (LAS unsigned char*)lds_raw;
    const int tid = threadIdx.x, lane = tid & 63, wave = __builtin_amdgcn_readfirstlane(tid >> 6);
    const int G = gridDim.x; const int bx = blockIdx.x; const int vcu = (G % 8 == 0) ? (bx % 8) * (G / 8) + bx / 8 : bx;
    unsigned char* ws = args.ws;
    const int lo = args.ph_lo, hi = args.ph_hi;
    unsigned* ctl = (unsigned*)(ws + WS_CTL);
    volatile LAS unsigned* bst = (volatile LAS unsigned*)(lds + LDS_BYTES - 16);
    if (tid == 0) { bst[0] = 0u; bst[1] = 0u; }
    __syncthreads();
    XcdBarrier xbar; xbar.bar = ctl + CW_BAR; xbar.x = 0; xbar.st = bst; bool xposted = false;
    const bool one_launch = (lo == 0 && hi == N_PHASES);
    if (one_launch) { xbar = xcd_barrier_post(ctl + CW_BAR, bst); xposted = true; }
#ifndef HY_PHASE_MASK
#define HY_PHASE_MASK 0x7f
#endif
#define IN(k) (((HY_PHASE_MASK >> (k)) & 1) && lo <= (k) && (k) < hi)
#define BOTH(k) (IN(k) && IN((k) + 1))
#ifndef HY_DUP_MASK
#define HY_DUP_MASK 0
#endif
#ifndef HY_PROBE_NULL
#define HY_PROBE_NULL 0
#endif
#ifndef HY_ML_PROBE_MODE
#define HY_ML_PROBE_MODE 0
#endif
#define DUP(k) (((HY_DUP_MASK) >> (k)) & 1)
#define GRID_BAR_CG() do { cg::this_grid().sync(); } while (0)
#define GRID_BAR() do { if (!xposted) { xbar = xcd_barrier_post(ctl + CW_BAR, bst); xposted = true; } xcd_barrier(xbar); } while (0)

    if (IN(0) && DUP(0)) { p0_prologue(args, lds, vcu, G, tid, wave, lane); __syncthreads(); }
    if (IN(0)) { p0_prologue(args, lds, vcu, G, tid, wave, lane); if (BOTH(0)) GRID_BAR(); }

    if (IN(1)) {
        { const float* Rg = (const float*)(ws + WS_ROPE); LAS float* Rl = (LAS float*)(lds + ROPE_LDS_OFF); LAS float* Gl = (LAS float*)(lds + QKG_LDS_OFF);
          for (int e = tid; e < 64 * 32 * 2; e += NWAVES * 64) Rl[e] = Rg[e];
          if (tid < 128) { Gl[tid] = args.in[5][tid]; Gl[128 + tid] = args.in[6][tid]; }
          __syncthreads(); }
        { pg8::Gemm g{(const pg8::bf16_t*)((unsigned char*)args.out + DO_H8), (const pg8::bf16_t*)(ws + WS_W8T), NTOK, NQ8, DM / 2, DM / 128}; pg8::StaticOrder S; S.init(NTOK, NQ8, G, bx);
          pg8::EpiProjT<0, 2> E{ws, (PG8_LAS float*)(lds + XCH_OFF), (PG8_LAS float*)(lds + ROPE_LDS_OFF), (PG8_LAS float*)(lds + QKG_LDS_OFF), (unsigned char*)args.out + DO_Q, (PG8_LAS float*)(lds + SCL_LDS_OFF), (const float*)(ws + WS_SA), (const float*)(ws + WS_SW)};
          pg8::gemm_phase<pg8::EpiProjT<0, 2>, pg8::StaticOrder, true, true, 2>(lds, g, S, E); }
        { pg8::Gemm g{(const pg8::bf16_t*)(ws + WS_H), (const pg8::bf16_t*)(ws + WS_W1B), NTOK, NB1 - NB0, DM, DM / 64}; pg8::StaticOrder S; S.init(NTOK, NB1 - NB0, G, bx);
          pg8::EpiProjT<NB0 / 256, 0> E{ws, (PG8_LAS float*)(lds + XCH_OFF), (PG8_LAS float*)(lds + ROPE_LDS_OFF), (PG8_LAS float*)(lds + QKG_LDS_OFF), (unsigned char*)args.out + DO_Q, nullptr, nullptr, nullptr};
          pg8::gemm_phase<pg8::EpiProjT<NB0 / 256, 0>, pg8::StaticOrder, true, true, 0>(lds, g, S, E); }
        { const int nun = (NTOK / 256) * (NQ8 / 256), full = nun / G, rem = nun - full * G, light = G - rem;
          if (bx >= rem) for (int it = (bx - rem) * NWAVES + wave; it < NTOK / 48; it += light * NWAVES) gate_rows48(ws, args.in[4], it * 48, lane); }
        if (BOTH(1)) GRID_BAR();
    }

static_assert(!HY_SEPARATE_ROPE, "the attention body takes fp8 q / k rows, which only the fused in-projection epilogue writes");
#if HY_SEPARATE_ROPE
    if (IN(2)) { p2_qknorm_rope(args, vcu, G, wave, lane); if (BOTH(2)) GRID_BAR(); }
#endif

#define ATTN_UNIT(grp_, w_) do { const int b_ = (grp_) >> 1, kvh_ = (grp_) & 1, h_ = kvh_ * 4 + ((w_) >> 3), qb_ = (w_) & 7; const size_t row0_ = (size_t)b_ * SEQ + qb_ * 256; \
        const unsigned char* Q_ = (const unsigned char*)args.out + DO_Q + row0_ * 1024 + h_ * 128; unsigned char* O_ = ws + WS_MIX + row0_ * 4096 + h_ * 128; const unsigned char* K_ = ws + WS_AK + (size_t)b_ * SEQ * 256 + kvh_ * 128; \
        const attn::bf16* V_ = (const attn::bf16*)(ws + WS_AV) + (size_t)b_ * SEQ * 256 + kvh_ * 128; const bf16* Z_ = (const bf16*)(ws + WS_AZ) + row0_ * 1024 + h_ * 128; \
        int seqv_ = SEQ; asm volatile("" : "+s"(seqv_)); attn::attn_dense_body<attn::bf16>(Q_, K_, V_, O_, Z_, seqv_, (char*)lds_raw); __syncthreads(); } while (0)
#if HY_SCHED_J
    const bool schedJ = one_launch && G == 256;
    if (schedJ) {
        const int xl = vcu >> 5, s = vcu & 31;
        if (s < 24) ml::mlstm_item<0>(ws, lds, xl * 24 + s, tid);
        else for (int j = 0; j < 2; ++j) ATTN_UNIT(xl, 2 * (s - 24) + j);
        GRID_BAR();
        const int n_rest = (s < 16) ? 6 : 5, n_p5 = (s < 16) ? 8 : 16, p5_0 = (s < 16) ? 8 * (xl * 16 + s) : 1024 + 16 * (xl * 16 + (s - 16));
        int p5_done = 0;
        for (int jr = 0; jr < n_rest; ++jr) {
            if ((jr & 1) == 0) { const int tgt = (n_p5 * ((jr >> 1) + 1)) / 3;
                p5_batch(args, lds, p5_0 + p5_done, tgt - p5_done); p5_done = tgt; }
            const int li = s + 32 * jr;
            const int grp = (li < 16) ? xl : xl + 8 * (1 + ((li - 16) >> 5)), w = (li < 16) ? 16 + li : (li - 16) & 31;
            ATTN_UNIT(grp, w);
        }
        GRID_BAR();
    }
#else
    const bool schedJ = false;
#endif

    if (!schedJ && IN(3)) {
        for (int u = vcu; u < NSEQ * 2 * 32; u += G) ATTN_UNIT(u >> 5, u & 31);
        if (BOTH(3)) GRID_BAR();
    }

    if (!schedJ && IN(4) && DUP(4)) {
#if HY_MLSTM_REF
        p4_mlstm_recurrent(args, lds, vcu, G, tid);
#else
        for (int item = vcu; item < NSEQ * 8; item += G) ml::mlstm_item<HY_ML_PROBE_MODE>(ws, lds, item, tid);
#endif
        if (BOTH(4)) GRID_BAR(); }

    if (!schedJ && IN(4)) {
#if HY_MLSTM_REF
        p4_mlstm_recurrent(args, lds, vcu, G, tid);
#else
        for (int item = vcu; item < NSEQ * 8; item += G) ml::mlstm_item<0>(ws, lds, item, tid);
#endif
        if (BOTH(4)) GRID_BAR(); }

    if (!schedJ && IN(5) && DUP(5)) { p5_mlstm_finalize(args, lds, vcu, G, tid, wave, lane); }
    if (!schedJ && IN(5)) { p5_mlstm_finalize(args, lds, vcu, G, tid, wave, lane); if (BOTH(5)) GRID_BAR(); }

    if (IN(6)) {
        pg8::Gemm g{(const pg8::bf16_t*)(ws + WS_MIX), (const pg8::bf16_t*)(ws + WS_W2T), NTOK, DM, DM, pg8::F8_TILES + 1024 / 64}; pg8::StaticOrder S; S.init(NTOK, DM, G, bx);
        pg8::EpiOut E{args.in[0], args.in[1], args.out};
        pg8::gemm_phase<pg8::EpiOut, pg8::StaticOrder, true, true, 3>(lds, g, S, E);
    }
    if (one_launch && lo < 0) GRID_BAR_CG();
#undef IN
#undef BOTH
}

extern "C" void kernel_launch(void* const* d_in, const int* in_sizes, int n_in, void* d_out, int out_size, void* d_ws, size_t ws_size, hipStream_t stream) {
    static int grid = 0;
    if (grid == 0) {
        if (n_in != 9 || in_sizes[0] != TOK_PROMPT * DM || in_sizes[1] != (NTOK - TOK_PROMPT) * DM || out_size != NTOK * DM || ws_size < WS_END) {
            fprintf(stderr, "kernel_launch: shape mismatch n_in %d in0 %d in1 %d out %d ws %zu (need %zu)\n", n_in, n_in > 0 ? in_sizes[0] : -1, n_in > 1 ? in_sizes[1] : -1, out_size, ws_size, (size_t)WS_END); grid = -1; return; }
        int dev = 0, cus = 0, per_cu = 0;
        if (hipGetDevice(&dev) != hipSuccess || hipDeviceGetAttribute(&cus, hipDeviceAttributeMultiprocessorCount, dev) != hipSuccess) { fprintf(stderr, "kernel_launch: device query failed\n"); grid = -1; return; }
        if (hipFuncSetAttribute((const void*)hy_fwd, hipFuncAttributeMaxDynamicSharedMemorySize, LDS_BYTES) != hipSuccess) { fprintf(stderr, "kernel_launch: hipFuncSetAttribute failed\n"); grid = -1; return; }
        if (hipOccupancyMaxActiveBlocksPerMultiprocessor(&per_cu, (const void*)hy_fwd, NWAVES * 64, LDS_BYTES) != hipSuccess || per_cu < 1) { fprintf(stderr, "kernel_launch: occupancy query says %d\n", per_cu); per_cu = 1; }
        (void)hipGetLastError();
        grid = cus;
    }
    if (grid < 0) return;
    if (hipMemsetAsync((char*)d_ws + WS_CTL, 0, 65536, stream) != hipSuccess) { fprintf(stderr, "kernel_launch: hipMemsetAsync of the control words failed\n"); return; }
    Args a{};
    for (int i = 0; i < 9; ++i) a.in[i] = (const float*)d_in[i];
    a.out = (float*)d_out; a.ws = (unsigned char*)d_ws;
#if HY_N_LAUNCHES == 1
    a.ph_lo = 0; a.ph_hi = N_PHASES;
    void* kargs[] = {&a};
    hipError_t e = hipLaunchCooperativeKernel((const void*)hy_fwd, dim3(grid), dim3(NWAVES * 64), kargs, LDS_BYTES, stream);
    if (e != hipSuccess) fprintf(stderr, "kernel_launch: cooperative launch failed: %s (grid %d)\n", hipGetErrorString(e), grid);
#else
    for (int p = 0; p < N_PHASES; ++p) {
        a.ph_lo = p; a.ph_hi = p + 1;
        hipLaunchKernelGGL(hy_fwd, dim3(grid), dim3(NWAVES * 64), LDS_BYTES, stream, a);
        const hipError_t le = hipPeekAtLastError();
        if (le != hipSuccess) { fprintf(stderr, "kernel_launch: launch %d failed: %s\n", p, hipGetErrorName(le)); break; }
    }
#endif
}
```

```cpp
#include <hip/hip_runtime.h>
#include <hip/hip_bf16.h>
#include <hip/hip_cooperative_groups.h>
#include <cstdio>
#include <cstdint>
#include <cmath>
namespace cg = cooperative_groups;

#ifndef HY_SEPARATE_ROPE
#define HY_SEPARATE_ROPE 0
#endif
#ifndef HY_SCHED_J
#define HY_SCHED_J 1
#endif
#ifndef HY_MLSTM_REF
#define HY_MLSTM_REF 0
#endif
#ifndef HY_N_LAUNCHES
#define HY_N_LAUNCHES 1
#endif

constexpr int SEQ = 2048, NSEQ = 24, NTOK = NSEQ * SEQ, TOK_PROMPT = 8 * SEQ, DM = 2048;
constexpr int NPROJ = 6672, NP256 = 6656;
constexpr float EPS = 1e-6f;

constexpr size_t MiB = 1u << 20;
constexpr size_t WS_CTL = 0, CTL_ZERO_BYTES = 1 * MiB;
constexpr int CW_BAR = 4096, CW_QUEUE = 8192;
constexpr size_t WS_ROPE = 1 * MiB;
constexpr size_t WS_W8T = 2 * MiB;
constexpr size_t WS_W1B = 14 * MiB;
constexpr size_t WS_WGT = 18 * MiB;
constexpr size_t WS_SW = 19 * MiB;
constexpr size_t WS_SA = 20 * MiB;
constexpr size_t WS_W2T = 30 * MiB;
constexpr size_t WS_GATES = 38 * MiB;
constexpr size_t WS_H = 42 * MiB;
constexpr size_t WS_HF = WS_H, WS_HB = WS_H + 96 * MiB;
constexpr size_t WS_MIX = 234 * MiB;
constexpr size_t DO_H8 = 0, DO_Q = 96 * MiB;
constexpr float V8_SCALE = 16.f, P8_SCALE = 16.f;
constexpr float QK8_SCALE = 16.f;
constexpr float A8_SCALE = 256.f, W8_SCALE = 512.f;
constexpr size_t WS_AK = 426 * MiB, WS_AV = 450 * MiB;
constexpr size_t WS_AZ = 474 * MiB;
constexpr size_t WS_MQ = 570 * MiB, WS_MK = 618 * MiB;
constexpr size_t WS_MV = 666 * MiB, WS_MO = 762 * MiB, WS_MZ = 858 * MiB;
constexpr size_t WS_END = 954 * MiB;

typedef unsigned short bf16;
__device__ __forceinline__ unsigned f2bf(float f) { unsigned u = __builtin_bit_cast(unsigned, f); return (u + 0x7fffu + ((u >> 16) & 1u)) >> 16; }
__device__ __forceinline__ unsigned pk2(float lo, float hi) { return f2bf(lo) | (f2bf(hi) << 16); }
__device__ __forceinline__ float bf2f(unsigned short b) { return __builtin_bit_cast(float, (unsigned)b << 16); }
__device__ __forceinline__ float bflo(unsigned w) { return __builtin_bit_cast(float, w << 16); }
__device__ __forceinline__ float bfhi(unsigned w) { return __builtin_bit_cast(float, w & 0xffff0000u); }
constexpr int NQA = 2560, NB0 = 2560, NB1 = 3584, NQ8 = 5632;
__device__ __forceinline__ unsigned pk4f8(float a, float b, float c, float d) {
    a = __builtin_fminf(__builtin_fmaxf(a, -448.f), 448.f); b = __builtin_fminf(__builtin_fmaxf(b, -448.f), 448.f); c = __builtin_fminf(__builtin_fmaxf(c, -448.f), 448.f); d = __builtin_fminf(__builtin_fmaxf(d, -448.f), 448.f);
    int w = 0; w = __builtin_amdgcn_cvt_pk_fp8_f32(a, b, w, false); w = __builtin_amdgcn_cvt_pk_fp8_f32(c, d, w, true); return (unsigned)w; }
__device__ __forceinline__ float log_sigmoid_f(float x) { return x >= 0.f ? -log1pf(expf(-x)) : x - log1pf(expf(x)); }
namespace pg8 {
#define PG8_LAS __attribute__((address_space(3)))
typedef unsigned short bf16_t;
typedef short bf16x8 __attribute__((ext_vector_type(8)));
typedef float f32x4 __attribute__((ext_vector_type(4)));
typedef unsigned u32x4 __attribute__((ext_vector_type(4)));
typedef int i32x4 __attribute__((ext_vector_type(4)));
constexpr int F8_TILES = 8;
constexpr int BM = 256, BK = 64, HALF = 128, HTB = HALF * BK * 2  , STAGE_BYTES = 8 * HTB, NXCD = 8, WGM = 8;

__host__ __device__ __forceinline__ int lds_byte(int r, int c) { const int st = (r >> 4) * 2 + (c >> 5), rr = r & 15, cc = c & 31, ob = rr * 64 + cc * 2; return st * 1024 + (ob ^ (((ob >> 9) & 1) << 5)); }
__host__ __device__ __forceinline__ void stage_rc(int b, int& R, int& C) { const int st = b / 1024, sb = b % 1024, swz = sb ^ (((sb >> 9) & 1) << 5); R = (st >> 1) * 16 + swz / 64; C = (st & 1) * 32 + (swz % 64) / 2; }
__host__ __device__ __forceinline__ int perm32(int rho) { const int n = rho >> 4, i = rho & 15; return 8 * (i >> 2) + 4 * n + (i & 3); }

struct Unit { int pm, pn; };
struct Gemm { const bf16_t* A; const bf16_t* Bt; int M, N, K, kt; };

struct StaticOrder {
    int nM, nN, nwg, G, c;
    __host__ __device__ void init(int M, int N, int G_, int c_) { nM = M / BM; nN = N / BM; nwg = nM * nN; G = G_; c = c_; }
    __host__ __device__ bool next(int i, Unit& u) const {
        const long L = (long)i * G + c; if (L >= nwg) return false;
        int wgid = (int)L; { const int q = nwg / NXCD, r = nwg % NXCD, xcd = wgid % NXCD, off = wgid / NXCD; wgid = (xcd < r ? xcd * (q + 1) : r * (q + 1) + (xcd - r) * q) + off; }
        const int nig = WGM * nN, gid = wgid / nig, fm = gid * WGM, gsz = (nM - fm) < WGM ? (nM - fm) : WGM;
        u.pm = fm + ((wgid % nig) % gsz); u.pn = (wgid % nig) / gsz; return true;
    }
    __device__ __forceinline__ void a_ready(const Unit&) const {}
    __device__ __forceinline__ void done(const Unit&) const {}
};


__device__ __forceinline__ unsigned cvt_pk_bf16(float lo, float hi) { unsigned r; asm volatile("v_cvt_pk_bf16_f32 %0, %1, %2" : "=v"(r) : "v"(lo), "v"(hi)); return r; }

template <int PN0, int MODE>
struct EpiProjT {
    static constexpr bool PERM = true, AFTER_DRAIN = false, PREFETCH = (MODE == 2); static constexpr int NSTORE = 16;
    unsigned char* ws; PG8_LAS float* xch; PG8_LAS float* ropeL; PG8_LAS float* qkgL;
    unsigned char* qb;
    PG8_LAS float* scl; const float* SA; const float* SW;
    __device__ __forceinline__ void prefetch(const Unit& u, int ui, int wid, int lane) const {
        const float* src = (wid < 4) ? SA + (size_t)u.pm * BM + wid * 64 + lane : SW + u.pn * BM + (wid - 4) * 64 + lane;
        __builtin_amdgcn_global_load_lds((const unsigned*)src, (PG8_LAS unsigned*)(scl + (ui & 1) * 512 + wid * 64), 4, 0, 0); }
    __device__ __forceinline__ void operator()(const f32x4 (&acc)[2][2][4][2], const Unit& u, int wr, int wc, int fr, int fq, int par = 0) const {
        const int pn = (MODE == 2) ? (u.pn < 10 ? u.pn : u.pn + 4) : u.pn + PN0; const int row0 = u.pm * BM + wr * 64 + fr;
        constexpr float SC = (MODE == 1) ? (1.f / 4096.f) : 1.f;
        float sa[2][4]; f32x4 sw[2][2];
        if constexpr (MODE == 2) { PG8_LAS float* T = scl + par * 512;
#pragma unroll
            for (int ai = 0; ai < 2; ++ai)
#pragma unroll
                for (int m = 0; m < 4; ++m) sa[ai][m] = T[ai * HALF + wr * 64 + m * 16 + fr];
#pragma unroll
            for (int bj = 0; bj < 2; ++bj)
#pragma unroll
                for (int n = 0; n < 2; ++n) sw[bj][n] = *(const PG8_LAS f32x4*)(T + 256 + bj * HALF + wc * 32 + 8 * fq + 4 * n); }
        auto val = [&](int ai, int bj, int m, int n) -> f32x4 {
            if constexpr (MODE == 2) { const i32x4 iv = __builtin_bit_cast(i32x4, acc[ai][bj][m][n]); const f32x4 f = {(float)iv[0], (float)iv[1], (float)iv[2], (float)iv[3]}; return f * sa[ai][m] * sw[bj][n]; }
            else return acc[ai][bj][m][n] * SC; };
        if (!HY_SEPARATE_ROPE && PN0 <= 4 && pn <= 4) {
            PG8_LAS float* gsrc = qkgL + ((pn < 4) ? 0 : 128); const int cb = 64 * (wc >> 1) + 16 * (wc & 1) + 4 * fq;
            const f32x4 g1 = *(const PG8_LAS f32x4*)(gsrc + cb), g2 = *(const PG8_LAS f32x4*)(gsrc + cb + 32);
#pragma unroll
            for (int ai = 0; ai < 2; ++ai)
#pragma unroll
                for (int m = 0; m < 4; ++m)
#pragma unroll
                    for (int bj = 0; bj < 2; ++bj) { const f32x4 a = val(ai, bj, m, 0), b = val(ai, bj, m, 1);
                        float s = ((a[0] * a[0] + a[1] * a[1]) + (a[2] * a[2] + a[3] * a[3])) + ((b[0] * b[0] + b[1] * b[1]) + (b[2] * b[2] + b[3] * b[3]));
                        s += __shfl_xor(s, 16); s += __shfl_xor(s, 32);
                        if (fq == 0) xch[((ai * HALF + wr * 64 + m * 16 + fr) * 2 + bj) * 4 + wc] = s; }
            asm volatile("s_waitcnt lgkmcnt(0)" ::: "memory"); __builtin_amdgcn_s_barrier(); asm volatile("" ::: "memory");
            unsigned char* base = pn < 4 ? qb : ws + WS_AK; const int ldc = (pn < 4) ? 1024 : 256; const int colt = (pn < 4) ? pn * 256 : 0;
            PG8_LAS float* R = ropeL; const int j0 = 16 * (wc & 1) + 4 * fq;
#pragma unroll
            for (int ai = 0; ai < 2; ++ai)
#pragma unroll
                for (int m = 0; m < 4; ++m) { const int row = row0 + ai * HALF + m * 16; const int tl = row & (SEQ - 1); const int pos = (wc < 2) ? (tl >> 6) : (tl & 63);
                    const f32x4 cs0 = *(const PG8_LAS f32x4*)(R + (pos * 32 + j0) * 2), cs1 = *(const PG8_LAS f32x4*)(R + (pos * 32 + j0) * 2 + 4);
#pragma unroll
                    for (int bj = 0; bj < 2; ++bj) { const f32x4 pt = *(const PG8_LAS f32x4*)(xch + ((ai * HALF + wr * 64 + m * 16 + fr) * 2 + bj) * 4);
                        const float rstd = 1.f / sqrtf(((pt[0] + pt[1]) + (pt[2] + pt[3])) * (1.f / 128.f) + EPS);
                        const f32x4 y1 = val(ai, bj, m, 0) * rstd * g1, y2 = val(ai, bj, m, 1) * rstd * g2;
                        const float o10 = y1[0] * cs0[0] - y2[0] * cs0[1], o11 = y1[1] * cs0[2] - y2[1] * cs0[3], o12 = y1[2] * cs1[0] - y2[2] * cs1[1], o13 = y1[3] * cs1[2] - y2[3] * cs1[3];
                        const float o20 = y2[0] * cs0[0] + y1[0] * cs0[1], o21 = y2[1] * cs0[2] + y1[1] * cs0[3], o22 = y2[2] * cs1[0] + y1[2] * cs1[1], o23 = y2[3] * cs1[2] + y1[3] * cs1[3];
                        unsigned char* dst = base + (size_t)row * ldc + colt + bj * HALF + cb;
                        *(unsigned*)dst = pk4f8(o10 * QK8_SCALE, o11 * QK8_SCALE, o12 * QK8_SCALE, o13 * QK8_SCALE); *(unsigned*)(dst + 32) = pk4f8(o20 * QK8_SCALE, o21 * QK8_SCALE, o22 * QK8_SCALE, o23 * QK8_SCALE); } }
            return;
        }
        size_t off; int ldc, colt;
        if (pn < 4)       { off = 0; ldc = 1024; colt = pn * 256; }
        else if (pn == 4) { off = WS_AK;  ldc = 256;  colt = 0; }
        else if (pn == 5) { off = WS_AV;  ldc = 256;  colt = 0; }
        else if (pn < 10) { off = WS_AZ;  ldc = 1024; colt = (pn - 6) * 256; }
        else if (pn < 12) { off = WS_MQ;  ldc = 512;  colt = (pn - 10) * 256; }
        else if (pn < 14) { off = WS_MK;  ldc = 512;  colt = (pn - 12) * 256; }
        else if (pn < 18) { off = WS_MV;  ldc = 1024; colt = (pn - 14) * 256; }
        else if (pn < 22) { off = WS_MO;  ldc = 1024; colt = (pn - 18) * 256; }
        else              { off = WS_MZ;  ldc = 1024; colt = (pn - 22) * 256; }
        if constexpr (MODE == 2) { if (pn == 5) {
            unsigned char* VT = ws + WS_AV;
            int fr_ = fr, fq_ = fq; asm volatile("" : "+v"(fr_), "+v"(fq_));
            const int b = u.pm >> 3, tile0 = (u.pm & 7) * 4 + wr, qi = fr_ & 3; const unsigned sel = (unsigned)qi | ((unsigned)(4 + qi) << 8);
#pragma unroll
            for (int ai = 0; ai < 2; ++ai)
#pragma unroll
                for (int m = 0; m < 4; ++m)
#pragma unroll
                    for (int bj = 0; bj < 2; ++bj)
#pragma unroll
                        for (int n = 0; n < 2; ++n) { const f32x4 v = val(ai, bj, m, n) * V8_SCALE; const int w = (int)pk4f8(v[0], v[1], v[2], v[3]);
                            const unsigned w0 = (unsigned)__builtin_amdgcn_update_dpp(0, w, 0x00, 0xf, 0xf, false), w1 = (unsigned)__builtin_amdgcn_update_dpp(0, w, 0x55, 0xf, 0xf, false);
                            const unsigned w2 = (unsigned)__builtin_amdgcn_update_dpp(0, w, 0xaa, 0xf, 0xf, false), w3 = (unsigned)__builtin_amdgcn_update_dpp(0, w, 0xff, 0xf, 0xf, false);
                            const unsigned x01 = __builtin_amdgcn_perm(w1, w0, sel), x23 = __builtin_amdgcn_perm(w3, w2, sel), o4 = __builtin_amdgcn_perm(x23, x01, 0x05040100u);
                            const int d = 32 * wc + 8 * fq_ + 4 * n + qi, dw = ((fr_ >> 2) & 1) * 8 + (m >> 1) * 4 + (m & 1) * 2 + ((fr_ >> 3) & 1);
                            *(unsigned*)(VT + ((size_t)((b * 2 + bj) * 128 + d)) * 2048 + (tile0 + 2 * ai) * 64 + dw * 4) = o4; }
            return; } }
        bf16_t* base = (bf16_t*)(pn < 4 ? qb : ws + off);
        const int col0 = colt + wc * 32 + 8 * fq;
#pragma unroll
        for (int ai = 0; ai < 2; ++ai)
#pragma unroll
            for (int m = 0; m < 4; ++m) { bf16_t* rowp = base + (size_t)(row0 + ai * HALF + m * 16) * ldc + col0;
#pragma unroll
                for (int bj = 0; bj < 2; ++bj) { const f32x4 v0 = val(ai, bj, m, 0), v1 = val(ai, bj, m, 1);
                    u32x4 w; w.x = cvt_pk_bf16(v0[0], v0[1]); w.y = cvt_pk_bf16(v0[2], v0[3]); w.z = cvt_pk_bf16(v1[0], v1[1]); w.w = cvt_pk_bf16(v1[2], v1[3]);
                    *(u32x4*)(rowp + bj * HALF) = w; } }
    }
};
struct EpiNull { static constexpr bool PERM = true, AFTER_DRAIN = false, PREFETCH = false; static constexpr int NSTORE = 0;
    __device__ __forceinline__ void operator()(const f32x4 (&acc)[2][2][4][2], const Unit& u, int wr, int wc, int fr, int fq) const {
#pragma unroll
        for (int ai = 0; ai < 2; ++ai)
#pragma unroll
            for (int bj = 0; bj < 2; ++bj)
#pragma unroll
                for (int m = 0; m < 4; ++m) asm volatile("" :: "v"(acc[ai][bj][m][0]), "v"(acc[ai][bj][m][1])); } };
struct EpiOut {
    static constexpr bool PERM = false, AFTER_DRAIN = false, PREFETCH = false; static constexpr int NSTORE = 32;
    const float* xp; const float* xs; float* out;
    __device__ __forceinline__ void operator()(const f32x4 (&acc)[2][2][4][2], const Unit& u, int wr, int wc, int fr, int fq) const {
        const int row0 = u.pm * BM + wr * 64 + fr; const int col0 = u.pn * BM + wc * 32 + 4 * fq;
        const bool pr = row0 < TOK_PROMPT; const float* xb = (pr ? xp : xs) + col0;
        const size_t xsub = pr ? 0 : (size_t)TOK_PROMPT * DM; float* ob = out + col0;
        f32x4 xr[4][4];
#define EPO_LOAD(g_) do { const size_t ro_ = (size_t)(row0 + ((g_) >> 2) * HALF + ((g_) & 3) * 16) * DM - xsub; \
            xr[(g_) & 3][0] = *(const f32x4*)(xb + ro_); xr[(g_) & 3][1] = *(const f32x4*)(xb + ro_ + 16); xr[(g_) & 3][2] = *(const f32x4*)(xb + ro_ + HALF); xr[(g_) & 3][3] = *(const f32x4*)(xb + ro_ + HALF + 16); } while (0)
        EPO_LOAD(0); EPO_LOAD(1); EPO_LOAD(2);
#pragma unroll
        for (int g = 0; g < 8; ++g) { if (g + 3 < 8) EPO_LOAD(g + 3);
            const int ai = g >> 2, m = g & 3; const size_t ro = (size_t)(row0 + ai * HALF + m * 16) * DM;
            *(f32x4*)(ob + ro) = xr[g & 3][0] + acc[ai][0][m][0]; *(f32x4*)(ob + ro + 16) = xr[g & 3][1] + acc[ai][0][m][1];
            *(f32x4*)(ob + ro + HALF) = xr[g & 3][2] + acc[ai][1][m][0]; *(f32x4*)(ob + ro + HALF + 16) = xr[g & 3][3] + acc[ai][1][m][1]; }
#undef EPO_LOAD
    }
};

template <class Epi, class Sched, bool ALIGN_EPI = false, bool SP2 = false, int MODE = 0>
__device__ __forceinline__ void gemm_phase(PG8_LAS unsigned char* lds, const Gemm g, const Sched& S, const Epi& E) {
    int tid_ = threadIdx.x; asm volatile("" : "+v"(tid_));
    const int tid = tid_, wid = __builtin_amdgcn_readfirstlane(tid >> 6), lane = tid & 63, wr = wid >> 2, wc = wid & 3, fr = lane & 15, fq = lane >> 4;
    const int K = g.K, nt = g.kt;
    unsigned voffA[2], voffB[2];
#pragma unroll
    for (int i = 0; i < 2; ++i) { int R, C; stage_rc(tid * 16 + i * 8192, R, C); const int Rb = Epi::PERM ? ((R & ~31) + perm32(R & 31)) : R;
        voffA[i] = (unsigned)(R * K + C) * 2u; voffB[i] = (unsigned)(Rb * K + C) * 2u; }
    const size_t kstep = (size_t)(BK * 2);
    const size_t hstep = (size_t)HALF * K * 2;
    const size_t tstep = 2 * hstep;
    const unsigned ldsw = (unsigned)wid * 1024u;
    const int aoff = lds_byte(wr * 64 + fr, fq * 8), boff = lds_byte(wc * 32 + fr, fq * 8);
#define PG8_SA(b, h) (((b) * 2 + (h)) * HTB)
#define PG8_SB(b, h) ((4 + (b) * 2 + (h)) * HTB)
#define PG8_STAGE(bufoff, gbase, voff) do { _Pragma("unroll") for (int _i = 0; _i < 2; ++_i) \
        __builtin_amdgcn_global_load_lds((const unsigned*)((const char*)(gbase) + (voff)[_i]), (PG8_LAS unsigned*)(lds + (bufoff) + ldsw + _i * 8192), 16, 0, 0); } while (0)
#define PG8_LDA(dst, b, h) do { _Pragma("unroll") for (int m = 0; m < 4; ++m) _Pragma("unroll") for (int k = 0; k < 2; ++k) dst[m][k] = *(const PG8_LAS bf16x8*)(lds + PG8_SA(b, h) + aoff + m * 2048 + k * 1024); } while (0)
#define PG8_LDB(dst, b, h) do { _Pragma("unroll") for (int n = 0; n < 2; ++n) _Pragma("unroll") for (int k = 0; k < 2; ++k) dst[n][k] = *(const PG8_LAS bf16x8*)(lds + PG8_SB(b, h) + boff + n * 2048 + k * 1024); } while (0)
#define PG8_CAT8(x_) __builtin_shufflevector(__builtin_bit_cast(i32x4, (x_)[0]), __builtin_bit_cast(i32x4, (x_)[1]), 0, 1, 2, 3, 4, 5, 6, 7)
#define PG8_MMA_F8(ai, bj, At, Bt) do { _Pragma("unroll") for (int m = 0; m < 4; ++m) _Pragma("unroll") for (int n = 0; n < 2; ++n) \
        asm volatile("v_mfma_f32_16x16x128_f8f6f4 %0, %1, %2, %0" : "+v"(acc[ai][bj][m][n]) : "v"(PG8_CAT8(Bt[n])), "v"(PG8_CAT8(At[m]))); } while (0)
#define PG8_MMA_I8(ai, bj, At, Bt) do { _Pragma("unroll") for (int k = 0; k < 2; ++k) _Pragma("unroll") for (int m = 0; m < 4; ++m) _Pragma("unroll") for (int n = 0; n < 2; ++n) \
        asm volatile("v_mfma_i32_16x16x64_i8 %0, %1, %2, %0" : "+v"(acc[ai][bj][m][n]) : "v"(Bt[n][k]), "v"(At[m][k])); } while (0)
#define PG8_MMA_BF(ai, bj, At, Bt) do { _Pragma("unroll") for (int m = 0; m < 4; ++m) _Pragma("unroll") for (int n = 0; n < 2; ++n) _Pragma("unroll") for (int k = 0; k < 2; ++k) \
        acc[ai][bj][m][n] = __builtin_amdgcn_mfma_f32_16x16x32_bf16(Bt[n][k], At[m][k], acc[ai][bj][m][n], 0, 0, 0); } while (0)
#define PG8_MMA(ai, bj, At, Bt) do { __builtin_amdgcn_s_setprio(1); \
        if constexpr (MODE == 1) PG8_MMA_F8(ai, bj, At, Bt); else if constexpr (MODE == 2) PG8_MMA_I8(ai, bj, At, Bt); else PG8_MMA_BF(ai, bj, At, Bt); \
        __builtin_amdgcn_s_setprio(0); } while (0)
#define PG8_MMAW_F8(ai, bj, At, Bt) do { __builtin_amdgcn_s_setprio(1); PG8_MMA_F8(ai, bj, At, Bt); __builtin_amdgcn_s_setprio(0); } while (0)
#define PG8_MMAW_BF(ai, bj, At, Bt) do { __builtin_amdgcn_s_setprio(1); PG8_MMA_BF(ai, bj, At, Bt); __builtin_amdgcn_s_setprio(0); } while (0)
#define PG8_WAIT_V(n) asm volatile("s_waitcnt vmcnt(" #n ")" ::: "memory")
#define PG8_WAIT_L(n) asm volatile("s_waitcnt lgkmcnt(" #n ")" ::: "memory")
#define PG8_BAR __builtin_amdgcn_s_barrier()
#define PG8_SCHED __builtin_amdgcn_sched_barrier(0)
    Unit cur, nxt; int ui = 0;
    if (!S.next(0, cur)) return;
    f32x4 acc[2][2][4][2];
#pragma unroll
    for (int a = 0; a < 2; ++a)
#pragma unroll
        for (int b = 0; b < 2; ++b)
#pragma unroll
            for (int m = 0; m < 4; ++m)
#pragma unroll
                for (int n = 0; n < 2; ++n) { acc[a][b][m][n] = (f32x4){0.f, 0.f, 0.f, 0.f}; if constexpr (MODE != 0) asm volatile("" : "+v"(acc[a][b][m][n])); }
    bf16x8 At[4][2], B0[2][2], B1[2][2];
    const char* cA = (const char*)g.A + (size_t)cur.pm * tstep; const char* cB = (const char*)g.Bt + (size_t)cur.pn * tstep;
    S.a_ready(cur);
    if constexpr (SP2) {
        PG8_STAGE(PG8_SB(0, 0), cB, voffB); PG8_STAGE(PG8_SB(0, 1), cB + hstep, voffB); PG8_STAGE(PG8_SA(0, 0), cA, voffA); PG8_STAGE(PG8_SA(0, 1), cA + hstep, voffA);
        if (wr == 1) PG8_BAR;
        PG8_WAIT_V(2); PG8_BAR;
        PG8_STAGE(PG8_SB(1, 0), cB + kstep, voffB); PG8_STAGE(PG8_SA(1, 0), cA + kstep, voffA); PG8_STAGE(PG8_SB(1, 1), cB + hstep + kstep, voffB);
        PG8_WAIT_V(6); PG8_BAR;
    } else {
        PG8_STAGE(PG8_SB(0, 0), cB, voffB); PG8_STAGE(PG8_SA(0, 0), cA, voffA); PG8_STAGE(PG8_SB(0, 1), cB + hstep, voffB); PG8_STAGE(PG8_SA(0, 1), cA + hstep, voffA);
        if (wr == 1) PG8_BAR;
        PG8_WAIT_V(4); PG8_BAR;
        PG8_STAGE(PG8_SB(1, 0), cB + kstep, voffB); PG8_STAGE(PG8_SA(1, 0), cA + kstep, voffA); PG8_STAGE(PG8_SB(1, 1), cB + hstep + kstep, voffB);
        PG8_WAIT_V(6); PG8_BAR;
    }
    for (;;) {
        const bool has_next = S.next(ui + 1, nxt);
        const char* nA = has_next ? (const char*)g.A + (size_t)nxt.pm * tstep : cA; const char* nB = has_next ? (const char*)g.Bt + (size_t)nxt.pn * tstep : cB;
        static_assert(SP2, "gemm_phase: only the SP2 K-loop is carried");
#define PG8_WAIT_FIRST() do { if constexpr (Epi::NSTORE >= 32) asm volatile("s_waitcnt vmcnt(40)\n\ts_cmp_lg_u32 %0, 0\n\ts_cbranch_scc1 1f\n\ts_waitcnt vmcnt(8)\n1:" :: "s"(relax_s) : "memory", "scc"); \
            else if constexpr (Epi::NSTORE >= 16) asm volatile("s_waitcnt vmcnt(24)\n\ts_cmp_lg_u32 %0, 0\n\ts_cbranch_scc1 1f\n\ts_waitcnt vmcnt(8)\n1:" :: "s"(relax_s) : "memory", "scc"); \
            else PG8_WAIT_V(8); } while (0)
#define PG8_TRIP(MMAX) do { \
            const bool last = (t == nt - 2); \
            const char* a1 = cA + (size_t)(t + 1) * kstep; \
            const char* a2 = last ? nA : cA + (size_t)(t + 2) * kstep; const char* b2 = last ? nB : cB + (size_t)(t + 2) * kstep; \
            const char* a3 = a2 + kstep; const char* b3 = b2 + kstep; \
            if (last && has_next) S.a_ready(nxt); \
            const int relax_s = __builtin_amdgcn_readfirstlane((Epi::NSTORE > 0 && t == 0 && ui > 0) ? 1 : 0); \
            PG8_LDB(B0, 0, 0); PG8_LDB(B1, 0, 1); PG8_SCHED; PG8_LDA(At, 0, 0); PG8_STAGE(PG8_SA(1, 1), a1 + hstep, voffA); \
            PG8_WAIT_FIRST(); PG8_WAIT_L(0); PG8_BAR; MMAX(0, 0, At, B0); MMAX(0, 1, At, B1); PG8_BAR; PG8_SCHED; \
            PG8_LDA(At, 0, 1); PG8_STAGE(PG8_SB(0, 0), b2, voffB); PG8_STAGE(PG8_SB(0, 1), b2 + hstep, voffB); PG8_STAGE(PG8_SA(0, 0), a2, voffA); \
            PG8_WAIT_FIRST(); PG8_WAIT_L(0); PG8_BAR; MMAX(1, 0, At, B0); MMAX(1, 1, At, B1); PG8_BAR; PG8_SCHED; \
            if constexpr (Epi::PREFETCH) { if (t == 0) E.prefetch(cur, ui, wid, lane); } \
            PG8_LDB(B0, 1, 0); PG8_LDB(B1, 1, 1); PG8_SCHED; PG8_LDA(At, 1, 0); PG8_STAGE(PG8_SA(0, 1), a2 + hstep, voffA); \
            PG8_WAIT_V(8); PG8_WAIT_L(0); PG8_BAR; MMAX(0, 0, At, B0); MMAX(0, 1, At, B1); PG8_BAR; PG8_SCHED; \
            PG8_LDA(At, 1, 1); PG8_STAGE(PG8_SB(1, 0), b3, voffB); PG8_STAGE(PG8_SB(1, 1), b3 + hstep, voffB); PG8_STAGE(PG8_SA(1, 0), a3, voffA); \
            PG8_WAIT_V(8); PG8_WAIT_L(0); PG8_BAR; MMAX(1, 0, At, B0); MMAX(1, 1, At, B1); PG8_BAR; PG8_SCHED; } while (0)
        if constexpr (MODE == 3) {
            for (int t = 0; t < F8_TILES; t += 2) PG8_TRIP(PG8_MMAW_F8);
            asm volatile("s_nop 15\n\ts_nop 15" ::: "memory"); PG8_SCHED;
#pragma unroll
            for (int a = 0; a < 2; ++a)
#pragma unroll
                for (int b = 0; b < 2; ++b)
#pragma unroll
                    for (int m = 0; m < 4; ++m)
#pragma unroll
                        for (int n = 0; n < 2; ++n) acc[a][b][m][n] *= (1.f / (A8_SCALE * W8_SCALE));
            for (int t = F8_TILES; t < nt; t += 2) PG8_TRIP(PG8_MMAW_BF);
        } else { for (int t = 0; t < nt; t += 2) PG8_TRIP(PG8_MMA); }
#undef PG8_TRIP
#undef PG8_WAIT_FIRST
        if constexpr (MODE == 1 || MODE == 2) { asm volatile("s_nop 15\n\ts_nop 15" ::: "memory"); PG8_SCHED; }
        if constexpr (ALIGN_EPI) { if (wr == 0) PG8_BAR; }
        if constexpr (!Epi::AFTER_DRAIN) { if constexpr (Epi::PREFETCH) E(acc, cur, wr, wc, fr, fq, ui & 1); else E(acc, cur, wr, wc, fr, fq); S.done(cur); }
        if (!has_next) break;
#pragma unroll
        for (int a = 0; a < 2; ++a)
#pragma unroll
            for (int b = 0; b < 2; ++b)
#pragma unroll
                for (int m = 0; m < 4; ++m)
#pragma unroll
                    for (int n = 0; n < 2; ++n) { acc[a][b][m][n] = (f32x4){0.f, 0.f, 0.f, 0.f}; if constexpr (MODE != 0) asm volatile("" : "+v"(acc[a][b][m][n])); }
        cur = nxt; cA = nA; cB = nB; ++ui;
        if constexpr (ALIGN_EPI) { if (wr == 1) PG8_BAR; }
    }
    PG8_WAIT_V(0);
    if constexpr (!ALIGN_EPI) { if (wr == 0) PG8_BAR; }
    PG8_BAR;
    if constexpr (Epi::AFTER_DRAIN) { E.fused(acc, cur, wr, wc, fr, fq, lds, wid, lane); S.done(cur); }
#undef PG8_SA
#undef PG8_SB
#undef PG8_STAGE
#undef PG8_LDA
#undef PG8_LDB
#undef PG8_MMA
#undef PG8_MMAW_F8
#undef PG8_MMAW_BF
#undef PG8_MMA_F8
#undef PG8_MMA_I8
#undef PG8_MMA_BF
#undef PG8_CAT8
#undef PG8_WAIT_V
#undef PG8_WAIT_L
#undef PG8_BAR
#undef PG8_SCHED
}
}
namespace attn {
using bf16 = __hip_bfloat16;
constexpr int   D = 128, NW = 8, QBLK = 32, KVBLK = 64;
constexpr float SCALE = 0.088388347648318440f / (QK8_SCALE * QK8_SCALE);
constexpr float THR = 3.f;
constexpr int SDEPTH = 2;
constexpr int LDQ = 1024, LDK = 256, LDO = 4096, LDZ = 1024;
constexpr size_t SHM_V = KVBLK * D, SHM_K = KVBLK * D, SHM_ATTN = 65536 + NW * 64 * 4;
using bf16x8 = __attribute__((ext_vector_type(8))) short;
using s16x4  = __attribute__((ext_vector_type(4))) short;
using f32x16 = __attribute__((ext_vector_type(16))) float;
using f32x8  = __attribute__((ext_vector_type(8))) float;
using u32x4  = __attribute__((ext_vector_type(4))) unsigned;
#define KSWZ(row, colB) ((row) * 128 + ((colB) ^ ((((row) >> 1) & 7) << 4)))
#define VSWZ(row, colB) ((row) * 64 + ((colB) ^ ((((row) >> 2) & 3) << 4)))
typedef int i32x8 __attribute__((ext_vector_type(8)));
typedef int i32x4a __attribute__((ext_vector_type(4)));
#define SBAR() __builtin_amdgcn_sched_barrier(0)
__device__ __forceinline__ int crow(int r, int hi) { return (r & 3) + 8 * (r >> 2) + 4 * hi; }
__device__ __forceinline__ unsigned cvtpk(float lo, float hi) {
  unsigned r; asm volatile("v_cvt_pk_bf16_f32 %0, %1, %2" : "=v"(r) : "v"(lo), "v"(hi)); return r;
}
template <typename TIn> struct Stage;
template <> struct Stage<bf16>  { using T = bf16x8;
  __device__ static __forceinline__ T ld8(const bf16* p) { return *reinterpret_cast<const bf16x8*>(p); }
  __device__ static __forceinline__ bf16x8 tobf(T x) { return x; } };
template <> struct Stage<float> { using T = f32x8;
  __device__ static __forceinline__ T ld8(const float* p) { return *reinterpret_cast<const f32x8*>(p); }
  __device__ static __forceinline__ bf16x8 tobf(T x) {
    u32x4 w = {cvtpk(x[0], x[1]), cvtpk(x[2], x[3]), cvtpk(x[4], x[5]), cvtpk(x[6], x[7])}; return *reinterpret_cast<bf16x8*>(&w); } };

__device__ __forceinline__ void partialSM(f32x16& p0, f32x16& p1, float& m_reg, float& mn, float& alpha) {
  constexpr float C = SCALE * 1.4426950408889634f;
  float pmax = p0[0]; for (int r = 1; r < 16; ++r) pmax = fmaxf(pmax, p0[r]); for (int r = 0; r < 16; ++r) pmax = fmaxf(pmax, p1[r]);
  { auto rr = __builtin_amdgcn_permlane32_swap(__float_as_uint(pmax), __float_as_uint(pmax), false, false);
    pmax = fmaxf(__uint_as_float(rr[0]), __uint_as_float(rr[1])); }
  if (__builtin_expect(__all(pmax - m_reg <= THR / SCALE), 1)) { mn = m_reg; alpha = 1.f; }
  else { mn = fmaxf(m_reg, pmax); alpha = __builtin_amdgcn_exp2f((m_reg - mn) * C); m_reg = mn; }
  float mnC = -mn * C;
  for (int r = 0; r < 16; ++r) p0[r] = fmaf(p0[r], C, mnC); for (int r = 0; r < 16; ++r) p1[r] = fmaf(p1[r], C, mnC);
  for (int r = 0; r < 16; ++r) p0[r] = __builtin_amdgcn_exp2f(p0[r]);
}
__device__ __forceinline__ void finishSM(f32x16& p0, f32x16& p1, float alpha, float& l_reg, i32x8& pa) {
  for (int r = 0; r < 16; ++r) p1[r] = __builtin_amdgcn_exp2f(p1[r]);
  float ps = 0; for (int r = 0; r < 16; ++r) ps += p0[r]; for (int r = 0; r < 16; ++r) ps += p1[r];
  { auto rr = __builtin_amdgcn_permlane32_swap(__float_as_uint(ps), __float_as_uint(ps), false, false);
    ps = __uint_as_float(rr[0]) + __uint_as_float(rr[1]); }
  l_reg = l_reg * alpha + ps;
#pragma unroll
  for (int q = 0; q < 4; ++q) { pa[q] = (int)pk4f8(p0[4 * q] * P8_SCALE, p0[4 * q + 1] * P8_SCALE, p0[4 * q + 2] * P8_SCALE, p0[4 * q + 3] * P8_SCALE);
    pa[4 + q] = (int)pk4f8(p1[4 * q] * P8_SCALE, p1[4 * q + 1] * P8_SCALE, p1[4 * q + 2] * P8_SCALE, p1[4 * q + 3] * P8_SCALE); }
}
__device__ __forceinline__ void qkt(f32x16& p0, f32x16& p1, const unsigned char* Ks, const i32x8* qf, int r32, int hi) {
  i32x8 ka[2], kb[2];
#pragma unroll
  for (int s = 0; s < 2; ++s) { const int cb = 64 * s + 32 * hi;
    const i32x4a a0 = *reinterpret_cast<const i32x4a*>(Ks + KSWZ(r32, cb)), a1 = *reinterpret_cast<const i32x4a*>(Ks + KSWZ(r32, cb + 16));
    const i32x4a b0 = *reinterpret_cast<const i32x4a*>(Ks + KSWZ(32 + r32, cb)), b1 = *reinterpret_cast<const i32x4a*>(Ks + KSWZ(32 + r32, cb + 16));
    ka[s] = __builtin_shufflevector(a0, a1, 0, 1, 2, 3, 4, 5, 6, 7); kb[s] = __builtin_shufflevector(b0, b1, 0, 1, 2, 3, 4, 5, 6, 7); }
  asm volatile("v_mfma_f32_32x32x64_f8f6f4 %0, %1, %2, 0" : "=&v"(p0) : "v"(ka[0]), "v"(qf[0]));
  asm volatile("v_mfma_f32_32x32x64_f8f6f4 %0, %1, %2, 0" : "=&v"(p1) : "v"(kb[0]), "v"(qf[0]));
  asm volatile("v_mfma_f32_32x32x64_f8f6f4 %0, %1, %2, %0" : "+v"(p0) : "v"(ka[1]), "v"(qf[1]));
  asm volatile("v_mfma_f32_32x32x64_f8f6f4 %0, %1, %2, %0\n\ts_nop 15\n\ts_nop 7" : "+v"(p1) : "v"(kb[1]), "v"(qf[1]));
}
template <int D0> __device__ __forceinline__ void pv_one(f32x16& od, const unsigned char* Vs, i32x8 pa, int r32, int hi) {
  const i32x4a lo = *reinterpret_cast<const i32x4a*>(Vs + VSWZ(32 * D0 + r32, 32 * hi)), hi4 = *reinterpret_cast<const i32x4a*>(Vs + VSWZ(32 * D0 + r32, 32 * hi + 16));
  const i32x8 vb = __builtin_shufflevector(lo, hi4, 0, 1, 2, 3, 4, 5, 6, 7);
  if (D0 == 0) asm volatile("s_nop 1\n\tv_mfma_f32_32x32x64_f8f6f4 %0, %1, %2, %0" : "+v"(od) : "v"(pa), "v"(vb));
  else asm volatile("v_mfma_f32_32x32x64_f8f6f4 %0, %1, %2, %0" : "+v"(od) : "v"(pa), "v"(vb));
}
__device__ __forceinline__ void pv_d0(f32x16* o, const unsigned char* Vs, i32x8 pa, int r32, int hi) {
  pv_one<0>(o[0], Vs, pa, r32, hi); pv_one<1>(o[1], Vs, pa, r32, hi); pv_one<2>(o[2], Vs, pa, r32, hi); pv_one<3>(o[3], Vs, pa, r32, hi);
}
#define O_SETTLE() do { asm volatile("s_nop 15\n\ts_nop 7" ::: "memory"); SBAR(); } while (0)

template <typename TQ>
__device__ __forceinline__ void attn_dense_body(const unsigned char* __restrict__ Qb, const unsigned char* __restrict__ Kh, const unsigned char* __restrict__ Vh,
                                                unsigned char* Ob, const unsigned short* __restrict__ Zb, int seq, char* lds) {
  using St = Stage<bf16>; using SQ = Stage<TQ>;
  int tid = threadIdx.x; asm volatile("" : "+v"(tid));
  const int wid = tid >> 6, lane = tid & 63, r32 = lane & 31, hi = lane >> 5;
  unsigned char* V_lds = (unsigned char*)lds; unsigned char* K_lds = (unsigned char*)(lds + 2 * SHM_V);
  float* ws = (float*)(lds + 65536) + wid * 64; float* li_l = ws; float* al_l = ws + 32;
  float m_reg = -1e30f, l_reg = 0; f32x16 o[4] = {}; i32x8 qr[2];
  const unsigned char* Qw = Qb + (long)(wid * QBLK + r32) * LDQ + hi * 32;
#pragma unroll
  for (int s2 = 0; s2 < 2; ++s2) { const i32x4a lo = *reinterpret_cast<const i32x4a*>(Qw + 64 * s2), hi4 = *reinterpret_cast<const i32x4a*>(Qw + 64 * s2 + 16); qr[s2] = __builtin_shufflevector(lo, hi4, 0, 1, 2, 3, 4, 5, 6, 7); }
  const int kr = tid >> 3, kc = (tid & 7) * 16, kst = KSWZ(kr, kc);
  const int vr = tid >> 2, vc = (tid & 3) * 16, vst = VSWZ(vr, vc);
  struct { i32x4a vs, ks; } sr_[SDEPTH];
#define SLOAD(i, k0) do { sr_[i].vs = *reinterpret_cast<const i32x4a*>(Vh + (long)vr * 2048 + (k0) + vc); \
    sr_[i].ks = *reinterpret_cast<const i32x4a*>(Kh + (long)((k0) + kr) * LDK + kc); } while (0)
#define SWRITE(b, i) do { *(i32x4a*)(V_lds + (b) * SHM_V + vst) = sr_[i].vs; *(i32x4a*)(K_lds + (b) * SHM_K + kst) = sr_[i].ks; } while (0)
#define SWAIT() do { if constexpr (SDEPTH == 2) asm volatile("s_waitcnt vmcnt(2)" ::: "memory"); else asm volatile("s_waitcnt vmcnt(0)" ::: "memory"); } while (0)
#define RESC(a) do { if (__any((a) < 1.f)) { if (hi == 0) al_l[r32] = (a); asm volatile("s_waitcnt lgkmcnt(0)" ::: "memory"); O_SETTLE(); \
    for (int d = 0; d < 4; ++d) for (int r = 0; r < 16; ++r) o[d][r] *= al_l[crow(r, hi)]; } } while (0)
  f32x16 pA0, pA1, pB0, pB1; float mnA, mnB, alA, alB; i32x8 pa; const int NT = seq / KVBLK;
  constexpr int SE = 0, SO = SDEPTH - 1;
  SLOAD(SE, 0); asm volatile("s_waitcnt vmcnt(0)" ::: "memory"); SWRITE(0, SE); __syncthreads();
  qkt(pA0, pA1, K_lds, qr, r32, hi); partialSM(pA0, pA1, m_reg, mnA, alA);
  SLOAD(SO, KVBLK); if constexpr (SDEPTH == 2) { if (2 < NT) SLOAD(SE, 2 * KVBLK); }
  SWAIT(); SWRITE(1, SO); __syncthreads();
  for (int j = 1; j + 1 < NT; j += 2) {
    SBAR(); qkt(pB0, pB1, K_lds + SHM_K, qr, r32, hi);
    finishSM(pA0, pA1, alA, l_reg, pa); SBAR();
    SLOAD(SO, (j + SDEPTH) * KVBLK); SBAR();
    pv_d0(o, V_lds, pa, r32, hi); partialSM(pB0, pB1, m_reg, mnB, alB);
    __syncthreads(); SWAIT(); SWRITE(0, SE);
    RESC(alB); __syncthreads();
    SBAR(); qkt(pA0, pA1, K_lds, qr, r32, hi);
    finishSM(pB0, pB1, alB, l_reg, pa); SBAR();
    if (SDEPTH == 1 || j + 3 < NT) SLOAD(SE, (j + 1 + SDEPTH) * KVBLK); SBAR();
    pv_d0(o, V_lds + SHM_V, pa, r32, hi); partialSM(pA0, pA1, m_reg, mnA, alA);
    __syncthreads(); SWAIT(); SWRITE(1, SO);
    RESC(alA); __syncthreads();
  }
  SBAR(); qkt(pB0, pB1, K_lds + SHM_K, qr, r32, hi);
  finishSM(pA0, pA1, alA, l_reg, pa); SBAR();
  pv_d0(o, V_lds, pa, r32, hi); partialSM(pB0, pB1, m_reg, mnB, alB);
  __syncthreads(); RESC(alB);
  finishSM(pB0, pB1, alB, l_reg, pa); SBAR();
  pv_d0(o, V_lds + SHM_V, pa, r32, hi);
  if (hi == 0) li_l[r32] = l_reg; asm volatile("s_waitcnt lgkmcnt(0)" ::: "memory"); O_SETTLE();
  float rli[16];
#pragma unroll
  for (int r = 0; r < 16; ++r) rli[r] = __builtin_amdgcn_rcpf(li_l[crow(r, hi)]) * (1.f / (P8_SCALE * V8_SCALE));
  __syncthreads();
  { unsigned short* stg = (unsigned short*)(lds + wid * 8192);
#pragma unroll
    for (int r = 0; r < 16; ++r) { const int orow = crow(r, hi);
#pragma unroll
      for (int d0 = 0; d0 < 4; ++d0) { unsigned u = __builtin_bit_cast(unsigned, o[d0][r] * rli[r]); u = (u + 0x7fffu + ((u >> 16) & 1u)) >> 16; stg[orow * 128 + d0 * 32 + r32] = (unsigned short)u; } }
    asm volatile("s_waitcnt lgkmcnt(0)" ::: "memory");
    unsigned char* Ow = Ob + (long)(wid * QBLK) * LDO; const unsigned short* Zw = Zb + (long)(wid * QBLK) * LDZ;
#pragma unroll 2
    for (int i = 0; i < 8; ++i) { const int row = i * 4 + (lane >> 4), ch = lane & 15;
      const u32x4 ov = *(const u32x4*)(stg + row * 128 + ch * 8); const u32x4 zv = *(const u32x4*)(Zw + (long)row * LDZ + ch * 8); float g8[8];
#pragma unroll
      for (int e = 0; e < 4; ++e) { const float z0 = __builtin_bit_cast(float, zv[e] << 16), z1 = __builtin_bit_cast(float, zv[e] & 0xffff0000u);
        g8[2 * e] = __builtin_bit_cast(float, ov[e] << 16) * (z0 * __builtin_amdgcn_rcpf(1.f + __expf(-z0))) * A8_SCALE; g8[2 * e + 1] = __builtin_bit_cast(float, ov[e] & 0xffff0000u) * (z1 * __builtin_amdgcn_rcpf(1.f + __expf(-z1))) * A8_SCALE; }
      typedef unsigned u32x2o __attribute__((ext_vector_type(2)));
      u32x2o w; w.x = pk4f8(g8[0], g8[1], g8[2], g8[3]); w.y = pk4f8(g8[4], g8[5], g8[6], g8[7]);
      *(u32x2o*)(Ow + (long)row * LDO + ch * 8) = w; } }
#undef SLOAD
#undef SWRITE
#undef SWAIT
#undef RESC
}

}
namespace ml {
typedef short bf16x8 __attribute__((ext_vector_type(8)));
typedef short v4i16 __attribute__((ext_vector_type(4)));
typedef float f32x4 __attribute__((ext_vector_type(4)));
typedef float f32x16 __attribute__((ext_vector_type(16)));
typedef unsigned u32x4 __attribute__((ext_vector_type(4)));
typedef unsigned u32x2 __attribute__((ext_vector_type(2)));
#define ML_LAS __attribute__((address_space(3)))
constexpr int BUFB = 65536, Q_OFF = 0, K_OFF = 16384, V_OFF = 32768;
constexpr int P_OFF = 131072, DENP_OFF = P_OFF + 8192, QNP_OFF = DENP_OFF + 512, VEC_OFF = QNP_OFF + 2048, VEC_SLOT = 2 * 256, VR_OFF = VEC_OFF + 2 * VEC_SLOT, NB_OFF = VR_OFF + 8 * 256, LDS_END = NB_OFF + 512;
__device__ __forceinline__ unsigned fxor(unsigned row) { return ((row & 3u) << 2) | ((row >> 2) & 3u); }
__device__ __forceinline__ unsigned off_b(unsigned row, unsigned ch) { return 256u * row + 16u * (ch ^ fxor(row)); }
__device__ __forceinline__ unsigned off_p(unsigned t, unsigned ch) { return 128u * t + 16u * (ch ^ (t & 7u)); }
__device__ __forceinline__ unsigned tr_addr(unsigned lane, unsigned c, unsigned ks, unsigned t) { const unsigned h = lane >> 5, blk = (lane >> 4) & 1u, q = (lane & 15u) >> 2, p = lane & 3u; return off_b(16u * ks + 8u * h + 4u * t + q, 4u * c + 2u * blk + (p >> 1)) + 8u * (p & 1u); }
__device__ __forceinline__ unsigned tr_addr16(unsigned lane, unsigned c, unsigned ks, unsigned t) { const unsigned g = lane >> 4, q = (lane & 15u) >> 2, p = lane & 3u; return off_b(32u * ks + 8u * g + 4u * t + q, 2u * c + (p >> 1)) + 8u * (p & 1u); }
__device__ __forceinline__ v4i16 trrd(ML_LAS unsigned char* p) { return __builtin_amdgcn_ds_read_tr16_b64_v4i16((ML_LAS v4i16*)p); }
template <int OFF> __device__ __forceinline__ v4i16 trra(unsigned addr) { v4i16 r; asm volatile("ds_read_b64_tr_b16 %0, %1 offset:%2" : "=v"(r) : "v"(addr), "i"(OFF) : "memory"); return r; }
__device__ __forceinline__ void glds16(const void* gsrc, unsigned lds_dst) { unsigned keep;
    asm volatile("s_mov_b32 %0, m0\n\ts_mov_b32 m0, %2\n\ts_nop 0\n\tglobal_load_lds_dwordx4 %1, off\n\ts_mov_b32 m0, %0" : "=&s"(keep) : "v"(gsrc), "s"(lds_dst) : "memory"); }
#define ML_TRWAIT() do { asm volatile("s_waitcnt lgkmcnt(0)" ::: "memory"); __builtin_amdgcn_sched_barrier(0); } while (0)
__device__ __forceinline__ bf16x8 cat8(v4i16 lo, v4i16 hi) { return (bf16x8){lo[0], lo[1], lo[2], lo[3], hi[0], hi[1], hi[2], hi[3]}; }
__device__ __forceinline__ unsigned pkbf(float lo, float hi) { unsigned r; asm volatile("v_cvt_pk_bf16_f32 %0, %1, %2" : "=v"(r) : "v"(lo), "v"(hi)); return r; }
__device__ __forceinline__ float s2f(short x) { return __builtin_bit_cast(float, (unsigned)(unsigned short)x << 16); }
__device__ __forceinline__ bf16x8 pack8(float a0, float a1, float a2, float a3, float a4, float a5, float a6, float a7) { u32x4 w = {pkbf(a0, a1), pkbf(a2, a3), pkbf(a4, a5), pkbf(a6, a7)}; return __builtin_bit_cast(bf16x8, w); }
__device__ __forceinline__ float scan_add(float v, int lane) {
#pragma unroll
    for (int o = 1; o < 64; o <<= 1) { const float u = __shfl_up(v, o); if (lane >= o) v += u; }
    return v; }
__device__ __forceinline__ float scan_max(float v, int lane) {
#pragma unroll
    for (int o = 1; o < 64; o <<= 1) { const float u = __shfl_up(v, o); if (lane >= o) v = fmaxf(v, u); }
    return v; }
#define ML_OPAQUE_LANE(ln) unsigned ln = (unsigned)lane; asm volatile("" : "+v"(ln))
__device__ __forceinline__ float rdlane(float v, int l) { return __builtin_bit_cast(float, __builtin_amdgcn_readlane(__builtin_bit_cast(int, v), l)); }

__device__ __forceinline__ void stage(ML_LAS unsigned char* lds, int bsel, int c, int b, int hd, int dir, const unsigned short* MQ, const unsigned short* MK, const unsigned short* MV, int wid, int lane) {
    const int rl = lane >> 4, pos = lane & 15;
#pragma unroll
    for (int half = 0; half < 2; ++half) {
        const int grp = wid + 8 * half, row = 4 * grp + rl, ch = pos ^ ((rl << 2) | (grp & 3));
        const int p = 64 * c + row, tok = dir ? (SEQ - 1 - p) : p; const size_t trow = (size_t)b * SEQ + tok;
        ML_LAS unsigned char* d = lds + bsel * BUFB + grp * 1024;
        __builtin_amdgcn_global_load_lds((const unsigned*)(MQ + trow * 512 + hd * 128 + 8 * ch), (ML_LAS unsigned*)(d + Q_OFF), 16, 0, 0);
        __builtin_amdgcn_global_load_lds((const unsigned*)(MK + trow * 512 + hd * 128 + 8 * ch), (ML_LAS unsigned*)(d + K_OFF), 16, 0, 0);
        __builtin_amdgcn_global_load_lds((const unsigned*)(MV + trow * 1024 + hd * 256 + 8 * ch), (ML_LAS unsigned*)(d + V_OFF), 16, 0, 0);
        __builtin_amdgcn_global_load_lds((const unsigned*)(MV + trow * 1024 + hd * 256 + 128 + 8 * ch), (ML_LAS unsigned*)(d + V_OFF + 16384), 16, 0, 0);
    }
}

#define ML_DPPF(old_, src_, ctrl_, rm_) __builtin_bit_cast(float, __builtin_amdgcn_update_dpp(__builtin_bit_cast(int, (float)(old_)), __builtin_bit_cast(int, (float)(src_)), ctrl_, rm_, 0xf, false))
__device__ __forceinline__ float dscan_add(float v) {
    v += ML_DPPF(0.f, v, 0x111, 0xf); v += ML_DPPF(0.f, v, 0x112, 0xf); v += ML_DPPF(0.f, v, 0x114, 0xf); v += ML_DPPF(0.f, v, 0x118, 0xf);
    v += ML_DPPF(0.f, v, 0x142, 0xa); v += ML_DPPF(0.f, v, 0x143, 0xc); return v; }
__device__ __forceinline__ float dscan_max(float v) { const float NI = -3.0e38f;
    v = fmaxf(v, ML_DPPF(NI, v, 0x111, 0xf)); v = fmaxf(v, ML_DPPF(NI, v, 0x112, 0xf)); v = fmaxf(v, ML_DPPF(NI, v, 0x114, 0xf)); v = fmaxf(v, ML_DPPF(NI, v, 0x118, 0xf));
    v = fmaxf(v, ML_DPPF(NI, v, 0x142, 0xa)); v = fmaxf(v, ML_DPPF(NI, v, 0x143, 0xc)); return v; }

template <int MODE> __device__ __forceinline__ void mlstm_item(unsigned char* ws, ML_LAS unsigned char* lds, int item, int tid) {
    const int lane = tid & 63, wid = __builtin_amdgcn_readfirstlane(tid >> 6);
    const int b = item >> 3, hd = (item >> 1) & 3, dir = item & 1;
    const float* GT = (const float*)(ws + WS_GATES) + dir * 8 + hd;
    ML_LAS float* DENP = (ML_LAS float*)(lds + DENP_OFF); ML_LAS float* QNP = (ML_LAS float*)(lds + QNP_OFF); ML_LAS float* NB = (ML_LAS float*)(lds + NB_OFF + wid * 64);
    unsigned dq0, dq1, dv0, dv1;
    { const int rl = lane >> 4, pos = lane & 15;
      const int g0 = wid, g1 = wid + 8; const int r0 = 4 * g0 + rl, r1 = 4 * g1 + rl; const int c0 = pos ^ ((rl << 2) | (g0 & 3)), c1 = pos ^ ((rl << 2) | (g1 & 3));
      const int m0 = dir ? 63 - r0 : r0, m1 = dir ? 63 - r1 : r1;
      dq0 = (unsigned)(m0 * 1024 + 16 * c0); dq1 = (unsigned)(m1 * 1024 + 16 * c1); dv0 = (unsigned)(m0 * 2048 + 16 * c0); dv1 = (unsigned)(m1 * 2048 + 16 * c1); }
    const unsigned goff = (unsigned)((dir ? 63 - lane : lane) * 64);
    unsigned trL0, trL1, trX;
    { const unsigned h = lane >> 5, blk = (lane >> 4) & 1u, q = (lane & 15u) >> 2, p = lane & 3u; const unsigned A = 256u * (8u * h + q) + 8u * (p & 1u), lo = 2u * blk + (p >> 1);
      trL0 = A + 16u * (lo ^ ((2u * h) & 3u)); trL1 = A + 16u * (lo ^ ((2u * h + 1u) & 3u)) + 1024u; trX = 64u * q; }
    f32x16 C[4]; f32x4 n4 = {0.f, 0.f, 0.f, 0.f};
#pragma unroll
    for (int i = 0; i < 4; ++i) C[i] = (f32x16){0.f};
    const char* gq = (const char*)(ws + WS_MQ) + ((size_t)b * SEQ * 512 + hd * 128) * 2; const char* gk = (const char*)(ws + WS_MK) + ((size_t)b * SEQ * 512 + hd * 128) * 2;
    const char* gv = (const char*)(ws + WS_MV) + ((size_t)b * SEQ * 1024 + hd * 256) * 2; const char* gg = (const char*)GT + (size_t)b * SEQ * 64;
    unsigned char* ho = ws + (dir ? WS_HB : WS_HF) + ((size_t)(b * 4 + hd) * 32) * 32768 + wid * 4096 + lane * 16;
    const unsigned lds0 = (unsigned)(uintptr_t)lds;
#define ML_TB(c_) (MODE == 1 ? (dir ? (SEQ - 64) : 0) : (dir ? (SEQ - 64 * ((c_) + 1)) : 64 * (c_)))
#define ML_STAGE(bsel_, c_) do { const int tb_ = ML_TB(c_); const unsigned d_ = (unsigned)__builtin_amdgcn_readfirstlane((int)(lds0 + (bsel_) * BUFB + wid * 1024)); \
        const char* q_ = gq + (size_t)tb_ * 1024; const char* k_ = gk + (size_t)tb_ * 1024; const char* v_ = gv + (size_t)tb_ * 2048; \
        glds16(q_ + dq0, d_ + Q_OFF); glds16(q_ + dq1, d_ + Q_OFF + 8192); glds16(k_ + dq0, d_ + K_OFF); glds16(k_ + dq1, d_ + K_OFF + 8192); \
        glds16(v_ + dv0, d_ + V_OFF); glds16(v_ + dv1, d_ + V_OFF + 8192); glds16(v_ + 256 + dv0, d_ + V_OFF + 16384); glds16(v_ + 256 + dv1, d_ + V_OFF + 16384 + 8192); } while (0)
#define ML_GATES(c_, gi_, gf_) do { const char* g_ = gg + (size_t)ML_TB(c_) * 64 + goff; gi_ = *(const float*)g_; gf_ = *(const float*)(g_ + 16); } while (0)
#define ML_VEC(cc_, gi_, gf_, sc_out_) do { ML_LAS float* T_ = (ML_LAS float*)(lds + VEC_OFF + ((cc_) & 1) * VEC_SLOT); \
        const float bcs_ = dscan_add(gf_), cx_ = (gi_) - bcs_, cm_ = dscan_max(cx_), M_ = fmaxf(m, cm_); const float g_ = rdlane(bcs_, 63), M63_ = rdlane(M_, 63); \
        T_[lane] = __expf(cx_ - M63_); T_[64 + lane] = __expf(-(bcs_ + M63_)); \
        sc_out_ = __expf(m - M63_); m = g_ + M63_; } while (0)
    float m = 0.f, sc, sc_n = 1.f, gi_a, gf_a, gi_b = 0.f, gf_b = 0.f; u32x4 pend[4] = {{0u, 0u, 0u, 0u}, {0u, 0u, 0u, 0u}, {0u, 0u, 0u, 0u}, {0u, 0u, 0u, 0u}};
    ML_STAGE(0, 0); ML_GATES(0, gi_a, gf_a); ML_VEC(0, gi_a, gf_a, sc); ML_GATES(1, gi_a, gf_a);
    for (int c = 0; c < SEQ / 64; ++c) {
        const int bsel = c & 1;
        ML_LAS unsigned char* bQ = lds + bsel * BUFB + Q_OFF; ML_LAS unsigned char* bK = lds + bsel * BUFB + K_OFF; ML_LAS unsigned char* bV = lds + bsel * BUFB + V_OFF;
        ML_LAS float* VWE = (ML_LAS float*)(lds + VEC_OFF + bsel * VEC_SLOT); ML_LAS float* VEMT = VWE + 64; ML_LAS float* VR = (ML_LAS float*)(lds + VR_OFF + wid * 256);
        asm volatile("s_waitcnt vmcnt(0) lgkmcnt(0)" ::: "memory"); __builtin_amdgcn_s_barrier(); asm volatile("" ::: "memory");
        if (c > 0) { unsigned char* hc = ho + (size_t)(c - 1) * 32768; *(u32x4*)(hc) = pend[0]; *(u32x4*)(hc + 1024) = pend[1]; *(u32x4*)(hc + 2048) = pend[2]; *(u32x4*)(hc + 3072) = pend[3]; }
        if (c + 1 < SEQ / 64) { ML_STAGE(bsel ^ 1, c + 1);
            if (c + 2 < SEQ / 64) ML_GATES(c + 2, gi_b, gf_b);
            ML_VEC(c + 1, gi_a, gf_a, sc_n); }
        if (MODE == 2) { asm volatile("s_waitcnt lgkmcnt(0)" ::: "memory"); __builtin_amdgcn_s_barrier(); continue; }
        { ML_OPAQUE_LANE(ln); const unsigned r15 = ln & 15u, kg = ln >> 4; const int tj = wid >> 1, sb = (wid & 1) * 2; const unsigned t = 16u * tj + r15;
          const unsigned xq = fxor(r15) << 4;
          ML_LAS unsigned char* qrow = bQ + 256u * t;
          bf16x8 qf[4];
#pragma unroll
          for (int ks = 0; ks < 4; ++ks) qf[ks] = *(const ML_LAS bf16x8*)(qrow + (((4u * ks + kg) << 4) ^ xq));
          float dsum = 0.f; const unsigned hb = 8u * (kg & 1u), kh = kg >> 1;
#pragma unroll
          for (int u = 0; u < 2; ++u) { const unsigned si = sb + u; ML_LAS unsigned char* krow = bK + 256u * (16u * si + r15) + hb;
              f32x4 acc = {0.f, 0.f, 0.f, 0.f};
#pragma unroll
              for (int ks = 0; ks < 4; ++ks) { const unsigned g2 = 4u * ks + 2u * kh;
                  const u32x2 lo = *(const ML_LAS u32x2*)(krow + ((g2 << 4) ^ xq)), hi = *(const ML_LAS u32x2*)(krow + (((g2 + 1u) << 4) ^ xq));
                  const u32x4 kw = {lo.x, lo.y, hi.x, hi.y};
                  acc = __builtin_amdgcn_mfma_f32_16x16x32_bf16(__builtin_bit_cast(bf16x8, kw), qf[ks], acc, 0, 0, 0); }
              const unsigned s0 = 16u * si + 4u * kg; const f32x4 ws4 = *(const ML_LAS f32x4*)(VWE + s0);
              float p[4];
#pragma unroll
              for (int r = 0; r < 4; ++r) { p[r] = (s0 + r <= t) ? acc[r] : 0.f; dsum = fmaf(p[r], ws4[r], dsum); }
              const u32x2 pw = {pkbf(p[0], p[1]), pkbf(p[2], p[3])};
              *(ML_LAS u32x2*)(lds + P_OFF + 128u * t + (((2u * si + kh) ^ (t & 7u)) << 4) + hb) = pw; }
          dsum += __shfl_xor(dsum, 16); dsum += __shfl_xor(dsum, 32);
          if (ln < 16u) DENP[(wid & 1) * 64 + t] = dsum; }
        n4 = n4 * sc;
        { ML_OPAQUE_LANE(ln); const unsigned r15 = ln & 15u, kg = ln >> 4; if (r15 == 0) *(ML_LAS f32x4*)(NB + 4 * kg) = n4;
          const f32x4 nA = *(const ML_LAS f32x4*)(NB + 0), nB = *(const ML_LAS f32x4*)(NB + 4), nC = *(const ML_LAS f32x4*)(NB + 8), nD = *(const ML_LAS f32x4*)(NB + 12);
          const unsigned t = ln; ML_LAS unsigned char* qrow = bQ + 256u * t; const unsigned xq = fxor(t) << 4;
          const bf16x8 c0 = *(const ML_LAS bf16x8*)(qrow + (((2u * wid) << 4) ^ xq)), c1 = *(const ML_LAS bf16x8*)(qrow + (((2u * wid + 1u) << 4) ^ xq));
          float qn = 0.f;
#pragma unroll
          for (int e = 0; e < 4; ++e) { qn = fmaf(s2f(c0[e]), nA[e], qn); qn = fmaf(s2f(c0[4 + e]), nC[e], qn); qn = fmaf(s2f(c1[e]), nB[e], qn); qn = fmaf(s2f(c1[4 + e]), nD[e], qn); }
          QNP[wid * 64 + t] = qn; }
        f32x16 Y0, Y1;
        { ML_OPAQUE_LANE(ln); const unsigned r31 = ln & 31u, h5 = ln >> 5; const unsigned xq = fxor(r31) << 4; ML_LAS unsigned char* q0 = bQ + 256u * r31; ML_LAS unsigned char* q1 = q0 + 256u * 32u;
#pragma unroll
          for (int i = 0; i < 4; ++i) { C[i] = C[i] * sc;
#pragma unroll
              for (int s = 0; s < 2; ++s) { const bf16x8 bfr = pack8(C[i][8 * s + 0], C[i][8 * s + 1], C[i][8 * s + 2], C[i][8 * s + 3], C[i][8 * s + 4], C[i][8 * s + 5], C[i][8 * s + 6], C[i][8 * s + 7]);
                  const unsigned co = ((4u * i + 2u * s + h5) << 4) ^ xq;
                  const bf16x8 a0 = *(const ML_LAS bf16x8*)(q0 + co), a1 = *(const ML_LAS bf16x8*)(q1 + co);
                  if (i == 0 && s == 0) { Y0 = __builtin_amdgcn_mfma_f32_32x32x16_bf16(a0, bfr, (f32x16){0.f}, 0, 0, 0); Y1 = __builtin_amdgcn_mfma_f32_32x32x16_bf16(a1, bfr, (f32x16){0.f}, 0, 0, 0); }
                  else { Y0 = __builtin_amdgcn_mfma_f32_32x32x16_bf16(a0, bfr, Y0, 0, 0, 0); Y1 = __builtin_amdgcn_mfma_f32_32x32x16_bf16(a1, bfr, Y1, 0, 0, 0); } } } }
        bf16x8 vw[4];
        { ML_OPAQUE_LANE(ln); const unsigned h5 = ln >> 5, kg = ln >> 4; const unsigned vt = wid >> 2, vc = wid & 3; bf16x8 vf[4];
          ML_LAS unsigned char* v0 = bV + 16384u * vt + ((64u * vc) ^ trX); ML_LAS unsigned char* va = v0 + trL0; ML_LAS unsigned char* vb = v0 + trL1;
#pragma unroll
          for (int ks = 0; ks < 4; ++ks) vf[ks] = cat8(trrd(va + 4096 * ks), trrd(vb + 4096 * ks));
          ML_LAS float* vwe = VWE + 8 * h5;
#pragma unroll
          for (int ks = 0; ks < 4; ++ks) { const f32x4 w0 = *(const ML_LAS f32x4*)(vwe + 16 * ks), w1 = *(const ML_LAS f32x4*)(vwe + 16 * ks + 4);
              vw[ks] = pack8(s2f(vf[ks][0]) * w0[0], s2f(vf[ks][1]) * w0[1], s2f(vf[ks][2]) * w0[2], s2f(vf[ks][3]) * w0[3], s2f(vf[ks][4]) * w1[0], s2f(vf[ks][5]) * w1[1], s2f(vf[ks][6]) * w1[2], s2f(vf[ks][7]) * w1[3]); }
          ML_LAS unsigned char* ka = bK + trL0; ML_LAS unsigned char* kb = bK + trL1;
#pragma unroll
          for (int i = 0; i < 4; ++i) { const unsigned xo = (64u * i) ^ trX;
#pragma unroll
              for (int ks = 0; ks < 4; ++ks) C[i] = __builtin_amdgcn_mfma_f32_32x32x16_bf16(cat8(trrd(ka + xo + 4096 * ks), trrd(kb + xo + 4096 * ks)), vw[ks], C[i], 0, 0, 0); }
          ML_LAS unsigned char* t16a = bK + tr_addr16(ln, wid, 0, 0); ML_LAS unsigned char* t16b = bK + tr_addr16(ln, wid, 0, 1);
#pragma unroll
          for (int ks = 0; ks < 2; ++ks) { const bf16x8 af = cat8(trrd(t16a + 8192 * ks), trrd(t16b + 8192 * ks));
              const f32x4 w0 = *(const ML_LAS f32x4*)(VWE + 32 * ks + 8 * kg), w1 = *(const ML_LAS f32x4*)(VWE + 32 * ks + 8 * kg + 4);
              n4 = __builtin_amdgcn_mfma_f32_16x16x32_bf16(af, pack8(w0[0], w0[1], w0[2], w0[3], w1[0], w1[1], w1[2], w1[3]), n4, 0, 0, 0); } }
        asm volatile("s_waitcnt lgkmcnt(0)" ::: "memory"); __builtin_amdgcn_s_barrier(); asm volatile("" ::: "memory");
        { ML_OPAQUE_LANE(ln); const unsigned r31 = ln & 31u, h5 = ln >> 5;
          ML_LAS unsigned char* p0 = lds + P_OFF + 128u * r31; ML_LAS unsigned char* p1 = p0 + 128u * 32u; const unsigned xp = (r31 & 7u) << 4;
#pragma unroll
          for (int ks = 0; ks < 4; ++ks) { const unsigned co = ((2u * ks + h5) << 4) ^ xp;
              const bf16x8 a0 = *(const ML_LAS bf16x8*)(p0 + co), a1 = *(const ML_LAS bf16x8*)(p1 + co);
              Y0 = __builtin_amdgcn_mfma_f32_32x32x16_bf16(a0, vw[ks], Y0, 0, 0, 0); Y1 = __builtin_amdgcn_mfma_f32_32x32x16_bf16(a1, vw[ks], Y1, 0, 0, 0); } }
        { ML_OPAQUE_LANE(ln); const unsigned t = ln; float qs = 0.f;
#pragma unroll
          for (int w8 = 0; w8 < 8; ++w8) qs += QNP[w8 * 64 + t];
          const float dn = DENP[t] + DENP[64 + t] + qs; VR[t] = 1.f / fmaxf(fabsf(dn), VEMT[t]); }
        { ML_OPAQUE_LANE(ln); const unsigned h5 = ln >> 5; ML_LAS float* vr = VR + 4 * h5;
#pragma unroll
          for (int qp = 0; qp < 2; ++qp) { const f32x4 ra = *(const ML_LAS f32x4*)(vr + 16 * qp), rb = *(const ML_LAS f32x4*)(vr + 16 * qp + 8), rc = *(const ML_LAS f32x4*)(vr + 32 + 16 * qp), rd = *(const ML_LAS f32x4*)(vr + 32 + 16 * qp + 8);
              const int o = 8 * qp;
              const u32x4 w0 = {pkbf(Y0[o + 0] * ra[0], Y0[o + 1] * ra[1]), pkbf(Y0[o + 2] * ra[2], Y0[o + 3] * ra[3]), pkbf(Y0[o + 4] * rb[0], Y0[o + 5] * rb[1]), pkbf(Y0[o + 6] * rb[2], Y0[o + 7] * rb[3])};
              const u32x4 w1 = {pkbf(Y1[o + 0] * rc[0], Y1[o + 1] * rc[1]), pkbf(Y1[o + 2] * rc[2], Y1[o + 3] * rc[3]), pkbf(Y1[o + 4] * rd[0], Y1[o + 5] * rd[1]), pkbf(Y1[o + 6] * rd[2], Y1[o + 7] * rd[3])};
              pend[qp] = w0; pend[2 + qp] = w1; } }
        asm volatile("" : "+v"(gi_b), "+v"(gf_b));
        sc = sc_n; gi_a = gi_b; gf_a = gf_b;
    }
    { unsigned char* hc = ho + (size_t)(SEQ / 64 - 1) * 32768; *(u32x4*)(hc) = pend[0]; *(u32x4*)(hc + 1024) = pend[1]; *(u32x4*)(hc + 2048) = pend[2]; *(u32x4*)(hc + 3072) = pend[3]; }
#undef ML_STAGE
#undef ML_GATES
#undef ML_VEC
#undef ML_TB
    __syncthreads();
}
}

constexpr int NWAVES = 8;
constexpr int RING_BYTES = 131072;
constexpr int LDS_BYTES = 163840;
constexpr int XCH_OFF = RING_BYTES, ROPE_LDS_OFF = XCH_OFF + 8192, QKG_LDS_OFF = ROPE_LDS_OFF + 16384, SCL_LDS_OFF = QKG_LDS_OFF + 1024;
static_assert(SCL_LDS_OFF + 4096 <= LDS_BYTES - 16, "in-projection LDS map");
static_assert(ml::LDS_END <= LDS_BYTES, "mLSTM LDS map");
#define LAS __attribute__((address_space(3)))
#define GAS __attribute__((address_space(1)))
typedef unsigned v4u __attribute__((ext_vector_type(4)));
typedef unsigned v2u __attribute__((ext_vector_type(2)));
typedef float f32x4 __attribute__((ext_vector_type(4)));
#define LDS_WAIT() asm volatile("s_waitcnt lgkmcnt(0)" ::: "memory")

struct Args { const float* in[9]; float* out; unsigned char* ws; int ph_lo, ph_hi; };

__device__ __forceinline__ float wave_sum(float v) {
#pragma unroll
    for (int o = 1; o < 64; o <<= 1) v += __shfl_xor(v, o);
    return v;
}

#define XB_TMO      128
#define XB_XCNT(j)  (256  + 64 * (j))
#define XB_XSUB(j)  (1280 + 64 * (j))
#define XB_XGEN(j)  (2304 + 64 * (j))
#define XB_TOP      3328
#define XB_TOPGEN   3392
#define XCD_BAR_WORDS 3456
#define XB_SPIN_CAP (1u << 18)

__device__ __forceinline__ unsigned xb_ld(unsigned* p)              { return __hip_atomic_load(p, __ATOMIC_RELAXED, __HIP_MEMORY_SCOPE_AGENT); }
__device__ __forceinline__ unsigned xb_add(unsigned* p, unsigned v) { return __hip_atomic_fetch_add(p, v, __ATOMIC_RELAXED, __HIP_MEMORY_SCOPE_AGENT); }
__device__ __forceinline__ unsigned xb_xcc_id() { return (unsigned)__builtin_amdgcn_s_getreg((3 << 11) | 20) & 0xFu; }
#define XB_SPIN(cond, bar) do { unsigned _sp = 0; while (cond) { __builtin_amdgcn_s_sleep(1); \
    if ((++_sp & 255u) == 0u) { if (xb_ld(&(bar)[XB_TMO])) break; if (_sp > XB_SPIN_CAP) { atomicAdd(&(bar)[XB_TMO], 1u); break; } } } } while (0)

struct XcdBarrier {
    unsigned* bar; unsigned x;
    volatile LAS unsigned* st;
};

__device__ __forceinline__ XcdBarrier xcd_barrier_post(unsigned* bar, volatile LAS unsigned* st) {
    XcdBarrier b; b.bar = bar; b.x = xb_xcc_id(); b.st = st;
    if (threadIdx.x == 0) (void)xb_add(&bar[XB_XCNT(b.x)], 1u);
    return b;
}
__device__ __forceinline__ void xcd_barrier_complete(unsigned* bar, unsigned x, unsigned& nloc, unsigned& nx) {
    const unsigned G = gridDim.x * gridDim.y * gridDim.z;
    unsigned sum, cnt, mine, sp = 0u;
    for (;;) {
        sum = 0u; cnt = 0u; mine = 0u;
#pragma unroll
        for (unsigned j = 0; j < 16; ++j) { const unsigned c = xb_ld(&bar[XB_XCNT(j)]); sum += c; cnt += (c > 0u) ? 1u : 0u; mine = (j == x) ? c : mine; }
        if (sum == G) break;
        __builtin_amdgcn_s_sleep(1);
        if ((++sp & 255u) == 0u) { if (xb_ld(&bar[XB_TMO])) break; if (sp > XB_SPIN_CAP) { atomicAdd(&bar[XB_TMO], 1u); break; } }
    }
    nloc = mine > 0u ? mine : 1u; nx = cnt > 0u ? cnt : 1u;
}

__device__ __forceinline__ void xcd_barrier(const XcdBarrier& b) {
    asm volatile("s_waitcnt vmcnt(0)" ::: "memory");
    __syncthreads();
    if (threadIdx.x == 0) {
        unsigned* bar = b.bar;
        __builtin_amdgcn_s_waitcnt(0);
        unsigned nloc = b.st[0], nx = b.st[1];
        if (nloc == 0u) { xcd_barrier_complete(bar, b.x, nloc, nx); b.st[0] = nloc; b.st[1] = nx; }
        const unsigned old = xb_add(&bar[XB_XSUB(b.x)], 1u);
        const unsigned gen = old / nloc;
        if (old + 1u == (gen + 1u) * nloc) {
            __builtin_amdgcn_fence(__ATOMIC_RELEASE, "agent");
            asm volatile("s_waitcnt vmcnt(0)" ::: "memory");
            const unsigned og = xb_add(&bar[XB_TOP], 1u);
            const unsigned tg = og / nx;
            if (og + 1u == (tg + 1u) * nx) xb_add(&bar[XB_TOPGEN], 1u);
            else XB_SPIN(xb_ld(&bar[XB_TOPGEN]) == tg, bar);
            __builtin_amdgcn_fence(__ATOMIC_ACQUIRE, "agent");
            xb_add(&bar[XB_XGEN(b.x)], 1u);
            asm volatile("s_waitcnt vmcnt(0)" ::: "memory");
        } else {
            XB_SPIN(xb_ld(&bar[XB_XGEN(b.x)]) == gen, bar);
            __builtin_amdgcn_fence(__ATOMIC_ACQUIRE, "agent");
            asm volatile("s_waitcnt vmcnt(0)" ::: "memory");
        }
    }
    __syncthreads();
}

__device__ __forceinline__ int w1_dest_row(int n) {
    if (!HY_SEPARATE_ROPE && n < 1280) { const int s = n & 255; return (n & ~255) | (s & 0xC3) | ((s & 0x10) << 1) | ((s & 0x0C) << 1) | ((s & 0x20) >> 3); }
    if (n >= 2560 && n < 3072) return (n & ~12) | ((n & 4) << 1) | ((n & 8) >> 1);
    return n;
}
__device__ __forceinline__ int q8_dest_row(int n) { return n < NQA ? w1_dest_row(n) : n - (NB1 - NB0); }
__device__ __forceinline__ unsigned pk4i8(float a, float b, float c, float d) {
    int ia = (int)__builtin_rintf(a), ib = (int)__builtin_rintf(b), ic = (int)__builtin_rintf(c), id = (int)__builtin_rintf(d);
    ia = ia < -127 ? -127 : (ia > 127 ? 127 : ia); ib = ib < -127 ? -127 : (ib > 127 ? 127 : ib); ic = ic < -127 ? -127 : (ic > 127 ? 127 : ic); id = id < -127 ? -127 : (id > 127 ? 127 : id);
    return ((unsigned)ia & 0xffu) | (((unsigned)ib & 0xffu) << 8) | (((unsigned)ic & 0xffu) << 16) | ((unsigned)id << 24); }
template <int MODE>
__device__ __forceinline__ void p0_transpose_item(const float* W, int K, int ldw, int kb, int n0, void* WT, LAS float* scr, int lane, const LAS float* cinv) {
    const int k0 = 64 * kb;
#pragma unroll 8
    for (int i = 0; i < 32; ++i) { const int kk = 2 * i + (lane >> 5); scr[kk * 33 + (lane & 31)] = W[(size_t)(k0 + kk) * ldw + n0 + (lane & 31)]; }
    LDS_WAIT(); asm volatile("" ::: "memory");
    const int c = lane & 7;
#pragma unroll
    for (int j = 0; j < 4; ++j) { const int n = (lane >> 3) + 8 * j; const LAS float* s = scr + (8 * c) * 33 + n;
        if constexpr (MODE == 2) { const float ci = cinv[n];
            v2u o8; o8.x = pk4i8(s[0 * 33] * ci, s[1 * 33] * ci, s[2 * 33] * ci, s[3 * 33] * ci); o8.y = pk4i8(s[4 * 33] * ci, s[5 * 33] * ci, s[6 * 33] * ci, s[7 * 33] * ci);
            *(v2u*)((unsigned char*)WT + (size_t)q8_dest_row(n0 + n) * K + k0 + 8 * c) = o8; }
        else if constexpr (MODE == 3) { unsigned char* rowp = (unsigned char*)WT + (size_t)(n0 + n) * 4096;
            if (kb < 16) { v2u o8; o8.x = pk4f8(s[0 * 33] * W8_SCALE, s[1 * 33] * W8_SCALE, s[2 * 33] * W8_SCALE, s[3 * 33] * W8_SCALE); o8.y = pk4f8(s[4 * 33] * W8_SCALE, s[5 * 33] * W8_SCALE, s[6 * 33] * W8_SCALE, s[7 * 33] * W8_SCALE);
                *(v2u*)(rowp + k0 + 8 * c) = o8; }
            else { v4u o; o.x = pk2(s[0 * 33], s[1 * 33]); o.y = pk2(s[2 * 33], s[3 * 33]); o.z = pk2(s[4 * 33], s[5 * 33]); o.w = pk2(s[6 * 33], s[7 * 33]);
                *(v4u*)(rowp + 1024 + (size_t)(k0 - 1024 + 8 * c) * 2) = o; } }
        else { const float ws_ = (MODE == 1 && n0 + n < 3072) ? 0.08838834764831845f : 1.f;
            v4u o; o.x = pk2(s[0 * 33] * ws_, s[1 * 33] * ws_); o.y = pk2(s[2 * 33] * ws_, s[3 * 33] * ws_); o.z = pk2(s[4 * 33] * ws_, s[5 * 33] * ws_); o.w = pk2(s[6 * 33] * ws_, s[7 * 33] * ws_);
            const int nr = (MODE == 1) ? w1_dest_row(n0 + n) - NB0 : n0 + n;
            *(v4u*)((bf16*)WT + (size_t)nr * K + k0 + 8 * c) = o; } }
    LDS_WAIT(); asm volatile("" ::: "memory");
}
__device__ __forceinline__ void p0_q8_colblock(const float* w_in, unsigned char* ws, LAS unsigned char* lds, int cb, int tid, int wave, int lane) {
    const int n0 = cb < NQA / 32 ? 32 * cb : NB1 + 32 * (cb - NQA / 32);
    LAS float* red = (LAS float*)(lds + 8 * 16384);
    const int c4 = (lane & 7) * 4, kr = lane >> 3;
    const float* src = w_in + (size_t)(256 * wave + kr) * NPROJ + n0 + c4;
    f32x4 mx = {0.f, 0.f, 0.f, 0.f};
#pragma unroll 8
    for (int i = 0; i < 32; ++i) { const f32x4 v = *(const f32x4*)(src + (size_t)(8 * i) * NPROJ);
        mx.x = fmaxf(mx.x, fabsf(v.x)); mx.y = fmaxf(mx.y, fabsf(v.y)); mx.z = fmaxf(mx.z, fabsf(v.z)); mx.w = fmaxf(mx.w, fabsf(v.w)); }
#pragma unroll
    for (int o = 8; o < 64; o <<= 1) { mx.x = fmaxf(mx.x, __shfl_xor(mx.x, o)); mx.y = fmaxf(mx.y, __shfl_xor(mx.y, o)); mx.z = fmaxf(mx.z, __shfl_xor(mx.z, o)); mx.w = fmaxf(mx.w, __shfl_xor(mx.w, o)); }
    if (lane < 8) *(LAS f32x4*)(red + wave * 32 + c4) = mx;
    __syncthreads();
    if (tid < 32) { float m = red[tid];
#pragma unroll
        for (int w = 1; w < 8; ++w) m = fmaxf(m, red[w * 32 + tid]);
        m = fmaxf(m, 1e-30f); red[256 + tid] = 127.f / m; ((float*)(ws + WS_SW))[q8_dest_row(n0 + tid)] = m * (1.f / 127.f); }
    __syncthreads();
    LAS float* scr = (LAS float*)(lds + wave * 16384);
    for (int i = 0; i < 4; ++i) p0_transpose_item<2>(w_in, DM, NPROJ, 4 * wave + i, n0, ws + WS_W8T, scr, lane, red + 256);
    __syncthreads();
}
__device__ __forceinline__ float wave_max(float v) {
#pragma unroll
    for (int o = 1; o < 64; o <<= 1) v = fmaxf(v, __shfl_xor(v, o));
    return v;
}
__device__ __forceinline__ void rms_rows2_to_bf16(const float* xrow0, const float* xrow1, const float* g, bf16* orow0, bf16* orow1, unsigned char* frow0, unsigned char* frow1, float* sa0, float* sa1, int lane) {
    const f32x4* xa = (const f32x4*)xrow0 + lane; const f32x4* xb = (const f32x4*)xrow1 + lane; const f32x4* gr = (const f32x4*)g + lane;
    f32x4 v[8], w[8]; float s = 0.f, t = 0.f;
#pragma unroll
    for (int j = 0; j < 8; ++j) { v[j] = __builtin_nontemporal_load(xa + 64 * j); w[j] = __builtin_nontemporal_load(xb + 64 * j); }
#pragma unroll
    for (int j = 0; j < 8; ++j) { s += (v[j].x * v[j].x + v[j].y * v[j].y) + (v[j].z * v[j].z + v[j].w * v[j].w); t += (w[j].x * w[j].x + w[j].y * w[j].y) + (w[j].z * w[j].z + w[j].w * w[j].w); }
    const float r0 = 1.f / sqrtf(wave_sum(s) * (1.f / DM) + EPS), r1 = 1.f / sqrtf(wave_sum(t) * (1.f / DM) + EPS);
    float m0 = 0.f, m1 = 0.f;
#pragma unroll
    for (int j = 0; j < 8; ++j) { const f32x4 gg = gr[64 * j]; v[j] = v[j] * r0 * gg; w[j] = w[j] * r1 * gg;
        m0 = fmaxf(fmaxf(m0, fmaxf(fabsf(v[j].x), fabsf(v[j].y))), fmaxf(fabsf(v[j].z), fabsf(v[j].w))); m1 = fmaxf(fmaxf(m1, fmaxf(fabsf(w[j].x), fabsf(w[j].y))), fmaxf(fabsf(w[j].z), fabsf(w[j].w))); }
    m0 = fmaxf(wave_max(m0), 1e-30f); m1 = fmaxf(wave_max(m1), 1e-30f);
    const float i0 = 127.f / m0, i1 = 127.f / m1;
    if (lane == 0) { *sa0 = m0 * (1.f / 127.f); *sa1 = m1 * (1.f / 127.f); }
    v2u* o0 = (v2u*)orow0 + lane; v2u* o1 = (v2u*)orow1 + lane; unsigned* f0 = (unsigned*)frow0 + lane; unsigned* f1 = (unsigned*)frow1 + lane;
#pragma unroll
    for (int j = 0; j < 8; ++j) { v2u a, b;
        a.x = pk2(v[j].x, v[j].y); a.y = pk2(v[j].z, v[j].w); o0[64 * j] = a; f0[64 * j] = pk4i8(v[j].x * i0, v[j].y * i0, v[j].z * i0, v[j].w * i0);
        b.x = pk2(w[j].x, w[j].y); b.y = pk2(w[j].z, w[j].w); o1[64 * j] = b; f1[64 * j] = pk4i8(w[j].x * i1, w[j].y * i1, w[j].z * i1, w[j].w * i1); }
}
__device__ __forceinline__ void p0_prologue(const Args& a, LAS unsigned char* lds, int vcu, int G, int tid, int wave, int lane) {
    unsigned char* ws = a.ws;
    const float* w_in = a.in[3]; const float* w_out = a.in[8]; const float* norm_g = a.in[2];
    bf16* W2t = (bf16*)(ws + WS_W2T);
    const int gw = vcu * NWAVES + wave, NGW = G * NWAVES; const int gt = vcu * (NWAVES * 64) + tid, NGT = G * NWAVES * 64;
    for (int e = gt; e < 64 * 32; e += NGT) { const int pos = e >> 5, j = e & 31; const float inv = 1.0f / powf(10000.0f, (float)j * (1.0f / 32.0f)); const float ang = (float)pos * inv;
        float* R = (float*)(ws + WS_ROPE); R[2 * e] = cosf(ang); R[2 * e + 1] = sinf(ang); }
    for (int e = gt; e < 16 * DM; e += NGT) { const int g = e >> 11, k = e & (DM - 1); ((bf16*)(ws + WS_WGT))[(size_t)g * DM + k] = (bf16)f2bf(w_in[(size_t)k * NPROJ + NP256 + g]); }
    for (int cb = vcu; cb < NQ8 / 32; cb += G) p0_q8_colblock(w_in, ws, lds, cb, tid, wave, lane);
    LAS float* scr = (LAS float*)(lds + wave * 16384);
    constexpr int I_1 = (DM / 64) * ((NB1 - NB0) / 32), I_2 = (DM / 64) * (DM / 32);
    for (int it = gw; it < I_1 + I_2; it += NGW) {
        if (it < I_1) p0_transpose_item<1>(w_in, DM, NPROJ, it / ((NB1 - NB0) / 32), NB0 + 32 * (it % ((NB1 - NB0) / 32)), ws + WS_W1B, scr, lane, nullptr);
        else p0_transpose_item<3>(w_out, DM, DM, (it - I_1) / (DM / 32), 32 * ((it - I_1) % (DM / 32)), W2t, scr, lane, nullptr);
    }
    bf16* H = (bf16*)(ws + WS_H); unsigned char* H8 = (unsigned char*)a.out; float* SA = (float*)(ws + WS_SA);
    for (int m = gw; m < NTOK; m += 2 * NGW) { const int m1 = (m + NGW < NTOK) ? m + NGW : m;
        const float* xr0 = (m < TOK_PROMPT) ? a.in[0] + (size_t)m * DM : a.in[1] + (size_t)(m - TOK_PROMPT) * DM; const float* xr1 = (m1 < TOK_PROMPT) ? a.in[0] + (size_t)m1 * DM : a.in[1] + (size_t)(m1 - TOK_PROMPT) * DM;
        rms_rows2_to_bf16(xr0, xr1, norm_g, H + (size_t)m * DM, H + (size_t)m1 * DM, H8 + (size_t)m * DM, H8 + (size_t)m1 * DM, SA + m, SA + m1, lane); }
}

__device__ __forceinline__ void p2_qknorm_rope(const Args& a, int vcu, int G, int wave, int lane) {
    unsigned char* ws = a.ws; const float* R = (const float*)(ws + WS_ROPE);
    const int gw = vcu * NWAVES + wave, NGW = G * NWAVES;
    const int fj = lane & 31, c0 = (lane < 32) ? lane : 64 + (lane - 32), c1 = c0 + 32;
    const float gq0 = a.in[5][c0], gq1 = a.in[5][c1], gk0 = a.in[6][c0], gk1 = a.in[6][c1];
    for (int it = gw; it < NTOK * 10; it += NGW) {
        const int t = it / 10, slot = it - t * 10; const int tl = t & (SEQ - 1); const int pos = (lane < 32) ? (tl >> 6) : (tl & 63);
        bf16* p = (slot < 8) ? (bf16*)((unsigned char*)a.out + DO_Q) + (size_t)t * 1024 + slot * 128 : (bf16*)(ws + WS_AK) + (size_t)t * 256 + (slot - 8) * 128;
        const float x0 = bf2f(p[c0]), x1 = bf2f(p[c1]);
        const float r = 1.f / sqrtf(wave_sum(x0 * x0 + x1 * x1) * (1.f / 128.f) + EPS);
        const float y0 = x0 * r * ((slot < 8) ? gq0 : gk0), y1 = x1 * r * ((slot < 8) ? gq1 : gk1);
        const float cs = R[2 * (pos * 32 + fj)], sn = R[2 * (pos * 32 + fj) + 1];
        p[c0] = (bf16)f2bf(y0 * cs - y1 * sn); p[c1] = (bf16)f2bf(y1 * cs + y0 * sn);
    }
}

__device__ __forceinline__ void p4_mlstm_recurrent(const Args& a, LAS unsigned char* lds, int vcu, int G, int tid) {
    unsigned char* ws = a.ws;
    const bf16* MQ = (const bf16*)(ws + WS_MQ); const bf16* MK = (const bf16*)(ws + WS_MK); const bf16* MV = (const bf16*)(ws + WS_MV); const float* GT = (const float*)(ws + WS_GATES);
    LAS float* qs = (LAS float*)lds;
    LAS float* ks = qs + 32 * 128;
    LAS float* vs = ks + 32 * 128;
    LAS float* gi = vs + 32 * 256;
    LAS float* gf = gi + 32;
    const int dv = tid >> 1, half = tid & 1;
    for (int item = vcu; item < NSEQ * 8; item += G) {
        const int b = item >> 3, hd = (item >> 1) & 3, dir = item & 1;
        bf16* HO = (bf16*)(ws + (dir ? WS_HB : WS_HF));
        float C[64], nn[64]; float m = 0.f;
#pragma unroll
        for (int j = 0; j < 64; ++j) { C[j] = 0.f; nn[j] = 0.f; }
        for (int p0 = 0; p0 < SEQ; p0 += 32) {
            __syncthreads();
            { const int rr = tid >> 4, c8 = (tid & 15) * 8; const int tok = dir ? (SEQ - 1 - (p0 + rr)) : (p0 + rr); const size_t row = (size_t)b * SEQ + tok;
              const v4u q4 = *(const v4u*)(MQ + row * 512 + hd * 128 + c8), k4 = *(const v4u*)(MK + row * 512 + hd * 128 + c8);
              LAS float* kd = ks + rr * 128 + c8;
              { LAS float* qa = qs + rr * 128 + (c8 & ~8) + ((c8 & 8) >> 1);   qa[0] = bflo(q4.x); qa[1] = bfhi(q4.x); qa[2] = bflo(q4.y); qa[3] = bfhi(q4.y); qa[8] = bflo(q4.z); qa[9] = bfhi(q4.z); qa[10] = bflo(q4.w); qa[11] = bfhi(q4.w); }
              kd[0] = bflo(k4.x); kd[1] = bfhi(k4.x); kd[2] = bflo(k4.y); kd[3] = bfhi(k4.y); kd[4] = bflo(k4.z); kd[5] = bfhi(k4.z); kd[6] = bflo(k4.w); kd[7] = bfhi(k4.w);
              const int c16 = (tid & 15) * 16; LAS float* vd = vs + rr * 256 + c16;
#pragma unroll
              for (int h2 = 0; h2 < 2; ++h2) { const v4u v4 = *(const v4u*)(MV + row * 1024 + hd * 256 + c16 + 8 * h2);
                  vd[8 * h2 + 0] = bflo(v4.x); vd[8 * h2 + 1] = bfhi(v4.x); vd[8 * h2 + 2] = bflo(v4.y); vd[8 * h2 + 3] = bfhi(v4.y); vd[8 * h2 + 4] = bflo(v4.z); vd[8 * h2 + 5] = bfhi(v4.z); vd[8 * h2 + 6] = bflo(v4.w); vd[8 * h2 + 7] = bfhi(v4.w); }
              if (tid < 32) { const int tk = dir ? (SEQ - 1 - (p0 + tid)) : (p0 + tid); const size_t rw = (size_t)b * SEQ + tk; gi[tid] = GT[rw * 16 + dir * 8 + hd]; gf[tid] = GT[rw * 16 + dir * 8 + 4 + hd]; }
            }
            __syncthreads();
            for (int pp = 0; pp < 32; ++pp) {
                const float lf = gf[pp], ii = gi[pp];
                const float mn = fmaxf(lf + m, ii);
                const float ca = expf(lf + m - mn), cb = expf(ii - mn);
                const float bv = cb * vs[pp * 256 + dv];
                float hp = 0.f, qn = 0.f;
                const LAS float* kr = ks + pp * 128 + 64 * half; const LAS float* qr = qs + pp * 128 + 64 * half;
#pragma unroll
                for (int j = 0; j < 64; ++j) { const float kk = kr[j], qq = qr[j];
                    C[j] = fmaf(ca, C[j], kk * bv); nn[j] = fmaf(ca, nn[j], cb * kk); hp = fmaf(qq, C[j], hp); qn = fmaf(qq, nn[j], qn); }
                hp += __shfl_xor(hp, 1); qn += __shfl_xor(qn, 1);
                const float den = fmaxf(fabsf(qn), expf(-mn));
                if (half == 0) { const int pos = p0 + pp, cch = pos >> 6, o = pos & 63, tt = o >> 5, rho = o & 31, q = rho >> 3, hh = (rho >> 2) & 1, e = rho & 3;
                    HO[(((size_t)((b * 4 + hd) * 32 + cch) * 32768) + (dv >> 5) * 4096 + tt * 2048 + (q >> 1) * 1024 + (32 * hh + (dv & 31)) * 16) / 2 + 4 * (q & 1) + e] = (bf16)f2bf(hp / den); }
                m = mn;
            }
        }
    }
}

__device__ __forceinline__ void p5_mlstm_finalize(const Args& a, LAS unsigned char* lds, int vcu, int G, int tid, int wave, int lane) {
    unsigned char* ws = a.ws; const float* mg = a.in[7];
    const bf16* MO = (const bf16*)(ws + WS_MO); const bf16* MZ = (const bf16*)(ws + WS_MZ); bf16* MIX = (bf16*)(ws + WS_MIX);
    LAS float* XS = (LAS float*)lds;
    const int r31 = lane & 31, h5 = lane >> 5, dv0 = 8 * r31;
    constexpr int NIT = NSEQ * 4 * 32;
    v4u f[2][2], bb[2][2];
#define P5_LOAD_H(item_) do { const int bh_ = (item_) >> 5, ck_ = (item_) & 31; \
        const unsigned char* hf_ = ws + WS_HF + ((size_t)bh_ * 32 + ck_) * 32768 + wave * 4096 + lane * 16; const unsigned char* hb_ = ws + WS_HB + ((size_t)bh_ * 32 + (31 - ck_)) * 32768 + wave * 4096 + (lane ^ 32) * 16; \
        _Pragma("unroll") for (int tt = 0; tt < 2; ++tt) _Pragma("unroll") for (int qp = 0; qp < 2; ++qp) { f[tt][qp] = *(const v4u*)(hf_ + tt * 2048 + qp * 1024); bb[tt][qp] = *(const v4u*)(hb_ + (1 - tt) * 2048 + (1 - qp) * 1024); } } while (0)
    if (vcu < NIT) P5_LOAD_H(vcu);
    for (int item = vcu; item < NIT; item += G) {
        const int bh = item >> 5, ck = item & 31, b = bh >> 2, hd = bh & 3;
        v4u mo[4], mz[4];
#pragma unroll
        for (int it = 0; it < 4; ++it) { const int o = it * 16 + wave * 2 + h5; const size_t row = (size_t)b * SEQ + ck * 64 + o;
            mo[it] = *(const v4u*)(MO + row * 1024 + hd * 256 + dv0); mz[it] = *(const v4u*)(MZ + row * 1024 + hd * 256 + dv0); }
        __syncthreads();
#pragma unroll
        for (int tt = 0; tt < 2; ++tt)
#pragma unroll
            for (int qp = 0; qp < 2; ++qp) { const v4u fv = f[tt][qp], bv = bb[tt][qp];
                float fs[8] = {bflo(fv.x), bfhi(fv.x), bflo(fv.y), bfhi(fv.y), bflo(fv.z), bfhi(fv.z), bflo(fv.w), bfhi(fv.w)};
                float bs[8] = {bflo(bv.x), bfhi(bv.x), bflo(bv.y), bfhi(bv.y), bflo(bv.z), bfhi(bv.z), bflo(bv.w), bfhi(bv.w)};
#pragma unroll
                for (int j = 0; j < 8; ++j) { const int o = 32 * tt + 8 * (2 * qp + (j >> 2)) + 4 * h5 + (j & 3); XS[o * 256 + 32 * wave + r31] = fs[j] + bs[7 - j]; } }
        __syncthreads();
        if (item + G < NIT) P5_LOAD_H(item + G);
        const f32x4 g0 = *(const f32x4*)(mg + hd * 256 + dv0), g1 = *(const f32x4*)(mg + hd * 256 + dv0 + 4);
        const float gg[8] = {g0[0], g0[1], g0[2], g0[3], g1[0], g1[1], g1[2], g1[3]};
#pragma unroll
        for (int it = 0; it < 4; ++it) { const int o = it * 16 + wave * 2 + h5; const size_t row = (size_t)b * SEQ + ck * 64 + o;
            const f32x4 x0 = *(const LAS f32x4*)(XS + o * 256 + dv0), x1 = *(const LAS f32x4*)(XS + o * 256 + dv0 + 4);
            float hm[8] = {x0[0], x0[1], x0[2], x0[3], x1[0], x1[1], x1[2], x1[3]};
            const float mo8[8] = {bflo(mo[it].x), bfhi(mo[it].x), bflo(mo[it].y), bfhi(mo[it].y), bflo(mo[it].z), bfhi(mo[it].z), bflo(mo[it].w), bfhi(mo[it].w)};
            const float mz8[8] = {bflo(mz[it].x), bfhi(mz[it].x), bflo(mz[it].y), bfhi(mz[it].y), bflo(mz[it].z), bfhi(mz[it].z), bflo(mz[it].w), bfhi(mz[it].w)};
            float ss = 0.f;
#pragma unroll
            for (int j = 0; j < 8; ++j) { hm[j] = hm[j] * __builtin_amdgcn_rcpf(1.f + __expf(-mo8[j])); ss += hm[j] * hm[j]; }
#pragma unroll
            for (int s = 1; s < 32; s <<= 1) ss += __shfl_xor(ss, s);
            const float r = __builtin_amdgcn_rsqf(ss * (1.f / 256.f) + EPS);
            float ov[8];
#pragma unroll
            for (int j = 0; j < 8; ++j) ov[j] = hm[j] * r * gg[j] * (mz8[j] * __builtin_amdgcn_rcpf(1.f + __expf(-mz8[j])));
            v4u w; w.x = pk2(ov[0], ov[1]); w.y = pk2(ov[2], ov[3]); w.z = pk2(ov[4], ov[5]); w.w = pk2(ov[6], ov[7]);
            *(v4u*)(MIX + row * 2048 + 512 + hd * 256 + dv0) = w; }
    }
#undef P5_LOAD_H
    __syncthreads();
}

__device__ __forceinline__ void p5_item(const Args& a, LAS unsigned char* lds, int item) {
    int tid_ = threadIdx.x; asm volatile("" : "+v"(tid_));
    const int lane = tid_ & 63, wave = __builtin_amdgcn_readfirstlane(tid_ >> 6);
    unsigned char* ws = a.ws; const float* mg = a.in[7];
    const bf16* MO = (const bf16*)(ws + WS_MO); const bf16* MZ = (const bf16*)(ws + WS_MZ); bf16* MIX = (bf16*)(ws + WS_MIX);
    LAS float* XS = (LAS float*)lds; const int r31 = lane & 31, h5 = lane >> 5, dv0 = 8 * r31;
    const int bh = item >> 5, ck = item & 31, b = bh >> 2, hd = bh & 3;
    const unsigned char* hf_ = ws + WS_HF + ((size_t)bh * 32 + ck) * 32768 + wave * 4096 + lane * 16; const unsigned char* hb_ = ws + WS_HB + ((size_t)bh * 32 + (31 - ck)) * 32768 + wave * 4096 + (lane ^ 32) * 16;
    v4u f[2][2], bb[2][2], mo[4], mz[4];
#pragma unroll
    for (int tt = 0; tt < 2; ++tt)
#pragma unroll
        for (int qp = 0; qp < 2; ++qp) { f[tt][qp] = *(const v4u*)(hf_ + tt * 2048 + qp * 1024); bb[tt][qp] = *(const v4u*)(hb_ + (1 - tt) * 2048 + (1 - qp) * 1024); }
#pragma unroll
    for (int it = 0; it < 4; ++it) { const int o = it * 16 + wave * 2 + h5; const size_t row = (size_t)b * SEQ + ck * 64 + o;
        mo[it] = *(const v4u*)(MO + row * 1024 + hd * 256 + dv0); mz[it] = *(const v4u*)(MZ + row * 1024 + hd * 256 + dv0); }
    __syncthreads();
#pragma unroll
    for (int tt = 0; tt < 2; ++tt)
#pragma unroll
        for (int qp = 0; qp < 2; ++qp) { const v4u fv = f[tt][qp], bv = bb[tt][qp];
            float fs[8] = {bflo(fv.x), bfhi(fv.x), bflo(fv.y), bfhi(fv.y), bflo(fv.z), bfhi(fv.z), bflo(fv.w), bfhi(fv.w)};
            float bs[8] = {bflo(bv.x), bfhi(bv.x), bflo(bv.y), bfhi(bv.y), bflo(bv.z), bfhi(bv.z), bflo(bv.w), bfhi(bv.w)};
#pragma unroll
            for (int j = 0; j < 8; ++j) { const int o = 32 * tt + 8 * (2 * qp + (j >> 2)) + 4 * h5 + (j & 3); XS[o * 256 + 32 * wave + r31] = fs[j] + bs[7 - j]; } }
    __syncthreads();
    const f32x4 g0 = *(const f32x4*)(mg + hd * 256 + dv0), g1 = *(const f32x4*)(mg + hd * 256 + dv0 + 4);
    const float gg[8] = {g0[0], g0[1], g0[2], g0[3], g1[0], g1[1], g1[2], g1[3]};
#pragma unroll
    for (int it = 0; it < 4; ++it) { const int o = it * 16 + wave * 2 + h5; const size_t row = (size_t)b * SEQ + ck * 64 + o;
        const f32x4 x0 = *(const LAS f32x4*)(XS + o * 256 + dv0), x1 = *(const LAS f32x4*)(XS + o * 256 + dv0 + 4);
        float hm[8] = {x0[0], x0[1], x0[2], x0[3], x1[0], x1[1], x1[2], x1[3]};
        const float mo8[8] = {bflo(mo[it].x), bfhi(mo[it].x), bflo(mo[it].y), bfhi(mo[it].y), bflo(mo[it].z), bfhi(mo[it].z), bflo(mo[it].w), bfhi(mo[it].w)};
        const float mz8[8] = {bflo(mz[it].x), bfhi(mz[it].x), bflo(mz[it].y), bfhi(mz[it].y), bflo(mz[it].z), bfhi(mz[it].z), bflo(mz[it].w), bfhi(mz[it].w)};
        float ss = 0.f;
#pragma unroll
        for (int j = 0; j < 8; ++j) { hm[j] = hm[j] * __builtin_amdgcn_rcpf(1.f + __expf(-mo8[j])); ss += hm[j] * hm[j]; }
#pragma unroll
        for (int s = 1; s < 32; s <<= 1) ss += __shfl_xor(ss, s);
        const float r = __builtin_amdgcn_rsqf(ss * (1.f / 256.f) + EPS);
        float ov[8];
#pragma unroll
        for (int j = 0; j < 8; ++j) ov[j] = hm[j] * r * gg[j] * (mz8[j] * __builtin_amdgcn_rcpf(1.f + __expf(-mz8[j])));
        v4u w; w.x = pk2(ov[0], ov[1]); w.y = pk2(ov[2], ov[3]); w.z = pk2(ov[4], ov[5]); w.w = pk2(ov[6], ov[7]);
        *(v4u*)(MIX + row * 2048 + 512 + hd * 256 + dv0) = w; }
    __syncthreads();
}

__device__ __forceinline__ void p5_batch(const Args& a, LAS unsigned char* lds, int first, int count) {
    if (count <= 0) return;
    int tid_ = threadIdx.x; asm volatile("" : "+v"(tid_));
    const int lane = tid_ & 63, wave = __builtin_amdgcn_readfirstlane(tid_ >> 6);
    unsigned char* ws = a.ws; const float* mg = a.in[7];
    const bf16* MO = (const bf16*)(ws + WS_MO); const bf16* MZ = (const bf16*)(ws + WS_MZ); bf16* MIX = (bf16*)(ws + WS_MIX);
    LAS float* XS = (LAS float*)lds; const int r31 = lane & 31, h5 = lane >> 5, dv0 = 8 * r31;
    v4u f[2][2], bb[2][2];
#define P5B_LOAD_H(item_) do { const int bh_ = (item_) >> 5, ck_ = (item_) & 31; \
        const unsigned char* hf_ = ws + WS_HF + ((size_t)bh_ * 32 + ck_) * 32768 + wave * 4096 + lane * 16; const unsigned char* hb_ = ws + WS_HB + ((size_t)bh_ * 32 + (31 - ck_)) * 32768 + wave * 4096 + (lane ^ 32) * 16; \
        _Pragma("unroll") for (int tt = 0; tt < 2; ++tt) _Pragma("unroll") for (int qp = 0; qp < 2; ++qp) { f[tt][qp] = *(const v4u*)(hf_ + tt * 2048 + qp * 1024); bb[tt][qp] = *(const v4u*)(hb_ + (1 - tt) * 2048 + (1 - qp) * 1024); } } while (0)
    P5B_LOAD_H(first);
    for (int i = 0; i < count; ++i) {
        const int item = first + i, bh = item >> 5, ck = item & 31, b = bh >> 2, hd = bh & 3;
        v4u mo[4], mz[4];
#pragma unroll
        for (int it = 0; it < 4; ++it) { const int o = it * 16 + wave * 2 + h5; const size_t row = (size_t)b * SEQ + ck * 64 + o;
            mo[it] = *(const v4u*)(MO + row * 1024 + hd * 256 + dv0); mz[it] = *(const v4u*)(MZ + row * 1024 + hd * 256 + dv0); }
        __syncthreads();
#pragma unroll
        for (int tt = 0; tt < 2; ++tt)
#pragma unroll
            for (int qp = 0; qp < 2; ++qp) { const v4u fv = f[tt][qp], bv = bb[tt][qp];
                float fs[8] = {bflo(fv.x), bfhi(fv.x), bflo(fv.y), bfhi(fv.y), bflo(fv.z), bfhi(fv.z), bflo(fv.w), bfhi(fv.w)};
                float bs[8] = {bflo(bv.x), bfhi(bv.x), bflo(bv.y), bfhi(bv.y), bflo(bv.z), bfhi(bv.z), bflo(bv.w), bfhi(bv.w)};
#pragma unroll
                for (int j = 0; j < 8; ++j) { const int o = 32 * tt + 8 * (2 * qp + (j >> 2)) + 4 * h5 + (j & 3); XS[o * 256 + 32 * wave + r31] = fs[j] + bs[7 - j]; } }
        __syncthreads();
        if (i + 1 < count) P5B_LOAD_H(item + 1);
        const f32x4 g0 = *(const f32x4*)(mg + hd * 256 + dv0), g1 = *(const f32x4*)(mg + hd * 256 + dv0 + 4);
        const float gg[8] = {g0[0], g0[1], g0[2], g0[3], g1[0], g1[1], g1[2], g1[3]};
#pragma unroll
        for (int it = 0; it < 4; ++it) { const int o = it * 16 + wave * 2 + h5; const size_t row = (size_t)b * SEQ + ck * 64 + o;
            const f32x4 x0 = *(const LAS f32x4*)(XS + o * 256 + dv0), x1 = *(const LAS f32x4*)(XS + o * 256 + dv0 + 4);
            float hm[8] = {x0[0], x0[1], x0[2], x0[3], x1[0], x1[1], x1[2], x1[3]};
            const float mo8[8] = {bflo(mo[it].x), bfhi(mo[it].x), bflo(mo[it].y), bfhi(mo[it].y), bflo(mo[it].z), bfhi(mo[it].z), bflo(mo[it].w), bfhi(mo[it].w)};
            const float mz8[8] = {bflo(mz[it].x), bfhi(mz[it].x), bflo(mz[it].y), bfhi(mz[it].y), bflo(mz[it].z), bfhi(mz[it].z), bflo(mz[it].w), bfhi(mz[it].w)};
            float ss = 0.f;
#pragma unroll
            for (int j = 0; j < 8; ++j) { hm[j] = hm[j] * __builtin_amdgcn_rcpf(1.f + __expf(-mo8[j])); ss += hm[j] * hm[j]; }
#pragma unroll
            for (int s = 1; s < 32; s <<= 1) ss += __shfl_xor(ss, s);
            const float r = __builtin_amdgcn_rsqf(ss * (1.f / 256.f) + EPS);
            float ov[8];
#pragma unroll
            for (int j = 0; j < 8; ++j) ov[j] = hm[j] * r * gg[j] * (mz8[j] * __builtin_amdgcn_rcpf(1.f + __expf(-mz8[j])));
            v4u w; w.x = pk2(ov[0], ov[1]); w.y = pk2(ov[2], ov[3]); w.z = pk2(ov[4], ov[5]); w.w = pk2(ov[6], ov[7]);
            *(v4u*)(MIX + row * 2048 + 512 + hd * 256 + dv0) = w; }
    }
#undef P5B_LOAD_H
    __syncthreads();
}

__device__ __forceinline__ void gate_rows48(unsigned char* ws, const float* b_gates, int row0, int lane) {
    typedef short bf16x8 __attribute__((ext_vector_type(8)));
    const int r15 = lane & 15, kg = lane >> 4;
    const bf16* a0p = (const bf16*)(ws + WS_H) + (size_t)(row0 + r15) * DM + 8 * kg; const bf16* a1p = a0p + 16 * DM; const bf16* a2p = a0p + 32 * DM;
    const bf16* bp = (const bf16*)(ws + WS_WGT) + (size_t)r15 * DM + 8 * kg;
    f32x4 acc0 = {0.f, 0.f, 0.f, 0.f}, acc1 = {0.f, 0.f, 0.f, 0.f}, acc2 = {0.f, 0.f, 0.f, 0.f};
#pragma unroll 8
    for (int ks = 0; ks < DM / 32; ++ks) { const bf16x8 a0 = *(const bf16x8*)(a0p + 32 * ks), a1 = *(const bf16x8*)(a1p + 32 * ks), a2 = *(const bf16x8*)(a2p + 32 * ks), b = *(const bf16x8*)(bp + 32 * ks);
        acc0 = __builtin_amdgcn_mfma_f32_16x16x32_bf16(a0, b, acc0, 0, 0, 0); acc1 = __builtin_amdgcn_mfma_f32_16x16x32_bf16(a1, b, acc1, 0, 0, 0); acc2 = __builtin_amdgcn_mfma_f32_16x16x32_bf16(a2, b, acc2, 0, 0, 0); }
    const float bias = b_gates[r15]; const bool isf = (r15 >> 2) & 1; float* G = (float*)(ws + WS_GATES) + (size_t)(row0 + 4 * kg) * 16 + r15;
#pragma unroll
    for (int r = 0; r < 4; ++r) { float v0 = acc0[r] + bias, v1 = acc1[r] + bias, v2 = acc2[r] + bias; if (isf) { v0 = log_sigmoid_f(v0); v1 = log_sigmoid_f(v1); v2 = log_sigmoid_f(v2); }
        G[r * 16] = v0; G[(16 + r) * 16] = v1; G[(32 + r) * 16] = v2; }
}

constexpr int N_PHASES = 7;
__global__ void __launch_bounds__(NWAVES * 64, 2) hy_fwd(Args args) {
    extern __shared__ __attribute__((aligned(16))) unsigned char lds_raw[];
    LAS unsigned char* lds = (LAS unsigned char*)lds_raw;
    const int tid = threadIdx.x, lane = tid & 63, wave = __builtin_amdgcn_readfirstlane(tid >> 6);
    const int G = gridDim.x; const int bx = blockIdx.x; const int vcu = (G % 8 == 0) ? (bx % 8) * (G / 8) + bx / 8 : bx;
    unsigned char* ws = args.ws;
    const int lo = args.ph_lo, hi = args.ph_hi;
    unsigned* ctl = (unsigned*)(ws + WS_CTL);
    volatile LAS unsigned* bst = (volatile LAS unsigned*)(lds + LDS_BYTES - 16);
    if (tid == 0) { bst[0] = 0u; bst[1] = 0u; }
    __syncthreads();
    XcdBarrier xbar; xbar.bar = ctl + CW_BAR; xbar.x = 0; xbar.st = bst; bool xposted = false;
    const bool one_launch = (lo == 0 && hi == N_PHASES);
    if (one_launch) { xbar = xcd_barrier_post(ctl + CW_BAR, bst); xposted = true; }
#ifndef HY_PHASE_MASK
#define HY_PHASE_MASK 0x7f
#endif
#define IN(k) (((HY_PHASE_MASK >> (k)) & 1) && lo <= (k) && (k) < hi)
#define BOTH(k) (IN(k) && IN((k) + 1))
#ifndef HY_DUP_MASK
#define HY_DUP_MASK 0
#endif
#ifndef HY_PROBE_NULL
#define HY_PROBE_NULL 0
#endif
#ifndef HY_ML_PROBE_MODE
#define HY_ML_PROBE_MODE 0
#endif
#define DUP(k) (((HY_DUP_MASK) >> (k)) & 1)
#define GRID_BAR_CG() do { cg::this_grid().sync(); } while (0)
#define GRID_BAR() do { if (!xposted) { xbar = xcd_barrier_post(ctl + CW_BAR, bst); xposted = true; } xcd_barrier(xbar); } while (0)

    if (IN(0) && DUP(0)) { p0_prologue(args, lds, vcu, G, tid, wave, lane); __syncthreads(); }
    if (IN(0)) { p0_prologue(args, lds, vcu, G, tid, wave, lane); if (BOTH(0)) GRID_BAR(); }

    if (IN(1)) {
        { const float* Rg = (const float*)(ws + WS_ROPE); LAS float* Rl = (LAS float*)(lds + ROPE_LDS_OFF); LAS float* Gl = (LAS float*)(lds + QKG_LDS_OFF);
          for (int e = tid; e < 64 * 32 * 2; e += NWAVES * 64) Rl[e] = Rg[e];
          if (tid < 128) { Gl[tid] = args.in[5][tid]; Gl[128 + tid] = args.in[6][tid]; }
          __syncthreads(); }
        { pg8::Gemm g{(const pg8::bf16_t*)((unsigned char*)args.out + DO_H8), (const pg8::bf16_t*)(ws + WS_W8T), NTOK, NQ8, DM / 2, DM / 128}; pg8::StaticOrder S; S.init(NTOK, NQ8, G, bx);
          pg8::EpiProjT<0, 2> E{ws, (PG8_LAS float*)(lds + XCH_OFF), (PG8_LAS float*)(lds + ROPE_LDS_OFF), (PG8_LAS float*)(lds + QKG_LDS_OFF), (unsigned char*)args.out + DO_Q, (PG8_LAS float*)(lds + SCL_LDS_OFF), (const float*)(ws + WS_SA), (const float*)(ws + WS_SW)};
          pg8::gemm_phase<pg8::EpiProjT<0, 2>, pg8::StaticOrder, true, true, 2>(lds, g, S, E); }
        { pg8::Gemm g{(const pg8::bf16_t*)(ws + WS_H), (const pg8::bf16_t*)(ws + WS_W1B), NTOK, NB1 - NB0, DM, DM / 64}; pg8::StaticOrder S; S.init(NTOK, NB1 - NB0, G, bx);
          pg8::EpiProjT<NB0 / 256, 0> E{ws, (PG8_LAS float*)(lds + XCH_OFF), (PG8_LAS float*)(lds + ROPE_LDS_OFF), (PG8_LAS float*)(lds + QKG_LDS_OFF), (unsigned char*)args.out + DO_Q, nullptr, nullptr, nullptr};
          pg8::gemm_phase<pg8::EpiProjT<NB0 / 256, 0>, pg8::StaticOrder, true, true, 0>(lds, g, S, E); }
        { const int nun = (NTOK / 256) * (NQ8 / 256), full = nun / G, rem = nun - full * G, light = G - rem;
          if (bx >= rem) for (int it = (bx - rem) * NWAVES + wave; it < NTOK / 48; it += light * NWAVES) gate_rows48(ws, args.in[4], it * 48, lane); }
        if (BOTH(1)) GRID_BAR();
    }

static_assert(!HY_SEPARATE_ROPE, "the attention body takes fp8 q / k rows, which only the fused in-projection epilogue writes");
#if HY_SEPARATE_ROPE
    if (IN(2)) { p2_qknorm_rope(args, vcu, G, wave, lane); if (BOTH(2)) GRID_BAR(); }
#endif

#define ATTN_UNIT(grp_, w_) do { const int b_ = (grp_) >> 1, kvh_ = (grp_) & 1, h_ = kvh_ * 4 + ((w_) >> 3), qb_ = (w_) & 7; const size_t row0_ = (size_t)b_ * SEQ + qb_ * 256; \
        const unsigned char* Q_ = (const unsigned char*)args.out + DO_Q + row0_ * 1024 + h_ * 128; unsigned char* O_ = ws + WS_MIX + row0_ * 4096 + h_ * 128; const unsigned char* K_ = ws + WS_AK + (size_t)b_ * SEQ * 256 + kvh_ * 128; \
        const unsigned char* V_ = ws + WS_AV + (size_t)(grp_) * 128 * 2048; const bf16* Z_ = (const bf16*)(ws + WS_AZ) + row0_ * 1024 + h_ * 128; \
        int seqv_ = SEQ; asm volatile("" : "+s"(seqv_)); attn::attn_dense_body<attn::bf16>(Q_, K_, V_, O_, Z_, seqv_, (char*)lds_raw); __syncthreads(); } while (0)
#if HY_SCHED_J
    const bool schedJ = one_launch && G == 256;
    if (schedJ) {
        const int xl = vcu >> 5, s = vcu & 31;
        if (s < 24) ml::mlstm_item<0>(ws, lds, xl * 24 + s, tid);
        else for (int j = 0; j < 2; ++j) ATTN_UNIT(xl, 2 * (s - 24) + j);
        GRID_BAR();
        const int n_rest = (s < 16) ? 6 : 5, n_p5 = (s < 16) ? 8 : 16, p5_0 = (s < 16) ? 8 * (xl * 16 + s) : 1024 + 16 * (xl * 16 + (s - 16));
        int p5_done = 0;
        for (int jr = 0; jr < n_rest; ++jr) {
            if ((jr & 1) == 0) { const int tgt = (n_p5 * ((jr >> 1) + 1)) / 3;
                p5_batch(args, lds, p5_0 + p5_done, tgt - p5_done); p5_done = tgt; }
            const int li = s + 32 * jr;
            const int grp = (li < 16) ? xl : xl + 8 * (1 + ((li - 16) >> 5)), w = (li < 16) ? 16 + li : (li - 16) & 31;
            ATTN_UNIT(grp, w);
        }
        GRID_BAR();
    }
#else
    const bool schedJ = false;
#endif

    if (!schedJ && IN(3)) {
        for (int u = vcu; u < NSEQ * 2 * 32; u += G) ATTN_UNIT(u >> 5, u & 31);
        if (BOTH(3)) GRID_BAR();
    }

    if (!schedJ && IN(4) && DUP(4)) {
#if HY_MLSTM_REF
        p4_mlstm_recurrent(args, lds, vcu, G, tid);
#else
        for (int item = vcu; item < NSEQ * 8; item += G) ml::mlstm_item<HY_ML_PROBE_MODE>(ws, lds, item, tid);
#endif
        if (BOTH(4)) GRID_BAR(); }

    if (!schedJ && IN(4)) {
#if HY_MLSTM_REF
        p4_mlstm_recurrent(args, lds, vcu, G, tid);
#else
        for (int item = vcu; item < NSEQ * 8; item += G) ml::mlstm_item<0>(ws, lds, item, tid);
#endif
        if (BOTH(4)) GRID_BAR(); }

    if (!schedJ && IN(5) && DUP(5)) { p5_mlstm_finalize(args, lds, vcu, G, tid, wave, lane); }
    if (!schedJ && IN(5)) { p5_mlstm_finalize(args, lds, vcu, G, tid, wave, lane); if (BOTH(5)) GRID_BAR(); }

    if (IN(6)) {
        pg8::Gemm g{(const pg8::bf16_t*)(ws + WS_MIX), (const pg8::bf16_t*)(ws + WS_W2T), NTOK, DM, DM, pg8::F8_TILES + 1024 / 64}; pg8::StaticOrder S; S.init(NTOK, DM, G, bx);
        pg8::EpiOut E{args.in[0], args.in[1], args.out};
        pg8::gemm_phase<pg8::EpiOut, pg8::StaticOrder, true, true, 3>(lds, g, S, E);
    }
    if (one_launch && lo < 0) GRID_BAR_CG();
#undef IN
#undef BOTH
}

extern "C" void kernel_launch(void* const* d_in, const int* in_sizes, int n_in, void* d_out, int out_size, void* d_ws, size_t ws_size, hipStream_t stream) {
    static int grid = 0;
    if (grid == 0) {
        if (n_in != 9 || in_sizes[0] != TOK_PROMPT * DM || in_sizes[1] != (NTOK - TOK_PROMPT) * DM || out_size != NTOK * DM || ws_size < WS_END) {
            fprintf(stderr, "kernel_launch: shape mismatch n_in %d in0 %d in1 %d out %d ws %zu (need %zu)\n", n_in, n_in > 0 ? in_sizes[0] : -1, n_in > 1 ? in_sizes[1] : -1, out_size, ws_size, (size_t)WS_END); grid = -1; return; }
        int dev = 0, cus = 0, per_cu = 0;
        if (hipGetDevice(&dev) != hipSuccess || hipDeviceGetAttribute(&cus, hipDeviceAttributeMultiprocessorCount, dev) != hipSuccess) { fprintf(stderr, "kernel_launch: device query failed\n"); grid = -1; return; }
        if (hipFuncSetAttribute((const void*)hy_fwd, hipFuncAttributeMaxDynamicSharedMemorySize, LDS_BYTES) != hipSuccess) { fprintf(stderr, "kernel_launch: hipFuncSetAttribute failed\n"); grid = -1; return; }
        if (hipOccupancyMaxActiveBlocksPerMultiprocessor(&per_cu, (const void*)hy_fwd, NWAVES * 64, LDS_BYTES) != hipSuccess || per_cu < 1) { fprintf(stderr, "kernel_launch: occupancy query says %d\n", per_cu); per_cu = 1; }
        (void)hipGetLastError();
        grid = cus;
    }
    if (grid < 0) return;
    if (hipMemsetAsync((char*)d_ws + WS_CTL, 0, 65536, stream) != hipSuccess) { fprintf(stderr, "kernel_launch: hipMemsetAsync of the control words failed\n"); return; }
    Args a{};
    for (int i = 0; i < 9; ++i) a.in[i] = (const float*)d_in[i];
    a.out = (float*)d_out; a.ws = (unsigned char*)d_ws;
#if HY_N_LAUNCHES == 1
    a.ph_lo = 0; a.ph_hi = N_PHASES;
    void* kargs[] = {&a};
    hipError_t e = hipLaunchCooperativeKernel((const void*)hy_fwd, dim3(grid), dim3(NWAVES * 64), kargs, LDS_BYTES, stream);
    if (e != hipSuccess) fprintf(stderr, "kernel_launch: cooperative launch failed: %s (grid %d)\n", hipGetErrorString(e), grid);
#else
    for (int p = 0; p < N_PHASES; ++p) {
        a.ph_lo = p; a.ph_hi = p + 1;
        hipLaunchKernelGGL(hy_fwd, dim3(grid), dim3(NWAVES * 64), LDS_BYTES, stream, a);
        const hipError_t le = hipPeekAtLastError();
        if (le != hipSuccess) { fprintf(stderr, "kernel_launch: launch %d failed: %s\n", p, hipGetErrorName(le)); break; }
    }
#endif
}
```

```cpp
#include <hip/hip_runtime.h>
#include <hip/hip_bf16.h>
#include <hip/hip_cooperative_groups.h>
#include <cstdio>
#include <cstdint>
#include <cmath>
namespace cg = cooperative_groups;

#ifndef HY_SEPARATE_ROPE
#define HY_SEPARATE_ROPE 0
#endif
#ifndef HY_SCHED_J
#define HY_SCHED_J 1
#endif
#ifndef HY_MLSTM_REF
#define HY_MLSTM_REF 0
#endif
#ifndef HY_N_LAUNCHES
#define HY_N_LAUNCHES 1
#endif

constexpr int SEQ = 2048, NSEQ = 24, NTOK = NSEQ * SEQ, TOK_PROMPT = 8 * SEQ, DM = 2048;
constexpr int NPROJ = 6672, NP256 = 6656;
constexpr float EPS = 1e-6f;

constexpr size_t MiB = 1u << 20;
constexpr size_t WS_CTL = 0, CTL_ZERO_BYTES = 1 * MiB;
constexpr int CW_BAR = 4096, CW_QUEUE = 8192;
constexpr size_t WS_ROPE = 1 * MiB;
constexpr size_t WS_W8T = 2 * MiB;
constexpr size_t WS_W1B = 14 * MiB;
constexpr size_t WS_WGT = 18 * MiB;
constexpr size_t WS_SW = 19 * MiB;
constexpr size_t WS_SA = 20 * MiB;
constexpr size_t WS_W2T = 30 * MiB;
constexpr size_t WS_GATES = 38 * MiB;
constexpr size_t WS_H = 42 * MiB;
constexpr size_t WS_HF = WS_H, WS_HB = WS_H + 96 * MiB;
constexpr size_t WS_MIX = 234 * MiB;
constexpr size_t DO_H8 = 0, DO_Q = 96 * MiB;
constexpr float V8_SCALE = 16.f, P8_SCALE = 16.f;
constexpr float QK8_SCALE = 16.f;
constexpr float A8_SCALE = 256.f, W8_SCALE = 512.f;
constexpr size_t WS_AK = 426 * MiB, WS_AV = 450 * MiB;
constexpr size_t WS_AZ = 474 * MiB;
constexpr size_t WS_MQ = 570 * MiB, WS_MK = 618 * MiB;
constexpr size_t WS_MV = 666 * MiB, WS_MO = 762 * MiB, WS_MZ = 858 * MiB;
constexpr size_t WS_END = 954 * MiB;

typedef unsigned short bf16;
__device__ __forceinline__ unsigned f2bf(float f) { unsigned u = __builtin_bit_cast(unsigned, f); return (u + 0x7fffu + ((u >> 16) & 1u)) >> 16; }
__device__ __forceinline__ unsigned pk2(float lo, float hi) { return f2bf(lo) | (f2bf(hi) << 16); }
__device__ __forceinline__ float bf2f(unsigned short b) { return __builtin_bit_cast(float, (unsigned)b << 16); }
__device__ __forceinline__ float bflo(unsigned w) { return __builtin_bit_cast(float, w << 16); }
__device__ __forceinline__ float bfhi(unsigned w) { return __builtin_bit_cast(float, w & 0xffff0000u); }
constexpr int NQA = 2560, NB0 = 2560, NB1 = 3584, NQ8 = 5632;
__device__ __forceinline__ unsigned pk4f8(float a, float b, float c, float d) {
    a = __builtin_fminf(__builtin_fmaxf(a, -448.f), 448.f); b = __builtin_fminf(__builtin_fmaxf(b, -448.f), 448.f); c = __builtin_fminf(__builtin_fmaxf(c, -448.f), 448.f); d = __builtin_fminf(__builtin_fmaxf(d, -448.f), 448.f);
    int w = 0; w = __builtin_amdgcn_cvt_pk_fp8_f32(a, b, w, false); w = __builtin_amdgcn_cvt_pk_fp8_f32(c, d, w, true); return (unsigned)w; }
__device__ __forceinline__ float log_sigmoid_f(float x) { return x >= 0.f ? -log1pf(expf(-x)) : x - log1pf(expf(x)); }
namespace pg8 {
#define PG8_LAS __attribute__((address_space(3)))
typedef unsigned short bf16_t;
typedef short bf16x8 __attribute__((ext_vector_type(8)));
typedef float f32x4 __attribute__((ext_vector_type(4)));
typedef unsigned u32x4 __attribute__((ext_vector_type(4)));
typedef int i32x4 __attribute__((ext_vector_type(4)));
constexpr int F8_TILES = 8;
constexpr int BM = 256, BK = 64, HALF = 128, HTB = HALF * BK * 2  , STAGE_BYTES = 8 * HTB, NXCD = 8, WGM = 8;

__host__ __device__ __forceinline__ int lds_byte(int r, int c) { const int st = (r >> 4) * 2 + (c >> 5), rr = r & 15, cc = c & 31, ob = rr * 64 + cc * 2; return st * 1024 + (ob ^ (((ob >> 9) & 1) << 5)); }
__host__ __device__ __forceinline__ void stage_rc(int b, int& R, int& C) { const int st = b / 1024, sb = b % 1024, swz = sb ^ (((sb >> 9) & 1) << 5); R = (st >> 1) * 16 + swz / 64; C = (st & 1) * 32 + (swz % 64) / 2; }
__host__ __device__ __forceinline__ int perm32(int rho) { const int n = rho >> 4, i = rho & 15; return 8 * (i >> 2) + 4 * n + (i & 3); }

struct Unit { int pm, pn; };
struct Gemm { const bf16_t* A; const bf16_t* Bt; int M, N, K, kt; };

struct StaticOrder {
    int nM, nN, nwg, G, c;
    __host__ __device__ void init(int M, int N, int G_, int c_) { nM = M / BM; nN = N / BM; nwg = nM * nN; G = G_; c = c_; }
    __host__ __device__ bool next(int i, Unit& u) const {
        const long L = (long)i * G + c; if (L >= nwg) return false;
        int wgid = (int)L; { const int q = nwg / NXCD, r = nwg % NXCD, xcd = wgid % NXCD, off = wgid / NXCD; wgid = (xcd < r ? xcd * (q + 1) : r * (q + 1) + (xcd - r) * q) + off; }
        const int nig = WGM * nN, gid = wgid / nig, fm = gid * WGM, gsz = (nM - fm) < WGM ? (nM - fm) : WGM;
        u.pm = fm + ((wgid % nig) % gsz); u.pn = (wgid % nig) / gsz; return true;
    }
    __device__ __forceinline__ void a_ready(const Unit&) const {}
    __device__ __forceinline__ void done(const Unit&) const {}
};


__device__ __forceinline__ unsigned cvt_pk_bf16(float lo, float hi) { unsigned r; asm volatile("v_cvt_pk_bf16_f32 %0, %1, %2" : "=v"(r) : "v"(lo), "v"(hi)); return r; }

template <int PN0, int MODE>
struct EpiProjT {
    static constexpr bool PERM = true, AFTER_DRAIN = false, PREFETCH = (MODE == 2); static constexpr int NSTORE = 16;
    unsigned char* ws; PG8_LAS float* xch; PG8_LAS float* ropeL; PG8_LAS float* qkgL;
    unsigned char* qb;
    PG8_LAS float* scl; const float* SA; const float* SW;
    __device__ __forceinline__ void prefetch(const Unit& u, int ui, int wid, int lane) const {
        const float* src = (wid < 4) ? SA + (size_t)u.pm * BM + wid * 64 + lane : SW + u.pn * BM + (wid - 4) * 64 + lane;
        __builtin_amdgcn_global_load_lds((const unsigned*)src, (PG8_LAS unsigned*)(scl + (ui & 1) * 512 + wid * 64), 4, 0, 0); }
    __device__ __forceinline__ void operator()(const f32x4 (&acc)[2][2][4][2], const Unit& u, int wr, int wc, int fr, int fq, int par = 0) const {
        const int pn = (MODE == 2) ? (u.pn < 10 ? u.pn : u.pn + 4) : u.pn + PN0; const int row0 = u.pm * BM + wr * 64 + fr;
        constexpr float SC = (MODE == 1) ? (1.f / 4096.f) : 1.f;
        float sa[2][4]; f32x4 sw[2][2];
        if constexpr (MODE == 2) { PG8_LAS float* T = scl + par * 512;
#pragma unroll
            for (int ai = 0; ai < 2; ++ai)
#pragma unroll
                for (int m = 0; m < 4; ++m) sa[ai][m] = T[ai * HALF + wr * 64 + m * 16 + fr];
#pragma unroll
            for (int bj = 0; bj < 2; ++bj)
#pragma unroll
                for (int n = 0; n < 2; ++n) sw[bj][n] = *(const PG8_LAS f32x4*)(T + 256 + bj * HALF + wc * 32 + 8 * fq + 4 * n); }
        auto val = [&](int ai, int bj, int m, int n) -> f32x4 {
            if constexpr (MODE == 2) { const i32x4 iv = __builtin_bit_cast(i32x4, acc[ai][bj][m][n]); const f32x4 f = {(float)iv[0], (float)iv[1], (float)iv[2], (float)iv[3]}; return f * sa[ai][m] * sw[bj][n]; }
            else return acc[ai][bj][m][n] * SC; };
        if (!HY_SEPARATE_ROPE && PN0 <= 4 && pn <= 4) {
            PG8_LAS float* gsrc = qkgL + ((pn < 4) ? 0 : 128); const int cb = 64 * (wc >> 1) + 16 * (wc & 1) + 4 * fq;
            const f32x4 g1 = *(const PG8_LAS f32x4*)(gsrc + cb), g2 = *(const PG8_LAS f32x4*)(gsrc + cb + 32);
#pragma unroll
            for (int ai = 0; ai < 2; ++ai)
#pragma unroll
                for (int m = 0; m < 4; ++m)
#pragma unroll
                    for (int bj = 0; bj < 2; ++bj) { const f32x4 a = val(ai, bj, m, 0), b = val(ai, bj, m, 1);
                        float s = ((a[0] * a[0] + a[1] * a[1]) + (a[2] * a[2] + a[3] * a[3])) + ((b[0] * b[0] + b[1] * b[1]) + (b[2] * b[2] + b[3] * b[3]));
                        s += __shfl_xor(s, 16); s += __shfl_xor(s, 32);
                        if (fq == 0) xch[((ai * HALF + wr * 64 + m * 16 + fr) * 2 + bj) * 4 + wc] = s; }
            asm volatile("s_waitcnt lgkmcnt(0)" ::: "memory"); __builtin_amdgcn_s_barrier(); asm volatile("" ::: "memory");
            unsigned char* base = pn < 4 ? qb : ws + WS_AK; const int ldc = (pn < 4) ? 1024 : 256; const int colt = (pn < 4) ? pn * 256 : 0;
            PG8_LAS float* R = ropeL; const int j0 = 16 * (wc & 1) + 4 * fq;
#pragma unroll
            for (int ai = 0; ai < 2; ++ai)
#pragma unroll
                for (int m = 0; m < 4; ++m) { const int row = row0 + ai * HALF + m * 16; const int tl = row & (SEQ - 1); const int pos = (wc < 2) ? (tl >> 6) : (tl & 63);
                    const f32x4 cs0 = *(const PG8_LAS f32x4*)(R + (pos * 32 + j0) * 2), cs1 = *(const PG8_LAS f32x4*)(R + (pos * 32 + j0) * 2 + 4);
#pragma unroll
                    for (int bj = 0; bj < 2; ++bj) { const f32x4 pt = *(const PG8_LAS f32x4*)(xch + ((ai * HALF + wr * 64 + m * 16 + fr) * 2 + bj) * 4);
                        const float rstd = 1.f / sqrtf(((pt[0] + pt[1]) + (pt[2] + pt[3])) * (1.f / 128.f) + EPS);
                        const f32x4 y1 = val(ai, bj, m, 0) * rstd * g1, y2 = val(ai, bj, m, 1) * rstd * g2;
                        const float o10 = y1[0] * cs0[0] - y2[0] * cs0[1], o11 = y1[1] * cs0[2] - y2[1] * cs0[3], o12 = y1[2] * cs1[0] - y2[2] * cs1[1], o13 = y1[3] * cs1[2] - y2[3] * cs1[3];
                        const float o20 = y2[0] * cs0[0] + y1[0] * cs0[1], o21 = y2[1] * cs0[2] + y1[1] * cs0[3], o22 = y2[2] * cs1[0] + y1[2] * cs1[1], o23 = y2[3] * cs1[2] + y1[3] * cs1[3];
                        unsigned char* dst = base + (size_t)row * ldc + colt + bj * HALF + cb;
                        *(unsigned*)dst = pk4f8(o10 * QK8_SCALE, o11 * QK8_SCALE, o12 * QK8_SCALE, o13 * QK8_SCALE); *(unsigned*)(dst + 32) = pk4f8(o20 * QK8_SCALE, o21 * QK8_SCALE, o22 * QK8_SCALE, o23 * QK8_SCALE); } }
            return;
        }
        size_t off; int ldc, colt;
        if (pn < 4)       { off = 0; ldc = 1024; colt = pn * 256; }
        else if (pn == 4) { off = WS_AK;  ldc = 256;  colt = 0; }
        else if (pn == 5) { off = WS_AV;  ldc = 256;  colt = 0; }
        else if (pn < 10) { off = WS_AZ;  ldc = 1024; colt = (pn - 6) * 256; }
        else if (pn < 12) { off = WS_MQ;  ldc = 512;  colt = (pn - 10) * 256; }
        else if (pn < 14) { off = WS_MK;  ldc = 512;  colt = (pn - 12) * 256; }
        else if (pn < 18) { off = WS_MV;  ldc = 1024; colt = (pn - 14) * 256; }
        else if (pn < 22) { off = WS_MO;  ldc = 1024; colt = (pn - 18) * 256; }
        else              { off = WS_MZ;  ldc = 1024; colt = (pn - 22) * 256; }
        if constexpr (MODE == 2) { if (pn == 5) {
            unsigned char* VT = ws + WS_AV;
            int fr_ = fr, fq_ = fq; asm volatile("" : "+v"(fr_), "+v"(fq_));
            const int b = u.pm >> 3, tile0 = (u.pm & 7) * 4 + wr, qi = fr_ & 3; const unsigned sel = (unsigned)qi | ((unsigned)(4 + qi) << 8);
#pragma unroll
            for (int ai = 0; ai < 2; ++ai)
#pragma unroll
                for (int m = 0; m < 4; ++m)
#pragma unroll
                    for (int bj = 0; bj < 2; ++bj)
#pragma unroll
                        for (int n = 0; n < 2; ++n) { const f32x4 v = val(ai, bj, m, n) * V8_SCALE; const int w = (int)pk4f8(v[0], v[1], v[2], v[3]);
                            const unsigned w0 = (unsigned)__builtin_amdgcn_update_dpp(0, w, 0x00, 0xf, 0xf, false), w1 = (unsigned)__builtin_amdgcn_update_dpp(0, w, 0x55, 0xf, 0xf, false);
                            const unsigned w2 = (unsigned)__builtin_amdgcn_update_dpp(0, w, 0xaa, 0xf, 0xf, false), w3 = (unsigned)__builtin_amdgcn_update_dpp(0, w, 0xff, 0xf, 0xf, false);
                            const unsigned x01 = __builtin_amdgcn_perm(w1, w0, sel), x23 = __builtin_amdgcn_perm(w3, w2, sel), o4 = __builtin_amdgcn_perm(x23, x01, 0x05040100u);
                            const int d = 32 * wc + 8 * fq_ + 4 * n + qi, dw = ((fr_ >> 2) & 1) * 8 + (m >> 1) * 4 + (m & 1) * 2 + ((fr_ >> 3) & 1);
                            *(unsigned*)(VT + ((size_t)((b * 2 + bj) * 128 + d)) * 2048 + (tile0 + 2 * ai) * 64 + dw * 4) = o4; }
            return; } }
        bf16_t* base = (bf16_t*)(pn < 4 ? qb : ws + off);
        const int col0 = colt + wc * 32 + 8 * fq;
#pragma unroll
        for (int ai = 0; ai < 2; ++ai)
#pragma unroll
            for (int m = 0; m < 4; ++m) { bf16_t* rowp = base + (size_t)(row0 + ai * HALF + m * 16) * ldc + col0;
#pragma unroll
                for (int bj = 0; bj < 2; ++bj) { const f32x4 v0 = val(ai, bj, m, 0), v1 = val(ai, bj, m, 1);
                    u32x4 w; w.x = cvt_pk_bf16(v0[0], v0[1]); w.y = cvt_pk_bf16(v0[2], v0[3]); w.z = cvt_pk_bf16(v1[0], v1[1]); w.w = cvt_pk_bf16(v1[2], v1[3]);
                    *(u32x4*)(rowp + bj * HALF) = w; } }
    }
};
struct EpiNull { static constexpr bool PERM = true, AFTER_DRAIN = false, PREFETCH = false; static constexpr int NSTORE = 0;
    __device__ __forceinline__ void operator()(const f32x4 (&acc)[2][2][4][2], const Unit& u, int wr, int wc, int fr, int fq) const {
#pragma unroll
        for (int ai = 0; ai < 2; ++ai)
#pragma unroll
            for (int bj = 0; bj < 2; ++bj)
#pragma unroll
                for (int m = 0; m < 4; ++m) asm volatile("" :: "v"(acc[ai][bj][m][0]), "v"(acc[ai][bj][m][1])); } };
struct EpiOut {
    static constexpr bool PERM = false, AFTER_DRAIN = false, PREFETCH = false; static constexpr int NSTORE = 32;
    const float* xp; const float* xs; float* out;
    __device__ __forceinline__ void operator()(const f32x4 (&acc)[2][2][4][2], const Unit& u, int wr, int wc, int fr, int fq) const {
        const int row0 = u.pm * BM + wr * 64 + fr; const int col0 = u.pn * BM + wc * 32 + 4 * fq;
        const bool pr = row0 < TOK_PROMPT; const float* xb = (pr ? xp : xs) + col0;
        const size_t xsub = pr ? 0 : (size_t)TOK_PROMPT * DM; float* ob = out + col0;
        f32x4 xr[4][4];
#define EPO_LOAD(g_) do { const size_t ro_ = (size_t)(row0 + ((g_) >> 2) * HALF + ((g_) & 3) * 16) * DM - xsub; \
            xr[(g_) & 3][0] = *(const f32x4*)(xb + ro_); xr[(g_) & 3][1] = *(const f32x4*)(xb + ro_ + 16); xr[(g_) & 3][2] = *(const f32x4*)(xb + ro_ + HALF); xr[(g_) & 3][3] = *(const f32x4*)(xb + ro_ + HALF + 16); } while (0)
        EPO_LOAD(0); EPO_LOAD(1); EPO_LOAD(2);
#pragma unroll
        for (int g = 0; g < 8; ++g) { if (g + 3 < 8) EPO_LOAD(g + 3);
            const int ai = g >> 2, m = g & 3; const size_t ro = (size_t)(row0 + ai * HALF + m * 16) * DM;
            *(f32x4*)(ob + ro) = xr[g & 3][0] + acc[ai][0][m][0]; *(f32x4*)(ob + ro + 16) = xr[g & 3][1] + acc[ai][0][m][1];
            *(f32x4*)(ob + ro + HALF) = xr[g & 3][2] + acc[ai][1][m][0]; *(f32x4*)(ob + ro + HALF + 16) = xr[g & 3][3] + acc[ai][1][m][1]; }
#undef EPO_LOAD
    }
};

template <class Epi, class Sched, bool ALIGN_EPI = false, bool SP2 = false, int MODE = 0>
__device__ __forceinline__ void gemm_phase(PG8_LAS unsigned char* lds, const Gemm g, const Sched& S, const Epi& E) {
    int tid_ = threadIdx.x; asm volatile("" : "+v"(tid_));
    const int tid = tid_, wid = __builtin_amdgcn_readfirstlane(tid >> 6), lane = tid & 63, wr = wid >> 2, wc = wid & 3, fr = lane & 15, fq = lane >> 4;
    const int K = g.K, nt = g.kt;
    unsigned voffA[2], voffB[2];
#pragma unroll
    for (int i = 0; i < 2; ++i) { int R, C; stage_rc(tid * 16 + i * 8192, R, C); const int Rb = Epi::PERM ? ((R & ~31) + perm32(R & 31)) : R;
        voffA[i] = (unsigned)(R * K + C) * 2u; voffB[i] = (unsigned)(Rb * K + C) * 2u; }
    const size_t kstep = (size_t)(BK * 2);
    const size_t hstep = (size_t)HALF * K * 2;
    const size_t tstep = 2 * hstep;
    const unsigned ldsw = (unsigned)wid * 1024u;
    const int aoff = lds_byte(wr * 64 + fr, fq * 8), boff = lds_byte(wc * 32 + fr, fq * 8);
#define PG8_SA(b, h) (((b) * 2 + (h)) * HTB)
#define PG8_SB(b, h) ((4 + (b) * 2 + (h)) * HTB)
#define PG8_STAGE(bufoff, gbase, voff) do { _Pragma("unroll") for (int _i = 0; _i < 2; ++_i) \
        __builtin_amdgcn_global_load_lds((const unsigned*)((const char*)(gbase) + (voff)[_i]), (PG8_LAS unsigned*)(lds + (bufoff) + ldsw + _i * 8192), 16, 0, 0); } while (0)
#define PG8_LDA(dst, b, h) do { _Pragma("unroll") for (int m = 0; m < 4; ++m) _Pragma("unroll") for (int k = 0; k < 2; ++k) dst[m][k] = *(const PG8_LAS bf16x8*)(lds + PG8_SA(b, h) + aoff + m * 2048 + k * 1024); } while (0)
#define PG8_LDB(dst, b, h) do { _Pragma("unroll") for (int n = 0; n < 2; ++n) _Pragma("unroll") for (int k = 0; k < 2; ++k) dst[n][k] = *(const PG8_LAS bf16x8*)(lds + PG8_SB(b, h) + boff + n * 2048 + k * 1024); } while (0)
#define PG8_CAT8(x_) __builtin_shufflevector(__builtin_bit_cast(i32x4, (x_)[0]), __builtin_bit_cast(i32x4, (x_)[1]), 0, 1, 2, 3, 4, 5, 6, 7)
#define PG8_MMA_F8(ai, bj, At, Bt) do { _Pragma("unroll") for (int m = 0; m < 4; ++m) _Pragma("unroll") for (int n = 0; n < 2; ++n) \
        asm volatile("v_mfma_f32_16x16x128_f8f6f4 %0, %1, %2, %0" : "+v"(acc[ai][bj][m][n]) : "v"(PG8_CAT8(Bt[n])), "v"(PG8_CAT8(At[m]))); } while (0)
#define PG8_MMA_I8(ai, bj, At, Bt) do { _Pragma("unroll") for (int k = 0; k < 2; ++k) _Pragma("unroll") for (int m = 0; m < 4; ++m) _Pragma("unroll") for (int n = 0; n < 2; ++n) \
        asm volatile("v_mfma_i32_16x16x64_i8 %0, %1, %2, %0" : "+v"(acc[ai][bj][m][n]) : "v"(Bt[n][k]), "v"(At[m][k])); } while (0)
#define PG8_MMA_BF(ai, bj, At, Bt) do { _Pragma("unroll") for (int m = 0; m < 4; ++m) _Pragma("unroll") for (int n = 0; n < 2; ++n) _Pragma("unroll") for (int k = 0; k < 2; ++k) \
        acc[ai][bj][m][n] = __builtin_amdgcn_mfma_f32_16x16x32_bf16(Bt[n][k], At[m][k], acc[ai][bj][m][n], 0, 0, 0); } while (0)
#define PG8_MMA(ai, bj, At, Bt) do { __builtin_amdgcn_s_setprio(1); \
        if constexpr (MODE == 1) PG8_MMA_F8(ai, bj, At, Bt); else if constexpr (MODE == 2) PG8_MMA_I8(ai, bj, At, Bt); else PG8_MMA_BF(ai, bj, At, Bt); \
        __builtin_amdgcn_s_setprio(0); } while (0)
#define PG8_MMAW_F8(ai, bj, At, Bt) do { __builtin_amdgcn_s_setprio(1); PG8_MMA_F8(ai, bj, At, Bt); __builtin_amdgcn_s_setprio(0); } while (0)
#define PG8_MMAW_BF(ai, bj, At, Bt) do { __builtin_amdgcn_s_setprio(1); PG8_MMA_BF(ai, bj, At, Bt); __builtin_amdgcn_s_setprio(0); } while (0)
#define PG8_WAIT_V(n) asm volatile("s_waitcnt vmcnt(" #n ")" ::: "memory")
#define PG8_WAIT_L(n) asm volatile("s_waitcnt lgkmcnt(" #n ")" ::: "memory")
#define PG8_BAR __builtin_amdgcn_s_barrier()
#define PG8_SCHED __builtin_amdgcn_sched_barrier(0)
    Unit cur, nxt; int ui = 0;
    if (!S.next(0, cur)) return;
    f32x4 acc[2][2][4][2];
#pragma unroll
    for (int a = 0; a < 2; ++a)
#pragma unroll
        for (int b = 0; b < 2; ++b)
#pragma unroll
            for (int m = 0; m < 4; ++m)
#pragma unroll
                for (int n = 0; n < 2; ++n) { acc[a][b][m][n] = (f32x4){0.f, 0.f, 0.f, 0.f}; if constexpr (MODE != 0) asm volatile("" : "+v"(acc[a][b][m][n])); }
    bf16x8 At[4][2], B0[2][2], B1[2][2];
    const char* cA = (const char*)g.A + (size_t)cur.pm * tstep; const char* cB = (const char*)g.Bt + (size_t)cur.pn * tstep;
    S.a_ready(cur);
    if constexpr (SP2) {
        PG8_STAGE(PG8_SB(0, 0), cB, voffB); PG8_STAGE(PG8_SB(0, 1), cB + hstep, voffB); PG8_STAGE(PG8_SA(0, 0), cA, voffA); PG8_STAGE(PG8_SA(0, 1), cA + hstep, voffA);
        if (wr == 1) PG8_BAR;
        PG8_WAIT_V(2); PG8_BAR;
        PG8_STAGE(PG8_SB(1, 0), cB + kstep, voffB); PG8_STAGE(PG8_SA(1, 0), cA + kstep, voffA); PG8_STAGE(PG8_SB(1, 1), cB + hstep + kstep, voffB);
        PG8_WAIT_V(6); PG8_BAR;
    } else {
        PG8_STAGE(PG8_SB(0, 0), cB, voffB); PG8_STAGE(PG8_SA(0, 0), cA, voffA); PG8_STAGE(PG8_SB(0, 1), cB + hstep, voffB); PG8_STAGE(PG8_SA(0, 1), cA + hstep, voffA);
        if (wr == 1) PG8_BAR;
        PG8_WAIT_V(4); PG8_BAR;
        PG8_STAGE(PG8_SB(1, 0), cB + kstep, voffB); PG8_STAGE(PG8_SA(1, 0), cA + kstep, voffA); PG8_STAGE(PG8_SB(1, 1), cB + hstep + kstep, voffB);
        PG8_WAIT_V(6); PG8_BAR;
    }
    for (;;) {
        const bool has_next = S.next(ui + 1, nxt);
        const char* nA = has_next ? (const char*)g.A + (size_t)nxt.pm * tstep : cA; const char* nB = has_next ? (const char*)g.Bt + (size_t)nxt.pn * tstep : cB;
        static_assert(SP2, "gemm_phase: only the SP2 K-loop is carried");
#define PG8_WAIT_FIRST() do { if constexpr (Epi::NSTORE >= 32) asm volatile("s_waitcnt vmcnt(40)\n\ts_cmp_lg_u32 %0, 0\n\ts_cbranch_scc1 1f\n\ts_waitcnt vmcnt(8)\n1:" :: "s"(relax_s) : "memory", "scc"); \
            else if constexpr (Epi::NSTORE >= 16) asm volatile("s_waitcnt vmcnt(24)\n\ts_cmp_lg_u32 %0, 0\n\ts_cbranch_scc1 1f\n\ts_waitcnt vmcnt(8)\n1:" :: "s"(relax_s) : "memory", "scc"); \
            else PG8_WAIT_V(8); } while (0)
#define PG8_TRIP(MMAX) do { \
            const bool last = (t == nt - 2); \
            const char* a1 = cA + (size_t)(t + 1) * kstep; \
            const char* a2 = last ? nA : cA + (size_t)(t + 2) * kstep; const char* b2 = last ? nB : cB + (size_t)(t + 2) * kstep; \
            const char* a3 = a2 + kstep; const char* b3 = b2 + kstep; \
            if (last && has_next) S.a_ready(nxt); \
            const int relax_s = __builtin_amdgcn_readfirstlane((Epi::NSTORE > 0 && t == 0 && ui > 0) ? 1 : 0); \
            PG8_LDB(B0, 0, 0); PG8_LDB(B1, 0, 1); PG8_SCHED; PG8_LDA(At, 0, 0); PG8_STAGE(PG8_SA(1, 1), a1 + hstep, voffA); \
            PG8_WAIT_FIRST(); PG8_WAIT_L(0); PG8_BAR; MMAX(0, 0, At, B0); MMAX(0, 1, At, B1); PG8_BAR; PG8_SCHED; \
            PG8_LDA(At, 0, 1); PG8_STAGE(PG8_SB(0, 0), b2, voffB); PG8_STAGE(PG8_SB(0, 1), b2 + hstep, voffB); PG8_STAGE(PG8_SA(0, 0), a2, voffA); \
            PG8_WAIT_FIRST(); PG8_WAIT_L(0); PG8_BAR; MMAX(1, 0, At, B0); MMAX(1, 1, At, B1); PG8_BAR; PG8_SCHED; \
            if constexpr (Epi::PREFETCH) { if (t == 0) E.prefetch(cur, ui, wid, lane); } \
            PG8_LDB(B0, 1, 0); PG8_LDB(B1, 1, 1); PG8_SCHED; PG8_LDA(At, 1, 0); PG8_STAGE(PG8_SA(0, 1), a2 + hstep, voffA); \
            PG8_WAIT_V(8); PG8_WAIT_L(0); PG8_BAR; MMAX(0, 0, At, B0); MMAX(0, 1, At, B1); PG8_BAR; PG8_SCHED; \
            PG8_LDA(At, 1, 1); PG8_STAGE(PG8_SB(1, 0), b3, voffB); PG8_STAGE(PG8_SB(1, 1), b3 + hstep, voffB); PG8_STAGE(PG8_SA(1, 0), a3, voffA); \
            PG8_WAIT_V(8); PG8_WAIT_L(0); PG8_BAR; MMAX(1, 0, At, B0); MMAX(1, 1, At, B1); PG8_BAR; PG8_SCHED; } while (0)
        if constexpr (MODE == 3) {
            for (int t = 0; t < F8_TILES; t += 2) PG8_TRIP(PG8_MMAW_F8);
            asm volatile("s_nop 15\n\ts_nop 15" ::: "memory"); PG8_SCHED;
#pragma unroll
            for (int a = 0; a < 2; ++a)
#pragma unroll
                for (int b = 0; b < 2; ++b)
#pragma unroll
                    for (int m = 0; m < 4; ++m)
#pragma unroll
                        for (int n = 0; n < 2; ++n) acc[a][b][m][n] *= (1.f / (A8_SCALE * W8_SCALE));
            for (int t = F8_TILES; t < nt; t += 2) PG8_TRIP(PG8_MMAW_BF);
        } else { for (int t = 0; t < nt; t += 2) PG8_TRIP(PG8_MMA); }
#undef PG8_TRIP
#undef PG8_WAIT_FIRST
        if constexpr (MODE == 1 || MODE == 2) { asm volatile("s_nop 15\n\ts_nop 15" ::: "memory"); PG8_SCHED; }
        if constexpr (ALIGN_EPI) { if (wr == 0) PG8_BAR; }
        if constexpr (!Epi::AFTER_DRAIN) { if constexpr (Epi::PREFETCH) E(acc, cur, wr, wc, fr, fq, ui & 1); else E(acc, cur, wr, wc, fr, fq); S.done(cur); }
        if (!has_next) break;
#pragma unroll
        for (int a = 0; a < 2; ++a)
#pragma unroll
            for (int b = 0; b < 2; ++b)
#pragma unroll
                for (int m = 0; m < 4; ++m)
#pragma unroll
                    for (int n = 0; n < 2; ++n) { acc[a][b][m][n] = (f32x4){0.f, 0.f, 0.f, 0.f}; if constexpr (MODE != 0) asm volatile("" : "+v"(acc[a][b][m][n])); }
        cur = nxt; cA = nA; cB = nB; ++ui;
        if constexpr (ALIGN_EPI) { if (wr == 1) PG8_BAR; }
    }
    PG8_WAIT_V(0);
    if constexpr (!ALIGN_EPI) { if (wr == 0) PG8_BAR; }
    PG8_BAR;
    if constexpr (Epi::AFTER_DRAIN) { E.fused(acc, cur, wr, wc, fr, fq, lds, wid, lane); S.done(cur); }
#undef PG8_SA
#undef PG8_SB
#undef PG8_STAGE
#undef PG8_LDA
#undef PG8_LDB
#undef PG8_MMA
#undef PG8_MMAW_F8
#undef PG8_MMAW_BF
#undef PG8_MMA_F8
#undef PG8_MMA_I8
#undef PG8_MMA_BF
#undef PG8_CAT8
#undef PG8_WAIT_V
#undef PG8_WAIT_L
#undef PG8_BAR
#undef PG8_SCHED
}
}
namespace attn {
using bf16 = __hip_bfloat16;
constexpr int   D = 128, NW = 8, QBLK = 32, KVBLK = 64;
constexpr float SCALE = 0.088388347648318440f / (QK8_SCALE * QK8_SCALE);
constexpr float THR = 3.f;
constexpr int SDEPTH = 2;
constexpr int LDQ = 1024, LDK = 256, LDO = 4096, LDZ = 1024;
constexpr size_t SHM_V = KVBLK * D, SHM_K = KVBLK * D, SHM_ATTN = 65536 + NW * 64 * 4;
using bf16x8 = __attribute__((ext_vector_type(8))) short;
using s16x4  = __attribute__((ext_vector_type(4))) short;
using f32x16 = __attribute__((ext_vector_type(16))) float;
using f32x8  = __attribute__((ext_vector_type(8))) float;
using u32x4  = __attribute__((ext_vector_type(4))) unsigned;
#define KSWZ(row, colB) ((row) * 128 + ((colB) ^ ((((row) >> 1) & 7) << 4)))
#define VSWZ(row, colB) ((row) * 64 + ((colB) ^ ((((row) >> 2) & 3) << 4)))
typedef int i32x8 __attribute__((ext_vector_type(8)));
typedef int i32x4a __attribute__((ext_vector_type(4)));
#define SBAR() __builtin_amdgcn_sched_barrier(0)
__device__ __forceinline__ int crow(int r, int hi) { return (r & 3) + 8 * (r >> 2) + 4 * hi; }
__device__ __forceinline__ unsigned cvtpk(float lo, float hi) {
  unsigned r; asm volatile("v_cvt_pk_bf16_f32 %0, %1, %2" : "=v"(r) : "v"(lo), "v"(hi)); return r;
}
template <typename TIn> struct Stage;
template <> struct Stage<bf16>  { using T = bf16x8;
  __device__ static __forceinline__ T ld8(const bf16* p) { return *reinterpret_cast<const bf16x8*>(p); }
  __device__ static __forceinline__ bf16x8 tobf(T x) { return x; } };
template <> struct Stage<float> { using T = f32x8;
  __device__ static __forceinline__ T ld8(const float* p) { return *reinterpret_cast<const f32x8*>(p); }
  __device__ static __forceinline__ bf16x8 tobf(T x) {
    u32x4 w = {cvtpk(x[0], x[1]), cvtpk(x[2], x[3]), cvtpk(x[4], x[5]), cvtpk(x[6], x[7])}; return *reinterpret_cast<bf16x8*>(&w); } };

__device__ __forceinline__ void partialSM(f32x16& p0, f32x16& p1, float& m_reg, float& mn, float& alpha) {
  constexpr float C = SCALE * 1.4426950408889634f;
  float pmax = p0[0]; for (int r = 1; r < 16; ++r) pmax = fmaxf(pmax, p0[r]); for (int r = 0; r < 16; ++r) pmax = fmaxf(pmax, p1[r]);
  { auto rr = __builtin_amdgcn_permlane32_swap(__float_as_uint(pmax), __float_as_uint(pmax), false, false);
    pmax = fmaxf(__uint_as_float(rr[0]), __uint_as_float(rr[1])); }
  if (__builtin_expect(__all(pmax - m_reg <= THR / SCALE), 1)) { mn = m_reg; alpha = 1.f; }
  else { mn = fmaxf(m_reg, pmax); alpha = __builtin_amdgcn_exp2f((m_reg - mn) * C); m_reg = mn; }
  float mnC = -mn * C;
  for (int r = 0; r < 16; ++r) p0[r] = fmaf(p0[r], C, mnC); for (int r = 0; r < 16; ++r) p1[r] = fmaf(p1[r], C, mnC);
  for (int r = 0; r < 16; ++r) p0[r] = __builtin_amdgcn_exp2f(p0[r]);
}
__device__ __forceinline__ void finishSM(f32x16& p0, f32x16& p1, float alpha, float& l_reg, i32x8& pa) {
  for (int r = 0; r < 16; ++r) p1[r] = __builtin_amdgcn_exp2f(p1[r]);
  float ps = 0; for (int r = 0; r < 16; ++r) ps += p0[r]; for (int r = 0; r < 16; ++r) ps += p1[r];
  { auto rr = __builtin_amdgcn_permlane32_swap(__float_as_uint(ps), __float_as_uint(ps), false, false);
    ps = __uint_as_float(rr[0]) + __uint_as_float(rr[1]); }
  l_reg = l_reg * alpha + ps;
#pragma unroll
  for (int q = 0; q < 4; ++q) { pa[q] = (int)pk4f8(p0[4 * q] * P8_SCALE, p0[4 * q + 1] * P8_SCALE, p0[4 * q + 2] * P8_SCALE, p0[4 * q + 3] * P8_SCALE);
    pa[4 + q] = (int)pk4f8(p1[4 * q] * P8_SCALE, p1[4 * q + 1] * P8_SCALE, p1[4 * q + 2] * P8_SCALE, p1[4 * q + 3] * P8_SCALE); }
}
__device__ __forceinline__ void qkt(f32x16& p0, f32x16& p1, const unsigned char* Ks, const i32x8* qf, int r32, int hi) {
  i32x8 ka[2], kb[2];
#pragma unroll
  for (int s = 0; s < 2; ++s) { const int cb = 64 * s + 32 * hi;
    const i32x4a a0 = *reinterpret_cast<const i32x4a*>(Ks + KSWZ(r32, cb)), a1 = *reinterpret_cast<const i32x4a*>(Ks + KSWZ(r32, cb + 16));
    const i32x4a b0 = *reinterpret_cast<const i32x4a*>(Ks + KSWZ(32 + r32, cb)), b1 = *reinterpret_cast<const i32x4a*>(Ks + KSWZ(32 + r32, cb + 16));
    ka[s] = __builtin_shufflevector(a0, a1, 0, 1, 2, 3, 4, 5, 6, 7); kb[s] = __builtin_shufflevector(b0, b1, 0, 1, 2, 3, 4, 5, 6, 7); }
  asm volatile("v_mfma_f32_32x32x64_f8f6f4 %0, %1, %2, 0" : "=&v"(p0) : "v"(ka[0]), "v"(qf[0]));
  asm volatile("v_mfma_f32_32x32x64_f8f6f4 %0, %1, %2, 0" : "=&v"(p1) : "v"(kb[0]), "v"(qf[0]));
  asm volatile("v_mfma_f32_32x32x64_f8f6f4 %0, %1, %2, %0" : "+v"(p0) : "v"(ka[1]), "v"(qf[1]));
  asm volatile("v_mfma_f32_32x32x64_f8f6f4 %0, %1, %2, %0\n\ts_nop 15\n\ts_nop 7" : "+v"(p1) : "v"(kb[1]), "v"(qf[1]));
}
template <int D0> __device__ __forceinline__ void pv_one(f32x16& od, const unsigned char* Vs, i32x8 pa, int r32, int hi) {
  const i32x4a lo = *reinterpret_cast<const i32x4a*>(Vs + VSWZ(32 * D0 + r32, 32 * hi)), hi4 = *reinterpret_cast<const i32x4a*>(Vs + VSWZ(32 * D0 + r32, 32 * hi + 16));
  const i32x8 vb = __builtin_shufflevector(lo, hi4, 0, 1, 2, 3, 4, 5, 6, 7);
  if (D0 == 0) asm volatile("s_nop 1\n\tv_mfma_f32_32x32x64_f8f6f4 %0, %1, %2, %0" : "+v"(od) : "v"(pa), "v"(vb));
  else asm volatile("v_mfma_f32_32x32x64_f8f6f4 %0, %1, %2, %0" : "+v"(od) : "v"(pa), "v"(vb));
}
__device__ __forceinline__ void pv_d0(f32x16* o, const unsigned char* Vs, i32x8 pa, int r32, int hi) {
  pv_one<0>(o[0], Vs, pa, r32, hi); pv_one<1>(o[1], Vs, pa, r32, hi); pv_one<2>(o[2], Vs, pa, r32, hi); pv_one<3>(o[3], Vs, pa, r32, hi);
}
#define O_SETTLE() do { asm volatile("s_nop 15\n\ts_nop 7" ::: "memory"); SBAR(); } while (0)

template <typename TQ>
__device__ __forceinline__ void attn_dense_body(const unsigned char* __restrict__ Qb, const unsigned char* __restrict__ Kh, const unsigned char* __restrict__ Vh,
                                                unsigned char* Ob, const unsigned short* __restrict__ Zb, int seq, char* lds) {
  using St = Stage<bf16>; using SQ = Stage<TQ>;
  int tid = threadIdx.x; asm volatile("" : "+v"(tid));
  const int wid = tid >> 6, lane = tid & 63, r32 = lane & 31, hi = lane >> 5;
  unsigned char* V_lds = (unsigned char*)lds; unsigned char* K_lds = (unsigned char*)(lds + 2 * SHM_V);
  float* ws = (float*)(lds + 65536) + wid * 64; float* li_l = ws; float* al_l = ws + 32;
  float m_reg = -1e30f, l_reg = 0; f32x16 o[4] = {}; i32x8 qr[2];
  const unsigned char* Qw = Qb + (long)(wid * QBLK + r32) * LDQ + hi * 32;
#pragma unroll
  for (int s2 = 0; s2 < 2; ++s2) { const i32x4a lo = *reinterpret_cast<const i32x4a*>(Qw + 64 * s2), hi4 = *reinterpret_cast<const i32x4a*>(Qw + 64 * s2 + 16); qr[s2] = __builtin_shufflevector(lo, hi4, 0, 1, 2, 3, 4, 5, 6, 7); }
  const int kr = tid >> 3, kc = (tid & 7) * 16, kst = KSWZ(kr, kc);
  const int vr = tid >> 2, vc = (tid & 3) * 16, vst = VSWZ(vr, vc);
  struct { i32x4a vs, ks; } sr_[SDEPTH];
#define SLOAD(i, k0) do { sr_[i].vs = *reinterpret_cast<const i32x4a*>(Vh + (long)vr * 2048 + (k0) + vc); \
    sr_[i].ks = *reinterpret_cast<const i32x4a*>(Kh + (long)((k0) + kr) * LDK + kc); } while (0)
#define SWRITE(b, i) do { *(i32x4a*)(V_lds + (b) * SHM_V + vst) = sr_[i].vs; *(i32x4a*)(K_lds + (b) * SHM_K + kst) = sr_[i].ks; } while (0)
#define SWAIT() do { if constexpr (SDEPTH == 2) asm volatile("s_waitcnt vmcnt(2)" ::: "memory"); else asm volatile("s_waitcnt vmcnt(0)" ::: "memory"); } while (0)
#define RESC(a) do { if (__any((a) < 1.f)) { if (hi == 0) al_l[r32] = (a); asm volatile("s_waitcnt lgkmcnt(0)" ::: "memory"); O_SETTLE(); \
    for (int d = 0; d < 4; ++d) for (int r = 0; r < 16; ++r) o[d][r] *= al_l[crow(r, hi)]; } } while (0)
  f32x16 pA0, pA1, pB0, pB1; float mnA, mnB, alA, alB; i32x8 pa; const int NT = seq / KVBLK;
  constexpr int SE = 0, SO = SDEPTH - 1;
  SLOAD(SE, 0); asm volatile("s_waitcnt vmcnt(0)" ::: "memory"); SWRITE(0, SE); __syncthreads();
  qkt(pA0, pA1, K_lds, qr, r32, hi); partialSM(pA0, pA1, m_reg, mnA, alA);
  SLOAD(SO, KVBLK); if constexpr (SDEPTH == 2) { if (2 < NT) SLOAD(SE, 2 * KVBLK); }
  SWAIT(); SWRITE(1, SO); __syncthreads();
  for (int j = 1; j + 1 < NT; j += 2) {
    SBAR(); qkt(pB0, pB1, K_lds + SHM_K, qr, r32, hi);
    finishSM(pA0, pA1, alA, l_reg, pa); SBAR();
    SLOAD(SO, (j + SDEPTH) * KVBLK); SBAR();
    pv_d0(o, V_lds, pa, r32, hi); partialSM(pB0, pB1, m_reg, mnB, alB);
    __syncthreads(); SWAIT(); SWRITE(0, SE);
    RESC(alB); __syncthreads();
    SBAR(); qkt(pA0, pA1, K_lds, qr, r32, hi);
    finishSM(pB0, pB1, alB, l_reg, pa); SBAR();
    if (SDEPTH == 1 || j + 3 < NT) SLOAD(SE, (j + 1 + SDEPTH) * KVBLK); SBAR();
    pv_d0(o, V_lds + SHM_V, pa, r32, hi); partialSM(pA0, pA1, m_reg, mnA, alA);
    __syncthreads(); SWAIT(); SWRITE(1, SO);
    RESC(alA); __syncthreads();
  }
  SBAR(); qkt(pB0, pB1, K_lds + SHM_K, qr, r32, hi);
  finishSM(pA0, pA1, alA, l_reg, pa); SBAR();
  pv_d0(o, V_lds, pa, r32, hi); partialSM(pB0, pB1, m_reg, mnB, alB);
  __syncthreads(); RESC(alB);
  finishSM(pB0, pB1, alB, l_reg, pa); SBAR();
  pv_d0(o, V_lds + SHM_V, pa, r32, hi);
  if (hi == 0) li_l[r32] = l_reg; asm volatile("s_waitcnt lgkmcnt(0)" ::: "memory"); O_SETTLE();
  float rli[16];
#pragma unroll
  for (int r = 0; r < 16; ++r) rli[r] = __builtin_amdgcn_rcpf(li_l[crow(r, hi)]) * (1.f / (P8_SCALE * V8_SCALE));
  __syncthreads();
  { unsigned short* stg = (unsigned short*)(lds + wid * 8192);
#pragma unroll
    for (int r = 0; r < 16; ++r) { const int orow = crow(r, hi);
#pragma unroll
      for (int d0 = 0; d0 < 4; ++d0) { unsigned u = __builtin_bit_cast(unsigned, o[d0][r] * rli[r]); u = (u + 0x7fffu + ((u >> 16) & 1u)) >> 16; stg[orow * 128 + d0 * 32 + r32] = (unsigned short)u; } }
    asm volatile("s_waitcnt lgkmcnt(0)" ::: "memory");
    unsigned char* Ow = Ob + (long)(wid * QBLK) * LDO; const unsigned short* Zw = Zb + (long)(wid * QBLK) * LDZ;
#pragma unroll 2
    for (int i = 0; i < 8; ++i) { const int row = i * 4 + (lane >> 4), ch = lane & 15;
      const u32x4 ov = *(const u32x4*)(stg + row * 128 + ch * 8); const u32x4 zv = *(const u32x4*)(Zw + (long)row * LDZ + ch * 8); float g8[8];
#pragma unroll
      for (int e = 0; e < 4; ++e) { const float z0 = __builtin_bit_cast(float, zv[e] << 16), z1 = __builtin_bit_cast(float, zv[e] & 0xffff0000u);
        g8[2 * e] = __builtin_bit_cast(float, ov[e] << 16) * (z0 * __builtin_amdgcn_rcpf(1.f + __expf(-z0))) * A8_SCALE; g8[2 * e + 1] = __builtin_bit_cast(float, ov[e] & 0xffff0000u) * (z1 * __builtin_amdgcn_rcpf(1.f + __expf(-z1))) * A8_SCALE; }
      typedef unsigned u32x2o __attribute__((ext_vector_type(2)));
      u32x2o w; w.x = pk4f8(g8[0], g8[1], g8[2], g8[3]); w.y = pk4f8(g8[4], g8[5], g8[6], g8[7]);
      *(u32x2o*)(Ow + (long)row * LDO + ch * 8) = w; } }
#undef SLOAD
#undef SWRITE
#undef SWAIT
#undef RESC
}

}
namespace ml {
typedef short bf16x8 __attribute__((ext_vector_type(8)));
typedef short v4i16 __attribute__((ext_vector_type(4)));
typedef float f32x4 __attribute__((ext_vector_type(4)));
typedef float f32x16 __attribute__((ext_vector_type(16)));
typedef unsigned u32x4 __attribute__((ext_vector_type(4)));
typedef unsigned u32x2 __attribute__((ext_vector_type(2)));
#define ML_LAS __attribute__((address_space(3)))
constexpr int BUFB = 65536, Q_OFF = 0, K_OFF = 16384, V_OFF = 32768;
constexpr int P_OFF = 131072, DENP_OFF = P_OFF + 8192, QNP_OFF = DENP_OFF + 512, VEC_OFF = QNP_OFF + 2048, VEC_SLOT = 2 * 256, VR_OFF = VEC_OFF + 2 * VEC_SLOT, NB_OFF = VR_OFF + 8 * 256, LDS_END = NB_OFF + 512;
__device__ __forceinline__ unsigned fxor(unsigned row) { return ((row & 3u) << 2) | ((row >> 2) & 3u); }
__device__ __forceinline__ unsigned off_b(unsigned row, unsigned ch) { return 256u * row + 16u * (ch ^ fxor(row)); }
__device__ __forceinline__ unsigned off_p(unsigned t, unsigned ch) { return 128u * t + 16u * (ch ^ (t & 7u)); }
__device__ __forceinline__ unsigned tr_addr(unsigned lane, unsigned c, unsigned ks, unsigned t) { const unsigned h = lane >> 5, blk = (lane >> 4) & 1u, q = (lane & 15u) >> 2, p = lane & 3u; return off_b(16u * ks + 8u * h + 4u * t + q, 4u * c + 2u * blk + (p >> 1)) + 8u * (p & 1u); }
__device__ __forceinline__ unsigned tr_addr16(unsigned lane, unsigned c, unsigned ks, unsigned t) { const unsigned g = lane >> 4, q = (lane & 15u) >> 2, p = lane & 3u; return off_b(32u * ks + 8u * g + 4u * t + q, 2u * c + (p >> 1)) + 8u * (p & 1u); }
__device__ __forceinline__ v4i16 trrd(ML_LAS unsigned char* p) { return __builtin_amdgcn_ds_read_tr16_b64_v4i16((ML_LAS v4i16*)p); }
template <int OFF> __device__ __forceinline__ v4i16 trra(unsigned addr) { v4i16 r; asm volatile("ds_read_b64_tr_b16 %0, %1 offset:%2" : "=v"(r) : "v"(addr), "i"(OFF) : "memory"); return r; }
__device__ __forceinline__ void glds16(const void* gsrc, unsigned lds_dst) { unsigned keep;
    asm volatile("s_mov_b32 %0, m0\n\ts_mov_b32 m0, %2\n\ts_nop 0\n\tglobal_load_lds_dwordx4 %1, off\n\ts_mov_b32 m0, %0" : "=&s"(keep) : "v"(gsrc), "s"(lds_dst) : "memory"); }
#define ML_TRWAIT() do { asm volatile("s_waitcnt lgkmcnt(0)" ::: "memory"); __builtin_amdgcn_sched_barrier(0); } while (0)
__device__ __forceinline__ bf16x8 cat8(v4i16 lo, v4i16 hi) { return (bf16x8){lo[0], lo[1], lo[2], lo[3], hi[0], hi[1], hi[2], hi[3]}; }
__device__ __forceinline__ unsigned pkbf(float lo, float hi) { unsigned r; asm volatile("v_cvt_pk_bf16_f32 %0, %1, %2" : "=v"(r) : "v"(lo), "v"(hi)); return r; }
__device__ __forceinline__ float s2f(short x) { return __builtin_bit_cast(float, (unsigned)(unsigned short)x << 16); }
__device__ __forceinline__ bf16x8 pack8(float a0, float a1, float a2, float a3, float a4, float a5, float a6, float a7) { u32x4 w = {pkbf(a0, a1), pkbf(a2, a3), pkbf(a4, a5), pkbf(a6, a7)}; return __builtin_bit_cast(bf16x8, w); }
__device__ __forceinline__ float scan_add(float v, int lane) {
#pragma unroll
    for (int o = 1; o < 64; o <<= 1) { const float u = __shfl_up(v, o); if (lane >= o) v += u; }
    return v; }
__device__ __forceinline__ float scan_max(float v, int lane) {
#pragma unroll
    for (int o = 1; o < 64; o <<= 1) { const float u = __shfl_up(v, o); if (lane >= o) v = fmaxf(v, u); }
    return v; }
#define ML_OPAQUE_LANE(ln) unsigned ln = (unsigned)lane; asm volatile("" : "+v"(ln))
__device__ __forceinline__ float rdlane(float v, int l) { return __builtin_bit_cast(float, __builtin_amdgcn_readlane(__builtin_bit_cast(int, v), l)); }

__device__ __forceinline__ void stage(ML_LAS unsigned char* lds, int bsel, int c, int b, int hd, int dir, const unsigned short* MQ, const unsigned short* MK, const unsigned short* MV, int wid, int lane) {
    const int rl = lane >> 4, pos = lane & 15;
#pragma unroll
    for (int half = 0; half < 2; ++half) {
        const int grp = wid + 8 * half, row = 4 * grp + rl, ch = pos ^ ((rl << 2) | (grp & 3));
        const int p = 64 * c + row, tok = dir ? (SEQ - 1 - p) : p; const size_t trow = (size_t)b * SEQ + tok;
        ML_LAS unsigned char* d = lds + bsel * BUFB + grp * 1024;
        __builtin_amdgcn_global_load_lds((const unsigned*)(MQ + trow * 512 + hd * 128 + 8 * ch), (ML_LAS unsigned*)(d + Q_OFF), 16, 0, 0);
        __builtin_amdgcn_global_load_lds((const unsigned*)(MK + trow * 512 + hd * 128 + 8 * ch), (ML_LAS unsigned*)(d + K_OFF), 16, 0, 0);
        __builtin_amdgcn_global_load_lds((const unsigned*)(MV + trow * 1024 + hd * 256 + 8 * ch), (ML_LAS unsigned*)(d + V_OFF), 16, 0, 0);
        __builtin_amdgcn_global_load_lds((const unsigned*)(MV + trow * 1024 + hd * 256 + 128 + 8 * ch), (ML_LAS unsigned*)(d + V_OFF + 16384), 16, 0, 0);
    }
}

#define ML_DPPF(old_, src_, ctrl_, rm_) __builtin_bit_cast(float, __builtin_amdgcn_update_dpp(__builtin_bit_cast(int, (float)(old_)), __builtin_bit_cast(int, (float)(src_)), ctrl_, rm_, 0xf, false))
__device__ __forceinline__ float dscan_add(float v) {
    v += ML_DPPF(0.f, v, 0x111, 0xf); v += ML_DPPF(0.f, v, 0x112, 0xf); v += ML_DPPF(0.f, v, 0x114, 0xf); v += ML_DPPF(0.f, v, 0x118, 0xf);
    v += ML_DPPF(0.f, v, 0x142, 0xa); v += ML_DPPF(0.f, v, 0x143, 0xc); return v; }
__device__ __forceinline__ float dscan_max(float v) { const float NI = -3.0e38f;
    v = fmaxf(v, ML_DPPF(NI, v, 0x111, 0xf)); v = fmaxf(v, ML_DPPF(NI, v, 0x112, 0xf)); v = fmaxf(v, ML_DPPF(NI, v, 0x114, 0xf)); v = fmaxf(v, ML_DPPF(NI, v, 0x118, 0xf));
    v = fmaxf(v, ML_DPPF(NI, v, 0x142, 0xa)); v = fmaxf(v, ML_DPPF(NI, v, 0x143, 0xc)); return v; }

template <int MODE> __device__ __forceinline__ void mlstm_item(unsigned char* ws, ML_LAS unsigned char* lds, int item, int tid) {
    const int lane = tid & 63, wid = __builtin_amdgcn_readfirstlane(tid >> 6);
    const int b = item >> 3, hd = (item >> 1) & 3, dir = item & 1;
    const float* GT = (const float*)(ws + WS_GATES) + dir * 8 + hd;
    ML_LAS float* DENP = (ML_LAS float*)(lds + DENP_OFF); ML_LAS float* QNP = (ML_LAS float*)(lds + QNP_OFF); ML_LAS float* NB = (ML_LAS float*)(lds + NB_OFF + wid * 64);
    unsigned dq0, dq1, dv0, dv1;
    { const int rl = lane >> 4, pos = lane & 15;
      const int g0 = wid, g1 = wid + 8; const int r0 = 4 * g0 + rl, r1 = 4 * g1 + rl; const int c0 = pos ^ ((rl << 2) | (g0 & 3)), c1 = pos ^ ((rl << 2) | (g1 & 3));
      const int m0 = dir ? 63 - r0 : r0, m1 = dir ? 63 - r1 : r1;
      dq0 = (unsigned)(m0 * 1024 + 16 * c0); dq1 = (unsigned)(m1 * 1024 + 16 * c1); dv0 = (unsigned)(m0 * 2048 + 16 * c0); dv1 = (unsigned)(m1 * 2048 + 16 * c1); }
    const unsigned goff = (unsigned)((dir ? 63 - lane : lane) * 64);
    unsigned trL0, trL1, trX;
    { const unsigned h = lane >> 5, blk = (lane >> 4) & 1u, q = (lane & 15u) >> 2, p = lane & 3u; const unsigned A = 256u * (8u * h + q) + 8u * (p & 1u), lo = 2u * blk + (p >> 1);
      trL0 = A + 16u * (lo ^ ((2u * h) & 3u)); trL1 = A + 16u * (lo ^ ((2u * h + 1u) & 3u)) + 1024u; trX = 64u * q; }
    f32x16 C[4]; f32x4 n4 = {0.f, 0.f, 0.f, 0.f};
#pragma unroll
    for (int i = 0; i < 4; ++i) C[i] = (f32x16){0.f};
    const char* gq = (const char*)(ws + WS_MQ) + ((size_t)b * SEQ * 512 + hd * 128) * 2; const char* gk = (const char*)(ws + WS_MK) + ((size_t)b * SEQ * 512 + hd * 128) * 2;
    const char* gv = (const char*)(ws + WS_MV) + ((size_t)b * SEQ * 1024 + hd * 256) * 2; const char* gg = (const char*)GT + (size_t)b * SEQ * 64;
    unsigned char* ho = ws + (dir ? WS_HB : WS_HF) + ((size_t)(b * 4 + hd) * 32) * 32768 + wid * 4096 + lane * 16;
    const unsigned lds0 = (unsigned)(uintptr_t)lds;
#define ML_TB(c_) (MODE == 1 ? (dir ? (SEQ - 64) : 0) : (dir ? (SEQ - 64 * ((c_) + 1)) : 64 * (c_)))
#define ML_STAGE(bsel_, c_) do { const int tb_ = ML_TB(c_); const unsigned d_ = (unsigned)__builtin_amdgcn_readfirstlane((int)(lds0 + (bsel_) * BUFB + wid * 1024)); \
        const char* q_ = gq + (size_t)tb_ * 1024; const char* k_ = gk + (size_t)tb_ * 1024; const char* v_ = gv + (size_t)tb_ * 2048; \
        glds16(q_ + dq0, d_ + Q_OFF); glds16(q_ + dq1, d_ + Q_OFF + 8192); glds16(k_ + dq0, d_ + K_OFF); glds16(k_ + dq1, d_ + K_OFF + 8192); \
        glds16(v_ + dv0, d_ + V_OFF); glds16(v_ + dv1, d_ + V_OFF + 8192); glds16(v_ + 256 + dv0, d_ + V_OFF + 16384); glds16(v_ + 256 + dv1, d_ + V_OFF + 16384 + 8192); } while (0)
#define ML_GATES(c_, gi_, gf_) do { const char* g_ = gg + (size_t)ML_TB(c_) * 64 + goff; gi_ = *(const float*)g_; gf_ = *(const float*)(g_ + 16); } while (0)
#define ML_VEC(cc_, gi_, gf_, sc_out_) do { ML_LAS float* T_ = (ML_LAS float*)(lds + VEC_OFF + ((cc_) & 1) * VEC_SLOT); \
        const float bcs_ = dscan_add(gf_), cx_ = (gi_) - bcs_, cm_ = dscan_max(cx_), M_ = fmaxf(m, cm_); const float g_ = rdlane(bcs_, 63), M63_ = rdlane(M_, 63); \
        T_[lane] = __expf(cx_ - M63_); T_[64 + lane] = __expf(-(bcs_ + M63_)); \
        sc_out_ = __expf(m - M63_); m = g_ + M63_; } while (0)
    float m = 0.f, sc, sc_n = 1.f, gi_a, gf_a, gi_b = 0.f, gf_b = 0.f; u32x4 pend[4] = {{0u, 0u, 0u, 0u}, {0u, 0u, 0u, 0u}, {0u, 0u, 0u, 0u}, {0u, 0u, 0u, 0u}};
    ML_STAGE(0, 0); ML_GATES(0, gi_a, gf_a); ML_VEC(0, gi_a, gf_a, sc); ML_GATES(1, gi_a, gf_a);
    for (int c = 0; c < SEQ / 64; ++c) {
        const int bsel = c & 1;
        ML_LAS unsigned char* bQ = lds + bsel * BUFB + Q_OFF; ML_LAS unsigned char* bK = lds + bsel * BUFB + K_OFF; ML_LAS unsigned char* bV = lds + bsel * BUFB + V_OFF;
        ML_LAS float* VWE = (ML_LAS float*)(lds + VEC_OFF + bsel * VEC_SLOT); ML_LAS float* VEMT = VWE + 64; ML_LAS float* VR = (ML_LAS float*)(lds + VR_OFF + wid * 256);
        asm volatile("s_waitcnt vmcnt(0) lgkmcnt(0)" ::: "memory"); __builtin_amdgcn_s_barrier(); asm volatile("" ::: "memory");
        if (c > 0) { unsigned char* hc = ho + (size_t)(c - 1) * 32768; *(u32x4*)(hc) = pend[0]; *(u32x4*)(hc + 1024) = pend[1]; *(u32x4*)(hc + 2048) = pend[2]; *(u32x4*)(hc + 3072) = pend[3]; }
        if (c + 1 < SEQ / 64) { ML_STAGE(bsel ^ 1, c + 1);
            if (c + 2 < SEQ / 64) ML_GATES(c + 2, gi_b, gf_b);
            ML_VEC(c + 1, gi_a, gf_a, sc_n); }
        if (MODE == 2) { asm volatile("s_waitcnt lgkmcnt(0)" ::: "memory"); __builtin_amdgcn_s_barrier(); continue; }
        { ML_OPAQUE_LANE(ln); const unsigned r15 = ln & 15u, kg = ln >> 4; const int tj = wid >> 1, sb = (wid & 1) * 2; const unsigned t = 16u * tj + r15;
          const unsigned xq = fxor(r15) << 4;
          ML_LAS unsigned char* qrow = bQ + 256u * t;
          bf16x8 qf[4];
#pragma unroll
          for (int ks = 0; ks < 4; ++ks) qf[ks] = *(const ML_LAS bf16x8*)(qrow + (((4u * ks + kg) << 4) ^ xq));
          float dsum = 0.f; const unsigned hb = 8u * (kg & 1u), kh = kg >> 1;
#pragma unroll
          for (int u = 0; u < 2; ++u) { const unsigned si = sb + u; ML_LAS unsigned char* krow = bK + 256u * (16u * si + r15) + hb;
              f32x4 acc = {0.f, 0.f, 0.f, 0.f};
#pragma unroll
              for (int ks = 0; ks < 4; ++ks) { const unsigned g2 = 4u * ks + 2u * kh;
                  const u32x2 lo = *(const ML_LAS u32x2*)(krow + ((g2 << 4) ^ xq)), hi = *(const ML_LAS u32x2*)(krow + (((g2 + 1u) << 4) ^ xq));
                  const u32x4 kw = {lo.x, lo.y, hi.x, hi.y};
                  acc = __builtin_amdgcn_mfma_f32_16x16x32_bf16(__builtin_bit_cast(bf16x8, kw), qf[ks], acc, 0, 0, 0); }
              const unsigned s0 = 16u * si + 4u * kg; const f32x4 ws4 = *(const ML_LAS f32x4*)(VWE + s0);
              float p[4];
#pragma unroll
              for (int r = 0; r < 4; ++r) { p[r] = (s0 + r <= t) ? acc[r] : 0.f; dsum = fmaf(p[r], ws4[r], dsum); }
              const u32x2 pw = {pkbf(p[0], p[1]), pkbf(p[2], p[3])};
              *(ML_LAS u32x2*)(lds + P_OFF + 128u * t + (((2u * si + kh) ^ (t & 7u)) << 4) + hb) = pw; }
          dsum += __shfl_xor(dsum, 16); dsum += __shfl_xor(dsum, 32);
          if (ln < 16u) DENP[(wid & 1) * 64 + t] = dsum; }
        n4 = n4 * sc;
        { ML_OPAQUE_LANE(ln); const unsigned r15 = ln & 15u, kg = ln >> 4; if (r15 == 0) *(ML_LAS f32x4*)(NB + 4 * kg) = n4;
          const f32x4 nA = *(const ML_LAS f32x4*)(NB + 0), nB = *(const ML_LAS f32x4*)(NB + 4), nC = *(const ML_LAS f32x4*)(NB + 8), nD = *(const ML_LAS f32x4*)(NB + 12);
          const unsigned t = ln; ML_LAS unsigned char* qrow = bQ + 256u * t; const unsigned xq = fxor(t) << 4;
          const bf16x8 c0 = *(const ML_LAS bf16x8*)(qrow + (((2u * wid) << 4) ^ xq)), c1 = *(const ML_LAS bf16x8*)(qrow + (((2u * wid + 1u) << 4) ^ xq));
          float qn = 0.f;
#pragma unroll
          for (int e = 0; e < 4; ++e) { qn = fmaf(s2f(c0[e]), nA[e], qn); qn = fmaf(s2f(c0[4 + e]), nC[e], qn); qn = fmaf(s2f(c1[e]), nB[e], qn); qn = fmaf(s2f(c1[4 + e]), nD[e], qn); }
          QNP[wid * 64 + t] = qn; }
        f32x16 Y0, Y1;
        { ML_OPAQUE_LANE(ln); const unsigned r31 = ln & 31u, h5 = ln >> 5; const unsigned xq = fxor(r31) << 4; ML_LAS unsigned char* q0 = bQ + 256u * r31; ML_LAS unsigned char* q1 = q0 + 256u * 32u;
#pragma unroll
          for (int i = 0; i < 4; ++i) { C[i] = C[i] * sc;
#pragma unroll
              for (int s = 0; s < 2; ++s) { const bf16x8 bfr = pack8(C[i][8 * s + 0], C[i][8 * s + 1], C[i][8 * s + 2], C[i][8 * s + 3], C[i][8 * s + 4], C[i][8 * s + 5], C[i][8 * s + 6], C[i][8 * s + 7]);
                  const unsigned co = ((4u * i + 2u * s + h5) << 4) ^ xq;
                  const bf16x8 a0 = *(const ML_LAS bf16x8*)(q0 + co), a1 = *(const ML_LAS bf16x8*)(q1 + co);
                  if (i == 0 && s == 0) { Y0 = __builtin_amdgcn_mfma_f32_32x32x16_bf16(a0, bfr, (f32x16){0.f}, 0, 0, 0); Y1 = __builtin_amdgcn_mfma_f32_32x32x16_bf16(a1, bfr, (f32x16){0.f}, 0, 0, 0); }
                  else { Y0 = __builtin_amdgcn_mfma_f32_32x32x16_bf16(a0, bfr, Y0, 0, 0, 0); Y1 = __builtin_amdgcn_mfma_f32_32x32x16_bf16(a1, bfr, Y1, 0, 0, 0); } } } }
        bf16x8 vw[4];
        { ML_OPAQUE_LANE(ln); const unsigned h5 = ln >> 5, kg = ln >> 4; const unsigned vt = wid >> 2, vc = wid & 3; bf16x8 vf[4];
          ML_LAS unsigned char* v0 = bV + 16384u * vt + ((64u * vc) ^ trX); ML_LAS unsigned char* va = v0 + trL0; ML_LAS unsigned char* vb = v0 + trL1;
#pragma unroll
          for (int ks = 0; ks < 4; ++ks) vf[ks] = cat8(trrd(va + 4096 * ks), trrd(vb + 4096 * ks));
          ML_LAS float* vwe = VWE + 8 * h5;
#pragma unroll
          for (int ks = 0; ks < 4; ++ks) { const f32x4 w0 = *(const ML_LAS f32x4*)(vwe + 16 * ks), w1 = *(const ML_LAS f32x4*)(vwe + 16 * ks + 4);
              vw[ks] = pack8(s2f(vf[ks][0]) * w0[0], s2f(vf[ks][1]) * w0[1], s2f(vf[ks][2]) * w0[2], s2f(vf[ks][3]) * w0[3], s2f(vf[ks][4]) * w1[0], s2f(vf[ks][5]) * w1[1], s2f(vf[ks][6]) * w1[2], s2f(vf[ks][7]) * w1[3]); }
          ML_LAS unsigned char* ka = bK + trL0; ML_LAS unsigned char* kb = bK + trL1;
#pragma unroll
          for (int i = 0; i < 4; ++i) { const unsigned xo = (64u * i) ^ trX;
#pragma unroll
              for (int ks = 0; ks < 4; ++ks) C[i] = __builtin_amdgcn_mfma_f32_32x32x16_bf16(cat8(trrd(ka + xo + 4096 * ks), trrd(kb + xo + 4096 * ks)), vw[ks], C[i], 0, 0, 0); }
          ML_LAS unsigned char* t16a = bK + tr_addr16(ln, wid, 0, 0); ML_LAS unsigned char* t16b = bK + tr_addr16(ln, wid, 0, 1);
#pragma unroll
          for (int ks = 0; ks < 2; ++ks) { const bf16x8 af = cat8(trrd(t16a + 8192 * ks), trrd(t16b + 8192 * ks));
              const f32x4 w0 = *(const ML_LAS f32x4*)(VWE + 32 * ks + 8 * kg), w1 = *(const ML_LAS f32x4*)(VWE + 32 * ks + 8 * kg + 4);
              n4 = __builtin_amdgcn_mfma_f32_16x16x32_bf16(af, pack8(w0[0], w0[1], w0[2], w0[3], w1[0], w1[1], w1[2], w1[3]), n4, 0, 0, 0); } }
        asm volatile("s_waitcnt lgkmcnt(0)" ::: "memory"); __builtin_amdgcn_s_barrier(); asm volatile("" ::: "memory");
        { ML_OPAQUE_LANE(ln); const unsigned r31 = ln & 31u, h5 = ln >> 5;
          ML_LAS unsigned char* p0 = lds + P_OFF + 128u * r31; ML_LAS unsigned char* p1 = p0 + 128u * 32u; const unsigned xp = (r31 & 7u) << 4;
#pragma unroll
          for (int ks = 0; ks < 4; ++ks) { const unsigned co = ((2u * ks + h5) << 4) ^ xp;
              const bf16x8 a0 = *(const ML_LAS bf16x8*)(p0 + co), a1 = *(const ML_LAS bf16x8*)(p1 + co);
              Y0 = __builtin_amdgcn_mfma_f32_32x32x16_bf16(a0, vw[ks], Y0, 0, 0, 0); Y1 = __builtin_amdgcn_mfma_f32_32x32x16_bf16(a1, vw[ks], Y1, 0, 0, 0); } }
        { ML_OPAQUE_LANE(ln); const unsigned t = ln; float qs = 0.f;
#pragma unroll
          for (int w8 = 0; w8 < 8; ++w8) qs += QNP[w8 * 64 + t];
          const float dn = DENP[t] + DENP[64 + t] + qs; VR[t] = 1.f / fmaxf(fabsf(dn), VEMT[t]); }
        { ML_OPAQUE_LANE(ln); const unsigned h5 = ln >> 5; ML_LAS float* vr = VR + 4 * h5;
#pragma unroll
          for (int qp = 0; qp < 2; ++qp) { const f32x4 ra = *(const ML_LAS f32x4*)(vr + 16 * qp), rb = *(const ML_LAS f32x4*)(vr + 16 * qp + 8), rc = *(const ML_LAS f32x4*)(vr + 32 + 16 * qp), rd = *(const ML_LAS f32x4*)(vr + 32 + 16 * qp + 8);
              const int o = 8 * qp;
              const u32x4 w0 = {pkbf(Y0[o + 0] * ra[0], Y0[o + 1] * ra[1]), pkbf(Y0[o + 2] * ra[2], Y0[o + 3] * ra[3]), pkbf(Y0[o + 4] * rb[0], Y0[o + 5] * rb[1]), pkbf(Y0[o + 6] * rb[2], Y0[o + 7] * rb[3])};
              const u32x4 w1 = {pkbf(Y1[o + 0] * rc[0], Y1[o + 1] * rc[1]), pkbf(Y1[o + 2] * rc[2], Y1[o + 3] * rc[3]), pkbf(Y1[o + 4] * rd[0], Y1[o + 5] * rd[1]), pkbf(Y1[o + 6] * rd[2], Y1[o + 7] * rd[3])};
              pend[qp] = w0; pend[2 + qp] = w1; } }
        asm volatile("" : "+v"(gi_b), "+v"(gf_b));
        sc = sc_n; gi_a = gi_b; gf_a = gf_b;
    }
    { unsigned char* hc = ho + (size_t)(SEQ / 64 - 1) * 32768; *(u32x4*)(hc) = pend[0]; *(u32x4*)(hc + 1024) = pend[1]; *(u32x4*)(hc + 2048) = pend[2]; *(u32x4*)(hc + 3072) = pend[3]; }
#undef ML_STAGE
#undef ML_GATES
#undef ML_VEC
#undef ML_TB
    __syncthreads();
}
}

constexpr int NWAVES = 8;
constexpr int RING_BYTES = 131072;
constexpr int LDS_BYTES = 163840;
constexpr int XCH_OFF = RING_BYTES, ROPE_LDS_OFF = XCH_OFF + 8192, QKG_LDS_OFF = ROPE_LDS_OFF + 16384, SCL_LDS_OFF = QKG_LDS_OFF + 1024;
static_assert(SCL_LDS_OFF + 4096 <= LDS_BYTES - 16, "in-projection LDS map");
static_assert(ml::LDS_END <= LDS_BYTES, "mLSTM LDS map");
#define LAS __attribute__((address_space(3)))
#define GAS __attribute__((address_space(1)))
typedef unsigned v4u __attribute__((ext_vector_type(4)));
typedef unsigned v2u __attribute__((ext_vector_type(2)));
typedef float f32x4 __attribute__((ext_vector_type(4)));
#define LDS_WAIT() asm volatile("s_waitcnt lgkmcnt(0)" ::: "memory")

struct Args { const float* in[9]; float* out; unsigned char* ws; int ph_lo, ph_hi; };

__device__ __forceinline__ float wave_sum(float v) {
#pragma unroll
    for (int o = 1; o < 64; o <<= 1) v += __shfl_xor(v, o);
    return v;
}

#define XB_TMO      128
#define XB_XCNT(j)  (256  + 64 * (j))
#define XB_XSUB(j)  (1280 + 64 * (j))
#define XB_XGEN(j)  (2304 + 64 * (j))
#define XB_TOP      3328
#define XB_TOPGEN   3392
#define XCD_BAR_WORDS 3456
#define XB_SPIN_CAP (1u << 18)

__device__ __forceinline__ unsigned xb_ld(unsigned* p)              { return __hip_atomic_load(p, __ATOMIC_RELAXED, __HIP_MEMORY_SCOPE_AGENT); }
__device__ __forceinline__ unsigned xb_add(unsigned* p, unsigned v) { return __hip_atomic_fetch_add(p, v, __ATOMIC_RELAXED, __HIP_MEMORY_SCOPE_AGENT); }
__device__ __forceinline__ unsigned xb_xcc_id() { return (unsigned)__builtin_amdgcn_s_getreg((3 << 11) | 20) & 0xFu; }
#define XB_SPIN(cond, bar) do { unsigned _sp = 0; while (cond) { __builtin_amdgcn_s_sleep(1); \
    if ((++_sp & 255u) == 0u) { if (xb_ld(&(bar)[XB_TMO])) break; if (_sp > XB_SPIN_CAP) { atomicAdd(&(bar)[XB_TMO], 1u); break; } } } } while (0)

struct XcdBarrier {
    unsigned* bar; unsigned x;
    volatile LAS unsigned* st;
};

__device__ __forceinline__ XcdBarrier xcd_barrier_post(unsigned* bar, volatile LAS unsigned* st) {
    XcdBarrier b; b.bar = bar; b.x = xb_xcc_id(); b.st = st;
    if (threadIdx.x == 0) (void)xb_add(&bar[XB_XCNT(b.x)], 1u);
    return b;
}
__device__ __forceinline__ void xcd_barrier_complete(unsigned* bar, unsigned x, unsigned& nloc, unsigned& nx) {
    const unsigned G = gridDim.x * gridDim.y * gridDim.z;
    unsigned sum, cnt, mine, sp = 0u;
    for (;;) {
        sum = 0u; cnt = 0u; mine = 0u;
#pragma unroll
        for (unsigned j = 0; j < 16; ++j) { const unsigned c = xb_ld(&bar[XB_XCNT(j)]); sum += c; cnt += (c > 0u) ? 1u : 0u; mine = (j == x) ? c : mine; }
        if (sum == G) break;
        __builtin_amdgcn_s_sleep(1);
        if ((++sp & 255u) == 0u) { if (xb_ld(&bar[XB_TMO])) break; if (sp > XB_SPIN_CAP) { atomicAdd(&bar[XB_TMO], 1u); break; } }
    }
    nloc = mine > 0u ? mine : 1u; nx = cnt > 0u ? cnt : 1u;
}

__device__ __forceinline__ void xcd_barrier(const XcdBarrier& b) {
    asm volatile("s_waitcnt vmcnt(0)" ::: "memory");
    __syncthreads();
    if (threadIdx.x == 0) {
        unsigned* bar = b.bar;
        __builtin_amdgcn_s_waitcnt(0);
        unsigned nloc = b.st[0], nx = b.st[1];
        if (nloc == 0u) { xcd_barrier_complete(bar, b.x, nloc, nx); b.st[0] = nloc; b.st[1] = nx; }
        const unsigned old = xb_add(&bar[XB_XSUB(b.x)], 1u);
        const unsigned gen = old / nloc;
        if (old + 1u == (gen + 1u) * nloc) {
            __builtin_amdgcn_fence(__ATOMIC_RELEASE, "agent");
            asm volatile("s_waitcnt vmcnt(0)" ::: "memory");
            const unsigned og = xb_add(&bar[XB_TOP], 1u);
            const unsigned tg = og / nx;
            if (og + 1u == (tg + 1u) * nx) xb_add(&bar[XB_TOPGEN], 1u);
            else XB_SPIN(xb_ld(&bar[XB_TOPGEN]) == tg, bar);
            __builtin_amdgcn_fence(__ATOMIC_ACQUIRE, "agent");
            xb_add(&bar[XB_XGEN(b.x)], 1u);
            asm volatile("s_waitcnt vmcnt(0)" ::: "memory");
        } else {
            XB_SPIN(xb_ld(&bar[XB_XGEN(b.x)]) == gen, bar);
            __builtin_amdgcn_fence(__ATOMIC_ACQUIRE, "agent");
            asm volatile("s_waitcnt vmcnt(0)" ::: "memory");
        }
    }
    __syncthreads();
}

__device__ __forceinline__ int w1_dest_row(int n) {
    if (!HY_SEPARATE_ROPE && n < 1280) { const int s = n & 255; return (n & ~255) | (s & 0xC3) | ((s & 0x10) << 1) | ((s & 0x0C) << 1) | ((s & 0x20) >> 3); }
    if (n >= 2560 && n < 3072) return (n & ~12) | ((n & 4) << 1) | ((n & 8) >> 1);
    return n;
}
__device__ __forceinline__ int q8_dest_row(int n) { return n < NQA ? w1_dest_row(n) : n - (NB1 - NB0); }
__device__ __forceinline__ unsigned pk4i8(float a, float b, float c, float d) {
    int ia = (int)__builtin_rintf(a), ib = (int)__builtin_rintf(b), ic = (int)__builtin_rintf(c), id = (int)__builtin_rintf(d);
    ia = ia < -127 ? -127 : (ia > 127 ? 127 : ia); ib = ib < -127 ? -127 : (ib > 127 ? 127 : ib); ic = ic < -127 ? -127 : (ic > 127 ? 127 : ic); id = id < -127 ? -127 : (id > 127 ? 127 : id);
    return ((unsigned)ia & 0xffu) | (((unsigned)ib & 0xffu) << 8) | (((unsigned)ic & 0xffu) << 16) | ((unsigned)id << 24); }
template <int MODE>
__device__ __forceinline__ void p0_transpose_item(const float* W, int K, int ldw, int kb, int n0, void* WT, LAS float* scr, int lane, const LAS float* cinv) {
    const int k0 = 64 * kb;
#pragma unroll 8
    for (int i = 0; i < 32; ++i) { const int kk = 2 * i + (lane >> 5); scr[kk * 33 + (lane & 31)] = W[(size_t)(k0 + kk) * ldw + n0 + (lane & 31)]; }
    LDS_WAIT(); asm volatile("" ::: "memory");
    const int c = lane & 7;
#pragma unroll
    for (int j = 0; j < 4; ++j) { const int n = (lane >> 3) + 8 * j; const LAS float* s = scr + (8 * c) * 33 + n;
        if constexpr (MODE == 2) { const float ci = cinv[n];
            v2u o8; o8.x = pk4i8(s[0 * 33] * ci, s[1 * 33] * ci, s[2 * 33] * ci, s[3 * 33] * ci); o8.y = pk4i8(s[4 * 33] * ci, s[5 * 33] * ci, s[6 * 33] * ci, s[7 * 33] * ci);
            *(v2u*)((unsigned char*)WT + (size_t)q8_dest_row(n0 + n) * K + k0 + 8 * c) = o8; }
        else if constexpr (MODE == 3) { unsigned char* rowp = (unsigned char*)WT + (size_t)(n0 + n) * 4096;
            if (kb < 16) { v2u o8; o8.x = pk4f8(s[0 * 33] * W8_SCALE, s[1 * 33] * W8_SCALE, s[2 * 33] * W8_SCALE, s[3 * 33] * W8_SCALE); o8.y = pk4f8(s[4 * 33] * W8_SCALE, s[5 * 33] * W8_SCALE, s[6 * 33] * W8_SCALE, s[7 * 33] * W8_SCALE);
                *(v2u*)(rowp + k0 + 8 * c) = o8; }
            else { v4u o; o.x = pk2(s[0 * 33], s[1 * 33]); o.y = pk2(s[2 * 33], s[3 * 33]); o.z = pk2(s[4 * 33], s[5 * 33]); o.w = pk2(s[6 * 33], s[7 * 33]);
                *(v4u*)(rowp + 1024 + (size_t)(k0 - 1024 + 8 * c) * 2) = o; } }
        else { const float ws_ = (MODE == 1 && n0 + n < 3072) ? 0.08838834764831845f : 1.f;
            v4u o; o.x = pk2(s[0 * 33] * ws_, s[1 * 33] * ws_); o.y = pk2(s[2 * 33] * ws_, s[3 * 33] * ws_); o.z = pk2(s[4 * 33] * ws_, s[5 * 33] * ws_); o.w = pk2(s[6 * 33] * ws_, s[7 * 33] * ws_);
            const int nr = (MODE == 1) ? w1_dest_row(n0 + n) - NB0 : n0 + n;
            *(v4u*)((bf16*)WT + (size_t)nr * K + k0 + 8 * c) = o; } }
    LDS_WAIT(); asm volatile("" ::: "memory");
}
__device__ __forceinline__ void p0_q8_colblock(const float* w_in, unsigned char* ws, LAS unsigned char* lds, int cb, int tid, int wave, int lane) {
    const int n0 = cb < NQA / 32 ? 32 * cb : NB1 + 32 * (cb - NQA / 32);
    LAS float* red = (LAS float*)(lds + 8 * 16384);
    const int c4 = (lane & 7) * 4, kr = lane >> 3;
    const float* src = w_in + (size_t)(256 * wave + kr) * NPROJ + n0 + c4;
    f32x4 mx = {0.f, 0.f, 0.f, 0.f};
#pragma unroll 8
    for (int i = 0; i < 32; ++i) { const f32x4 v = *(const f32x4*)(src + (size_t)(8 * i) * NPROJ);
        mx.x = fmaxf(mx.x, fabsf(v.x)); mx.y = fmaxf(mx.y, fabsf(v.y)); mx.z = fmaxf(mx.z, fabsf(v.z)); mx.w = fmaxf(mx.w, fabsf(v.w)); }
#pragma unroll
    for (int o = 8; o < 64; o <<= 1) { mx.x = fmaxf(mx.x, __shfl_xor(mx.x, o)); mx.y = fmaxf(mx.y, __shfl_xor(mx.y, o)); mx.z = fmaxf(mx.z, __shfl_xor(mx.z, o)); mx.w = fmaxf(mx.w, __shfl_xor(mx.w, o)); }
    if (lane < 8) *(LAS f32x4*)(red + wave * 32 + c4) = mx;
    __syncthreads();
    if (tid < 32) { float m = red[tid];
#pragma unroll
        for (int w = 1; w < 8; ++w) m = fmaxf(m, red[w * 32 + tid]);
        m = fmaxf(m, 1e-30f); red[256 + tid] = 127.f / m; ((float*)(ws + WS_SW))[q8_dest_row(n0 + tid)] = m * (1.f / 127.f); }
    __syncthreads();
    LAS float* scr = (LAS float*)(lds + wave * 16384);
    for (int i = 0; i < 4; ++i) p0_transpose_item<2>(w_in, DM, NPROJ, 4 * wave + i, n0, ws + WS_W8T, scr, lane, red + 256);
    __syncthreads();
}
__device__ __forceinline__ float wave_max(float v) {
#pragma unroll
    for (int o = 1; o < 64; o <<= 1) v = fmaxf(v, __shfl_xor(v, o));
    return v;
}
__device__ __forceinline__ void rms_rows2_to_bf16(const float* xrow0, const float* xrow1, const float* g, bf16* orow0, bf16* orow1, unsigned char* frow0, unsigned char* frow1, float* sa0, float* sa1, int lane) {
    const f32x4* xa = (const f32x4*)xrow0 + lane; const f32x4* xb = (const f32x4*)xrow1 + lane; const f32x4* gr = (const f32x4*)g + lane;
    f32x4 v[8], w[8]; float s = 0.f, t = 0.f;
#pragma unroll
    for (int j = 0; j < 8; ++j) { v[j] = __builtin_nontemporal_load(xa + 64 * j); w[j] = __builtin_nontemporal_load(xb + 64 * j); }
#pragma unroll
    for (int j = 0; j < 8; ++j) { s += (v[j].x * v[j].x + v[j].y * v[j].y) + (v[j].z * v[j].z + v[j].w * v[j].w); t += (w[j].x * w[j].x + w[j].y * w[j].y) + (w[j].z * w[j].z + w[j].w * w[j].w); }
    const float r0 = 1.f / sqrtf(wave_sum(s) * (1.f / DM) + EPS), r1 = 1.f / sqrtf(wave_sum(t) * (1.f / DM) + EPS);
    float m0 = 0.f, m1 = 0.f;
#pragma unroll
    for (int j = 0; j < 8; ++j) { const f32x4 gg = gr[64 * j]; v[j] = v[j] * r0 * gg; w[j] = w[j] * r1 * gg;
        m0 = fmaxf(fmaxf(m0, fmaxf(fabsf(v[j].x), fabsf(v[j].y))), fmaxf(fabsf(v[j].z), fabsf(v[j].w))); m1 = fmaxf(fmaxf(m1, fmaxf(fabsf(w[j].x), fabsf(w[j].y))), fmaxf(fabsf(w[j].z), fabsf(w[j].w))); }
    m0 = fmaxf(wave_max(m0), 1e-30f); m1 = fmaxf(wave_max(m1), 1e-30f);
    const float i0 = 127.f / m0, i1 = 127.f / m1;
    if (lane == 0) { *sa0 = m0 * (1.f / 127.f); *sa1 = m1 * (1.f / 127.f); }
    v2u* o0 = (v2u*)orow0 + lane; v2u* o1 = (v2u*)orow1 + lane; unsigned* f0 = (unsigned*)frow0 + lane; unsigned* f1 = (unsigned*)frow1 + lane;
#pragma unroll
    for (int j = 0; j < 8; ++j) { v2u a, b;
        a.x = pk2(v[j].x, v[j].y); a.y = pk2(v[j].z, v[j].w); o0[64 * j] = a; f0[64 * j] = pk4i8(v[j].x * i0, v[j].y * i0, v[j].z * i0, v[j].w * i0);
        b.x = pk2(w[j].x, w[j].y); b.y = pk2(w[j].z, w[j].w); o1[64 * j] = b; f1[64 * j] = pk4i8(w[j].x * i1, w[j].y * i1, w[j].z * i1, w[j].w * i1); }
}
__device__ __forceinline__ void p0_prologue(const Args& a, LAS unsigned char* lds, int vcu, int G, int tid, int wave, int lane) {
    unsigned char* ws = a.ws;
    const float* w_in = a.in[3]; const float* w_out = a.in[8]; const float* norm_g = a.in[2];
    bf16* W2t = (bf16*)(ws + WS_W2T);
    const int gw = vcu * NWAVES + wave, NGW = G * NWAVES; const int gt = vcu * (NWAVES * 64) + tid, NGT = G * NWAVES * 64;
    for (int e = gt; e < 64 * 32; e += NGT) { const int pos = e >> 5, j = e & 31; const float inv = 1.0f / powf(10000.0f, (float)j * (1.0f / 32.0f)); const float ang = (float)pos * inv;
        float* R = (float*)(ws + WS_ROPE); R[2 * e] = cosf(ang); R[2 * e + 1] = sinf(ang); }
    for (int e = gt; e < 16 * DM; e += NGT) { const int g = e >> 11, k = e & (DM - 1); ((bf16*)(ws + WS_WGT))[(size_t)g * DM + k] = (bf16)f2bf(w_in[(size_t)k * NPROJ + NP256 + g]); }
    for (int cb = vcu; cb < NQ8 / 32; cb += G) p0_q8_colblock(w_in, ws, lds, cb, tid, wave, lane);
    LAS float* scr = (LAS float*)(lds + wave * 16384);
    constexpr int I_1 = (DM / 64) * ((NB1 - NB0) / 32), I_2 = (DM / 64) * (DM / 32);
    for (int it = gw; it < I_1 + I_2; it += NGW) {
        if (it < I_1) p0_transpose_item<1>(w_in, DM, NPROJ, it / ((NB1 - NB0) / 32), NB0 + 32 * (it % ((NB1 - NB0) / 32)), ws + WS_W1B, scr, lane, nullptr);
        else p0_transpose_item<3>(w_out, DM, DM, (it - I_1) / (DM / 32), 32 * ((it - I_1) % (DM / 32)), W2t, scr, lane, nullptr);
    }
    bf16* H = (bf16*)(ws + WS_H); unsigned char* H8 = (unsigned char*)a.out; float* SA = (float*)(ws + WS_SA);
    for (int m = gw; m < NTOK; m += 2 * NGW) { const int m1 = (m + NGW < NTOK) ? m + NGW : m;
        const float* xr0 = (m < TOK_PROMPT) ? a.in[0] + (size_t)m * DM : a.in[1] + (size_t)(m - TOK_PROMPT) * DM; const float* xr1 = (m1 < TOK_PROMPT) ? a.in[0] + (size_t)m1 * DM : a.in[1] + (size_t)(m1 - TOK_PROMPT) * DM;
        rms_rows2_to_bf16(xr0, xr1, norm_g, H + (size_t)m * DM, H + (size_t)m1 * DM, H8 + (size_t)m * DM, H8 + (size_t)m1 * DM, SA + m, SA + m1, lane); }
}

__device__ __forceinline__ void p2_qknorm_rope(const Args& a, int vcu, int G, int wave, int lane) {
    unsigned char* ws = a.ws; const float* R = (const float*)(ws + WS_ROPE);
    const int gw = vcu * NWAVES + wave, NGW = G * NWAVES;
    const int fj = lane & 31, c0 = (lane < 32) ? lane : 64 + (lane - 32), c1 = c0 + 32;
    const float gq0 = a.in[5][c0], gq1 = a.in[5][c1], gk0 = a.in[6][c0], gk1 = a.in[6][c1];
    for (int it = gw; it < NTOK * 10; it += NGW) {
        const int t = it / 10, slot = it - t * 10; const int tl = t & (SEQ - 1); const int pos = (lane < 32) ? (tl >> 6) : (tl & 63);
        bf16* p = (slot < 8) ? (bf16*)((unsigned char*)a.out + DO_Q) + (size_t)t * 1024 + slot * 128 : (bf16*)(ws + WS_AK) + (size_t)t * 256 + (slot - 8) * 128;
        const float x0 = bf2f(p[c0]), x1 = bf2f(p[c1]);
        const float r = 1.f / sqrtf(wave_sum(x0 * x0 + x1 * x1) * (1.f / 128.f) + EPS);
        const float y0 = x0 * r * ((slot < 8) ? gq0 : gk0), y1 = x1 * r * ((slot < 8) ? gq1 : gk1);
        const float cs = R[2 * (pos * 32 + fj)], sn = R[2 * (pos * 32 + fj) + 1];
        p[c0] = (bf16)f2bf(y0 * cs - y1 * sn); p[c1] = (bf16)f2bf(y1 * cs + y0 * sn);
    }
}

__device__ __forceinline__ void p4_mlstm_recurrent(const Args& a, LAS unsigned char* lds, int vcu, int G, int tid) {
    unsigned char* ws = a.ws;
    const bf16* MQ = (const bf16*)(ws + WS_MQ); const bf16* MK = (const bf16*)(ws + WS_MK); const bf16* MV = (const bf16*)(ws + WS_MV); const float* GT = (const float*)(ws + WS_GATES);
    LAS float* qs = (LAS float*)lds;
    LAS float* ks = qs + 32 * 128;
    LAS float* vs = ks + 32 * 128;
    LAS float* gi = vs + 32 * 256;
    LAS float* gf = gi + 32;
    const int dv = tid >> 1, half = tid & 1;
    for (int item = vcu; item < NSEQ * 8; item += G) {
        const int b = item >> 3, hd = (item >> 1) & 3, dir = item & 1;
        bf16* HO = (bf16*)(ws + (dir ? WS_HB : WS_HF));
        float C[64], nn[64]; float m = 0.f;
#pragma unroll
        for (int j = 0; j < 64; ++j) { C[j] = 0.f; nn[j] = 0.f; }
        for (int p0 = 0; p0 < SEQ; p0 += 32) {
            __syncthreads();
            { const int rr = tid >> 4, c8 = (tid & 15) * 8; const int tok = dir ? (SEQ - 1 - (p0 + rr)) : (p0 + rr); const size_t row = (size_t)b * SEQ + tok;
              const v4u q4 = *(const v4u*)(MQ + row * 512 + hd * 128 + c8), k4 = *(const v4u*)(MK + row * 512 + hd * 128 + c8);
              LAS float* kd = ks + rr * 128 + c8;
              { LAS float* qa = qs + rr * 128 + (c8 & ~8) + ((c8 & 8) >> 1);   qa[0] = bflo(q4.x); qa[1] = bfhi(q4.x); qa[2] = bflo(q4.y); qa[3] = bfhi(q4.y); qa[8] = bflo(q4.z); qa[9] = bfhi(q4.z); qa[10] = bflo(q4.w); qa[11] = bfhi(q4.w); }
              kd[0] = bflo(k4.x); kd[1] = bfhi(k4.x); kd[2] = bflo(k4.y); kd[3] = bfhi(k4.y); kd[4] = bflo(k4.z); kd[5] = bfhi(k4.z); kd[6] = bflo(k4.w); kd[7] = bfhi(k4.w);
              const int c16 = (tid & 15) * 16; LAS float* vd = vs + rr * 256 + c16;
#pragma unroll
              for (int h2 = 0; h2 < 2; ++h2) { const v4u v4 = *(const v4u*)(MV + row * 1024 + hd * 256 + c16 + 8 * h2);
                  vd[8 * h2 + 0] = bflo(v4.x); vd[8 * h2 + 1] = bfhi(v4.x); vd[8 * h2 + 2] = bflo(v4.y); vd[8 * h2 + 3] = bfhi(v4.y); vd[8 * h2 + 4] = bflo(v4.z); vd[8 * h2 + 5] = bfhi(v4.z); vd[8 * h2 + 6] = bflo(v4.w); vd[8 * h2 + 7] = bfhi(v4.w); }
              if (tid < 32) { const int tk = dir ? (SEQ - 1 - (p0 + tid)) : (p0 + tid); const size_t rw = (size_t)b * SEQ + tk; gi[tid] = GT[rw * 16 + dir * 8 + hd]; gf[tid] = GT[rw * 16 + dir * 8 + 4 + hd]; }
            }
            __syncthreads();
            for (int pp = 0; pp < 32; ++pp) {
                const float lf = gf[pp], ii = gi[pp];
                const float mn = fmaxf(lf + m, ii);
                const float ca = expf(lf + m - mn), cb = expf(ii - mn);
                const float bv = cb * vs[pp * 256 + dv];
                float hp = 0.f, qn = 0.f;
                const LAS float* kr = ks + pp * 128 + 64 * half; const LAS float* qr = qs + pp * 128 + 64 * half;
#pragma unroll
                for (int j = 0; j < 64; ++j) { const float kk = kr[j], qq = qr[j];
                    C[j] = fmaf(ca, C[j], kk * bv); nn[j] = fmaf(ca, nn[j], cb * kk); hp = fmaf(qq, C[j], hp); qn = fmaf(qq, nn[j], qn); }
                hp += __shfl_xor(hp, 1); qn += __shfl_xor(qn, 1);
                const float den = fmaxf(fabsf(qn), expf(-mn));
                if (half == 0) { const int pos = p0 + pp, cch = pos >> 6, o = pos & 63, tt = o >> 5, rho = o & 31, q = rho >> 3, hh = (rho >> 2) & 1, e = rho & 3;
                    HO[(((size_t)((b * 4 + hd) * 32 + cch) * 32768) + (dv >> 5) * 4096 + tt * 2048 + (q >> 1) * 1024 + (32 * hh + (dv & 31)) * 16) / 2 + 4 * (q & 1) + e] = (bf16)f2bf(hp / den); }
                m = mn;
            }
        }
    }
}

__device__ __forceinline__ void p5_mlstm_finalize(const Args& a, LAS unsigned char* lds, int vcu, int G, int tid, int wave, int lane) {
    unsigned char* ws = a.ws; const float* mg = a.in[7];
    const bf16* MO = (const bf16*)(ws + WS_MO); const bf16* MZ = (const bf16*)(ws + WS_MZ); bf16* MIX = (bf16*)(ws + WS_MIX);
    LAS float* XS = (LAS float*)lds;
    const int r31 = lane & 31, h5 = lane >> 5, dv0 = 8 * r31;
    constexpr int NIT = NSEQ * 4 * 32;
    v4u f[2][2], bb[2][2];
#define P5_LOAD_H(item_) do { const int bh_ = (item_) >> 5, ck_ = (item_) & 31; \
        const unsigned char* hf_ = ws + WS_HF + ((size_t)bh_ * 32 + ck_) * 32768 + wave * 4096 + lane * 16; const unsigned char* hb_ = ws + WS_HB + ((size_t)bh_ * 32 + (31 - ck_)) * 32768 + wave * 4096 + (lane ^ 32) * 16; \
        _Pragma("unroll") for (int tt = 0; tt < 2; ++tt) _Pragma("unroll") for (int qp = 0; qp < 2; ++qp) { f[tt][qp] = *(const v4u*)(hf_ + tt * 2048 + qp * 1024); bb[tt][qp] = *(const v4u*)(hb_ + (1 - tt) * 2048 + (1 - qp) * 1024); } } while (0)
    if (vcu < NIT) P5_LOAD_H(vcu);
    for (int item = vcu; item < NIT; item += G) {
        const int bh = item >> 5, ck = item & 31, b = bh >> 2, hd = bh & 3;
        v4u mo[4], mz[4];
#pragma unroll
        for (int it = 0; it < 4; ++it) { const int o = it * 16 + wave * 2 + h5; const size_t row = (size_t)b * SEQ + ck * 64 + o;
            mo[it] = *(const v4u*)(MO + row * 1024 + hd * 256 + dv0); mz[it] = *(const v4u*)(MZ + row * 1024 + hd * 256 + dv0); }
        __syncthreads();
#pragma unroll
        for (int tt = 0; tt < 2; ++tt)
#pragma unroll
            for (int qp = 0; qp < 2; ++qp) { const v4u fv = f[tt][qp], bv = bb[tt][qp];
                float fs[8] = {bflo(fv.x), bfhi(fv.x), bflo(fv.y), bfhi(fv.y), bflo(fv.z), bfhi(fv.z), bflo(fv.w), bfhi(fv.w)};
                float bs[8] = {bflo(bv.x), bfhi(bv.x), bflo(bv.y), bfhi(bv.y), bflo(bv.z), bfhi(bv.z), bflo(bv.w), bfhi(bv.w)};
#pragma unroll
                for (int j = 0; j < 8; ++j) { const int o = 32 * tt + 8 * (2 * qp + (j >> 2)) + 4 * h5 + (j & 3); XS[o * 256 + 32 * wave + r31] = fs[j] + bs[7 - j]; } }
        __syncthreads();
        if (item + G < NIT) P5_LOAD_H(item + G);
        const f32x4 g0 = *(const f32x4*)(mg + hd * 256 + dv0), g1 = *(const f32x4*)(mg + hd * 256 + dv0 + 4);
        const float gg[8] = {g0[0], g0[1], g0[2], g0[3], g1[0], g1[1], g1[2], g1[3]};
#pragma unroll
        for (int it = 0; it < 4; ++it) { const int o = it * 16 + wave * 2 + h5; const size_t row = (size_t)b * SEQ + ck * 64 + o;
            const f32x4 x0 = *(const LAS f32x4*)(XS + o * 256 + dv0), x1 = *(const LAS f32x4*)(XS + o * 256 + dv0 + 4);
            float hm[8] = {x0[0], x0[1], x0[2], x0[3], x1[0], x1[1], x1[2], x1[3]};
            const float mo8[8] = {bflo(mo[it].x), bfhi(mo[it].x), bflo(mo[it].y), bfhi(mo[it].y), bflo(mo[it].z), bfhi(mo[it].z), bflo(mo[it].w), bfhi(mo[it].w)};
            const float mz8[8] = {bflo(mz[it].x), bfhi(mz[it].x), bflo(mz[it].y), bfhi(mz[it].y), bflo(mz[it].z), bfhi(mz[it].z), bflo(mz[it].w), bfhi(mz[it].w)};
            float ss = 0.f;
#pragma unroll
            for (int j = 0; j < 8; ++j) { hm[j] = hm[j] * __builtin_amdgcn_rcpf(1.f + __expf(-mo8[j])); ss += hm[j] * hm[j]; }
#pragma unroll
            for (int s = 1; s < 32; s <<= 1) ss += __shfl_xor(ss, s);
            const float r = __builtin_amdgcn_rsqf(ss * (1.f / 256.f) + EPS);
            float ov[8];
#pragma unroll
            for (int j = 0; j < 8; ++j) ov[j] = hm[j] * r * gg[j] * (mz8[j] * __builtin_amdgcn_rcpf(1.f + __expf(-mz8[j])));
            v4u w; w.x = pk2(ov[0], ov[1]); w.y = pk2(ov[2], ov[3]); w.z = pk2(ov[4], ov[5]); w.w = pk2(ov[6], ov[7]);
            *(v4u*)(MIX + row * 2048 + 512 + hd * 256 + dv0) = w; }
    }
#undef P5_LOAD_H
    __syncthreads();
}

__device__ __forceinline__ void p5_item(const Args& a, LAS unsigned char* lds, int item) {
    int tid_ = threadIdx.x; asm volatile("" : "+v"(tid_));
    const int lane = tid_ & 63, wave = __builtin_amdgcn_readfirstlane(tid_ >> 6);
    unsigned char* ws = a.ws; const float* mg = a.in[7];
    const bf16* MO = (const bf16*)(ws + WS_MO); const bf16* MZ = (const bf16*)(ws + WS_MZ); bf16* MIX = (bf16*)(ws + WS_MIX);
    LAS float* XS = (LAS float*)lds; const int r31 = lane & 31, h5 = lane >> 5, dv0 = 8 * r31;
    const int bh = item >> 5, ck = item & 31, b = bh >> 2, hd = bh & 3;
    const unsigned char* hf_ = ws + WS_HF + ((size_t)bh * 32 + ck) * 32768 + wave * 4096 + lane * 16; const unsigned char* hb_ = ws + WS_HB + ((size_t)bh * 32 + (31 - ck)) * 32768 + wave * 4096 + (lane ^ 32) * 16;
    v4u f[2][2], bb[2][2], mo[4], mz[4];
#pragma unroll
    for (int tt = 0; tt < 2; ++tt)
#pragma unroll
        for (int qp = 0; qp < 2; ++qp) { f[tt][qp] = *(const v4u*)(hf_ + tt * 2048 + qp * 1024); bb[tt][qp] = *(const v4u*)(hb_ + (1 - tt) * 2048 + (1 - qp) * 1024); }
#pragma unroll
    for (int it = 0; it < 4; ++it) { const int o = it * 16 + wave * 2 + h5; const size_t row = (size_t)b * SEQ + ck * 64 + o;
        mo[it] = *(const v4u*)(MO + row * 1024 + hd * 256 + dv0); mz[it] = *(const v4u*)(MZ + row * 1024 + hd * 256 + dv0); }
    __syncthreads();
#pragma unroll
    for (int tt = 0; tt < 2; ++tt)
#pragma unroll
        for (int qp = 0; qp < 2; ++qp) { const v4u fv = f[tt][qp], bv = bb[tt][qp];
            float fs[8] = {bflo(fv.x), bfhi(fv.x), bflo(fv.y), bfhi(fv.y), bflo(fv.z), bfhi(fv.z), bflo(fv.w), bfhi(fv.w)};
            float bs[8] = {bflo(bv.x), bfhi(bv.x), bflo(bv.y), bfhi(bv.y), bflo(bv.z), bfhi(bv.z), bflo(bv.w), bfhi(bv.w)};
#pragma unroll
            for (int j = 0; j < 8; ++j) { const int o = 32 * tt + 8 * (2 * qp + (j >> 2)) + 4 * h5 + (j & 3); XS[o * 256 + 32 * wave + r31] = fs[j] + bs[7 - j]; } }
    __syncthreads();
    const f32x4 g0 = *(const f32x4*)(mg + hd * 256 + dv0), g1 = *(const f32x4*)(mg + hd * 256 + dv0 + 4);
    const float gg[8] = {g0[0], g0[1], g0[2], g0[3], g1[0], g1[1], g1[2], g1[3]};
#pragma unroll
    for (int it = 0; it < 4; ++it) { const int o = it * 16 + wave * 2 + h5; const size_t row = (size_t)b * SEQ + ck * 64 + o;
        const f32x4 x0 = *(const LAS f32x4*)(XS + o * 256 + dv0), x1 = *(const LAS f32x4*)(XS + o * 256 + dv0 + 4);
        float hm[8] = {x0[0], x0[1], x0[2], x0[3], x1[0], x1[1], x1[2], x1[3]};
        const float mo8[8] = {bflo(mo[it].x), bfhi(mo[it].x), bflo(mo[it].y), bfhi(mo[it].y), bflo(mo[it].z), bfhi(mo[it].z), bflo(mo[it].w), bfhi(mo[it].w)};
        const float mz8[8] = {bflo(mz[it].x), bfhi(mz[it].x), bflo(mz[it].y), bfhi(mz[it].y), bflo(mz[it].z), bfhi(mz[it].z), bflo(mz[it].w), bfhi(mz[it].w)};
        float ss = 0.f;
#pragma unroll
        for (int j = 0; j < 8; ++j) { hm[j] = hm[j] * __builtin_amdgcn_rcpf(1.f + __expf(-mo8[j])); ss += hm[j] * hm[j]; }
#pragma unroll
        for (int s = 1; s < 32; s <<= 1) ss += __shfl_xor(ss, s);
        const float r = __builtin_amdgcn_rsqf(ss * (1.f / 256.f) + EPS);
        float ov[8];
#pragma unroll
        for (int j = 0; j < 8; ++j) ov[j] = hm[j] * r * gg[j] * (mz8[j] * __builtin_amdgcn_rcpf(1.f + __expf(-mz8[j])));
        v4u w; w.x = pk2(ov[0], ov[1]); w.y = pk2(ov[2], ov[3]); w.z = pk2(ov[4], ov[5]); w.w = pk2(ov[6], ov[7]);
        *(v4u*)(MIX + row * 2048 + 512 + hd * 256 + dv0) = w; }
    __syncthreads();
}

__device__ __forceinline__ void p5_batch(const Args& a, LAS unsigned char* lds, int first, int count) {
    if (count <= 0) return;
    int tid_ = threadIdx.x; asm volatile("" : "+v"(tid_));
    const int lane = tid_ & 63, wave = __builtin_amdgcn_readfirstlane(tid_ >> 6);
    unsigned char* ws = a.ws; const float* mg = a.in[7];
    const bf16* MO = (const bf16*)(ws + WS_MO); const bf16* MZ = (const bf16*)(ws + WS_MZ); bf16* MIX = (bf16*)(ws + WS_MIX);
    LAS float* XS = (LAS float*)lds; const int r31 = lane & 31, h5 = lane >> 5, dv0 = 8 * r31;
    v4u f[2][2], bb[2][2];
#define P5B_LOAD_H(item_) do { const int bh_ = (item_) >> 5, ck_ = (item_) & 31; \
        const unsigned char* hf_ = ws + WS_HF + ((size_t)bh_ * 32 + ck_) * 32768 + wave * 4096 + lane * 16; const unsigned char* hb_ = ws + WS_HB + ((size_t)bh_ * 32 + (31 - ck_)) * 32768 + wave * 4096 + (lane ^ 32) * 16; \
        _Pragma("unroll") for (int tt = 0; tt < 2; ++tt) _Pragma("unroll") for (int qp = 0; qp < 2; ++qp) { f[tt][qp] = *(const v4u*)(hf_ + tt * 2048 + qp * 1024); bb[tt][qp] = *(const v4u*)(hb_ + (1 - tt) * 2048 + (1 - qp) * 1024); } } while (0)
    P5B_LOAD_H(first);
    for (int i = 0; i < count; ++i) {
        const int item = first + i, bh = item >> 5, ck = item & 31, b = bh >> 2, hd = bh & 3;
        v4u mo[4], mz[4];
#pragma unroll
        for (int it = 0; it < 4; ++it) { const int o = it * 16 + wave * 2 + h5; const size_t row = (size_t)b * SEQ + ck * 64 + o;
            mo[it] = *(const v4u*)(MO + row * 1024 + hd * 256 + dv0); mz[it] = *(const v4u*)(MZ + row * 1024 + hd * 256 + dv0); }
        __syncthreads();
#pragma unroll
        for (int tt = 0; tt < 2; ++tt)
#pragma unroll
            for (int qp = 0; qp < 2; ++qp) { const v4u fv = f[tt][qp], bv = bb[tt][qp];
                float fs[8] = {bflo(fv.x), bfhi(fv.x), bflo(fv.y), bfhi(fv.y), bflo(fv.z), bfhi(fv.z), bflo(fv.w), bfhi(fv.w)};
                float bs[8] = {bflo(bv.x), bfhi(bv.x), bflo(bv.y), bfhi(bv.y), bflo(bv.z), bfhi(bv.z), bflo(bv.w), bfhi(bv.w)};
#pragma unroll
                for (int j = 0; j < 8; ++j) { const int o = 32 * tt + 8 * (2 * qp + (j >> 2)) + 4 * h5 + (j & 3); XS[o * 256 + 32 * wave + r31] = fs[j] + bs[7 - j]; } }
        __syncthreads();
        if (i + 1 < count) P5B_LOAD_H(item + 1);
        const f32x4 g0 = *(const f32x4*)(mg + hd * 256 + dv0), g1 = *(const f32x4*)(mg + hd * 256 + dv0 + 4);
        const float gg[8] = {g0[0], g0[1], g0[2], g0[3], g1[0], g1[1], g1[2], g1[3]};
#pragma unroll
        for (int it = 0; it < 4; ++it) { const int o = it * 16 + wave * 2 + h5; const size_t row = (size_t)b * SEQ + ck * 64 + o;
            const f32x4 x0 = *(const LAS f32x4*)(XS + o * 256 + dv0), x1 = *(const LAS f32x4*)(XS + o * 256 + dv0 + 4);
            float hm[8] = {x0[0], x0[1], x0[2], x0[3], x1[0], x1[1], x1[2], x1[3]};
            const float mo8[8] = {bflo(mo[it].x), bfhi(mo[it].x), bflo(mo[it].y), bfhi(mo[it].y), bflo(mo[it].z), bfhi(mo[it].z), bflo(mo[it].w), bfhi(mo[it].w)};
            const float mz8[8] = {bflo(mz[it].x), bfhi(mz[it].x), bflo(mz[it].y), bfhi(mz[it].y), bflo(mz[it].z), bfhi(mz[it].z), bflo(mz[it].w), bfhi(mz[it].w)};
            float ss = 0.f;
#pragma unroll
            for (int j = 0; j < 8; ++j) { hm[j] = hm[j] * __builtin_amdgcn_rcpf(1.f + __expf(-mo8[j])); ss += hm[j] * hm[j]; }
#pragma unroll
            for (int s = 1; s < 32; s <<= 1) ss += __shfl_xor(ss, s);
            const float r = __builtin_amdgcn_rsqf(ss * (1.f / 256.f) + EPS);
            float ov[8];
#pragma unroll
            for (int j = 0; j < 8; ++j) ov[j] = hm[j] * r * gg[j] * (mz8[j] * __builtin_amdgcn_rcpf(1.f + __expf(-mz8[j])));
            v4u w; w.x = pk2(ov[0], ov[1]); w.y = pk2(ov[2], ov[3]); w.z = pk2(ov[4], ov[5]); w.w = pk2(ov[6], ov[7]);
            *(v4u*)(MIX + row * 2048 + 512 + hd * 256 + dv0) = w; }
    }
#undef P5B_LOAD_H
    __syncthreads();
}

__device__ __forceinline__ void gate_rows48(unsigned char* ws, const float* b_gates, int row0, int lane) {
    typedef short bf16x8 __attribute__((ext_vector_type(8)));
    const int r15 = lane & 15, kg = lane >> 4;
    const bf16* a0p = (const bf16*)(ws + WS_H) + (size_t)(row0 + r15) * DM + 8 * kg; const bf16* a1p = a0p + 16 * DM; const bf16* a2p = a0p + 32 * DM;
    const bf16* bp = (const bf16*)(ws + WS_WGT) + (size_t)r15 * DM + 8 * kg;
    f32x4 acc0 = {0.f, 0.f, 0.f, 0.f}, acc1 = {0.f, 0.f, 0.f, 0.f}, acc2 = {0.f, 0.f, 0.f, 0.f};
#pragma unroll 8
    for (int ks = 0; ks < DM / 32; ++ks) { const bf16x8 a0 = *(const bf16x8*)(a0p + 32 * ks), a1 = *(const bf16x8*)(a1p + 32 * ks), a2 = *(const bf16x8*)(a2p + 32 * ks), b = *(const bf16x8*)(bp + 32 * ks);
        acc0 = __builtin_amdgcn_mfma_f32_16x16x32_bf16(a0, b, acc0, 0, 0, 0); acc1 = __builtin_amdgcn_mfma_f32_16x16x32_bf16(a1, b, acc1, 0, 0, 0); acc2 = __builtin_amdgcn_mfma_f32_16x16x32_bf16(a2, b, acc2, 0, 0, 0); }
    const float bias = b_gates[r15]; const bool isf = (r15 >> 2) & 1; float* G = (float*)(ws + WS_GATES) + (size_t)(row0 + 4 * kg) * 16 + r15;
#pragma unroll
    for (int r = 0; r < 4; ++r) { float v0 = acc0[r] + bias, v1 = acc1[r] + bias, v2 = acc2[r] + bias; if (isf) { v0 = log_sigmoid_f(v0); v1 = log_sigmoid_f(v1); v2 = log_sigmoid_f(v2); }
        G[r * 16] = v0; G[(16 + r) * 16] = v1; G[(32 + r) * 16] = v2; }
}

constexpr int N_PHASES = 7;
__global__ void __launch_bounds__(NWAVES * 64, 2) hy_fwd(Args args) {
    extern __shared__ __attribute__((aligned(16))) unsigned char lds_raw[];
    LAS unsigned char* lds = (LAS unsigned char*)lds_raw;
    const int tid = threadIdx.x, lane = tid & 63, wave = __builtin_amdgcn_readfirstlane(tid >> 6);
    const int G = gridDim.x; const int bx = blockIdx.x; const int vcu = (G % 8 == 0) ? (bx % 8) * (G / 8) + bx / 8 : bx;
    unsigned char* ws = args.ws;
    const int lo = args.ph_lo, hi = args.ph_hi;
    unsigned* ctl = (unsigned*)(ws + WS_CTL);
    volatile LAS unsigned* bst = (volatile LAS unsigned*)(lds + LDS_BYTES - 16);
    if (tid == 0) { bst[0] = 0u; bst[1] = 0u; }
    __syncthreads();
    XcdBarrier xbar; xbar.bar = ctl + CW_BAR; xbar.x = 0; xbar.st = bst; bool xposted = false;
    const bool one_launch = (lo == 0 && hi == N_PHASES);
    if (one_launch) { xbar = xcd_barrier_post(ctl + CW_BAR, bst); xposted = true; }
#ifndef HY_PHASE_MASK
#define HY_PHASE_MASK 0x7f
#endif
#define IN(k) (((HY_PHASE_MASK >> (k)) & 1) && lo <= (k) && (k) < hi)
#define BOTH(k) (IN(k) && IN((k) + 1))
#ifndef HY_DUP_MASK
#define HY_DUP_MASK 0
#endif
#ifndef HY_PROBE_NULL
#define HY_PROBE_NULL 0
#endif
#ifndef HY_ML_PROBE_MODE
#define HY_ML_PROBE_MODE 0
#endif
#define DUP(k) (((HY_DUP_MASK) >> (k)) & 1)
#define GRID_BAR_CG() do { cg::this_grid().sync(); } while (0)
#define GRID_BAR() do { if (!xposted) { xbar = xcd_barrier_post(ctl + CW_BAR, bst); xposted = true; } xcd_barrier(xbar); } while (0)

    if (IN(0) && DUP(0)) { p0_prologue(args, lds, vcu, G, tid, wave, lane); __syncthreads(); }
    if (IN(0)) { p0_prologue(args, lds, vcu, G, tid, wave, lane); if (BOTH(0)) GRID_BAR(); }

    if (IN(1)) {
        { const float* Rg = (const float*)(ws + WS_ROPE); LAS float* Rl = (LAS float*)(lds + ROPE_LDS_OFF); LAS float* Gl = (LAS float*)(lds + QKG_LDS_OFF);
          for (int e = tid; e < 64 * 32 * 2; e += NWAVES * 64) Rl[e] = Rg[e];
          if (tid < 128) { Gl[tid] = args.in[5][tid]; Gl[128 + tid] = args.in[6][tid]; }
          __syncthreads(); }
        { pg8::Gemm g{(const pg8::bf16_t*)((unsigned char*)args.out + DO_H8), (const pg8::bf16_t*)(ws + WS_W8T), NTOK, NQ8, DM / 2, DM / 128}; pg8::StaticOrder S; S.init(NTOK, NQ8, G, bx);
          pg8::EpiProjT<0, 2> E{ws, (PG8_LAS float*)(lds + XCH_OFF), (PG8_LAS float*)(lds + ROPE_LDS_OFF), (PG8_LAS float*)(lds + QKG_LDS_OFF), (unsigned char*)args.out + DO_Q, (PG8_LAS float*)(lds + SCL_LDS_OFF), (const float*)(ws + WS_SA), (const float*)(ws + WS_SW)};
          pg8::gemm_phase<pg8::EpiProjT<0, 2>, pg8::StaticOrder, true, true, 2>(lds, g, S, E); }
        { pg8::Gemm g{(const pg8::bf16_t*)(ws + WS_H), (const pg8::bf16_t*)(ws + WS_W1B), NTOK, NB1 - NB0, DM, DM / 64}; pg8::StaticOrder S; S.init(NTOK, NB1 - NB0, G, bx);
          pg8::EpiProjT<NB0 / 256, 0> E{ws, (PG8_LAS float*)(lds + XCH_OFF), (PG8_LAS float*)(lds + ROPE_LDS_OFF), (PG8_LAS float*)(lds + QKG_LDS_OFF), (unsigned char*)args.out + DO_Q, nullptr, nullptr, nullptr};
          pg8::gemm_phase<pg8::EpiProjT<NB0 / 256, 0>, pg8::StaticOrder, true, true, 0>(lds, g, S, E); }
        { const int nun = (NTOK / 256) * (NQ8 / 256), full = nun / G, rem = nun - full * G, light = G - rem;
          if (bx >= rem) for (int it = (bx - rem) * NWAVES + wave; it < NTOK / 48; it += light * NWAVES) gate_rows48(ws, args.in[4], it * 48, lane); }
        if (BOTH(1)) GRID_BAR();
    }

static_assert(!HY_SEPARATE_ROPE, "the attention body takes fp8 q / k rows, which only the fused in-projection epilogue writes");
#if HY_SEPARATE_ROPE
    if (IN(2)) { p2_qknorm_rope(args, vcu, G, wave, lane); if (BOTH(2)) GRID_BAR(); }
#endif

#define ATTN_UNIT(grp_, w_) do { const int b_ = (grp_) >> 1, kvh_ = (grp_) & 1, h_ = kvh_ * 4 + ((w_) >> 3), qb_ = (w_) & 7; const size_t row0_ = (size_t)b_ * SEQ + qb_ * 256; \
        const unsigned char* Q_ = (const unsigned char*)args.out + DO_Q + row0_ * 1024 + h_ * 128; unsigned char* O_ = ws + WS_MIX + row0_ * 4096 + h_ * 128; const unsigned char* K_ = ws + WS_AK + (size_t)b_ * SEQ * 256 + kvh_ * 128; \
        const unsigned char* V_ = ws + WS_AV + (size_t)(grp_) * 128 * 2048; const bf16* Z_ = (const bf16*)(ws + WS_AZ) + row0_ * 1024 + h_ * 128; \
        int seqv_ = SEQ; asm volatile("" : "+s"(seqv_)); attn::attn_dense_body<attn::bf16>(Q_, K_, V_, O_, Z_, seqv_, (char*)lds_raw); __syncthreads(); } while (0)
#if HY_SCHED_J
    const bool schedJ = one_launch && G == 256;
    if (schedJ) {
        const int xl = vcu >> 5, s = vcu & 31;
        if (s < 24) ml::mlstm_item<0>(ws, lds, xl * 24 + s, tid);
        else for (int j = 0; j < 3; ++j) ATTN_UNIT(xl, 3 * (s - 24) + j);
        GRID_BAR();
        const int n_rest = (s < 8) ? 6 : 5, n_p5 = (s < 8) ? 6 : 14, p5_0 = (s < 8) ? 6 * (xl * 8 + s) : 384 + 14 * (xl * 24 + (s - 8));
        int p5_done = 0;
        for (int jr = 0; jr < n_rest; ++jr) {
            if ((jr & 1) == 0) { const int tgt = (n_p5 * ((jr >> 1) + 1)) / 3;
                p5_batch(args, lds, p5_0 + p5_done, tgt - p5_done); p5_done = tgt; }
            const int li = s + 32 * jr;
            const int grp = (li < 8) ? xl : xl + 8 * (1 + ((li - 8) >> 5)), w = (li < 8) ? 24 + li : (li - 8) & 31;
            ATTN_UNIT(grp, w);
        }
        GRID_BAR();
    }
#else
    const bool schedJ = false;
#endif

    if (!schedJ && IN(3)) {
        for (int u = vcu; u < NSEQ * 2 * 32; u += G) ATTN_UNIT(u >> 5, u & 31);
        if (BOTH(3)) GRID_BAR();
    }

    if (!schedJ && IN(4) && DUP(4)) {
#if HY_MLSTM_REF
        p4_mlstm_recurrent(args, lds, vcu, G, tid);
#else
        for (int item = vcu; item < NSEQ * 8; item += G) ml::mlstm_item<HY_ML_PROBE_MODE>(ws, lds, item, tid);
#endif
        if (BOTH(4)) GRID_BAR(); }

    if (!schedJ && IN(4)) {
#if HY_MLSTM_REF
        p4_mlstm_recurrent(args, lds, vcu, G, tid);
#else
        for (int item = vcu; item < NSEQ * 8; item += G) ml::mlstm_item<0>(ws, lds, item, tid);
#endif
        if (BOTH(4)) GRID_BAR(); }

    if (!schedJ && IN(5) && DUP(5)) { p5_mlstm_finalize(args, lds, vcu, G, tid, wave, lane); }
    if (!schedJ && IN(5)) { p5_mlstm_finalize(args, lds, vcu, G, tid, wave, lane); if (BOTH(5)) GRID_BAR(); }

    if (IN(6)) {
        pg8::Gemm g{(const pg8::bf16_t*)(ws + WS_MIX), (const pg8::bf16_t*)(ws + WS_W2T), NTOK, DM, DM, pg8::F8_TILES + 1024 / 64}; pg8::StaticOrder S; S.init(NTOK, DM, G, bx);
        pg8::EpiOut E{args.in[0], args.in[1], args.out};
        pg8::gemm_phase<pg8::EpiOut, pg8::StaticOrder, true, true, 3>(lds, g, S, E);
    }
    if (one_launch && lo < 0) GRID_BAR_CG();
#undef IN
#undef BOTH
}

extern "C" void kernel_launch(void* const* d_in, const int* in_sizes, int n_in, void* d_out, int out_size, void* d_ws, size_t ws_size, hipStream_t stream) {
    static int grid = 0;
    if (grid == 0) {
        if (n_in != 9 || in_sizes[0] != TOK_PROMPT * DM || in_sizes[1] != (NTOK - TOK_PROMPT) * DM || out_size != NTOK * DM || ws_size < WS_END) {
            fprintf(stderr, "kernel_launch: shape mismatch n_in %d in0 %d in1 %d out %d ws %zu (need %zu)\n", n_in, n_in > 0 ? in_sizes[0] : -1, n_in > 1 ? in_sizes[1] : -1, out_size, ws_size, (size_t)WS_END); grid = -1; return; }
        int dev = 0, cus = 0, per_cu = 0;
        if (hipGetDevice(&dev) != hipSuccess || hipDeviceGetAttribute(&cus, hipDeviceAttributeMultiprocessorCount, dev) != hipSuccess) { fprintf(stderr, "kernel_launch: device query failed\n"); grid = -1; return; }
        if (hipFuncSetAttribute((const void*)hy_fwd, hipFuncAttributeMaxDynamicSharedMemorySize, LDS_BYTES) != hipSuccess) { fprintf(stderr, "kernel_launch: hipFuncSetAttribute failed\n"); grid = -1; return; }
        if (hipOccupancyMaxActiveBlocksPerMultiprocessor(&per_cu, (const void*)hy_fwd, NWAVES * 64, LDS_BYTES) != hipSuccess || per_cu < 1) { fprintf(stderr, "kernel_launch: occupancy query says %d\n", per_cu); per_cu = 1; }
        (void)hipGetLastError();
        grid = cus;
    }
    if (grid < 0) return;
    if (hipMemsetAsync((char*)d_ws + WS_CTL, 0, 65536, stream) != hipSuccess) { fprintf(stderr, "kernel_launch: hipMemsetAsync of the control words failed\n"); return; }
    Args a{};
    for (int i = 0; i < 9; ++i) a.in[i] = (const float*)d_in[i];
    a.out = (float*)d_out; a.ws = (unsigned char*)d_ws;
#if HY_N_LAUNCHES == 1
    a.ph_lo = 0; a.ph_hi = N_PHASES;
    void* kargs[] = {&a};
    hipError_t e = hipLaunchCooperativeKernel((const void*)hy_fwd, dim3(grid), dim3(NWAVES * 64), kargs, LDS_BYTES, stream);
    if (e != hipSuccess) fprintf(stderr, "kernel_launch: cooperative launch failed: %s (grid %d)\n", hipGetErrorString(e), grid);
#else
    for (int p = 0; p < N_PHASES; ++p) {
        a.ph_lo = p; a.ph_hi = p + 1;
        hipLaunchKernelGGL(hy_fwd, dim3(grid), dim3(NWAVES * 64), LDS_BYTES, stream, a);
        const hipError_t le = hipPeekAtLastError();
        if (le != hipSuccess) { fprintf(stderr, "kernel_launch: launch %d failed: %s\n", p, hipGetErrorName(le)); break; }
    }
#endif
}
```

```cpp
#include <hip/hip_runtime.h>
#include <hip/hip_bf16.h>
#include <hip/hip_cooperative_groups.h>
#include <cstdio>
#include <cstdint>
#include <cmath>
namespace cg = cooperative_groups;

#ifndef HY_SEPARATE_ROPE
#define HY_SEPARATE_ROPE 0
#endif
#ifndef HY_SCHED_J
#define HY_SCHED_J 1
#endif
#ifndef HY_MLSTM_REF
#define HY_MLSTM_REF 0
#endif
#ifndef HY_N_LAUNCHES
#define HY_N_LAUNCHES 1
#endif

constexpr int SEQ = 2048, NSEQ = 24, NTOK = NSEQ * SEQ, TOK_PROMPT = 8 * SEQ, DM = 2048;
constexpr int NPROJ = 6672, NP256 = 6656;
constexpr float EPS = 1e-6f;

constexpr size_t MiB = 1u << 20;
constexpr size_t WS_CTL = 0, CTL_ZERO_BYTES = 1 * MiB;
constexpr int CW_BAR = 4096, CW_QUEUE = 8192;
constexpr size_t WS_ROPE = 1 * MiB;
constexpr size_t WS_W8T = 2 * MiB;
constexpr size_t WS_W1B = 14 * MiB;
constexpr size_t WS_WGT = 18 * MiB;
constexpr size_t WS_SW = 19 * MiB;
constexpr size_t WS_SA = 20 * MiB;
constexpr size_t WS_W2T = 30 * MiB;
constexpr size_t WS_GATES = 38 * MiB;
constexpr size_t WS_H = 42 * MiB;
constexpr size_t WS_HF = WS_H, WS_HB = WS_H + 96 * MiB;
constexpr size_t WS_MIX = 234 * MiB;
constexpr size_t DO_H8 = 0, DO_Q = 96 * MiB;
constexpr float V8_SCALE = 16.f, P8_SCALE = 16.f;
constexpr float QK8_SCALE = 16.f;
constexpr float A8_SCALE = 256.f, W8_SCALE = 512.f;
constexpr size_t WS_AK = 426 * MiB, WS_AV = 450 * MiB;
constexpr size_t WS_AZ = 474 * MiB;
constexpr size_t WS_MQ = 570 * MiB, WS_MK = 618 * MiB;
constexpr size_t WS_MV = 666 * MiB, WS_MO = 762 * MiB, WS_MZ = 858 * MiB;
constexpr size_t WS_END = 954 * MiB;

typedef unsigned short bf16;
__device__ __forceinline__ unsigned f2bf(float f) { unsigned u = __builtin_bit_cast(unsigned, f); return (u + 0x7fffu + ((u >> 16) & 1u)) >> 16; }
__device__ __forceinline__ unsigned pk2(float lo, float hi) { return f2bf(lo) | (f2bf(hi) << 16); }
__device__ __forceinline__ float bf2f(unsigned short b) { return __builtin_bit_cast(float, (unsigned)b << 16); }
__device__ __forceinline__ float bflo(unsigned w) { return __builtin_bit_cast(float, w << 16); }
__device__ __forceinline__ float bfhi(unsigned w) { return __builtin_bit_cast(float, w & 0xffff0000u); }
constexpr int NQA = 2560, NB0 = 2560, NB1 = 3584, NQ8 = 5632;
__device__ __forceinline__ unsigned pk4f8(float a, float b, float c, float d) {
    a = __builtin_fminf(__builtin_fmaxf(a, -448.f), 448.f); b = __builtin_fminf(__builtin_fmaxf(b, -448.f), 448.f); c = __builtin_fminf(__builtin_fmaxf(c, -448.f), 448.f); d = __builtin_fminf(__builtin_fmaxf(d, -448.f), 448.f);
    int w = 0; w = __builtin_amdgcn_cvt_pk_fp8_f32(a, b, w, false); w = __builtin_amdgcn_cvt_pk_fp8_f32(c, d, w, true); return (unsigned)w; }
__device__ __forceinline__ unsigned pk4f8_nc(float a, float b, float c, float d) {
    int w = __builtin_bit_cast(int, a); w = __builtin_amdgcn_cvt_pk_fp8_f32(a, b, w, false); w = __builtin_amdgcn_cvt_pk_fp8_f32(c, d, w, true); return (unsigned)w; }
__device__ __forceinline__ float log_sigmoid_f(float x) { return x >= 0.f ? -log1pf(expf(-x)) : x - log1pf(expf(x)); }
namespace pg8 {
#define PG8_LAS __attribute__((address_space(3)))
typedef unsigned short bf16_t;
typedef short bf16x8 __attribute__((ext_vector_type(8)));
typedef float f32x4 __attribute__((ext_vector_type(4)));
typedef unsigned u32x4 __attribute__((ext_vector_type(4)));
typedef int i32x4 __attribute__((ext_vector_type(4)));
constexpr int F8_TILES = 8;
constexpr int BM = 256, BK = 64, HALF = 128, HTB = HALF * BK * 2  , STAGE_BYTES = 8 * HTB, NXCD = 8, WGM = 8;

__host__ __device__ __forceinline__ int lds_byte(int r, int c) { const int st = (r >> 4) * 2 + (c >> 5), rr = r & 15, cc = c & 31, ob = rr * 64 + cc * 2; return st * 1024 + (ob ^ (((ob >> 9) & 1) << 5)); }
__host__ __device__ __forceinline__ void stage_rc(int b, int& R, int& C) { const int st = b / 1024, sb = b % 1024, swz = sb ^ (((sb >> 9) & 1) << 5); R = (st >> 1) * 16 + swz / 64; C = (st & 1) * 32 + (swz % 64) / 2; }
__host__ __device__ __forceinline__ int perm32(int rho) { const int n = rho >> 4, i = rho & 15; return 8 * (i >> 2) + 4 * n + (i & 3); }

struct Unit { int pm, pn; };
struct Gemm { const bf16_t* A; const bf16_t* Bt; int M, N, K, kt; };

struct StaticOrder {
    int nM, nN, nwg, G, c;
    __host__ __device__ void init(int M, int N, int G_, int c_) { nM = M / BM; nN = N / BM; nwg = nM * nN; G = G_; c = c_; }
    __host__ __device__ bool next(int i, Unit& u) const {
        const long L = (long)i * G + c; if (L >= nwg) return false;
        int wgid = (int)L; { const int q = nwg / NXCD, r = nwg % NXCD, xcd = wgid % NXCD, off = wgid / NXCD; wgid = (xcd < r ? xcd * (q + 1) : r * (q + 1) + (xcd - r) * q) + off; }
        const int nig = WGM * nN, gid = wgid / nig, fm = gid * WGM, gsz = (nM - fm) < WGM ? (nM - fm) : WGM;
        u.pm = fm + ((wgid % nig) % gsz); u.pn = (wgid % nig) / gsz; return true;
    }
    __device__ __forceinline__ void a_ready(const Unit&) const {}
    __device__ __forceinline__ void done(const Unit&) const {}
};


__device__ __forceinline__ unsigned cvt_pk_bf16(float lo, float hi) { unsigned r; asm volatile("v_cvt_pk_bf16_f32 %0, %1, %2" : "=v"(r) : "v"(lo), "v"(hi)); return r; }

template <int PN0, int MODE>
struct EpiProjT {
    static constexpr bool PERM = true, AFTER_DRAIN = false, PREFETCH = (MODE == 2); static constexpr int NSTORE = 16;
    unsigned char* ws; PG8_LAS float* xch; PG8_LAS float* ropeL; PG8_LAS float* qkgL;
    unsigned char* qb;
    PG8_LAS float* scl; const float* SA; const float* SW;
    __device__ __forceinline__ void prefetch(const Unit& u, int ui, int wid, int lane) const {
        const float* src = (wid < 4) ? SA + (size_t)u.pm * BM + wid * 64 + lane : SW + u.pn * BM + (wid - 4) * 64 + lane;
        __builtin_amdgcn_global_load_lds((const unsigned*)src, (PG8_LAS unsigned*)(scl + (ui & 1) * 512 + wid * 64), 4, 0, 0); }
    __device__ __forceinline__ void operator()(const f32x4 (&acc)[2][2][4][2], const Unit& u, int wr, int wc, int fr, int fq, int par = 0) const {
        const int pn = (MODE == 2) ? (u.pn < 10 ? u.pn : u.pn + 4) : u.pn + PN0; const int row0 = u.pm * BM + wr * 64 + fr;
        constexpr float SC = (MODE == 1) ? (1.f / 4096.f) : 1.f;
        float sa[2][4]; f32x4 sw[2][2];
        if constexpr (MODE == 2) { PG8_LAS float* T = scl + par * 512;
#pragma unroll
            for (int ai = 0; ai < 2; ++ai)
#pragma unroll
                for (int m = 0; m < 4; ++m) sa[ai][m] = T[ai * HALF + wr * 64 + m * 16 + fr];
#pragma unroll
            for (int bj = 0; bj < 2; ++bj)
#pragma unroll
                for (int n = 0; n < 2; ++n) sw[bj][n] = *(const PG8_LAS f32x4*)(T + 256 + bj * HALF + wc * 32 + 8 * fq + 4 * n); }
        auto val = [&](int ai, int bj, int m, int n) -> f32x4 {
            if constexpr (MODE == 2) { const i32x4 iv = __builtin_bit_cast(i32x4, acc[ai][bj][m][n]); const f32x4 f = {(float)iv[0], (float)iv[1], (float)iv[2], (float)iv[3]}; return f * sa[ai][m] * sw[bj][n]; }
            else return acc[ai][bj][m][n] * SC; };
        if (!HY_SEPARATE_ROPE && PN0 <= 4 && pn <= 4) {
            PG8_LAS float* gsrc = qkgL + ((pn < 4) ? 0 : 128); const int cb = 64 * (wc >> 1) + 16 * (wc & 1) + 4 * fq;
            const f32x4 g1 = *(const PG8_LAS f32x4*)(gsrc + cb), g2 = *(const PG8_LAS f32x4*)(gsrc + cb + 32);
#pragma unroll
            for (int ai = 0; ai < 2; ++ai)
#pragma unroll
                for (int m = 0; m < 4; ++m)
#pragma unroll
                    for (int bj = 0; bj < 2; ++bj) { const f32x4 a = val(ai, bj, m, 0), b = val(ai, bj, m, 1);
                        float s = ((a[0] * a[0] + a[1] * a[1]) + (a[2] * a[2] + a[3] * a[3])) + ((b[0] * b[0] + b[1] * b[1]) + (b[2] * b[2] + b[3] * b[3]));
                        s += __shfl_xor(s, 16); s += __shfl_xor(s, 32);
                        if (fq == 0) xch[((ai * HALF + wr * 64 + m * 16 + fr) * 2 + bj) * 4 + wc] = s; }
            asm volatile("s_waitcnt lgkmcnt(0)" ::: "memory"); __builtin_amdgcn_s_barrier(); asm volatile("" ::: "memory");
            unsigned char* base = pn < 4 ? qb : ws + WS_AK; const int ldc = (pn < 4) ? 1024 : 256; const int colt = (pn < 4) ? pn * 256 : 0;
            PG8_LAS float* R = ropeL; const int j0 = 16 * (wc & 1) + 4 * fq;
#pragma unroll
            for (int ai = 0; ai < 2; ++ai)
#pragma unroll
                for (int m = 0; m < 4; ++m) { const int row = row0 + ai * HALF + m * 16; const int tl = row & (SEQ - 1); const int pos = (wc < 2) ? (tl >> 6) : (tl & 63);
                    const f32x4 cs0 = *(const PG8_LAS f32x4*)(R + (pos * 32 + j0) * 2), cs1 = *(const PG8_LAS f32x4*)(R + (pos * 32 + j0) * 2 + 4);
#pragma unroll
                    for (int bj = 0; bj < 2; ++bj) { const f32x4 pt = *(const PG8_LAS f32x4*)(xch + ((ai * HALF + wr * 64 + m * 16 + fr) * 2 + bj) * 4);
                        const float rstd = 1.f / sqrtf(((pt[0] + pt[1]) + (pt[2] + pt[3])) * (1.f / 128.f) + EPS);
                        const f32x4 y1 = val(ai, bj, m, 0) * rstd * g1, y2 = val(ai, bj, m, 1) * rstd * g2;
                        const float o10 = y1[0] * cs0[0] - y2[0] * cs0[1], o11 = y1[1] * cs0[2] - y2[1] * cs0[3], o12 = y1[2] * cs1[0] - y2[2] * cs1[1], o13 = y1[3] * cs1[2] - y2[3] * cs1[3];
                        const float o20 = y2[0] * cs0[0] + y1[0] * cs0[1], o21 = y2[1] * cs0[2] + y1[1] * cs0[3], o22 = y2[2] * cs1[0] + y1[2] * cs1[1], o23 = y2[3] * cs1[2] + y1[3] * cs1[3];
                        unsigned char* dst = base + (size_t)row * ldc + colt + bj * HALF + cb;
                        *(unsigned*)dst = pk4f8(o10 * QK8_SCALE, o11 * QK8_SCALE, o12 * QK8_SCALE, o13 * QK8_SCALE); *(unsigned*)(dst + 32) = pk4f8(o20 * QK8_SCALE, o21 * QK8_SCALE, o22 * QK8_SCALE, o23 * QK8_SCALE); } }
            return;
        }
        size_t off; int ldc, colt;
        if (pn < 4)       { off = 0; ldc = 1024; colt = pn * 256; }
        else if (pn == 4) { off = WS_AK;  ldc = 256;  colt = 0; }
        else if (pn == 5) { off = WS_AV;  ldc = 256;  colt = 0; }
        else if (pn < 10) { off = WS_AZ;  ldc = 1024; colt = (pn - 6) * 256; }
        else if (pn < 12) { off = WS_MQ;  ldc = 512;  colt = (pn - 10) * 256; }
        else if (pn < 14) { off = WS_MK;  ldc = 512;  colt = (pn - 12) * 256; }
        else if (pn < 18) { off = WS_MV;  ldc = 1024; colt = (pn - 14) * 256; }
        else if (pn < 22) { off = WS_MO;  ldc = 1024; colt = (pn - 18) * 256; }
        else              { off = WS_MZ;  ldc = 1024; colt = (pn - 22) * 256; }
        if constexpr (MODE == 2) { if (pn == 5) {
            unsigned char* VT = ws + WS_AV;
            int fr_ = fr, fq_ = fq; asm volatile("" : "+v"(fr_), "+v"(fq_));
            const int b = u.pm >> 3, tile0 = (u.pm & 7) * 4 + wr, qi = fr_ & 3; const unsigned sel = (unsigned)qi | ((unsigned)(4 + qi) << 8);
#pragma unroll
            for (int ai = 0; ai < 2; ++ai)
#pragma unroll
                for (int m = 0; m < 4; ++m)
#pragma unroll
                    for (int bj = 0; bj < 2; ++bj)
#pragma unroll
                        for (int n = 0; n < 2; ++n) { const f32x4 v = val(ai, bj, m, n) * V8_SCALE; const int w = (int)pk4f8(v[0], v[1], v[2], v[3]);
                            const unsigned w0 = (unsigned)__builtin_amdgcn_update_dpp(0, w, 0x00, 0xf, 0xf, false), w1 = (unsigned)__builtin_amdgcn_update_dpp(0, w, 0x55, 0xf, 0xf, false);
                            const unsigned w2 = (unsigned)__builtin_amdgcn_update_dpp(0, w, 0xaa, 0xf, 0xf, false), w3 = (unsigned)__builtin_amdgcn_update_dpp(0, w, 0xff, 0xf, 0xf, false);
                            const unsigned x01 = __builtin_amdgcn_perm(w1, w0, sel), x23 = __builtin_amdgcn_perm(w3, w2, sel), o4 = __builtin_amdgcn_perm(x23, x01, 0x05040100u);
                            const int d = 32 * wc + 8 * fq_ + 4 * n + qi, dw = ((fr_ >> 2) & 1) * 8 + (m >> 1) * 4 + (m & 1) * 2 + ((fr_ >> 3) & 1);
                            *(unsigned*)(VT + ((size_t)((b * 2 + bj) * 128 + d)) * 2048 + (tile0 + 2 * ai) * 64 + dw * 4) = o4; }
            return; } }
        bf16_t* base = (bf16_t*)(pn < 4 ? qb : ws + off);
        const int col0 = colt + wc * 32 + 8 * fq;
#pragma unroll
        for (int ai = 0; ai < 2; ++ai)
#pragma unroll
            for (int m = 0; m < 4; ++m) { bf16_t* rowp = base + (size_t)(row0 + ai * HALF + m * 16) * ldc + col0;
#pragma unroll
                for (int bj = 0; bj < 2; ++bj) { const f32x4 v0 = val(ai, bj, m, 0), v1 = val(ai, bj, m, 1);
                    u32x4 w; w.x = cvt_pk_bf16(v0[0], v0[1]); w.y = cvt_pk_bf16(v0[2], v0[3]); w.z = cvt_pk_bf16(v1[0], v1[1]); w.w = cvt_pk_bf16(v1[2], v1[3]);
                    *(u32x4*)(rowp + bj * HALF) = w; } }
    }
};
struct EpiNull { static constexpr bool PERM = true, AFTER_DRAIN = false, PREFETCH = false; static constexpr int NSTORE = 0;
    __device__ __forceinline__ void operator()(const f32x4 (&acc)[2][2][4][2], const Unit& u, int wr, int wc, int fr, int fq) const {
#pragma unroll
        for (int ai = 0; ai < 2; ++ai)
#pragma unroll
            for (int bj = 0; bj < 2; ++bj)
#pragma unroll
                for (int m = 0; m < 4; ++m) asm volatile("" :: "v"(acc[ai][bj][m][0]), "v"(acc[ai][bj][m][1])); } };
struct EpiOut {
    static constexpr bool PERM = false, AFTER_DRAIN = false, PREFETCH = false; static constexpr int NSTORE = 32;
    const float* xp; const float* xs; float* out;
    __device__ __forceinline__ void operator()(const f32x4 (&acc)[2][2][4][2], const Unit& u, int wr, int wc, int fr, int fq) const {
        const int row0 = u.pm * BM + wr * 64 + fr; const int col0 = u.pn * BM + wc * 32 + 4 * fq;
        const bool pr = row0 < TOK_PROMPT; const float* xb = (pr ? xp : xs) + col0;
        const size_t xsub = pr ? 0 : (size_t)TOK_PROMPT * DM; float* ob = out + col0;
        f32x4 xr[4][4];
#define EPO_LOAD(g_) do { const size_t ro_ = (size_t)(row0 + ((g_) >> 2) * HALF + ((g_) & 3) * 16) * DM - xsub; \
            xr[(g_) & 3][0] = *(const f32x4*)(xb + ro_); xr[(g_) & 3][1] = *(const f32x4*)(xb + ro_ + 16); xr[(g_) & 3][2] = *(const f32x4*)(xb + ro_ + HALF); xr[(g_) & 3][3] = *(const f32x4*)(xb + ro_ + HALF + 16); } while (0)
        EPO_LOAD(0); EPO_LOAD(1); EPO_LOAD(2);
#pragma unroll
        for (int g = 0; g < 8; ++g) { if (g + 3 < 8) EPO_LOAD(g + 3);
            const int ai = g >> 2, m = g & 3; const size_t ro = (size_t)(row0 + ai * HALF + m * 16) * DM;
            *(f32x4*)(ob + ro) = xr[g & 3][0] + acc[ai][0][m][0]; *(f32x4*)(ob + ro + 16) = xr[g & 3][1] + acc[ai][0][m][1];
            *(f32x4*)(ob + ro + HALF) = xr[g & 3][2] + acc[ai][1][m][0]; *(f32x4*)(ob + ro + HALF + 16) = xr[g & 3][3] + acc[ai][1][m][1]; }
#undef EPO_LOAD
    }
};

template <class Epi, class Sched, bool ALIGN_EPI = false, bool SP2 = false, int MODE = 0>
__device__ __forceinline__ void gemm_phase(PG8_LAS unsigned char* lds, const Gemm g, const Sched& S, const Epi& E) {
    int tid_ = threadIdx.x; asm volatile("" : "+v"(tid_));
    const int tid = tid_, wid = __builtin_amdgcn_readfirstlane(tid >> 6), lane = tid & 63, wr = wid >> 2, wc = wid & 3, fr = lane & 15, fq = lane >> 4;
    const int K = g.K, nt = g.kt;
    unsigned voffA[2], voffB[2];
#pragma unroll
    for (int i = 0; i < 2; ++i) { int R, C; stage_rc(tid * 16 + i * 8192, R, C); const int Rb = Epi::PERM ? ((R & ~31) + perm32(R & 31)) : R;
        voffA[i] = (unsigned)(R * K + C) * 2u; voffB[i] = (unsigned)(Rb * K + C) * 2u; }
    const size_t kstep = (size_t)(BK * 2);
    const size_t hstep = (size_t)HALF * K * 2;
    const size_t tstep = 2 * hstep;
    const unsigned ldsw = (unsigned)wid * 1024u;
    const int aoff = lds_byte(wr * 64 + fr, fq * 8), boff = lds_byte(wc * 32 + fr, fq * 8);
#define PG8_SA(b, h) (((b) * 2 + (h)) * HTB)
#define PG8_SB(b, h) ((4 + (b) * 2 + (h)) * HTB)
#define PG8_STAGE(bufoff, gbase, voff) do { _Pragma("unroll") for (int _i = 0; _i < 2; ++_i) \
        __builtin_amdgcn_global_load_lds((const unsigned*)((const char*)(gbase) + (voff)[_i]), (PG8_LAS unsigned*)(lds + (bufoff) + ldsw + _i * 8192), 16, 0, 0); } while (0)
#define PG8_LDA(dst, b, h) do { _Pragma("unroll") for (int m = 0; m < 4; ++m) _Pragma("unroll") for (int k = 0; k < 2; ++k) dst[m][k] = *(const PG8_LAS bf16x8*)(lds + PG8_SA(b, h) + aoff + m * 2048 + k * 1024); } while (0)
#define PG8_LDB(dst, b, h) do { _Pragma("unroll") for (int n = 0; n < 2; ++n) _Pragma("unroll") for (int k = 0; k < 2; ++k) dst[n][k] = *(const PG8_LAS bf16x8*)(lds + PG8_SB(b, h) + boff + n * 2048 + k * 1024); } while (0)
#define PG8_CAT8(x_) __builtin_shufflevector(__builtin_bit_cast(i32x4, (x_)[0]), __builtin_bit_cast(i32x4, (x_)[1]), 0, 1, 2, 3, 4, 5, 6, 7)
#define PG8_MMA_F8(ai, bj, At, Bt) do { _Pragma("unroll") for (int m = 0; m < 4; ++m) _Pragma("unroll") for (int n = 0; n < 2; ++n) \
        asm volatile("v_mfma_f32_16x16x128_f8f6f4 %0, %1, %2, %0" : "+v"(acc[ai][bj][m][n]) : "v"(PG8_CAT8(Bt[n])), "v"(PG8_CAT8(At[m]))); } while (0)
#define PG8_MMA_I8(ai, bj, At, Bt) do { _Pragma("unroll") for (int k = 0; k < 2; ++k) _Pragma("unroll") for (int m = 0; m < 4; ++m) _Pragma("unroll") for (int n = 0; n < 2; ++n) \
        asm volatile("v_mfma_i32_16x16x64_i8 %0, %1, %2, %0" : "+v"(acc[ai][bj][m][n]) : "v"(Bt[n][k]), "v"(At[m][k])); } while (0)
#define PG8_MMA_BF(ai, bj, At, Bt) do { _Pragma("unroll") for (int m = 0; m < 4; ++m) _Pragma("unroll") for (int n = 0; n < 2; ++n) _Pragma("unroll") for (int k = 0; k < 2; ++k) \
        acc[ai][bj][m][n] = __builtin_amdgcn_mfma_f32_16x16x32_bf16(Bt[n][k], At[m][k], acc[ai][bj][m][n], 0, 0, 0); } while (0)
#define PG8_MMA(ai, bj, At, Bt) do { __builtin_amdgcn_s_setprio(1); \
        if constexpr (MODE == 1) PG8_MMA_F8(ai, bj, At, Bt); else if constexpr (MODE == 2) PG8_MMA_I8(ai, bj, At, Bt); else PG8_MMA_BF(ai, bj, At, Bt); \
        __builtin_amdgcn_s_setprio(0); } while (0)
#define PG8_MMAW_F8(ai, bj, At, Bt) do { __builtin_amdgcn_s_setprio(1); PG8_MMA_F8(ai, bj, At, Bt); __builtin_amdgcn_s_setprio(0); } while (0)
#define PG8_MMAW_BF(ai, bj, At, Bt) do { __builtin_amdgcn_s_setprio(1); PG8_MMA_BF(ai, bj, At, Bt); __builtin_amdgcn_s_setprio(0); } while (0)
#define PG8_WAIT_V(n) asm volatile("s_waitcnt vmcnt(" #n ")" ::: "memory")
#define PG8_WAIT_L(n) asm volatile("s_waitcnt lgkmcnt(" #n ")" ::: "memory")
#define PG8_BAR __builtin_amdgcn_s_barrier()
#define PG8_SCHED __builtin_amdgcn_sched_barrier(0)
    Unit cur, nxt; int ui = 0;
    if (!S.next(0, cur)) return;
    f32x4 acc[2][2][4][2];
#pragma unroll
    for (int a = 0; a < 2; ++a)
#pragma unroll
        for (int b = 0; b < 2; ++b)
#pragma unroll
            for (int m = 0; m < 4; ++m)
#pragma unroll
                for (int n = 0; n < 2; ++n) { acc[a][b][m][n] = (f32x4){0.f, 0.f, 0.f, 0.f}; if constexpr (MODE != 0) asm volatile("" : "+v"(acc[a][b][m][n])); }
    bf16x8 At[4][2], B0[2][2], B1[2][2];
    const char* cA = (const char*)g.A + (size_t)cur.pm * tstep; const char* cB = (const char*)g.Bt + (size_t)cur.pn * tstep;
    S.a_ready(cur);
    if constexpr (SP2) {
        PG8_STAGE(PG8_SB(0, 0), cB, voffB); PG8_STAGE(PG8_SB(0, 1), cB + hstep, voffB); PG8_STAGE(PG8_SA(0, 0), cA, voffA); PG8_STAGE(PG8_SA(0, 1), cA + hstep, voffA);
        if (wr == 1) PG8_BAR;
        PG8_WAIT_V(2); PG8_BAR;
        PG8_STAGE(PG8_SB(1, 0), cB + kstep, voffB); PG8_STAGE(PG8_SA(1, 0), cA + kstep, voffA); PG8_STAGE(PG8_SB(1, 1), cB + hstep + kstep, voffB);
        PG8_WAIT_V(6); PG8_BAR;
    } else {
        PG8_STAGE(PG8_SB(0, 0), cB, voffB); PG8_STAGE(PG8_SA(0, 0), cA, voffA); PG8_STAGE(PG8_SB(0, 1), cB + hstep, voffB); PG8_STAGE(PG8_SA(0, 1), cA + hstep, voffA);
        if (wr == 1) PG8_BAR;
        PG8_WAIT_V(4); PG8_BAR;
        PG8_STAGE(PG8_SB(1, 0), cB + kstep, voffB); PG8_STAGE(PG8_SA(1, 0), cA + kstep, voffA); PG8_STAGE(PG8_SB(1, 1), cB + hstep + kstep, voffB);
        PG8_WAIT_V(6); PG8_BAR;
    }
    for (;;) {
        const bool has_next = S.next(ui + 1, nxt);
        const char* nA = has_next ? (const char*)g.A + (size_t)nxt.pm * tstep : cA; const char* nB = has_next ? (const char*)g.Bt + (size_t)nxt.pn * tstep : cB;
        static_assert(SP2, "gemm_phase: only the SP2 K-loop is carried");
#define PG8_WAIT_FIRST() do { if constexpr (Epi::NSTORE >= 32) asm volatile("s_waitcnt vmcnt(40)\n\ts_cmp_lg_u32 %0, 0\n\ts_cbranch_scc1 1f\n\ts_waitcnt vmcnt(8)\n1:" :: "s"(relax_s) : "memory", "scc"); \
            else if constexpr (Epi::NSTORE >= 16) asm volatile("s_waitcnt vmcnt(24)\n\ts_cmp_lg_u32 %0, 0\n\ts_cbranch_scc1 1f\n\ts_waitcnt vmcnt(8)\n1:" :: "s"(relax_s) : "memory", "scc"); \
            else PG8_WAIT_V(8); } while (0)
#define PG8_TRIP(MMAX) do { \
            const bool last = (t == nt - 2); \
            const char* a1 = cA + (size_t)(t + 1) * kstep; \
            const char* a2 = last ? nA : cA + (size_t)(t + 2) * kstep; const char* b2 = last ? nB : cB + (size_t)(t + 2) * kstep; \
            const char* a3 = a2 + kstep; const char* b3 = b2 + kstep; \
            if (last && has_next) S.a_ready(nxt); \
            const int relax_s = __builtin_amdgcn_readfirstlane((Epi::NSTORE > 0 && t == 0 && ui > 0) ? 1 : 0); \
            PG8_LDB(B0, 0, 0); PG8_LDB(B1, 0, 1); PG8_SCHED; PG8_LDA(At, 0, 0); PG8_STAGE(PG8_SA(1, 1), a1 + hstep, voffA); \
            PG8_WAIT_FIRST(); PG8_WAIT_L(0); PG8_BAR; MMAX(0, 0, At, B0); MMAX(0, 1, At, B1); PG8_BAR; PG8_SCHED; \
            PG8_LDA(At, 0, 1); PG8_STAGE(PG8_SB(0, 0), b2, voffB); PG8_STAGE(PG8_SB(0, 1), b2 + hstep, voffB); PG8_STAGE(PG8_SA(0, 0), a2, voffA); \
            PG8_WAIT_FIRST(); PG8_WAIT_L(0); PG8_BAR; MMAX(1, 0, At, B0); MMAX(1, 1, At, B1); PG8_BAR; PG8_SCHED; \
            if constexpr (Epi::PREFETCH) { if (t == 0) E.prefetch(cur, ui, wid, lane); } \
            PG8_LDB(B0, 1, 0); PG8_LDB(B1, 1, 1); PG8_SCHED; PG8_LDA(At, 1, 0); PG8_STAGE(PG8_SA(0, 1), a2 + hstep, voffA); \
            PG8_WAIT_V(8); PG8_WAIT_L(0); PG8_BAR; MMAX(0, 0, At, B0); MMAX(0, 1, At, B1); PG8_BAR; PG8_SCHED; \
            PG8_LDA(At, 1, 1); PG8_STAGE(PG8_SB(1, 0), b3, voffB); PG8_STAGE(PG8_SB(1, 1), b3 + hstep, voffB); PG8_STAGE(PG8_SA(1, 0), a3, voffA); \
            PG8_WAIT_V(8); PG8_WAIT_L(0); PG8_BAR; MMAX(1, 0, At, B0); MMAX(1, 1, At, B1); PG8_BAR; PG8_SCHED; } while (0)
        if constexpr (MODE == 3) {
            for (int t = 0; t < F8_TILES; t += 2) PG8_TRIP(PG8_MMAW_F8);
            asm volatile("s_nop 15\n\ts_nop 15" ::: "memory"); PG8_SCHED;
#pragma unroll
            for (int a = 0; a < 2; ++a)
#pragma unroll
                for (int b = 0; b < 2; ++b)
#pragma unroll
                    for (int m = 0; m < 4; ++m)
#pragma unroll
                        for (int n = 0; n < 2; ++n) acc[a][b][m][n] *= (1.f / (A8_SCALE * W8_SCALE));
            for (int t = F8_TILES; t < nt; t += 2) PG8_TRIP(PG8_MMAW_BF);
        } else { for (int t = 0; t < nt; t += 2) PG8_TRIP(PG8_MMA); }
#undef PG8_TRIP
#undef PG8_WAIT_FIRST
        if constexpr (MODE == 1 || MODE == 2) { asm volatile("s_nop 15\n\ts_nop 15" ::: "memory"); PG8_SCHED; }
        if constexpr (ALIGN_EPI) { if (wr == 0) PG8_BAR; }
        if constexpr (!Epi::AFTER_DRAIN) { if constexpr (Epi::PREFETCH) E(acc, cur, wr, wc, fr, fq, ui & 1); else E(acc, cur, wr, wc, fr, fq); S.done(cur); }
        if (!has_next) break;
#pragma unroll
        for (int a = 0; a < 2; ++a)
#pragma unroll
            for (int b = 0; b < 2; ++b)
#pragma unroll
                for (int m = 0; m < 4; ++m)
#pragma unroll
                    for (int n = 0; n < 2; ++n) { acc[a][b][m][n] = (f32x4){0.f, 0.f, 0.f, 0.f}; if constexpr (MODE != 0) asm volatile("" : "+v"(acc[a][b][m][n])); }
        cur = nxt; cA = nA; cB = nB; ++ui;
        if constexpr (ALIGN_EPI) { if (wr == 1) PG8_BAR; }
    }
    PG8_WAIT_V(0);
    if constexpr (!ALIGN_EPI) { if (wr == 0) PG8_BAR; }
    PG8_BAR;
    if constexpr (Epi::AFTER_DRAIN) { E.fused(acc, cur, wr, wc, fr, fq, lds, wid, lane); S.done(cur); }
#undef PG8_SA
#undef PG8_SB
#undef PG8_STAGE
#undef PG8_LDA
#undef PG8_LDB
#undef PG8_MMA
#undef PG8_MMAW_F8
#undef PG8_MMAW_BF
#undef PG8_MMA_F8
#undef PG8_MMA_I8
#undef PG8_MMA_BF
#undef PG8_CAT8
#undef PG8_WAIT_V
#undef PG8_WAIT_L
#undef PG8_BAR
#undef PG8_SCHED
}
}
namespace attn {
using bf16 = __hip_bfloat16;
constexpr int   D = 128, NW = 8, QBLK = 32, KVBLK = 64;
constexpr float SCALE = 0.088388347648318440f / (QK8_SCALE * QK8_SCALE);
constexpr float THR = 3.f;
constexpr int SDEPTH = 2;
constexpr int LDQ = 1024, LDK = 256, LDO = 4096, LDZ = 1024;
constexpr size_t SHM_V = KVBLK * D, SHM_K = KVBLK * D, SHM_ATTN = 65536 + NW * 64 * 4;
using bf16x8 = __attribute__((ext_vector_type(8))) short;
using s16x4  = __attribute__((ext_vector_type(4))) short;
using f32x16 = __attribute__((ext_vector_type(16))) float;
using f32x8  = __attribute__((ext_vector_type(8))) float;
using u32x4  = __attribute__((ext_vector_type(4))) unsigned;
#define KSWZ(row, colB) ((row) * 128 + ((colB) ^ ((((row) >> 1) & 7) << 4)))
#define VSWZ(row, colB) ((row) * 64 + ((colB) ^ ((((row) >> 2) & 3) << 4)))
typedef int i32x8 __attribute__((ext_vector_type(8)));
typedef int i32x4a __attribute__((ext_vector_type(4)));
#define SBAR() __builtin_amdgcn_sched_barrier(0)
__device__ __forceinline__ int crow(int r, int hi) { return (r & 3) + 8 * (r >> 2) + 4 * hi; }
__device__ __forceinline__ unsigned cvtpk(float lo, float hi) {
  unsigned r; asm volatile("v_cvt_pk_bf16_f32 %0, %1, %2" : "=v"(r) : "v"(lo), "v"(hi)); return r;
}
template <typename TIn> struct Stage;
template <> struct Stage<bf16>  { using T = bf16x8;
  __device__ static __forceinline__ T ld8(const bf16* p) { return *reinterpret_cast<const bf16x8*>(p); }
  __device__ static __forceinline__ bf16x8 tobf(T x) { return x; } };
template <> struct Stage<float> { using T = f32x8;
  __device__ static __forceinline__ T ld8(const float* p) { return *reinterpret_cast<const f32x8*>(p); }
  __device__ static __forceinline__ bf16x8 tobf(T x) {
    u32x4 w = {cvtpk(x[0], x[1]), cvtpk(x[2], x[3]), cvtpk(x[4], x[5]), cvtpk(x[6], x[7])}; return *reinterpret_cast<bf16x8*>(&w); } };

__device__ __forceinline__ void partialSM(f32x16& p0, f32x16& p1, float& m_reg, float& mn, float& alpha) {
  constexpr float C = SCALE * 1.4426950408889634f;
  float pmax = p0[0]; for (int r = 1; r < 16; ++r) pmax = fmaxf(pmax, p0[r]); for (int r = 0; r < 16; ++r) pmax = fmaxf(pmax, p1[r]);
  { auto rr = __builtin_amdgcn_permlane32_swap(__float_as_uint(pmax), __float_as_uint(pmax), false, false);
    pmax = fmaxf(__uint_as_float(rr[0]), __uint_as_float(rr[1])); }
  if (__builtin_expect(__all(pmax - m_reg <= THR / SCALE), 1)) { mn = m_reg; alpha = 1.f; }
  else { mn = fmaxf(m_reg, pmax); alpha = __builtin_amdgcn_exp2f((m_reg - mn) * C); m_reg = mn; }
  float mnC = fmaf(-mn, C, 4.0f);
  for (int r = 0; r < 16; ++r) p0[r] = fmaf(p0[r], C, mnC); for (int r = 0; r < 16; ++r) p1[r] = fmaf(p1[r], C, mnC);
  for (int r = 0; r < 16; ++r) p0[r] = __builtin_amdgcn_exp2f(p0[r]);
}
__device__ __forceinline__ void finishSM(f32x16& p0, f32x16& p1, float alpha, float& l_reg, i32x8& pa) {
  for (int r = 0; r < 16; ++r) p1[r] = __builtin_amdgcn_exp2f(p1[r]);
  float ps = 0; for (int r = 0; r < 16; ++r) ps += p0[r]; for (int r = 0; r < 16; ++r) ps += p1[r];
  { auto rr = __builtin_amdgcn_permlane32_swap(__float_as_uint(ps), __float_as_uint(ps), false, false);
    ps = __uint_as_float(rr[0]) + __uint_as_float(rr[1]); }
  l_reg = l_reg * alpha + ps;
#pragma unroll
  for (int q = 0; q < 4; ++q) { pa[q] = (int)pk4f8_nc(p0[4 * q], p0[4 * q + 1], p0[4 * q + 2], p0[4 * q + 3]);
    pa[4 + q] = (int)pk4f8_nc(p1[4 * q], p1[4 * q + 1], p1[4 * q + 2], p1[4 * q + 3]); }
}
__device__ __forceinline__ void qkt(f32x16& p0, f32x16& p1, const unsigned char* Ks, const i32x8* qf, int r32, int hi) {
  i32x8 ka[2], kb[2];
#pragma unroll
  for (int s = 0; s < 2; ++s) { const int cb = 64 * s + 32 * hi;
    const i32x4a a0 = *reinterpret_cast<const i32x4a*>(Ks + KSWZ(r32, cb)), a1 = *reinterpret_cast<const i32x4a*>(Ks + KSWZ(r32, cb + 16));
    const i32x4a b0 = *reinterpret_cast<const i32x4a*>(Ks + KSWZ(32 + r32, cb)), b1 = *reinterpret_cast<const i32x4a*>(Ks + KSWZ(32 + r32, cb + 16));
    ka[s] = __builtin_shufflevector(a0, a1, 0, 1, 2, 3, 4, 5, 6, 7); kb[s] = __builtin_shufflevector(b0, b1, 0, 1, 2, 3, 4, 5, 6, 7); }
  asm volatile("v_mfma_f32_32x32x64_f8f6f4 %0, %1, %2, 0" : "=&v"(p0) : "v"(ka[0]), "v"(qf[0]));
  asm volatile("v_mfma_f32_32x32x64_f8f6f4 %0, %1, %2, 0" : "=&v"(p1) : "v"(kb[0]), "v"(qf[0]));
  asm volatile("v_mfma_f32_32x32x64_f8f6f4 %0, %1, %2, %0" : "+v"(p0) : "v"(ka[1]), "v"(qf[1]));
  asm volatile("v_mfma_f32_32x32x64_f8f6f4 %0, %1, %2, %0\n\ts_nop 15\n\ts_nop 7" : "+v"(p1) : "v"(kb[1]), "v"(qf[1]));
}
template <int D0> __device__ __forceinline__ void pv_one(f32x16& od, const unsigned char* Vs, i32x8 pa, int r32, int hi) {
  const i32x4a lo = *reinterpret_cast<const i32x4a*>(Vs + VSWZ(32 * D0 + r32, 32 * hi)), hi4 = *reinterpret_cast<const i32x4a*>(Vs + VSWZ(32 * D0 + r32, 32 * hi + 16));
  const i32x8 vb = __builtin_shufflevector(lo, hi4, 0, 1, 2, 3, 4, 5, 6, 7);
  if (D0 == 0) asm volatile("s_nop 1\n\tv_mfma_f32_32x32x64_f8f6f4 %0, %1, %2, %0" : "+v"(od) : "v"(pa), "v"(vb));
  else asm volatile("v_mfma_f32_32x32x64_f8f6f4 %0, %1, %2, %0" : "+v"(od) : "v"(pa), "v"(vb));
}
__device__ __forceinline__ void pv_d0(f32x16* o, const unsigned char* Vs, i32x8 pa, int r32, int hi) {
  pv_one<0>(o[0], Vs, pa, r32, hi); pv_one<1>(o[1], Vs, pa, r32, hi); pv_one<2>(o[2], Vs, pa, r32, hi); pv_one<3>(o[3], Vs, pa, r32, hi);
}
#define O_SETTLE() do { asm volatile("s_nop 15\n\ts_nop 7" ::: "memory"); SBAR(); } while (0)

template <typename TQ>
__device__ __forceinline__ void attn_dense_body(const unsigned char* __restrict__ Qb, const unsigned char* __restrict__ Kh, const unsigned char* __restrict__ Vh,
                                                unsigned char* Ob, const unsigned short* __restrict__ Zb, int seq, char* lds) {
  using St = Stage<bf16>; using SQ = Stage<TQ>;
  int tid = threadIdx.x; asm volatile("" : "+v"(tid));
  const int wid = tid >> 6, lane = tid & 63, r32 = lane & 31, hi = lane >> 5;
  unsigned char* V_lds = (unsigned char*)lds; unsigned char* K_lds = (unsigned char*)(lds + 2 * SHM_V);
  float* ws = (float*)(lds + 65536) + wid * 64; float* li_l = ws; float* al_l = ws + 32;
  float m_reg = -1e30f, l_reg = 0; f32x16 o[4] = {}; i32x8 qr[2];
  const unsigned char* Qw = Qb + (long)(wid * QBLK + r32) * LDQ + hi * 32;
#pragma unroll
  for (int s2 = 0; s2 < 2; ++s2) { const i32x4a lo = *reinterpret_cast<const i32x4a*>(Qw + 64 * s2), hi4 = *reinterpret_cast<const i32x4a*>(Qw + 64 * s2 + 16); qr[s2] = __builtin_shufflevector(lo, hi4, 0, 1, 2, 3, 4, 5, 6, 7); }
  const int kr = tid >> 3, kc = (tid & 7) * 16, kst = KSWZ(kr, kc);
  const int vr = tid >> 2, vc = (tid & 3) * 16, vst = VSWZ(vr, vc);
  struct { i32x4a vs, ks; } sr_[SDEPTH];
#define SLOAD(i, k0) do { sr_[i].vs = *reinterpret_cast<const i32x4a*>(Vh + (long)vr * 2048 + (k0) + vc); \
    sr_[i].ks = *reinterpret_cast<const i32x4a*>(Kh + (long)((k0) + kr) * LDK + kc); } while (0)
#define SWRITE(b, i) do { *(i32x4a*)(V_lds + (b) * SHM_V + vst) = sr_[i].vs; *(i32x4a*)(K_lds + (b) * SHM_K + kst) = sr_[i].ks; } while (0)
#define SWAIT() do { if constexpr (SDEPTH == 2) asm volatile("s_waitcnt vmcnt(2)" ::: "memory"); else asm volatile("s_waitcnt vmcnt(0)" ::: "memory"); } while (0)
#define RESC(a) do { if (__any((a) < 1.f)) { if (hi == 0) al_l[r32] = (a); asm volatile("s_waitcnt lgkmcnt(0)" ::: "memory"); O_SETTLE(); \
    for (int d = 0; d < 4; ++d) for (int r = 0; r < 16; ++r) o[d][r] *= al_l[crow(r, hi)]; } } while (0)
  f32x16 pA0, pA1, pB0, pB1; float mnA, mnB, alA, alB; i32x8 pa; const int NT = seq / KVBLK;
  constexpr int SE = 0, SO = SDEPTH - 1;
  SLOAD(SE, 0); asm volatile("s_waitcnt vmcnt(0)" ::: "memory"); SWRITE(0, SE); __syncthreads();
  qkt(pA0, pA1, K_lds, qr, r32, hi); partialSM(pA0, pA1, m_reg, mnA, alA);
  SLOAD(SO, KVBLK); if constexpr (SDEPTH == 2) { if (2 < NT) SLOAD(SE, 2 * KVBLK); }
  SWAIT(); SWRITE(1, SO); __syncthreads();
  for (int j = 1; j + 1 < NT; j += 2) {
    SBAR(); qkt(pB0, pB1, K_lds + SHM_K, qr, r32, hi);
    finishSM(pA0, pA1, alA, l_reg, pa); SBAR();
    SLOAD(SO, (j + SDEPTH) * KVBLK); SBAR();
    pv_d0(o, V_lds, pa, r32, hi); partialSM(pB0, pB1, m_reg, mnB, alB);
    __syncthreads(); SWAIT(); SWRITE(0, SE);
    RESC(alB); __syncthreads();
    SBAR(); qkt(pA0, pA1, K_lds, qr, r32, hi);
    finishSM(pB0, pB1, alB, l_reg, pa); SBAR();
    if (SDEPTH == 1 || j + 3 < NT) SLOAD(SE, (j + 1 + SDEPTH) * KVBLK); SBAR();
    pv_d0(o, V_lds + SHM_V, pa, r32, hi); partialSM(pA0, pA1, m_reg, mnA, alA);
    __syncthreads(); SWAIT(); SWRITE(1, SO);
    RESC(alA); __syncthreads();
  }
  SBAR(); qkt(pB0, pB1, K_lds + SHM_K, qr, r32, hi);
  finishSM(pA0, pA1, alA, l_reg, pa); SBAR();
  pv_d0(o, V_lds, pa, r32, hi); partialSM(pB0, pB1, m_reg, mnB, alB);
  __syncthreads(); RESC(alB);
  finishSM(pB0, pB1, alB, l_reg, pa); SBAR();
  pv_d0(o, V_lds + SHM_V, pa, r32, hi);
  if (hi == 0) li_l[r32] = l_reg; asm volatile("s_waitcnt lgkmcnt(0)" ::: "memory"); O_SETTLE();
  float rli[16];
#pragma unroll
  for (int r = 0; r < 16; ++r) rli[r] = __builtin_amdgcn_rcpf(li_l[crow(r, hi)]) * (1.f / V8_SCALE);
  __syncthreads();
  { unsigned short* stg = (unsigned short*)(lds + wid * 8192);
#pragma unroll
    for (int r = 0; r < 16; ++r) { const int orow = crow(r, hi);
#pragma unroll
      for (int d0 = 0; d0 < 4; ++d0) { unsigned u = __builtin_bit_cast(unsigned, o[d0][r] * rli[r]); u = (u + 0x7fffu + ((u >> 16) & 1u)) >> 16; stg[orow * 128 + d0 * 32 + r32] = (unsigned short)u; } }
    asm volatile("s_waitcnt lgkmcnt(0)" ::: "memory");
    unsigned char* Ow = Ob + (long)(wid * QBLK) * LDO; const unsigned short* Zw = Zb + (long)(wid * QBLK) * LDZ;
#pragma unroll 2
    for (int i = 0; i < 8; ++i) { const int row = i * 4 + (lane >> 4), ch = lane & 15;
      const u32x4 ov = *(const u32x4*)(stg + row * 128 + ch * 8); const u32x4 zv = *(const u32x4*)(Zw + (long)row * LDZ + ch * 8); float g8[8];
#pragma unroll
      for (int e = 0; e < 4; ++e) { const float z0 = __builtin_bit_cast(float, zv[e] << 16), z1 = __builtin_bit_cast(float, zv[e] & 0xffff0000u);
        g8[2 * e] = __builtin_bit_cast(float, ov[e] << 16) * (z0 * __builtin_amdgcn_rcpf(1.f + __expf(-z0))) * A8_SCALE; g8[2 * e + 1] = __builtin_bit_cast(float, ov[e] & 0xffff0000u) * (z1 * __builtin_amdgcn_rcpf(1.f + __expf(-z1))) * A8_SCALE; }
      typedef unsigned u32x2o __attribute__((ext_vector_type(2)));
      u32x2o w; w.x = pk4f8(g8[0], g8[1], g8[2], g8[3]); w.y = pk4f8(g8[4], g8[5], g8[6], g8[7]);
      *(u32x2o*)(Ow + (long)row * LDO + ch * 8) = w; } }
#undef SLOAD
#undef SWRITE
#undef SWAIT
#undef RESC
}

}
namespace ml {
typedef short bf16x8 __attribute__((ext_vector_type(8)));
typedef short v4i16 __attribute__((ext_vector_type(4)));
typedef float f32x4 __attribute__((ext_vector_type(4)));
typedef float f32x16 __attribute__((ext_vector_type(16)));
typedef unsigned u32x4 __attribute__((ext_vector_type(4)));
typedef unsigned u32x2 __attribute__((ext_vector_type(2)));
#define ML_LAS __attribute__((address_space(3)))
constexpr int BUFB = 65536, Q_OFF = 0, K_OFF = 16384, V_OFF = 32768;
constexpr int P_OFF = 131072, DENP_OFF = P_OFF + 8192, QNP_OFF = DENP_OFF + 512, VEC_OFF = QNP_OFF + 2048, VEC_SLOT = 2 * 256, VR_OFF = VEC_OFF + 2 * VEC_SLOT, NB_OFF = VR_OFF + 8 * 256, LDS_END = NB_OFF + 512;
__device__ __forceinline__ unsigned fxor(unsigned row) { return ((row & 3u) << 2) | ((row >> 2) & 3u); }
__device__ __forceinline__ unsigned off_b(unsigned row, unsigned ch) { return 256u * row + 16u * (ch ^ fxor(row)); }
__device__ __forceinline__ unsigned off_p(unsigned t, unsigned ch) { return 128u * t + 16u * (ch ^ (t & 7u)); }
__device__ __forceinline__ unsigned tr_addr(unsigned lane, unsigned c, unsigned ks, unsigned t) { const unsigned h = lane >> 5, blk = (lane >> 4) & 1u, q = (lane & 15u) >> 2, p = lane & 3u; return off_b(16u * ks + 8u * h + 4u * t + q, 4u * c + 2u * blk + (p >> 1)) + 8u * (p & 1u); }
__device__ __forceinline__ unsigned tr_addr16(unsigned lane, unsigned c, unsigned ks, unsigned t) { const unsigned g = lane >> 4, q = (lane & 15u) >> 2, p = lane & 3u; return off_b(32u * ks + 8u * g + 4u * t + q, 2u * c + (p >> 1)) + 8u * (p & 1u); }
__device__ __forceinline__ v4i16 trrd(ML_LAS unsigned char* p) { return __builtin_amdgcn_ds_read_tr16_b64_v4i16((ML_LAS v4i16*)p); }
template <int OFF> __device__ __forceinline__ v4i16 trra(unsigned addr) { v4i16 r; asm volatile("ds_read_b64_tr_b16 %0, %1 offset:%2" : "=v"(r) : "v"(addr), "i"(OFF) : "memory"); return r; }
__device__ __forceinline__ void glds16(const void* gsrc, unsigned lds_dst) { unsigned keep;
    asm volatile("s_mov_b32 %0, m0\n\ts_mov_b32 m0, %2\n\ts_nop 0\n\tglobal_load_lds_dwordx4 %1, off\n\ts_mov_b32 m0, %0" : "=&s"(keep) : "v"(gsrc), "s"(lds_dst) : "memory"); }
#define ML_TRWAIT() do { asm volatile("s_waitcnt lgkmcnt(0)" ::: "memory"); __builtin_amdgcn_sched_barrier(0); } while (0)
__device__ __forceinline__ bf16x8 cat8(v4i16 lo, v4i16 hi) { return (bf16x8){lo[0], lo[1], lo[2], lo[3], hi[0], hi[1], hi[2], hi[3]}; }
__device__ __forceinline__ unsigned pkbf(float lo, float hi) { unsigned r; asm volatile("v_cvt_pk_bf16_f32 %0, %1, %2" : "=v"(r) : "v"(lo), "v"(hi)); return r; }
__device__ __forceinline__ float s2f(short x) { return __builtin_bit_cast(float, (unsigned)(unsigned short)x << 16); }
__device__ __forceinline__ bf16x8 pack8(float a0, float a1, float a2, float a3, float a4, float a5, float a6, float a7) { u32x4 w = {pkbf(a0, a1), pkbf(a2, a3), pkbf(a4, a5), pkbf(a6, a7)}; return __builtin_bit_cast(bf16x8, w); }
__device__ __forceinline__ float scan_add(float v, int lane) {
#pragma unroll
    for (int o = 1; o < 64; o <<= 1) { const float u = __shfl_up(v, o); if (lane >= o) v += u; }
    return v; }
__device__ __forceinline__ float scan_max(float v, int lane) {
#pragma unroll
    for (int o = 1; o < 64; o <<= 1) { const float u = __shfl_up(v, o); if (lane >= o) v = fmaxf(v, u); }
    return v; }
#define ML_OPAQUE_LANE(ln) unsigned ln = (unsigned)lane; asm volatile("" : "+v"(ln))
__device__ __forceinline__ float rdlane(float v, int l) { return __builtin_bit_cast(float, __builtin_amdgcn_readlane(__builtin_bit_cast(int, v), l)); }

__device__ __forceinline__ void stage(ML_LAS unsigned char* lds, int bsel, int c, int b, int hd, int dir, const unsigned short* MQ, const unsigned short* MK, const unsigned short* MV, int wid, int lane) {
    const int rl = lane >> 4, pos = lane & 15;
#pragma unroll
    for (int half = 0; half < 2; ++half) {
        const int grp = wid + 8 * half, row = 4 * grp + rl, ch = pos ^ ((rl << 2) | (grp & 3));
        const int p = 64 * c + row, tok = dir ? (SEQ - 1 - p) : p; const size_t trow = (size_t)b * SEQ + tok;
        ML_LAS unsigned char* d = lds + bsel * BUFB + grp * 1024;
        __builtin_amdgcn_global_load_lds((const unsigned*)(MQ + trow * 512 + hd * 128 + 8 * ch), (ML_LAS unsigned*)(d + Q_OFF), 16, 0, 0);
        __builtin_amdgcn_global_load_lds((const unsigned*)(MK + trow * 512 + hd * 128 + 8 * ch), (ML_LAS unsigned*)(d + K_OFF), 16, 0, 0);
        __builtin_amdgcn_global_load_lds((const unsigned*)(MV + trow * 1024 + hd * 256 + 8 * ch), (ML_LAS unsigned*)(d + V_OFF), 16, 0, 0);
        __builtin_amdgcn_global_load_lds((const unsigned*)(MV + trow * 1024 + hd * 256 + 128 + 8 * ch), (ML_LAS unsigned*)(d + V_OFF + 16384), 16, 0, 0);
    }
}

#define ML_DPPF(old_, src_, ctrl_, rm_) __builtin_bit_cast(float, __builtin_amdgcn_update_dpp(__builtin_bit_cast(int, (float)(old_)), __builtin_bit_cast(int, (float)(src_)), ctrl_, rm_, 0xf, false))
__device__ __forceinline__ float dscan_add(float v) {
    v += ML_DPPF(0.f, v, 0x111, 0xf); v += ML_DPPF(0.f, v, 0x112, 0xf); v += ML_DPPF(0.f, v, 0x114, 0xf); v += ML_DPPF(0.f, v, 0x118, 0xf);
    v += ML_DPPF(0.f, v, 0x142, 0xa); v += ML_DPPF(0.f, v, 0x143, 0xc); return v; }
__device__ __forceinline__ float dscan_max(float v) { const float NI = -3.0e38f;
    v = fmaxf(v, ML_DPPF(NI, v, 0x111, 0xf)); v = fmaxf(v, ML_DPPF(NI, v, 0x112, 0xf)); v = fmaxf(v, ML_DPPF(NI, v, 0x114, 0xf)); v = fmaxf(v, ML_DPPF(NI, v, 0x118, 0xf));
    v = fmaxf(v, ML_DPPF(NI, v, 0x142, 0xa)); v = fmaxf(v, ML_DPPF(NI, v, 0x143, 0xc)); return v; }

template <int MODE> __device__ __forceinline__ void mlstm_item(unsigned char* ws, ML_LAS unsigned char* lds, int item, int tid) {
    const int lane = tid & 63, wid = __builtin_amdgcn_readfirstlane(tid >> 6);
    const int b = item >> 3, hd = (item >> 1) & 3, dir = item & 1;
    const float* GT = (const float*)(ws + WS_GATES) + dir * 8 + hd;
    ML_LAS float* DENP = (ML_LAS float*)(lds + DENP_OFF); ML_LAS float* QNP = (ML_LAS float*)(lds + QNP_OFF); ML_LAS float* NB = (ML_LAS float*)(lds + NB_OFF + wid * 64);
    unsigned dq0, dq1, dv0, dv1;
    { const int rl = lane >> 4, pos = lane & 15;
      const int g0 = wid, g1 = wid + 8; const int r0 = 4 * g0 + rl, r1 = 4 * g1 + rl; const int c0 = pos ^ ((rl << 2) | (g0 & 3)), c1 = pos ^ ((rl << 2) | (g1 & 3));
      const int m0 = dir ? 63 - r0 : r0, m1 = dir ? 63 - r1 : r1;
      dq0 = (unsigned)(m0 * 1024 + 16 * c0); dq1 = (unsigned)(m1 * 1024 + 16 * c1); dv0 = (unsigned)(m0 * 2048 + 16 * c0); dv1 = (unsigned)(m1 * 2048 + 16 * c1); }
    const unsigned goff = (unsigned)((dir ? 63 - lane : lane) * 64);
    unsigned trL0, trL1, trX;
    { const unsigned h = lane >> 5, blk = (lane >> 4) & 1u, q = (lane & 15u) >> 2, p = lane & 3u; const unsigned A = 256u * (8u * h + q) + 8u * (p & 1u), lo = 2u * blk + (p >> 1);
      trL0 = A + 16u * (lo ^ ((2u * h) & 3u)); trL1 = A + 16u * (lo ^ ((2u * h + 1u) & 3u)) + 1024u; trX = 64u * q; }
    f32x16 C[4]; f32x4 n4 = {0.f, 0.f, 0.f, 0.f};
#pragma unroll
    for (int i = 0; i < 4; ++i) C[i] = (f32x16){0.f};
    const char* gq = (const char*)(ws + WS_MQ) + ((size_t)b * SEQ * 512 + hd * 128) * 2; const char* gk = (const char*)(ws + WS_MK) + ((size_t)b * SEQ * 512 + hd * 128) * 2;
    const char* gv = (const char*)(ws + WS_MV) + ((size_t)b * SEQ * 1024 + hd * 256) * 2; const char* gg = (const char*)GT + (size_t)b * SEQ * 64;
    unsigned char* ho = ws + (dir ? WS_HB : WS_HF) + ((size_t)(b * 4 + hd) * 32) * 32768 + wid * 4096 + lane * 16;
    const unsigned lds0 = (unsigned)(uintptr_t)lds;
#define ML_TB(c_) (MODE == 1 ? (dir ? (SEQ - 64) : 0) : (dir ? (SEQ - 64 * ((c_) + 1)) : 64 * (c_)))
#define ML_STAGE(bsel_, c_) do { const int tb_ = ML_TB(c_); const unsigned d_ = (unsigned)__builtin_amdgcn_readfirstlane((int)(lds0 + (bsel_) * BUFB + wid * 1024)); \
        const char* q_ = gq + (size_t)tb_ * 1024; const char* k_ = gk + (size_t)tb_ * 1024; const char* v_ = gv + (size_t)tb_ * 2048; \
        glds16(q_ + dq0, d_ + Q_OFF); glds16(q_ + dq1, d_ + Q_OFF + 8192); glds16(k_ + dq0, d_ + K_OFF); glds16(k_ + dq1, d_ + K_OFF + 8192); \
        glds16(v_ + dv0, d_ + V_OFF); glds16(v_ + dv1, d_ + V_OFF + 8192); glds16(v_ + 256 + dv0, d_ + V_OFF + 16384); glds16(v_ + 256 + dv1, d_ + V_OFF + 16384 + 8192); } while (0)
#define ML_GATES(c_, gi_, gf_) do { const char* g_ = gg + (size_t)ML_TB(c_) * 64 + goff; gi_ = *(const float*)g_; gf_ = *(const float*)(g_ + 16); } while (0)
#define ML_VEC(cc_, gi_, gf_, sc_out_) do { ML_LAS float* T_ = (ML_LAS float*)(lds + VEC_OFF + ((cc_) & 1) * VEC_SLOT); \
        const float bcs_ = dscan_add(gf_), cx_ = (gi_) - bcs_, cm_ = dscan_max(cx_), M_ = fmaxf(m, cm_); const float g_ = rdlane(bcs_, 63), M63_ = rdlane(M_, 63); \
        T_[lane] = __expf(cx_ - M63_); T_[64 + lane] = __expf(-(bcs_ + M63_)); \
        sc_out_ = __expf(m - M63_); m = g_ + M63_; } while (0)
    float m = 0.f, sc, sc_n = 1.f, gi_a, gf_a, gi_b = 0.f, gf_b = 0.f; u32x4 pend[4] = {{0u, 0u, 0u, 0u}, {0u, 0u, 0u, 0u}, {0u, 0u, 0u, 0u}, {0u, 0u, 0u, 0u}};
    ML_STAGE(0, 0); ML_GATES(0, gi_a, gf_a); ML_VEC(0, gi_a, gf_a, sc); ML_GATES(1, gi_a, gf_a);
    for (int c = 0; c < SEQ / 64; ++c) {
        const int bsel = c & 1;
        ML_LAS unsigned char* bQ = lds + bsel * BUFB + Q_OFF; ML_LAS unsigned char* bK = lds + bsel * BUFB + K_OFF; ML_LAS unsigned char* bV = lds + bsel * BUFB + V_OFF;
        ML_LAS float* VWE = (ML_LAS float*)(lds + VEC_OFF + bsel * VEC_SLOT); ML_LAS float* VEMT = VWE + 64; ML_LAS float* VR = (ML_LAS float*)(lds + VR_OFF + wid * 256);
        asm volatile("s_waitcnt vmcnt(0) lgkmcnt(0)" ::: "memory"); __builtin_amdgcn_s_barrier(); asm volatile("" ::: "memory");
        if (c > 0) { unsigned char* hc = ho + (size_t)(c - 1) * 32768; *(u32x4*)(hc) = pend[0]; *(u32x4*)(hc + 1024) = pend[1]; *(u32x4*)(hc + 2048) = pend[2]; *(u32x4*)(hc + 3072) = pend[3]; }
        if (c + 1 < SEQ / 64) { ML_STAGE(bsel ^ 1, c + 1);
            if (c + 2 < SEQ / 64) ML_GATES(c + 2, gi_b, gf_b);
            ML_VEC(c + 1, gi_a, gf_a, sc_n); }
        if (MODE == 2) { asm volatile("s_waitcnt lgkmcnt(0)" ::: "memory"); __builtin_amdgcn_s_barrier(); continue; }
        { ML_OPAQUE_LANE(ln); const unsigned r15 = ln & 15u, kg = ln >> 4; const int tj = wid >> 1, sb = (wid & 1) * 2; const unsigned t = 16u * tj + r15;
          const unsigned xq = fxor(r15) << 4;
          ML_LAS unsigned char* qrow = bQ + 256u * t;
          bf16x8 qf[4];
#pragma unroll
          for (int ks = 0; ks < 4; ++ks) qf[ks] = *(const ML_LAS bf16x8*)(qrow + (((4u * ks + kg) << 4) ^ xq));
          float dsum = 0.f; const unsigned hb = 8u * (kg & 1u), kh = kg >> 1;
#pragma unroll
          for (int u = 0; u < 2; ++u) { const unsigned si = sb + u; ML_LAS unsigned char* krow = bK + 256u * (16u * si + r15) + hb;
              f32x4 acc = {0.f, 0.f, 0.f, 0.f};
#pragma unroll
              for (int ks = 0; ks < 4; ++ks) { const unsigned g2 = 4u * ks + 2u * kh;
                  const u32x2 lo = *(const ML_LAS u32x2*)(krow + ((g2 << 4) ^ xq)), hi = *(const ML_LAS u32x2*)(krow + (((g2 + 1u) << 4) ^ xq));
                  const u32x4 kw = {lo.x, lo.y, hi.x, hi.y};
                  acc = __builtin_amdgcn_mfma_f32_16x16x32_bf16(__builtin_bit_cast(bf16x8, kw), qf[ks], acc, 0, 0, 0); }
              const unsigned s0 = 16u * si + 4u * kg; const f32x4 ws4 = *(const ML_LAS f32x4*)(VWE + s0);
              float p[4];
#pragma unroll
              for (int r = 0; r < 4; ++r) { p[r] = (s0 + r <= t) ? acc[r] : 0.f; dsum = fmaf(p[r], ws4[r], dsum); }
              const u32x2 pw = {pkbf(p[0], p[1]), pkbf(p[2], p[3])};
              *(ML_LAS u32x2*)(lds + P_OFF + 128u * t + (((2u * si + kh) ^ (t & 7u)) << 4) + hb) = pw; }
          dsum += __shfl_xor(dsum, 16); dsum += __shfl_xor(dsum, 32);
          if (ln < 16u) DENP[(wid & 1) * 64 + t] = dsum; }
        n4 = n4 * sc;
        { ML_OPAQUE_LANE(ln); const unsigned r15 = ln & 15u, kg = ln >> 4; if (r15 == 0) *(ML_LAS f32x4*)(NB + 4 * kg) = n4;
          const f32x4 nA = *(const ML_LAS f32x4*)(NB + 0), nB = *(const ML_LAS f32x4*)(NB + 4), nC = *(const ML_LAS f32x4*)(NB + 8), nD = *(const ML_LAS f32x4*)(NB + 12);
          const unsigned t = ln; ML_LAS unsigned char* qrow = bQ + 256u * t; const unsigned xq = fxor(t) << 4;
          const bf16x8 c0 = *(const ML_LAS bf16x8*)(qrow + (((2u * wid) << 4) ^ xq)), c1 = *(const ML_LAS bf16x8*)(qrow + (((2u * wid + 1u) << 4) ^ xq));
          float qn = 0.f;
#pragma unroll
          for (int e = 0; e < 4; ++e) { qn = fmaf(s2f(c0[e]), nA[e], qn); qn = fmaf(s2f(c0[4 + e]), nC[e], qn); qn = fmaf(s2f(c1[e]), nB[e], qn); qn = fmaf(s2f(c1[4 + e]), nD[e], qn); }
          QNP[wid * 64 + t] = qn; }
        f32x16 Y0, Y1;
        { ML_OPAQUE_LANE(ln); const unsigned r31 = ln & 31u, h5 = ln >> 5; const unsigned xq = fxor(r31) << 4; ML_LAS unsigned char* q0 = bQ + 256u * r31; ML_LAS unsigned char* q1 = q0 + 256u * 32u;
#pragma unroll
          for (int i = 0; i < 4; ++i) { C[i] = C[i] * sc;
#pragma unroll
              for (int s = 0; s < 2; ++s) { const bf16x8 bfr = pack8(C[i][8 * s + 0], C[i][8 * s + 1], C[i][8 * s + 2], C[i][8 * s + 3], C[i][8 * s + 4], C[i][8 * s + 5], C[i][8 * s + 6], C[i][8 * s + 7]);
                  const unsigned co = ((4u * i + 2u * s + h5) << 4) ^ xq;
                  const bf16x8 a0 = *(const ML_LAS bf16x8*)(q0 + co), a1 = *(const ML_LAS bf16x8*)(q1 + co);
                  if (i == 0 && s == 0) { Y0 = __builtin_amdgcn_mfma_f32_32x32x16_bf16(a0, bfr, (f32x16){0.f}, 0, 0, 0); Y1 = __builtin_amdgcn_mfma_f32_32x32x16_bf16(a1, bfr, (f32x16){0.f}, 0, 0, 0); }
                  else { Y0 = __builtin_amdgcn_mfma_f32_32x32x16_bf16(a0, bfr, Y0, 0, 0, 0); Y1 = __builtin_amdgcn_mfma_f32_32x32x16_bf16(a1, bfr, Y1, 0, 0, 0); } } } }
        bf16x8 vw[4];
        { ML_OPAQUE_LANE(ln); const unsigned h5 = ln >> 5, kg = ln >> 4; const unsigned vt = wid >> 2, vc = wid & 3; bf16x8 vf[4];
          ML_LAS unsigned char* v0 = bV + 16384u * vt + ((64u * vc) ^ trX); ML_LAS unsigned char* va = v0 + trL0; ML_LAS unsigned char* vb = v0 + trL1;
#pragma unroll
          for (int ks = 0; ks < 4; ++ks) vf[ks] = cat8(trrd(va + 4096 * ks), trrd(vb + 4096 * ks));
          ML_LAS float* vwe = VWE + 8 * h5;
#pragma unroll
          for (int ks = 0; ks < 4; ++ks) { const f32x4 w0 = *(const ML_LAS f32x4*)(vwe + 16 * ks), w1 = *(const ML_LAS f32x4*)(vwe + 16 * ks + 4);
              vw[ks] = pack8(s2f(vf[ks][0]) * w0[0], s2f(vf[ks][1]) * w0[1], s2f(vf[ks][2]) * w0[2], s2f(vf[ks][3]) * w0[3], s2f(vf[ks][4]) * w1[0], s2f(vf[ks][5]) * w1[1], s2f(vf[ks][6]) * w1[2], s2f(vf[ks][7]) * w1[3]); }
          ML_LAS unsigned char* ka = bK + trL0; ML_LAS unsigned char* kb = bK + trL1;
#pragma unroll
          for (int i = 0; i < 4; ++i) { const unsigned xo = (64u * i) ^ trX;
#pragma unroll
              for (int ks = 0; ks < 4; ++ks) C[i] = __builtin_amdgcn_mfma_f32_32x32x16_bf16(cat8(trrd(ka + xo + 4096 * ks), trrd(kb + xo + 4096 * ks)), vw[ks], C[i], 0, 0, 0); }
          ML_LAS unsigned char* t16a = bK + tr_addr16(ln, wid, 0, 0); ML_LAS unsigned char* t16b = bK + tr_addr16(ln, wid, 0, 1);
#pragma unroll
          for (int ks = 0; ks < 2; ++ks) { const bf16x8 af = cat8(trrd(t16a + 8192 * ks), trrd(t16b + 8192 * ks));
              const f32x4 w0 = *(const ML_LAS f32x4*)(VWE + 32 * ks + 8 * kg), w1 = *(const ML_LAS f32x4*)(VWE + 32 * ks + 8 * kg + 4);
              n4 = __builtin_amdgcn_mfma_f32_16x16x32_bf16(af, pack8(w0[0], w0[1], w0[2], w0[3], w1[0], w1[1], w1[2], w1[3]), n4, 0, 0, 0); } }
        asm volatile("s_waitcnt lgkmcnt(0)" ::: "memory"); __builtin_amdgcn_s_barrier(); asm volatile("" ::: "memory");
        { ML_OPAQUE_LANE(ln); const unsigned r31 = ln & 31u, h5 = ln >> 5;
          ML_LAS unsigned char* p0 = lds + P_OFF + 128u * r31; ML_LAS unsigned char* p1 = p0 + 128u * 32u; const unsigned xp = (r31 & 7u) << 4;
#pragma unroll
          for (int ks = 0; ks < 4; ++ks) { const unsigned co = ((2u * ks + h5) << 4) ^ xp;
              const bf16x8 a0 = *(const ML_LAS bf16x8*)(p0 + co), a1 = *(const ML_LAS bf16x8*)(p1 + co);
              Y0 = __builtin_amdgcn_mfma_f32_32x32x16_bf16(a0, vw[ks], Y0, 0, 0, 0); Y1 = __builtin_amdgcn_mfma_f32_32x32x16_bf16(a1, vw[ks], Y1, 0, 0, 0); } }
        { ML_OPAQUE_LANE(ln); const unsigned t = ln; float qs = 0.f;
#pragma unroll
          for (int w8 = 0; w8 < 8; ++w8) qs += QNP[w8 * 64 + t];
          const float dn = DENP[t] + DENP[64 + t] + qs; VR[t] = 1.f / fmaxf(fabsf(dn), VEMT[t]); }
        { ML_OPAQUE_LANE(ln); const unsigned h5 = ln >> 5; ML_LAS float* vr = VR + 4 * h5;
#pragma unroll
          for (int qp = 0; qp < 2; ++qp) { const f32x4 ra = *(const ML_LAS f32x4*)(vr + 16 * qp), rb = *(const ML_LAS f32x4*)(vr + 16 * qp + 8), rc = *(const ML_LAS f32x4*)(vr + 32 + 16 * qp), rd = *(const ML_LAS f32x4*)(vr + 32 + 16 * qp + 8);
              const int o = 8 * qp;
              const u32x4 w0 = {pkbf(Y0[o + 0] * ra[0], Y0[o + 1] * ra[1]), pkbf(Y0[o + 2] * ra[2], Y0[o + 3] * ra[3]), pkbf(Y0[o + 4] * rb[0], Y0[o + 5] * rb[1]), pkbf(Y0[o + 6] * rb[2], Y0[o + 7] * rb[3])};
              const u32x4 w1 = {pkbf(Y1[o + 0] * rc[0], Y1[o + 1] * rc[1]), pkbf(Y1[o + 2] * rc[2], Y1[o + 3] * rc[3]), pkbf(Y1[o + 4] * rd[0], Y1[o + 5] * rd[1]), pkbf(Y1[o + 6] * rd[2], Y1[o + 7] * rd[3])};
              pend[qp] = w0; pend[2 + qp] = w1; } }
        asm volatile("" : "+v"(gi_b), "+v"(gf_b));
        sc = sc_n; gi_a = gi_b; gf_a = gf_b;
    }
    { unsigned char* hc = ho + (size_t)(SEQ / 64 - 1) * 32768; *(u32x4*)(hc) = pend[0]; *(u32x4*)(hc + 1024) = pend[1]; *(u32x4*)(hc + 2048) = pend[2]; *(u32x4*)(hc + 3072) = pend[3]; }
#undef ML_STAGE
#undef ML_GATES
#undef ML_VEC
#undef ML_TB
    __syncthreads();
}
}

constexpr int NWAVES = 8;
constexpr int RING_BYTES = 131072;
constexpr int LDS_BYTES = 163840;
constexpr int XCH_OFF = RING_BYTES, ROPE_LDS_OFF = XCH_OFF + 8192, QKG_LDS_OFF = ROPE_LDS_OFF + 16384, SCL_LDS_OFF = QKG_LDS_OFF + 1024;
static_assert(SCL_LDS_OFF + 4096 <= LDS_BYTES - 16, "in-projection LDS map");
static_assert(ml::LDS_END <= LDS_BYTES, "mLSTM LDS map");
#define LAS __attribute__((address_space(3)))
#define GAS __attribute__((address_space(1)))
typedef unsigned v4u __attribute__((ext_vector_type(4)));
typedef unsigned v2u __attribute__((ext_vector_type(2)));
typedef float f32x4 __attribute__((ext_vector_type(4)));
#define LDS_WAIT() asm volatile("s_waitcnt lgkmcnt(0)" ::: "memory")

struct Args { const float* in[9]; float* out; unsigned char* ws; int ph_lo, ph_hi; };

__device__ __forceinline__ float wave_sum(float v) {
#pragma unroll
    for (int o = 1; o < 64; o <<= 1) v += __shfl_xor(v, o);
    return v;
}

#define XB_TMO      128
#define XB_XCNT(j)  (256  + 64 * (j))
#define XB_XSUB(j)  (1280 + 64 * (j))
#define XB_XGEN(j)  (2304 + 64 * (j))
#define XB_TOP      3328
#define XB_TOPGEN   3392
#define XCD_BAR_WORDS 3456
#define XB_SPIN_CAP (1u << 18)

__device__ __forceinline__ unsigned xb_ld(unsigned* p)              { return __hip_atomic_load(p, __ATOMIC_RELAXED, __HIP_MEMORY_SCOPE_AGENT); }
__device__ __forceinline__ unsigned xb_add(unsigned* p, unsigned v) { return __hip_atomic_fetch_add(p, v, __ATOMIC_RELAXED, __HIP_MEMORY_SCOPE_AGENT); }
__device__ __forceinline__ unsigned xb_xcc_id() { return (unsigned)__builtin_amdgcn_s_getreg((3 << 11) | 20) & 0xFu; }
#define XB_SPIN(cond, bar) do { unsigned _sp = 0; while (cond) { __builtin_amdgcn_s_sleep(1); \
    if ((++_sp & 255u) == 0u) { if (xb_ld(&(bar)[XB_TMO])) break; if (_sp > XB_SPIN_CAP) { atomicAdd(&(bar)[XB_TMO], 1u); break; } } } } while (0)

struct XcdBarrier {
    unsigned* bar; unsigned x;
    volatile LAS unsigned* st;
};

__device__ __forceinline__ XcdBarrier xcd_barrier_post(unsigned* bar, volatile LAS unsigned* st) {
    XcdBarrier b; b.bar = bar; b.x = xb_xcc_id(); b.st = st;
    if (threadIdx.x == 0) (void)xb_add(&bar[XB_XCNT(b.x)], 1u);
    return b;
}
__device__ __forceinline__ void xcd_barrier_complete(unsigned* bar, unsigned x, unsigned& nloc, unsigned& nx) {
    const unsigned G = gridDim.x * gridDim.y * gridDim.z;
    unsigned sum, cnt, mine, sp = 0u;
    for (;;) {
        sum = 0u; cnt = 0u; mine = 0u;
#pragma unroll
        for (unsigned j = 0; j < 16; ++j) { const unsigned c = xb_ld(&bar[XB_XCNT(j)]); sum += c; cnt += (c > 0u) ? 1u : 0u; mine = (j == x) ? c : mine; }
        if (sum == G) break;
        __builtin_amdgcn_s_sleep(1);
        if ((++sp & 255u) == 0u) { if (xb_ld(&bar[XB_TMO])) break; if (sp > XB_SPIN_CAP) { atomicAdd(&bar[XB_TMO], 1u); break; } }
    }
    nloc = mine > 0u ? mine : 1u; nx = cnt > 0u ? cnt : 1u;
}

__device__ __forceinline__ void xcd_barrier(const XcdBarrier& b) {
    asm volatile("s_waitcnt vmcnt(0)" ::: "memory");
    __syncthreads();
    if (threadIdx.x == 0) {
        unsigned* bar = b.bar;
        __builtin_amdgcn_s_waitcnt(0);
        unsigned nloc = b.st[0], nx = b.st[1];
        if (nloc == 0u) { xcd_barrier_complete(bar, b.x, nloc, nx); b.st[0] = nloc; b.st[1] = nx; }
        const unsigned old = xb_add(&bar[XB_XSUB(b.x)], 1u);
        const unsigned gen = old / nloc;
        if (old + 1u == (gen + 1u) * nloc) {
            __builtin_amdgcn_fence(__ATOMIC_RELEASE, "agent");
            asm volatile("s_waitcnt vmcnt(0)" ::: "memory");
            const unsigned og = xb_add(&bar[XB_TOP], 1u);
            const unsigned tg = og / nx;
            if (og + 1u == (tg + 1u) * nx) xb_add(&bar[XB_TOPGEN], 1u);
            else XB_SPIN(xb_ld(&bar[XB_TOPGEN]) == tg, bar);
            __builtin_amdgcn_fence(__ATOMIC_ACQUIRE, "agent");
            xb_add(&bar[XB_XGEN(b.x)], 1u);
            asm volatile("s_waitcnt vmcnt(0)" ::: "memory");
        } else {
            XB_SPIN(xb_ld(&bar[XB_XGEN(b.x)]) == gen, bar);
            __builtin_amdgcn_fence(__ATOMIC_ACQUIRE, "agent");
            asm volatile("s_waitcnt vmcnt(0)" ::: "memory");
        }
    }
    __syncthreads();
}

__device__ __forceinline__ int w1_dest_row(int n) {
    if (!HY_SEPARATE_ROPE && n < 1280) { const int s = n & 255; return (n & ~255) | (s & 0xC3) | ((s & 0x10) << 1) | ((s & 0x0C) << 1) | ((s & 0x20) >> 3); }
    if (n >= 2560 && n < 3072) return (n & ~12) | ((n & 4) << 1) | ((n & 8) >> 1);
    return n;
}
__device__ __forceinline__ int q8_dest_row(int n) { return n < NQA ? w1_dest_row(n) : n - (NB1 - NB0); }
__device__ __forceinline__ unsigned pk4i8(float a, float b, float c, float d) {
    int ia = (int)__builtin_rintf(a), ib = (int)__builtin_rintf(b), ic = (int)__builtin_rintf(c), id = (int)__builtin_rintf(d);
    ia = ia < -127 ? -127 : (ia > 127 ? 127 : ia); ib = ib < -127 ? -127 : (ib > 127 ? 127 : ib); ic = ic < -127 ? -127 : (ic > 127 ? 127 : ic); id = id < -127 ? -127 : (id > 127 ? 127 : id);
    return ((unsigned)ia & 0xffu) | (((unsigned)ib & 0xffu) << 8) | (((unsigned)ic & 0xffu) << 16) | ((unsigned)id << 24); }
template <int MODE>
__device__ __forceinline__ void p0_transpose_item(const float* W, int K, int ldw, int kb, int n0, void* WT, LAS float* scr, int lane, const LAS float* cinv) {
    const int k0 = 64 * kb;
#pragma unroll 8
    for (int i = 0; i < 32; ++i) { const int kk = 2 * i + (lane >> 5); scr[kk * 33 + (lane & 31)] = W[(size_t)(k0 + kk) * ldw + n0 + (lane & 31)]; }
    LDS_WAIT(); asm volatile("" ::: "memory");
    const int c = lane & 7;
#pragma unroll
    for (int j = 0; j < 4; ++j) { const int n = (lane >> 3) + 8 * j; const LAS float* s = scr + (8 * c) * 33 + n;
        if constexpr (MODE == 2) { const float ci = cinv[n];
            v2u o8; o8.x = pk4i8(s[0 * 33] * ci, s[1 * 33] * ci, s[2 * 33] * ci, s[3 * 33] * ci); o8.y = pk4i8(s[4 * 33] * ci, s[5 * 33] * ci, s[6 * 33] * ci, s[7 * 33] * ci);
            *(v2u*)((unsigned char*)WT + (size_t)q8_dest_row(n0 + n) * K + k0 + 8 * c) = o8; }
        else if constexpr (MODE == 3) { unsigned char* rowp = (unsigned char*)WT + (size_t)(n0 + n) * 4096;
            if (kb < 16) { v2u o8; o8.x = pk4f8(s[0 * 33] * W8_SCALE, s[1 * 33] * W8_SCALE, s[2 * 33] * W8_SCALE, s[3 * 33] * W8_SCALE); o8.y = pk4f8(s[4 * 33] * W8_SCALE, s[5 * 33] * W8_SCALE, s[6 * 33] * W8_SCALE, s[7 * 33] * W8_SCALE);
                *(v2u*)(rowp + k0 + 8 * c) = o8; }
            else { v4u o; o.x = pk2(s[0 * 33], s[1 * 33]); o.y = pk2(s[2 * 33], s[3 * 33]); o.z = pk2(s[4 * 33], s[5 * 33]); o.w = pk2(s[6 * 33], s[7 * 33]);
                *(v4u*)(rowp + 1024 + (size_t)(k0 - 1024 + 8 * c) * 2) = o; } }
        else { const float ws_ = (MODE == 1 && n0 + n < 3072) ? 0.08838834764831845f : 1.f;
            v4u o; o.x = pk2(s[0 * 33] * ws_, s[1 * 33] * ws_); o.y = pk2(s[2 * 33] * ws_, s[3 * 33] * ws_); o.z = pk2(s[4 * 33] * ws_, s[5 * 33] * ws_); o.w = pk2(s[6 * 33] * ws_, s[7 * 33] * ws_);
            const int nr = (MODE == 1) ? w1_dest_row(n0 + n) - NB0 : n0 + n;
            *(v4u*)((bf16*)WT + (size_t)nr * K + k0 + 8 * c) = o; } }
    LDS_WAIT(); asm volatile("" ::: "memory");
}
__device__ __forceinline__ void p0_q8_colblock(const float* w_in, unsigned char* ws, LAS unsigned char* lds, int cb, int tid, int wave, int lane) {
    const int n0 = cb < NQA / 32 ? 32 * cb : NB1 + 32 * (cb - NQA / 32);
    LAS float* red = (LAS float*)(lds + 8 * 16384);
    const int c4 = (lane & 7) * 4, kr = lane >> 3;
    const float* src = w_in + (size_t)(256 * wave + kr) * NPROJ + n0 + c4;
    f32x4 mx = {0.f, 0.f, 0.f, 0.f};
#pragma unroll 8
    for (int i = 0; i < 32; ++i) { const f32x4 v = *(const f32x4*)(src + (size_t)(8 * i) * NPROJ);
        mx.x = fmaxf(mx.x, fabsf(v.x)); mx.y = fmaxf(mx.y, fabsf(v.y)); mx.z = fmaxf(mx.z, fabsf(v.z)); mx.w = fmaxf(mx.w, fabsf(v.w)); }
#pragma unroll
    for (int o = 8; o < 64; o <<= 1) { mx.x = fmaxf(mx.x, __shfl_xor(mx.x, o)); mx.y = fmaxf(mx.y, __shfl_xor(mx.y, o)); mx.z = fmaxf(mx.z, __shfl_xor(mx.z, o)); mx.w = fmaxf(mx.w, __shfl_xor(mx.w, o)); }
    if (lane < 8) *(LAS f32x4*)(red + wave * 32 + c4) = mx;
    __syncthreads();
    if (tid < 32) { float m = red[tid];
#pragma unroll
        for (int w = 1; w < 8; ++w) m = fmaxf(m, red[w * 32 + tid]);
        m = fmaxf(m, 1e-30f); red[256 + tid] = 127.f / m; ((float*)(ws + WS_SW))[q8_dest_row(n0 + tid)] = m * (1.f / 127.f); }
    __syncthreads();
    LAS float* scr = (LAS float*)(lds + wave * 16384);
    for (int i = 0; i < 4; ++i) p0_transpose_item<2>(w_in, DM, NPROJ, 4 * wave + i, n0, ws + WS_W8T, scr, lane, red + 256);
    __syncthreads();
}
__device__ __forceinline__ float wave_max(float v) {
#pragma unroll
    for (int o = 1; o < 64; o <<= 1) v = fmaxf(v, __shfl_xor(v, o));
    return v;
}
__device__ __forceinline__ void rms_rows2_to_bf16(const float* xrow0, const float* xrow1, const float* g, bf16* orow0, bf16* orow1, unsigned char* frow0, unsigned char* frow1, float* sa0, float* sa1, int lane) {
    const f32x4* xa = (const f32x4*)xrow0 + lane; const f32x4* xb = (const f32x4*)xrow1 + lane; const f32x4* gr = (const f32x4*)g + lane;
    f32x4 v[8], w[8]; float s = 0.f, t = 0.f;
#pragma unroll
    for (int j = 0; j < 8; ++j) { v[j] = __builtin_nontemporal_load(xa + 64 * j); w[j] = __builtin_nontemporal_load(xb + 64 * j); }
#pragma unroll
    for (int j = 0; j < 8; ++j) { s += (v[j].x * v[j].x + v[j].y * v[j].y) + (v[j].z * v[j].z + v[j].w * v[j].w); t += (w[j].x * w[j].x + w[j].y * w[j].y) + (w[j].z * w[j].z + w[j].w * w[j].w); }
    const float r0 = 1.f / sqrtf(wave_sum(s) * (1.f / DM) + EPS), r1 = 1.f / sqrtf(wave_sum(t) * (1.f / DM) + EPS);
    float m0 = 0.f, m1 = 0.f;
#pragma unroll
    for (int j = 0; j < 8; ++j) { const f32x4 gg = gr[64 * j]; v[j] = v[j] * r0 * gg; w[j] = w[j] * r1 * gg;
        m0 = fmaxf(fmaxf(m0, fmaxf(fabsf(v[j].x), fabsf(v[j].y))), fmaxf(fabsf(v[j].z), fabsf(v[j].w))); m1 = fmaxf(fmaxf(m1, fmaxf(fabsf(w[j].x), fabsf(w[j].y))), fmaxf(fabsf(w[j].z), fabsf(w[j].w))); }
    m0 = fmaxf(wave_max(m0), 1e-30f); m1 = fmaxf(wave_max(m1), 1e-30f);
    const float i0 = 127.f / m0, i1 = 127.f / m1;
    if (lane == 0) { *sa0 = m0 * (1.f / 127.f); *sa1 = m1 * (1.f / 127.f); }
    v2u* o0 = (v2u*)orow0 + lane; v2u* o1 = (v2u*)orow1 + lane; unsigned* f0 = (unsigned*)frow0 + lane; unsigned* f1 = (unsigned*)frow1 + lane;
#pragma unroll
    for (int j = 0; j < 8; ++j) { v2u a, b;
        a.x = pk2(v[j].x, v[j].y); a.y = pk2(v[j].z, v[j].w); o0[64 * j] = a; f0[64 * j] = pk4i8(v[j].x * i0, v[j].y * i0, v[j].z * i0, v[j].w * i0);
        b.x = pk2(w[j].x, w[j].y); b.y = pk2(w[j].z, w[j].w); o1[64 * j] = b; f1[64 * j] = pk4i8(w[j].x * i1, w[j].y * i1, w[j].z * i1, w[j].w * i1); }
}
__device__ __forceinline__ void p0_prologue(const Args& a, LAS unsigned char* lds, int vcu, int G, int tid, int wave, int lane) {
    unsigned char* ws = a.ws;
    const float* w_in = a.in[3]; const float* w_out = a.in[8]; const float* norm_g = a.in[2];
    bf16* W2t = (bf16*)(ws + WS_W2T);
    const int gw = vcu * NWAVES + wave, NGW = G * NWAVES; const int gt = vcu * (NWAVES * 64) + tid, NGT = G * NWAVES * 64;
    for (int e = gt; e < 64 * 32; e += NGT) { const int pos = e >> 5, j = e & 31; const float inv = 1.0f / powf(10000.0f, (float)j * (1.0f / 32.0f)); const float ang = (float)pos * inv;
        float* R = (float*)(ws + WS_ROPE); R[2 * e] = cosf(ang); R[2 * e + 1] = sinf(ang); }
    for (int e = gt; e < 16 * DM; e += NGT) { const int g = e >> 11, k = e & (DM - 1); ((bf16*)(ws + WS_WGT))[(size_t)g * DM + k] = (bf16)f2bf(w_in[(size_t)k * NPROJ + NP256 + g]); }
    for (int cb = vcu; cb < NQ8 / 32; cb += G) p0_q8_colblock(w_in, ws, lds, cb, tid, wave, lane);
    LAS float* scr = (LAS float*)(lds + wave * 16384);
    constexpr int I_1 = (DM / 64) * ((NB1 - NB0) / 32), I_2 = (DM / 64) * (DM / 32);
    for (int it = gw; it < I_1 + I_2; it += NGW) {
        if (it < I_1) p0_transpose_item<1>(w_in, DM, NPROJ, it / ((NB1 - NB0) / 32), NB0 + 32 * (it % ((NB1 - NB0) / 32)), ws + WS_W1B, scr, lane, nullptr);
        else p0_transpose_item<3>(w_out, DM, DM, (it - I_1) / (DM / 32), 32 * ((it - I_1) % (DM / 32)), W2t, scr, lane, nullptr);
    }
    bf16* H = (bf16*)(ws + WS_H); unsigned char* H8 = (unsigned char*)a.out; float* SA = (float*)(ws + WS_SA);
    for (int m = gw; m < NTOK; m += 2 * NGW) { const int m1 = (m + NGW < NTOK) ? m + NGW : m;
        const float* xr0 = (m < TOK_PROMPT) ? a.in[0] + (size_t)m * DM : a.in[1] + (size_t)(m - TOK_PROMPT) * DM; const float* xr1 = (m1 < TOK_PROMPT) ? a.in[0] + (size_t)m1 * DM : a.in[1] + (size_t)(m1 - TOK_PROMPT) * DM;
        rms_rows2_to_bf16(xr0, xr1, norm_g, H + (size_t)m * DM, H + (size_t)m1 * DM, H8 + (size_t)m * DM, H8 + (size_t)m1 * DM, SA + m, SA + m1, lane); }
}

__device__ __forceinline__ void p2_qknorm_rope(const Args& a, int vcu, int G, int wave, int lane) {
    unsigned char* ws = a.ws; const float* R = (const float*)(ws + WS_ROPE);
    const int gw = vcu * NWAVES + wave, NGW = G * NWAVES;
    const int fj = lane & 31, c0 = (lane < 32) ? lane : 64 + (lane - 32), c1 = c0 + 32;
    const float gq0 = a.in[5][c0], gq1 = a.in[5][c1], gk0 = a.in[6][c0], gk1 = a.in[6][c1];
    for (int it = gw; it < NTOK * 10; it += NGW) {
        const int t = it / 10, slot = it - t * 10; const int tl = t & (SEQ - 1); const int pos = (lane < 32) ? (tl >> 6) : (tl & 63);
        bf16* p = (slot < 8) ? (bf16*)((unsigned char*)a.out + DO_Q) + (size_t)t * 1024 + slot * 128 : (bf16*)(ws + WS_AK) + (size_t)t * 256 + (slot - 8) * 128;
        const float x0 = bf2f(p[c0]), x1 = bf2f(p[c1]);
        const float r = 1.f / sqrtf(wave_sum(x0 * x0 + x1 * x1) * (1.f / 128.f) + EPS);
        const float y0 = x0 * r * ((slot < 8) ? gq0 : gk0), y1 = x1 * r * ((slot < 8) ? gq1 : gk1);
        const float cs = R[2 * (pos * 32 + fj)], sn = R[2 * (pos * 32 + fj) + 1];
        p[c0] = (bf16)f2bf(y0 * cs - y1 * sn); p[c1] = (bf16)f2bf(y1 * cs + y0 * sn);
    }
}

__device__ __forceinline__ void p4_mlstm_recurrent(const Args& a, LAS unsigned char* lds, int vcu, int G, int tid) {
    unsigned char* ws = a.ws;
    const bf16* MQ = (const bf16*)(ws + WS_MQ); const bf16* MK = (const bf16*)(ws + WS_MK); const bf16* MV = (const bf16*)(ws + WS_MV); const float* GT = (const float*)(ws + WS_GATES);
    LAS float* qs = (LAS float*)lds;
    LAS float* ks = qs + 32 * 128;
    LAS float* vs = ks + 32 * 128;
    LAS float* gi = vs + 32 * 256;
    LAS float* gf = gi + 32;
    const int dv = tid >> 1, half = tid & 1;
    for (int item = vcu; item < NSEQ * 8; item += G) {
        const int b = item >> 3, hd = (item >> 1) & 3, dir = item & 1;
        bf16* HO = (bf16*)(ws + (dir ? WS_HB : WS_HF));
        float C[64], nn[64]; float m = 0.f;
#pragma unroll
        for (int j = 0; j < 64; ++j) { C[j] = 0.f; nn[j] = 0.f; }
        for (int p0 = 0; p0 < SEQ; p0 += 32) {
            __syncthreads();
            { const int rr = tid >> 4, c8 = (tid & 15) * 8; const int tok = dir ? (SEQ - 1 - (p0 + rr)) : (p0 + rr); const size_t row = (size_t)b * SEQ + tok;
              const v4u q4 = *(const v4u*)(MQ + row * 512 + hd * 128 + c8), k4 = *(const v4u*)(MK + row * 512 + hd * 128 + c8);
              LAS float* kd = ks + rr * 128 + c8;
              { LAS float* qa = qs + rr * 128 + (c8 & ~8) + ((c8 & 8) >> 1);   qa[0] = bflo(q4.x); qa[1] = bfhi(q4.x); qa[2] = bflo(q4.y); qa[3] = bfhi(q4.y); qa[8] = bflo(q4.z); qa[9] = bfhi(q4.z); qa[10] = bflo(q4.w); qa[11] = bfhi(q4.w); }
              kd[0] = bflo(k4.x); kd[1] = bfhi(k4.x); kd[2] = bflo(k4.y); kd[3] = bfhi(k4.y); kd[4] = bflo(k4.z); kd[5] = bfhi(k4.z); kd[6] = bflo(k4.w); kd[7] = bfhi(k4.w);
              const int c16 = (tid & 15) * 16; LAS float* vd = vs + rr * 256 + c16;
#pragma unroll
              for (int h2 = 0; h2 < 2; ++h2) { const v4u v4 = *(const v4u*)(MV + row * 1024 + hd * 256 + c16 + 8 * h2);
                  vd[8 * h2 + 0] = bflo(v4.x); vd[8 * h2 + 1] = bfhi(v4.x); vd[8 * h2 + 2] = bflo(v4.y); vd[8 * h2 + 3] = bfhi(v4.y); vd[8 * h2 + 4] = bflo(v4.z); vd[8 * h2 + 5] = bfhi(v4.z); vd[8 * h2 + 6] = bflo(v4.w); vd[8 * h2 + 7] = bfhi(v4.w); }
              if (tid < 32) { const int tk = dir ? (SEQ - 1 - (p0 + tid)) : (p0 + tid); const size_t rw = (size_t)b * SEQ + tk; gi[tid] = GT[rw * 16 + dir * 8 + hd]; gf[tid] = GT[rw * 16 + dir * 8 + 4 + hd]; }
            }
            __syncthreads();
            for (int pp = 0; pp < 32; ++pp) {
                const float lf = gf[pp], ii = gi[pp];
                const float mn = fmaxf(lf + m, ii);
                const float ca = expf(lf + m - mn), cb = expf(ii - mn);
                const float bv = cb * vs[pp * 256 + dv];
                float hp = 0.f, qn = 0.f;
                const LAS float* kr = ks + pp * 128 + 64 * half; const LAS float* qr = qs + pp * 128 + 64 * half;
#pragma unroll
                for (int j = 0; j < 64; ++j) { const float kk = kr[j], qq = qr[j];
                    C[j] = fmaf(ca, C[j], kk * bv); nn[j] = fmaf(ca, nn[j], cb * kk); hp = fmaf(qq, C[j], hp); qn = fmaf(qq, nn[j], qn); }
                hp += __shfl_xor(hp, 1); qn += __shfl_xor(qn, 1);
                const float den = fmaxf(fabsf(qn), expf(-mn));
                if (half == 0) { const int pos = p0 + pp, cch = pos >> 6, o = pos & 63, tt = o >> 5, rho = o & 31, q = rho >> 3, hh = (rho >> 2) & 1, e = rho & 3;
                    HO[(((size_t)((b * 4 + hd) * 32 + cch) * 32768) + (dv >> 5) * 4096 + tt * 2048 + (q >> 1) * 1024 + (32 * hh + (dv & 31)) * 16) / 2 + 4 * (q & 1) + e] = (bf16)f2bf(hp / den); }
                m = mn;
            }
        }
    }
}

__device__ __forceinline__ void p5_mlstm_finalize(const Args& a, LAS unsigned char* lds, int vcu, int G, int tid, int wave, int lane) {
    unsigned char* ws = a.ws; const float* mg = a.in[7];
    const bf16* MO = (const bf16*)(ws + WS_MO); const bf16* MZ = (const bf16*)(ws + WS_MZ); bf16* MIX = (bf16*)(ws + WS_MIX);
    LAS float* XS = (LAS float*)lds;
    const int r31 = lane & 31, h5 = lane >> 5, dv0 = 8 * r31;
    constexpr int NIT = NSEQ * 4 * 32;
    v4u f[2][2], bb[2][2];
#define P5_LOAD_H(item_) do { const int bh_ = (item_) >> 5, ck_ = (item_) & 31; \
        const unsigned char* hf_ = ws + WS_HF + ((size_t)bh_ * 32 + ck_) * 32768 + wave * 4096 + lane * 16; const unsigned char* hb_ = ws + WS_HB + ((size_t)bh_ * 32 + (31 - ck_)) * 32768 + wave * 4096 + (lane ^ 32) * 16; \
        _Pragma("unroll") for (int tt = 0; tt < 2; ++tt) _Pragma("unroll") for (int qp = 0; qp < 2; ++qp) { f[tt][qp] = *(const v4u*)(hf_ + tt * 2048 + qp * 1024); bb[tt][qp] = *(const v4u*)(hb_ + (1 - tt) * 2048 + (1 - qp) * 1024); } } while (0)
    if (vcu < NIT) P5_LOAD_H(vcu);
    for (int item = vcu; item < NIT; item += G) {
        const int bh = item >> 5, ck = item & 31, b = bh >> 2, hd = bh & 3;
        v4u mo[4], mz[4];
#pragma unroll
        for (int it = 0; it < 4; ++it) { const int o = it * 16 + wave * 2 + h5; const size_t row = (size_t)b * SEQ + ck * 64 + o;
            mo[it] = *(const v4u*)(MO + row * 1024 + hd * 256 + dv0); mz[it] = *(const v4u*)(MZ + row * 1024 + hd * 256 + dv0); }
        __syncthreads();
#pragma unroll
        for (int tt = 0; tt < 2; ++tt)
#pragma unroll
            for (int qp = 0; qp < 2; ++qp) { const v4u fv = f[tt][qp], bv = bb[tt][qp];
                float fs[8] = {bflo(fv.x), bfhi(fv.x), bflo(fv.y), bfhi(fv.y), bflo(fv.z), bfhi(fv.z), bflo(fv.w), bfhi(fv.w)};
                float bs[8] = {bflo(bv.x), bfhi(bv.x), bflo(bv.y), bfhi(bv.y), bflo(bv.z), bfhi(bv.z), bflo(bv.w), bfhi(bv.w)};
#pragma unroll
                for (int j = 0; j < 8; ++j) { const int o = 32 * tt + 8 * (2 * qp + (j >> 2)) + 4 * h5 + (j & 3); XS[o * 256 + 32 * wave + r31] = fs[j] + bs[7 - j]; } }
        __syncthreads();
        if (item + G < NIT) P5_LOAD_H(item + G);
        const f32x4 g0 = *(const f32x4*)(mg + hd * 256 + dv0), g1 = *(const f32x4*)(mg + hd * 256 + dv0 + 4);
        const float gg[8] = {g0[0], g0[1], g0[2], g0[3], g1[0], g1[1], g1[2], g1[3]};
#pragma unroll
        for (int it = 0; it < 4; ++it) { const int o = it * 16 + wave * 2 + h5; const size_t row = (size_t)b * SEQ + ck * 64 + o;
            const f32x4 x0 = *(const LAS f32x4*)(XS + o * 256 + dv0), x1 = *(const LAS f32x4*)(XS + o * 256 + dv0 + 4);
            float hm[8] = {x0[0], x0[1], x0[2], x0[3], x1[0], x1[1], x1[2], x1[3]};
            const float mo8[8] = {bflo(mo[it].x), bfhi(mo[it].x), bflo(mo[it].y), bfhi(mo[it].y), bflo(mo[it].z), bfhi(mo[it].z), bflo(mo[it].w), bfhi(mo[it].w)};
            const float mz8[8] = {bflo(mz[it].x), bfhi(mz[it].x), bflo(mz[it].y), bfhi(mz[it].y), bflo(mz[it].z), bfhi(mz[it].z), bflo(mz[it].w), bfhi(mz[it].w)};
            float ss = 0.f;
#pragma unroll
            for (int j = 0; j < 8; ++j) { hm[j] = hm[j] * __builtin_amdgcn_rcpf(1.f + __expf(-mo8[j])); ss += hm[j] * hm[j]; }
#pragma unroll
            for (int s = 1; s < 32; s <<= 1) ss += __shfl_xor(ss, s);
            const float r = __builtin_amdgcn_rsqf(ss * (1.f / 256.f) + EPS);
            float ov[8];
#pragma unroll
            for (int j = 0; j < 8; ++j) ov[j] = hm[j] * r * gg[j] * (mz8[j] * __builtin_amdgcn_rcpf(1.f + __expf(-mz8[j])));
            v4u w; w.x = pk2(ov[0], ov[1]); w.y = pk2(ov[2], ov[3]); w.z = pk2(ov[4], ov[5]); w.w = pk2(ov[6], ov[7]);
            *(v4u*)(MIX + row * 2048 + 512 + hd * 256 + dv0) = w; }
    }
#undef P5_LOAD_H
    __syncthreads();
}

__device__ __forceinline__ void p5_item(const Args& a, LAS unsigned char* lds, int item) {
    int tid_ = threadIdx.x; asm volatile("" : "+v"(tid_));
    const int lane = tid_ & 63, wave = __builtin_amdgcn_readfirstlane(tid_ >> 6);
    unsigned char* ws = a.ws; const float* mg = a.in[7];
    const bf16* MO = (const bf16*)(ws + WS_MO); const bf16* MZ = (const bf16*)(ws + WS_MZ); bf16* MIX = (bf16*)(ws + WS_MIX);
    LAS float* XS = (LAS float*)lds; const int r31 = lane & 31, h5 = lane >> 5, dv0 = 8 * r31;
    const int bh = item >> 5, ck = item & 31, b = bh >> 2, hd = bh & 3;
    const unsigned char* hf_ = ws + WS_HF + ((size_t)bh * 32 + ck) * 32768 + wave * 4096 + lane * 16; const unsigned char* hb_ = ws + WS_HB + ((size_t)bh * 32 + (31 - ck)) * 32768 + wave * 4096 + (lane ^ 32) * 16;
    v4u f[2][2], bb[2][2], mo[4], mz[4];
#pragma unroll
    for (int tt = 0; tt < 2; ++tt)
#pragma unroll
        for (int qp = 0; qp < 2; ++qp) { f[tt][qp] = *(const v4u*)(hf_ + tt * 2048 + qp * 1024); bb[tt][qp] = *(const v4u*)(hb_ + (1 - tt) * 2048 + (1 - qp) * 1024); }
#pragma unroll
    for (int it = 0; it < 4; ++it) { const int o = it * 16 + wave * 2 + h5; const size_t row = (size_t)b * SEQ + ck * 64 + o;
        mo[it] = *(const v4u*)(MO + row * 1024 + hd * 256 + dv0); mz[it] = *(const v4u*)(MZ + row * 1024 + hd * 256 + dv0); }
    __syncthreads();
#pragma unroll
    for (int tt = 0; tt < 2; ++tt)
#pragma unroll
        for (int qp = 0; qp < 2; ++qp) { const v4u fv = f[tt][qp], bv = bb[tt][qp];
            float fs[8] = {bflo(fv.x), bfhi(fv.x), bflo(fv.y), bfhi(fv.y), bflo(fv.z), bfhi(fv.z), bflo(fv.w), bfhi(fv.w)};
            float bs[8] = {bflo(bv.x), bfhi(bv.x), bflo(bv.y), bfhi(bv.y), bflo(bv.z), bfhi(bv.z), bflo(bv.w), bfhi(bv.w)};
#pragma unroll
            for (int j = 0; j < 8; ++j) { const int o = 32 * tt + 8 * (2 * qp + (j >> 2)) + 4 * h5 + (j & 3); XS[o * 256 + 32 * wave + r31] = fs[j] + bs[7 - j]; } }
    __syncthreads();
    const f32x4 g0 = *(const f32x4*)(mg + hd * 256 + dv0), g1 = *(const f32x4*)(mg + hd * 256 + dv0 + 4);
    const float gg[8] = {g0[0], g0[1], g0[2], g0[3], g1[0], g1[1], g1[2], g1[3]};
#pragma unroll
    for (int it = 0; it < 4; ++it) { const int o = it * 16 + wave * 2 + h5; const size_t row = (size_t)b * SEQ + ck * 64 + o;
        const f32x4 x0 = *(const LAS f32x4*)(XS + o * 256 + dv0), x1 = *(const LAS f32x4*)(XS + o * 256 + dv0 + 4);
        float hm[8] = {x0[0], x0[1], x0[2], x0[3], x1[0], x1[1], x1[2], x1[3]};
        const float mo8[8] = {bflo(mo[it].x), bfhi(mo[it].x), bflo(mo[it].y), bfhi(mo[it].y), bflo(mo[it].z), bfhi(mo[it].z), bflo(mo[it].w), bfhi(mo[it].w)};
        const float mz8[8] = {bflo(mz[it].x), bfhi(mz[it].x), bflo(mz[it].y), bfhi(mz[it].y), bflo(mz[it].z), bfhi(mz[it].z), bflo(mz[it].w), bfhi(mz[it].w)};
        float ss = 0.f;
#pragma unroll
        for (int j = 0; j < 8; ++j) { hm[j] = hm[j] * __builtin_amdgcn_rcpf(1.f + __expf(-mo8[j])); ss += hm[j] * hm[j]; }
#pragma unroll
        for (int s = 1; s < 32; s <<= 1) ss += __shfl_xor(ss, s);
        const float r = __builtin_amdgcn_rsqf(ss * (1.f / 256.f) + EPS);
        float ov[8];
#pragma unroll
        for (int j = 0; j < 8; ++j) ov[j] = hm[j] * r * gg[j] * (mz8[j] * __builtin_amdgcn_rcpf(1.f + __expf(-mz8[j])));
        v4u w; w.x = pk2(ov[0], ov[1]); w.y = pk2(ov[2], ov[3]); w.z = pk2(ov[4], ov[5]); w.w = pk2(ov[6], ov[7]);
        *(v4u*)(MIX + row * 2048 + 512 + hd * 256 + dv0) = w; }
    __syncthreads();
}

__device__ __forceinline__ void p5_batch(const Args& a, LAS unsigned char* lds, int first, int count) {
    if (count <= 0) return;
    int tid_ = threadIdx.x; asm volatile("" : "+v"(tid_));
    const int lane = tid_ & 63, wave = __builtin_amdgcn_readfirstlane(tid_ >> 6);
    unsigned char* ws = a.ws; const float* mg = a.in[7];
    const bf16* MO = (const bf16*)(ws + WS_MO); const bf16* MZ = (const bf16*)(ws + WS_MZ); bf16* MIX = (bf16*)(ws + WS_MIX);
    LAS float* XS = (LAS float*)lds; const int r31 = lane & 31, h5 = lane >> 5, dv0 = 8 * r31;
    v4u f[2][2], bb[2][2];
#define P5B_LOAD_H(item_) do { const int bh_ = (item_) >> 5, ck_ = (item_) & 31; \
        const unsigned char* hf_ = ws + WS_HF + ((size_t)bh_ * 32 + ck_) * 32768 + wave * 4096 + lane * 16; const unsigned char* hb_ = ws + WS_HB + ((size_t)bh_ * 32 + (31 - ck_)) * 32768 + wave * 4096 + (lane ^ 32) * 16; \
        _Pragma("unroll") for (int tt = 0; tt < 2; ++tt) _Pragma("unroll") for (int qp = 0; qp < 2; ++qp) { f[tt][qp] = *(const v4u*)(hf_ + tt * 2048 + qp * 1024); bb[tt][qp] = *(const v4u*)(hb_ + (1 - tt) * 2048 + (1 - qp) * 1024); } } while (0)
    P5B_LOAD_H(first);
    for (int i = 0; i < count; ++i) {
        const int item = first + i, bh = item >> 5, ck = item & 31, b = bh >> 2, hd = bh & 3;
        v4u mo[4], mz[4];
#pragma unroll
        for (int it = 0; it < 4; ++it) { const int o = it * 16 + wave * 2 + h5; const size_t row = (size_t)b * SEQ + ck * 64 + o;
            mo[it] = *(const v4u*)(MO + row * 1024 + hd * 256 + dv0); mz[it] = *(const v4u*)(MZ + row * 1024 + hd * 256 + dv0); }
        __syncthreads();
#pragma unroll
        for (int tt = 0; tt < 2; ++tt)
#pragma unroll
            for (int qp = 0; qp < 2; ++qp) { const v4u fv = f[tt][qp], bv = bb[tt][qp];
                float fs[8] = {bflo(fv.x), bfhi(fv.x), bflo(fv.y), bfhi(fv.y), bflo(fv.z), bfhi(fv.z), bflo(fv.w), bfhi(fv.w)};
                float bs[8] = {bflo(bv.x), bfhi(bv.x), bflo(bv.y), bfhi(bv.y), bflo(bv.z), bfhi(bv.z), bflo(bv.w), bfhi(bv.w)};
#pragma unroll
                for (int j = 0; j < 8; ++j) { const int o = 32 * tt + 8 * (2 * qp + (j >> 2)) + 4 * h5 + (j & 3); XS[o * 256 + 32 * wave + r31] = fs[j] + bs[7 - j]; } }
        __syncthreads();
        if (i + 1 < count) P5B_LOAD_H(item + 1);
        const f32x4 g0 = *(const f32x4*)(mg + hd * 256 + dv0), g1 = *(const f32x4*)(mg + hd * 256 + dv0 + 4);
        const float gg[8] = {g0[0], g0[1], g0[2], g0[3], g1[0], g1[1], g1[2], g1[3]};
#pragma unroll
        for (int it = 0; it < 4; ++it) { const int o = it * 16 + wave * 2 + h5; const size_t row = (size_t)b * SEQ + ck * 64 + o;
            const f32x4 x0 = *(const LAS f32x4*)(XS + o * 256 + dv0), x1 = *(const LAS f32x4*)(XS + o * 256 + dv0 + 4);
            float hm[8] = {x0[0], x0[1], x0[2], x0[3], x1[0], x1[1], x1[2], x1[3]};
            const float mo8[8] = {bflo(mo[it].x), bfhi(mo[it].x), bflo(mo[it].y), bfhi(mo[it].y), bflo(mo[it].z), bfhi(mo[it].z), bflo(mo[it].w), bfhi(mo[it].w)};
            const float mz8[8] = {bflo(mz[it].x), bfhi(mz[it].x), bflo(mz[it].y), bfhi(mz[it].y), bflo(mz[it].z), bfhi(mz[it].z), bflo(mz[it].w), bfhi(mz[it].w)};
            float ss = 0.f;
#pragma unroll
            for (int j = 0; j < 8; ++j) { hm[j] = hm[j] * __builtin_amdgcn_rcpf(1.f + __expf(-mo8[j])); ss += hm[j] * hm[j]; }
#pragma unroll
            for (int s = 1; s < 32; s <<= 1) ss += __shfl_xor(ss, s);
            const float r = __builtin_amdgcn_rsqf(ss * (1.f / 256.f) + EPS);
            float ov[8];
#pragma unroll
            for (int j = 0; j < 8; ++j) ov[j] = hm[j] * r * gg[j] * (mz8[j] * __builtin_amdgcn_rcpf(1.f + __expf(-mz8[j])));
            v4u w; w.x = pk2(ov[0], ov[1]); w.y = pk2(ov[2], ov[3]); w.z = pk2(ov[4], ov[5]); w.w = pk2(ov[6], ov[7]);
            *(v4u*)(MIX + row * 2048 + 512 + hd * 256 + dv0) = w; }
    }
#undef P5B_LOAD_H
    __syncthreads();
}

__device__ __forceinline__ void gate_rows48(unsigned char* ws, const float* b_gates, int row0, int lane) {
    typedef short bf16x8 __attribute__((ext_vector_type(8)));
    const int r15 = lane & 15, kg = lane >> 4;
    const bf16* a0p = (const bf16*)(ws + WS_H) + (size_t)(row0 + r15) * DM + 8 * kg; const bf16* a1p = a0p + 16 * DM; const bf16* a2p = a0p + 32 * DM;
    const bf16* bp = (const bf16*)(ws + WS_WGT) + (size_t)r15 * DM + 8 * kg;
    f32x4 acc0 = {0.f, 0.f, 0.f, 0.f}, acc1 = {0.f, 0.f, 0.f, 0.f}, acc2 = {0.f, 0.f, 0.f, 0.f};
#pragma unroll 8
    for (int ks = 0; ks < DM / 32; ++ks) { const bf16x8 a0 = *(const bf16x8*)(a0p + 32 * ks), a1 = *(const bf16x8*)(a1p + 32 * ks), a2 = *(const bf16x8*)(a2p + 32 * ks), b = *(const bf16x8*)(bp + 32 * ks);
        acc0 = __builtin_amdgcn_mfma_f32_16x16x32_bf16(a0, b, acc0, 0, 0, 0); acc1 = __builtin_amdgcn_mfma_f32_16x16x32_bf16(a1, b, acc1, 0, 0, 0); acc2 = __builtin_amdgcn_mfma_f32_16x16x32_bf16(a2, b, acc2, 0, 0, 0); }
    const float bias = b_gates[r15]; const bool isf = (r15 >> 2) & 1; float* G = (float*)(ws + WS_GATES) + (size_t)(row0 + 4 * kg) * 16 + r15;
#pragma unroll
    for (int r = 0; r < 4; ++r) { float v0 = acc0[r] + bias, v1 = acc1[r] + bias, v2 = acc2[r] + bias; if (isf) { v0 = log_sigmoid_f(v0); v1 = log_sigmoid_f(v1); v2 = log_sigmoid_f(v2); }
        G[r * 16] = v0; G[(16 + r) * 16] = v1; G[(32 + r) * 16] = v2; }
}

constexpr int N_PHASES = 7;
__global__ void __launch_bounds__(NWAVES * 64, 2) hy_fwd(Args args) {
    extern __shared__ __attribute__((aligned(16))) unsigned char lds_raw[];
    LAS unsigned char* lds = (LAS unsigned char*)lds_raw;
    const int tid = threadIdx.x, lane = tid & 63, wave = __builtin_amdgcn_readfirstlane(tid >> 6);
    const int G = gridDim.x; const int bx = blockIdx.x; const int vcu = (G % 8 == 0) ? (bx % 8) * (G / 8) + bx / 8 : bx;
    unsigned char* ws = args.ws;
    const int lo = args.ph_lo, hi = args.ph_hi;
    unsigned* ctl = (unsigned*)(ws + WS_CTL);
    volatile LAS unsigned* bst = (volatile LAS unsigned*)(lds + LDS_BYTES - 16);
    if (tid == 0) { bst[0] = 0u; bst[1] = 0u; }
    __syncthreads();
    XcdBarrier xbar; xbar.bar = ctl + CW_BAR; xbar.x = 0; xbar.st = bst; bool xposted = false;
    const bool one_launch = (lo == 0 && hi == N_PHASES);
    if (one_launch) { xbar = xcd_barrier_post(ctl + CW_BAR, bst); xposted = true; }
#ifndef HY_PHASE_MASK
#define HY_PHASE_MASK 0x7f
#endif
#define IN(k) (((HY_PHASE_MASK >> (k)) & 1) && lo <= (k) && (k) < hi)
#define BOTH(k) (IN(k) && IN((k) + 1))
#ifndef HY_DUP_MASK
#define HY_DUP_MASK 0
#endif
#ifndef HY_PROBE_NULL
#define HY_PROBE_NULL 0
#endif
#ifndef HY_ML_PROBE_MODE
#define HY_ML_PROBE_MODE 0
#endif
#define DUP(k) (((HY_DUP_MASK) >> (k)) & 1)
#define GRID_BAR_CG() do { cg::this_grid().sync(); } while (0)
#define GRID_BAR() do { if (!xposted) { xbar = xcd_barrier_post(ctl + CW_BAR, bst); xposted = true; } xcd_barrier(xbar); } while (0)

    if (IN(0) && DUP(0)) { p0_prologue(args, lds, vcu, G, tid, wave, lane); __syncthreads(); }
    if (IN(0)) { p0_prologue(args, lds, vcu, G, tid, wave, lane); if (BOTH(0)) GRID_BAR(); }

    if (IN(1)) {
        { const float* Rg = (const float*)(ws + WS_ROPE); LAS float* Rl = (LAS float*)(lds + ROPE_LDS_OFF); LAS float* Gl = (LAS float*)(lds + QKG_LDS_OFF);
          for (int e = tid; e < 64 * 32 * 2; e += NWAVES * 64) Rl[e] = Rg[e];
          if (tid < 128) { Gl[tid] = args.in[5][tid]; Gl[128 + tid] = args.in[6][tid]; }
          __syncthreads(); }
        { pg8::Gemm g{(const pg8::bf16_t*)((unsigned char*)args.out + DO_H8), (const pg8::bf16_t*)(ws + WS_W8T), NTOK, NQ8, DM / 2, DM / 128}; pg8::StaticOrder S; S.init(NTOK, NQ8, G, bx);
          pg8::EpiProjT<0, 2> E{ws, (PG8_LAS float*)(lds + XCH_OFF), (PG8_LAS float*)(lds + ROPE_LDS_OFF), (PG8_LAS float*)(lds + QKG_LDS_OFF), (unsigned char*)args.out + DO_Q, (PG8_LAS float*)(lds + SCL_LDS_OFF), (const float*)(ws + WS_SA), (const float*)(ws + WS_SW)};
          pg8::gemm_phase<pg8::EpiProjT<0, 2>, pg8::StaticOrder, true, true, 2>(lds, g, S, E); }
        { pg8::Gemm g{(const pg8::bf16_t*)(ws + WS_H), (const pg8::bf16_t*)(ws + WS_W1B), NTOK, NB1 - NB0, DM, DM / 64}; pg8::StaticOrder S; S.init(NTOK, NB1 - NB0, G, bx);
          pg8::EpiProjT<NB0 / 256, 0> E{ws, (PG8_LAS float*)(lds + XCH_OFF), (PG8_LAS float*)(lds + ROPE_LDS_OFF), (PG8_LAS float*)(lds + QKG_LDS_OFF), (unsigned char*)args.out + DO_Q, nullptr, nullptr, nullptr};
          pg8::gemm_phase<pg8::EpiProjT<NB0 / 256, 0>, pg8::StaticOrder, true, true, 0>(lds, g, S, E); }
        { const int nun = (NTOK / 256) * (NQ8 / 256), full = nun / G, rem = nun - full * G, light = G - rem;
          if (bx >= rem) for (int it = (bx - rem) * NWAVES + wave; it < NTOK / 48; it += light * NWAVES) gate_rows48(ws, args.in[4], it * 48, lane); }
        if (BOTH(1)) GRID_BAR();
    }

static_assert(!HY_SEPARATE_ROPE, "the attention body takes fp8 q / k rows, which only the fused in-projection epilogue writes");
#if HY_SEPARATE_ROPE
    if (IN(2)) { p2_qknorm_rope(args, vcu, G, wave, lane); if (BOTH(2)) GRID_BAR(); }
#endif

#define ATTN_UNIT(grp_, w_) do { const int b_ = (grp_) >> 1, kvh_ = (grp_) & 1, h_ = kvh_ * 4 + ((w_) >> 3), qb_ = (w_) & 7; const size_t row0_ = (size_t)b_ * SEQ + qb_ * 256; \
        const unsigned char* Q_ = (const unsigned char*)args.out + DO_Q + row0_ * 1024 + h_ * 128; unsigned char* O_ = ws + WS_MIX + row0_ * 4096 + h_ * 128; const unsigned char* K_ = ws + WS_AK + (size_t)b_ * SEQ * 256 + kvh_ * 128; \
        const unsigned char* V_ = ws + WS_AV + (size_t)(grp_) * 128 * 2048; const bf16* Z_ = (const bf16*)(ws + WS_AZ) + row0_ * 1024 + h_ * 128; \
        int seqv_ = SEQ; asm volatile("" : "+s"(seqv_)); attn::attn_dense_body<attn::bf16>(Q_, K_, V_, O_, Z_, seqv_, (char*)lds_raw); __syncthreads(); } while (0)
#if HY_SCHED_J
    const bool schedJ = one_launch && G == 256;
    if (schedJ) {
        const int xl = vcu >> 5, s = vcu & 31;
        if (s < 24) ml::mlstm_item<0>(ws, lds, xl * 24 + s, tid);
        else for (int j = 0; j < 3; ++j) ATTN_UNIT(xl, 3 * (s - 24) + j);
        GRID_BAR();
        const int n_rest = (s < 8) ? 6 : 5, n_p5 = (s < 8) ? 6 : 14, p5_0 = (s < 8) ? 6 * (xl * 8 + s) : 384 + 14 * (xl * 24 + (s - 8));
        int p5_done = 0;
        for (int jr = 0; jr < n_rest; ++jr) {
            if ((jr & 1) == 0) { const int tgt = (n_p5 * ((jr >> 1) + 1)) / 3;
                p5_batch(args, lds, p5_0 + p5_done, tgt - p5_done); p5_done = tgt; }
            const int li = s + 32 * jr;
            const int grp = (li < 8) ? xl : xl + 8 * (1 + ((li - 8) >> 5)), w = (li < 8) ? 24 + li : (li - 8) & 31;
            ATTN_UNIT(grp, w);
        }
        GRID_BAR();
    }
#else
    const bool schedJ = false;
#endif

    if (!schedJ && IN(3)) {
        for (int u = vcu; u < NSEQ * 2 * 32; u += G) ATTN_UNIT(u >> 5, u & 31);
        if (BOTH(3)) GRID_BAR();
    }

    if (!schedJ && IN(4) && DUP(4)) {
#if HY_MLSTM_REF
        p4_mlstm_recurrent(args, lds, vcu, G, tid);
#else
        for (int item = vcu; item < NSEQ * 8; item += G) ml::mlstm_item<HY_ML_PROBE_MODE>(ws, lds, item, tid);
#endif
        if (BOTH(4)) GRID_BAR(); }

    if (!schedJ && IN(4)) {
#if HY_MLSTM_REF
        p4_mlstm_recurrent(args, lds, vcu, G, tid);
#else
        for (int item = vcu; item < NSEQ * 8; item += G) ml::mlstm_item<0>(ws, lds, item, tid);
#endif
        if (BOTH(4)) GRID_BAR(); }

    if (!schedJ && IN(5) && DUP(5)) { p5_mlstm_finalize(args, lds, vcu, G, tid, wave, lane); }
    if (!schedJ && IN(5)) { p5_mlstm_finalize(args, lds, vcu, G, tid, wave, lane); if (BOTH(5)) GRID_BAR(); }

    if (IN(6)) {
        pg8::Gemm g{(const pg8::bf16_t*)(ws + WS_MIX), (const pg8::bf16_t*)(ws + WS_W2T), NTOK, DM, DM, pg8::F8_TILES + 1024 / 64}; pg8::StaticOrder S; S.init(NTOK, DM, G, bx);
        pg8::EpiOut E{args.in[0], args.in[1], args.out};
        pg8::gemm_phase<pg8::EpiOut, pg8::StaticOrder, true, true, 3>(lds, g, S, E);
    }
    if (one_launch && lo < 0) GRID_BAR_CG();
#undef IN
#undef BOTH
}

extern "C" void kernel_launch(void* const* d_in, const int* in_sizes, int n_in, void* d_out, int out_size, void* d_ws, size_t ws_size, hipStream_t stream) {
    static int grid = 0;
    if (grid == 0) {
        if (n_in != 9 || in_sizes[0] != TOK_PROMPT * DM || in_sizes[1] != (NTOK - TOK_PROMPT) * DM || out_size != NTOK * DM || ws_size < WS_END) {
            fprintf(stderr, "kernel_launch: shape mismatch n_in %d in0 %d in1 %d out %d ws %zu (need %zu)\n", n_in, n_in > 0 ? in_sizes[0] : -1, n_in > 1 ? in_sizes[1] : -1, out_size, ws_size, (size_t)WS_END); grid = -1; return; }
        int dev = 0, cus = 0, per_cu = 0;
        if (hipGetDevice(&dev) != hipSuccess || hipDeviceGetAttribute(&cus, hipDeviceAttributeMultiprocessorCount, dev) != hipSuccess) { fprintf(stderr, "kernel_launch: device query failed\n"); grid = -1; return; }
        if (hipFuncSetAttribute((const void*)hy_fwd, hipFuncAttributeMaxDynamicSharedMemorySize, LDS_BYTES) != hipSuccess) { fprintf(stderr, "kernel_launch: hipFuncSetAttribute failed\n"); grid = -1; return; }
        if (hipOccupancyMaxActiveBlocksPerMultiprocessor(&per_cu, (const void*)hy_fwd, NWAVES * 64, LDS_BYTES) != hipSuccess || per_cu < 1) { fprintf(stderr, "kernel_launch: occupancy query says %d\n", per_cu); per_cu = 1; }
        (void)hipGetLastError();
        grid = cus;
    }
    if (grid < 0) return;
    if (hipMemsetAsync((char*)d_ws + WS_CTL, 0, 65536, stream) != hipSuccess) { fprintf(stderr, "kernel_launch: hipMemsetAsync of the control words failed\n"); return; }
    Args a{};
    for (int i = 0; i < 9; ++i) a.in[i] = (const float*)d_in[i];
    a.out = (float*)d_out; a.ws = (unsigned char*)d_ws;
#if HY_N_LAUNCHES == 1
    a.ph_lo = 0; a.ph_hi = N_PHASES;
    void* kargs[] = {&a};
    hipError_t e = hipLaunchCooperativeKernel((const void*)hy_fwd, dim3(grid), dim3(NWAVES * 64), kargs, LDS_BYTES, stream);
    if (e != hipSuccess) fprintf(stderr, "kernel_launch: cooperative launch failed: %s (grid %d)\n", hipGetErrorString(e), grid);
#else
    for (int p = 0; p < N_PHASES; ++p) {
        a.ph_lo = p; a.ph_hi = p + 1;
        hipLaunchKernelGGL(hy_fwd, dim3(grid), dim3(NWAVES * 64), LDS_BYTES, stream, a);
        const hipError_t le = hipPeekAtLastError();
        if (le != hipSuccess) { fprintf(stderr, "kernel_launch: launch %d failed: %s\n", p, hipGetErrorName(le)); break; }
    }
#endif
}
```

```cpp
#include <hip/hip_runtime.h>
#include <hip/hip_bf16.h>
#include <hip/hip_cooperative_groups.h>
#include <cstdio>
#include <cstdint>
#include <cmath>
namespace cg = cooperative_groups;

#ifndef HY_SEPARATE_ROPE
#define HY_SEPARATE_ROPE 0
#endif
#ifndef HY_SCHED_J
#define HY_SCHED_J 1
#endif
#ifndef HY_MLSTM_REF
#define HY_MLSTM_REF 0
#endif
#ifndef HY_N_LAUNCHES
#define HY_N_LAUNCHES 1
#endif

constexpr int SEQ = 2048, NSEQ = 24, NTOK = NSEQ * SEQ, TOK_PROMPT = 8 * SEQ, DM = 2048;
constexpr int NPROJ = 6672, NP256 = 6656;
constexpr float EPS = 1e-6f;

constexpr size_t MiB = 1u << 20;
constexpr size_t WS_CTL = 0, CTL_ZERO_BYTES = 1 * MiB;
constexpr int CW_BAR = 4096, CW_QUEUE = 8192;
constexpr size_t WS_ROPE = 1 * MiB;
constexpr size_t WS_W8T = 2 * MiB;
constexpr size_t WS_W1B = 14 * MiB;
constexpr size_t WS_WGT = 18 * MiB;
constexpr size_t WS_SW = 19 * MiB;
constexpr size_t WS_SA = 20 * MiB;
constexpr size_t WS_W2T = 30 * MiB;
constexpr size_t WS_GATES = 38 * MiB;
constexpr size_t WS_H = 42 * MiB;
constexpr size_t WS_HF = WS_H, WS_HB = WS_H + 96 * MiB;
constexpr size_t WS_MIX = 234 * MiB;
constexpr size_t DO_H8 = 0, DO_Q = 96 * MiB;
constexpr float V8_SCALE = 16.f, P8_SCALE = 16.f;
constexpr float QK8_SCALE = 16.f;
constexpr float A8_SCALE = 256.f, W8_SCALE = 512.f;
constexpr size_t WS_AK = 426 * MiB, WS_AV = 450 * MiB;
constexpr size_t WS_AZ = 474 * MiB;
constexpr size_t WS_MQ = 570 * MiB, WS_MK = 618 * MiB;
constexpr size_t WS_MV = 666 * MiB, WS_MO = 762 * MiB, WS_MZ = 858 * MiB;
constexpr size_t WS_END = 954 * MiB;

typedef unsigned short bf16;
__device__ __forceinline__ unsigned f2bf(float f) { unsigned u = __builtin_bit_cast(unsigned, f); return (u + 0x7fffu + ((u >> 16) & 1u)) >> 16; }
__device__ __forceinline__ unsigned pk2(float lo, float hi) { return f2bf(lo) | (f2bf(hi) << 16); }
__device__ __forceinline__ float bf2f(unsigned short b) { return __builtin_bit_cast(float, (unsigned)b << 16); }
__device__ __forceinline__ float bflo(unsigned w) { return __builtin_bit_cast(float, w << 16); }
__device__ __forceinline__ float bfhi(unsigned w) { return __builtin_bit_cast(float, w & 0xffff0000u); }
constexpr int NQA = 2560, NB0 = 2560, NB1 = 3584, NQ8 = 5632;
__device__ __forceinline__ unsigned pk4f8(float a, float b, float c, float d) {
    a = __builtin_fminf(__builtin_fmaxf(a, -448.f), 448.f); b = __builtin_fminf(__builtin_fmaxf(b, -448.f), 448.f); c = __builtin_fminf(__builtin_fmaxf(c, -448.f), 448.f); d = __builtin_fminf(__builtin_fmaxf(d, -448.f), 448.f);
    int w = 0; w = __builtin_amdgcn_cvt_pk_fp8_f32(a, b, w, false); w = __builtin_amdgcn_cvt_pk_fp8_f32(c, d, w, true); return (unsigned)w; }
__device__ __forceinline__ unsigned pk4f8_nc(float a, float b, float c, float d) {
    int w = __builtin_bit_cast(int, a); w = __builtin_amdgcn_cvt_pk_fp8_f32(a, b, w, false); w = __builtin_amdgcn_cvt_pk_fp8_f32(c, d, w, true); return (unsigned)w; }
__device__ __forceinline__ float log_sigmoid_f(float x) { return x >= 0.f ? -log1pf(expf(-x)) : x - log1pf(expf(x)); }
namespace pg8 {
#define PG8_LAS __attribute__((address_space(3)))
typedef unsigned short bf16_t;
typedef short bf16x8 __attribute__((ext_vector_type(8)));
typedef float f32x4 __attribute__((ext_vector_type(4)));
typedef unsigned u32x4 __attribute__((ext_vector_type(4)));
typedef int i32x4 __attribute__((ext_vector_type(4)));
constexpr int F8_TILES = 8;
constexpr int BM = 256, BK = 64, HALF = 128, HTB = HALF * BK * 2  , STAGE_BYTES = 8 * HTB, NXCD = 8, WGM = 8;

__host__ __device__ __forceinline__ int lds_byte(int r, int c) { const int st = (r >> 4) * 2 + (c >> 5), rr = r & 15, cc = c & 31, ob = rr * 64 + cc * 2; return st * 1024 + (ob ^ (((ob >> 9) & 1) << 5)); }
__host__ __device__ __forceinline__ void stage_rc(int b, int& R, int& C) { const int st = b / 1024, sb = b % 1024, swz = sb ^ (((sb >> 9) & 1) << 5); R = (st >> 1) * 16 + swz / 64; C = (st & 1) * 32 + (swz % 64) / 2; }
__host__ __device__ __forceinline__ int perm32(int rho) { const int n = rho >> 4, i = rho & 15; return 8 * (i >> 2) + 4 * n + (i & 3); }

struct Unit { int pm, pn; };
struct Gemm { const bf16_t* A; const bf16_t* Bt; int M, N, K, kt; };

struct StaticOrder {
    int nM, nN, nwg, G, c;
    __host__ __device__ void init(int M, int N, int G_, int c_) { nM = M / BM; nN = N / BM; nwg = nM * nN; G = G_; c = c_; }
    __host__ __device__ bool next(int i, Unit& u) const {
        const long L = (long)i * G + c; if (L >= nwg) return false;
        int wgid = (int)L; { const int q = nwg / NXCD, r = nwg % NXCD, xcd = wgid % NXCD, off = wgid / NXCD; wgid = (xcd < r ? xcd * (q + 1) : r * (q + 1) + (xcd - r) * q) + off; }
        const int nig = WGM * nN, gid = wgid / nig, fm = gid * WGM, gsz = (nM - fm) < WGM ? (nM - fm) : WGM;
        u.pm = fm + ((wgid % nig) % gsz); u.pn = (wgid % nig) / gsz; return true;
    }
    __device__ __forceinline__ void a_ready(const Unit&) const {}
    __device__ __forceinline__ void done(const Unit&) const {}
};


__device__ __forceinline__ unsigned cvt_pk_bf16(float lo, float hi) { unsigned r; asm volatile("v_cvt_pk_bf16_f32 %0, %1, %2" : "=v"(r) : "v"(lo), "v"(hi)); return r; }

template <int PN0, int MODE>
struct EpiProjT {
    static constexpr bool PERM = true, AFTER_DRAIN = false, PREFETCH = (MODE == 2); static constexpr int NSTORE = 16;
    unsigned char* ws; PG8_LAS float* xch; PG8_LAS float* ropeL; PG8_LAS float* qkgL;
    unsigned char* qb;
    PG8_LAS float* scl; const float* SA; const float* SW;
    __device__ __forceinline__ void prefetch(const Unit& u, int ui, int wid, int lane) const {
        const float* src = (wid < 4) ? SA + (size_t)u.pm * BM + wid * 64 + lane : SW + u.pn * BM + (wid - 4) * 64 + lane;
        __builtin_amdgcn_global_load_lds((const unsigned*)src, (PG8_LAS unsigned*)(scl + (ui & 1) * 512 + wid * 64), 4, 0, 0); }
    __device__ __forceinline__ void operator()(const f32x4 (&acc)[2][2][4][2], const Unit& u, int wr, int wc, int fr, int fq, int par = 0) const {
        const int pn = (MODE == 2) ? (u.pn < 10 ? u.pn : u.pn + 4) : u.pn + PN0; const int row0 = u.pm * BM + wr * 64 + fr;
        constexpr float SC = (MODE == 1) ? (1.f / 4096.f) : 1.f;
        float sa[2][4]; f32x4 sw[2][2];
        if constexpr (MODE == 2) { PG8_LAS float* T = scl + par * 512;
#pragma unroll
            for (int ai = 0; ai < 2; ++ai)
#pragma unroll
                for (int m = 0; m < 4; ++m) sa[ai][m] = T[ai * HALF + wr * 64 + m * 16 + fr];
#pragma unroll
            for (int bj = 0; bj < 2; ++bj)
#pragma unroll
                for (int n = 0; n < 2; ++n) sw[bj][n] = *(const PG8_LAS f32x4*)(T + 256 + bj * HALF + wc * 32 + 8 * fq + 4 * n); }
        auto val = [&](int ai, int bj, int m, int n) -> f32x4 {
            if constexpr (MODE == 2) { const i32x4 iv = __builtin_bit_cast(i32x4, acc[ai][bj][m][n]); const f32x4 f = {(float)iv[0], (float)iv[1], (float)iv[2], (float)iv[3]}; return f * sa[ai][m] * sw[bj][n]; }
            else return acc[ai][bj][m][n] * SC; };
        if (!HY_SEPARATE_ROPE && PN0 <= 4 && pn <= 4) {
            PG8_LAS float* gsrc = qkgL + ((pn < 4) ? 0 : 128); const int cb = 64 * (wc >> 1) + 16 * (wc & 1) + 4 * fq;
            const f32x4 g1 = *(const PG8_LAS f32x4*)(gsrc + cb), g2 = *(const PG8_LAS f32x4*)(gsrc + cb + 32);
#pragma unroll
            for (int ai = 0; ai < 2; ++ai)
#pragma unroll
                for (int m = 0; m < 4; ++m)
#pragma unroll
                    for (int bj = 0; bj < 2; ++bj) { const f32x4 a = val(ai, bj, m, 0), b = val(ai, bj, m, 1);
                        float s = ((a[0] * a[0] + a[1] * a[1]) + (a[2] * a[2] + a[3] * a[3])) + ((b[0] * b[0] + b[1] * b[1]) + (b[2] * b[2] + b[3] * b[3]));
                        s += __shfl_xor(s, 16); s += __shfl_xor(s, 32);
                        if (fq == 0) xch[((ai * HALF + wr * 64 + m * 16 + fr) * 2 + bj) * 4 + wc] = s; }
            asm volatile("s_waitcnt lgkmcnt(0)" ::: "memory"); __builtin_amdgcn_s_barrier(); asm volatile("" ::: "memory");
            unsigned char* base = pn < 4 ? qb : ws + WS_AK; const int ldc = (pn < 4) ? 1024 : 256; const int colt = (pn < 4) ? pn * 256 : 0;
            PG8_LAS float* R = ropeL; const int j0 = 16 * (wc & 1) + 4 * fq;
#pragma unroll
            for (int ai = 0; ai < 2; ++ai)
#pragma unroll
                for (int m = 0; m < 4; ++m) { const int row = row0 + ai * HALF + m * 16; const int tl = row & (SEQ - 1); const int pos = (wc < 2) ? (tl >> 6) : (tl & 63);
                    const f32x4 cs0 = *(const PG8_LAS f32x4*)(R + (pos * 32 + j0) * 2), cs1 = *(const PG8_LAS f32x4*)(R + (pos * 32 + j0) * 2 + 4);
#pragma unroll
                    for (int bj = 0; bj < 2; ++bj) { const f32x4 pt = *(const PG8_LAS f32x4*)(xch + ((ai * HALF + wr * 64 + m * 16 + fr) * 2 + bj) * 4);
                        const float rstd = 1.f / sqrtf(((pt[0] + pt[1]) + (pt[2] + pt[3])) * (1.f / 128.f) + EPS);
                        const f32x4 y1 = val(ai, bj, m, 0) * rstd * g1, y2 = val(ai, bj, m, 1) * rstd * g2;
                        const float o10 = y1[0] * cs0[0] - y2[0] * cs0[1], o11 = y1[1] * cs0[2] - y2[1] * cs0[3], o12 = y1[2] * cs1[0] - y2[2] * cs1[1], o13 = y1[3] * cs1[2] - y2[3] * cs1[3];
                        const float o20 = y2[0] * cs0[0] + y1[0] * cs0[1], o21 = y2[1] * cs0[2] + y1[1] * cs0[3], o22 = y2[2] * cs1[0] + y1[2] * cs1[1], o23 = y2[3] * cs1[2] + y1[3] * cs1[3];
                        unsigned char* dst = base + (size_t)row * ldc + colt + bj * HALF + cb;
                        *(unsigned*)dst = pk4f8(o10 * QK8_SCALE, o11 * QK8_SCALE, o12 * QK8_SCALE, o13 * QK8_SCALE); *(unsigned*)(dst + 32) = pk4f8(o20 * QK8_SCALE, o21 * QK8_SCALE, o22 * QK8_SCALE, o23 * QK8_SCALE); } }
            return;
        }
        size_t off; int ldc, colt;
        if (pn < 4)       { off = 0; ldc = 1024; colt = pn * 256; }
        else if (pn == 4) { off = WS_AK;  ldc = 256;  colt = 0; }
        else if (pn == 5) { off = WS_AV;  ldc = 256;  colt = 0; }
        else if (pn < 10) { off = WS_AZ;  ldc = 1024; colt = (pn - 6) * 256; }
        else if (pn < 12) { off = WS_MQ;  ldc = 512;  colt = (pn - 10) * 256; }
        else if (pn < 14) { off = WS_MK;  ldc = 512;  colt = (pn - 12) * 256; }
        else if (pn < 18) { off = WS_MV;  ldc = 1024; colt = (pn - 14) * 256; }
        else if (pn < 22) { off = WS_MO;  ldc = 1024; colt = (pn - 18) * 256; }
        else              { off = WS_MZ;  ldc = 1024; colt = (pn - 22) * 256; }
        if constexpr (MODE == 2) { if (pn == 5) {
            unsigned char* VT = ws + WS_AV;
            int fr_ = fr, fq_ = fq; asm volatile("" : "+v"(fr_), "+v"(fq_));
            const int b = u.pm >> 3, tile0 = (u.pm & 7) * 4 + wr, qi = fr_ & 3; const unsigned sel = (unsigned)qi | ((unsigned)(4 + qi) << 8);
#pragma unroll
            for (int ai = 0; ai < 2; ++ai)
#pragma unroll
                for (int m = 0; m < 4; ++m)
#pragma unroll
                    for (int bj = 0; bj < 2; ++bj)
#pragma unroll
                        for (int n = 0; n < 2; ++n) { const f32x4 v = val(ai, bj, m, n) * V8_SCALE; const int w = (int)pk4f8(v[0], v[1], v[2], v[3]);
                            const unsigned w0 = (unsigned)__builtin_amdgcn_update_dpp(0, w, 0x00, 0xf, 0xf, false), w1 = (unsigned)__builtin_amdgcn_update_dpp(0, w, 0x55, 0xf, 0xf, false);
                            const unsigned w2 = (unsigned)__builtin_amdgcn_update_dpp(0, w, 0xaa, 0xf, 0xf, false), w3 = (unsigned)__builtin_amdgcn_update_dpp(0, w, 0xff, 0xf, 0xf, false);
                            const unsigned x01 = __builtin_amdgcn_perm(w1, w0, sel), x23 = __builtin_amdgcn_perm(w3, w2, sel), o4 = __builtin_amdgcn_perm(x23, x01, 0x05040100u);
                            const int d = 32 * wc + 8 * fq_ + 4 * n + qi, dw = ((fr_ >> 2) & 1) * 8 + (m >> 1) * 4 + (m & 1) * 2 + ((fr_ >> 3) & 1);
                            *(unsigned*)(VT + ((size_t)((b * 2 + bj) * 128 + d)) * 2048 + (tile0 + 2 * ai) * 64 + dw * 4) = o4; }
            return; } }
        bf16_t* base = (bf16_t*)(pn < 4 ? qb : ws + off);
        const int col0 = colt + wc * 32 + 8 * fq;
#pragma unroll
        for (int ai = 0; ai < 2; ++ai)
#pragma unroll
            for (int m = 0; m < 4; ++m) { bf16_t* rowp = base + (size_t)(row0 + ai * HALF + m * 16) * ldc + col0;
#pragma unroll
                for (int bj = 0; bj < 2; ++bj) { const f32x4 v0 = val(ai, bj, m, 0), v1 = val(ai, bj, m, 1);
                    u32x4 w; w.x = cvt_pk_bf16(v0[0], v0[1]); w.y = cvt_pk_bf16(v0[2], v0[3]); w.z = cvt_pk_bf16(v1[0], v1[1]); w.w = cvt_pk_bf16(v1[2], v1[3]);
                    *(u32x4*)(rowp + bj * HALF) = w; } }
    }
};
struct EpiNull { static constexpr bool PERM = true, AFTER_DRAIN = false, PREFETCH = false; static constexpr int NSTORE = 0;
    __device__ __forceinline__ void operator()(const f32x4 (&acc)[2][2][4][2], const Unit& u, int wr, int wc, int fr, int fq) const {
#pragma unroll
        for (int ai = 0; ai < 2; ++ai)
#pragma unroll
            for (int bj = 0; bj < 2; ++bj)
#pragma unroll
                for (int m = 0; m < 4; ++m) asm volatile("" :: "v"(acc[ai][bj][m][0]), "v"(acc[ai][bj][m][1])); } };
struct EpiOut {
    static constexpr bool PERM = false, AFTER_DRAIN = false, PREFETCH = false; static constexpr int NSTORE = 32;
    const float* xp; const float* xs; float* out;
    __device__ __forceinline__ void operator()(const f32x4 (&acc)[2][2][4][2], const Unit& u, int wr, int wc, int fr, int fq) const {
        const int row0 = u.pm * BM + wr * 64 + fr; const int col0 = u.pn * BM + wc * 32 + 4 * fq;
        const bool pr = row0 < TOK_PROMPT; const float* xb = (pr ? xp : xs) + col0;
        const size_t xsub = pr ? 0 : (size_t)TOK_PROMPT * DM; float* ob = out + col0;
        f32x4 xr[4][4];
#define EPO_LOAD(g_) do { const size_t ro_ = (size_t)(row0 + ((g_) >> 2) * HALF + ((g_) & 3) * 16) * DM - xsub; \
            xr[(g_) & 3][0] = *(const f32x4*)(xb + ro_); xr[(g_) & 3][1] = *(const f32x4*)(xb + ro_ + 16); xr[(g_) & 3][2] = *(const f32x4*)(xb + ro_ + HALF); xr[(g_) & 3][3] = *(const f32x4*)(xb + ro_ + HALF + 16); } while (0)
        EPO_LOAD(0); EPO_LOAD(1); EPO_LOAD(2);
#pragma unroll
        for (int g = 0; g < 8; ++g) { if (g + 3 < 8) EPO_LOAD(g + 3);
            const int ai = g >> 2, m = g & 3; const size_t ro = (size_t)(row0 + ai * HALF + m * 16) * DM;
            *(f32x4*)(ob + ro) = xr[g & 3][0] + acc[ai][0][m][0]; *(f32x4*)(ob + ro + 16) = xr[g & 3][1] + acc[ai][0][m][1];
            *(f32x4*)(ob + ro + HALF) = xr[g & 3][2] + acc[ai][1][m][0]; *(f32x4*)(ob + ro + HALF + 16) = xr[g & 3][3] + acc[ai][1][m][1]; }
#undef EPO_LOAD
    }
};

template <class Epi, class Sched, bool ALIGN_EPI = false, bool SP2 = false, int MODE = 0>
__device__ __forceinline__ void gemm_phase(PG8_LAS unsigned char* lds, const Gemm g, const Sched& S, const Epi& E) {
    int tid_ = threadIdx.x; asm volatile("" : "+v"(tid_));
    const int tid = tid_, wid = __builtin_amdgcn_readfirstlane(tid >> 6), lane = tid & 63, wr = wid >> 2, wc = wid & 3, fr = lane & 15, fq = lane >> 4;
    const int K = g.K, nt = g.kt;
    unsigned voffA[2], voffB[2];
#pragma unroll
    for (int i = 0; i < 2; ++i) { int R, C; stage_rc(tid * 16 + i * 8192, R, C); const int Rb = Epi::PERM ? ((R & ~31) + perm32(R & 31)) : R;
        voffA[i] = (unsigned)(R * K + C) * 2u; voffB[i] = (unsigned)(Rb * K + C) * 2u; }
    const size_t kstep = (size_t)(BK * 2);
    const size_t hstep = (size_t)HALF * K * 2;
    const size_t tstep = 2 * hstep;
    const unsigned ldsw = (unsigned)wid * 1024u;
    const int aoff = lds_byte(wr * 64 + fr, fq * 8), boff = lds_byte(wc * 32 + fr, fq * 8);
#define PG8_SA(b, h) (((b) * 2 + (h)) * HTB)
#define PG8_SB(b, h) ((4 + (b) * 2 + (h)) * HTB)
#define PG8_STAGE(bufoff, gbase, voff) do { _Pragma("unroll") for (int _i = 0; _i < 2; ++_i) \
        __builtin_amdgcn_global_load_lds((const unsigned*)((const char*)(gbase) + (voff)[_i]), (PG8_LAS unsigned*)(lds + (bufoff) + ldsw + _i * 8192), 16, 0, 0); } while (0)
#define PG8_LDA(dst, b, h) do { _Pragma("unroll") for (int m = 0; m < 4; ++m) _Pragma("unroll") for (int k = 0; k < 2; ++k) dst[m][k] = *(const PG8_LAS bf16x8*)(lds + PG8_SA(b, h) + aoff + m * 2048 + k * 1024); } while (0)
#define PG8_LDB(dst, b, h) do { _Pragma("unroll") for (int n = 0; n < 2; ++n) _Pragma("unroll") for (int k = 0; k < 2; ++k) dst[n][k] = *(const PG8_LAS bf16x8*)(lds + PG8_SB(b, h) + boff + n * 2048 + k * 1024); } while (0)
#define PG8_CAT8(x_) __builtin_shufflevector(__builtin_bit_cast(i32x4, (x_)[0]), __builtin_bit_cast(i32x4, (x_)[1]), 0, 1, 2, 3, 4, 5, 6, 7)
#define PG8_MMA_F8(ai, bj, At, Bt) do { _Pragma("unroll") for (int m = 0; m < 4; ++m) _Pragma("unroll") for (int n = 0; n < 2; ++n) \
        asm volatile("v_mfma_f32_16x16x128_f8f6f4 %0, %1, %2, %0" : "+v"(acc[ai][bj][m][n]) : "v"(PG8_CAT8(Bt[n])), "v"(PG8_CAT8(At[m]))); } while (0)
#define PG8_MMA_I8(ai, bj, At, Bt) do { _Pragma("unroll") for (int k = 0; k < 2; ++k) _Pragma("unroll") for (int m = 0; m < 4; ++m) _Pragma("unroll") for (int n = 0; n < 2; ++n) \
        asm volatile("v_mfma_i32_16x16x64_i8 %0, %1, %2, %0" : "+v"(acc[ai][bj][m][n]) : "v"(Bt[n][k]), "v"(At[m][k])); } while (0)
#define PG8_MMA_BF(ai, bj, At, Bt) do { _Pragma("unroll") for (int m = 0; m < 4; ++m) _Pragma("unroll") for (int n = 0; n < 2; ++n) _Pragma("unroll") for (int k = 0; k < 2; ++k) \
        acc[ai][bj][m][n] = __builtin_amdgcn_mfma_f32_16x16x32_bf16(Bt[n][k], At[m][k], acc[ai][bj][m][n], 0, 0, 0); } while (0)
#define PG8_MMA(ai, bj, At, Bt) do { __builtin_amdgcn_s_setprio(1); \
        if constexpr (MODE == 1) PG8_MMA_F8(ai, bj, At, Bt); else if constexpr (MODE == 2) PG8_MMA_I8(ai, bj, At, Bt); else PG8_MMA_BF(ai, bj, At, Bt); \
        __builtin_amdgcn_s_setprio(0); } while (0)
#define PG8_MMAW_F8(ai, bj, At, Bt) do { __builtin_amdgcn_s_setprio(1); PG8_MMA_F8(ai, bj, At, Bt); __builtin_amdgcn_s_setprio(0); } while (0)
#define PG8_MMAW_BF(ai, bj, At, Bt) do { __builtin_amdgcn_s_setprio(1); PG8_MMA_BF(ai, bj, At, Bt); __builtin_amdgcn_s_setprio(0); } while (0)
#define PG8_WAIT_V(n) asm volatile("s_waitcnt vmcnt(" #n ")" ::: "memory")
#define PG8_WAIT_L(n) asm volatile("s_waitcnt lgkmcnt(" #n ")" ::: "memory")
#define PG8_BAR __builtin_amdgcn_s_barrier()
#define PG8_SCHED __builtin_amdgcn_sched_barrier(0)
    Unit cur, nxt; int ui = 0;
    if (!S.next(0, cur)) return;
    f32x4 acc[2][2][4][2];
#pragma unroll
    for (int a = 0; a < 2; ++a)
#pragma unroll
        for (int b = 0; b < 2; ++b)
#pragma unroll
            for (int m = 0; m < 4; ++m)
#pragma unroll
                for (int n = 0; n < 2; ++n) { acc[a][b][m][n] = (f32x4){0.f, 0.f, 0.f, 0.f}; if constexpr (MODE != 0) asm volatile("" : "+v"(acc[a][b][m][n])); }
    bf16x8 At[4][2], B0[2][2], B1[2][2];
    const char* cA = (const char*)g.A + (size_t)cur.pm * tstep; const char* cB = (const char*)g.Bt + (size_t)cur.pn * tstep;
    S.a_ready(cur);
    if constexpr (SP2) {
        PG8_STAGE(PG8_SB(0, 0), cB, voffB); PG8_STAGE(PG8_SB(0, 1), cB + hstep, voffB); PG8_STAGE(PG8_SA(0, 0), cA, voffA); PG8_STAGE(PG8_SA(0, 1), cA + hstep, voffA);
        if (wr == 1) PG8_BAR;
        PG8_WAIT_V(2); PG8_BAR;
        PG8_STAGE(PG8_SB(1, 0), cB + kstep, voffB); PG8_STAGE(PG8_SA(1, 0), cA + kstep, voffA); PG8_STAGE(PG8_SB(1, 1), cB + hstep + kstep, voffB);
        PG8_WAIT_V(6); PG8_BAR;
    } else {
        PG8_STAGE(PG8_SB(0, 0), cB, voffB); PG8_STAGE(PG8_SA(0, 0), cA, voffA); PG8_STAGE(PG8_SB(0, 1), cB + hstep, voffB); PG8_STAGE(PG8_SA(0, 1), cA + hstep, voffA);
        if (wr == 1) PG8_BAR;
        PG8_WAIT_V(4); PG8_BAR;
        PG8_STAGE(PG8_SB(1, 0), cB + kstep, voffB); PG8_STAGE(PG8_SA(1, 0), cA + kstep, voffA); PG8_STAGE(PG8_SB(1, 1), cB + hstep + kstep, voffB);
        PG8_WAIT_V(6); PG8_BAR;
    }
    for (;;) {
        const bool has_next = S.next(ui + 1, nxt);
        const char* nA = has_next ? (const char*)g.A + (size_t)nxt.pm * tstep : cA; const char* nB = has_next ? (const char*)g.Bt + (size_t)nxt.pn * tstep : cB;
        static_assert(SP2, "gemm_phase: only the SP2 K-loop is carried");
#define PG8_WAIT_FIRST() do { if constexpr (Epi::NSTORE >= 32) asm volatile("s_waitcnt vmcnt(40)\n\ts_cmp_lg_u32 %0, 0\n\ts_cbranch_scc1 1f\n\ts_waitcnt vmcnt(8)\n1:" :: "s"(relax_s) : "memory", "scc"); \
            else if constexpr (Epi::NSTORE >= 16) asm volatile("s_waitcnt vmcnt(24)\n\ts_cmp_lg_u32 %0, 0\n\ts_cbranch_scc1 1f\n\ts_waitcnt vmcnt(8)\n1:" :: "s"(relax_s) : "memory", "scc"); \
            else PG8_WAIT_V(8); } while (0)
#define PG8_TRIP(MMAX) do { \
            const bool last = (t == nt - 2); \
            const char* a1 = cA + (size_t)(t + 1) * kstep; \
            const char* a2 = last ? nA : cA + (size_t)(t + 2) * kstep; const char* b2 = last ? nB : cB + (size_t)(t + 2) * kstep; \
            const char* a3 = a2 + kstep; const char* b3 = b2 + kstep; \
            if (last && has_next) S.a_ready(nxt); \
            const int relax_s = __builtin_amdgcn_readfirstlane((Epi::NSTORE > 0 && t == 0 && ui > 0) ? 1 : 0); \
            PG8_LDB(B0, 0, 0); PG8_LDB(B1, 0, 1); PG8_SCHED; PG8_LDA(At, 0, 0); PG8_STAGE(PG8_SA(1, 1), a1 + hstep, voffA); \
            PG8_WAIT_FIRST(); PG8_WAIT_L(0); PG8_BAR; MMAX(0, 0, At, B0); MMAX(0, 1, At, B1); PG8_BAR; PG8_SCHED; \
            PG8_LDA(At, 0, 1); PG8_STAGE(PG8_SB(0, 0), b2, voffB); PG8_STAGE(PG8_SB(0, 1), b2 + hstep, voffB); PG8_STAGE(PG8_SA(0, 0), a2, voffA); \
            PG8_WAIT_FIRST(); PG8_WAIT_L(0); PG8_BAR; MMAX(1, 0, At, B0); MMAX(1, 1, At, B1); PG8_BAR; PG8_SCHED; \
            if constexpr (Epi::PREFETCH) { if (t == 0) E.prefetch(cur, ui, wid, lane); } \
            PG8_LDB(B0, 1, 0); PG8_LDB(B1, 1, 1); PG8_SCHED; PG8_LDA(At, 1, 0); PG8_STAGE(PG8_SA(0, 1), a2 + hstep, voffA); \
            PG8_WAIT_V(8); PG8_WAIT_L(0); PG8_BAR; MMAX(0, 0, At, B0); MMAX(0, 1, At, B1); PG8_BAR; PG8_SCHED; \
            PG8_LDA(At, 1, 1); PG8_STAGE(PG8_SB(1, 0), b3, voffB); PG8_STAGE(PG8_SB(1, 1), b3 + hstep, voffB); PG8_STAGE(PG8_SA(1, 0), a3, voffA); \
            PG8_WAIT_V(8); PG8_WAIT_L(0); PG8_BAR; MMAX(1, 0, At, B0); MMAX(1, 1, At, B1); PG8_BAR; PG8_SCHED; } while (0)
        if constexpr (MODE == 3) {
            for (int t = 0; t < F8_TILES; t += 2) PG8_TRIP(PG8_MMAW_F8);
            asm volatile("s_nop 15\n\ts_nop 15" ::: "memory"); PG8_SCHED;
#pragma unroll
            for (int a = 0; a < 2; ++a)
#pragma unroll
                for (int b = 0; b < 2; ++b)
#pragma unroll
                    for (int m = 0; m < 4; ++m)
#pragma unroll
                        for (int n = 0; n < 2; ++n) acc[a][b][m][n] *= (1.f / (A8_SCALE * W8_SCALE));
            for (int t = F8_TILES; t < nt; t += 2) PG8_TRIP(PG8_MMAW_BF);
        } else { for (int t = 0; t < nt; t += 2) PG8_TRIP(PG8_MMA); }
#undef PG8_TRIP
#undef PG8_WAIT_FIRST
        if constexpr (MODE == 1 || MODE == 2) { asm volatile("s_nop 15\n\ts_nop 15" ::: "memory"); PG8_SCHED; }
        if constexpr (ALIGN_EPI) { if (wr == 0) PG8_BAR; }
        if constexpr (!Epi::AFTER_DRAIN) { if constexpr (Epi::PREFETCH) E(acc, cur, wr, wc, fr, fq, ui & 1); else E(acc, cur, wr, wc, fr, fq); S.done(cur); }
        if (!has_next) break;
#pragma unroll
        for (int a = 0; a < 2; ++a)
#pragma unroll
            for (int b = 0; b < 2; ++b)
#pragma unroll
                for (int m = 0; m < 4; ++m)
#pragma unroll
                    for (int n = 0; n < 2; ++n) { acc[a][b][m][n] = (f32x4){0.f, 0.f, 0.f, 0.f}; if constexpr (MODE != 0) asm volatile("" : "+v"(acc[a][b][m][n])); }
        cur = nxt; cA = nA; cB = nB; ++ui;
        if constexpr (ALIGN_EPI) { if (wr == 1) PG8_BAR; }
    }
    PG8_WAIT_V(0);
    if constexpr (!ALIGN_EPI) { if (wr == 0) PG8_BAR; }
    PG8_BAR;
    if constexpr (Epi::AFTER_DRAIN) { E.fused(acc, cur, wr, wc, fr, fq, lds, wid, lane); S.done(cur); }
#undef PG8_SA
#undef PG8_SB
#undef PG8_STAGE
#undef PG8_LDA
#undef PG8_LDB
#undef PG8_MMA
#undef PG8_MMAW_F8
#undef PG8_MMAW_BF
#undef PG8_MMA_F8
#undef PG8_MMA_I8
#undef PG8_MMA_BF
#undef PG8_CAT8
#undef PG8_WAIT_V
#undef PG8_WAIT_L
#undef PG8_BAR
#undef PG8_SCHED
}
}
namespace attn {
using bf16 = __hip_bfloat16;
constexpr int   D = 128, NW = 8, QBLK = 32, KVBLK = 64;
constexpr float SCALE = 0.088388347648318440f / (QK8_SCALE * QK8_SCALE);
constexpr float THR = 3.f;
constexpr int SDEPTH = 2;
constexpr int LDQ = 1024, LDK = 256, LDO = 4096, LDZ = 1024;
constexpr size_t SHM_V = KVBLK * D, SHM_K = KVBLK * D, SHM_ATTN = 65536 + NW * 64 * 4 + 32;
using bf16x8 = __attribute__((ext_vector_type(8))) short;
using s16x4  = __attribute__((ext_vector_type(4))) short;
using f32x16 = __attribute__((ext_vector_type(16))) float;
using f32x8  = __attribute__((ext_vector_type(8))) float;
using u32x4  = __attribute__((ext_vector_type(4))) unsigned;
#define KSWZ(row, colB) ((row) * 128 + ((colB) ^ ((((row) >> 1) & 7) << 4)))
#define VSWZ(row, colB) ((row) * 64 + ((colB) ^ ((((row) >> 2) & 3) << 4)))
typedef int i32x8 __attribute__((ext_vector_type(8)));
typedef int i32x4a __attribute__((ext_vector_type(4)));
#define SBAR() __builtin_amdgcn_sched_barrier(0)
__device__ __forceinline__ int crow(int r, int hi) { return (r & 3) + 8 * (r >> 2) + 4 * hi; }
__device__ __forceinline__ unsigned cvtpk(float lo, float hi) {
  unsigned r; asm volatile("v_cvt_pk_bf16_f32 %0, %1, %2" : "=v"(r) : "v"(lo), "v"(hi)); return r;
}
template <typename TIn> struct Stage;
template <> struct Stage<bf16>  { using T = bf16x8;
  __device__ static __forceinline__ T ld8(const bf16* p) { return *reinterpret_cast<const bf16x8*>(p); }
  __device__ static __forceinline__ bf16x8 tobf(T x) { return x; } };
template <> struct Stage<float> { using T = f32x8;
  __device__ static __forceinline__ T ld8(const float* p) { return *reinterpret_cast<const f32x8*>(p); }
  __device__ static __forceinline__ bf16x8 tobf(T x) {
    u32x4 w = {cvtpk(x[0], x[1]), cvtpk(x[2], x[3]), cvtpk(x[4], x[5]), cvtpk(x[6], x[7])}; return *reinterpret_cast<bf16x8*>(&w); } };

__device__ __forceinline__ void partialSM(f32x16& p0, f32x16& p1, float& m_reg, float& mn, float& alpha) {
  constexpr float C = SCALE * 1.4426950408889634f;
  float pmax = p0[0]; for (int r = 1; r < 16; ++r) pmax = fmaxf(pmax, p0[r]); for (int r = 0; r < 16; ++r) pmax = fmaxf(pmax, p1[r]);
  { auto rr = __builtin_amdgcn_permlane32_swap(__float_as_uint(pmax), __float_as_uint(pmax), false, false);
    pmax = fmaxf(__uint_as_float(rr[0]), __uint_as_float(rr[1])); }
  if (__builtin_expect(__all(pmax - m_reg <= THR / SCALE), 1)) { mn = m_reg; alpha = 1.f; }
  else { mn = fmaxf(m_reg, pmax); alpha = __builtin_amdgcn_exp2f((m_reg - mn) * C); m_reg = mn; }
  float mnC = fmaf(-mn, C, 4.0f);
  for (int r = 0; r < 16; ++r) p0[r] = fmaf(p0[r], C, mnC); for (int r = 0; r < 16; ++r) p1[r] = fmaf(p1[r], C, mnC);
  for (int r = 0; r < 16; ++r) p0[r] = __builtin_amdgcn_exp2f(p0[r]);
}
__device__ __forceinline__ void finishSM(f32x16& p0, f32x16& p1, i32x8& pa) {
  for (int r = 0; r < 16; ++r) p1[r] = __builtin_amdgcn_exp2f(p1[r]);
#pragma unroll
  for (int q = 0; q < 4; ++q) { pa[q] = (int)pk4f8_nc(p0[4 * q], p0[4 * q + 1], p0[4 * q + 2], p0[4 * q + 3]);
    pa[4 + q] = (int)pk4f8_nc(p1[4 * q], p1[4 * q + 1], p1[4 * q + 2], p1[4 * q + 3]); }
}
__device__ __forceinline__ void qkt(f32x16& p0, f32x16& p1, const unsigned char* Ks, const i32x8* qf, int r32, int hi) {
  i32x8 ka[2], kb[2];
#pragma unroll
  for (int s = 0; s < 2; ++s) { const int cb = 64 * s + 32 * hi;
    const i32x4a a0 = *reinterpret_cast<const i32x4a*>(Ks + KSWZ(r32, cb)), a1 = *reinterpret_cast<const i32x4a*>(Ks + KSWZ(r32, cb + 16));
    const i32x4a b0 = *reinterpret_cast<const i32x4a*>(Ks + KSWZ(32 + r32, cb)), b1 = *reinterpret_cast<const i32x4a*>(Ks + KSWZ(32 + r32, cb + 16));
    ka[s] = __builtin_shufflevector(a0, a1, 0, 1, 2, 3, 4, 5, 6, 7); kb[s] = __builtin_shufflevector(b0, b1, 0, 1, 2, 3, 4, 5, 6, 7); }
  asm volatile("v_mfma_f32_32x32x64_f8f6f4 %0, %1, %2, 0" : "=&v"(p0) : "v"(ka[0]), "v"(qf[0]));
  asm volatile("v_mfma_f32_32x32x64_f8f6f4 %0, %1, %2, 0" : "=&v"(p1) : "v"(kb[0]), "v"(qf[0]));
  asm volatile("v_mfma_f32_32x32x64_f8f6f4 %0, %1, %2, %0" : "+v"(p0) : "v"(ka[1]), "v"(qf[1]));
  asm volatile("v_mfma_f32_32x32x64_f8f6f4 %0, %1, %2, %0\n\ts_nop 15\n\ts_nop 7" : "+v"(p1) : "v"(kb[1]), "v"(qf[1]));
}
template <int D0> __device__ __forceinline__ void pv_one(f32x16& od, const unsigned char* Vs, i32x8 pa, int r32, int hi) {
  const i32x4a lo = *reinterpret_cast<const i32x4a*>(Vs + VSWZ(32 * D0 + r32, 32 * hi)), hi4 = *reinterpret_cast<const i32x4a*>(Vs + VSWZ(32 * D0 + r32, 32 * hi + 16));
  const i32x8 vb = __builtin_shufflevector(lo, hi4, 0, 1, 2, 3, 4, 5, 6, 7);
  if (D0 == 0) asm volatile("s_nop 1\n\tv_mfma_f32_32x32x64_f8f6f4 %0, %1, %2, %0" : "+v"(od) : "v"(pa), "v"(vb));
  else asm volatile("v_mfma_f32_32x32x64_f8f6f4 %0, %1, %2, %0" : "+v"(od) : "v"(pa), "v"(vb));
}
__device__ __forceinline__ void pv_d0(f32x16* o, const unsigned char* Vs, i32x8 pa, int r32, int hi, const unsigned char* ones) {
  pv_one<0>(o[0], Vs, pa, r32, hi); pv_one<1>(o[1], Vs, pa, r32, hi); pv_one<2>(o[2], Vs, pa, r32, hi); pv_one<3>(o[3], Vs, pa, r32, hi);
  const i32x4a u0 = *reinterpret_cast<const i32x4a*>(ones), u1 = *reinterpret_cast<const i32x4a*>(ones + 16);
  const i32x8 ub = __builtin_shufflevector(u0, u1, 0, 1, 2, 3, 4, 5, 6, 7);
  asm volatile("v_mfma_f32_32x32x64_f8f6f4 %0, %1, %2, %0" : "+v"(o[4]) : "v"(pa), "v"(ub));
}
#define O_SETTLE() do { asm volatile("s_nop 15\n\ts_nop 7" ::: "memory"); SBAR(); } while (0)

template <typename TQ>
__device__ __forceinline__ void attn_dense_body(const unsigned char* __restrict__ Qb, const unsigned char* __restrict__ Kh, const unsigned char* __restrict__ Vh,
                                                unsigned char* Ob, const unsigned short* __restrict__ Zb, int seq, char* lds) {
  using St = Stage<bf16>; using SQ = Stage<TQ>;
  int tid = threadIdx.x; asm volatile("" : "+v"(tid));
  const int wid = tid >> 6, lane = tid & 63, r32 = lane & 31, hi = lane >> 5;
  unsigned char* V_lds = (unsigned char*)lds; unsigned char* K_lds = (unsigned char*)(lds + 2 * SHM_V);
  float* ws = (float*)(lds + 65536) + wid * 64; float* li_l = ws; float* al_l = ws + 32;
  float m_reg = -1e30f; f32x16 o[5] = {}; i32x8 qr[2];
  const unsigned char* ones = (const unsigned char*)(lds + 65536 + 2048); if (tid < 8) *(unsigned*)(lds + 65536 + 2048 + 4 * tid) = 0x38383838u;
  const unsigned char* Qw = Qb + (long)(wid * QBLK + r32) * LDQ + hi * 32;
#pragma unroll
  for (int s2 = 0; s2 < 2; ++s2) { const i32x4a lo = *reinterpret_cast<const i32x4a*>(Qw + 64 * s2), hi4 = *reinterpret_cast<const i32x4a*>(Qw + 64 * s2 + 16); qr[s2] = __builtin_shufflevector(lo, hi4, 0, 1, 2, 3, 4, 5, 6, 7); }
  const int kr = tid >> 3, kc = (tid & 7) * 16, kst = KSWZ(kr, kc);
  const int vr = tid >> 2, vc = (tid & 3) * 16, vst = VSWZ(vr, vc);
  struct { i32x4a vs, ks; } sr_[SDEPTH];
#define SLOAD(i, k0) do { sr_[i].vs = *reinterpret_cast<const i32x4a*>(Vh + (long)vr * 2048 + (k0) + vc); \
    sr_[i].ks = *reinterpret_cast<const i32x4a*>(Kh + (long)((k0) + kr) * LDK + kc); } while (0)
#define SWRITE(b, i) do { *(i32x4a*)(V_lds + (b) * SHM_V + vst) = sr_[i].vs; *(i32x4a*)(K_lds + (b) * SHM_K + kst) = sr_[i].ks; } while (0)
#define SWAIT() do { if constexpr (SDEPTH == 2) asm volatile("s_waitcnt vmcnt(2)" ::: "memory"); else asm volatile("s_waitcnt vmcnt(0)" ::: "memory"); } while (0)
#define RESC(a) do { if (__any((a) < 1.f)) { if (hi == 0) al_l[r32] = (a); asm volatile("s_waitcnt lgkmcnt(0)" ::: "memory"); O_SETTLE(); \
    for (int d = 0; d < 5; ++d) for (int r = 0; r < 16; ++r) o[d][r] *= al_l[crow(r, hi)]; } } while (0)
  f32x16 pA0, pA1, pB0, pB1; float mnA, mnB, alA, alB; i32x8 pa; const int NT = seq / KVBLK;
  constexpr int SE = 0, SO = SDEPTH - 1;
  SLOAD(SE, 0); asm volatile("s_waitcnt vmcnt(0)" ::: "memory"); SWRITE(0, SE); __syncthreads();
  qkt(pA0, pA1, K_lds, qr, r32, hi); partialSM(pA0, pA1, m_reg, mnA, alA);
  SLOAD(SO, KVBLK); if constexpr (SDEPTH == 2) { if (2 < NT) SLOAD(SE, 2 * KVBLK); }
  SWAIT(); SWRITE(1, SO); __syncthreads();
  for (int j = 1; j + 1 < NT; j += 2) {
    SBAR(); qkt(pB0, pB1, K_lds + SHM_K, qr, r32, hi);
    finishSM(pA0, pA1, pa); SBAR();
    SLOAD(SO, (j + SDEPTH) * KVBLK); SBAR();
    pv_d0(o, V_lds, pa, r32, hi, ones); partialSM(pB0, pB1, m_reg, mnB, alB);
    __syncthreads(); SWAIT(); SWRITE(0, SE);
    RESC(alB); __syncthreads();
    SBAR(); qkt(pA0, pA1, K_lds, qr, r32, hi);
    finishSM(pB0, pB1, pa); SBAR();
    if (SDEPTH == 1 || j + 3 < NT) SLOAD(SE, (j + 1 + SDEPTH) * KVBLK); SBAR();
    pv_d0(o, V_lds + SHM_V, pa, r32, hi, ones); partialSM(pA0, pA1, m_reg, mnA, alA);
    __syncthreads(); SWAIT(); SWRITE(1, SO);
    RESC(alA); __syncthreads();
  }
  SBAR(); qkt(pB0, pB1, K_lds + SHM_K, qr, r32, hi);
  finishSM(pA0, pA1, pa); SBAR();
  pv_d0(o, V_lds, pa, r32, hi, ones); partialSM(pB0, pB1, m_reg, mnB, alB);
  __syncthreads(); RESC(alB);
  finishSM(pB0, pB1, pa); SBAR();
  pv_d0(o, V_lds + SHM_V, pa, r32, hi, ones);
  O_SETTLE();
  float rli[16];
#pragma unroll
  for (int r = 0; r < 16; ++r) rli[r] = __builtin_amdgcn_rcpf(o[4][r]) * (1.f / V8_SCALE);
  __syncthreads();
  { unsigned short* stg = (unsigned short*)(lds + wid * 8192);
#pragma unroll
    for (int r = 0; r < 16; ++r) { const int orow = crow(r, hi);
#pragma unroll
      for (int d0 = 0; d0 < 4; ++d0) { unsigned u = __builtin_bit_cast(unsigned, o[d0][r] * rli[r]); u = (u + 0x7fffu + ((u >> 16) & 1u)) >> 16; stg[orow * 128 + d0 * 32 + r32] = (unsigned short)u; } }
    asm volatile("s_waitcnt lgkmcnt(0)" ::: "memory");
    unsigned char* Ow = Ob + (long)(wid * QBLK) * LDO; const unsigned short* Zw = Zb + (long)(wid * QBLK) * LDZ;
#pragma unroll 2
    for (int i = 0; i < 8; ++i) { const int row = i * 4 + (lane >> 4), ch = lane & 15;
      const u32x4 ov = *(const u32x4*)(stg + row * 128 + ch * 8); const u32x4 zv = *(const u32x4*)(Zw + (long)row * LDZ + ch * 8); float g8[8];
#pragma unroll
      for (int e = 0; e < 4; ++e) { const float z0 = __builtin_bit_cast(float, zv[e] << 16), z1 = __builtin_bit_cast(float, zv[e] & 0xffff0000u);
        g8[2 * e] = __builtin_bit_cast(float, ov[e] << 16) * (z0 * __builtin_amdgcn_rcpf(1.f + __expf(-z0))) * A8_SCALE; g8[2 * e + 1] = __builtin_bit_cast(float, ov[e] & 0xffff0000u) * (z1 * __builtin_amdgcn_rcpf(1.f + __expf(-z1))) * A8_SCALE; }
      typedef unsigned u32x2o __attribute__((ext_vector_type(2)));
      u32x2o w; w.x = pk4f8(g8[0], g8[1], g8[2], g8[3]); w.y = pk4f8(g8[4], g8[5], g8[6], g8[7]);
      *(u32x2o*)(Ow + (long)row * LDO + ch * 8) = w; } }
#undef SLOAD
#undef SWRITE
#undef SWAIT
#undef RESC
}

}
namespace ml {
typedef short bf16x8 __attribute__((ext_vector_type(8)));
typedef short v4i16 __attribute__((ext_vector_type(4)));
typedef float f32x4 __attribute__((ext_vector_type(4)));
typedef float f32x16 __attribute__((ext_vector_type(16)));
typedef unsigned u32x4 __attribute__((ext_vector_type(4)));
typedef unsigned u32x2 __attribute__((ext_vector_type(2)));
#define ML_LAS __attribute__((address_space(3)))
constexpr int BUFB = 65536, Q_OFF = 0, K_OFF = 16384, V_OFF = 32768;
constexpr int P_OFF = 131072, DENP_OFF = P_OFF + 8192, QNP_OFF = DENP_OFF + 512, VEC_OFF = QNP_OFF + 2048, VEC_SLOT = 2 * 256, VR_OFF = VEC_OFF + 2 * VEC_SLOT, NB_OFF = VR_OFF + 8 * 256, LDS_END = NB_OFF + 512;
__device__ __forceinline__ unsigned fxor(unsigned row) { return ((row & 3u) << 2) | ((row >> 2) & 3u); }
__device__ __forceinline__ unsigned off_b(unsigned row, unsigned ch) { return 256u * row + 16u * (ch ^ fxor(row)); }
__device__ __forceinline__ unsigned off_p(unsigned t, unsigned ch) { return 128u * t + 16u * (ch ^ (t & 7u)); }
__device__ __forceinline__ unsigned tr_addr(unsigned lane, unsigned c, unsigned ks, unsigned t) { const unsigned h = lane >> 5, blk = (lane >> 4) & 1u, q = (lane & 15u) >> 2, p = lane & 3u; return off_b(16u * ks + 8u * h + 4u * t + q, 4u * c + 2u * blk + (p >> 1)) + 8u * (p & 1u); }
__device__ __forceinline__ unsigned tr_addr16(unsigned lane, unsigned c, unsigned ks, unsigned t) { const unsigned g = lane >> 4, q = (lane & 15u) >> 2, p = lane & 3u; return off_b(32u * ks + 8u * g + 4u * t + q, 2u * c + (p >> 1)) + 8u * (p & 1u); }
__device__ __forceinline__ v4i16 trrd(ML_LAS unsigned char* p) { return __builtin_amdgcn_ds_read_tr16_b64_v4i16((ML_LAS v4i16*)p); }
template <int OFF> __device__ __forceinline__ v4i16 trra(unsigned addr) { v4i16 r; asm volatile("ds_read_b64_tr_b16 %0, %1 offset:%2" : "=v"(r) : "v"(addr), "i"(OFF) : "memory"); return r; }
__device__ __forceinline__ void glds16(const void* gsrc, unsigned lds_dst) { unsigned keep;
    asm volatile("s_mov_b32 %0, m0\n\ts_mov_b32 m0, %2\n\ts_nop 0\n\tglobal_load_lds_dwordx4 %1, off\n\ts_mov_b32 m0, %0" : "=&s"(keep) : "v"(gsrc), "s"(lds_dst) : "memory"); }
#define ML_TRWAIT() do { asm volatile("s_waitcnt lgkmcnt(0)" ::: "memory"); __builtin_amdgcn_sched_barrier(0); } while (0)
__device__ __forceinline__ bf16x8 cat8(v4i16 lo, v4i16 hi) { return (bf16x8){lo[0], lo[1], lo[2], lo[3], hi[0], hi[1], hi[2], hi[3]}; }
__device__ __forceinline__ unsigned pkbf(float lo, float hi) { unsigned r; asm volatile("v_cvt_pk_bf16_f32 %0, %1, %2" : "=v"(r) : "v"(lo), "v"(hi)); return r; }
__device__ __forceinline__ float s2f(short x) { return __builtin_bit_cast(float, (unsigned)(unsigned short)x << 16); }
__device__ __forceinline__ bf16x8 pack8(float a0, float a1, float a2, float a3, float a4, float a5, float a6, float a7) { u32x4 w = {pkbf(a0, a1), pkbf(a2, a3), pkbf(a4, a5), pkbf(a6, a7)}; return __builtin_bit_cast(bf16x8, w); }
__device__ __forceinline__ float scan_add(float v, int lane) {
#pragma unroll
    for (int o = 1; o < 64; o <<= 1) { const float u = __shfl_up(v, o); if (lane >= o) v += u; }
    return v; }
__device__ __forceinline__ float scan_max(float v, int lane) {
#pragma unroll
    for (int o = 1; o < 64; o <<= 1) { const float u = __shfl_up(v, o); if (lane >= o) v = fmaxf(v, u); }
    return v; }
#define ML_OPAQUE_LANE(ln) unsigned ln = (unsigned)lane; asm volatile("" : "+v"(ln))
__device__ __forceinline__ float rdlane(float v, int l) { return __builtin_bit_cast(float, __builtin_amdgcn_readlane(__builtin_bit_cast(int, v), l)); }

__device__ __forceinline__ void stage(ML_LAS unsigned char* lds, int bsel, int c, int b, int hd, int dir, const unsigned short* MQ, const unsigned short* MK, const unsigned short* MV, int wid, int lane) {
    const int rl = lane >> 4, pos = lane & 15;
#pragma unroll
    for (int half = 0; half < 2; ++half) {
        const int grp = wid + 8 * half, row = 4 * grp + rl, ch = pos ^ ((rl << 2) | (grp & 3));
        const int p = 64 * c + row, tok = dir ? (SEQ - 1 - p) : p; const size_t trow = (size_t)b * SEQ + tok;
        ML_LAS unsigned char* d = lds + bsel * BUFB + grp * 1024;
        __builtin_amdgcn_global_load_lds((const unsigned*)(MQ + trow * 512 + hd * 128 + 8 * ch), (ML_LAS unsigned*)(d + Q_OFF), 16, 0, 0);
        __builtin_amdgcn_global_load_lds((const unsigned*)(MK + trow * 512 + hd * 128 + 8 * ch), (ML_LAS unsigned*)(d + K_OFF), 16, 0, 0);
        __builtin_amdgcn_global_load_lds((const unsigned*)(MV + trow * 1024 + hd * 256 + 8 * ch), (ML_LAS unsigned*)(d + V_OFF), 16, 0, 0);
        __builtin_amdgcn_global_load_lds((const unsigned*)(MV + trow * 1024 + hd * 256 + 128 + 8 * ch), (ML_LAS unsigned*)(d + V_OFF + 16384), 16, 0, 0);
    }
}

#define ML_DPPF(old_, src_, ctrl_, rm_) __builtin_bit_cast(float, __builtin_amdgcn_update_dpp(__builtin_bit_cast(int, (float)(old_)), __builtin_bit_cast(int, (float)(src_)), ctrl_, rm_, 0xf, false))
__device__ __forceinline__ float dscan_add(float v) {
    v += ML_DPPF(0.f, v, 0x111, 0xf); v += ML_DPPF(0.f, v, 0x112, 0xf); v += ML_DPPF(0.f, v, 0x114, 0xf); v += ML_DPPF(0.f, v, 0x118, 0xf);
    v += ML_DPPF(0.f, v, 0x142, 0xa); v += ML_DPPF(0.f, v, 0x143, 0xc); return v; }
__device__ __forceinline__ float dscan_max(float v) { const float NI = -3.0e38f;
    v = fmaxf(v, ML_DPPF(NI, v, 0x111, 0xf)); v = fmaxf(v, ML_DPPF(NI, v, 0x112, 0xf)); v = fmaxf(v, ML_DPPF(NI, v, 0x114, 0xf)); v = fmaxf(v, ML_DPPF(NI, v, 0x118, 0xf));
    v = fmaxf(v, ML_DPPF(NI, v, 0x142, 0xa)); v = fmaxf(v, ML_DPPF(NI, v, 0x143, 0xc)); return v; }

template <int MODE> __device__ __forceinline__ void mlstm_item(unsigned char* ws, ML_LAS unsigned char* lds, int item, int tid) {
    const int lane = tid & 63, wid = __builtin_amdgcn_readfirstlane(tid >> 6);
    const int b = item >> 3, hd = (item >> 1) & 3, dir = item & 1;
    const float* GT = (const float*)(ws + WS_GATES) + dir * 8 + hd;
    ML_LAS float* DENP = (ML_LAS float*)(lds + DENP_OFF); ML_LAS float* QNP = (ML_LAS float*)(lds + QNP_OFF); ML_LAS float* NB = (ML_LAS float*)(lds + NB_OFF + wid * 64);
    unsigned dq0, dq1, dv0, dv1;
    { const int rl = lane >> 4, pos = lane & 15;
      const int g0 = wid, g1 = wid + 8; const int r0 = 4 * g0 + rl, r1 = 4 * g1 + rl; const int c0 = pos ^ ((rl << 2) | (g0 & 3)), c1 = pos ^ ((rl << 2) | (g1 & 3));
      const int m0 = dir ? 63 - r0 : r0, m1 = dir ? 63 - r1 : r1;
      dq0 = (unsigned)(m0 * 1024 + 16 * c0); dq1 = (unsigned)(m1 * 1024 + 16 * c1); dv0 = (unsigned)(m0 * 2048 + 16 * c0); dv1 = (unsigned)(m1 * 2048 + 16 * c1); }
    const unsigned goff = (unsigned)((dir ? 63 - lane : lane) * 64);
    unsigned trL0, trL1, trX;
    { const unsigned h = lane >> 5, blk = (lane >> 4) & 1u, q = (lane & 15u) >> 2, p = lane & 3u; const unsigned A = 256u * (8u * h + q) + 8u * (p & 1u), lo = 2u * blk + (p >> 1);
      trL0 = A + 16u * (lo ^ ((2u * h) & 3u)); trL1 = A + 16u * (lo ^ ((2u * h + 1u) & 3u)) + 1024u; trX = 64u * q; }
    f32x16 C[4]; f32x4 n4 = {0.f, 0.f, 0.f, 0.f};
#pragma unroll
    for (int i = 0; i < 4; ++i) C[i] = (f32x16){0.f};
    const char* gq = (const char*)(ws + WS_MQ) + ((size_t)b * SEQ * 512 + hd * 128) * 2; const char* gk = (const char*)(ws + WS_MK) + ((size_t)b * SEQ * 512 + hd * 128) * 2;
    const char* gv = (const char*)(ws + WS_MV) + ((size_t)b * SEQ * 1024 + hd * 256) * 2; const char* gg = (const char*)GT + (size_t)b * SEQ * 64;
    unsigned char* ho = ws + (dir ? WS_HB : WS_HF) + ((size_t)(b * 4 + hd) * 32) * 32768 + wid * 4096 + lane * 16;
    const unsigned lds0 = (unsigned)(uintptr_t)lds;
#define ML_TB(c_) (MODE == 1 ? (dir ? (SEQ - 64) : 0) : (dir ? (SEQ - 64 * ((c_) + 1)) : 64 * (c_)))
#define ML_STAGE(bsel_, c_) do { const int tb_ = ML_TB(c_); const unsigned d_ = (unsigned)__builtin_amdgcn_readfirstlane((int)(lds0 + (bsel_) * BUFB + wid * 1024)); \
        const char* q_ = gq + (size_t)tb_ * 1024; const char* k_ = gk + (size_t)tb_ * 1024; const char* v_ = gv + (size_t)tb_ * 2048; \
        glds16(q_ + dq0, d_ + Q_OFF); glds16(q_ + dq1, d_ + Q_OFF + 8192); glds16(k_ + dq0, d_ + K_OFF); glds16(k_ + dq1, d_ + K_OFF + 8192); \
        glds16(v_ + dv0, d_ + V_OFF); glds16(v_ + dv1, d_ + V_OFF + 8192); glds16(v_ + 256 + dv0, d_ + V_OFF + 16384); glds16(v_ + 256 + dv1, d_ + V_OFF + 16384 + 8192); } while (0)
#define ML_GATES(c_, gi_, gf_) do { const char* g_ = gg + (size_t)ML_TB(c_) * 64 + goff; gi_ = *(const float*)g_; gf_ = *(const float*)(g_ + 16); } while (0)
#define ML_VEC(cc_, gi_, gf_, sc_out_) do { ML_LAS float* T_ = (ML_LAS float*)(lds + VEC_OFF + ((cc_) & 1) * VEC_SLOT); \
        const float bcs_ = dscan_add(gf_), cx_ = (gi_) - bcs_, cm_ = dscan_max(cx_), M_ = fmaxf(m, cm_); const float g_ = rdlane(bcs_, 63), M63_ = rdlane(M_, 63); \
        T_[lane] = __expf(cx_ - M63_); T_[64 + lane] = __expf(-(bcs_ + M63_)); \
        sc_out_ = __expf(m - M63_); m = g_ + M63_; } while (0)
    float m = 0.f, sc, sc_n = 1.f, gi_a, gf_a, gi_b = 0.f, gf_b = 0.f; u32x4 pend[4] = {{0u, 0u, 0u, 0u}, {0u, 0u, 0u, 0u}, {0u, 0u, 0u, 0u}, {0u, 0u, 0u, 0u}};
    ML_STAGE(0, 0); ML_GATES(0, gi_a, gf_a); ML_VEC(0, gi_a, gf_a, sc); ML_GATES(1, gi_a, gf_a);
    for (int c = 0; c < SEQ / 64; ++c) {
        const int bsel = c & 1;
        ML_LAS unsigned char* bQ = lds + bsel * BUFB + Q_OFF; ML_LAS unsigned char* bK = lds + bsel * BUFB + K_OFF; ML_LAS unsigned char* bV = lds + bsel * BUFB + V_OFF;
        ML_LAS float* VWE = (ML_LAS float*)(lds + VEC_OFF + bsel * VEC_SLOT); ML_LAS float* VEMT = VWE + 64; ML_LAS float* VR = (ML_LAS float*)(lds + VR_OFF + wid * 256);
        asm volatile("s_waitcnt vmcnt(0) lgkmcnt(0)" ::: "memory"); __builtin_amdgcn_s_barrier(); asm volatile("" ::: "memory");
        if (c > 0) { unsigned char* hc = ho + (size_t)(c - 1) * 32768; *(u32x4*)(hc) = pend[0]; *(u32x4*)(hc + 1024) = pend[1]; *(u32x4*)(hc + 2048) = pend[2]; *(u32x4*)(hc + 3072) = pend[3]; }
        if (c + 1 < SEQ / 64) { ML_STAGE(bsel ^ 1, c + 1);
            if (c + 2 < SEQ / 64) ML_GATES(c + 2, gi_b, gf_b);
            ML_VEC(c + 1, gi_a, gf_a, sc_n); }
        if (MODE == 2) { asm volatile("s_waitcnt lgkmcnt(0)" ::: "memory"); __builtin_amdgcn_s_barrier(); continue; }
        { ML_OPAQUE_LANE(ln); const unsigned r15 = ln & 15u, kg = ln >> 4; const int tj = wid >> 1, sb = (wid & 1) * 2; const unsigned t = 16u * tj + r15;
          const unsigned xq = fxor(r15) << 4;
          ML_LAS unsigned char* qrow = bQ + 256u * t;
          bf16x8 qf[4];
#pragma unroll
          for (int ks = 0; ks < 4; ++ks) qf[ks] = *(const ML_LAS bf16x8*)(qrow + (((4u * ks + kg) << 4) ^ xq));
          float dsum = 0.f; const unsigned hb = 8u * (kg & 1u), kh = kg >> 1;
#pragma unroll
          for (int u = 0; u < 2; ++u) { const unsigned si = sb + u; ML_LAS unsigned char* krow = bK + 256u * (16u * si + r15) + hb;
              f32x4 acc = {0.f, 0.f, 0.f, 0.f};
#pragma unroll
              for (int ks = 0; ks < 4; ++ks) { const unsigned g2 = 4u * ks + 2u * kh;
                  const u32x2 lo = *(const ML_LAS u32x2*)(krow + ((g2 << 4) ^ xq)), hi = *(const ML_LAS u32x2*)(krow + (((g2 + 1u) << 4) ^ xq));
                  const u32x4 kw = {lo.x, lo.y, hi.x, hi.y};
                  acc = __builtin_amdgcn_mfma_f32_16x16x32_bf16(__builtin_bit_cast(bf16x8, kw), qf[ks], acc, 0, 0, 0); }
              const unsigned s0 = 16u * si + 4u * kg; const f32x4 ws4 = *(const ML_LAS f32x4*)(VWE + s0);
              float p[4];
#pragma unroll
              for (int r = 0; r < 4; ++r) { p[r] = (s0 + r <= t) ? acc[r] : 0.f; dsum = fmaf(p[r], ws4[r], dsum); }
              const u32x2 pw = {pkbf(p[0], p[1]), pkbf(p[2], p[3])};
              *(ML_LAS u32x2*)(lds + P_OFF + 128u * t + (((2u * si + kh) ^ (t & 7u)) << 4) + hb) = pw; }
          dsum += __shfl_xor(dsum, 16); dsum += __shfl_xor(dsum, 32);
          if (ln < 16u) DENP[(wid & 1) * 64 + t] = dsum; }
        n4 = n4 * sc;
        { ML_OPAQUE_LANE(ln); const unsigned r15 = ln & 15u, kg = ln >> 4; if (r15 == 0) *(ML_LAS f32x4*)(NB + 4 * kg) = n4;
          const f32x4 nA = *(const ML_LAS f32x4*)(NB + 0), nB = *(const ML_LAS f32x4*)(NB + 4), nC = *(const ML_LAS f32x4*)(NB + 8), nD = *(const ML_LAS f32x4*)(NB + 12);
          const unsigned t = ln; ML_LAS unsigned char* qrow = bQ + 256u * t; const unsigned xq = fxor(t) << 4;
          const bf16x8 c0 = *(const ML_LAS bf16x8*)(qrow + (((2u * wid) << 4) ^ xq)), c1 = *(const ML_LAS bf16x8*)(qrow + (((2u * wid + 1u) << 4) ^ xq));
          float qn = 0.f;
#pragma unroll
          for (int e = 0; e < 4; ++e) { qn = fmaf(s2f(c0[e]), nA[e], qn); qn = fmaf(s2f(c0[4 + e]), nC[e], qn); qn = fmaf(s2f(c1[e]), nB[e], qn); qn = fmaf(s2f(c1[4 + e]), nD[e], qn); }
          QNP[wid * 64 + t] = qn; }
        f32x16 Y0, Y1;
        { ML_OPAQUE_LANE(ln); const unsigned r31 = ln & 31u, h5 = ln >> 5; const unsigned xq = fxor(r31) << 4; ML_LAS unsigned char* q0 = bQ + 256u * r31; ML_LAS unsigned char* q1 = q0 + 256u * 32u;
#pragma unroll
          for (int i = 0; i < 4; ++i) { C[i] = C[i] * sc;
#pragma unroll
              for (int s = 0; s < 2; ++s) { const bf16x8 bfr = pack8(C[i][8 * s + 0], C[i][8 * s + 1], C[i][8 * s + 2], C[i][8 * s + 3], C[i][8 * s + 4], C[i][8 * s + 5], C[i][8 * s + 6], C[i][8 * s + 7]);
                  const unsigned co = ((4u * i + 2u * s + h5) << 4) ^ xq;
                  const bf16x8 a0 = *(const ML_LAS bf16x8*)(q0 + co), a1 = *(const ML_LAS bf16x8*)(q1 + co);
                  if (i == 0 && s == 0) { Y0 = __builtin_amdgcn_mfma_f32_32x32x16_bf16(a0, bfr, (f32x16){0.f}, 0, 0, 0); Y1 = __builtin_amdgcn_mfma_f32_32x32x16_bf16(a1, bfr, (f32x16){0.f}, 0, 0, 0); }
                  else { Y0 = __builtin_amdgcn_mfma_f32_32x32x16_bf16(a0, bfr, Y0, 0, 0, 0); Y1 = __builtin_amdgcn_mfma_f32_32x32x16_bf16(a1, bfr, Y1, 0, 0, 0); } } } }
        bf16x8 vw[4];
        { ML_OPAQUE_LANE(ln); const unsigned h5 = ln >> 5, kg = ln >> 4; const unsigned vt = wid >> 2, vc = wid & 3; bf16x8 vf[4];
          ML_LAS unsigned char* v0 = bV + 16384u * vt + ((64u * vc) ^ trX); ML_LAS unsigned char* va = v0 + trL0; ML_LAS unsigned char* vb = v0 + trL1;
#pragma unroll
          for (int ks = 0; ks < 4; ++ks) vf[ks] = cat8(trrd(va + 4096 * ks), trrd(vb + 4096 * ks));
          ML_LAS float* vwe = VWE + 8 * h5;
#pragma unroll
          for (int ks = 0; ks < 4; ++ks) { const f32x4 w0 = *(const ML_LAS f32x4*)(vwe + 16 * ks), w1 = *(const ML_LAS f32x4*)(vwe + 16 * ks + 4);
              vw[ks] = pack8(s2f(vf[ks][0]) * w0[0], s2f(vf[ks][1]) * w0[1], s2f(vf[ks][2]) * w0[2], s2f(vf[ks][3]) * w0[3], s2f(vf[ks][4]) * w1[0], s2f(vf[ks][5]) * w1[1], s2f(vf[ks][6]) * w1[2], s2f(vf[ks][7]) * w1[3]); }
          ML_LAS unsigned char* ka = bK + trL0; ML_LAS unsigned char* kb = bK + trL1;
#pragma unroll
          for (int i = 0; i < 4; ++i) { const unsigned xo = (64u * i) ^ trX;
#pragma unroll
              for (int ks = 0; ks < 4; ++ks) C[i] = __builtin_amdgcn_mfma_f32_32x32x16_bf16(cat8(trrd(ka + xo + 4096 * ks), trrd(kb + xo + 4096 * ks)), vw[ks], C[i], 0, 0, 0); }
          ML_LAS unsigned char* t16a = bK + tr_addr16(ln, wid, 0, 0); ML_LAS unsigned char* t16b = bK + tr_addr16(ln, wid, 0, 1);
#pragma unroll
          for (int ks = 0; ks < 2; ++ks) { const bf16x8 af = cat8(trrd(t16a + 8192 * ks), trrd(t16b + 8192 * ks));
              const f32x4 w0 = *(const ML_LAS f32x4*)(VWE + 32 * ks + 8 * kg), w1 = *(const ML_LAS f32x4*)(VWE + 32 * ks + 8 * kg + 4);
              n4 = __builtin_amdgcn_mfma_f32_16x16x32_bf16(af, pack8(w0[0], w0[1], w0[2], w0[3], w1[0], w1[1], w1[2], w1[3]), n4, 0, 0, 0); } }
        asm volatile("s_waitcnt lgkmcnt(0)" ::: "memory"); __builtin_amdgcn_s_barrier(); asm volatile("" ::: "memory");
        { ML_OPAQUE_LANE(ln); const unsigned r31 = ln & 31u, h5 = ln >> 5;
          ML_LAS unsigned char* p0 = lds + P_OFF + 128u * r31; ML_LAS unsigned char* p1 = p0 + 128u * 32u; const unsigned xp = (r31 & 7u) << 4;
#pragma unroll
          for (int ks = 0; ks < 4; ++ks) { const unsigned co = ((2u * ks + h5) << 4) ^ xp;
              const bf16x8 a0 = *(const ML_LAS bf16x8*)(p0 + co), a1 = *(const ML_LAS bf16x8*)(p1 + co);
              Y0 = __builtin_amdgcn_mfma_f32_32x32x16_bf16(a0, vw[ks], Y0, 0, 0, 0); Y1 = __builtin_amdgcn_mfma_f32_32x32x16_bf16(a1, vw[ks], Y1, 0, 0, 0); } }
        { ML_OPAQUE_LANE(ln); const unsigned t = ln; float qs = 0.f;
#pragma unroll
          for (int w8 = 0; w8 < 8; ++w8) qs += QNP[w8 * 64 + t];
          const float dn = DENP[t] + DENP[64 + t] + qs; VR[t] = 1.f / fmaxf(fabsf(dn), VEMT[t]); }
        { ML_OPAQUE_LANE(ln); const unsigned h5 = ln >> 5; ML_LAS float* vr = VR + 4 * h5;
#pragma unroll
          for (int qp = 0; qp < 2; ++qp) { const f32x4 ra = *(const ML_LAS f32x4*)(vr + 16 * qp), rb = *(const ML_LAS f32x4*)(vr + 16 * qp + 8), rc = *(const ML_LAS f32x4*)(vr + 32 + 16 * qp), rd = *(const ML_LAS f32x4*)(vr + 32 + 16 * qp + 8);
              const int o = 8 * qp;
              const u32x4 w0 = {pkbf(Y0[o + 0] * ra[0], Y0[o + 1] * ra[1]), pkbf(Y0[o + 2] * ra[2], Y0[o + 3] * ra[3]), pkbf(Y0[o + 4] * rb[0], Y0[o + 5] * rb[1]), pkbf(Y0[o + 6] * rb[2], Y0[o + 7] * rb[3])};
              const u32x4 w1 = {pkbf(Y1[o + 0] * rc[0], Y1[o + 1] * rc[1]), pkbf(Y1[o + 2] * rc[2], Y1[o + 3] * rc[3]), pkbf(Y1[o + 4] * rd[0], Y1[o + 5] * rd[1]), pkbf(Y1[o + 6] * rd[2], Y1[o + 7] * rd[3])};
              pend[qp] = w0; pend[2 + qp] = w1; } }
        asm volatile("" : "+v"(gi_b), "+v"(gf_b));
        sc = sc_n; gi_a = gi_b; gf_a = gf_b;
    }
    { unsigned char* hc = ho + (size_t)(SEQ / 64 - 1) * 32768; *(u32x4*)(hc) = pend[0]; *(u32x4*)(hc + 1024) = pend[1]; *(u32x4*)(hc + 2048) = pend[2]; *(u32x4*)(hc + 3072) = pend[3]; }
#undef ML_STAGE
#undef ML_GATES
#undef ML_VEC
#undef ML_TB
    __syncthreads();
}
}

constexpr int NWAVES = 8;
constexpr int RING_BYTES = 131072;
constexpr int LDS_BYTES = 163840;
constexpr int XCH_OFF = RING_BYTES, ROPE_LDS_OFF = XCH_OFF + 8192, QKG_LDS_OFF = ROPE_LDS_OFF + 16384, SCL_LDS_OFF = QKG_LDS_OFF + 1024;
static_assert(SCL_LDS_OFF + 4096 <= LDS_BYTES - 16, "in-projection LDS map");
static_assert(ml::LDS_END <= LDS_BYTES, "mLSTM LDS map");
#define LAS __attribute__((address_space(3)))
#define GAS __attribute__((address_space(1)))
typedef unsigned v4u __attribute__((ext_vector_type(4)));
typedef unsigned v2u __attribute__((ext_vector_type(2)));
typedef float f32x4 __attribute__((ext_vector_type(4)));
#define LDS_WAIT() asm volatile("s_waitcnt lgkmcnt(0)" ::: "memory")

struct Args { const float* in[9]; float* out; unsigned char* ws; int ph_lo, ph_hi; };

__device__ __forceinline__ float wave_sum(float v) {
#pragma unroll
    for (int o = 1; o < 64; o <<= 1) v += __shfl_xor(v, o);
    return v;
}

#define XB_TMO      128
#define XB_XCNT(j)  (256  + 64 * (j))
#define XB_XSUB(j)  (1280 + 64 * (j))
#define XB_XGEN(j)  (2304 + 64 * (j))
#define XB_TOP      3328
#define XB_TOPGEN   3392
#define XCD_BAR_WORDS 3456
#define XB_SPIN_CAP (1u << 18)

__device__ __forceinline__ unsigned xb_ld(unsigned* p)              { return __hip_atomic_load(p, __ATOMIC_RELAXED, __HIP_MEMORY_SCOPE_AGENT); }
__device__ __forceinline__ unsigned xb_add(unsigned* p, unsigned v) { return __hip_atomic_fetch_add(p, v, __ATOMIC_RELAXED, __HIP_MEMORY_SCOPE_AGENT); }
__device__ __forceinline__ unsigned xb_xcc_id() { return (unsigned)__builtin_amdgcn_s_getreg((3 << 11) | 20) & 0xFu; }
#define XB_SPIN(cond, bar) do { unsigned _sp = 0; while (cond) { __builtin_amdgcn_s_sleep(1); \
    if ((++_sp & 255u) == 0u) { if (xb_ld(&(bar)[XB_TMO])) break; if (_sp > XB_SPIN_CAP) { atomicAdd(&(bar)[XB_TMO], 1u); break; } } } } while (0)

struct XcdBarrier {
    unsigned* bar; unsigned x;
    volatile LAS unsigned* st;
};

__device__ __forceinline__ XcdBarrier xcd_barrier_post(unsigned* bar, volatile LAS unsigned* st) {
    XcdBarrier b; b.bar = bar; b.x = xb_xcc_id(); b.st = st;
    if (threadIdx.x == 0) (void)xb_add(&bar[XB_XCNT(b.x)], 1u);
    return b;
}
__device__ __forceinline__ void xcd_barrier_complete(unsigned* bar, unsigned x, unsigned& nloc, unsigned& nx) {
    const unsigned G = gridDim.x * gridDim.y * gridDim.z;
    unsigned sum, cnt, mine, sp = 0u;
    for (;;) {
        sum = 0u; cnt = 0u; mine = 0u;
#pragma unroll
        for (unsigned j = 0; j < 16; ++j) { const unsigned c = xb_ld(&bar[XB_XCNT(j)]); sum += c; cnt += (c > 0u) ? 1u : 0u; mine = (j == x) ? c : mine; }
        if (sum == G) break;
        __builtin_amdgcn_s_sleep(1);
        if ((++sp & 255u) == 0u) { if (xb_ld(&bar[XB_TMO])) break; if (sp > XB_SPIN_CAP) { atomicAdd(&bar[XB_TMO], 1u); break; } }
    }
    nloc = mine > 0u ? mine : 1u; nx = cnt > 0u ? cnt : 1u;
}

__device__ __forceinline__ void xcd_barrier(const XcdBarrier& b) {
    asm volatile("s_waitcnt vmcnt(0)" ::: "memory");
    __syncthreads();
    if (threadIdx.x == 0) {
        unsigned* bar = b.bar;
        __builtin_amdgcn_s_waitcnt(0);
        unsigned nloc = b.st[0], nx = b.st[1];
        if (nloc == 0u) { xcd_barrier_complete(bar, b.x, nloc, nx); b.st[0] = nloc; b.st[1] = nx; }
        const unsigned old = xb_add(&bar[XB_XSUB(b.x)], 1u);
        const unsigned gen = old / nloc;
        if (old + 1u == (gen + 1u) * nloc) {
            __builtin_amdgcn_fence(__ATOMIC_RELEASE, "agent");
            asm volatile("s_waitcnt vmcnt(0)" ::: "memory");
            const unsigned og = xb_add(&bar[XB_TOP], 1u);
            const unsigned tg = og / nx;
            if (og + 1u == (tg + 1u) * nx) xb_add(&bar[XB_TOPGEN], 1u);
            else XB_SPIN(xb_ld(&bar[XB_TOPGEN]) == tg, bar);
            __builtin_amdgcn_fence(__ATOMIC_ACQUIRE, "agent");
            xb_add(&bar[XB_XGEN(b.x)], 1u);
            asm volatile("s_waitcnt vmcnt(0)" ::: "memory");
        } else {
            XB_SPIN(xb_ld(&bar[XB_XGEN(b.x)]) == gen, bar);
            __builtin_amdgcn_fence(__ATOMIC_ACQUIRE, "agent");
            asm volatile("s_waitcnt vmcnt(0)" ::: "memory");
        }
    }
    __syncthreads();
}

__device__ __forceinline__ int w1_dest_row(int n) {
    if (!HY_SEPARATE_ROPE && n < 1280) { const int s = n & 255; return (n & ~255) | (s & 0xC3) | ((s & 0x10) << 1) | ((s & 0x0C) << 1) | ((s & 0x20) >> 3); }
    if (n >= 2560 && n < 3072) return (n & ~12) | ((n & 4) << 1) | ((n & 8) >> 1);
    return n;
}
__device__ __forceinline__ int q8_dest_row(int n) { return n < NQA ? w1_dest_row(n) : n - (NB1 - NB0); }
__device__ __forceinline__ unsigned pk4i8(float a, float b, float c, float d) {
    int ia = (int)__builtin_rintf(a), ib = (int)__builtin_rintf(b), ic = (int)__builtin_rintf(c), id = (int)__builtin_rintf(d);
    ia = ia < -127 ? -127 : (ia > 127 ? 127 : ia); ib = ib < -127 ? -127 : (ib > 127 ? 127 : ib); ic = ic < -127 ? -127 : (ic > 127 ? 127 : ic); id = id < -127 ? -127 : (id > 127 ? 127 : id);
    return ((unsigned)ia & 0xffu) | (((unsigned)ib & 0xffu) << 8) | (((unsigned)ic & 0xffu) << 16) | ((unsigned)id << 24); }
template <int MODE>
__device__ __forceinline__ void p0_transpose_item(const float* W, int K, int ldw, int kb, int n0, void* WT, LAS float* scr, int lane, const LAS float* cinv) {
    const int k0 = 64 * kb;
#pragma unroll 8
    for (int i = 0; i < 32; ++i) { const int kk = 2 * i + (lane >> 5); scr[kk * 33 + (lane & 31)] = W[(size_t)(k0 + kk) * ldw + n0 + (lane & 31)]; }
    LDS_WAIT(); asm volatile("" ::: "memory");
    const int c = lane & 7;
#pragma unroll
    for (int j = 0; j < 4; ++j) { const int n = (lane >> 3) + 8 * j; const LAS float* s = scr + (8 * c) * 33 + n;
        if constexpr (MODE == 2) { const float ci = cinv[n];
            v2u o8; o8.x = pk4i8(s[0 * 33] * ci, s[1 * 33] * ci, s[2 * 33] * ci, s[3 * 33] * ci); o8.y = pk4i8(s[4 * 33] * ci, s[5 * 33] * ci, s[6 * 33] * ci, s[7 * 33] * ci);
            *(v2u*)((unsigned char*)WT + (size_t)q8_dest_row(n0 + n) * K + k0 + 8 * c) = o8; }
        else if constexpr (MODE == 3) { unsigned char* rowp = (unsigned char*)WT + (size_t)(n0 + n) * 4096;
            if (kb < 16) { v2u o8; o8.x = pk4f8(s[0 * 33] * W8_SCALE, s[1 * 33] * W8_SCALE, s[2 * 33] * W8_SCALE, s[3 * 33] * W8_SCALE); o8.y = pk4f8(s[4 * 33] * W8_SCALE, s[5 * 33] * W8_SCALE, s[6 * 33] * W8_SCALE, s[7 * 33] * W8_SCALE);
                *(v2u*)(rowp + k0 + 8 * c) = o8; }
            else { v4u o; o.x = pk2(s[0 * 33], s[1 * 33]); o.y = pk2(s[2 * 33], s[3 * 33]); o.z = pk2(s[4 * 33], s[5 * 33]); o.w = pk2(s[6 * 33], s[7 * 33]);
                *(v4u*)(rowp + 1024 + (size_t)(k0 - 1024 + 8 * c) * 2) = o; } }
        else { const float ws_ = (MODE == 1 && n0 + n < 3072) ? 0.08838834764831845f : 1.f;
            v4u o; o.x = pk2(s[0 * 33] * ws_, s[1 * 33] * ws_); o.y = pk2(s[2 * 33] * ws_, s[3 * 33] * ws_); o.z = pk2(s[4 * 33] * ws_, s[5 * 33] * ws_); o.w = pk2(s[6 * 33] * ws_, s[7 * 33] * ws_);
            const int nr = (MODE == 1) ? w1_dest_row(n0 + n) - NB0 : n0 + n;
            *(v4u*)((bf16*)WT + (size_t)nr * K + k0 + 8 * c) = o; } }
    LDS_WAIT(); asm volatile("" ::: "memory");
}
__device__ __forceinline__ void p0_q8_colblock(const float* w_in, unsigned char* ws, LAS unsigned char* lds, int cb, int tid, int wave, int lane) {
    const int n0 = cb < NQA / 32 ? 32 * cb : NB1 + 32 * (cb - NQA / 32);
    LAS float* red = (LAS float*)(lds + 8 * 16384);
    const int c4 = (lane & 7) * 4, kr = lane >> 3;
    const float* src = w_in + (size_t)(256 * wave + kr) * NPROJ + n0 + c4;
    f32x4 mx = {0.f, 0.f, 0.f, 0.f};
#pragma unroll 8
    for (int i = 0; i < 32; ++i) { const f32x4 v = *(const f32x4*)(src + (size_t)(8 * i) * NPROJ);
        mx.x = fmaxf(mx.x, fabsf(v.x)); mx.y = fmaxf(mx.y, fabsf(v.y)); mx.z = fmaxf(mx.z, fabsf(v.z)); mx.w = fmaxf(mx.w, fabsf(v.w)); }
#pragma unroll
    for (int o = 8; o < 64; o <<= 1) { mx.x = fmaxf(mx.x, __shfl_xor(mx.x, o)); mx.y = fmaxf(mx.y, __shfl_xor(mx.y, o)); mx.z = fmaxf(mx.z, __shfl_xor(mx.z, o)); mx.w = fmaxf(mx.w, __shfl_xor(mx.w, o)); }
    if (lane < 8) *(LAS f32x4*)(red + wave * 32 + c4) = mx;
    __syncthreads();
    if (tid < 32) { float m = red[tid];
#pragma unroll
        for (int w = 1; w < 8; ++w) m = fmaxf(m, red[w * 32 + tid]);
        m = fmaxf(m, 1e-30f); red[256 + tid] = 127.f / m; ((float*)(ws + WS_SW))[q8_dest_row(n0 + tid)] = m * (1.f / 127.f); }
    __syncthreads();
    LAS float* scr = (LAS float*)(lds + wave * 16384);
    for (int i = 0; i < 4; ++i) p0_transpose_item<2>(w_in, DM, NPROJ, 4 * wave + i, n0, ws + WS_W8T, scr, lane, red + 256);
    __syncthreads();
}
__device__ __forceinline__ float wave_max(float v) {
#pragma unroll
    for (int o = 1; o < 64; o <<= 1) v = fmaxf(v, __shfl_xor(v, o));
    return v;
}
__device__ __forceinline__ void rms_rows2_to_bf16(const float* xrow0, const float* xrow1, const float* g, bf16* orow0, bf16* orow1, unsigned char* frow0, unsigned char* frow1, float* sa0, float* sa1, int lane) {
    const f32x4* xa = (const f32x4*)xrow0 + lane; const f32x4* xb = (const f32x4*)xrow1 + lane; const f32x4* gr = (const f32x4*)g + lane;
    f32x4 v[8], w[8]; float s = 0.f, t = 0.f;
#pragma unroll
    for (int j = 0; j < 8; ++j) { v[j] = __builtin_nontemporal_load(xa + 64 * j); w[j] = __builtin_nontemporal_load(xb + 64 * j); }
#pragma unroll
    for (int j = 0; j < 8; ++j) { s += (v[j].x * v[j].x + v[j].y * v[j].y) + (v[j].z * v[j].z + v[j].w * v[j].w); t += (w[j].x * w[j].x + w[j].y * w[j].y) + (w[j].z * w[j].z + w[j].w * w[j].w); }
    const float r0 = 1.f / sqrtf(wave_sum(s) * (1.f / DM) + EPS), r1 = 1.f / sqrtf(wave_sum(t) * (1.f / DM) + EPS);
    float m0 = 0.f, m1 = 0.f;
#pragma unroll
    for (int j = 0; j < 8; ++j) { const f32x4 gg = gr[64 * j]; v[j] = v[j] * r0 * gg; w[j] = w[j] * r1 * gg;
        m0 = fmaxf(fmaxf(m0, fmaxf(fabsf(v[j].x), fabsf(v[j].y))), fmaxf(fabsf(v[j].z), fabsf(v[j].w))); m1 = fmaxf(fmaxf(m1, fmaxf(fabsf(w[j].x), fabsf(w[j].y))), fmaxf(fabsf(w[j].z), fabsf(w[j].w))); }
    m0 = fmaxf(wave_max(m0), 1e-30f); m1 = fmaxf(wave_max(m1), 1e-30f);
    const float i0 = 127.f / m0, i1 = 127.f / m1;
    if (lane == 0) { *sa0 = m0 * (1.f / 127.f); *sa1 = m1 * (1.f / 127.f); }
    v2u* o0 = (v2u*)orow0 + lane; v2u* o1 = (v2u*)orow1 + lane; unsigned* f0 = (unsigned*)frow0 + lane; unsigned* f1 = (unsigned*)frow1 + lane;
#pragma unroll
    for (int j = 0; j < 8; ++j) { v2u a, b;
        a.x = pk2(v[j].x, v[j].y); a.y = pk2(v[j].z, v[j].w); o0[64 * j] = a; f0[64 * j] = pk4i8(v[j].x * i0, v[j].y * i0, v[j].z * i0, v[j].w * i0);
        b.x = pk2(w[j].x, w[j].y); b.y = pk2(w[j].z, w[j].w); o1[64 * j] = b; f1[64 * j] = pk4i8(w[j].x * i1, w[j].y * i1, w[j].z * i1, w[j].w * i1); }
}
__device__ __forceinline__ void p0_prologue(const Args& a, LAS unsigned char* lds, int vcu, int G, int tid, int wave, int lane) {
    unsigned char* ws = a.ws;
    const float* w_in = a.in[3]; const float* w_out = a.in[8]; const float* norm_g = a.in[2];
    bf16* W2t = (bf16*)(ws + WS_W2T);
    const int gw = vcu * NWAVES + wave, NGW = G * NWAVES; const int gt = vcu * (NWAVES * 64) + tid, NGT = G * NWAVES * 64;
    for (int e = gt; e < 64 * 32; e += NGT) { const int pos = e >> 5, j = e & 31; const float inv = 1.0f / powf(10000.0f, (float)j * (1.0f / 32.0f)); const float ang = (float)pos * inv;
        float* R = (float*)(ws + WS_ROPE); R[2 * e] = cosf(ang); R[2 * e + 1] = sinf(ang); }
    for (int e = gt; e < 16 * DM; e += NGT) { const int g = e >> 11, k = e & (DM - 1); ((bf16*)(ws + WS_WGT))[(size_t)g * DM + k] = (bf16)f2bf(w_in[(size_t)k * NPROJ + NP256 + g]); }
    for (int cb = vcu; cb < NQ8 / 32; cb += G) p0_q8_colblock(w_in, ws, lds, cb, tid, wave, lane);
    LAS float* scr = (LAS float*)(lds + wave * 16384);
    constexpr int I_1 = (DM / 64) * ((NB1 - NB0) / 32), I_2 = (DM / 64) * (DM / 32);
    for (int it = gw; it < I_1 + I_2; it += NGW) {
        if (it < I_1) p0_transpose_item<1>(w_in, DM, NPROJ, it / ((NB1 - NB0) / 32), NB0 + 32 * (it % ((NB1 - NB0) / 32)), ws + WS_W1B, scr, lane, nullptr);
        else p0_transpose_item<3>(w_out, DM, DM, (it - I_1) / (DM / 32), 32 * ((it - I_1) % (DM / 32)), W2t, scr, lane, nullptr);
    }
    bf16* H = (bf16*)(ws + WS_H); unsigned char* H8 = (unsigned char*)a.out; float* SA = (float*)(ws + WS_SA);
    for (int m = gw; m < NTOK; m += 2 * NGW) { const int m1 = (m + NGW < NTOK) ? m + NGW : m;
        const float* xr0 = (m < TOK_PROMPT) ? a.in[0] + (size_t)m * DM : a.in[1] + (size_t)(m - TOK_PROMPT) * DM; const float* xr1 = (m1 < TOK_PROMPT) ? a.in[0] + (size_t)m1 * DM : a.in[1] + (size_t)(m1 - TOK_PROMPT) * DM;
        rms_rows2_to_bf16(xr0, xr1, norm_g, H + (size_t)m * DM, H + (size_t)m1 * DM, H8 + (size_t)m * DM, H8 + (size_t)m1 * DM, SA + m, SA + m1, lane); }
}

__device__ __forceinline__ void p2_qknorm_rope(const Args& a, int vcu, int G, int wave, int lane) {
    unsigned char* ws = a.ws; const float* R = (const float*)(ws + WS_ROPE);
    const int gw = vcu * NWAVES + wave, NGW = G * NWAVES;
    const int fj = lane & 31, c0 = (lane < 32) ? lane : 64 + (lane - 32), c1 = c0 + 32;
    const float gq0 = a.in[5][c0], gq1 = a.in[5][c1], gk0 = a.in[6][c0], gk1 = a.in[6][c1];
    for (int it = gw; it < NTOK * 10; it += NGW) {
        const int t = it / 10, slot = it - t * 10; const int tl = t & (SEQ - 1); const int pos = (lane < 32) ? (tl >> 6) : (tl & 63);
        bf16* p = (slot < 8) ? (bf16*)((unsigned char*)a.out + DO_Q) + (size_t)t * 1024 + slot * 128 : (bf16*)(ws + WS_AK) + (size_t)t * 256 + (slot - 8) * 128;
        const float x0 = bf2f(p[c0]), x1 = bf2f(p[c1]);
        const float r = 1.f / sqrtf(wave_sum(x0 * x0 + x1 * x1) * (1.f / 128.f) + EPS);
        const float y0 = x0 * r * ((slot < 8) ? gq0 : gk0), y1 = x1 * r * ((slot < 8) ? gq1 : gk1);
        const float cs = R[2 * (pos * 32 + fj)], sn = R[2 * (pos * 32 + fj) + 1];
        p[c0] = (bf16)f2bf(y0 * cs - y1 * sn); p[c1] = (bf16)f2bf(y1 * cs + y0 * sn);
    }
}

__device__ __forceinline__ void p4_mlstm_recurrent(const Args& a, LAS unsigned char* lds, int vcu, int G, int tid) {
    unsigned char* ws = a.ws;
    const bf16* MQ = (const bf16*)(ws + WS_MQ); const bf16* MK = (const bf16*)(ws + WS_MK); const bf16* MV = (const bf16*)(ws + WS_MV); const float* GT = (const float*)(ws + WS_GATES);
    LAS float* qs = (LAS float*)lds;
    LAS float* ks = qs + 32 * 128;
    LAS float* vs = ks + 32 * 128;
    LAS float* gi = vs + 32 * 256;
    LAS float* gf = gi + 32;
    const int dv = tid >> 1, half = tid & 1;
    for (int item = vcu; item < NSEQ * 8; item += G) {
        const int b = item >> 3, hd = (item >> 1) & 3, dir = item & 1;
        bf16* HO = (bf16*)(ws + (dir ? WS_HB : WS_HF));
        float C[64], nn[64]; float m = 0.f;
#pragma unroll
        for (int j = 0; j < 64; ++j) { C[j] = 0.f; nn[j] = 0.f; }
        for (int p0 = 0; p0 < SEQ; p0 += 32) {
            __syncthreads();
            { const int rr = tid >> 4, c8 = (tid & 15) * 8; const int tok = dir ? (SEQ - 1 - (p0 + rr)) : (p0 + rr); const size_t row = (size_t)b * SEQ + tok;
              const v4u q4 = *(const v4u*)(MQ + row * 512 + hd * 128 + c8), k4 = *(const v4u*)(MK + row * 512 + hd * 128 + c8);
              LAS float* kd = ks + rr * 128 + c8;
              { LAS float* qa = qs + rr * 128 + (c8 & ~8) + ((c8 & 8) >> 1);   qa[0] = bflo(q4.x); qa[1] = bfhi(q4.x); qa[2] = bflo(q4.y); qa[3] = bfhi(q4.y); qa[8] = bflo(q4.z); qa[9] = bfhi(q4.z); qa[10] = bflo(q4.w); qa[11] = bfhi(q4.w); }
              kd[0] = bflo(k4.x); kd[1] = bfhi(k4.x); kd[2] = bflo(k4.y); kd[3] = bfhi(k4.y); kd[4] = bflo(k4.z); kd[5] = bfhi(k4.z); kd[6] = bflo(k4.w); kd[7] = bfhi(k4.w);
              const int c16 = (tid & 15) * 16; LAS float* vd = vs + rr * 256 + c16;
#pragma unroll
              for (int h2 = 0; h2 < 2; ++h2) { const v4u v4 = *(const v4u*)(MV + row * 1024 + hd * 256 + c16 + 8 * h2);
                  vd[8 * h2 + 0] = bflo(v4.x); vd[8 * h2 + 1] = bfhi(v4.x); vd[8 * h2 + 2] = bflo(v4.y); vd[8 * h2 + 3] = bfhi(v4.y); vd[8 * h2 + 4] = bflo(v4.z); vd[8 * h2 + 5] = bfhi(v4.z); vd[8 * h2 + 6] = bflo(v4.w); vd[8 * h2 + 7] = bfhi(v4.w); }
              if (tid < 32) { const int tk = dir ? (SEQ - 1 - (p0 + tid)) : (p0 + tid); const size_t rw = (size_t)b * SEQ + tk; gi[tid] = GT[rw * 16 + dir * 8 + hd]; gf[tid] = GT[rw * 16 + dir * 8 + 4 + hd]; }
            }
            __syncthreads();
            for (int pp = 0; pp < 32; ++pp) {
                const float lf = gf[pp], ii = gi[pp];
                const float mn = fmaxf(lf + m, ii);
                const float ca = expf(lf + m - mn), cb = expf(ii - mn);
                const float bv = cb * vs[pp * 256 + dv];
                float hp = 0.f, qn = 0.f;
                const LAS float* kr = ks + pp * 128 + 64 * half; const LAS float* qr = qs + pp * 128 + 64 * half;
#pragma unroll
                for (int j = 0; j < 64; ++j) { const float kk = kr[j], qq = qr[j];
                    C[j] = fmaf(ca, C[j], kk * bv); nn[j] = fmaf(ca, nn[j], cb * kk); hp = fmaf(qq, C[j], hp); qn = fmaf(qq, nn[j], qn); }
                hp += __shfl_xor(hp, 1); qn += __shfl_xor(qn, 1);
                const float den = fmaxf(fabsf(qn), expf(-mn));
                if (half == 0) { const int pos = p0 + pp, cch = pos >> 6, o = pos & 63, tt = o >> 5, rho = o & 31, q = rho >> 3, hh = (rho >> 2) & 1, e = rho & 3;
                    HO[(((size_t)((b * 4 + hd) * 32 + cch) * 32768) + (dv >> 5) * 4096 + tt * 2048 + (q >> 1) * 1024 + (32 * hh + (dv & 31)) * 16) / 2 + 4 * (q & 1) + e] = (bf16)f2bf(hp / den); }
                m = mn;
            }
        }
    }
}

__device__ __forceinline__ void p5_mlstm_finalize(const Args& a, LAS unsigned char* lds, int vcu, int G, int tid, int wave, int lane) {
    unsigned char* ws = a.ws; const float* mg = a.in[7];
    const bf16* MO = (const bf16*)(ws + WS_MO); const bf16* MZ = (const bf16*)(ws + WS_MZ); bf16* MIX = (bf16*)(ws + WS_MIX);
    LAS float* XS = (LAS float*)lds;
    const int r31 = lane & 31, h5 = lane >> 5, dv0 = 8 * r31;
    constexpr int NIT = NSEQ * 4 * 32;
    v4u f[2][2], bb[2][2];
#define P5_LOAD_H(item_) do { const int bh_ = (item_) >> 5, ck_ = (item_) & 31; \
        const unsigned char* hf_ = ws + WS_HF + ((size_t)bh_ * 32 + ck_) * 32768 + wave * 4096 + lane * 16; const unsigned char* hb_ = ws + WS_HB + ((size_t)bh_ * 32 + (31 - ck_)) * 32768 + wave * 4096 + (lane ^ 32) * 16; \
        _Pragma("unroll") for (int tt = 0; tt < 2; ++tt) _Pragma("unroll") for (int qp = 0; qp < 2; ++qp) { f[tt][qp] = *(const v4u*)(hf_ + tt * 2048 + qp * 1024); bb[tt][qp] = *(const v4u*)(hb_ + (1 - tt) * 2048 + (1 - qp) * 1024); } } while (0)
    if (vcu < NIT) P5_LOAD_H(vcu);
    for (int item = vcu; item < NIT; item += G) {
        const int bh = item >> 5, ck = item & 31, b = bh >> 2, hd = bh & 3;
        v4u mo[4], mz[4];
#pragma unroll
        for (int it = 0; it < 4; ++it) { const int o = it * 16 + wave * 2 + h5; const size_t row = (size_t)b * SEQ + ck * 64 + o;
            mo[it] = *(const v4u*)(MO + row * 1024 + hd * 256 + dv0); mz[it] = *(const v4u*)(MZ + row * 1024 + hd * 256 + dv0); }
        __syncthreads();
#pragma unroll
        for (int tt = 0; tt < 2; ++tt)
#pragma unroll
            for (int qp = 0; qp < 2; ++qp) { const v4u fv = f[tt][qp], bv = bb[tt][qp];
                float fs[8] = {bflo(fv.x), bfhi(fv.x), bflo(fv.y), bfhi(fv.y), bflo(fv.z), bfhi(fv.z), bflo(fv.w), bfhi(fv.w)};
                float bs[8] = {bflo(bv.x), bfhi(bv.x), bflo(bv.y), bfhi(bv.y), bflo(bv.z), bfhi(bv.z), bflo(bv.w), bfhi(bv.w)};
#pragma unroll
                for (int j = 0; j < 8; ++j) { const int o = 32 * tt + 8 * (2 * qp + (j >> 2)) + 4 * h5 + (j & 3); XS[o * 256 + 32 * wave + r31] = fs[j] + bs[7 - j]; } }
        __syncthreads();
        if (item + G < NIT) P5_LOAD_H(item + G);
        const f32x4 g0 = *(const f32x4*)(mg + hd * 256 + dv0), g1 = *(const f32x4*)(mg + hd * 256 + dv0 + 4);
        const float gg[8] = {g0[0], g0[1], g0[2], g0[3], g1[0], g1[1], g1[2], g1[3]};
#pragma unroll
        for (int it = 0; it < 4; ++it) { const int o = it * 16 + wave * 2 + h5; const size_t row = (size_t)b * SEQ + ck * 64 + o;
            const f32x4 x0 = *(const LAS f32x4*)(XS + o * 256 + dv0), x1 = *(const LAS f32x4*)(XS + o * 256 + dv0 + 4);
            float hm[8] = {x0[0], x0[1], x0[2], x0[3], x1[0], x1[1], x1[2], x1[3]};
            const float mo8[8] = {bflo(mo[it].x), bfhi(mo[it].x), bflo(mo[it].y), bfhi(mo[it].y), bflo(mo[it].z), bfhi(mo[it].z), bflo(mo[it].w), bfhi(mo[it].w)};
            const float mz8[8] = {bflo(mz[it].x), bfhi(mz[it].x), bflo(mz[it].y), bfhi(mz[it].y), bflo(mz[it].z), bfhi(mz[it].z), bflo(mz[it].w), bfhi(mz[it].w)};
            float ss = 0.f;
#pragma unroll
            for (int j = 0; j < 8; ++j) { hm[j] = hm[j] * __builtin_amdgcn_rcpf(1.f + __expf(-mo8[j])); ss += hm[j] * hm[j]; }
#pragma unroll
            for (int s = 1; s < 32; s <<= 1) ss += __shfl_xor(ss, s);
            const float r = __builtin_amdgcn_rsqf(ss * (1.f / 256.f) + EPS);
            float ov[8];
#pragma unroll
            for (int j = 0; j < 8; ++j) ov[j] = hm[j] * r * gg[j] * (mz8[j] * __builtin_amdgcn_rcpf(1.f + __expf(-mz8[j])));
            v4u w; w.x = pk2(ov[0], ov[1]); w.y = pk2(ov[2], ov[3]); w.z = pk2(ov[4], ov[5]); w.w = pk2(ov[6], ov[7]);
            *(v4u*)(MIX + row * 2048 + 512 + hd * 256 + dv0) = w; }
    }
#undef P5_LOAD_H
    __syncthreads();
}

__device__ __forceinline__ void p5_item(const Args& a, LAS unsigned char* lds, int item) {
    int tid_ = threadIdx.x; asm volatile("" : "+v"(tid_));
    const int lane = tid_ & 63, wave = __builtin_amdgcn_readfirstlane(tid_ >> 6);
    unsigned char* ws = a.ws; const float* mg = a.in[7];
    const bf16* MO = (const bf16*)(ws + WS_MO); const bf16* MZ = (const bf16*)(ws + WS_MZ); bf16* MIX = (bf16*)(ws + WS_MIX);
    LAS float* XS = (LAS float*)lds; const int r31 = lane & 31, h5 = lane >> 5, dv0 = 8 * r31;
    const int bh = item >> 5, ck = item & 31, b = bh >> 2, hd = bh & 3;
    const unsigned char* hf_ = ws + WS_HF + ((size_t)bh * 32 + ck) * 32768 + wave * 4096 + lane * 16; const unsigned char* hb_ = ws + WS_HB + ((size_t)bh * 32 + (31 - ck)) * 32768 + wave * 4096 + (lane ^ 32) * 16;
    v4u f[2][2], bb[2][2], mo[4], mz[4];
#pragma unroll
    for (int tt = 0; tt < 2; ++tt)
#pragma unroll
        for (int qp = 0; qp < 2; ++qp) { f[tt][qp] = *(const v4u*)(hf_ + tt * 2048 + qp * 1024); bb[tt][qp] = *(const v4u*)(hb_ + (1 - tt) * 2048 + (1 - qp) * 1024); }
#pragma unroll
    for (int it = 0; it < 4; ++it) { const int o = it * 16 + wave * 2 + h5; const size_t row = (size_t)b * SEQ + ck * 64 + o;
        mo[it] = *(const v4u*)(MO + row * 1024 + hd * 256 + dv0); mz[it] = *(const v4u*)(MZ + row * 1024 + hd * 256 + dv0); }
    __syncthreads();
#pragma unroll
    for (int tt = 0; tt < 2; ++tt)
#pragma unroll
        for (int qp = 0; qp < 2; ++qp) { const v4u fv = f[tt][qp], bv = bb[tt][qp];
            float fs[8] = {bflo(fv.x), bfhi(fv.x), bflo(fv.y), bfhi(fv.y), bflo(fv.z), bfhi(fv.z), bflo(fv.w), bfhi(fv.w)};
            float bs[8] = {bflo(bv.x), bfhi(bv.x), bflo(bv.y), bfhi(bv.y), bflo(bv.z), bfhi(bv.z), bflo(bv.w), bfhi(bv.w)};
#pragma unroll
            for (int j = 0; j < 8; ++j) { const int o = 32 * tt + 8 * (2 * qp + (j >> 2)) + 4 * h5 + (j & 3); XS[o * 256 + 32 * wave + r31] = fs[j] + bs[7 - j]; } }
    __syncthreads();
    const f32x4 g0 = *(const f32x4*)(mg + hd * 256 + dv0), g1 = *(const f32x4*)(mg + hd * 256 + dv0 + 4);
    const float gg[8] = {g0[0], g0[1], g0[2], g0[3], g1[0], g1[1], g1[2], g1[3]};
#pragma unroll
    for (int it = 0; it < 4; ++it) { const int o = it * 16 + wave * 2 + h5; const size_t row = (size_t)b * SEQ + ck * 64 + o;
        const f32x4 x0 = *(const LAS f32x4*)(XS + o * 256 + dv0), x1 = *(const LAS f32x4*)(XS + o * 256 + dv0 + 4);
        float hm[8] = {x0[0], x0[1], x0[2], x0[3], x1[0], x1[1], x1[2], x1[3]};
        const float mo8[8] = {bflo(mo[it].x), bfhi(mo[it].x), bflo(mo[it].y), bfhi(mo[it].y), bflo(mo[it].z), bfhi(mo[it].z), bflo(mo[it].w), bfhi(mo[it].w)};
        const float mz8[8] = {bflo(mz[it].x), bfhi(mz[it].x), bflo(mz[it].y), bfhi(mz[it].y), bflo(mz[it].z), bfhi(mz[it].z), bflo(mz[it].w), bfhi(mz[it].w)};
        float ss = 0.f;
#pragma unroll
        for (int j = 0; j < 8; ++j) { hm[j] = hm[j] * __builtin_amdgcn_rcpf(1.f + __expf(-mo8[j])); ss += hm[j] * hm[j]; }
#pragma unroll
        for (int s = 1; s < 32; s <<= 1) ss += __shfl_xor(ss, s);
        const float r = __builtin_amdgcn_rsqf(ss * (1.f / 256.f) + EPS);
        float ov[8];
#pragma unroll
        for (int j = 0; j < 8; ++j) ov[j] = hm[j] * r * gg[j] * (mz8[j] * __builtin_amdgcn_rcpf(1.f + __expf(-mz8[j])));
        v4u w; w.x = pk2(ov[0], ov[1]); w.y = pk2(ov[2], ov[3]); w.z = pk2(ov[4], ov[5]); w.w = pk2(ov[6], ov[7]);
        *(v4u*)(MIX + row * 2048 + 512 + hd * 256 + dv0) = w; }
    __syncthreads();
}

__device__ __forceinline__ void p5_batch(const Args& a, LAS unsigned char* lds, int first, int count) {
    if (count <= 0) return;
    int tid_ = threadIdx.x; asm volatile("" : "+v"(tid_));
    const int lane = tid_ & 63, wave = __builtin_amdgcn_readfirstlane(tid_ >> 6);
    unsigned char* ws = a.ws; const float* mg = a.in[7];
    const bf16* MO = (const bf16*)(ws + WS_MO); const bf16* MZ = (const bf16*)(ws + WS_MZ); bf16* MIX = (bf16*)(ws + WS_MIX);
    LAS float* XS = (LAS float*)lds; const int r31 = lane & 31, h5 = lane >> 5, dv0 = 8 * r31;
    v4u f[2][2], bb[2][2];
#define P5B_LOAD_H(item_) do { const int bh_ = (item_) >> 5, ck_ = (item_) & 31; \
        const unsigned char* hf_ = ws + WS_HF + ((size_t)bh_ * 32 + ck_) * 32768 + wave * 4096 + lane * 16; const unsigned char* hb_ = ws + WS_HB + ((size_t)bh_ * 32 + (31 - ck_)) * 32768 + wave * 4096 + (lane ^ 32) * 16; \
        _Pragma("unroll") for (int tt = 0; tt < 2; ++tt) _Pragma("unroll") for (int qp = 0; qp < 2; ++qp) { f[tt][qp] = *(const v4u*)(hf_ + tt * 2048 + qp * 1024); bb[tt][qp] = *(const v4u*)(hb_ + (1 - tt) * 2048 + (1 - qp) * 1024); } } while (0)
    P5B_LOAD_H(first);
    for (int i = 0; i < count; ++i) {
        const int item = first + i, bh = item >> 5, ck = item & 31, b = bh >> 2, hd = bh & 3;
        v4u mo[4], mz[4];
#pragma unroll
        for (int it = 0; it < 4; ++it) { const int o = it * 16 + wave * 2 + h5; const size_t row = (size_t)b * SEQ + ck * 64 + o;
            mo[it] = *(const v4u*)(MO + row * 1024 + hd * 256 + dv0); mz[it] = *(const v4u*)(MZ + row * 1024 + hd * 256 + dv0); }
        __syncthreads();
#pragma unroll
        for (int tt = 0; tt < 2; ++tt)
#pragma unroll
            for (int qp = 0; qp < 2; ++qp) { const v4u fv = f[tt][qp], bv = bb[tt][qp];
                float fs[8] = {bflo(fv.x), bfhi(fv.x), bflo(fv.y), bfhi(fv.y), bflo(fv.z), bfhi(fv.z), bflo(fv.w), bfhi(fv.w)};
                float bs[8] = {bflo(bv.x), bfhi(bv.x), bflo(bv.y), bfhi(bv.y), bflo(bv.z), bfhi(bv.z), bflo(bv.w), bfhi(bv.w)};
#pragma unroll
                for (int j = 0; j < 8; ++j) { const int o = 32 * tt + 8 * (2 * qp + (j >> 2)) + 4 * h5 + (j & 3); XS[o * 256 + 32 * wave + r31] = fs[j] + bs[7 - j]; } }
        __syncthreads();
        if (i + 1 < count) P5B_LOAD_H(item + 1);
        const f32x4 g0 = *(const f32x4*)(mg + hd * 256 + dv0), g1 = *(const f32x4*)(mg + hd * 256 + dv0 + 4);
        const float gg[8] = {g0[0], g0[1], g0[2], g0[3], g1[0], g1[1], g1[2], g1[3]};
#pragma unroll
        for (int it = 0; it < 4; ++it) { const int o = it * 16 + wave * 2 + h5; const size_t row = (size_t)b * SEQ + ck * 64 + o;
            const f32x4 x0 = *(const LAS f32x4*)(XS + o * 256 + dv0), x1 = *(const LAS f32x4*)(XS + o * 256 + dv0 + 4);
            float hm[8] = {x0[0], x0[1], x0[2], x0[3], x1[0], x1[1], x1[2], x1[3]};
            const float mo8[8] = {bflo(mo[it].x), bfhi(mo[it].x), bflo(mo[it].y), bfhi(mo[it].y), bflo(mo[it].z), bfhi(mo[it].z), bflo(mo[it].w), bfhi(mo[it].w)};
            const float mz8[8] = {bflo(mz[it].x), bfhi(mz[it].x), bflo(mz[it].y), bfhi(mz[it].y), bflo(mz[it].z), bfhi(mz[it].z), bflo(mz[it].w), bfhi(mz[it].w)};
            float ss = 0.f;
#pragma unroll
            for (int j = 0; j < 8; ++j) { hm[j] = hm[j] * __builtin_amdgcn_rcpf(1.f + __expf(-mo8[j])); ss += hm[j] * hm[j]; }
#pragma unroll
            for (int s = 1; s < 32; s <<= 1) ss += __shfl_xor(ss, s);
            const float r = __builtin_amdgcn_rsqf(ss * (1.f / 256.f) + EPS);
            float ov[8];
#pragma unroll
            for (int j = 0; j < 8; ++j) ov[j] = hm[j] * r * gg[j] * (mz8[j] * __builtin_amdgcn_rcpf(1.f + __expf(-mz8[j])));
            v4u w; w.x = pk2(ov[0], ov[1]); w.y = pk2(ov[2], ov[3]); w.z = pk2(ov[4], ov[5]); w.w = pk2(ov[6], ov[7]);
            *(v4u*)(MIX + row * 2048 + 512 + hd * 256 + dv0) = w; }
    }
#undef P5B_LOAD_H
    __syncthreads();
}

__device__ __forceinline__ void gate_rows48(unsigned char* ws, const float* b_gates, int row0, int lane) {
    typedef short bf16x8 __attribute__((ext_vector_type(8)));
    const int r15 = lane & 15, kg = lane >> 4;
    const bf16* a0p = (const bf16*)(ws + WS_H) + (size_t)(row0 + r15) * DM + 8 * kg; const bf16* a1p = a0p + 16 * DM; const bf16* a2p = a0p + 32 * DM;
    const bf16* bp = (const bf16*)(ws + WS_WGT) + (size_t)r15 * DM + 8 * kg;
    f32x4 acc0 = {0.f, 0.f, 0.f, 0.f}, acc1 = {0.f, 0.f, 0.f, 0.f}, acc2 = {0.f, 0.f, 0.f, 0.f};
#pragma unroll 8
    for (int ks = 0; ks < DM / 32; ++ks) { const bf16x8 a0 = *(const bf16x8*)(a0p + 32 * ks), a1 = *(const bf16x8*)(a1p + 32 * ks), a2 = *(const bf16x8*)(a2p + 32 * ks), b = *(const bf16x8*)(bp + 32 * ks);
        acc0 = __builtin_amdgcn_mfma_f32_16x16x32_bf16(a0, b, acc0, 0, 0, 0); acc1 = __builtin_amdgcn_mfma_f32_16x16x32_bf16(a1, b, acc1, 0, 0, 0); acc2 = __builtin_amdgcn_mfma_f32_16x16x32_bf16(a2, b, acc2, 0, 0, 0); }
    const float bias = b_gates[r15]; const bool isf = (r15 >> 2) & 1; float* G = (float*)(ws + WS_GATES) + (size_t)(row0 + 4 * kg) * 16 + r15;
#pragma unroll
    for (int r = 0; r < 4; ++r) { float v0 = acc0[r] + bias, v1 = acc1[r] + bias, v2 = acc2[r] + bias; if (isf) { v0 = log_sigmoid_f(v0); v1 = log_sigmoid_f(v1); v2 = log_sigmoid_f(v2); }
        G[r * 16] = v0; G[(16 + r) * 16] = v1; G[(32 + r) * 16] = v2; }
}

constexpr int N_PHASES = 7;
__global__ void __launch_bounds__(NWAVES * 64, 2) hy_fwd(Args args) {
    extern __shared__ __attribute__((aligned(16))) unsigned char lds_raw[];
    LAS unsigned char* lds = (LAS unsigned char*)lds_raw;
    const int tid = threadIdx.x, lane = tid & 63, wave = __builtin_amdgcn_readfirstlane(tid >> 6);
    const int G = gridDim.x; const int bx = blockIdx.x; const int vcu = (G % 8 == 0) ? (bx % 8) * (G / 8) + bx / 8 : bx;
    unsigned char* ws = args.ws;
    const int lo = args.ph_lo, hi = args.ph_hi;
    unsigned* ctl = (unsigned*)(ws + WS_CTL);
    volatile LAS unsigned* bst = (volatile LAS unsigned*)(lds + LDS_BYTES - 16);
    if (tid == 0) { bst[0] = 0u; bst[1] = 0u; }
    __syncthreads();
    XcdBarrier xbar; xbar.bar = ctl + CW_BAR; xbar.x = 0; xbar.st = bst; bool xposted = false;
    const bool one_launch = (lo == 0 && hi == N_PHASES);
    if (one_launch) { xbar = xcd_barrier_post(ctl + CW_BAR, bst); xposted = true; }
#ifndef HY_PHASE_MASK
#define HY_PHASE_MASK 0x7f
#endif
#define IN(k) (((HY_PHASE_MASK >> (k)) & 1) && lo <= (k) && (k) < hi)
#define BOTH(k) (IN(k) && IN((k) + 1))
#ifndef HY_DUP_MASK
#define HY_DUP_MASK 0
#endif
#ifndef HY_PROBE_NULL
#define HY_PROBE_NULL 0
#endif
#ifndef HY_ML_PROBE_MODE
#define HY_ML_PROBE_MODE 0
#endif
#define DUP(k) (((HY_DUP_MASK) >> (k)) & 1)
#define GRID_BAR_CG() do { cg::this_grid().sync(); } while (0)
#define GRID_BAR() do { if (!xposted) { xbar = xcd_barrier_post(ctl + CW_BAR, bst); xposted = true; } xcd_barrier(xbar); } while (0)

    if (IN(0) && DUP(0)) { p0_prologue(args, lds, vcu, G, tid, wave, lane); __syncthreads(); }
    if (IN(0)) { p0_prologue(args, lds, vcu, G, tid, wave, lane); if (BOTH(0)) GRID_BAR(); }

    if (IN(1)) {
        { const float* Rg = (const float*)(ws + WS_ROPE); LAS float* Rl = (LAS float*)(lds + ROPE_LDS_OFF); LAS float* Gl = (LAS float*)(lds + QKG_LDS_OFF);
          for (int e = tid; e < 64 * 32 * 2; e += NWAVES * 64) Rl[e] = Rg[e];
          if (tid < 128) { Gl[tid] = args.in[5][tid]; Gl[128 + tid] = args.in[6][tid]; }
          __syncthreads(); }
        { pg8::Gemm g{(const pg8::bf16_t*)((unsigned char*)args.out + DO_H8), (const pg8::bf16_t*)(ws + WS_W8T), NTOK, NQ8, DM / 2, DM / 128}; pg8::StaticOrder S; S.init(NTOK, NQ8, G, bx);
          pg8::EpiProjT<0, 2> E{ws, (PG8_LAS float*)(lds + XCH_OFF), (PG8_LAS float*)(lds + ROPE_LDS_OFF), (PG8_LAS float*)(lds + QKG_LDS_OFF), (unsigned char*)args.out + DO_Q, (PG8_LAS float*)(lds + SCL_LDS_OFF), (const float*)(ws + WS_SA), (const float*)(ws + WS_SW)};
          pg8::gemm_phase<pg8::EpiProjT<0, 2>, pg8::StaticOrder, true, true, 2>(lds, g, S, E); }
        { pg8::Gemm g{(const pg8::bf16_t*)(ws + WS_H), (const pg8::bf16_t*)(ws + WS_W1B), NTOK, NB1 - NB0, DM, DM / 64}; pg8::StaticOrder S; S.init(NTOK, NB1 - NB0, G, bx);
          pg8::EpiProjT<NB0 / 256, 0> E{ws, (PG8_LAS float*)(lds + XCH_OFF), (PG8_LAS float*)(lds + ROPE_LDS_OFF), (PG8_LAS float*)(lds + QKG_LDS_OFF), (unsigned char*)args.out + DO_Q, nullptr, nullptr, nullptr};
          pg8::gemm_phase<pg8::EpiProjT<NB0 / 256, 0>, pg8::StaticOrder, true, true, 0>(lds, g, S, E); }
        { const int nun = (NTOK / 256) * (NQ8 / 256), full = nun / G, rem = nun - full * G, light = G - rem;
          if (bx >= rem) for (int it = (bx - rem) * NWAVES + wave; it < NTOK / 48; it += light * NWAVES) gate_rows48(ws, args.in[4], it * 48, lane); }
        if (BOTH(1)) GRID_BAR();
    }

static_assert(!HY_SEPARATE_ROPE, "the attention body takes fp8 q / k rows, which only the fused in-projection epilogue writes");
#if HY_SEPARATE_ROPE
    if (IN(2)) { p2_qknorm_rope(args, vcu, G, wave, lane); if (BOTH(2)) GRID_BAR(); }
#endif

#define ATTN_UNIT(grp_, w_) do { const int b_ = (grp_) >> 1, kvh_ = (grp_) & 1, h_ = kvh_ * 4 + ((w_) >> 3), qb_ = (w_) & 7; const size_t row0_ = (size_t)b_ * SEQ + qb_ * 256; \
        const unsigned char* Q_ = (const unsigned char*)args.out + DO_Q + row0_ * 1024 + h_ * 128; unsigned char* O_ = ws + WS_MIX + row0_ * 4096 + h_ * 128; const unsigned char* K_ = ws + WS_AK + (size_t)b_ * SEQ * 256 + kvh_ * 128; \
        const unsigned char* V_ = ws + WS_AV + (size_t)(grp_) * 128 * 2048; const bf16* Z_ = (const bf16*)(ws + WS_AZ) + row0_ * 1024 + h_ * 128; \
        int seqv_ = SEQ; asm volatile("" : "+s"(seqv_)); attn::attn_dense_body<attn::bf16>(Q_, K_, V_, O_, Z_, seqv_, (char*)lds_raw); __syncthreads(); } while (0)
#if HY_SCHED_J
    const bool schedJ = one_launch && G == 256;
    if (schedJ) {
        const int xl = vcu >> 5, s = vcu & 31;
        if (s < 24) ml::mlstm_item<0>(ws, lds, xl * 24 + s, tid);
        else for (int j = 0; j < 3; ++j) ATTN_UNIT(xl, 3 * (s - 24) + j);
        GRID_BAR();
        const int n_rest = (s < 8) ? 6 : 5, n_p5 = (s < 8) ? 6 : 14, p5_0 = (s < 8) ? 6 * (xl * 8 + s) : 384 + 14 * (xl * 24 + (s - 8));
        int p5_done = 0;
        for (int jr = 0; jr < n_rest; ++jr) {
            if ((jr & 1) == 0) { const int tgt = (n_p5 * ((jr >> 1) + 1)) / 3;
                p5_batch(args, lds, p5_0 + p5_done, tgt - p5_done); p5_done = tgt; }
            const int li = s + 32 * jr;
            const int grp = (li < 8) ? xl : xl + 8 * (1 + ((li - 8) >> 5)), w = (li < 8) ? 24 + li : (li - 8) & 31;
            ATTN_UNIT(grp, w);
        }
        GRID_BAR();
    }
#else
    const bool schedJ = false;
#endif

    if (!schedJ && IN(3)) {
        for (int u = vcu; u < NSEQ * 2 * 32; u += G) ATTN_UNIT(u >> 5, u & 31);
        if (BOTH(3)) GRID_BAR();
    }

    if (!schedJ && IN(4) && DUP(4)) {
#if HY_MLSTM_REF
        p4_mlstm_recurrent(args, lds, vcu, G, tid);
#else
        for (int item = vcu; item < NSEQ * 8; item += G) ml::mlstm_item<HY_ML_PROBE_MODE>(ws, lds, item, tid);
#endif
        if (BOTH(4)) GRID_BAR(); }

    if (!schedJ && IN(4)) {
#if HY_MLSTM_REF
        p4_mlstm_recurrent(args, lds, vcu, G, tid);
#else
        for (int item = vcu; item < NSEQ * 8; item += G) ml::mlstm_item<0>(ws, lds, item, tid);
#endif
        if (BOTH(4)) GRID_BAR(); }

    if (!schedJ && IN(5) && DUP(5)) { p5_mlstm_finalize(args, lds, vcu, G, tid, wave, lane); }
    if (!schedJ && IN(5)) { p5_mlstm_finalize(args, lds, vcu, G, tid, wave, lane); if (BOTH(5)) GRID_BAR(); }

    if (IN(6)) {
        pg8::Gemm g{(const pg8::bf16_t*)(ws + WS_MIX), (const pg8::bf16_t*)(ws + WS_W2T), NTOK, DM, DM, pg8::F8_TILES + 1024 / 64}; pg8::StaticOrder S; S.init(NTOK, DM, G, bx);
        pg8::EpiOut E{args.in[0], args.in[1], args.out};
        pg8::gemm_phase<pg8::EpiOut, pg8::StaticOrder, true, true, 3>(lds, g, S, E);
    }
    if (one_launch && lo < 0) GRID_BAR_CG();
#undef IN
#undef BOTH
}

extern "C" void kernel_launch(void* const* d_in, const int* in_sizes, int n_in, void* d_out, int out_size, void* d_ws, size_t ws_size, hipStream_t stream) {
    static int grid = 0;
    if (grid == 0) {
        if (n_in != 9 || in_sizes[0] != TOK_PROMPT * DM || in_sizes[1] != (NTOK - TOK_PROMPT) * DM || out_size != NTOK * DM || ws_size < WS_END) {
            fprintf(stderr, "kernel_launch: shape mismatch n_in %d in0 %d in1 %d out %d ws %zu (need %zu)\n", n_in, n_in > 0 ? in_sizes[0] : -1, n_in > 1 ? in_sizes[1] : -1, out_size, ws_size, (size_t)WS_END); grid = -1; return; }
        int dev = 0, cus = 0, per_cu = 0;
        if (hipGetDevice(&dev) != hipSuccess || hipDeviceGetAttribute(&cus, hipDeviceAttributeMultiprocessorCount, dev) != hipSuccess) { fprintf(stderr, "kernel_launch: device query failed\n"); grid = -1; return; }
        if (hipFuncSetAttribute((const void*)hy_fwd, hipFuncAttributeMaxDynamicSharedMemorySize, LDS_BYTES) != hipSuccess) { fprintf(stderr, "kernel_launch: hipFuncSetAttribute failed\n"); grid = -1; return; }
        if (hipOccupancyMaxActiveBlocksPerMultiprocessor(&per_cu, (const void*)hy_fwd, NWAVES * 64, LDS_BYTES) != hipSuccess || per_cu < 1) { fprintf(stderr, "kernel_launch: occupancy query says %d\n", per_cu); per_cu = 1; }
        (void)hipGetLastError();
        grid = cus;
    }
    if (grid < 0) return;
    if (hipMemsetAsync((char*)d_ws + WS_CTL, 0, 65536, stream) != hipSuccess) { fprintf(stderr, "kernel_launch: hipMemsetAsync of the control words failed\n"); return; }
    Args a{};
    for (int i = 0; i < 9; ++i) a.in[i] = (const float*)d_in[i];
    a.out = (float*)d_out; a.ws = (unsigned char*)d_ws;
#if HY_N_LAUNCHES == 1
    a.ph_lo = 0; a.ph_hi = N_PHASES;
    void* kargs[] = {&a};
    hipError_t e = hipLaunchCooperativeKernel((const void*)hy_fwd, dim3(grid), dim3(NWAVES * 64), kargs, LDS_BYTES, stream);
    if (e != hipSuccess) fprintf(stderr, "kernel_launch: cooperative launch failed: %s (grid %d)\n", hipGetErrorString(e), grid);
#else
    for (int p = 0; p < N_PHASES; ++p) {
        a.ph_lo = p; a.ph_hi = p + 1;
        hipLaunchKernelGGL(hy_fwd, dim3(grid), dim3(NWAVES * 64), LDS_BYTES, stream, a);
        const hipError_t le = hipPeekAtLastError();
        if (le != hipSuccess) { fprintf(stderr, "kernel_launch: launch %d failed: %s\n", p, hipGetErrorName(le)); break; }
    }
#endif
}
```
